# Optimizing an MI355X kernel written in HIP

```python
import jax, jax.numpy as jnp
from jax import lax
import numpy as np

D_MODEL = 1024
BATCH = 1
SEQ = 16384
DEPTH = 1

CHUNK = 64
Q_BLOCK = 128
EPS = 1e-6
MAX_STREAM_OFFSET = 4096

D_RNN = D_MODEL
LRU_BLOCK_W = 256
LRU_BLOCKS = D_RNN // LRU_BLOCK_W
CONV_W = 4
LRU_C = 8.0

MLA_HEADS = 16
V_HEAD = D_MODEL // MLA_HEADS
QK_NOPE = 64
QK_ROPE = 32
QK_HEAD = QK_NOPE + QK_ROPE
Q_LORA = 768
KV_LORA = 256
ROPE_THETA = 10000.0

N_BRANCH = 2
IN_SPLITS = (D_RNN, D_RNN, Q_LORA, KV_LORA, QK_ROPE, N_BRANCH * D_MODEL)
D_IN = sum(IN_SPLITS)

N_GROUPS = 4
EXPERTS_PER_GROUP = 8
N_EXPERTS = N_GROUPS * EXPERTS_PER_GROUP
TOP_K = 2
D_EXPERT = 256
MOE_BLOCK = 128

kernel_name = "hybrid_rglru_mla_hiermoe_block"


def rms_norm(x, g):
    xf = x.astype(jnp.float32)
    y = xf * lax.rsqrt(jnp.mean(xf * xf, axis=-1, keepdims=True) + EPS)
    return (y * g.astype(jnp.float32)).astype(x.dtype)


def causal_conv(x, w, b):
    y = lax.conv_general_dilated(
        x, w[:, None, :].astype(x.dtype), window_strides=(1,),
        padding=[(CONV_W - 1, 0)], dimension_numbers=('NWC', 'WIO', 'NWC'),
        feature_group_count=x.shape[-1])
    return y + b.astype(x.dtype)


def rg_lru(x, wa, ba, wx, bx, lam):
    B, S, _ = x.shape
    xb = x.reshape(B, S, LRU_BLOCKS, LRU_BLOCK_W)
    r = jax.nn.sigmoid((jnp.einsum('bshi,hij->bshj', xb, wa).reshape(B, S, D_RNN) + ba).astype(jnp.float32))
    i = jax.nn.sigmoid((jnp.einsum('bshi,hij->bshj', xb, wx).reshape(B, S, D_RNN) + bx).astype(jnp.float32))
    log_a = -LRU_C * r * jax.nn.softplus(-lam.astype(jnp.float32))
    a = jnp.exp(log_a)
    mult = jnp.sqrt(-jnp.expm1(2.0 * log_a))
    b = mult * (i * x.astype(jnp.float32))

    def combine(left, right):
        a_l, b_l = left
        a_r, b_r = right
        return a_l * a_r, a_r * b_l + b_r

    _, h = lax.associative_scan(combine, (a, b), axis=1)
    return h.astype(x.dtype)


def rope(x, pos):
    half = QK_ROPE // 2
    freq = ROPE_THETA ** (-jnp.arange(half, dtype=jnp.float32) / half)
    ang = pos.astype(jnp.float32)[:, :, None, None] * freq
    cos, sin = jnp.cos(ang), jnp.sin(ang)
    x1 = x[..., :half].astype(jnp.float32)
    x2 = x[..., half:].astype(jnp.float32)
    return jnp.concatenate([x1 * cos - x2 * sin, x1 * sin + x2 * cos], axis=-1).astype(x.dtype)


def chunk_causal_attention(q, k, v):
    B, S, H, _ = q.shape
    scale = QK_HEAD ** -0.5
    outs = []
    for blk in range(S // Q_BLOCK):
        q0 = blk * Q_BLOCK
        k_end = q0 + Q_BLOCK
        qb = q[:, q0:k_end]
        s = jnp.einsum('bqhd,bkhd->bhqk', qb, k[:, :k_end]).astype(jnp.float32) * scale
        q_chunk = (q0 + jnp.arange(Q_BLOCK)) // CHUNK
        k_chunk = jnp.arange(k_end) // CHUNK
        mask = k_chunk[None, :] <= q_chunk[:, None]
        s = jnp.where(mask, s, -jnp.inf)
        p = jax.nn.softmax(s, axis=-1).astype(v.dtype)
        outs.append(jnp.einsum('bhqk,bkhd->bqhd', p, v[:, :k_end]))
    return jnp.concatenate(outs, axis=1).reshape(B, S, H * V_HEAD)


def mla(q_c, kv_c, k_pe, pos, q_a_g, w_uq, kv_a_g, w_ukv, q_norm_g, k_norm_g):
    B, S, _ = q_c.shape
    q = (rms_norm(q_c, q_a_g) @ w_uq).reshape(B, S, MLA_HEADS, QK_HEAD)
    kv = (rms_norm(kv_c, kv_a_g) @ w_ukv).reshape(B, S, MLA_HEADS, QK_NOPE + V_HEAD)
    k_nope, v = kv[..., :QK_NOPE], kv[..., QK_NOPE:]
    k_pe_h = jnp.broadcast_to(k_pe[:, :, None, :], (B, S, MLA_HEADS, QK_ROPE))
    k = jnp.concatenate([k_nope, k_pe_h], axis=-1)
    q = rms_norm(q, q_norm_g)
    k = rms_norm(k, k_norm_g)
    q = jnp.concatenate([q[..., :QK_NOPE], rope(q[..., QK_NOPE:], pos)], axis=-1)
    k = jnp.concatenate([k[..., :QK_NOPE], rope(k[..., QK_NOPE:], pos)], axis=-1)
    return chunk_causal_attention(q, k, v)


def hier_moe(x, wg, bg, we, be, w_gate, w_up, w_down):
    B, S, D = x.shape
    T = B * S
    xt = x.reshape(T, D)
    xf = xt.astype(jnp.float32)
    g_logits = xf @ wg.astype(jnp.float32) + bg.astype(jnp.float32)
    g_prob = jax.nn.softmax(g_logits, axis=-1)
    grp = jnp.argmax(g_logits, axis=-1)
    p_grp = jnp.take_along_axis(g_prob, grp[:, None], axis=1)
    e_logits = (xf @ we.astype(jnp.float32) + be.astype(jnp.float32)).reshape(T, N_GROUPS, EXPERTS_PER_GROUP)
    e_in = jnp.take_along_axis(e_logits, grp[:, None, None], axis=1)[:, 0]
    top_v, top_i = lax.top_k(e_in, TOP_K)
    combine = p_grp * jax.nn.softmax(top_v, axis=-1)
    expert = grp[:, None] * EXPERTS_PER_GROUP + top_i

    A = T * TOP_K
    e_flat = expert.reshape(A)
    tok_flat = jnp.arange(A, dtype=jnp.int32) // TOP_K
    c_flat = combine.reshape(A)
    order = jnp.argsort(e_flat)
    e_sorted = e_flat[order]
    counts = jnp.bincount(e_flat, length=N_EXPERTS)
    padded = (counts + MOE_BLOCK - 1) // MOE_BLOCK * MOE_BLOCK
    starts = jnp.cumsum(counts) - counts
    p_ends = jnp.cumsum(padded)
    p_starts = p_ends - padded
    dest = p_starts[e_sorted] + (jnp.arange(A) - starts[e_sorted])
    P = A + N_EXPERTS * MOE_BLOCK
    n_blk = P // MOE_BLOCK
    tok_pad = jnp.full((P,), T, jnp.int32).at[dest].set(tok_flat[order])
    c_pad = jnp.zeros((P,), jnp.float32).at[dest].set(c_flat[order])
    blk_expert = jnp.clip(jnp.searchsorted(p_ends, jnp.arange(n_blk) * MOE_BLOCK, side='right'), 0, N_EXPERTS - 1)
    x_pad = jnp.concatenate([xt, jnp.zeros((1, D), xt.dtype)], axis=0)[tok_pad].reshape(n_blk, MOE_BLOCK, D)

    def expert_block(args):
        xb, e = args
        hb = jax.nn.silu(xb @ w_gate[e]) * (xb @ w_up[e])
        return hb @ w_down[e]

    y = lax.map(expert_block, (x_pad, blk_expert)).reshape(P, D).astype(jnp.float32) * c_pad[:, None]
    out = jax.ops.segment_sum(y, tok_pad, num_segments=T + 1)[:T]
    return out.astype(x.dtype).reshape(B, S, D)


def setup_inputs(seed: int = 0) -> dict:
    key = jax.random.key(seed)
    ks = jax.random.split(key, 28)
    L = DEPTH

    def nrm(k, shape, s):
        return jax.random.normal(k, shape, jnp.float32) * s

    def gain(k, n):
        return 1.0 + 0.05 * jax.random.normal(k, (L, n), jnp.float32)

    x = jax.random.normal(ks[0], (BATCH, SEQ, D_MODEL), jnp.float32)
    offset = jax.random.randint(ks[1], (BATCH, 1), 0, MAX_STREAM_OFFSET, dtype=jnp.int32)
    positions = offset + jnp.arange(SEQ, dtype=jnp.int32)[None, :]
    a0 = jax.random.uniform(ks[2], (L, D_RNN), jnp.float32, 0.9, 0.999)
    s0 = a0 ** (1.0 / LRU_C)
    lru_lambda = jnp.log(s0) - jnp.log1p(-s0)
    return {
        "x": x,
        "positions": positions,
        "norm_mix_g": gain(ks[3], D_MODEL),
        "w_in": nrm(ks[4], (L, D_MODEL, D_IN), D_MODEL ** -0.5),
        "conv_w": nrm(ks[5], (L, CONV_W, D_RNN), CONV_W ** -0.5),
        "conv_b": nrm(ks[6], (L, D_RNN), 0.02),
        "lru_wa": nrm(ks[7], (L, LRU_BLOCKS, LRU_BLOCK_W, LRU_BLOCK_W), LRU_BLOCK_W ** -0.5),
        "lru_ba": nrm(ks[8], (L, D_RNN), 0.02),
        "lru_wx": nrm(ks[9], (L, LRU_BLOCKS, LRU_BLOCK_W, LRU_BLOCK_W), LRU_BLOCK_W ** -0.5),
        "lru_bx": nrm(ks[10], (L, D_RNN), 0.02),
        "lru_lambda": lru_lambda,
        "q_a_g": gain(ks[11], Q_LORA),
        "w_uq": nrm(ks[12], (L, Q_LORA, MLA_HEADS * QK_HEAD), Q_LORA ** -0.5),
        "kv_a_g": gain(ks[13], KV_LORA),
        "w_ukv": nrm(ks[14], (L, KV_LORA, MLA_HEADS * (QK_NOPE + V_HEAD)), KV_LORA ** -0.5),
        "q_norm_g": gain(ks[15], QK_HEAD),
        "k_norm_g": gain(ks[16], QK_HEAD),
        "w_out": nrm(ks[17], (L, D_MODEL, D_MODEL), D_MODEL ** -0.5),
        "norm_ffn_g": gain(ks[18], D_MODEL),
        "router_group_w": nrm(ks[19], (L, D_MODEL, N_GROUPS), D_MODEL ** -0.5),
        "router_group_b": nrm(ks[20], (L, N_GROUPS), 0.01),
        "router_expert_w": nrm(ks[21], (L, D_MODEL, N_EXPERTS), D_MODEL ** -0.5),
        "router_expert_b": nrm(ks[22], (L, N_EXPERTS), 0.01),
        "w_gate": nrm(ks[23], (L, N_EXPERTS, D_MODEL, D_EXPERT), D_MODEL ** -0.5),
        "w_up": nrm(ks[24], (L, N_EXPERTS, D_MODEL, D_EXPERT), D_MODEL ** -0.5),
        "w_down": nrm(ks[25], (L, N_EXPERTS, D_EXPERT, D_MODEL), D_EXPERT ** -0.5),
    }


def reference(x, positions, norm_mix_g, w_in, conv_w, conv_b, lru_wa, lru_ba, lru_wx, lru_bx,
              lru_lambda, q_a_g, w_uq, kv_a_g, w_ukv, q_norm_g, k_norm_g, w_out, norm_ffn_g,
              router_group_w, router_group_b, router_expert_w, router_expert_b,
              w_gate, w_up, w_down):
    B, S, _ = x.shape
    split_points = np.cumsum(IN_SPLITS)[:-1].tolist()
    h = x
    for l in range(DEPTH):
        u = rms_norm(h, norm_mix_g[l])
        proj = u @ w_in[l]
        x_rnn, g_rnn, q_c, kv_c, k_pe, gate_logits = jnp.split(proj, split_points, axis=-1)
        xa = causal_conv(x_rnn, conv_w[l], conv_b[l])
        ya = rg_lru(xa, lru_wa[l], lru_ba[l], lru_wx[l], lru_bx[l], lru_lambda[l]) * jax.nn.gelu(g_rnn)
        yb = mla(q_c, kv_c, k_pe, positions, q_a_g[l], w_uq[l], kv_a_g[l], w_ukv[l], q_norm_g[l], k_norm_g[l])
        gates = jax.nn.sigmoid(gate_logits.astype(jnp.float32)).reshape(B, S, N_BRANCH, D_MODEL)
        merged = gates[:, :, 0] * ya.astype(jnp.float32) + gates[:, :, 1] * yb.astype(jnp.float32)
        h = h + merged.astype(h.dtype) @ w_out[l]
        h = h + hier_moe(rms_norm(h, norm_ffn_g[l]), router_group_w[l], router_group_b[l],
                         router_expert_w[l], router_expert_b[l], w_gate[l], w_up[l], w_down[l])
    return h
```

```cpp
#include <hip/hip_runtime.h>
#include <hip/hip_bf16.h>
#include <cstdint>
#include <cstdio>
#include <cmath>
namespace orc {
typedef unsigned short bf16_t;
constexpr int M = 16384, D = 1024, DIN = 5152;
__device__ __forceinline__ float bf2f(bf16_t v) { return __uint_as_float(((unsigned)v) << 16); }
__device__ __forceinline__ bf16_t f2bf(float f) { unsigned u = __float_as_uint(f); return (bf16_t)((u + 0x7fffu + ((u >> 16) & 1u)) >> 16); }
__device__ __forceinline__ float wsum(float v) {
#pragma unroll
    for (int o = 1; o < 64; o <<= 1) v += __shfl_xor(v, o);
    return v;
}
__device__ __forceinline__ float sigm(float x) { return 1.f / (1.f + expf(-x)); }
__device__ __forceinline__ float gelu_t(float x) { return 0.5f * x * (1.f + tanhf(0.7978845608028654f * (x + 0.044715f * x * x * x))); }

__global__ void __launch_bounds__(256) nv_proj(const float* __restrict__ x, const int* __restrict__ pos, const float* __restrict__ g_mix, const float* __restrict__ w_in,
    const float* __restrict__ q_a_g, const float* __restrict__ w_uq, const float* __restrict__ kv_a_g, const float* __restrict__ w_ukv,
    const float* __restrict__ q_norm_g, const float* __restrict__ k_norm_g,
    bf16_t* XR, bf16_t* GR, bf16_t* GA, bf16_t* GB, bf16_t* Q, bf16_t* K, bf16_t* V) {
    extern __shared__ float sm[];
    float4* u4 = (float4*)sm;
    float* pr = sm + 4096;
    float* aux = pr + 4 * DIN;
    const int tid = threadIdx.x, lane = tid & 63, w = tid >> 6, t0 = blockIdx.x * 4;
    {
        const float* xr = x + (size_t)(t0 + w) * D;
        float v[16]; float ss = 0.f;
#pragma unroll
        for (int j = 0; j < 16; ++j) { v[j] = xr[lane + 64 * j]; ss += v[j] * v[j]; }
        ss = wsum(ss); const float rstd = rsqrtf(ss * (1.f / 1024.f) + 1e-6f);
#pragma unroll
        for (int j = 0; j < 16; ++j) sm[(lane + 64 * j) * 4 + w] = v[j] * rstd * g_mix[lane + 64 * j];
    }
    __syncthreads();
    for (int n = tid; n < DIN; n += 256) {
        float a0 = 0.f, a1 = 0.f, a2 = 0.f, a3 = 0.f;
#pragma unroll 8
        for (int k = 0; k < 1024; ++k) { const float wv = w_in[(size_t)k * DIN + n]; const float4 uu = u4[k]; a0 += uu.x * wv; a1 += uu.y * wv; a2 += uu.z * wv; a3 += uu.w * wv; }
        pr[n] = a0; pr[DIN + n] = a1; pr[2 * DIN + n] = a2; pr[3 * DIN + n] = a3;
    }
    __syncthreads();
    for (int i = tid; i < 4096; i += 256) { const int t = i >> 10, c = i & 1023; const size_t o = (size_t)(t0 + t) * D + c; const float* p = pr + t * DIN;
        XR[o] = f2bf(p[c]); GR[o] = f2bf(gelu_t(p[1024 + c])); GA[o] = f2bf(sigm(p[3104 + c])); GB[o] = f2bf(sigm(p[4128 + c])); }
    float* qn = sm;
    {
        const float* p = pr + w * DIN; float ss = 0.f;
        for (int k = lane; k < 768; k += 64) { const float v = p[2048 + k]; ss += v * v; }
        ss = wsum(ss); const float rs = rsqrtf(ss * (1.f / 768.f) + 1e-6f);
        for (int k = lane; k < 768; k += 64) qn[w * 768 + k] = p[2048 + k] * rs * q_a_g[k];
        float s2 = 0.f;
        for (int k = lane; k < 256; k += 64) { const float v = p[2816 + k]; s2 += v * v; }
        s2 = wsum(s2); const float rs2 = rsqrtf(s2 * (1.f / 256.f) + 1e-6f);
        for (int k = lane; k < 256; k += 64) aux[w * 256 + k] = p[2816 + k] * rs2 * kv_a_g[k];
    }
    __syncthreads();
    for (int n = tid; n < 1536; n += 256) {
        float a0 = 0.f, a1 = 0.f, a2 = 0.f, a3 = 0.f;
#pragma unroll 8
        for (int k = 0; k < 768; ++k) { const float wv = w_uq[(size_t)k * 1536 + n]; a0 += qn[k] * wv; a1 += qn[768 + k] * wv; a2 += qn[1536 + k] * wv; a3 += qn[2304 + k] * wv; }
        pr[n] = a0; pr[DIN + n] = a1; pr[2 * DIN + n] = a2; pr[3 * DIN + n] = a3;
    }
    for (int n = tid; n < 2048; n += 256) {
        float a0 = 0.f, a1 = 0.f, a2 = 0.f, a3 = 0.f;
#pragma unroll 8
        for (int k = 0; k < 256; ++k) { const float wv = w_ukv[(size_t)k * 2048 + n]; a0 += aux[k] * wv; a1 += aux[256 + k] * wv; a2 += aux[512 + k] * wv; a3 += aux[768 + k] * wv; }
        pr[3104 + n] = a0; pr[DIN + 3104 + n] = a1; pr[2 * DIN + 3104 + n] = a2; pr[3 * DIN + 3104 + n] = a3;
    }
    __syncthreads();
    if (tid < 64) {
        const int t = tid >> 4, h = tid & 15; const float p = (float)pos[t0 + t];
        const float* qh = pr + t * DIN + h * 96; const float* kn = pr + t * DIN + 3104 + h * 128; const float* kpe = pr + t * DIN + 3072;
        float ss = 0.f; for (int d = 0; d < 96; ++d) ss += qh[d] * qh[d];
        const float rs = rsqrtf(ss * (1.f / 96.f) + 1e-6f);
        float sk = 0.f; for (int d = 0; d < 64; ++d) sk += kn[d] * kn[d]; for (int j = 0; j < 32; ++j) sk += kpe[j] * kpe[j];
        const float rk = rsqrtf(sk * (1.f / 96.f) + 1e-6f);
        bf16_t* Qo = Q + ((size_t)(t0 + t) * 16 + h) * 96; bf16_t* Ko = K + ((size_t)(t0 + t) * 16 + h) * 96;
        for (int d = 0; d < 64; ++d) { Qo[d] = f2bf(qh[d] * rs * q_norm_g[d]); Ko[d] = f2bf(kn[d] * rk * k_norm_g[d]); }
        for (int j = 0; j < 16; ++j) {
            const float fr = powf(10000.f, -(float)j / 16.f); const float ang = p * fr; const float cs = cosf(ang), sn = sinf(ang);
            const float q1 = qh[64 + j] * rs * q_norm_g[64 + j], q2 = qh[80 + j] * rs * q_norm_g[80 + j];
            Qo[64 + j] = f2bf(q1 * cs - q2 * sn); Qo[80 + j] = f2bf(q1 * sn + q2 * cs);
            const float k1 = kpe[j] * rk * k_norm_g[64 + j], k2 = kpe[16 + j] * rk * k_norm_g[80 + j];
            Ko[64 + j] = f2bf(k1 * cs - k2 * sn); Ko[80 + j] = f2bf(k1 * sn + k2 * cs);
        }
        for (int d = 0; d < 64; ++d) V[(size_t)(t0 + t) * D + h * 64 + d] = f2bf(kn[64 + d]);
    }
}

__global__ void __launch_bounds__(64) nv_attn(const bf16_t* __restrict__ Q, const bf16_t* __restrict__ K, const bf16_t* __restrict__ V, bf16_t* GBio) {
    __shared__ float Ks[64 * 96]; __shared__ float Vs[64 * 64];
    const int c = blockIdx.x, h = blockIdx.y, lane = threadIdx.x, t = c * 64 + lane;
    float q[96]; const float scale = 0.10206207261596575f;
#pragma unroll
    for (int d = 0; d < 96; ++d) q[d] = bf2f(Q[((size_t)t * 16 + h) * 96 + d]) * scale;
    float o[64];
#pragma unroll
    for (int d = 0; d < 64; ++d) o[d] = 0.f;
    float m = -INFINITY, l = 0.f;
    for (int kt = 0; kt <= c; ++kt) {
        __syncthreads();
        { const bf16_t* kr = K + ((size_t)(kt * 64 + lane) * 16 + h) * 96; const bf16_t* vr = V + (size_t)(kt * 64 + lane) * D + h * 64;
#pragma unroll 8
          for (int d = 0; d < 96; ++d) Ks[lane * 96 + d] = bf2f(kr[d]);
#pragma unroll 8
          for (int d = 0; d < 64; ++d) Vs[lane * 64 + d] = bf2f(vr[d]); }
        __syncthreads();
        for (int j = 0; j < 64; ++j) {
            float s = 0.f;
#pragma unroll
            for (int d = 0; d < 96; ++d) s += q[d] * Ks[j * 96 + d];
            const float mn = fmaxf(m, s), al = __expf(m - mn), p = __expf(s - mn);
            l = l * al + p; m = mn;
#pragma unroll
            for (int d = 0; d < 64; ++d) o[d] = o[d] * al + p * Vs[j * 64 + d];
        }
    }
    const float il = 1.f / l;
#pragma unroll
    for (int d = 0; d < 64; ++d) { const size_t idx = (size_t)t * D + h * 64 + d; GBio[idx] = f2bf(bf2f(GBio[idx]) * o[d] * il); }
}

__global__ void __launch_bounds__(256) nv_lru_ab(const bf16_t* __restrict__ XR, const float* __restrict__ conv_w, const float* __restrict__ conv_b,
    const float* __restrict__ wa, const float* __restrict__ ba, const float* __restrict__ wx, const float* __restrict__ bx, const float* __restrict__ lam,
    float* LA, float* BB) {
    __shared__ float xa[4 * 1024];
    const int tid = threadIdx.x, t0 = blockIdx.x * 4;
    for (int i = tid; i < 4096; i += 256) { const int t = i >> 10, c = i & 1023, tt = t0 + t; float acc = conv_b[c];
#pragma unroll
        for (int k = 0; k < 4; ++k) { const int ts = tt - 3 + k; if (ts >= 0) acc += conv_w[k * 1024 + c] * bf2f(XR[(size_t)ts * D + c]); }
        xa[i] = acc; }
    __syncthreads();
    for (int blk = 0; blk < 4; ++blk) {
        const int c = blk * 256 + tid;
        float r0 = 0.f, r1 = 0.f, r2 = 0.f, r3 = 0.f, i0 = 0.f, i1 = 0.f, i2 = 0.f, i3 = 0.f;
#pragma unroll 4
        for (int i = 0; i < 256; ++i) { const float a = wa[blk * 65536 + i * 256 + tid], b = wx[blk * 65536 + i * 256 + tid];
            const float x0 = xa[blk * 256 + i], x1 = xa[1024 + blk * 256 + i], x2 = xa[2048 + blk * 256 + i], x3 = xa[3072 + blk * 256 + i];
            r0 += x0 * a; r1 += x1 * a; r2 += x2 * a; r3 += x3 * a; i0 += x0 * b; i1 += x1 * b; i2 += x2 * b; i3 += x3 * b; }
        const float sp = log1pf(expf(-lam[c]));
        const float rr[4] = {r0, r1, r2, r3}, ii[4] = {i0, i1, i2, i3};
#pragma unroll
        for (int t = 0; t < 4; ++t) { const float r = sigm(rr[t] + ba[c]), iv = sigm(ii[t] + bx[c]); const float la = -8.f * r * sp; const float mult = sqrtf(-expm1f(2.f * la));
            LA[(size_t)(t0 + t) * D + c] = la; BB[(size_t)(t0 + t) * D + c] = mult * iv * xa[t * 1024 + c]; }
    }
}

__global__ void __launch_bounds__(256) nv_scan(const float* __restrict__ LA, const float* __restrict__ BB, bf16_t* GRio, const bf16_t* __restrict__ GA, const bf16_t* __restrict__ YB) {
    const int c = blockIdx.x * 256 + threadIdx.x; float h = 0.f;
    for (int t = 0; t < M; t += 8) {
        float la[8], bb[8], gr[8], ga[8], yb[8];
#pragma unroll
        for (int j = 0; j < 8; ++j) { const size_t o = (size_t)(t + j) * D + c; la[j] = LA[o]; bb[j] = BB[o]; gr[j] = bf2f(GRio[o]); ga[j] = bf2f(GA[o]); yb[j] = bf2f(YB[o]); }
#pragma unroll
        for (int j = 0; j < 8; ++j) { h = expf(la[j]) * h + bb[j]; GRio[(size_t)(t + j) * D + c] = f2bf(h * gr[j] * ga[j] + yb[j]); }
    }
}

__global__ void __launch_bounds__(256) nv_wout(const float* __restrict__ x, const bf16_t* __restrict__ MG, const float* __restrict__ w_out, float* H) {
    __shared__ float4 m4[1024];
    const int tid = threadIdx.x, t0 = blockIdx.x * 4;
    for (int i = tid; i < 4096; i += 256) { const int t = i >> 10, c = i & 1023; ((float*)m4)[c * 4 + t] = bf2f(MG[(size_t)(t0 + t) * D + c]); }
    __syncthreads();
    float acc[4][4];
#pragma unroll
    for (int j = 0; j < 4; ++j)
#pragma unroll
        for (int t = 0; t < 4; ++t) acc[j][t] = 0.f;
#pragma unroll 4
    for (int k = 0; k < 1024; ++k) { const float4 mm = m4[k];
#pragma unroll
        for (int j = 0; j < 4; ++j) { const float wv = w_out[(size_t)k * D + tid + 256 * j]; acc[j][0] += mm.x * wv; acc[j][1] += mm.y * wv; acc[j][2] += mm.z * wv; acc[j][3] += mm.w * wv; } }
#pragma unroll
    for (int j = 0; j < 4; ++j)
#pragma unroll
        for (int t = 0; t < 4; ++t) { const size_t o = (size_t)(t0 + t) * D + tid + 256 * j; H[o] = x[o] + acc[j][t]; }
}

__global__ void __launch_bounds__(256) nv_moe(float* H, const float* __restrict__ g_ffn, const float* __restrict__ wg, const float* __restrict__ bg, const float* __restrict__ we, const float* __restrict__ be,
    const float* __restrict__ w_gate, const float* __restrict__ w_up, const float* __restrict__ w_down) {
    __shared__ float xs[1024], hb[256], lg[36], red[4], cw[2]; __shared__ int sel[2];
    const int tid = threadIdx.x, lane = tid & 63, w = tid >> 6; const size_t row = (size_t)blockIdx.x * D;
    float v[4]; float ss = 0.f;
#pragma unroll
    for (int j = 0; j < 4; ++j) { v[j] = H[row + tid + 256 * j]; ss += v[j] * v[j]; }
    ss = wsum(ss); if (lane == 0) red[w] = ss; __syncthreads();
    const float rstd = rsqrtf((red[0] + red[1] + red[2] + red[3]) * (1.f / 1024.f) + 1e-6f);
#pragma unroll
    for (int j = 0; j < 4; ++j) xs[tid + 256 * j] = v[j] * rstd * g_ffn[tid + 256 * j];
    __syncthreads();
    if (tid < 36) { float a = 0.f;
        if (tid < 4) { for (int k = 0; k < 1024; ++k) a += xs[k] * wg[k * 4 + tid]; a += bg[tid]; }
        else { const int j = tid - 4; for (int k = 0; k < 1024; ++k) a += xs[k] * we[k * 32 + j]; a += be[j]; }
        lg[tid] = a; }
    __syncthreads();
    if (tid == 0) {
        int grp = 0; float mx = lg[0]; for (int j = 1; j < 4; ++j) if (lg[j] > mx) { mx = lg[j]; grp = j; }
        float den = 0.f; for (int j = 0; j < 4; ++j) den += expf(lg[j] - mx);
        const float pg = 1.f / den;
        const float* e = lg + 4 + grp * 8; int i1 = 0; for (int j = 1; j < 8; ++j) if (e[j] > e[i1]) i1 = j;
        int i2 = (i1 == 0) ? 1 : 0; for (int j = 0; j < 8; ++j) if (j != i1 && e[j] > e[i2]) i2 = j;
        const float e2 = expf(e[i2] - e[i1]); const float s1 = 1.f / (1.f + e2), s2 = e2 / (1.f + e2);
        cw[0] = pg * s1; cw[1] = pg * s2; sel[0] = grp * 8 + i1; sel[1] = grp * 8 + i2;
    }
    __syncthreads();
    float oa[4] = {0.f, 0.f, 0.f, 0.f};
    for (int kk = 0; kk < 2; ++kk) {
        const int e = sel[kk]; const float* wgp = w_gate + (size_t)e * 262144 + tid; const float* wup = w_up + (size_t)e * 262144 + tid;
        float g = 0.f, u = 0.f;
#pragma unroll 8
        for (int k = 0; k < 1024; ++k) { g += xs[k] * wgp[k * 256]; u += xs[k] * wup[k * 256]; }
        hb[tid] = g / (1.f + expf(-g)) * u;
        __syncthreads();
        const float* wd = w_down + (size_t)e * 262144 + tid; float a[4] = {0.f, 0.f, 0.f, 0.f};
#pragma unroll 4
        for (int i = 0; i < 256; ++i) { const float hv = hb[i];
#pragma unroll
            for (int j = 0; j < 4; ++j) a[j] += hv * wd[i * 1024 + 256 * j]; }
#pragma unroll
        for (int j = 0; j < 4; ++j) oa[j] += cw[kk] * a[j];
        __syncthreads();
    }
#pragma unroll
    for (int j = 0; j < 4; ++j) H[row + tid + 256 * j] = v[j] + oa[j];
}

constexpr size_t MiB = 1u << 20;
static void run(void* const* d_in, float* d_out, unsigned char* ws, hipStream_t stream) {
    const float* x = (const float*)d_in[0]; const int* pos = (const int*)d_in[1];
    bf16_t* XR = (bf16_t*)(ws + 0 * MiB); bf16_t* GR = (bf16_t*)(ws + 32 * MiB); bf16_t* Q = (bf16_t*)(ws + 64 * MiB); bf16_t* K = (bf16_t*)(ws + 112 * MiB); bf16_t* V = (bf16_t*)(ws + 160 * MiB);
    float* LA = (float*)(ws + 64 * MiB); float* BB = (float*)(ws + 128 * MiB);
    bf16_t* GA = (bf16_t*)d_out; bf16_t* GB = GA + (size_t)M * D;
    static bool attr = false;
    const int lds1 = (4096 + 4 * DIN + 1024) * 4;
    if (!attr) { (void)hipFuncSetAttribute((const void*)nv_proj, hipFuncAttributeMaxDynamicSharedMemorySize, lds1); attr = true; }
    nv_proj<<<M / 4, 256, lds1, stream>>>(x, pos, (const float*)d_in[2], (const float*)d_in[3], (const float*)d_in[11], (const float*)d_in[12], (const float*)d_in[13], (const float*)d_in[14],
        (const float*)d_in[15], (const float*)d_in[16], XR, GR, GA, GB, Q, K, V);
    nv_attn<<<dim3(256, 16), 64, 0, stream>>>(Q, K, V, GB);
    nv_lru_ab<<<M / 4, 256, 0, stream>>>(XR, (const float*)d_in[4], (const float*)d_in[5], (const float*)d_in[6], (const float*)d_in[7], (const float*)d_in[8], (const float*)d_in[9], (const float*)d_in[10], LA, BB);
    nv_scan<<<4, 256, 0, stream>>>(LA, BB, GR, GA, GB);
    nv_wout<<<M / 4, 256, 0, stream>>>(x, GR, (const float*)d_in[17], d_out);
    nv_moe<<<M, 256, 0, stream>>>(d_out, (const float*)d_in[18], (const float*)d_in[19], (const float*)d_in[20], (const float*)d_in[21], (const float*)d_in[22],
        (const float*)d_in[23], (const float*)d_in[24], (const float*)d_in[25]);
}
}
extern "C" void kernel_launch(void* const* d_in, const int* in_sizes, int n_in, void* d_out, int out_size, void* d_ws, size_t ws_size, hipStream_t stream) {
    (void)in_sizes; (void)n_in; (void)out_size; (void)ws_size;
    orc::run(d_in, (float*)d_out, (unsigned char*)d_ws, stream);
}
```

```cpp
#include <hip/hip_runtime.h>
#include <hip/hip_bf16.h>
#include <cstdint>
#include <cstdio>
#include <cmath>
namespace mk {
#define LAS __attribute__((address_space(3)))
#define GAS __attribute__((address_space(1)))
typedef unsigned short bf16_t;
typedef short bf16x8 __attribute__((ext_vector_type(8)));
typedef short s16x4 __attribute__((ext_vector_type(4)));
typedef float f32x2 __attribute__((ext_vector_type(2)));
typedef float f32x4 __attribute__((ext_vector_type(4)));
typedef float f32x16 __attribute__((ext_vector_type(16)));
typedef unsigned u32x2 __attribute__((ext_vector_type(2)));
typedef unsigned u32x4 __attribute__((ext_vector_type(4)));
typedef GAS unsigned gu32;

constexpr int M = 16384, D = 1024, NWAVES = 8, NTHREADS = 512;
constexpr float EPS = 1e-6f, LOG2E = 1.4426950408889634f;
constexpr size_t MiB = 1u << 20;
constexpr size_t WS_CTL = 0, CTL_BYTES = 1 * MiB;
constexpr size_t WS_WIN = 1 * MiB, WS_WUQ = 12 * MiB, WS_WUKV = 15 * MiB, WS_WLRU = 16 * MiB, WS_WOUT = 17 * MiB;
constexpr size_t WS_CS = 19 * MiB, WS_KPE = 21 * MiB, WS_MISC = 23 * MiB, WS_LIST = 25 * MiB;
constexpr size_t WS_R1 = 29 * MiB, WS_XR = 77 * MiB, WS_GR = 109 * MiB, WS_GA = 141 * MiB, WS_QC = 173 * MiB, WS_KVC = 197 * MiB, WS_KIMG = 205 * MiB, WS_DBG = 253 * MiB;
constexpr size_t MISC_HALO = 0, MISC_HEND = 512 * 1024, MISC_AEND = 768 * 1024, MISC_KSSQ = 1024 * 1024, MISC_WR = 1152 * 1024, MISC_TOK = 1408 * 1024;
constexpr size_t WS_SSQP = 253 * MiB, SSQP_KV = 786432, SSQP_H = 1048576;
constexpr size_t WS_Y = WS_QC;
constexpr size_t WS_WGU = WS_R1, WS_WDN = WS_R1 + 32 * MiB;
constexpr int CW_TMO = 0, CW_CODE = 1, CW_BAR = 4096, CW_CNT = 8192;
constexpr size_t CTL_SSQ_Q = 65536, CTL_SSQ_KV = 131072, CTL_SSQ_H = 196608;
constexpr int RING_BYTES = 131072, LDSCTL_OFF = RING_BYTES, MISC_OFF = LDSCTL_OFF + 320, LDS_XCH = 135168  , LDS_BYTES = 147456;

#define RLX_AGENT __ATOMIC_RELAXED, __HIP_MEMORY_SCOPE_AGENT
#define LDS_WAIT() asm volatile("s_waitcnt lgkmcnt(0)" ::: "memory")
#define VM_WAIT() asm volatile("s_waitcnt vmcnt(0)" ::: "memory")
__device__ __forceinline__ float bf2f(unsigned v) { return __uint_as_float(v << 16); }
__device__ __forceinline__ unsigned f2bf(float f) { unsigned u = __float_as_uint(f); return (u + 0x7fffu + ((u >> 16) & 1u)) >> 16; }
__device__ __forceinline__ unsigned pk2(float lo, float hi) { typedef __bf16 bf16x2_t __attribute__((ext_vector_type(2))); f32x2 v = {lo, hi}; bf16x2_t b = __builtin_convertvector(v, bf16x2_t); return __builtin_bit_cast(unsigned, b); }
__device__ __forceinline__ float lo2f(unsigned w) { return __uint_as_float(w << 16); }
__device__ __forceinline__ float hi2f(unsigned w) { return __uint_as_float(w & 0xffff0000u); }
__device__ __forceinline__ float fexp2(float x) { return __builtin_amdgcn_exp2f(x); }
__device__ __forceinline__ float frcp(float x) { return __builtin_amdgcn_rcpf(x); }
__device__ __forceinline__ float fsigm(float x) { return frcp(1.f + fexp2(-x * LOG2E)); }
__device__ __forceinline__ float fgelu(float x) { const float u = 0.7978845608028654f * (x + 0.044715f * x * x * x); return x * frcp(1.f + fexp2(-2.f * LOG2E * u)); }
__device__ __forceinline__ float wave_sum(float v) {
#pragma unroll
    for (int o = 1; o < 64; o <<= 1) v += __shfl_xor(v, o);
    return v;
}

#define XB_TMO      128
#define XB_XCNT(j)  (256  + 64 * (j))
#define XB_XSUB(j)  (1280 + 64 * (j))
#define XB_XGEN(j)  (2304 + 64 * (j))
#define XB_TOP      3328
#define XB_TOPGEN   3392
#define XCD_BAR_WORDS 3456
#define XB_SPIN_CAP (1u << 18)
__device__ __forceinline__ unsigned xb_ld(unsigned* p)              { return __hip_atomic_load(p, __ATOMIC_RELAXED, __HIP_MEMORY_SCOPE_AGENT); }
__device__ __forceinline__ unsigned xb_add(unsigned* p, unsigned v) { return __hip_atomic_fetch_add(p, v, __ATOMIC_RELAXED, __HIP_MEMORY_SCOPE_AGENT); }
__device__ __forceinline__ unsigned xb_xcc_id() { return (unsigned)__builtin_amdgcn_s_getreg((3 << 11) | 20) & 0xFu; }
#define XB_SPIN(cond, bar) do { unsigned _sp = 0; while (cond) { __builtin_amdgcn_s_sleep(1); \
    if ((++_sp & 255u) == 0u) { if (xb_ld(&(bar)[XB_TMO])) break; if (_sp > XB_SPIN_CAP) { atomicAdd(&(bar)[XB_TMO], 1u); break; } } } } while (0)
struct XcdBarrier { unsigned* bar; unsigned x; volatile LAS unsigned* st; };
__device__ __forceinline__ XcdBarrier xcd_barrier_post(unsigned* bar, volatile LAS unsigned* st) {
    XcdBarrier b; b.bar = bar; b.x = xb_xcc_id(); b.st = st;
    if (threadIdx.x == 0) (void)xb_add(&bar[XB_XCNT(b.x)], 1u);
    return b;
}
__device__ __forceinline__ void xcd_barrier_complete(unsigned* bar, unsigned x, unsigned& nloc, unsigned& nx) {
    const unsigned G = gridDim.x * gridDim.y * gridDim.z;
    unsigned sum, cnt, mine, sp = 0u;
    for (;;) {
        sum = 0u; cnt = 0u; mine = 0u;
#pragma unroll
        for (unsigned j = 0; j < 16; ++j) { const unsigned c = xb_ld(&bar[XB_XCNT(j)]); sum += c; cnt += (c > 0u) ? 1u : 0u; mine = (j == x) ? c : mine; }
        if (sum == G) break;
        __builtin_amdgcn_s_sleep(1);
        if ((++sp & 255u) == 0u) { if (xb_ld(&bar[XB_TMO])) break; if (sp > XB_SPIN_CAP) { atomicAdd(&bar[XB_TMO], 1u); break; } }
    }
    nloc = mine > 0u ? mine : 1u; nx = cnt > 0u ? cnt : 1u;
}
__device__ __forceinline__ void xcd_barrier(const XcdBarrier& b) {
    asm volatile("s_waitcnt vmcnt(0)" ::: "memory");
    __syncthreads();
    if (threadIdx.x == 0) {
        unsigned* bar = b.bar;
        __builtin_amdgcn_s_waitcnt(0);
        unsigned nloc = b.st[0], nx = b.st[1];
        if (nloc == 0u) { xcd_barrier_complete(bar, b.x, nloc, nx); b.st[0] = nloc; b.st[1] = nx; }
        const unsigned old = xb_add(&bar[XB_XSUB(b.x)], 1u);
        const unsigned gen = old / nloc;
        if (old + 1u == (gen + 1u) * nloc) {
            __builtin_amdgcn_fence(__ATOMIC_RELEASE, "agent");
            asm volatile("s_waitcnt vmcnt(0)" ::: "memory");
            const unsigned og = xb_add(&bar[XB_TOP], 1u);
            const unsigned tg = og / nx;
            if (og + 1u == (tg + 1u) * nx) xb_add(&bar[XB_TOPGEN], 1u);
            else XB_SPIN(xb_ld(&bar[XB_TOPGEN]) == tg, bar);
            __builtin_amdgcn_fence(__ATOMIC_ACQUIRE, "agent");
            xb_add(&bar[XB_XGEN(b.x)], 1u);
            asm volatile("s_waitcnt vmcnt(0)" ::: "memory");
        } else {
            XB_SPIN(xb_ld(&bar[XB_XGEN(b.x)]) == gen, bar);
            __builtin_amdgcn_fence(__ATOMIC_ACQUIRE, "agent");
            asm volatile("s_waitcnt vmcnt(0)" ::: "memory");
        }
    }
    __syncthreads();
}

constexpr int BM = 256, BK = 64, HALF = 128, HTB = HALF * BK * 2, STAGE_BYTES = 8 * HTB;
__device__ __forceinline__ int lds_byte(int r, int c) { const int st = (r >> 4) * 2 + (c >> 5), rr = r & 15, cc = c & 31, ob = rr * 64 + cc * 2; return st * 1024 + (ob ^ (((ob >> 9) & 1) << 5)); }
__device__ __forceinline__ void stage_rc(int b, int& R, int& C) { const int st = b / 1024, sb = b % 1024, swz = sb ^ (((sb >> 9) & 1) << 5); R = (st >> 1) * 16 + swz / 64; C = (st & 1) * 32 + (swz % 64) / 2; }
__device__ __forceinline__ int perm32(int rho) { const int n = rho >> 4, i = rho & 15; return 8 * (i >> 2) + 4 * n + (i & 3); }

struct Unit { int pm, pn; const char* A; const char* B; const int* gat; int valid; int x0, x1; };
typedef f32x4 Acc[2][2][4][2];

#define PG8_SA(b, h) (((b) * 2 + (h)) * HTB)
#define PG8_SB(b, h) ((4 + (b) * 2 + (h)) * HTB)
#define PG8_STAGE(bufoff, gbase, voff) do { _Pragma("unroll") for (int _i = 0; _i < 2; ++_i) \
        __builtin_amdgcn_global_load_lds((const unsigned*)((const char*)(gbase) + (voff)[_i]), (LAS unsigned*)(lds + (bufoff) + ldsw + _i * 8192), 16, 0, 0); } while (0)
#define PG8_LDA(dst, b, h) do { _Pragma("unroll") for (int m = 0; m < 4; ++m) _Pragma("unroll") for (int k = 0; k < 2; ++k) dst[m][k] = *(const LAS bf16x8*)(lds + PG8_SA(b, h) + aoff + m * 2048 + k * 1024); } while (0)
#define PG8_LDB(dst, b, h) do { _Pragma("unroll") for (int n = 0; n < 2; ++n) _Pragma("unroll") for (int k = 0; k < 2; ++k) dst[n][k] = *(const LAS bf16x8*)(lds + PG8_SB(b, h) + boff + n * 2048 + k * 1024); } while (0)
#define PG8_MMA(ai, bj, At, Bt) do { __builtin_amdgcn_s_setprio(1); _Pragma("unroll") for (int m = 0; m < 4; ++m) _Pragma("unroll") for (int n = 0; n < 2; ++n) _Pragma("unroll") for (int k = 0; k < 2; ++k) \
        acc[ai][bj][m][n] = __builtin_amdgcn_mfma_f32_16x16x32_bf16(Bt[n][k], At[m][k], acc[ai][bj][m][n], 0, 0, 0); __builtin_amdgcn_s_setprio(0); } while (0)
#define PG8_WAIT_V(n) asm volatile("s_waitcnt vmcnt(" #n ")" ::: "memory")
#define PG8_WAIT_L(n) asm volatile("s_waitcnt lgkmcnt(" #n ")" ::: "memory")
#define PG8_BAR __builtin_amdgcn_s_barrier()
#define PG8_SCHED __builtin_amdgcn_sched_barrier(0)
#define PG8_VOFFA(u, vo) do { _Pragma("unroll") for (int _h = 0; _h < 2; ++_h) _Pragma("unroll") for (int _i = 0; _i < 2; ++_i) { const int _row = _h * HALF + Ra[_i]; \
        const int _ri = (u).gat ? (_row < (u).valid ? (u).gat[_row] : 0) : _row; vo[_h][_i] = (unsigned)(_ri * lda + Ca[_i]) * 2u; } } while (0)

template <class Epi, class Sched, bool ALIGN_EPI>
__device__ __forceinline__ void gemm_phase(LAS unsigned char* lds, const int K, const int lda, const Sched& S, const Epi& E) {
    const int tid = threadIdx.x, wid = __builtin_amdgcn_readfirstlane(tid >> 6), lane = tid & 63, wr = wid >> 2, wc = wid & 3, fr = lane & 15, fq = lane >> 4;
    const int nt = K / BK;
    int Ra[2], Ca[2]; unsigned voffB[2];
#pragma unroll
    for (int i = 0; i < 2; ++i) { int R, C; stage_rc(tid * 16 + i * 8192, R, C); const int Rb = Epi::PERM ? ((R & ~31) + perm32(R & 31)) : R; Ra[i] = R; Ca[i] = C; voffB[i] = (unsigned)(Rb * K + C) * 2u; }
    const size_t kstep = (size_t)(BK * 2);
    const size_t hstep = (size_t)HALF * K * 2;
    const unsigned ldsw = (unsigned)wid * 1024u;
    const int aoff = lds_byte(wr * 64 + fr, fq * 8), boff = lds_byte(wc * 32 + fr, fq * 8);
    Unit cur, nxt; int ui = 0;
    if (!S.next(0, cur)) return;
    Acc acc;
#pragma unroll
    for (int a = 0; a < 2; ++a)
#pragma unroll
        for (int b = 0; b < 2; ++b)
#pragma unroll
            for (int m = 0; m < 4; ++m)
#pragma unroll
                for (int n = 0; n < 2; ++n) acc[a][b][m][n] = (f32x4){0.f, 0.f, 0.f, 0.f};
    bf16x8 At[4][2], B0[2][2], B1[2][2];
    unsigned vC[2][2], vN[2][2];
    PG8_VOFFA(cur, vC);
    const char* cA = cur.A; const char* cB = cur.B;
    PG8_STAGE(PG8_SB(0, 0), cB, voffB); PG8_STAGE(PG8_SB(0, 1), cB + hstep, voffB); PG8_STAGE(PG8_SA(0, 0), cA, vC[0]); PG8_STAGE(PG8_SA(0, 1), cA, vC[1]);
    if (wr == 1) PG8_BAR;
    PG8_WAIT_V(2); PG8_BAR;
    PG8_STAGE(PG8_SB(1, 0), cB + kstep, voffB); PG8_STAGE(PG8_SA(1, 0), cA + kstep, vC[0]); PG8_STAGE(PG8_SB(1, 1), cB + hstep + kstep, voffB);
    PG8_WAIT_V(6); PG8_BAR;
    for (;;) {
        const bool has_next = S.next(ui + 1, nxt);
        if (!has_next) nxt = cur;
        PG8_VOFFA(nxt, vN);
        const char* nA = nxt.A; const char* nB = nxt.B;
#pragma unroll 1
        for (int t = 0; t < nt; t += 2) {
            const bool last = (t == nt - 2);
            const char* a1 = cA + (size_t)(t + 1) * kstep;
            const char* a2 = last ? nA : cA + (size_t)(t + 2) * kstep; const char* b2 = last ? nB : cB + (size_t)(t + 2) * kstep;
            const char* a3 = a2 + kstep; const char* b3 = b2 + kstep;
            unsigned vS[2][2];
#pragma unroll
            for (int h = 0; h < 2; ++h)
#pragma unroll
                for (int i = 0; i < 2; ++i) vS[h][i] = last ? vN[h][i] : vC[h][i];
            PG8_LDB(B0, 0, 0); PG8_LDB(B1, 0, 1); PG8_SCHED; PG8_LDA(At, 0, 0); PG8_STAGE(PG8_SA(1, 1), a1, vC[1]);
            PG8_WAIT_V(8); PG8_WAIT_L(0); PG8_BAR; PG8_MMA(0, 0, At, B0); PG8_MMA(0, 1, At, B1); PG8_BAR; PG8_SCHED;
            PG8_LDA(At, 0, 1); PG8_STAGE(PG8_SB(0, 0), b2, voffB); PG8_STAGE(PG8_SB(0, 1), b2 + hstep, voffB); PG8_STAGE(PG8_SA(0, 0), a2, vS[0]);
            PG8_WAIT_V(8); PG8_WAIT_L(0); PG8_BAR; PG8_MMA(1, 0, At, B0); PG8_MMA(1, 1, At, B1); PG8_BAR; PG8_SCHED;
            PG8_LDB(B0, 1, 0); PG8_LDB(B1, 1, 1); PG8_SCHED; PG8_LDA(At, 1, 0); PG8_STAGE(PG8_SA(0, 1), a2, vS[1]);
            PG8_WAIT_V(8); PG8_WAIT_L(0); PG8_BAR; PG8_MMA(0, 0, At, B0); PG8_MMA(0, 1, At, B1); PG8_BAR; PG8_SCHED;
            PG8_LDA(At, 1, 1); PG8_STAGE(PG8_SB(1, 0), b3, voffB); PG8_STAGE(PG8_SB(1, 1), b3 + hstep, voffB); PG8_STAGE(PG8_SA(1, 0), a3, vS[0]);
            PG8_WAIT_V(8); PG8_WAIT_L(0); PG8_BAR; PG8_MMA(1, 0, At, B0); PG8_MMA(1, 1, At, B1); PG8_BAR; PG8_SCHED;
        }
        if constexpr (ALIGN_EPI) { if (wr == 0) PG8_BAR; }
        if constexpr (!Epi::AFTER_DRAIN) { E(acc, cur, wr, wc, fr, fq); }
        if (!has_next) break;
#pragma unroll
        for (int a = 0; a < 2; ++a)
#pragma unroll
            for (int b = 0; b < 2; ++b)
#pragma unroll
                for (int m = 0; m < 4; ++m)
#pragma unroll
                    for (int n = 0; n < 2; ++n) acc[a][b][m][n] = (f32x4){0.f, 0.f, 0.f, 0.f};
        cur = nxt; cA = nA; cB = nB; ++ui;
#pragma unroll
        for (int h = 0; h < 2; ++h)
#pragma unroll
            for (int i = 0; i < 2; ++i) vC[h][i] = vN[h][i];
        if constexpr (ALIGN_EPI) { if (wr == 1) PG8_BAR; }
    }
    PG8_WAIT_V(0);
    if constexpr (!ALIGN_EPI) { if (wr == 0) PG8_BAR; }
    PG8_BAR;
    if constexpr (Epi::AFTER_DRAIN) { E.fused(acc, cur, wr, wc, fr, fq, lds, wid, lane); }
}
struct DenseOrder {
    int nM, nN, nwg, G, c; const char* A; const char* B; size_t a_tile, b_tile; int a_col_tile;
    int pn_per_ablk;
    __device__ void init(int Mr, int N, int G_, int c_, const void* A_, const void* B_, int lda, int K, int pnpa = 0, int acolbytes = 0) {
        nM = Mr / BM; nN = N / BM; nwg = nM * nN; G = G_; c = c_; A = (const char*)A_; B = (const char*)B_; a_tile = (size_t)BM * lda * 2; b_tile = (size_t)BM * K * 2; pn_per_ablk = pnpa; a_col_tile = acolbytes; }
    __device__ bool next(int i, Unit& u) const {
        const long L = (long)i * G + c; if (L >= nwg) return false;
        int wgid = (int)L; { const int q = nwg / 8, r = nwg % 8, xcd = wgid % 8, off = wgid / 8; wgid = (xcd < r ? xcd * (q + 1) : r * (q + 1) + (xcd - r) * q) + off; }
        const int WGM = 8, nig = WGM * nN, gid = wgid / nig, fm = gid * WGM, gsz = (nM - fm) < WGM ? (nM - fm) : WGM;
        u.pm = fm + ((wgid % nig) % gsz); u.pn = (wgid % nig) / gsz;
        u.A = A + (size_t)u.pm * a_tile + (pn_per_ablk ? (size_t)(u.pn / pn_per_ablk) * a_col_tile : 0); u.B = B + (size_t)u.pn * b_tile; u.gat = nullptr; u.valid = 256; u.x0 = 0; u.x1 = 0; return true;
    }
};
struct OneOrder {
    int first, nN; const char* A; const char* B; size_t a_tile, b_tile; int a_col_tile; int c; int total;
    __device__ bool next(int i, Unit& u) const {
        if (i > 0) return false; const int L = first + c; if (L >= total) return false;
        u.pm = L / nN; u.pn = L % nN; u.A = A + (size_t)u.pm * a_tile + (size_t)(u.pn >> 1) * a_col_tile; u.B = B + (size_t)u.pn * b_tile; u.gat = nullptr; u.valid = 256; u.x0 = 0; u.x1 = 0; return true; }
};
struct MoeOrder {
    const volatile LAS int* tpre; const volatile LAS int* cnt; int ncol; int G, c; const char* A; const char* B; size_t b_exp; size_t b_tile; const int* lists; int gather; size_t a_tile;
    __device__ bool next(int i, Unit& u) const {
        const int L = i * G + c; const int ntile = __builtin_amdgcn_readfirstlane(tpre[32]); if (L >= ntile * ncol) return false;
        const int T = L / ncol, pn = L % ncol; int e = 0;
#pragma unroll 1
        for (int j = 1; j < 32; ++j) if (T >= tpre[j]) e = j;
        e = __builtin_amdgcn_readfirstlane(e);
        const int rt = __builtin_amdgcn_readfirstlane(T - tpre[e]); int valid = cnt[e] - rt * 256; valid = __builtin_amdgcn_readfirstlane(valid > 256 ? 256 : valid);
        u.pm = T; u.pn = pn; u.x0 = e; u.x1 = rt; u.valid = valid; u.B = B + (size_t)e * b_exp + (size_t)pn * b_tile;
        if (gather) { u.A = A; u.gat = lists + (size_t)e * M + rt * 256; } else { u.A = A + (size_t)T * a_tile; u.gat = nullptr; }
        return true; }
};

__device__ __forceinline__ u32x4 pack8(f32x4 a, f32x4 b) { u32x4 w; w.x = pk2(a[0], a[1]); w.y = pk2(a[2], a[3]); w.z = pk2(b[0], b[1]); w.w = pk2(b[2], b[3]); return w; }
__device__ __forceinline__ float dot4(f32x4 a) { return (a[0] * a[0] + a[1] * a[1]) + (a[2] * a[2] + a[3] * a[3]); }

struct EpiProj {
    static constexpr bool PERM = true, AFTER_DRAIN = false;
    bf16_t *XR, *GR, *QC, *KVC, *GA, *GB, *HALO; float *KPE, *ssq_q, *ssq_kv;
    __device__ __forceinline__ void operator()(const Acc& acc, const Unit& u, int wr, int wc, int fr, int fq) const {
        const int pn = u.pn, rowb = u.pm * BM + wr * 64 + fr;
        if (pn == 20) {
            if (wc == 0) {
#pragma unroll
                for (int ai = 0; ai < 2; ++ai)
#pragma unroll
                    for (int m = 0; m < 4; ++m) { float* p = KPE + (size_t)(rowb + ai * HALF + m * 16) * 32 + 8 * fq; *(f32x4*)p = acc[ai][0][m][0]; *(f32x4*)(p + 4) = acc[ai][0][m][1]; }
            }
            return;
        }
        bf16_t* dst; int ldc, colt, act = 0; float* ssq = nullptr; int nslot = 0, slot = 0;
        if (pn < 4) { dst = XR; ldc = 1024; colt = pn * 256; }
        else if (pn < 8) { dst = GR; ldc = 1024; colt = (pn - 4) * 256; act = 1; }
        else if (pn < 11) { dst = QC; ldc = 768; colt = (pn - 8) * 256; ssq = ssq_q; nslot = 12; slot = (pn - 8) * 4 + wc; }
        else if (pn == 11) { dst = KVC; ldc = 256; colt = 0; ssq = ssq_kv; nslot = 4; slot = wc; }
        else if (pn < 16) { dst = GA; ldc = 1024; colt = (pn - 12) * 256; act = 2; }
        else { dst = GB; ldc = 1024; colt = (pn - 16) * 256; act = 2; }
        const int col0 = colt + wc * 32 + 8 * fq;
#pragma unroll
        for (int ai = 0; ai < 2; ++ai)
#pragma unroll
            for (int m = 0; m < 4; ++m) {
                const int row = rowb + ai * HALF + m * 16; float ss = 0.f;
#pragma unroll
                for (int bj = 0; bj < 2; ++bj) {
                    f32x4 v0 = acc[ai][bj][m][0], v1 = acc[ai][bj][m][1];
                    if (ssq) ss += dot4(v0) + dot4(v1);
                    if (act == 1) {
#pragma unroll
                        for (int e = 0; e < 4; ++e) { v0[e] = fgelu(v0[e]); v1[e] = fgelu(v1[e]); }
                    } else if (act == 2) {
#pragma unroll
                        for (int e = 0; e < 4; ++e) { v0[e] = fsigm(v0[e]); v1[e] = fsigm(v1[e]); }
                    }
                    *(u32x4*)(dst + (size_t)row * ldc + col0 + bj * HALF) = pack8(v0, v1);
                }
                if (ssq) { ss += __shfl_xor(ss, 16); ss += __shfl_xor(ss, 32); if (fq == 0) ssq[(size_t)row * nslot + slot] = ss; }
            }
        if (pn < 4 && wr == 1 && fr >= 13) {
#pragma unroll
            for (int bj = 0; bj < 2; ++bj) *(u32x4*)(HALO + ((size_t)u.pm * 3 + (fr - 13)) * 1024 + col0 + bj * HALF) = pack8(acc[1][bj][3][0], acc[1][bj][3][1]);
        }
    }
};

struct EpiQ {
    static constexpr bool PERM = true, AFTER_DRAIN = false;
    bf16_t* Q; const float* ssq_q;
    __device__ __forceinline__ void operator()(const Acc& acc, const Unit& u, int wr, int wc, int fr, int fq) const {
        const int rowb = u.pm * BM + wr * 64 + fr, col0 = u.pn * BM + wc * 32 + 8 * fq;
#pragma unroll
        for (int ai = 0; ai < 2; ++ai)
#pragma unroll
            for (int m = 0; m < 4; ++m) {
                const int row = rowb + ai * HALF + m * 16; const float rs = ssq_q[row];
#pragma unroll
                for (int bj = 0; bj < 2; ++bj) *(u32x4*)(Q + (size_t)row * 1536 + col0 + bj * HALF) = pack8(acc[ai][bj][m][0] * rs, acc[ai][bj][m][1] * rs);
            }
    }
};

struct EpiKV {
    static constexpr bool PERM = true, AFTER_DRAIN = false;
    unsigned char* KIMG; unsigned char* VIMG; const float* ssq_kv; const float* kssq; const float* KPER; const float* kg;
    __device__ __forceinline__ void operator()(const Acc& acc, const Unit& u, int wr, int wc, int fr, int fq) const {
        const int rowb = u.pm * BM + wr * 64 + fr, h = 2 * u.pn + (wc & 1);
        if (wc < 2) {
            f32x4 g[2][2];
#pragma unroll
            for (int bj = 0; bj < 2; ++bj)
#pragma unroll
                for (int n = 0; n < 2; ++n) g[bj][n] = *(const f32x4*)(kg + 32 * bj + 8 * fq + 4 * n);
            const f32x4 gr0 = *(const f32x4*)(kg + 64 + 8 * fq), gr1 = *(const f32x4*)(kg + 64 + 8 * fq + 4); (void)gr0; (void)gr1;
#pragma unroll
            for (int ai = 0; ai < 2; ++ai)
#pragma unroll
                for (int m = 0; m < 4; ++m) {
                    const int row = rowb + ai * HALF + m * 16; const float rs = ssq_kv[row];
                    f32x4 v[2][2]; float ss = 0.f;
#pragma unroll
                    for (int bj = 0; bj < 2; ++bj)
#pragma unroll
                        for (int n = 0; n < 2; ++n) { v[bj][n] = acc[ai][bj][m][n] * rs; ss += dot4(v[bj][n]); }
                    ss += __shfl_xor(ss, 16); ss += __shfl_xor(ss, 32);
                    const float rk = rsqrtf((ss + kssq[row]) * (1.f / 96.f) + EPS);
                    unsigned char* img = KIMG + ((size_t)h * 256 + (row >> 6)) * 12288 + (row & 63) * 16;
#pragma unroll
                    for (int bj = 0; bj < 2; ++bj) *(u32x4*)(img + (4 * bj + fq) * 1024) = pack8(v[bj][0] * g[bj][0] * rk, v[bj][1] * g[bj][1] * rk);
                    const f32x4 r0 = *(const f32x4*)(KPER + (size_t)row * 32 + 8 * fq), r1 = *(const f32x4*)(KPER + (size_t)row * 32 + 8 * fq + 4);
                    *(u32x4*)(img + (8 + fq) * 1024) = pack8(r0 * rk, r1 * rk);
                    asm volatile("" ::: "memory");
                }
        } else {
#pragma unroll
            for (int ai = 0; ai < 2; ++ai)
#pragma unroll
                for (int m = 0; m < 4; ++m) {
                    const int row = rowb + ai * HALF + m * 16; const float rs = ssq_kv[row]; const int key = row & 63;
                    unsigned char* img = VIMG + ((size_t)h * 256 + (row >> 6)) * 8192 + (key >> 4) * 1024 + (key & 15) * 64 + fq * 16;
#pragma unroll
                    for (int bj = 0; bj < 2; ++bj) *(u32x4*)(img + bj * 4096) = pack8(acc[ai][bj][m][0] * rs, acc[ai][bj][m][1] * rs);
                    asm volatile("" ::: "memory");
                }
        }
    }
};

struct EpiLru {
    static constexpr bool PERM = false, AFTER_DRAIN = true;
    const bf16_t* XA; const float *ba, *bx, *lam; bf16_t* GRio; bf16_t* GAio; float* HEND; float* AEND;
    __device__ __forceinline__ void fused(Acc& acc, const Unit& u, int wr, int wc, int fr, int fq, LAS unsigned char* lds, int wid, int lane) const {
        const int chb = 256 * (u.pn >> 1) + 128 * (u.pn & 1), tid = threadIdx.x;
        LAS unsigned* S = (LAS unsigned*)lds;
        {
            f32x4 vba[2], vbx[2], vsp[2];
#pragma unroll
            for (int n = 0; n < 2; ++n) { const int c = chb + 32 * wc + 16 * n + 4 * fq; vba[n] = *(const f32x4*)(ba + c); vbx[n] = *(const f32x4*)(bx + c); const f32x4 l4 = *(const f32x4*)(lam + c);
#pragma unroll
                for (int e = 0; e < 4; ++e) vsp[n][e] = -8.f * LOG2E * log1pf(expf(-l4[e])); }
#pragma unroll
            for (int ai = 0; ai < 2; ++ai)
#pragma unroll
                for (int m = 0; m < 4; ++m) {
                    const int r = ai * HALF + wr * 64 + m * 16 + fr; const size_t grow = (size_t)(u.pm * BM + r) * 1024;
#pragma unroll
                    for (int n = 0; n < 2; ++n) {
                        const int x0 = 32 * wc + 16 * n + 4 * fq; const u32x2 xw = *(const u32x2*)(XA + grow + chb + x0);
                        const float xa[4] = {lo2f(xw.x), hi2f(xw.x), lo2f(xw.y), hi2f(xw.y)}; u32x4 o;
#pragma unroll
                        for (int e = 0; e < 4; ++e) {
                            const float rr = fsigm(acc[ai][0][m][n][e] + vba[n][e]), ii = fsigm(acc[ai][1][m][n][e] + vbx[n][e]);
                            const float la2 = rr * vsp[n][e]; const float a2 = fexp2(2.f * la2); const float mult = sqrtf(fmaxf(1.f - a2, 0.f));
                            o[e] = (f2bf(la2) << 16) | f2bf(mult * ii * xa[e]);
                        }
                        *(LAS u32x4*)(S + r * 128 + ((((x0 >> 2) ^ (r & 7)) << 2))) = o;
                    }
                    asm volatile("" ::: "memory");
                }
        }
        LDS_WAIT(); __builtin_amdgcn_s_barrier(); asm volatile("" ::: "memory");
        const int cp = tid & 63, sg = tid >> 6, c0 = 2 * cp; LAS f32x4* X = (LAS f32x4*)(lds + LDS_XCH);
        float h0 = 0.f, h1 = 0.f, s0 = 0.f, s1 = 0.f;
#pragma unroll 4
        for (int j = 0; j < 32; ++j) { const int r = sg * 32 + j; const u32x2 w = *(const LAS u32x2*)(S + r * 128 + ((((c0 >> 2) ^ (r & 7)) << 2) | (c0 & 3)));
            const float l0 = hi2f(w.x), l1 = hi2f(w.y); h0 = fexp2(l0) * h0 + lo2f(w.x); h1 = fexp2(l1) * h1 + lo2f(w.y); s0 += l0; s1 += l1; }
        X[sg * 64 + cp] = (f32x4){h0, s0, h1, s1};
        LDS_WAIT(); __builtin_amdgcn_s_barrier(); asm volatile("" ::: "memory");
        h0 = 0.f; h1 = 0.f; s0 = 0.f; s1 = 0.f;
        for (int q = 0; q < sg; ++q) { const f32x4 x = X[q * 64 + cp]; h0 = fexp2(x[1]) * h0 + x[0]; s0 += x[1]; h1 = fexp2(x[3]) * h1 + x[2]; s1 += x[3]; }
        const size_t gbase = (size_t)(u.pm * BM) * 1024 + chb + c0;
#pragma unroll 4
        for (int j = 0; j < 32; ++j) { const int r = sg * 32 + j; const u32x2 w = *(const LAS u32x2*)(S + r * 128 + ((((c0 >> 2) ^ (r & 7)) << 2) | (c0 & 3)));
            const float l0 = hi2f(w.x), l1 = hi2f(w.y); h0 = fexp2(l0) * h0 + lo2f(w.x); h1 = fexp2(l1) * h1 + lo2f(w.y); s0 += l0; s1 += l1;
            const size_t o = gbase + (size_t)r * 1024; const unsigned gr = *(const unsigned*)(GRio + o), ga = *(const unsigned*)(GAio + o);
            const float g0 = lo2f(gr) * lo2f(ga), g1 = hi2f(gr) * hi2f(ga);
            *(unsigned*)(GRio + o) = pk2(h0 * g0, h1 * g1); *(unsigned*)(GAio + o) = pk2(fexp2(s0) * g0, fexp2(s1) * g1); }
        if (sg == 7) { *(f32x2*)(HEND + (size_t)u.pm * 1024 + chb + c0) = (f32x2){h0, h1}; *(f32x2*)(AEND + (size_t)u.pm * 1024 + chb + c0) = (f32x2){fexp2(s0), fexp2(s1)}; }
        LDS_WAIT(); __builtin_amdgcn_s_barrier(); asm volatile("" ::: "memory");
    }
};

struct EpiWout {
    static constexpr bool PERM = true, AFTER_DRAIN = false;
    const float* x; float* out; bf16_t* HB; float* ssq_h;
    __device__ __forceinline__ void operator()(const Acc& acc, const Unit& u, int wr, int wc, int fr, int fq) const {
        const int rowb = u.pm * BM + wr * 64 + fr, col0 = u.pn * BM + wc * 32 + 8 * fq;
#pragma unroll
        for (int ai = 0; ai < 2; ++ai)
#pragma unroll
            for (int m = 0; m < 4; ++m) {
                const int row = rowb + ai * HALF + m * 16; float ss = 0.f;
#pragma unroll
                for (int bj = 0; bj < 2; ++bj) { const size_t o = (size_t)row * 1024 + col0 + bj * HALF;
                    const f32x4 h0 = *(const f32x4*)(x + o) + acc[ai][bj][m][0], h1 = *(const f32x4*)(x + o + 4) + acc[ai][bj][m][1];
                    ss += dot4(h0) + dot4(h1); *(f32x4*)(out + o) = h0; *(f32x4*)(out + o + 4) = h1; *(u32x4*)(HB + o) = pack8(h0, h1); }
                ss += __shfl_xor(ss, 16); ss += __shfl_xor(ss, 32); if (fq == 0) ssq_h[(size_t)row * 16 + u.pn * 4 + wc] = ss;
            }
    }
};

struct EpiMoeGU {
    static constexpr bool PERM = false, AFTER_DRAIN = false;
    bf16_t* HID; const float* ssq_h; const int* lists;
    __device__ __forceinline__ void operator()(const Acc& acc, const Unit& u, int wr, int wc, int fr, int fq) const {
        const int rb = wr * 64 + fr;
#pragma unroll
        for (int ai = 0; ai < 2; ++ai)
#pragma unroll
            for (int m = 0; m < 4; ++m) {
                const int r = rb + ai * HALF + m * 16;
                if (r < u.valid) {
                    const int tok = lists[(size_t)u.x0 * M + u.x1 * 256 + r]; const float rs = ssq_h[tok];
#pragma unroll
                    for (int n = 0; n < 2; ++n) { f32x4 g = acc[ai][0][m][n] * rs, up = acc[ai][1][m][n] * rs, hb;
#pragma unroll
                        for (int e = 0; e < 4; ++e) hb[e] = g[e] * fsigm(g[e]) * up[e];
                        u32x2 w; w.x = pk2(hb[0], hb[1]); w.y = pk2(hb[2], hb[3]);
                        *(u32x2*)((char*)HID + (unsigned)((((unsigned)u.pm * 256u + (unsigned)r) * 256u + 128u * (unsigned)u.pn + 32u * (unsigned)wc + 16u * (unsigned)n + 4u * (unsigned)fq) * 2u)) = w; }
                }
                asm volatile("" ::: "memory");
            }
    }
};
struct EpiMoeDown {
    static constexpr bool PERM = true, AFTER_DRAIN = false;
    bf16_t* Y; const float* cwl;
    __device__ __forceinline__ void operator()(const Acc& acc, const Unit& u, int wr, int wc, int fr, int fq) const {
        const int rb = wr * 64 + fr, col0 = u.pn * BM + wc * 32 + 8 * fq;
#pragma unroll
        for (int ai = 0; ai < 2; ++ai)
#pragma unroll
            for (int m = 0; m < 4; ++m) {
                const int r = rb + ai * HALF + m * 16;
                if (r < u.valid) { const float cw = cwl[(size_t)u.x0 * M + u.x1 * 256 + r];
#pragma unroll
                    for (int bj = 0; bj < 2; ++bj) *(u32x4*)((char*)Y + (unsigned)((((unsigned)u.pm * 256u + (unsigned)r) * 1024u + (unsigned)(col0 + bj * HALF)) * 2u)) = pack8(acc[ai][bj][m][0] * cw, acc[ai][bj][m][1] * cw); }
                asm volatile("" ::: "memory");
            }
    }
};
struct Frame {
    LAS unsigned char* lds; volatile LAS unsigned* MISC; gu32* ctl;
    int tid, lane, wave, vcu, G;
    void* const* in_dummy;
};
struct Args { const void* in[26]; float* out; unsigned char* ws; int ph_lo, ph_hi; };
typedef const __attribute__((address_space(4))) Args& CArgs;

__device__ __forceinline__ void tr_item(const float* W, int ldn, int ns0, bf16_t* WT, int K, int nd0, int k0, const float* kscale, LAS float* scr, int lane) {
#pragma unroll 8
    for (int i = 0; i < 32; ++i) { const int kk = 2 * i + (lane >> 5); float v = W[(size_t)(k0 + kk) * ldn + ns0 + (lane & 31)]; if (kscale) v *= kscale[k0 + kk]; scr[kk * 33 + (lane & 31)] = v; }
    LDS_WAIT(); asm volatile("" ::: "memory");
    const int c = lane & 7;
#pragma unroll
    for (int j = 0; j < 4; ++j) { const int n = (lane >> 3) + 8 * j; const LAS float* s = scr + (8 * c) * 33 + n;
        u32x4 o; o.x = pk2(s[0 * 33], s[1 * 33]); o.y = pk2(s[2 * 33], s[3 * 33]); o.z = pk2(s[4 * 33], s[5 * 33]); o.w = pk2(s[6 * 33], s[7 * 33]);
        *(u32x4*)(WT + (size_t)(nd0 + n) * K + k0 + 8 * c) = o; }
    LDS_WAIT(); asm volatile("" ::: "memory");
}

__device__ __forceinline__ void p0_prologue(Frame& F, CArgs a) {
    LAS float* scr = (LAS float*)(F.lds + F.wave * 16384);
    const int gw = F.vcu * NWAVES + F.wave, NGW = F.G * NWAVES, lane = F.lane;
    unsigned char* ws = a.ws;
    const float* w_in = (const float*)a.in[3];
    bf16_t* WIN = (bf16_t*)(ws + WS_WIN); bf16_t* WUQ = (bf16_t*)(ws + WS_WUQ); bf16_t* WUKV = (bf16_t*)(ws + WS_WUKV); bf16_t* WLRU = (bf16_t*)(ws + WS_WLRU); bf16_t* WOUT = (bf16_t*)(ws + WS_WOUT);
    constexpr int I_IN = 16 * 168, I_UQ = 12 * 48, I_UKV = 4 * 64, I_LRU = 4 * 64, I_OUT = 16 * 32, NITEMS = I_IN + I_UQ + I_UKV + I_LRU + I_OUT;
    for (int it = gw; it < NITEMS; it += NGW) {
        int r = it;
        if (r < I_IN) { const int kb = r / 168, nb = r % 168, nd0 = 32 * nb, k0 = 64 * kb;
            if (nd0 < 5152) { const int ns0 = nd0 < 3072 ? nd0 : (nd0 < 5120 ? nd0 + 32 : 3072); tr_item(w_in, 5152, ns0, WIN, 1024, nd0, k0, nullptr, scr, lane); }
            else { const int c = lane & 7;
#pragma unroll
                for (int j = 0; j < 4; ++j) { const int n = (lane >> 3) + 8 * j; *(u32x4*)(WIN + (size_t)(nd0 + n) * 1024 + k0 + 8 * c) = (u32x4){0u, 0u, 0u, 0u}; } }
            continue; }
        r -= I_IN;
        if (r < I_UQ) { const int kb = r / 48, nb = r % 48; tr_item((const float*)a.in[12], 1536, 32 * nb, WUQ, 768, 32 * nb, 64 * kb, (const float*)a.in[11], scr, lane); continue; }
        r -= I_UQ;
        if (r < I_UKV) { const int kb = r / 64, nb = r % 64, nd0 = 32 * nb, pn = nd0 >> 8, bj = (nd0 >> 7) & 1, wc = (nd0 >> 5) & 3;
            tr_item((const float*)a.in[14], 2048, (2 * pn + (wc & 1)) * 128 + (wc >> 1) * 64 + 32 * bj, WUKV, 256, nd0, 64 * kb, (const float*)a.in[13], scr, lane); continue; }
        r -= I_UKV;
        if (r < I_LRU) { const int kb = r / 64, nb = r % 64, nd0 = 32 * nb, pn = nd0 >> 8, bj = (nd0 >> 7) & 1, xb = nd0 & 127, blk = pn >> 1;
            tr_item((const float*)a.in[bj ? 8 : 6] + (size_t)blk * 65536, 256, 128 * (pn & 1) + xb, WLRU, 256, nd0, 64 * kb, nullptr, scr, lane); continue; }
        r -= I_LRU;
        { const int kb = r / 32, nb = r % 32; tr_item((const float*)a.in[17], 1024, 32 * nb, WOUT, 1024, 32 * nb, 64 * kb, nullptr, scr, lane); }
    }
    const float* x = (const float*)a.in[0]; const float* gm = (const float*)a.in[2]; bf16_t* XN = (bf16_t*)(ws + WS_R1);
    f32x4 g4[4];
#pragma unroll
    for (int j = 0; j < 4; ++j) g4[j] = *(const f32x4*)(gm + 4 * lane + 256 * j);
    for (int m = gw; m < M; m += NGW) {
        const f32x4* xr = (const f32x4*)(x + (size_t)m * D) + lane; f32x4 v[4]; float s = 0.f;
#pragma unroll
        for (int j = 0; j < 4; ++j) { v[j] = xr[64 * j]; s += dot4(v[j]); }
        const float rstd = rsqrtf(wave_sum(s) * (1.f / 1024.f) + EPS);
        u32x2* o8 = (u32x2*)(XN + (size_t)m * D) + lane;
#pragma unroll
        for (int j = 0; j < 4; ++j) { const f32x4 y = v[j] * rstd * g4[j]; u32x2 w; w.x = pk2(y[0], y[1]); w.y = pk2(y[2], y[3]); o8[64 * j] = w; }
    }
    const int gt = F.vcu * NTHREADS + F.tid, NGT = F.G * NTHREADS;
    const int* pos = (const int*)a.in[1]; float* CS = (float*)(ws + WS_CS);
    for (int i = gt; i < M * 16; i += NGT) { const int t = i >> 4, j = i & 15; const float fr = powf(10000.f, -(float)j / 16.f); const float ang = (float)pos[t] * fr; CS[t * 32 + j] = cosf(ang); CS[t * 32 + 16 + j] = sinf(ang); }
    float* WR = (float*)(ws + WS_MISC + MISC_WR); const float* gf = (const float*)a.in[18]; const float* wg = (const float*)a.in[19]; const float* we = (const float*)a.in[21];
    for (int i = gt; i < 36 * 1024; i += NGT) { const int j = i >> 10, k = i & 1023; WR[i] = (j < 4 ? wg[k * 4 + j] : we[k * 32 + (j - 4)]) * gf[k]; }
}

__device__ __forceinline__ void moe_weight_convert(Frame& F, CArgs a) {
    LAS float* scr = (LAS float*)(F.lds + F.wave * 16384);
    const int gw = F.vcu * NWAVES + F.wave, NGW = F.G * NWAVES, lane = F.lane;
    bf16_t* WGU = (bf16_t*)(a.ws + WS_WGU); bf16_t* WDN = (bf16_t*)(a.ws + WS_WDN); const float* gf = (const float*)a.in[18];
    constexpr int I_GU = 32 * 16 * 16, I_DN = 32 * 4 * 32;
    for (int it = gw; it < I_GU + I_DN; it += NGW) {
        if (it < I_GU) { const int e = it >> 8, r = it & 255, kb = r >> 4, nb = r & 15, nd0 = 32 * nb, pn = nd0 >> 8, bj = (nd0 >> 7) & 1, xb = nd0 & 127;
            tr_item((const float*)a.in[bj ? 24 : 23] + (size_t)e * 262144, 256, 128 * pn + xb, WGU + (size_t)e * 524288, 1024, nd0, 64 * kb, gf, scr, lane); }
        else { const int r0 = it - I_GU, e = r0 >> 7, r = r0 & 127, kb = r >> 5, nb = r & 31;
            tr_item((const float*)a.in[25] + (size_t)e * 262144, 1024, 32 * nb, WDN + (size_t)e * 262144, 256, 32 * nb, 64 * kb, nullptr, scr, lane); }
    }
}

__device__ __forceinline__ void p2a_conv(Frame& F, CArgs a) {
    unsigned char* ws = a.ws; bf16_t* XR = (bf16_t*)(ws + WS_XR); const bf16_t* HALO = (const bf16_t*)(ws + WS_MISC + MISC_HALO);
    const float* cw = (const float*)a.in[4]; const float* cb = (const float*)a.in[5];
    for (int b = F.vcu; b < 256; b += F.G) {
        const int pm = b >> 2, cg = b & 3, cp = F.tid & 127, sg = F.tid >> 7, c = cg * 256 + 2 * cp, base = pm * 256 + sg * 64;
        float h0[3], h1[3];
#pragma unroll
        for (int i = 0; i < 3; ++i) { unsigned w = 0u;
            if (sg == 0) { if (pm > 0) w = *(const unsigned*)(HALO + ((size_t)(pm - 1) * 3 + i) * 1024 + c); }
            else w = *(const unsigned*)(XR + (size_t)(base - 3 + i) * 1024 + c);
            h0[i] = lo2f(w); h1[i] = hi2f(w); }
        VM_WAIT(); __syncthreads();
        float w0[4], w1[4];
#pragma unroll
        for (int k = 0; k < 4; ++k) { w0[k] = cw[k * 1024 + c]; w1[k] = cw[k * 1024 + c + 1]; }
        const float b0 = cb[c], b1 = cb[c + 1];
        for (int j0 = 0; j0 < 64; j0 += 8) {
            unsigned xw[8];
#pragma unroll
            for (int j = 0; j < 8; ++j) xw[j] = *(const unsigned*)(XR + (size_t)(base + j0 + j) * 1024 + c);
#pragma unroll
            for (int j = 0; j < 8; ++j) { const float x0 = lo2f(xw[j]), x1 = hi2f(xw[j]);
                const float y0 = b0 + w0[0] * h0[0] + w0[1] * h0[1] + w0[2] * h0[2] + w0[3] * x0, y1 = b1 + w1[0] * h1[0] + w1[1] * h1[1] + w1[2] * h1[2] + w1[3] * x1;
                h0[0] = h0[1]; h0[1] = h0[2]; h0[2] = x0; h1[0] = h1[1]; h1[1] = h1[2]; h1[2] = x1;
                *(unsigned*)(XR + (size_t)(base + j0 + j) * 1024 + c) = pk2(y0, y1); }
        }
        __syncthreads();
    }
    const int gt = F.vcu * NTHREADS + F.tid, NGT = F.G * NTHREADS;
    const float* PQ = (const float*)(ws + WS_SSQP); const float* PKV = (const float*)(ws + WS_SSQP + SSQP_KV); float* RQ = (float*)(ws + WS_CTL + CTL_SSQ_Q); float* RKV = (float*)(ws + WS_CTL + CTL_SSQ_KV);
    float* KPE = (float*)(ws + WS_KPE); const float* CS = (const float*)(ws + WS_CS); float* KSSQ = (float*)(ws + WS_MISC + MISC_KSSQ); const float* kg = (const float*)a.in[16];
    for (int row = gt; row < M; row += NGT) {
        f32x4 kp[8], cs[8];
#pragma unroll
        for (int i = 0; i < 8; ++i) { kp[i] = *(const f32x4*)(KPE + (size_t)row * 32 + 4 * i); cs[i] = *(const f32x4*)(CS + (size_t)row * 32 + 4 * i); }
        float ss = 0.f;
#pragma unroll
        for (int i = 0; i < 8; ++i) ss += dot4(kp[i]);
        KSSQ[row] = ss;
        { const f32x4 a0 = *(const f32x4*)(PQ + (size_t)row * 12), a1 = *(const f32x4*)(PQ + (size_t)row * 12 + 4), a2 = *(const f32x4*)(PQ + (size_t)row * 12 + 8), b0 = *(const f32x4*)(PKV + (size_t)row * 4);
          const float sq = ((a0[0] + a0[1]) + (a0[2] + a0[3])) + ((a1[0] + a1[1]) + (a1[2] + a1[3])) + ((a2[0] + a2[1]) + (a2[2] + a2[3])), sk = (b0[0] + b0[1]) + (b0[2] + b0[3]);
          RQ[row] = rsqrtf(sq * (1.f / 768.f) + EPS); RKV[row] = rsqrtf(sk * (1.f / 256.f) + EPS); }
#pragma unroll
        for (int i = 0; i < 4; ++i) { const f32x4 g1 = *(const f32x4*)(kg + 64 + 4 * i), g2 = *(const f32x4*)(kg + 80 + 4 * i); const f32x4 k1 = kp[i] * g1, k2 = kp[4 + i] * g2;
            *(f32x4*)(KPE + (size_t)row * 32 + 4 * i) = k1 * cs[i] - k2 * cs[4 + i]; *(f32x4*)(KPE + (size_t)row * 32 + 16 + 4 * i) = k1 * cs[4 + i] + k2 * cs[i]; }
    }
}

__device__ __forceinline__ int crow(int r, int hi) { return (r & 3) + 8 * (r >> 2) + 4 * hi; }
__device__ __forceinline__ void glds16(const void* gsrc, unsigned lds_dst) { unsigned keep;
    asm volatile("s_mov_b32 %0, m0\n\ts_mov_b32 m0, %2\n\ts_nop 0\n\tglobal_load_lds_dwordx4 %1, off\n\ts_mov_b32 m0, %0" : "=&s"(keep) : "v"(gsrc), "s"(lds_dst) : "memory"); }
__device__ __forceinline__ void glds12(const void* gsrc, unsigned lds_dst) { unsigned keep;
    asm volatile("s_mov_b32 %0, m0\n\ts_mov_b32 m0, %2\n\ts_nop 0\n\tglobal_load_lds_dwordx3 %1, off\n\ts_mov_b32 m0, %0" : "=&s"(keep) : "v"(gsrc), "s"(lds_dst) : "memory"); }
#define AWAIT_BAR(N) asm volatile("s_waitcnt vmcnt(" #N ") lgkmcnt(0)\n\ts_barrier" ::: "memory")
constexpr int AT_K = 0, AT_V = 24576, AT_WS = 40960, AT_OST = 43008, AT_END = 75776;
constexpr float C2 = 0.10206207261596575f * 1.4426950408889634f;

__device__ __forceinline__ void attn_unit_v1(int h, int qb, CArgs a, const LAS float* carry, LAS unsigned char* shm) {
    const int tid = threadIdx.x, lane = tid & 63, r32 = lane & 31, hi = lane >> 5; const int wid = __builtin_amdgcn_readfirstlane(tid >> 6);
    unsigned char* ws = a.ws;
    const bf16_t* QRAW = (const bf16_t*)(ws + WS_R1); const unsigned char* KI = ws + WS_KIMG + (size_t)h * 256 * 12288; const unsigned char* VI = (const unsigned char*)a.out + 32 * MiB + (size_t)h * 256 * 8192;
    const float* CS = (const float*)(ws + WS_CS); const float* qg = (const float*)a.in[15];
    const int q0 = qb * 256, rowq = q0 + wid * 32 + r32;
    const unsigned lds0 = (unsigned)(uintptr_t)shm;
    LAS float* wsf = (LAS float*)(shm + AT_WS) + wid * 64;
    bf16x8 qr[6];
    {
        const bf16_t* qp = QRAW + (size_t)rowq * 1536 + h * 96 + hi * 8;
        u32x4 raw[6]; float qv[6][8]; float ss = 0.f;
#pragma unroll
        for (int d0 = 0; d0 < 6; ++d0) raw[d0] = *(const u32x4*)(qp + d0 * 16);
#pragma unroll
        for (int d0 = 0; d0 < 6; ++d0)
#pragma unroll
            for (int j = 0; j < 4; ++j) { qv[d0][2 * j] = lo2f(raw[d0][j]); qv[d0][2 * j + 1] = hi2f(raw[d0][j]); ss += qv[d0][2 * j] * qv[d0][2 * j] + qv[d0][2 * j + 1] * qv[d0][2 * j + 1]; }
        ss += __shfl_xor(ss, 32);
        const float rs = rsqrtf(ss * (1.f / 96.f) + EPS);
#pragma unroll
        for (int d0 = 0; d0 < 6; ++d0) { const f32x4 g0 = *(const f32x4*)(qg + d0 * 16 + hi * 8), g1 = *(const f32x4*)(qg + d0 * 16 + hi * 8 + 4);
#pragma unroll
            for (int j = 0; j < 4; ++j) { qv[d0][j] *= rs * g0[j]; qv[d0][4 + j] *= rs * g1[j]; } }
        const f32x4 c0 = *(const f32x4*)(CS + (size_t)rowq * 32 + hi * 8), c1 = *(const f32x4*)(CS + (size_t)rowq * 32 + hi * 8 + 4), s0 = *(const f32x4*)(CS + (size_t)rowq * 32 + 16 + hi * 8), s1 = *(const f32x4*)(CS + (size_t)rowq * 32 + 16 + hi * 8 + 4);
#pragma unroll
        for (int j = 0; j < 8; ++j) { const float cs = j < 4 ? c0[j & 3] : c1[j & 3], sn = j < 4 ? s0[j & 3] : s1[j & 3]; const float x1 = qv[4][j], x2 = qv[5][j]; qv[4][j] = x1 * cs - x2 * sn; qv[5][j] = x1 * sn + x2 * cs; }
#pragma unroll
        for (int d0 = 0; d0 < 6; ++d0) { u32x4 w;
#pragma unroll
            for (int j = 0; j < 4; ++j) w[j] = pk2(qv[d0][2 * j] * C2, qv[d0][2 * j + 1] * C2);
            qr[d0] = __builtin_bit_cast(bf16x8, w); }
    }
    const int NT = 4 * qb + 4, mylast = 4 * qb + (wid >> 1);
#define AT_DMA(t, buf) do { const unsigned char* kt_ = KI + (size_t)(t) * 12288 + wid * 1024 + lane * 16; const unsigned kd_ = lds0 + AT_K + (buf) * 12288 + wid * 1024; \
        glds16(kt_, (unsigned)__builtin_amdgcn_readfirstlane(kd_)); if (wid < 4) glds16(kt_ + 8192, (unsigned)__builtin_amdgcn_readfirstlane(kd_ + 8192)); \
        glds16(VI + (size_t)(t) * 8192 + wid * 1024 + lane * 16, (unsigned)__builtin_amdgcn_readfirstlane(lds0 + AT_V + (buf) * 8192 + wid * 1024)); } while (0)
#define AT_WAIT1() do { if (wid < 4) asm volatile("s_waitcnt vmcnt(3)" ::: "memory"); else asm volatile("s_waitcnt vmcnt(2)" ::: "memory"); asm volatile("s_waitcnt lgkmcnt(0)\n\ts_barrier" ::: "memory"); } while (0)
    float m_run = -1e30f, l_run = 0.f; f32x16 o[2]; o[0] = f32x16{}; o[1] = f32x16{};
    AT_DMA(0, 0);
    for (int t = 0; t < NT; ++t) {
        const int buf = t & 1;
        if (t + 1 < NT) { AT_DMA(t + 1, buf ^ 1); AT_WAIT1(); } else { AWAIT_BAR(0); }
        if (t <= mylast) {
            const LAS unsigned char* kb = shm + AT_K + buf * 12288 + hi * 1024 + r32 * 16;
            f32x16 p0 = f32x16{}, p1 = f32x16{};
#pragma unroll
            for (int d0 = 0; d0 < 6; ++d0) { const bf16x8 b0 = *(const LAS bf16x8*)(kb + d0 * 2048), b1 = *(const LAS bf16x8*)(kb + d0 * 2048 + 512);
                p0 = __builtin_amdgcn_mfma_f32_32x32x16_bf16(b0, qr[d0], p0, 0, 0, 0); p1 = __builtin_amdgcn_mfma_f32_32x32x16_bf16(b1, qr[d0], p1, 0, 0, 0); }
            float rm = fmaxf(p0[0], p1[0]);
#pragma unroll
            for (int r = 1; r < 16; ++r) rm = fmaxf(rm, fmaxf(p0[r], p1[r]));
            rm = fmaxf(rm, __shfl_xor(rm, 32));
            const float mn = fmaxf(m_run, rm), alpha = fexp2(m_run - mn); m_run = mn;
            float ps = 0.f;
#pragma unroll
            for (int r = 0; r < 16; ++r) { p0[r] = fexp2(p0[r] - mn); p1[r] = fexp2(p1[r] - mn); ps += p0[r] + p1[r]; }
            l_run = l_run * alpha + ps;
            if (__any(alpha != 1.f)) {
                if (hi == 0) wsf[r32] = alpha;
                LDS_WAIT();
#pragma unroll
                for (int r = 0; r < 16; ++r) { const float f = wsf[crow(r, hi)]; o[0][r] *= f; o[1][r] *= f; }
            }
            u32x4 pw[4];
#pragma unroll
            for (int j = 0; j < 4; ++j) { pw[0][j] = pk2(p0[2 * j], p0[2 * j + 1]); pw[1][j] = pk2(p0[8 + 2 * j], p0[8 + 2 * j + 1]); pw[2][j] = pk2(p1[2 * j], p1[2 * j + 1]); pw[3][j] = pk2(p1[8 + 2 * j], p1[8 + 2 * j + 1]); }
            const LAS unsigned char* vb = shm + AT_V + buf * 8192 + ((lane >> 4) & 1) * 32 + (lane & 3) * 8 + (4 * hi + ((lane & 15) >> 2)) * 64;
#pragma unroll
            for (int d0 = 0; d0 < 2; ++d0)
#pragma unroll
                for (int ks = 0; ks < 4; ++ks) {
                    typedef short v4i16_t __attribute__((ext_vector_type(4)));
                    const s16x4 lo = __builtin_bit_cast(s16x4, __builtin_amdgcn_ds_read_tr16_b64_v4i16((LAS v4i16_t*)(vb + d0 * 4096 + ks * 1024)));
                    const s16x4 hh = __builtin_bit_cast(s16x4, __builtin_amdgcn_ds_read_tr16_b64_v4i16((LAS v4i16_t*)(vb + d0 * 4096 + ks * 1024 + 512)));
                    const bf16x8 vf = (bf16x8){lo[0], lo[1], lo[2], lo[3], hh[0], hh[1], hh[2], hh[3]};
                    o[d0] = __builtin_amdgcn_mfma_f32_32x32x16_bf16(__builtin_bit_cast(bf16x8, pw[ks]), vf, o[d0], 0, 0, 0);
                }
        }
        asm volatile("s_waitcnt lgkmcnt(0)\n\ts_barrier" ::: "memory");
    }
#undef AT_DMA
#undef AT_WAIT1
    l_run += __shfl_xor(l_run, 32);
    if (hi == 0) wsf[32 + r32] = l_run;
    LDS_WAIT();
    LAS bf16_t* stg = (LAS bf16_t*)(shm + AT_OST) + wid * 2048;
#pragma unroll
    for (int r = 0; r < 16; ++r) { const int orow = crow(r, hi); const float il = frcp(wsf[32 + orow]);
#pragma unroll
        for (int d0 = 0; d0 < 2; ++d0) stg[orow * 64 + d0 * 32 + r32] = (bf16_t)f2bf(o[d0][r] * il); }
    LDS_WAIT();
    const bf16_t* GB = (const bf16_t*)a.out; bf16_t* HL = (bf16_t*)(ws + WS_GR); const bf16_t* AC = (const bf16_t*)(ws + WS_GA);
#pragma unroll
    for (int i = 0; i < 4; ++i) { const int row = i * 8 + (lane >> 3), ch = lane & 7; const u32x4 yv = *(const LAS u32x4*)(stg + row * 64 + ch * 8);
        const size_t go = (size_t)(q0 + wid * 32 + row) * 1024 + h * 64 + ch * 8;
        const u32x4 gb = *(const u32x4*)(GB + go), hl = *(const u32x4*)(HL + go), ac = *(const u32x4*)(AC + go); u32x4 w;
#pragma unroll
        for (int j = 0; j < 4; ++j) { const float c0 = carry[ch * 8 + 2 * j], c1 = carry[ch * 8 + 2 * j + 1];
            w[j] = pk2(lo2f(yv[j]) * lo2f(gb[j]) + lo2f(hl[j]) + lo2f(ac[j]) * c0, hi2f(yv[j]) * hi2f(gb[j]) + hi2f(hl[j]) + hi2f(ac[j]) * c1); }
        *(u32x4*)(HL + go) = w; }
    asm volatile("s_waitcnt lgkmcnt(0)\n\ts_barrier" ::: "memory");
}

__device__ __forceinline__ void p3_attention(Frame& F, CArgs a) {
    const int head = (F.vcu >> 4) & 15, s = F.vcu & 15; const int qbs[4] = {s, 31 - s, 32 + s, 63 - s};
    LAS float* carry = (LAS float*)(F.lds + LDS_XCH);
    if (F.wave == 0) {
        const float* HEND = (const float*)(a.ws + WS_MISC + MISC_HEND); const float* AEND = (const float*)(a.ws + WS_MISC + MISC_AEND); const int c = head * 64 + F.lane; float cr = 0.f;
        for (int k = 0; k < 64; ++k) {
#pragma unroll
            for (int i = 0; i < 4; ++i) if (k == qbs[i]) carry[i * 64 + F.lane] = cr;
            cr = AEND[(size_t)k * 1024 + c] * cr + HEND[(size_t)k * 1024 + c];
        }
    }
    LDS_WAIT(); __syncthreads();
    if (F.vcu < 256)
        for (int i = 0; i < 4; ++i) attn_unit_v1(head, qbs[i], a, carry + i * 64, F.lds);
}

__device__ __forceinline__ void p6_route(Frame& F, CArgs a) {
    unsigned char* ws = a.ws; const float* H = a.out; const float* WR = (const float*)(ws + WS_MISC + MISC_WR); float* RH = (float*)(ws + WS_CTL + CTL_SSQ_H); const float* PH = (const float*)(ws + WS_SSQP + SSQP_H);
    const float* bg = (const float*)a.in[20]; const float* be = (const float*)a.in[22];
    unsigned* cnt = (unsigned*)(ws + WS_CTL) + CW_CNT; int* lists = (int*)(ws + WS_LIST); float* cwl = (float*)(ws + WS_LIST + 2 * MiB); unsigned* tokinfo = (unsigned*)(ws + WS_MISC + MISC_TOK);
    const int gw = F.vcu * NWAVES + F.wave, NGW = F.G * NWAVES, lane = F.lane;
    for (int row0 = gw * 4; row0 < M; row0 += NGW * 4) {
        f32x4 hv[4][4];
#pragma unroll
        for (int r = 0; r < 4; ++r)
#pragma unroll
            for (int j = 0; j < 4; ++j) hv[r][j] = *(const f32x4*)(H + (size_t)(row0 + r) * 1024 + 4 * lane + 256 * j);
        float rs[4];
#pragma unroll
        for (int r = 0; r < 4; ++r) { const float* pp = PH + (size_t)(row0 + r) * 16; const f32x4 a0 = *(const f32x4*)pp, a1 = *(const f32x4*)(pp + 4), a2 = *(const f32x4*)(pp + 8), a3 = *(const f32x4*)(pp + 12);
            const float sh = (((a0[0] + a0[1]) + (a0[2] + a0[3])) + ((a1[0] + a1[1]) + (a1[2] + a1[3]))) + (((a2[0] + a2[1]) + (a2[2] + a2[3])) + ((a3[0] + a3[1]) + (a3[2] + a3[3])));
            rs[r] = rsqrtf(sh * (1.f / 1024.f) + EPS); if (lane == 0) RH[row0 + r] = rs[r]; }
        float gl[4][4];
        int grp[4]; float pg[4], v1[4], v2[4]; int i1[4], i2[4];
#pragma unroll
        for (int r = 0; r < 4; ++r) { v1[r] = -INFINITY; v2[r] = -INFINITY; i1[r] = 0; i2[r] = 0; grp[r] = 0; pg[r] = 0.f; }
#pragma unroll 1
        for (int jj = 0; jj < 36; ++jj) {
            f32x4 w[4];
#pragma unroll
            for (int j = 0; j < 4; ++j) w[j] = *(const f32x4*)(WR + (size_t)jj * 1024 + 4 * lane + 256 * j);
            float lg[4];
#pragma unroll
            for (int r = 0; r < 4; ++r) { float s = 0.f;
#pragma unroll
                for (int j = 0; j < 4; ++j) { const f32x4 p = hv[r][j] * w[j]; s += (p[0] + p[1]) + (p[2] + p[3]); }
                lg[r] = wave_sum(s) * rs[r] + (jj < 4 ? bg[jj] : be[jj - 4]); }
            if (jj < 4) {
#pragma unroll
                for (int r = 0; r < 4; ++r) {
#pragma unroll
                    for (int q = 0; q < 4; ++q) if (q == jj) gl[r][q] = lg[r];
                }
                if (jj == 3) {
#pragma unroll
                    for (int r = 0; r < 4; ++r) { int g = 0; float mx = gl[r][0];
#pragma unroll
                        for (int q = 1; q < 4; ++q) if (gl[r][q] > mx) { mx = gl[r][q]; g = q; }
                        float den = 0.f;
#pragma unroll
                        for (int q = 0; q < 4; ++q) den += expf(gl[r][q] - mx);
                        grp[r] = g; pg[r] = 1.f / den; }
                }
            } else {
                const int ge = (jj - 4) >> 3, ie = (jj - 4) & 7;
#pragma unroll
                for (int r = 0; r < 4; ++r) if (ge == grp[r]) { const float v = lg[r];
                    if (v > v1[r]) { v2[r] = v1[r]; i2[r] = i1[r]; v1[r] = v; i1[r] = ie; } else if (v > v2[r]) { v2[r] = v; i2[r] = ie; } }
            }
        }
        if (lane < 4) {
            int g = grp[0], a1 = i1[0], a2 = i2[0]; float p = pg[0], x1 = v1[0], x2 = v2[0];
#pragma unroll
            for (int r = 1; r < 4; ++r) if (lane == r) { g = grp[r]; a1 = i1[r]; a2 = i2[r]; p = pg[r]; x1 = v1[r]; x2 = v2[r]; }
            const float e2 = expf(x2 - x1), s1 = 1.f / (1.f + e2), s2 = e2 * s1; const int tok = row0 + lane;
            const int e1 = g * 8 + a1, eb = g * 8 + a2;
            const unsigned sl1 = atomicAdd(cnt + e1, 1u), sl2 = atomicAdd(cnt + eb, 1u);
            lists[(size_t)e1 * M + sl1] = tok; cwl[(size_t)e1 * M + sl1] = p * s1; lists[(size_t)eb * M + sl2] = tok; cwl[(size_t)eb * M + sl2] = p * s2;
            tokinfo[tok * 2] = ((unsigned)e1 << 16) | sl1; tokinfo[tok * 2 + 1] = ((unsigned)eb << 16) | sl2;
        }
    }
}

__device__ __forceinline__ void moe_prefix(Frame& F, CArgs a, volatile LAS int* tpre, volatile LAS int* cnts) {
    const unsigned* cnt = (const unsigned*)(a.ws + WS_CTL) + CW_CNT;
    if (F.tid == 0) { int acc = 0; for (int e = 0; e < 32; ++e) { const int c = (int)__hip_atomic_load(cnt + e, RLX_AGENT); tpre[e] = acc; cnts[e] = c; acc += (c + 255) >> 8; } tpre[32] = acc; }
    LDS_WAIT(); __syncthreads();
}

__device__ __forceinline__ void p8_final(Frame& F, CArgs a, const volatile LAS int* tpre) {
    float* out = a.out; const bf16_t* Y = (const bf16_t*)(a.ws + WS_Y); const unsigned* tokinfo = (const unsigned*)(a.ws + WS_MISC + MISC_TOK);
    const int gw = F.vcu * NWAVES + F.wave, NGW = F.G * NWAVES, lane = F.lane;
    for (int tok = gw; tok < M; tok += NGW) {
        const unsigned i0 = tokinfo[tok * 2], i1 = tokinfo[tok * 2 + 1];
        const size_t s0 = (size_t)tpre[i0 >> 16] * 256 + (i0 & 0xffffu), s1 = (size_t)tpre[i1 >> 16] * 256 + (i1 & 0xffffu);
#pragma unroll
        for (int j = 0; j < 2; ++j) { const size_t c = 8 * lane + 512 * j; const u32x4 y0 = *(const u32x4*)(Y + s0 * 1024 + c), y1 = *(const u32x4*)(Y + s1 * 1024 + c);
            f32x4 h0 = *(const f32x4*)(out + (size_t)tok * 1024 + c), h1 = *(const f32x4*)(out + (size_t)tok * 1024 + c + 4);
            h0[0] += lo2f(y0[0]) + lo2f(y1[0]); h0[1] += hi2f(y0[0]) + hi2f(y1[0]); h0[2] += lo2f(y0[1]) + lo2f(y1[1]); h0[3] += hi2f(y0[1]) + hi2f(y1[1]);
            h1[0] += lo2f(y0[2]) + lo2f(y1[2]); h1[1] += hi2f(y0[2]) + hi2f(y1[2]); h1[2] += lo2f(y0[3]) + lo2f(y1[3]); h1[3] += hi2f(y0[3]) + hi2f(y1[3]);
            *(f32x4*)(out + (size_t)tok * 1024 + c) = h0; *(f32x4*)(out + (size_t)tok * 1024 + c + 4) = h1; }
    }
}
constexpr int NPHASE = 10;
#ifndef MK_ONE_LAUNCH
#define MK_ONE_LAUNCH 0
#endif
__global__ void __launch_bounds__(NTHREADS, 2) mega(Args a) {
    extern __shared__ __attribute__((aligned(16))) unsigned char lds_raw[];
    Frame F;
    F.lds = (LAS unsigned char*)lds_raw; F.MISC = (volatile LAS unsigned*)(F.lds + MISC_OFF);
    F.tid = threadIdx.x; F.lane = F.tid & 63; F.wave = __builtin_amdgcn_readfirstlane(F.tid >> 6);
    F.G = gridDim.x; { const int bx = blockIdx.x; F.vcu = (F.G % 8 == 0) ? (bx % 8) * (F.G / 8) + bx / 8 : bx; }
    const __attribute__((address_space(4))) Args* ap0 = (const __attribute__((address_space(4))) Args*)__builtin_amdgcn_kernarg_segment_ptr();
#define KA() (*({ const __attribute__((address_space(4))) Args* p_ = ap0; asm volatile("" : "+s"(p_)); p_; }))
    unsigned char* ws = a.ws; F.ctl = (gu32*)(ws + WS_CTL);
    for (int u = F.tid; u < (LDS_BYTES - LDSCTL_OFF) / 4; u += NTHREADS) ((LAS unsigned*)(F.lds + LDSCTL_OFF))[u] = 0u;
    __syncthreads();
    const int lo = a.ph_lo, hi = a.ph_hi;
    XcdBarrier bar; bar.bar = (unsigned*)(F.ctl + CW_BAR); bar.x = 0; bar.st = nullptr;
    if (hi - lo > 1) bar = xcd_barrier_post((unsigned*)(F.ctl + CW_BAR), F.MISC + 8);
#ifndef PH_MASK
#define PH_MASK 0x3ff
#endif
#define IN(k) (((PH_MASK >> (k)) & 1) && lo <= (k) && (k) < hi)
#define SEAM(k) do { if (IN(k) && IN((k) + 1)) xcd_barrier(bar); } while (0)
    volatile LAS int* tpre = (volatile LAS int*)(F.lds + LDS_XCH + 8192); volatile LAS int* cnts = tpre + 40;
    const int bx = (int)blockIdx.x;
    float* ssq_q = (float*)(ws + WS_CTL + CTL_SSQ_Q); float* ssq_kv = (float*)(ws + WS_CTL + CTL_SSQ_KV); float* ssq_h = (float*)(ws + WS_CTL + CTL_SSQ_H);

    if (IN(0)) { p0_prologue(F, KA()); SEAM(0); }
    if (IN(1)) {
        DenseOrder S; S.init(M, 5376, F.G, bx, ws + WS_R1, ws + WS_WIN, 1024, 1024);
        EpiProj E{(bf16_t*)(ws + WS_XR), (bf16_t*)(ws + WS_GR), (bf16_t*)(ws + WS_QC), (bf16_t*)(ws + WS_KVC), (bf16_t*)(ws + WS_GA), (bf16_t*)KA().out, (bf16_t*)(ws + WS_MISC + MISC_HALO), (float*)(ws + WS_KPE), (float*)(ws + WS_SSQP), (float*)(ws + WS_SSQP + SSQP_KV)};
        gemm_phase<EpiProj, DenseOrder, true>(F.lds, 1024, 1024, S, E);
        SEAM(1);
    }
    if (IN(2)) { p2a_conv(F, KA()); SEAM(2); }
    if (IN(3)) {
#ifndef P3_MASK
#define P3_MASK 7
#endif
        if (P3_MASK & 1) { DenseOrder S; S.init(M, 1536, F.G, bx, ws + WS_QC, ws + WS_WUQ, 768, 768); EpiQ E{(bf16_t*)(ws + WS_R1), ssq_q}; gemm_phase<EpiQ, DenseOrder, true>(F.lds, 768, 768, S, E); }
        if (P3_MASK & 2) { DenseOrder S; S.init(M, 2048, F.G, bx, ws + WS_KVC, ws + WS_WUKV, 256, 256);
          EpiKV E{ws + WS_KIMG, (unsigned char*)KA().out + 32 * MiB, ssq_kv, (const float*)(ws + WS_MISC + MISC_KSSQ), (const float*)(ws + WS_KPE), (const float*)KA().in[16]};
          gemm_phase<EpiKV, DenseOrder, true>(F.lds, 256, 256, S, E); }
        EpiLru E{(const bf16_t*)(ws + WS_XR), (const float*)KA().in[7], (const float*)KA().in[9], (const float*)KA().in[10], (bf16_t*)(ws + WS_GR), (bf16_t*)(ws + WS_GA), (float*)(ws + WS_MISC + MISC_HEND), (float*)(ws + WS_MISC + MISC_AEND)};
        if (P3_MASK & 4) for (int half = 0; half < 2; ++half) {
            OneOrder S{half * F.G, 8, (const char*)(ws + WS_XR), (const char*)(ws + WS_WLRU), (size_t)256 * 1024 * 2, (size_t)256 * 256 * 2, 512, bx, 512};
            gemm_phase<EpiLru, OneOrder, false>(F.lds, 256, 1024, S, E);
        }
        SEAM(3);
    }
    if (IN(4)) { p3_attention(F, KA()); SEAM(4); }
    if (IN(5)) {
        DenseOrder S; S.init(M, 1024, F.G, bx, ws + WS_GR, ws + WS_WOUT, 1024, 1024);
        EpiWout E{(const float*)KA().in[0], KA().out, (bf16_t*)(ws + WS_XR), (float*)(ws + WS_SSQP + SSQP_H)};
        gemm_phase<EpiWout, DenseOrder, true>(F.lds, 1024, 1024, S, E);
        SEAM(5);
    }
    if (IN(6)) { p6_route(F, KA()); moe_weight_convert(F, KA()); SEAM(6); }
    if (IN(7)) {
        moe_prefix(F, KA(), tpre, cnts);
        MoeOrder S{tpre, cnts, 2, F.G, bx, (const char*)(ws + WS_XR), (const char*)(ws + WS_WGU), (size_t)512 * 1024 * 2, (size_t)256 * 1024 * 2, (const int*)(ws + WS_LIST), 1, 0};
        EpiMoeGU E{(bf16_t*)(ws + WS_GA), ssq_h, (const int*)(ws + WS_LIST)};
        gemm_phase<EpiMoeGU, MoeOrder, true>(F.lds, 1024, 1024, S, E);
        SEAM(7);
    }
    if (IN(8)) {
        if (!IN(7)) moe_prefix(F, KA(), tpre, cnts);
        MoeOrder S{tpre, cnts, 4, F.G, bx, (const char*)(ws + WS_GA), (const char*)(ws + WS_WDN), (size_t)1024 * 256 * 2, (size_t)256 * 256 * 2, (const int*)(ws + WS_LIST), 0, (size_t)256 * 256 * 2};
        EpiMoeDown E{(bf16_t*)(ws + WS_Y), (const float*)(ws + WS_LIST + 2 * MiB)};
        gemm_phase<EpiMoeDown, MoeOrder, true>(F.lds, 256, 256, S, E);
        SEAM(8);
    }
    if (IN(9)) { if (!IN(8)) moe_prefix(F, KA(), tpre, cnts); p8_final(F, KA(), tpre); }
#undef IN
#undef SEAM
}

[[maybe_unused]] static void launch(void* const* d_in, float* d_out, unsigned char* ws, hipStream_t stream, int one_launch) {
    static int grid = 0;
    if (grid == 0) {
        int dev = 0, cus = 0;
        if (hipGetDevice(&dev) != hipSuccess || hipDeviceGetAttribute(&cus, hipDeviceAttributeMultiprocessorCount, dev) != hipSuccess) { fprintf(stderr, "device query failed\n"); grid = -1; return; }
        if (hipFuncSetAttribute((const void*)mega, hipFuncAttributeMaxDynamicSharedMemorySize, LDS_BYTES) != hipSuccess) { fprintf(stderr, "hipFuncSetAttribute failed\n"); grid = -1; return; }
        (void)hipGetLastError();
        grid = cus;
        if (grid != 256) fprintf(stderr, "warning: %d CUs (kernel built for 256)\n", grid);
    }
    if (grid < 0) return;
    (void)hipMemsetAsync(ws + WS_CTL, 0, CTL_BYTES, stream);
    Args a{};
    for (int i = 0; i < 26; ++i) a.in[i] = d_in[i];
    a.out = d_out; a.ws = ws;
    if (one_launch) { a.ph_lo = 0; a.ph_hi = NPHASE; hipLaunchKernelGGL(mega, dim3(grid), dim3(NTHREADS), LDS_BYTES, stream, a); }
    else for (int p = 0; p < NPHASE; ++p) { a.ph_lo = p; a.ph_hi = p + 1; hipLaunchKernelGGL(mega, dim3(grid), dim3(NTHREADS), LDS_BYTES, stream, a); }
}
}
extern "C" void kernel_launch(void* const* d_in, const int* in_sizes, int n_in, void* d_out, int out_size, void* d_ws, size_t ws_size, hipStream_t stream) {
    (void)in_sizes; (void)n_in; (void)out_size; (void)ws_size;
    mk::launch(d_in, (float*)d_out, (unsigned char*)d_ws, stream, MK_ONE_LAUNCH);
}
```

```cpp
#include <hip/hip_runtime.h>
#include <hip/hip_bf16.h>
#include <cstdint>
#include <cstdio>
#include <cmath>
namespace mk {
#define LAS __attribute__((address_space(3)))
#define GAS __attribute__((address_space(1)))
typedef unsigned short bf16_t;
typedef short bf16x8 __attribute__((ext_vector_type(8)));
typedef short s16x4 __attribute__((ext_vector_type(4)));
typedef float f32x2 __attribute__((ext_vector_type(2)));
typedef float f32x4 __attribute__((ext_vector_type(4)));
typedef float f32x16 __attribute__((ext_vector_type(16)));
typedef unsigned u32x2 __attribute__((ext_vector_type(2)));
typedef unsigned u32x4 __attribute__((ext_vector_type(4)));
typedef GAS unsigned gu32;

constexpr int M = 16384, D = 1024, NWAVES = 8, NTHREADS = 512;
constexpr float EPS = 1e-6f, LOG2E = 1.4426950408889634f;
constexpr size_t MiB = 1u << 20;
constexpr size_t WS_CTL = 0, CTL_BYTES = 1 * MiB;
constexpr size_t WS_WIN = 1 * MiB, WS_WUQ = 12 * MiB, WS_WUKV = 15 * MiB, WS_WLRU = 16 * MiB, WS_WOUT = 17 * MiB;
constexpr size_t WS_CS = 19 * MiB, WS_KPE = 21 * MiB, WS_MISC = 23 * MiB, WS_LIST = 25 * MiB;
constexpr size_t WS_R1 = 29 * MiB, WS_XR = 77 * MiB, WS_GR = 109 * MiB, WS_GA = 141 * MiB, WS_QC = 173 * MiB, WS_KVC = 197 * MiB, WS_KIMG = 205 * MiB, WS_DBG = 253 * MiB;
constexpr size_t MISC_HALO = 0, MISC_HEND = 512 * 1024, MISC_AEND = 768 * 1024, MISC_KSSQ = 1024 * 1024, MISC_WR = 1152 * 1024, MISC_TOK = 1408 * 1024;
constexpr size_t WS_SSQP = 253 * MiB, SSQP_KV = 786432, SSQP_H = 1048576;
constexpr size_t WS_Y = WS_QC;
constexpr size_t WS_WGU = WS_R1, WS_WDN = WS_R1 + 32 * MiB;
constexpr int CW_TMO = 0, CW_CODE = 1, CW_BAR = 4096, CW_CNT = 8192;
constexpr size_t CTL_SSQ_Q = 65536, CTL_SSQ_KV = 131072, CTL_SSQ_H = 196608;
constexpr int RING_BYTES = 131072, LDSCTL_OFF = RING_BYTES, MISC_OFF = LDSCTL_OFF + 320, LDS_XCH = 135168  , LDS_BYTES = 147456;

#define RLX_AGENT __ATOMIC_RELAXED, __HIP_MEMORY_SCOPE_AGENT
#define LDS_WAIT() asm volatile("s_waitcnt lgkmcnt(0)" ::: "memory")
#define VM_WAIT() asm volatile("s_waitcnt vmcnt(0)" ::: "memory")
__device__ __forceinline__ float bf2f(unsigned v) { return __uint_as_float(v << 16); }
__device__ __forceinline__ unsigned f2bf(float f) { unsigned u = __float_as_uint(f); return (u + 0x7fffu + ((u >> 16) & 1u)) >> 16; }
__device__ __forceinline__ unsigned pk2(float lo, float hi) { typedef __bf16 bf16x2_t __attribute__((ext_vector_type(2))); f32x2 v = {lo, hi}; bf16x2_t b = __builtin_convertvector(v, bf16x2_t); return __builtin_bit_cast(unsigned, b); }
__device__ __forceinline__ float lo2f(unsigned w) { return __uint_as_float(w << 16); }
__device__ __forceinline__ float hi2f(unsigned w) { return __uint_as_float(w & 0xffff0000u); }
__device__ __forceinline__ float fexp2(float x) { return __builtin_amdgcn_exp2f(x); }
__device__ __forceinline__ float frcp(float x) { return __builtin_amdgcn_rcpf(x); }
__device__ __forceinline__ float fsigm(float x) { return frcp(1.f + fexp2(-x * LOG2E)); }
__device__ __forceinline__ float fgelu(float x) { const float u = 0.7978845608028654f * (x + 0.044715f * x * x * x); return x * frcp(1.f + fexp2(-2.f * LOG2E * u)); }
__device__ __forceinline__ float wave_sum(float v) {
#pragma unroll
    for (int o = 1; o < 64; o <<= 1) v += __shfl_xor(v, o);
    return v;
}

#define XB_TMO      128
#define XB_XCNT(j)  (256  + 64 * (j))
#define XB_XSUB(j)  (1280 + 64 * (j))
#define XB_XGEN(j)  (2304 + 64 * (j))
#define XB_TOP      3328
#define XB_TOPGEN   3392
#define XCD_BAR_WORDS 3456
#define XB_SPIN_CAP (1u << 18)
__device__ __forceinline__ unsigned xb_ld(unsigned* p)              { return __hip_atomic_load(p, __ATOMIC_RELAXED, __HIP_MEMORY_SCOPE_AGENT); }
__device__ __forceinline__ unsigned xb_add(unsigned* p, unsigned v) { return __hip_atomic_fetch_add(p, v, __ATOMIC_RELAXED, __HIP_MEMORY_SCOPE_AGENT); }
__device__ __forceinline__ unsigned xb_xcc_id() { return (unsigned)__builtin_amdgcn_s_getreg((3 << 11) | 20) & 0xFu; }
#define XB_SPIN(cond, bar) do { unsigned _sp = 0; while (cond) { __builtin_amdgcn_s_sleep(1); \
    if ((++_sp & 255u) == 0u) { if (xb_ld(&(bar)[XB_TMO])) break; if (_sp > XB_SPIN_CAP) { atomicAdd(&(bar)[XB_TMO], 1u); break; } } } } while (0)
struct XcdBarrier { unsigned* bar; unsigned x; volatile LAS unsigned* st; };
__device__ __forceinline__ XcdBarrier xcd_barrier_post(unsigned* bar, volatile LAS unsigned* st) {
    XcdBarrier b; b.bar = bar; b.x = xb_xcc_id(); b.st = st;
    if (threadIdx.x == 0) (void)xb_add(&bar[XB_XCNT(b.x)], 1u);
    return b;
}
__device__ __forceinline__ void xcd_barrier_complete(unsigned* bar, unsigned x, unsigned& nloc, unsigned& nx) {
    const unsigned G = gridDim.x * gridDim.y * gridDim.z;
    unsigned sum, cnt, mine, sp = 0u;
    for (;;) {
        sum = 0u; cnt = 0u; mine = 0u;
#pragma unroll
        for (unsigned j = 0; j < 16; ++j) { const unsigned c = xb_ld(&bar[XB_XCNT(j)]); sum += c; cnt += (c > 0u) ? 1u : 0u; mine = (j == x) ? c : mine; }
        if (sum == G) break;
        __builtin_amdgcn_s_sleep(1);
        if ((++sp & 255u) == 0u) { if (xb_ld(&bar[XB_TMO])) break; if (sp > XB_SPIN_CAP) { atomicAdd(&bar[XB_TMO], 1u); break; } }
    }
    nloc = mine > 0u ? mine : 1u; nx = cnt > 0u ? cnt : 1u;
}
__device__ __forceinline__ void xcd_barrier(const XcdBarrier& b) {
    asm volatile("s_waitcnt vmcnt(0)" ::: "memory");
    __syncthreads();
    if (threadIdx.x == 0) {
        unsigned* bar = b.bar;
        __builtin_amdgcn_s_waitcnt(0);
        unsigned nloc = b.st[0], nx = b.st[1];
        if (nloc == 0u) { xcd_barrier_complete(bar, b.x, nloc, nx); b.st[0] = nloc; b.st[1] = nx; }
        const unsigned old = xb_add(&bar[XB_XSUB(b.x)], 1u);
        const unsigned gen = old / nloc;
        if (old + 1u == (gen + 1u) * nloc) {
            __builtin_amdgcn_fence(__ATOMIC_RELEASE, "agent");
            asm volatile("s_waitcnt vmcnt(0)" ::: "memory");
            const unsigned og = xb_add(&bar[XB_TOP], 1u);
            const unsigned tg = og / nx;
            if (og + 1u == (tg + 1u) * nx) xb_add(&bar[XB_TOPGEN], 1u);
            else XB_SPIN(xb_ld(&bar[XB_TOPGEN]) == tg, bar);
            __builtin_amdgcn_fence(__ATOMIC_ACQUIRE, "agent");
            xb_add(&bar[XB_XGEN(b.x)], 1u);
            asm volatile("s_waitcnt vmcnt(0)" ::: "memory");
        } else {
            XB_SPIN(xb_ld(&bar[XB_XGEN(b.x)]) == gen, bar);
            __builtin_amdgcn_fence(__ATOMIC_ACQUIRE, "agent");
            asm volatile("s_waitcnt vmcnt(0)" ::: "memory");
        }
    }
    __syncthreads();
}

constexpr int BM = 256, BK = 64, HALF = 128, HTB = HALF * BK * 2, STAGE_BYTES = 8 * HTB;
__device__ __forceinline__ int lds_byte(int r, int c) { const int st = (r >> 4) * 2 + (c >> 5), rr = r & 15, cc = c & 31, ob = rr * 64 + cc * 2; return st * 1024 + (ob ^ (((ob >> 9) & 1) << 5)); }
__device__ __forceinline__ void stage_rc(int b, int& R, int& C) { const int st = b / 1024, sb = b % 1024, swz = sb ^ (((sb >> 9) & 1) << 5); R = (st >> 1) * 16 + swz / 64; C = (st & 1) * 32 + (swz % 64) / 2; }
__device__ __forceinline__ int perm32(int rho) { const int n = rho >> 4, i = rho & 15; return 8 * (i >> 2) + 4 * n + (i & 3); }

struct Unit { int pm, pn; const char* A; const char* B; const int* gat; int valid; int x0, x1; };
typedef f32x4 Acc[2][2][4][2];

#define PG8_SA(b, h) (((b) * 2 + (h)) * HTB)
#define PG8_SB(b, h) ((4 + (b) * 2 + (h)) * HTB)
#define PG8_STAGE(bufoff, gbase, voff) do { _Pragma("unroll") for (int _i = 0; _i < 2; ++_i) \
        __builtin_amdgcn_global_load_lds((const unsigned*)((const char*)(gbase) + (voff)[_i]), (LAS unsigned*)(lds + (bufoff) + ldsw + _i * 8192), 16, 0, 0); } while (0)
#define PG8_LDA(dst, b, h) do { _Pragma("unroll") for (int m = 0; m < 4; ++m) _Pragma("unroll") for (int k = 0; k < 2; ++k) dst[m][k] = *(const LAS bf16x8*)(lds + PG8_SA(b, h) + aoff + m * 2048 + k * 1024); } while (0)
#define PG8_LDB(dst, b, h) do { _Pragma("unroll") for (int n = 0; n < 2; ++n) _Pragma("unroll") for (int k = 0; k < 2; ++k) dst[n][k] = *(const LAS bf16x8*)(lds + PG8_SB(b, h) + boff + n * 2048 + k * 1024); } while (0)
#define PG8_MMA(ai, bj, At, Bt) do { __builtin_amdgcn_s_setprio(1); _Pragma("unroll") for (int m = 0; m < 4; ++m) _Pragma("unroll") for (int n = 0; n < 2; ++n) _Pragma("unroll") for (int k = 0; k < 2; ++k) \
        acc[ai][bj][m][n] = __builtin_amdgcn_mfma_f32_16x16x32_bf16(Bt[n][k], At[m][k], acc[ai][bj][m][n], 0, 0, 0); __builtin_amdgcn_s_setprio(0); } while (0)
#define PG8_WAIT_V(n) asm volatile("s_waitcnt vmcnt(" #n ")" ::: "memory")
#define PG8_WAIT_L(n) asm volatile("s_waitcnt lgkmcnt(" #n ")" ::: "memory")
#define PG8_BAR __builtin_amdgcn_s_barrier()
#define PG8_SCHED __builtin_amdgcn_sched_barrier(0)
#define PG8_VOFFA(u, vo) do { _Pragma("unroll") for (int _h = 0; _h < 2; ++_h) _Pragma("unroll") for (int _i = 0; _i < 2; ++_i) { const int _row = _h * HALF + Ra[_i]; \
        const int _ri = (u).gat ? (_row < (u).valid ? (u).gat[_row] : 0) : _row; vo[_h][_i] = (unsigned)(_ri * lda + Ca[_i]) * 2u; } } while (0)

template <class Epi, class Sched, bool ALIGN_EPI>
__device__ __forceinline__ void gemm_phase(LAS unsigned char* lds, const int K, const int lda, const Sched& S, const Epi& E) {
    const int tid = threadIdx.x, wid = __builtin_amdgcn_readfirstlane(tid >> 6), lane = tid & 63, wr = wid >> 2, wc = wid & 3, fr = lane & 15, fq = lane >> 4;
    const int nt = K / BK;
    int Ra[2], Ca[2]; unsigned voffB[2];
#pragma unroll
    for (int i = 0; i < 2; ++i) { int R, C; stage_rc(tid * 16 + i * 8192, R, C); const int Rb = Epi::PERM ? ((R & ~31) + perm32(R & 31)) : R; Ra[i] = R; Ca[i] = C; voffB[i] = (unsigned)(Rb * K + C) * 2u; }
    const size_t kstep = (size_t)(BK * 2);
    const size_t hstep = (size_t)HALF * K * 2;
    const unsigned ldsw = (unsigned)wid * 1024u;
    const int aoff = lds_byte(wr * 64 + fr, fq * 8), boff = lds_byte(wc * 32 + fr, fq * 8);
    Unit cur, nxt; int ui = 0;
    if (!S.next(0, cur)) return;
    Acc acc;
#pragma unroll
    for (int a = 0; a < 2; ++a)
#pragma unroll
        for (int b = 0; b < 2; ++b)
#pragma unroll
            for (int m = 0; m < 4; ++m)
#pragma unroll
                for (int n = 0; n < 2; ++n) acc[a][b][m][n] = (f32x4){0.f, 0.f, 0.f, 0.f};
    bf16x8 At[4][2], B0[2][2], B1[2][2];
    unsigned vC[2][2], vN[2][2];
    PG8_VOFFA(cur, vC);
    const char* cA = cur.A; const char* cB = cur.B;
    PG8_STAGE(PG8_SB(0, 0), cB, voffB); PG8_STAGE(PG8_SB(0, 1), cB + hstep, voffB); PG8_STAGE(PG8_SA(0, 0), cA, vC[0]); PG8_STAGE(PG8_SA(0, 1), cA, vC[1]);
    if (wr == 1) PG8_BAR;
    PG8_WAIT_V(2); PG8_BAR;
    PG8_STAGE(PG8_SB(1, 0), cB + kstep, voffB); PG8_STAGE(PG8_SA(1, 0), cA + kstep, vC[0]); PG8_STAGE(PG8_SB(1, 1), cB + hstep + kstep, voffB);
    PG8_WAIT_V(6); PG8_BAR;
    for (;;) {
        const bool has_next = S.next(ui + 1, nxt);
        if (!has_next) nxt = cur;
        PG8_VOFFA(nxt, vN);
        const char* nA = nxt.A; const char* nB = nxt.B;
#pragma unroll 1
        for (int t = 0; t < nt; t += 2) {
            const bool last = (t == nt - 2);
            const char* a1 = cA + (size_t)(t + 1) * kstep;
            const char* a2 = last ? nA : cA + (size_t)(t + 2) * kstep; const char* b2 = last ? nB : cB + (size_t)(t + 2) * kstep;
            const char* a3 = a2 + kstep; const char* b3 = b2 + kstep;
            unsigned vS[2][2];
#pragma unroll
            for (int h = 0; h < 2; ++h)
#pragma unroll
                for (int i = 0; i < 2; ++i) vS[h][i] = last ? vN[h][i] : vC[h][i];
            PG8_LDB(B0, 0, 0); PG8_LDB(B1, 0, 1); PG8_SCHED; PG8_LDA(At, 0, 0); PG8_STAGE(PG8_SA(1, 1), a1, vC[1]);
            PG8_WAIT_V(8); PG8_WAIT_L(0); PG8_BAR; PG8_MMA(0, 0, At, B0); PG8_MMA(0, 1, At, B1); PG8_BAR; PG8_SCHED;
            PG8_LDA(At, 0, 1); PG8_STAGE(PG8_SB(0, 0), b2, voffB); PG8_STAGE(PG8_SB(0, 1), b2 + hstep, voffB); PG8_STAGE(PG8_SA(0, 0), a2, vS[0]);
            PG8_WAIT_V(8); PG8_WAIT_L(0); PG8_BAR; PG8_MMA(1, 0, At, B0); PG8_MMA(1, 1, At, B1); PG8_BAR; PG8_SCHED;
            PG8_LDB(B0, 1, 0); PG8_LDB(B1, 1, 1); PG8_SCHED; PG8_LDA(At, 1, 0); PG8_STAGE(PG8_SA(0, 1), a2, vS[1]);
            PG8_WAIT_V(8); PG8_WAIT_L(0); PG8_BAR; PG8_MMA(0, 0, At, B0); PG8_MMA(0, 1, At, B1); PG8_BAR; PG8_SCHED;
            PG8_LDA(At, 1, 1); PG8_STAGE(PG8_SB(1, 0), b3, voffB); PG8_STAGE(PG8_SB(1, 1), b3 + hstep, voffB); PG8_STAGE(PG8_SA(1, 0), a3, vS[0]);
            PG8_WAIT_V(8); PG8_WAIT_L(0); PG8_BAR; PG8_MMA(1, 0, At, B0); PG8_MMA(1, 1, At, B1); PG8_BAR; PG8_SCHED;
        }
        if constexpr (ALIGN_EPI) { if (wr == 0) PG8_BAR; }
        if constexpr (!Epi::AFTER_DRAIN) { E(acc, cur, wr, wc, fr, fq); }
        if (!has_next) break;
#pragma unroll
        for (int a = 0; a < 2; ++a)
#pragma unroll
            for (int b = 0; b < 2; ++b)
#pragma unroll
                for (int m = 0; m < 4; ++m)
#pragma unroll
                    for (int n = 0; n < 2; ++n) acc[a][b][m][n] = (f32x4){0.f, 0.f, 0.f, 0.f};
        cur = nxt; cA = nA; cB = nB; ++ui;
#pragma unroll
        for (int h = 0; h < 2; ++h)
#pragma unroll
            for (int i = 0; i < 2; ++i) vC[h][i] = vN[h][i];
        if constexpr (ALIGN_EPI) { if (wr == 1) PG8_BAR; }
    }
    PG8_WAIT_V(0);
    if constexpr (!ALIGN_EPI) { if (wr == 0) PG8_BAR; }
    PG8_BAR;
    if constexpr (Epi::AFTER_DRAIN) { E.fused(acc, cur, wr, wc, fr, fq, lds, wid, lane); }
}
struct DenseOrder {
    int nM, nN, nwg, G, c; const char* A; const char* B; size_t a_tile, b_tile; int a_col_tile;
    int pn_per_ablk;
    __device__ void init(int Mr, int N, int G_, int c_, const void* A_, const void* B_, int lda, int K, int pnpa = 0, int acolbytes = 0) {
        nM = Mr / BM; nN = N / BM; nwg = nM * nN; G = G_; c = c_; A = (const char*)A_; B = (const char*)B_; a_tile = (size_t)BM * lda * 2; b_tile = (size_t)BM * K * 2; pn_per_ablk = pnpa; a_col_tile = acolbytes; }
    __device__ bool next(int i, Unit& u) const {
        const long L = (long)i * G + c; if (L >= nwg) return false;
        int wgid = (int)L; { const int q = nwg / 8, r = nwg % 8, xcd = wgid % 8, off = wgid / 8; wgid = (xcd < r ? xcd * (q + 1) : r * (q + 1) + (xcd - r) * q) + off; }
        const int WGM = 8, nig = WGM * nN, gid = wgid / nig, fm = gid * WGM, gsz = (nM - fm) < WGM ? (nM - fm) : WGM;
        u.pm = fm + ((wgid % nig) % gsz); u.pn = (wgid % nig) / gsz;
        u.A = A + (size_t)u.pm * a_tile + (pn_per_ablk ? (size_t)(u.pn / pn_per_ablk) * a_col_tile : 0); u.B = B + (size_t)u.pn * b_tile; u.gat = nullptr; u.valid = 256; u.x0 = 0; u.x1 = 0; return true;
    }
};
struct OneOrder {
    int first, nN; const char* A; const char* B; size_t a_tile, b_tile; int a_col_tile; int c; int total;
    __device__ bool next(int i, Unit& u) const {
        if (i > 0) return false; const int L = first + c; if (L >= total) return false;
        u.pm = L / nN; u.pn = L % nN; u.A = A + (size_t)u.pm * a_tile + (size_t)(u.pn >> 1) * a_col_tile; u.B = B + (size_t)u.pn * b_tile; u.gat = nullptr; u.valid = 256; u.x0 = 0; u.x1 = 0; return true; }
};
struct MoeOrder {
    const volatile LAS int* tpre; const volatile LAS int* cnt; int ncol; int G, c; const char* A; const char* B; size_t b_exp; size_t b_tile; const int* lists; int gather; size_t a_tile;
    __device__ bool next(int i, Unit& u) const {
        const int L = i * G + c; const int ntile = __builtin_amdgcn_readfirstlane(tpre[32]); if (L >= ntile * ncol) return false;
        const int T = L / ncol, pn = L % ncol; int e = 0;
#pragma unroll 1
        for (int j = 1; j < 32; ++j) if (T >= tpre[j]) e = j;
        e = __builtin_amdgcn_readfirstlane(e);
        const int rt = __builtin_amdgcn_readfirstlane(T - tpre[e]); int valid = cnt[e] - rt * 256; valid = __builtin_amdgcn_readfirstlane(valid > 256 ? 256 : valid);
        u.pm = T; u.pn = pn; u.x0 = e; u.x1 = rt; u.valid = valid; u.B = B + (size_t)e * b_exp + (size_t)pn * b_tile;
        if (gather) { u.A = A; u.gat = lists + (size_t)e * M + rt * 256; } else { u.A = A + (size_t)T * a_tile; u.gat = nullptr; }
        return true; }
};

__device__ __forceinline__ u32x4 pack8(f32x4 a, f32x4 b) { u32x4 w; w.x = pk2(a[0], a[1]); w.y = pk2(a[2], a[3]); w.z = pk2(b[0], b[1]); w.w = pk2(b[2], b[3]); return w; }
__device__ __forceinline__ float dot4(f32x4 a) { return (a[0] * a[0] + a[1] * a[1]) + (a[2] * a[2] + a[3] * a[3]); }

struct EpiProj {
    static constexpr bool PERM = true, AFTER_DRAIN = false;
    bf16_t *XR, *GR, *QC, *KVC, *GA, *GB, *HALO; float *KPE, *ssq_q, *ssq_kv;
    __device__ __forceinline__ void operator()(const Acc& acc, const Unit& u, int wr, int wc, int fr, int fq) const {
        const int pn = u.pn, rowb = u.pm * BM + wr * 64 + fr;
        if (pn == 20) {
            if (wc == 0) {
#pragma unroll
                for (int ai = 0; ai < 2; ++ai)
#pragma unroll
                    for (int m = 0; m < 4; ++m) { float* p = KPE + (size_t)(rowb + ai * HALF + m * 16) * 32 + 8 * fq; *(f32x4*)p = acc[ai][0][m][0]; *(f32x4*)(p + 4) = acc[ai][0][m][1]; }
            }
            return;
        }
        bf16_t* dst; int ldc, colt, act = 0; float* ssq = nullptr; int nslot = 0, slot = 0;
        if (pn < 4) { dst = XR; ldc = 1024; colt = pn * 256; }
        else if (pn < 8) { dst = GR; ldc = 1024; colt = (pn - 4) * 256; act = 1; }
        else if (pn < 11) { dst = QC; ldc = 768; colt = (pn - 8) * 256; ssq = ssq_q; nslot = 12; slot = (pn - 8) * 4 + wc; }
        else if (pn == 11) { dst = KVC; ldc = 256; colt = 0; ssq = ssq_kv; nslot = 4; slot = wc; }
        else if (pn < 16) { dst = GA; ldc = 1024; colt = (pn - 12) * 256; act = 2; }
        else { dst = GB; ldc = 1024; colt = (pn - 16) * 256; act = 2; }
        const int col0 = colt + wc * 32 + 8 * fq;
#pragma unroll
        for (int ai = 0; ai < 2; ++ai)
#pragma unroll
            for (int m = 0; m < 4; ++m) {
                const int row = rowb + ai * HALF + m * 16; float ss = 0.f;
#pragma unroll
                for (int bj = 0; bj < 2; ++bj) {
                    f32x4 v0 = acc[ai][bj][m][0], v1 = acc[ai][bj][m][1];
                    if (ssq) ss += dot4(v0) + dot4(v1);
                    if (act == 1) {
#pragma unroll
                        for (int e = 0; e < 4; ++e) { v0[e] = fgelu(v0[e]); v1[e] = fgelu(v1[e]); }
                    } else if (act == 2) {
#pragma unroll
                        for (int e = 0; e < 4; ++e) { v0[e] = fsigm(v0[e]); v1[e] = fsigm(v1[e]); }
                    }
                    *(u32x4*)(dst + (size_t)row * ldc + col0 + bj * HALF) = pack8(v0, v1);
                }
                if (ssq) { ss += __shfl_xor(ss, 16); ss += __shfl_xor(ss, 32); if (fq == 0) ssq[(size_t)row * nslot + slot] = ss; }
            }
        if (pn < 4 && wr == 1 && fr >= 13) {
#pragma unroll
            for (int bj = 0; bj < 2; ++bj) *(u32x4*)(HALO + ((size_t)u.pm * 3 + (fr - 13)) * 1024 + col0 + bj * HALF) = pack8(acc[1][bj][3][0], acc[1][bj][3][1]);
        }
    }
};

struct EpiQ {
    static constexpr bool PERM = true, AFTER_DRAIN = false;
    bf16_t* Q; const float* ssq_q;
    __device__ __forceinline__ void operator()(const Acc& acc, const Unit& u, int wr, int wc, int fr, int fq) const {
        const int rowb = u.pm * BM + wr * 64 + fr, col0 = u.pn * BM + wc * 32 + 8 * fq;
#pragma unroll
        for (int ai = 0; ai < 2; ++ai)
#pragma unroll
            for (int m = 0; m < 4; ++m) {
                const int row = rowb + ai * HALF + m * 16; const float rs = ssq_q[row];
#pragma unroll
                for (int bj = 0; bj < 2; ++bj) *(u32x4*)(Q + (size_t)row * 1536 + col0 + bj * HALF) = pack8(acc[ai][bj][m][0] * rs, acc[ai][bj][m][1] * rs);
            }
    }
};

struct EpiKV {
    static constexpr bool PERM = true, AFTER_DRAIN = false;
    unsigned char* KIMG; unsigned char* VIMG; const float* ssq_kv; const float* kssq; const float* KPER; const float* kg;
    __device__ __forceinline__ void operator()(const Acc& acc, const Unit& u, int wr, int wc, int fr, int fq) const {
        const int rowb = u.pm * BM + wr * 64 + fr, h = 2 * u.pn + (wc & 1);
        if (wc < 2) {
            f32x4 g[2][2];
#pragma unroll
            for (int bj = 0; bj < 2; ++bj)
#pragma unroll
                for (int n = 0; n < 2; ++n) g[bj][n] = *(const f32x4*)(kg + 32 * bj + 8 * fq + 4 * n);
            const f32x4 gr0 = *(const f32x4*)(kg + 64 + 8 * fq), gr1 = *(const f32x4*)(kg + 64 + 8 * fq + 4); (void)gr0; (void)gr1;
#pragma unroll
            for (int ai = 0; ai < 2; ++ai)
#pragma unroll
                for (int m = 0; m < 4; ++m) {
                    const int row = rowb + ai * HALF + m * 16; const float rs = ssq_kv[row];
                    f32x4 v[2][2]; float ss = 0.f;
#pragma unroll
                    for (int bj = 0; bj < 2; ++bj)
#pragma unroll
                        for (int n = 0; n < 2; ++n) { v[bj][n] = acc[ai][bj][m][n] * rs; ss += dot4(v[bj][n]); }
                    ss += __shfl_xor(ss, 16); ss += __shfl_xor(ss, 32);
                    const float rk = rsqrtf((ss + kssq[row]) * (1.f / 96.f) + EPS);
                    unsigned char* img = KIMG + ((size_t)h * 256 + (row >> 6)) * 12288 + (row & 63) * 16;
#pragma unroll
                    for (int bj = 0; bj < 2; ++bj) *(u32x4*)(img + (4 * bj + fq) * 1024) = pack8(v[bj][0] * g[bj][0] * rk, v[bj][1] * g[bj][1] * rk);
                    const f32x4 r0 = *(const f32x4*)(KPER + (size_t)row * 32 + 8 * fq), r1 = *(const f32x4*)(KPER + (size_t)row * 32 + 8 * fq + 4);
                    *(u32x4*)(img + (8 + fq) * 1024) = pack8(r0 * rk, r1 * rk);
                    asm volatile("" ::: "memory");
                }
        } else {
#pragma unroll
            for (int ai = 0; ai < 2; ++ai)
#pragma unroll
                for (int m = 0; m < 4; ++m) {
                    const int row = rowb + ai * HALF + m * 16; const float rs = ssq_kv[row]; const int key = row & 63;
                    unsigned char* img = VIMG + ((size_t)h * 256 + (row >> 6)) * 8192 + (key >> 4) * 1024 + (key & 15) * 64 + fq * 16;
#pragma unroll
                    for (int bj = 0; bj < 2; ++bj) *(u32x4*)(img + bj * 4096) = pack8(acc[ai][bj][m][0] * rs, acc[ai][bj][m][1] * rs);
                    asm volatile("" ::: "memory");
                }
        }
    }
};

struct EpiLru {
    static constexpr bool PERM = false, AFTER_DRAIN = true;
    const bf16_t* XA; const float *ba, *bx, *lam; bf16_t* GRio; bf16_t* GAio; float* HEND; float* AEND;
    __device__ __forceinline__ void fused(Acc& acc, const Unit& u, int wr, int wc, int fr, int fq, LAS unsigned char* lds, int wid, int lane) const {
        const int chb = 256 * (u.pn >> 1) + 128 * (u.pn & 1), tid = threadIdx.x;
        LAS unsigned* S = (LAS unsigned*)lds;
        {
            f32x4 vba[2], vbx[2], vsp[2];
#pragma unroll
            for (int n = 0; n < 2; ++n) { const int c = chb + 32 * wc + 16 * n + 4 * fq; vba[n] = *(const f32x4*)(ba + c); vbx[n] = *(const f32x4*)(bx + c); const f32x4 l4 = *(const f32x4*)(lam + c);
#pragma unroll
                for (int e = 0; e < 4; ++e) vsp[n][e] = -8.f * LOG2E * log1pf(expf(-l4[e])); }
#pragma unroll
            for (int ai = 0; ai < 2; ++ai)
#pragma unroll
                for (int m = 0; m < 4; ++m) {
                    const int r = ai * HALF + wr * 64 + m * 16 + fr; const size_t grow = (size_t)(u.pm * BM + r) * 1024;
#pragma unroll
                    for (int n = 0; n < 2; ++n) {
                        const int x0 = 32 * wc + 16 * n + 4 * fq; const u32x2 xw = *(const u32x2*)(XA + grow + chb + x0);
                        const float xa[4] = {lo2f(xw.x), hi2f(xw.x), lo2f(xw.y), hi2f(xw.y)}; u32x4 o;
#pragma unroll
                        for (int e = 0; e < 4; ++e) {
                            const float rr = fsigm(acc[ai][0][m][n][e] + vba[n][e]), ii = fsigm(acc[ai][1][m][n][e] + vbx[n][e]);
                            const float la2 = rr * vsp[n][e]; const float a2 = fexp2(2.f * la2); const float mult = sqrtf(fmaxf(1.f - a2, 0.f));
                            o[e] = (f2bf(la2) << 16) | f2bf(mult * ii * xa[e]);
                        }
                        *(LAS u32x4*)(S + r * 128 + ((((x0 >> 2) ^ (r & 7)) << 2))) = o;
                    }
                    asm volatile("" ::: "memory");
                }
        }
        LDS_WAIT(); __builtin_amdgcn_s_barrier(); asm volatile("" ::: "memory");
        const int cp = tid & 63, sg = tid >> 6, c0 = 2 * cp; LAS f32x4* X = (LAS f32x4*)(lds + LDS_XCH);
        float h0 = 0.f, h1 = 0.f, s0 = 0.f, s1 = 0.f;
#pragma unroll 4
        for (int j = 0; j < 32; ++j) { const int r = sg * 32 + j; const u32x2 w = *(const LAS u32x2*)(S + r * 128 + ((((c0 >> 2) ^ (r & 7)) << 2) | (c0 & 3)));
            const float l0 = hi2f(w.x), l1 = hi2f(w.y); h0 = fexp2(l0) * h0 + lo2f(w.x); h1 = fexp2(l1) * h1 + lo2f(w.y); s0 += l0; s1 += l1; }
        X[sg * 64 + cp] = (f32x4){h0, s0, h1, s1};
        LDS_WAIT(); __builtin_amdgcn_s_barrier(); asm volatile("" ::: "memory");
        h0 = 0.f; h1 = 0.f; s0 = 0.f; s1 = 0.f;
        for (int q = 0; q < sg; ++q) { const f32x4 x = X[q * 64 + cp]; h0 = fexp2(x[1]) * h0 + x[0]; s0 += x[1]; h1 = fexp2(x[3]) * h1 + x[2]; s1 += x[3]; }
        const size_t gbase = (size_t)(u.pm * BM) * 1024 + chb + c0;
#pragma unroll 4
        for (int j = 0; j < 32; ++j) { const int r = sg * 32 + j; const u32x2 w = *(const LAS u32x2*)(S + r * 128 + ((((c0 >> 2) ^ (r & 7)) << 2) | (c0 & 3)));
            const float l0 = hi2f(w.x), l1 = hi2f(w.y); h0 = fexp2(l0) * h0 + lo2f(w.x); h1 = fexp2(l1) * h1 + lo2f(w.y); s0 += l0; s1 += l1;
            const size_t o = gbase + (size_t)r * 1024; const unsigned gr = *(const unsigned*)(GRio + o), ga = *(const unsigned*)(GAio + o);
            const float g0 = lo2f(gr) * lo2f(ga), g1 = hi2f(gr) * hi2f(ga);
            *(unsigned*)(GRio + o) = pk2(h0 * g0, h1 * g1); *(unsigned*)(GAio + o) = pk2(fexp2(s0) * g0, fexp2(s1) * g1); }
        if (sg == 7) { *(f32x2*)(HEND + (size_t)u.pm * 1024 + chb + c0) = (f32x2){h0, h1}; *(f32x2*)(AEND + (size_t)u.pm * 1024 + chb + c0) = (f32x2){fexp2(s0), fexp2(s1)}; }
        LDS_WAIT(); __builtin_amdgcn_s_barrier(); asm volatile("" ::: "memory");
    }
};

struct EpiWout {
    static constexpr bool PERM = true, AFTER_DRAIN = false;
    const float* x; float* out; bf16_t* HB; float* ssq_h;
    __device__ __forceinline__ void operator()(const Acc& acc, const Unit& u, int wr, int wc, int fr, int fq) const {
        const int rowb = u.pm * BM + wr * 64 + fr, col0 = u.pn * BM + wc * 32 + 8 * fq;
#pragma unroll
        for (int ai = 0; ai < 2; ++ai)
#pragma unroll
            for (int m = 0; m < 4; ++m) {
                const int row = rowb + ai * HALF + m * 16; float ss = 0.f;
#pragma unroll
                for (int bj = 0; bj < 2; ++bj) { const size_t o = (size_t)row * 1024 + col0 + bj * HALF;
                    const f32x4 h0 = *(const f32x4*)(x + o) + acc[ai][bj][m][0], h1 = *(const f32x4*)(x + o + 4) + acc[ai][bj][m][1];
                    ss += dot4(h0) + dot4(h1); *(f32x4*)(out + o) = h0; *(f32x4*)(out + o + 4) = h1; *(u32x4*)(HB + o) = pack8(h0, h1); }
                ss += __shfl_xor(ss, 16); ss += __shfl_xor(ss, 32); if (fq == 0) ssq_h[(size_t)row * 16 + u.pn * 4 + wc] = ss;
            }
    }
};

struct EpiMoeGU {
    static constexpr bool PERM = false, AFTER_DRAIN = false;
    bf16_t* HID; const float* ssq_h; const int* lists;
    __device__ __forceinline__ void operator()(const Acc& acc, const Unit& u, int wr, int wc, int fr, int fq) const {
        const int rb = wr * 64 + fr;
#pragma unroll
        for (int ai = 0; ai < 2; ++ai)
#pragma unroll
            for (int m = 0; m < 4; ++m) {
                const int r = rb + ai * HALF + m * 16;
                if (r < u.valid) {
                    const int tok = lists[(size_t)u.x0 * M + u.x1 * 256 + r]; const float rs = ssq_h[tok];
#pragma unroll
                    for (int n = 0; n < 2; ++n) { f32x4 g = acc[ai][0][m][n] * rs, up = acc[ai][1][m][n] * rs, hb;
#pragma unroll
                        for (int e = 0; e < 4; ++e) hb[e] = g[e] * fsigm(g[e]) * up[e];
                        u32x2 w; w.x = pk2(hb[0], hb[1]); w.y = pk2(hb[2], hb[3]);
                        *(u32x2*)((char*)HID + (unsigned)((((unsigned)u.pm * 256u + (unsigned)r) * 256u + 128u * (unsigned)u.pn + 32u * (unsigned)wc + 16u * (unsigned)n + 4u * (unsigned)fq) * 2u)) = w; }
                }
                asm volatile("" ::: "memory");
            }
    }
};
struct EpiMoeDown {
    static constexpr bool PERM = true, AFTER_DRAIN = false;
    bf16_t* Y; const float* cwl;
    __device__ __forceinline__ void operator()(const Acc& acc, const Unit& u, int wr, int wc, int fr, int fq) const {
        const int rb = wr * 64 + fr, col0 = u.pn * BM + wc * 32 + 8 * fq;
#pragma unroll
        for (int ai = 0; ai < 2; ++ai)
#pragma unroll
            for (int m = 0; m < 4; ++m) {
                const int r = rb + ai * HALF + m * 16;
                if (r < u.valid) { const float cw = cwl[(size_t)u.x0 * M + u.x1 * 256 + r];
#pragma unroll
                    for (int bj = 0; bj < 2; ++bj) *(u32x4*)((char*)Y + (unsigned)((((unsigned)u.pm * 256u + (unsigned)r) * 1024u + (unsigned)(col0 + bj * HALF)) * 2u)) = pack8(acc[ai][bj][m][0] * cw, acc[ai][bj][m][1] * cw); }
                asm volatile("" ::: "memory");
            }
    }
};
struct Frame {
    LAS unsigned char* lds; volatile LAS unsigned* MISC; gu32* ctl;
    int tid, lane, wave, vcu, G;
    void* const* in_dummy;
};
struct Args { const void* in[26]; float* out; unsigned char* ws; int ph_lo, ph_hi; };
typedef const __attribute__((address_space(4))) Args& CArgs;

__device__ __forceinline__ void tr_item(const float* W, int ldn, int ns0, bf16_t* WT, int K, int nd0, int k0, const float* kscale, LAS float* scr, int lane) {
#pragma unroll 8
    for (int i = 0; i < 32; ++i) { const int kk = 2 * i + (lane >> 5); float v = W[(size_t)(k0 + kk) * ldn + ns0 + (lane & 31)]; if (kscale) v *= kscale[k0 + kk]; scr[kk * 33 + (lane & 31)] = v; }
    LDS_WAIT(); asm volatile("" ::: "memory");
    const int c = lane & 7;
#pragma unroll
    for (int j = 0; j < 4; ++j) { const int n = (lane >> 3) + 8 * j; const LAS float* s = scr + (8 * c) * 33 + n;
        u32x4 o; o.x = pk2(s[0 * 33], s[1 * 33]); o.y = pk2(s[2 * 33], s[3 * 33]); o.z = pk2(s[4 * 33], s[5 * 33]); o.w = pk2(s[6 * 33], s[7 * 33]);
        *(u32x4*)(WT + (size_t)(nd0 + n) * K + k0 + 8 * c) = o; }
    LDS_WAIT(); asm volatile("" ::: "memory");
}

__device__ __forceinline__ void p0_prologue(Frame& F, CArgs a) {
    LAS float* scr = (LAS float*)(F.lds + F.wave * 16384);
    const int gw = F.vcu * NWAVES + F.wave, NGW = F.G * NWAVES, lane = F.lane;
    unsigned char* ws = a.ws;
    const float* w_in = (const float*)a.in[3];
    bf16_t* WIN = (bf16_t*)(ws + WS_WIN); bf16_t* WUQ = (bf16_t*)(ws + WS_WUQ); bf16_t* WUKV = (bf16_t*)(ws + WS_WUKV); bf16_t* WLRU = (bf16_t*)(ws + WS_WLRU); bf16_t* WOUT = (bf16_t*)(ws + WS_WOUT);
    constexpr int I_IN = 16 * 168, I_UQ = 12 * 48, I_UKV = 4 * 64, I_LRU = 4 * 64, I_OUT = 16 * 32, NITEMS = I_IN + I_UQ + I_UKV + I_LRU + I_OUT;
    for (int it = gw; it < NITEMS; it += NGW) {
        int r = it;
        if (r < I_IN) { const int kb = r / 168, nb = r % 168, nd0 = 32 * nb, k0 = 64 * kb;
            if (nd0 < 5152) { const int ns0 = nd0 < 3072 ? nd0 : (nd0 < 5120 ? nd0 + 32 : 3072); tr_item(w_in, 5152, ns0, WIN, 1024, nd0, k0, nullptr, scr, lane); }
            else { const int c = lane & 7;
#pragma unroll
                for (int j = 0; j < 4; ++j) { const int n = (lane >> 3) + 8 * j; *(u32x4*)(WIN + (size_t)(nd0 + n) * 1024 + k0 + 8 * c) = (u32x4){0u, 0u, 0u, 0u}; } }
            continue; }
        r -= I_IN;
        if (r < I_UQ) { const int kb = r / 48, nb = r % 48; tr_item((const float*)a.in[12], 1536, 32 * nb, WUQ, 768, 32 * nb, 64 * kb, (const float*)a.in[11], scr, lane); continue; }
        r -= I_UQ;
        if (r < I_UKV) { const int kb = r / 64, nb = r % 64, nd0 = 32 * nb, pn = nd0 >> 8, bj = (nd0 >> 7) & 1, wc = (nd0 >> 5) & 3;
            tr_item((const float*)a.in[14], 2048, (2 * pn + (wc & 1)) * 128 + (wc >> 1) * 64 + 32 * bj, WUKV, 256, nd0, 64 * kb, (const float*)a.in[13], scr, lane); continue; }
        r -= I_UKV;
        if (r < I_LRU) { const int kb = r / 64, nb = r % 64, nd0 = 32 * nb, pn = nd0 >> 8, bj = (nd0 >> 7) & 1, xb = nd0 & 127, blk = pn >> 1;
            tr_item((const float*)a.in[bj ? 8 : 6] + (size_t)blk * 65536, 256, 128 * (pn & 1) + xb, WLRU, 256, nd0, 64 * kb, nullptr, scr, lane); continue; }
        r -= I_LRU;
        { const int kb = r / 32, nb = r % 32; tr_item((const float*)a.in[17], 1024, 32 * nb, WOUT, 1024, 32 * nb, 64 * kb, nullptr, scr, lane); }
    }
    const float* x = (const float*)a.in[0]; const float* gm = (const float*)a.in[2]; bf16_t* XN = (bf16_t*)(ws + WS_R1);
    f32x4 g4[4];
#pragma unroll
    for (int j = 0; j < 4; ++j) g4[j] = *(const f32x4*)(gm + 4 * lane + 256 * j);
    for (int m = gw; m < M; m += NGW) {
        const f32x4* xr = (const f32x4*)(x + (size_t)m * D) + lane; f32x4 v[4]; float s = 0.f;
#pragma unroll
        for (int j = 0; j < 4; ++j) { v[j] = xr[64 * j]; s += dot4(v[j]); }
        const float rstd = rsqrtf(wave_sum(s) * (1.f / 1024.f) + EPS);
        u32x2* o8 = (u32x2*)(XN + (size_t)m * D) + lane;
#pragma unroll
        for (int j = 0; j < 4; ++j) { const f32x4 y = v[j] * rstd * g4[j]; u32x2 w; w.x = pk2(y[0], y[1]); w.y = pk2(y[2], y[3]); o8[64 * j] = w; }
    }
    const int gt = F.vcu * NTHREADS + F.tid, NGT = F.G * NTHREADS;
    const int* pos = (const int*)a.in[1]; float* CS = (float*)(ws + WS_CS);
    for (int i = gt; i < M * 16; i += NGT) { const int t = i >> 4, j = i & 15; const float fr = powf(10000.f, -(float)j / 16.f); const float ang = (float)pos[t] * fr; CS[t * 32 + j] = cosf(ang); CS[t * 32 + 16 + j] = sinf(ang); }
    float* WR = (float*)(ws + WS_MISC + MISC_WR); const float* gf = (const float*)a.in[18]; const float* wg = (const float*)a.in[19]; const float* we = (const float*)a.in[21];
    for (int i = gt; i < 36 * 1024; i += NGT) { const int j = i >> 10, k = i & 1023; WR[i] = (j < 4 ? wg[k * 4 + j] : we[k * 32 + (j - 4)]) * gf[k]; }
}

__device__ __forceinline__ void moe_weight_convert(Frame& F, CArgs a) {
    LAS float* scr = (LAS float*)(F.lds + F.wave * 16384);
    const int gw = F.vcu * NWAVES + F.wave, NGW = F.G * NWAVES, lane = F.lane;
    bf16_t* WGU = (bf16_t*)(a.ws + WS_WGU); bf16_t* WDN = (bf16_t*)(a.ws + WS_WDN); const float* gf = (const float*)a.in[18];
    constexpr int I_GU = 32 * 16 * 16, I_DN = 32 * 4 * 32;
    for (int it = gw; it < I_GU + I_DN; it += NGW) {
        if (it < I_GU) { const int e = it >> 8, r = it & 255, kb = r >> 4, nb = r & 15, nd0 = 32 * nb, pn = nd0 >> 8, bj = (nd0 >> 7) & 1, xb = nd0 & 127;
            tr_item((const float*)a.in[bj ? 24 : 23] + (size_t)e * 262144, 256, 128 * pn + xb, WGU + (size_t)e * 524288, 1024, nd0, 64 * kb, gf, scr, lane); }
        else { const int r0 = it - I_GU, e = r0 >> 7, r = r0 & 127, kb = r >> 5, nb = r & 31;
            tr_item((const float*)a.in[25] + (size_t)e * 262144, 1024, 32 * nb, WDN + (size_t)e * 262144, 256, 32 * nb, 64 * kb, nullptr, scr, lane); }
    }
}

__device__ __forceinline__ void p2a_conv(Frame& F, CArgs a) {
    unsigned char* ws = a.ws; bf16_t* XR = (bf16_t*)(ws + WS_XR); const bf16_t* HALO = (const bf16_t*)(ws + WS_MISC + MISC_HALO);
    const float* cw = (const float*)a.in[4]; const float* cb = (const float*)a.in[5];
    for (int b = F.vcu; b < 256; b += F.G) {
        const int pm = b >> 2, cg = b & 3, cp = F.tid & 127, sg = F.tid >> 7, c = cg * 256 + 2 * cp, base = pm * 256 + sg * 64;
        float h0[3], h1[3];
#pragma unroll
        for (int i = 0; i < 3; ++i) { unsigned w = 0u;
            if (sg == 0) { if (pm > 0) w = *(const unsigned*)(HALO + ((size_t)(pm - 1) * 3 + i) * 1024 + c); }
            else w = *(const unsigned*)(XR + (size_t)(base - 3 + i) * 1024 + c);
            h0[i] = lo2f(w); h1[i] = hi2f(w); }
        VM_WAIT(); __syncthreads();
        float w0[4], w1[4];
#pragma unroll
        for (int k = 0; k < 4; ++k) { w0[k] = cw[k * 1024 + c]; w1[k] = cw[k * 1024 + c + 1]; }
        const float b0 = cb[c], b1 = cb[c + 1];
        for (int j0 = 0; j0 < 64; j0 += 8) {
            unsigned xw[8];
#pragma unroll
            for (int j = 0; j < 8; ++j) xw[j] = *(const unsigned*)(XR + (size_t)(base + j0 + j) * 1024 + c);
#pragma unroll
            for (int j = 0; j < 8; ++j) { const float x0 = lo2f(xw[j]), x1 = hi2f(xw[j]);
                const float y0 = b0 + w0[0] * h0[0] + w0[1] * h0[1] + w0[2] * h0[2] + w0[3] * x0, y1 = b1 + w1[0] * h1[0] + w1[1] * h1[1] + w1[2] * h1[2] + w1[3] * x1;
                h0[0] = h0[1]; h0[1] = h0[2]; h0[2] = x0; h1[0] = h1[1]; h1[1] = h1[2]; h1[2] = x1;
                *(unsigned*)(XR + (size_t)(base + j0 + j) * 1024 + c) = pk2(y0, y1); }
        }
        __syncthreads();
    }
    const int gt = F.vcu * NTHREADS + F.tid, NGT = F.G * NTHREADS;
    const float* PQ = (const float*)(ws + WS_SSQP); const float* PKV = (const float*)(ws + WS_SSQP + SSQP_KV); float* RQ = (float*)(ws + WS_CTL + CTL_SSQ_Q); float* RKV = (float*)(ws + WS_CTL + CTL_SSQ_KV);
    float* KPE = (float*)(ws + WS_KPE); const float* CS = (const float*)(ws + WS_CS); float* KSSQ = (float*)(ws + WS_MISC + MISC_KSSQ); const float* kg = (const float*)a.in[16];
    for (int row = gt; row < M; row += NGT) {
        f32x4 kp[8], cs[8];
#pragma unroll
        for (int i = 0; i < 8; ++i) { kp[i] = *(const f32x4*)(KPE + (size_t)row * 32 + 4 * i); cs[i] = *(const f32x4*)(CS + (size_t)row * 32 + 4 * i); }
        float ss = 0.f;
#pragma unroll
        for (int i = 0; i < 8; ++i) ss += dot4(kp[i]);
        KSSQ[row] = ss;
        { const f32x4 a0 = *(const f32x4*)(PQ + (size_t)row * 12), a1 = *(const f32x4*)(PQ + (size_t)row * 12 + 4), a2 = *(const f32x4*)(PQ + (size_t)row * 12 + 8), b0 = *(const f32x4*)(PKV + (size_t)row * 4);
          const float sq = ((a0[0] + a0[1]) + (a0[2] + a0[3])) + ((a1[0] + a1[1]) + (a1[2] + a1[3])) + ((a2[0] + a2[1]) + (a2[2] + a2[3])), sk = (b0[0] + b0[1]) + (b0[2] + b0[3]);
          RQ[row] = rsqrtf(sq * (1.f / 768.f) + EPS); RKV[row] = rsqrtf(sk * (1.f / 256.f) + EPS); }
#pragma unroll
        for (int i = 0; i < 4; ++i) { const f32x4 g1 = *(const f32x4*)(kg + 64 + 4 * i), g2 = *(const f32x4*)(kg + 80 + 4 * i); const f32x4 k1 = kp[i] * g1, k2 = kp[4 + i] * g2;
            *(f32x4*)(KPE + (size_t)row * 32 + 4 * i) = k1 * cs[i] - k2 * cs[4 + i]; *(f32x4*)(KPE + (size_t)row * 32 + 16 + 4 * i) = k1 * cs[4 + i] + k2 * cs[i]; }
    }
}

__device__ __forceinline__ int crow(int r, int hi) { return (r & 3) + 8 * (r >> 2) + 4 * hi; }
__device__ __forceinline__ void glds16(const void* gsrc, unsigned lds_dst) { unsigned keep;
    asm volatile("s_mov_b32 %0, m0\n\ts_mov_b32 m0, %2\n\ts_nop 0\n\tglobal_load_lds_dwordx4 %1, off\n\ts_mov_b32 m0, %0" : "=&s"(keep) : "v"(gsrc), "s"(lds_dst) : "memory"); }
__device__ __forceinline__ void glds12(const void* gsrc, unsigned lds_dst) { unsigned keep;
    asm volatile("s_mov_b32 %0, m0\n\ts_mov_b32 m0, %2\n\ts_nop 0\n\tglobal_load_lds_dwordx3 %1, off\n\ts_mov_b32 m0, %0" : "=&s"(keep) : "v"(gsrc), "s"(lds_dst) : "memory"); }
#define AWAIT_BAR(N) asm volatile("s_waitcnt vmcnt(" #N ") lgkmcnt(0)\n\ts_barrier" ::: "memory")
constexpr int AT_K = 0, AT_V = 24576, AT_WS = 40960, AT_OST = 43008, AT_END = 75776;
constexpr float C2 = 0.10206207261596575f * 1.4426950408889634f;

__device__ __forceinline__ void attn_unit_v1(int h, int qb, CArgs a, const LAS float* carry, LAS unsigned char* shm) {
    const int tid = threadIdx.x, lane = tid & 63, r32 = lane & 31, hi = lane >> 5; const int wid = __builtin_amdgcn_readfirstlane(tid >> 6);
    unsigned char* ws = a.ws;
    const bf16_t* QRAW = (const bf16_t*)(ws + WS_R1); const unsigned char* KI = ws + WS_KIMG + (size_t)h * 256 * 12288; const unsigned char* VI = (const unsigned char*)a.out + 32 * MiB + (size_t)h * 256 * 8192;
    const float* CS = (const float*)(ws + WS_CS); const float* qg = (const float*)a.in[15];
    const int q0 = qb * 256, rowq = q0 + wid * 32 + r32;
    const unsigned lds0 = (unsigned)(uintptr_t)shm;
    LAS float* wsf = (LAS float*)(shm + AT_WS) + wid * 64;
    bf16x8 qr[6];
    {
        const bf16_t* qp = QRAW + (size_t)rowq * 1536 + h * 96 + hi * 8;
        u32x4 raw[6]; float qv[6][8]; float ss = 0.f;
#pragma unroll
        for (int d0 = 0; d0 < 6; ++d0) raw[d0] = *(const u32x4*)(qp + d0 * 16);
#pragma unroll
        for (int d0 = 0; d0 < 6; ++d0)
#pragma unroll
            for (int j = 0; j < 4; ++j) { qv[d0][2 * j] = lo2f(raw[d0][j]); qv[d0][2 * j + 1] = hi2f(raw[d0][j]); ss += qv[d0][2 * j] * qv[d0][2 * j] + qv[d0][2 * j + 1] * qv[d0][2 * j + 1]; }
        ss += __shfl_xor(ss, 32);
        const float rs = rsqrtf(ss * (1.f / 96.f) + EPS);
#pragma unroll
        for (int d0 = 0; d0 < 6; ++d0) { const f32x4 g0 = *(const f32x4*)(qg + d0 * 16 + hi * 8), g1 = *(const f32x4*)(qg + d0 * 16 + hi * 8 + 4);
#pragma unroll
            for (int j = 0; j < 4; ++j) { qv[d0][j] *= rs * g0[j]; qv[d0][4 + j] *= rs * g1[j]; } }
        const f32x4 c0 = *(const f32x4*)(CS + (size_t)rowq * 32 + hi * 8), c1 = *(const f32x4*)(CS + (size_t)rowq * 32 + hi * 8 + 4), s0 = *(const f32x4*)(CS + (size_t)rowq * 32 + 16 + hi * 8), s1 = *(const f32x4*)(CS + (size_t)rowq * 32 + 16 + hi * 8 + 4);
#pragma unroll
        for (int j = 0; j < 8; ++j) { const float cs = j < 4 ? c0[j & 3] : c1[j & 3], sn = j < 4 ? s0[j & 3] : s1[j & 3]; const float x1 = qv[4][j], x2 = qv[5][j]; qv[4][j] = x1 * cs - x2 * sn; qv[5][j] = x1 * sn + x2 * cs; }
#pragma unroll
        for (int d0 = 0; d0 < 6; ++d0) { u32x4 w;
#pragma unroll
            for (int j = 0; j < 4; ++j) w[j] = pk2(qv[d0][2 * j] * C2, qv[d0][2 * j + 1] * C2);
            qr[d0] = __builtin_bit_cast(bf16x8, w); }
    }
    const int NT = 4 * qb + 4, mylast = 4 * qb + (wid >> 1);
#define AT_DMA(t, buf) do { const unsigned char* kt_ = KI + (size_t)(t) * 12288 + wid * 1024 + lane * 16; const unsigned kd_ = lds0 + AT_K + (buf) * 12288 + wid * 1024; \
        glds16(kt_, (unsigned)__builtin_amdgcn_readfirstlane(kd_)); if (wid < 4) glds16(kt_ + 8192, (unsigned)__builtin_amdgcn_readfirstlane(kd_ + 8192)); \
        glds16(VI + (size_t)(t) * 8192 + wid * 1024 + lane * 16, (unsigned)__builtin_amdgcn_readfirstlane(lds0 + AT_V + (buf) * 8192 + wid * 1024)); } while (0)
#define AT_WAIT1() do { if (wid < 4) asm volatile("s_waitcnt vmcnt(3)" ::: "memory"); else asm volatile("s_waitcnt vmcnt(2)" ::: "memory"); asm volatile("s_waitcnt lgkmcnt(0)\n\ts_barrier" ::: "memory"); } while (0)
    float m_run = -1e30f, l_run = 0.f; f32x16 o[2]; o[0] = f32x16{}; o[1] = f32x16{};
    AT_DMA(0, 0);
    for (int t = 0; t < NT; ++t) {
        const int buf = t & 1;
        if (t + 1 < NT) { AT_DMA(t + 1, buf ^ 1); AT_WAIT1(); } else { AWAIT_BAR(0); }
        if (t <= mylast) {
            const LAS unsigned char* kb = shm + AT_K + buf * 12288 + hi * 1024 + r32 * 16;
            f32x16 p0 = f32x16{}, p1 = f32x16{};
#pragma unroll
            for (int d0 = 0; d0 < 6; ++d0) { const bf16x8 b0 = *(const LAS bf16x8*)(kb + d0 * 2048), b1 = *(const LAS bf16x8*)(kb + d0 * 2048 + 512);
                p0 = __builtin_amdgcn_mfma_f32_32x32x16_bf16(b0, qr[d0], p0, 0, 0, 0); p1 = __builtin_amdgcn_mfma_f32_32x32x16_bf16(b1, qr[d0], p1, 0, 0, 0); }
            float rm = fmaxf(p0[0], p1[0]);
#pragma unroll
            for (int r = 1; r < 16; ++r) rm = fmaxf(rm, fmaxf(p0[r], p1[r]));
            rm = fmaxf(rm, __shfl_xor(rm, 32));
            const float mn = fmaxf(m_run, rm), alpha = fexp2(m_run - mn); m_run = mn;
            float ps = 0.f;
#pragma unroll
            for (int r = 0; r < 16; ++r) { p0[r] = fexp2(p0[r] - mn); p1[r] = fexp2(p1[r] - mn); ps += p0[r] + p1[r]; }
            l_run = l_run * alpha + ps;
            if (__any(alpha != 1.f)) {
                if (hi == 0) wsf[r32] = alpha;
                LDS_WAIT();
#pragma unroll
                for (int r = 0; r < 16; ++r) { const float f = wsf[crow(r, hi)]; o[0][r] *= f; o[1][r] *= f; }
            }
            u32x4 pw[4];
#pragma unroll
            for (int j = 0; j < 4; ++j) { pw[0][j] = pk2(p0[2 * j], p0[2 * j + 1]); pw[1][j] = pk2(p0[8 + 2 * j], p0[8 + 2 * j + 1]); pw[2][j] = pk2(p1[2 * j], p1[2 * j + 1]); pw[3][j] = pk2(p1[8 + 2 * j], p1[8 + 2 * j + 1]); }
            const LAS unsigned char* vb = shm + AT_V + buf * 8192 + ((lane >> 4) & 1) * 32 + (lane & 3) * 8 + (4 * hi + ((lane & 15) >> 2)) * 64;
#pragma unroll
            for (int d0 = 0; d0 < 2; ++d0)
#pragma unroll
                for (int ks = 0; ks < 4; ++ks) {
                    typedef short v4i16_t __attribute__((ext_vector_type(4)));
                    const s16x4 lo = __builtin_bit_cast(s16x4, __builtin_amdgcn_ds_read_tr16_b64_v4i16((LAS v4i16_t*)(vb + d0 * 4096 + ks * 1024)));
                    const s16x4 hh = __builtin_bit_cast(s16x4, __builtin_amdgcn_ds_read_tr16_b64_v4i16((LAS v4i16_t*)(vb + d0 * 4096 + ks * 1024 + 512)));
                    const bf16x8 vf = (bf16x8){lo[0], lo[1], lo[2], lo[3], hh[0], hh[1], hh[2], hh[3]};
                    o[d0] = __builtin_amdgcn_mfma_f32_32x32x16_bf16(__builtin_bit_cast(bf16x8, pw[ks]), vf, o[d0], 0, 0, 0);
                }
        }
        asm volatile("s_waitcnt lgkmcnt(0)\n\ts_barrier" ::: "memory");
    }
#undef AT_DMA
#undef AT_WAIT1
    l_run += __shfl_xor(l_run, 32);
    if (hi == 0) wsf[32 + r32] = l_run;
    LDS_WAIT();
    LAS bf16_t* stg = (LAS bf16_t*)(shm + AT_OST) + wid * 2048;
#pragma unroll
    for (int r = 0; r < 16; ++r) { const int orow = crow(r, hi); const float il = frcp(wsf[32 + orow]);
#pragma unroll
        for (int d0 = 0; d0 < 2; ++d0) stg[orow * 64 + d0 * 32 + r32] = (bf16_t)f2bf(o[d0][r] * il); }
    LDS_WAIT();
    const bf16_t* GB = (const bf16_t*)a.out; bf16_t* HL = (bf16_t*)(ws + WS_GR); const bf16_t* AC = (const bf16_t*)(ws + WS_GA);
#pragma unroll
    for (int i = 0; i < 4; ++i) { const int row = i * 8 + (lane >> 3), ch = lane & 7; const u32x4 yv = *(const LAS u32x4*)(stg + row * 64 + ch * 8);
        const size_t go = (size_t)(q0 + wid * 32 + row) * 1024 + h * 64 + ch * 8;
        const u32x4 gb = *(const u32x4*)(GB + go), hl = *(const u32x4*)(HL + go), ac = *(const u32x4*)(AC + go); u32x4 w;
#pragma unroll
        for (int j = 0; j < 4; ++j) { const float c0 = carry[ch * 8 + 2 * j], c1 = carry[ch * 8 + 2 * j + 1];
            w[j] = pk2(lo2f(yv[j]) * lo2f(gb[j]) + lo2f(hl[j]) + lo2f(ac[j]) * c0, hi2f(yv[j]) * hi2f(gb[j]) + hi2f(hl[j]) + hi2f(ac[j]) * c1); }
        *(u32x4*)(HL + go) = w; }
    asm volatile("s_waitcnt lgkmcnt(0)\n\ts_barrier" ::: "memory");
}

__device__ __forceinline__ void p3_attention(Frame& F, CArgs a) {
    const int head = (F.vcu >> 4) & 15, s = F.vcu & 15; const int qbs[4] = {s, 31 - s, 32 + s, 63 - s};
    LAS float* carry = (LAS float*)(F.lds + LDS_XCH);
    if (F.wave == 0) {
        const float* HEND = (const float*)(a.ws + WS_MISC + MISC_HEND); const float* AEND = (const float*)(a.ws + WS_MISC + MISC_AEND); const int c = head * 64 + F.lane; float cr = 0.f;
        for (int k = 0; k < 64; ++k) {
#pragma unroll
            for (int i = 0; i < 4; ++i) if (k == qbs[i]) carry[i * 64 + F.lane] = cr;
            cr = AEND[(size_t)k * 1024 + c] * cr + HEND[(size_t)k * 1024 + c];
        }
    }
    LDS_WAIT(); __syncthreads();
    if (F.vcu < 256)
        for (int i = 0; i < 4; ++i) attn_unit_v1(head, qbs[i], a, carry + i * 64, F.lds);
}

__device__ __forceinline__ void p6_route(Frame& F, CArgs a) {
    unsigned char* ws = a.ws; const float* H = a.out; const float* WR = (const float*)(ws + WS_MISC + MISC_WR); float* RH = (float*)(ws + WS_CTL + CTL_SSQ_H); const float* PH = (const float*)(ws + WS_SSQP + SSQP_H);
    const float* bg = (const float*)a.in[20]; const float* be = (const float*)a.in[22];
    unsigned* cnt = (unsigned*)(ws + WS_CTL) + CW_CNT; int* lists = (int*)(ws + WS_LIST); float* cwl = (float*)(ws + WS_LIST + 2 * MiB); unsigned* tokinfo = (unsigned*)(ws + WS_MISC + MISC_TOK);
    const int gw = F.vcu * NWAVES + F.wave, NGW = F.G * NWAVES, lane = F.lane;
    for (int row0 = gw * 4; row0 < M; row0 += NGW * 4) {
        f32x4 hv[4][4];
#pragma unroll
        for (int r = 0; r < 4; ++r)
#pragma unroll
            for (int j = 0; j < 4; ++j) hv[r][j] = *(const f32x4*)(H + (size_t)(row0 + r) * 1024 + 4 * lane + 256 * j);
        float rs[4];
#pragma unroll
        for (int r = 0; r < 4; ++r) { const float* pp = PH + (size_t)(row0 + r) * 16; const f32x4 a0 = *(const f32x4*)pp, a1 = *(const f32x4*)(pp + 4), a2 = *(const f32x4*)(pp + 8), a3 = *(const f32x4*)(pp + 12);
            const float sh = (((a0[0] + a0[1]) + (a0[2] + a0[3])) + ((a1[0] + a1[1]) + (a1[2] + a1[3]))) + (((a2[0] + a2[1]) + (a2[2] + a2[3])) + ((a3[0] + a3[1]) + (a3[2] + a3[3])));
            rs[r] = rsqrtf(sh * (1.f / 1024.f) + EPS); if (lane == 0) RH[row0 + r] = rs[r]; }
        float gl[4][4];
        int grp[4]; float pg[4], v1[4], v2[4]; int i1[4], i2[4];
#pragma unroll
        for (int r = 0; r < 4; ++r) { v1[r] = -INFINITY; v2[r] = -INFINITY; i1[r] = 0; i2[r] = 0; grp[r] = 0; pg[r] = 0.f; }
#pragma unroll 1
        for (int jj = 0; jj < 36; ++jj) {
            f32x4 w[4];
#pragma unroll
            for (int j = 0; j < 4; ++j) w[j] = *(const f32x4*)(WR + (size_t)jj * 1024 + 4 * lane + 256 * j);
            float lg[4];
#pragma unroll
            for (int r = 0; r < 4; ++r) { float s = 0.f;
#pragma unroll
                for (int j = 0; j < 4; ++j) { const f32x4 p = hv[r][j] * w[j]; s += (p[0] + p[1]) + (p[2] + p[3]); }
                lg[r] = wave_sum(s) * rs[r] + (jj < 4 ? bg[jj] : be[jj - 4]); }
            if (jj < 4) {
#pragma unroll
                for (int r = 0; r < 4; ++r) {
#pragma unroll
                    for (int q = 0; q < 4; ++q) if (q == jj) gl[r][q] = lg[r];
                }
                if (jj == 3) {
#pragma unroll
                    for (int r = 0; r < 4; ++r) { int g = 0; float mx = gl[r][0];
#pragma unroll
                        for (int q = 1; q < 4; ++q) if (gl[r][q] > mx) { mx = gl[r][q]; g = q; }
                        float den = 0.f;
#pragma unroll
                        for (int q = 0; q < 4; ++q) den += expf(gl[r][q] - mx);
                        grp[r] = g; pg[r] = 1.f / den; }
                }
            } else {
                const int ge = (jj - 4) >> 3, ie = (jj - 4) & 7;
#pragma unroll
                for (int r = 0; r < 4; ++r) if (ge == grp[r]) { const float v = lg[r];
                    if (v > v1[r]) { v2[r] = v1[r]; i2[r] = i1[r]; v1[r] = v; i1[r] = ie; } else if (v > v2[r]) { v2[r] = v; i2[r] = ie; } }
            }
        }
        if (lane < 4) {
            int g = grp[0], a1 = i1[0], a2 = i2[0]; float p = pg[0], x1 = v1[0], x2 = v2[0];
#pragma unroll
            for (int r = 1; r < 4; ++r) if (lane == r) { g = grp[r]; a1 = i1[r]; a2 = i2[r]; p = pg[r]; x1 = v1[r]; x2 = v2[r]; }
            const float e2 = expf(x2 - x1), s1 = 1.f / (1.f + e2), s2 = e2 * s1; const int tok = row0 + lane;
            const int e1 = g * 8 + a1, eb = g * 8 + a2;
            const unsigned sl1 = atomicAdd(cnt + e1, 1u), sl2 = atomicAdd(cnt + eb, 1u);
            lists[(size_t)e1 * M + sl1] = tok; cwl[(size_t)e1 * M + sl1] = p * s1; lists[(size_t)eb * M + sl2] = tok; cwl[(size_t)eb * M + sl2] = p * s2;
            tokinfo[tok * 2] = ((unsigned)e1 << 16) | sl1; tokinfo[tok * 2 + 1] = ((unsigned)eb << 16) | sl2;
        }
    }
}

__device__ __forceinline__ void moe_prefix(Frame& F, CArgs a, volatile LAS int* tpre, volatile LAS int* cnts) {
    const unsigned* cnt = (const unsigned*)(a.ws + WS_CTL) + CW_CNT;
    if (F.tid == 0) { int acc = 0; for (int e = 0; e < 32; ++e) { const int c = (int)__hip_atomic_load(cnt + e, RLX_AGENT); tpre[e] = acc; cnts[e] = c; acc += (c + 255) >> 8; } tpre[32] = acc; }
    LDS_WAIT(); __syncthreads();
}

__device__ __forceinline__ void p8_final(Frame& F, CArgs a, const volatile LAS int* tpre) {
    float* out = a.out; const bf16_t* Y = (const bf16_t*)(a.ws + WS_Y); const unsigned* tokinfo = (const unsigned*)(a.ws + WS_MISC + MISC_TOK);
    const int gw = F.vcu * NWAVES + F.wave, NGW = F.G * NWAVES, lane = F.lane;
    for (int tok = gw; tok < M; tok += NGW) {
        const unsigned i0 = tokinfo[tok * 2], i1 = tokinfo[tok * 2 + 1];
        const size_t s0 = (size_t)tpre[i0 >> 16] * 256 + (i0 & 0xffffu), s1 = (size_t)tpre[i1 >> 16] * 256 + (i1 & 0xffffu);
#pragma unroll
        for (int j = 0; j < 2; ++j) { const size_t c = 8 * lane + 512 * j; const u32x4 y0 = *(const u32x4*)(Y + s0 * 1024 + c), y1 = *(const u32x4*)(Y + s1 * 1024 + c);
            f32x4 h0 = *(const f32x4*)(out + (size_t)tok * 1024 + c), h1 = *(const f32x4*)(out + (size_t)tok * 1024 + c + 4);
            h0[0] += lo2f(y0[0]) + lo2f(y1[0]); h0[1] += hi2f(y0[0]) + hi2f(y1[0]); h0[2] += lo2f(y0[1]) + lo2f(y1[1]); h0[3] += hi2f(y0[1]) + hi2f(y1[1]);
            h1[0] += lo2f(y0[2]) + lo2f(y1[2]); h1[1] += hi2f(y0[2]) + hi2f(y1[2]); h1[2] += lo2f(y0[3]) + lo2f(y1[3]); h1[3] += hi2f(y0[3]) + hi2f(y1[3]);
            *(f32x4*)(out + (size_t)tok * 1024 + c) = h0; *(f32x4*)(out + (size_t)tok * 1024 + c + 4) = h1; }
    }
}
constexpr int NPHASE = 10;
#ifndef MK_ONE_LAUNCH
#define MK_ONE_LAUNCH 1
#endif
__global__ void __launch_bounds__(NTHREADS, 2) mega(Args a) {
    extern __shared__ __attribute__((aligned(16))) unsigned char lds_raw[];
    Frame F;
    F.lds = (LAS unsigned char*)lds_raw; F.MISC = (volatile LAS unsigned*)(F.lds + MISC_OFF);
    F.tid = threadIdx.x; F.lane = F.tid & 63; F.wave = __builtin_amdgcn_readfirstlane(F.tid >> 6);
    F.G = gridDim.x; { const int bx = blockIdx.x; F.vcu = (F.G % 8 == 0) ? (bx % 8) * (F.G / 8) + bx / 8 : bx; }
    const __attribute__((address_space(4))) Args* ap0 = (const __attribute__((address_space(4))) Args*)__builtin_amdgcn_kernarg_segment_ptr();
#define KA() (*({ const __attribute__((address_space(4))) Args* p_ = ap0; asm volatile("" : "+s"(p_)); p_; }))
    unsigned char* ws = a.ws; F.ctl = (gu32*)(ws + WS_CTL);
    for (int u = F.tid; u < (LDS_BYTES - LDSCTL_OFF) / 4; u += NTHREADS) ((LAS unsigned*)(F.lds + LDSCTL_OFF))[u] = 0u;
    __syncthreads();
    const int lo = a.ph_lo, hi = a.ph_hi;
    XcdBarrier bar; bar.bar = (unsigned*)(F.ctl + CW_BAR); bar.x = 0; bar.st = nullptr;
    if (hi - lo > 1) bar = xcd_barrier_post((unsigned*)(F.ctl + CW_BAR), F.MISC + 8);
#ifndef PH_MASK
#define PH_MASK 0x3ff
#endif
#define IN(k) (((PH_MASK >> (k)) & 1) && lo <= (k) && (k) < hi)
#define SEAM(k) do { if (IN(k) && IN((k) + 1)) xcd_barrier(bar); } while (0)
    volatile LAS int* tpre = (volatile LAS int*)(F.lds + LDS_XCH + 8192); volatile LAS int* cnts = tpre + 40;
    const int bx = (int)blockIdx.x;
    float* ssq_q = (float*)(ws + WS_CTL + CTL_SSQ_Q); float* ssq_kv = (float*)(ws + WS_CTL + CTL_SSQ_KV); float* ssq_h = (float*)(ws + WS_CTL + CTL_SSQ_H);

    if (IN(0)) { p0_prologue(F, KA()); SEAM(0); }
    if (IN(1)) {
        DenseOrder S; S.init(M, 5376, F.G, bx, ws + WS_R1, ws + WS_WIN, 1024, 1024);
        EpiProj E{(bf16_t*)(ws + WS_XR), (bf16_t*)(ws + WS_GR), (bf16_t*)(ws + WS_QC), (bf16_t*)(ws + WS_KVC), (bf16_t*)(ws + WS_GA), (bf16_t*)KA().out, (bf16_t*)(ws + WS_MISC + MISC_HALO), (float*)(ws + WS_KPE), (float*)(ws + WS_SSQP), (float*)(ws + WS_SSQP + SSQP_KV)};
        gemm_phase<EpiProj, DenseOrder, true>(F.lds, 1024, 1024, S, E);
        SEAM(1);
    }
    if (IN(2)) { p2a_conv(F, KA()); SEAM(2); }
    if (IN(3)) {
#ifndef P3_MASK
#define P3_MASK 7
#endif
        if (P3_MASK & 1) { DenseOrder S; S.init(M, 1536, F.G, bx, ws + WS_QC, ws + WS_WUQ, 768, 768); EpiQ E{(bf16_t*)(ws + WS_R1), ssq_q}; gemm_phase<EpiQ, DenseOrder, true>(F.lds, 768, 768, S, E); }
        if (P3_MASK & 2) { DenseOrder S; S.init(M, 2048, F.G, bx, ws + WS_KVC, ws + WS_WUKV, 256, 256);
          EpiKV E{ws + WS_KIMG, (unsigned char*)KA().out + 32 * MiB, ssq_kv, (const float*)(ws + WS_MISC + MISC_KSSQ), (const float*)(ws + WS_KPE), (const float*)KA().in[16]};
          gemm_phase<EpiKV, DenseOrder, true>(F.lds, 256, 256, S, E); }
        EpiLru E{(const bf16_t*)(ws + WS_XR), (const float*)KA().in[7], (const float*)KA().in[9], (const float*)KA().in[10], (bf16_t*)(ws + WS_GR), (bf16_t*)(ws + WS_GA), (float*)(ws + WS_MISC + MISC_HEND), (float*)(ws + WS_MISC + MISC_AEND)};
        if (P3_MASK & 4) for (int half = 0; half < 2; ++half) {
            OneOrder S{half * F.G, 8, (const char*)(ws + WS_XR), (const char*)(ws + WS_WLRU), (size_t)256 * 1024 * 2, (size_t)256 * 256 * 2, 512, bx, 512};
            gemm_phase<EpiLru, OneOrder, false>(F.lds, 256, 1024, S, E);
        }
        SEAM(3);
    }
    if (IN(4)) { p3_attention(F, KA()); SEAM(4); }
    if (IN(5)) {
        DenseOrder S; S.init(M, 1024, F.G, bx, ws + WS_GR, ws + WS_WOUT, 1024, 1024);
        EpiWout E{(const float*)KA().in[0], KA().out, (bf16_t*)(ws + WS_XR), (float*)(ws + WS_SSQP + SSQP_H)};
        gemm_phase<EpiWout, DenseOrder, true>(F.lds, 1024, 1024, S, E);
        SEAM(5);
    }
    if (IN(6)) { p6_route(F, KA()); moe_weight_convert(F, KA()); SEAM(6); }
    if (IN(7)) {
        moe_prefix(F, KA(), tpre, cnts);
        MoeOrder S{tpre, cnts, 2, F.G, bx, (const char*)(ws + WS_XR), (const char*)(ws + WS_WGU), (size_t)512 * 1024 * 2, (size_t)256 * 1024 * 2, (const int*)(ws + WS_LIST), 1, 0};
        EpiMoeGU E{(bf16_t*)(ws + WS_GA), ssq_h, (const int*)(ws + WS_LIST)};
        gemm_phase<EpiMoeGU, MoeOrder, true>(F.lds, 1024, 1024, S, E);
        SEAM(7);
    }
    if (IN(8)) {
        if (!IN(7)) moe_prefix(F, KA(), tpre, cnts);
        MoeOrder S{tpre, cnts, 4, F.G, bx, (const char*)(ws + WS_GA), (const char*)(ws + WS_WDN), (size_t)1024 * 256 * 2, (size_t)256 * 256 * 2, (const int*)(ws + WS_LIST), 0, (size_t)256 * 256 * 2};
        EpiMoeDown E{(bf16_t*)(ws + WS_Y), (const float*)(ws + WS_LIST + 2 * MiB)};
        gemm_phase<EpiMoeDown, MoeOrder, true>(F.lds, 256, 256, S, E);
        SEAM(8);
    }
    if (IN(9)) { if (!IN(8)) moe_prefix(F, KA(), tpre, cnts); p8_final(F, KA(), tpre); }
#undef IN
#undef SEAM
}

[[maybe_unused]] static void launch(void* const* d_in, float* d_out, unsigned char* ws, hipStream_t stream, int one_launch) {
    static int grid = 0;
    if (grid == 0) {
        int dev = 0, cus = 0;
        if (hipGetDevice(&dev) != hipSuccess || hipDeviceGetAttribute(&cus, hipDeviceAttributeMultiprocessorCount, dev) != hipSuccess) { fprintf(stderr, "device query failed\n"); grid = -1; return; }
        if (hipFuncSetAttribute((const void*)mega, hipFuncAttributeMaxDynamicSharedMemorySize, LDS_BYTES) != hipSuccess) { fprintf(stderr, "hipFuncSetAttribute failed\n"); grid = -1; return; }
        (void)hipGetLastError();
        grid = cus;
        if (grid != 256) fprintf(stderr, "warning: %d CUs (kernel built for 256)\n", grid);
    }
    if (grid < 0) return;
    (void)hipMemsetAsync(ws + WS_CTL, 0, CTL_BYTES, stream);
    Args a{};
    for (int i = 0; i < 26; ++i) a.in[i] = d_in[i];
    a.out = d_out; a.ws = ws;
    if (one_launch) { a.ph_lo = 0; a.ph_hi = NPHASE; hipLaunchKernelGGL(mega, dim3(grid), dim3(NTHREADS), LDS_BYTES, stream, a); }
    else for (int p = 0; p < NPHASE; ++p) { a.ph_lo = p; a.ph_hi = p + 1; hipLaunchKernelGGL(mega, dim3(grid), dim3(NTHREADS), LDS_BYTES, stream, a); }
}
}
extern "C" void kernel_launch(void* const* d_in, const int* in_sizes, int n_in, void* d_out, int out_size, void* d_ws, size_t ws_size, hipStream_t stream) {
    (void)in_sizes; (void)n_in; (void)out_size; (void)ws_size;
    mk::launch(d_in, (float*)d_out, (unsigned char*)d_ws, stream, MK_ONE_LAUNCH);
}
```

```cpp
#include <hip/hip_runtime.h>
#include <hip/hip_bf16.h>
#include <cstdint>
#include <cstdio>
#include <cmath>
namespace mk {
#define LAS __attribute__((address_space(3)))
#define GAS __attribute__((address_space(1)))
typedef unsigned short bf16_t;
typedef short bf16x8 __attribute__((ext_vector_type(8)));
typedef short s16x4 __attribute__((ext_vector_type(4)));
typedef float f32x2 __attribute__((ext_vector_type(2)));
typedef float f32x4 __attribute__((ext_vector_type(4)));
typedef float f32x16 __attribute__((ext_vector_type(16)));
typedef unsigned u32x2 __attribute__((ext_vector_type(2)));
typedef unsigned u32x4 __attribute__((ext_vector_type(4)));
typedef GAS unsigned gu32;

#ifndef MK_FP8V
#define MK_FP8V 1
#endif
#ifndef MK_FP8K
#define MK_FP8K 1
#endif
constexpr int M = 16384, D = 1024, NWAVES = 8, NTHREADS = 512;
constexpr float EPS = 1e-6f, LOG2E = 1.4426950408889634f;
constexpr size_t MiB = 1u << 20;
constexpr size_t WS_CTL = 0, CTL_BYTES = 1 * MiB;
constexpr size_t WS_WIN = 1 * MiB, WS_WUQ = 12 * MiB, WS_WUKV = 15 * MiB, WS_WLRU = 16 * MiB, WS_WOUT = 17 * MiB;
constexpr size_t WS_CS = 19 * MiB, WS_KPE = 21 * MiB, WS_MISC = 23 * MiB, WS_LIST = 25 * MiB;
constexpr size_t WS_R1 = 29 * MiB, WS_XR = 77 * MiB, WS_GR = 109 * MiB, WS_GA = 141 * MiB, WS_QC = 173 * MiB, WS_KVC = 197 * MiB, WS_KIMG = 205 * MiB, WS_DBG = 253 * MiB;
constexpr size_t MISC_HALO = 0, MISC_HEND = 512 * 1024, MISC_AEND = 768 * 1024, MISC_KSSQ = 1024 * 1024, MISC_WR = 1152 * 1024, MISC_TOK = 1408 * 1024;
constexpr size_t WS_SSQP = 253 * MiB, SSQP_KV = 786432, SSQP_H = 1048576;
constexpr size_t WS_Y = WS_QC;
constexpr size_t WS_WGU = WS_R1, WS_WDN = WS_R1 + 32 * MiB;
constexpr int CW_TMO = 0, CW_CODE = 1, CW_BAR = 4096, CW_CNT = 8192;
constexpr size_t CTL_SSQ_Q = 65536, CTL_SSQ_KV = 131072, CTL_SSQ_H = 196608;
constexpr int RING_BYTES = 131072, LDS_XCH = 135168  , LDSCTL_OFF = 147456, MISC_OFF = LDSCTL_OFF + 320, LDS_BYTES = 163840;

#define RLX_AGENT __ATOMIC_RELAXED, __HIP_MEMORY_SCOPE_AGENT
#define LDS_WAIT() asm volatile("s_waitcnt lgkmcnt(0)" ::: "memory")
#define VM_WAIT() asm volatile("s_waitcnt vmcnt(0)" ::: "memory")
__device__ __forceinline__ float bf2f(unsigned v) { return __uint_as_float(v << 16); }
__device__ __forceinline__ unsigned f2bf(float f) { unsigned u = __float_as_uint(f); return (u + 0x7fffu + ((u >> 16) & 1u)) >> 16; }
__device__ __forceinline__ unsigned pk2(float lo, float hi) { typedef __bf16 bf16x2_t __attribute__((ext_vector_type(2))); f32x2 v = {lo, hi}; bf16x2_t b = __builtin_convertvector(v, bf16x2_t); return __builtin_bit_cast(unsigned, b); }
__device__ __forceinline__ float lo2f(unsigned w) { return __uint_as_float(w << 16); }
__device__ __forceinline__ float hi2f(unsigned w) { return __uint_as_float(w & 0xffff0000u); }
__device__ __forceinline__ float fexp2(float x) { return __builtin_amdgcn_exp2f(x); }
__device__ __forceinline__ float frcp(float x) { return __builtin_amdgcn_rcpf(x); }
__device__ __forceinline__ float fsigm(float x) { return frcp(1.f + fexp2(-x * LOG2E)); }
__device__ __forceinline__ float fgelu(float x) { const float u = 0.7978845608028654f * (x + 0.044715f * x * x * x); return x * frcp(1.f + fexp2(-2.f * LOG2E * u)); }
__device__ __forceinline__ float wave_sum(float v) {
#pragma unroll
    for (int o = 1; o < 64; o <<= 1) v += __shfl_xor(v, o);
    return v;
}

#define XB_TMO      128
#define XB_XCNT(j)  (256  + 64 * (j))
#define XB_XSUB(j)  (1280 + 64 * (j))
#define XB_XGEN(j)  (2304 + 64 * (j))
#define XB_TOP      3328
#define XB_TOPGEN   3392
#define XCD_BAR_WORDS 3456
#define XB_SPIN_CAP (1u << 18)
__device__ __forceinline__ unsigned xb_ld(unsigned* p)              { return __hip_atomic_load(p, __ATOMIC_RELAXED, __HIP_MEMORY_SCOPE_AGENT); }
__device__ __forceinline__ unsigned xb_add(unsigned* p, unsigned v) { return __hip_atomic_fetch_add(p, v, __ATOMIC_RELAXED, __HIP_MEMORY_SCOPE_AGENT); }
__device__ __forceinline__ unsigned xb_xcc_id() { return (unsigned)__builtin_amdgcn_s_getreg((3 << 11) | 20) & 0xFu; }
#define XB_SPIN(cond, bar) do { unsigned _sp = 0; while (cond) { __builtin_amdgcn_s_sleep(1); \
    if ((++_sp & 255u) == 0u) { if (xb_ld(&(bar)[XB_TMO])) break; if (_sp > XB_SPIN_CAP) { atomicAdd(&(bar)[XB_TMO], 1u); break; } } } } while (0)
struct XcdBarrier { unsigned* bar; unsigned x; volatile LAS unsigned* st; };
__device__ __forceinline__ XcdBarrier xcd_barrier_post(unsigned* bar, volatile LAS unsigned* st) {
    XcdBarrier b; b.bar = bar; b.x = xb_xcc_id(); b.st = st;
    if (threadIdx.x == 0) (void)xb_add(&bar[XB_XCNT(b.x)], 1u);
    return b;
}
__device__ __forceinline__ void xcd_barrier_complete(unsigned* bar, unsigned x, unsigned& nloc, unsigned& nx) {
    const unsigned G = gridDim.x * gridDim.y * gridDim.z;
    unsigned sum, cnt, mine, sp = 0u;
    for (;;) {
        sum = 0u; cnt = 0u; mine = 0u;
#pragma unroll
        for (unsigned j = 0; j < 16; ++j) { const unsigned c = xb_ld(&bar[XB_XCNT(j)]); sum += c; cnt += (c > 0u) ? 1u : 0u; mine = (j == x) ? c : mine; }
        if (sum == G) break;
        __builtin_amdgcn_s_sleep(1);
        if ((++sp & 255u) == 0u) { if (xb_ld(&bar[XB_TMO])) break; if (sp > XB_SPIN_CAP) { atomicAdd(&bar[XB_TMO], 1u); break; } }
    }
    nloc = mine > 0u ? mine : 1u; nx = cnt > 0u ? cnt : 1u;
}
__device__ __forceinline__ void xcd_barrier(const XcdBarrier& b) {
    asm volatile("s_waitcnt vmcnt(0)" ::: "memory");
    __syncthreads();
    if (threadIdx.x == 0) {
        unsigned* bar = b.bar;
        __builtin_amdgcn_s_waitcnt(0);
        unsigned nloc = b.st[0], nx = b.st[1];
        if (nloc == 0u) { xcd_barrier_complete(bar, b.x, nloc, nx); b.st[0] = nloc; b.st[1] = nx; }
        const unsigned old = xb_add(&bar[XB_XSUB(b.x)], 1u);
        const unsigned gen = old / nloc;
        if (old + 1u == (gen + 1u) * nloc) {
            __builtin_amdgcn_fence(__ATOMIC_RELEASE, "agent");
            asm volatile("s_waitcnt vmcnt(0)" ::: "memory");
            const unsigned og = xb_add(&bar[XB_TOP], 1u);
            const unsigned tg = og / nx;
            if (og + 1u == (tg + 1u) * nx) xb_add(&bar[XB_TOPGEN], 1u);
            else XB_SPIN(xb_ld(&bar[XB_TOPGEN]) == tg, bar);
            __builtin_amdgcn_fence(__ATOMIC_ACQUIRE, "agent");
            xb_add(&bar[XB_XGEN(b.x)], 1u);
            asm volatile("s_waitcnt vmcnt(0)" ::: "memory");
        } else {
            XB_SPIN(xb_ld(&bar[XB_XGEN(b.x)]) == gen, bar);
            __builtin_amdgcn_fence(__ATOMIC_ACQUIRE, "agent");
            asm volatile("s_waitcnt vmcnt(0)" ::: "memory");
        }
    }
    __syncthreads();
}

constexpr int BM = 256, BK = 64, HALF = 128, HTB = HALF * BK * 2, STAGE_BYTES = 8 * HTB;
__device__ __forceinline__ int lds_byte(int r, int c) { const int st = (r >> 4) * 2 + (c >> 5), rr = r & 15, cc = c & 31, ob = rr * 64 + cc * 2; return st * 1024 + (ob ^ (((ob >> 9) & 1) << 5)); }
__device__ __forceinline__ void stage_rc(int b, int& R, int& C) { const int st = b / 1024, sb = b % 1024, swz = sb ^ (((sb >> 9) & 1) << 5); R = (st >> 1) * 16 + swz / 64; C = (st & 1) * 32 + (swz % 64) / 2; }
__device__ __forceinline__ int perm32(int rho) { const int n = rho >> 4, i = rho & 15; return 8 * (i >> 2) + 4 * n + (i & 3); }

struct Unit { int pm, pn; const char* A; const char* B; const int* gat; int valid; int x0, x1; };
typedef f32x4 Acc[2][2][4][2];

#define PG8_SA(b, h) (((b) * 2 + (h)) * HTB)
#define PG8_SB(b, h) ((4 + (b) * 2 + (h)) * HTB)
#define PG8_STAGE(bufoff, gbase, voff) do { _Pragma("unroll") for (int _i = 0; _i < 2; ++_i) \
        __builtin_amdgcn_global_load_lds((const unsigned*)((const char*)(gbase) + (voff)[_i]), (LAS unsigned*)(lds + (bufoff) + ldsw + _i * 8192), 16, 0, 0); } while (0)
#define PG8_LDA(dst, b, h) do { if constexpr (F8) { _Pragma("unroll") for (int m = 0; m < 4; ++m) { const u32x4 x0_ = *(const LAS u32x4*)(lds + PG8_SA(b, h) + a8o0 + m * 2048), x1_ = *(const LAS u32x4*)(lds + PG8_SA(b, h) + a8o1 + m * 2048); \
            dst##8[m] = __builtin_bit_cast(v8i_t, __builtin_shufflevector(x0_, x1_, 0, 1, 2, 3, 4, 5, 6, 7)); } } \
        else { _Pragma("unroll") for (int m = 0; m < 4; ++m) _Pragma("unroll") for (int k = 0; k < 2; ++k) dst[m][k] = *(const LAS bf16x8*)(lds + PG8_SA(b, h) + aoff + m * 2048 + k * 1024); } } while (0)
#define PG8_LDB(dst, b, h) do { if constexpr (F8) { _Pragma("unroll") for (int n = 0; n < 2; ++n) { const u32x4 x0_ = *(const LAS u32x4*)(lds + PG8_SB(b, h) + b8o0 + n * 2048), x1_ = *(const LAS u32x4*)(lds + PG8_SB(b, h) + b8o1 + n * 2048); \
            dst##8[n] = __builtin_bit_cast(v8i_t, __builtin_shufflevector(x0_, x1_, 0, 1, 2, 3, 4, 5, 6, 7)); } } \
        else { _Pragma("unroll") for (int n = 0; n < 2; ++n) _Pragma("unroll") for (int k = 0; k < 2; ++k) dst[n][k] = *(const LAS bf16x8*)(lds + PG8_SB(b, h) + boff + n * 2048 + k * 1024); } } while (0)
#define PG8_MMA(ai, bj, At, Bt) do { __builtin_amdgcn_s_setprio(1); if constexpr (F8) { _Pragma("unroll") for (int m = 0; m < 4; ++m) _Pragma("unroll") for (int n = 0; n < 2; ++n) \
            asm volatile("v_mfma_scale_f32_16x16x128_f8f6f4 %0, %1, %2, %0, %3, %4 op_sel_hi:[0,0,0]" : "+v"(acc[ai][bj][m][n]) : "v"(Bt##8[n]), "v"(At##8[m]), "v"(scw_), "v"(scx_)); } \
        else { _Pragma("unroll") for (int m = 0; m < 4; ++m) _Pragma("unroll") for (int n = 0; n < 2; ++n) _Pragma("unroll") for (int k = 0; k < 2; ++k) \
            acc[ai][bj][m][n] = __builtin_amdgcn_mfma_f32_16x16x32_bf16(Bt[n][k], At[m][k], acc[ai][bj][m][n], 0, 0, 0); } __builtin_amdgcn_s_setprio(0); } while (0)
#define PG8_WAIT_V(n) asm volatile("s_waitcnt vmcnt(" #n ")" ::: "memory")
#define PG8_WAIT_L(n) asm volatile("s_waitcnt lgkmcnt(" #n ")" ::: "memory")
#define PG8_BAR __builtin_amdgcn_s_barrier()
#define PG8_SCHED __builtin_amdgcn_sched_barrier(0)
#define PG8_VOFFA(u, vo) do { _Pragma("unroll") for (int _h = 0; _h < 2; ++_h) _Pragma("unroll") for (int _i = 0; _i < 2; ++_i) { const int _row = _h * HALF + Ra[_i]; \
        const int _ri = (u).gat ? (_row < (u).valid ? (u).gat[_row] : 0) : _row; vo[_h][_i] = F8 ? (unsigned)(_ri * lda + 2 * Ca[_i]) : (unsigned)(_ri * lda + Ca[_i]) * 2u; } } while (0)

typedef int v8i_t __attribute__((ext_vector_type(8)));
template <class Epi, class Sched, bool ALIGN_EPI, bool F8 = false, int SC_W = 0x7f7f7f7f>
__device__ __forceinline__ void gemm_phase(LAS unsigned char* lds, const int K, const int lda, const Sched& S, const Epi& E) {
    int tid_ = threadIdx.x; asm volatile("" : "+v"(tid_));
    const int tid = tid_, wid = __builtin_amdgcn_readfirstlane(tid >> 6), lane = tid & 63, wr = wid >> 2, wc = wid & 3, fr = lane & 15, fq = lane >> 4;
    const int nt = F8 ? K / 128 : K / BK;
    int Ra[2], Ca[2]; unsigned voffB[2];
#pragma unroll
    for (int i = 0; i < 2; ++i) { int R, C; stage_rc(tid * 16 + i * 8192, R, C); const int Rb = Epi::PERM ? ((R & ~31) + perm32(R & 31)) : R; Ra[i] = R; Ca[i] = C; voffB[i] = F8 ? (unsigned)(Rb * K + 2 * C) : (unsigned)(Rb * K + C) * 2u; }
    const size_t kstep = (size_t)(BK * 2);
    const size_t hstep = F8 ? (size_t)HALF * K : (size_t)HALF * K * 2;
    const unsigned ldsw = (unsigned)wid * 1024u;
    const int aoff = lds_byte(wr * 64 + fr, fq * 8), boff = lds_byte(wc * 32 + fr, fq * 8);
    const int a8o0 = lds_byte(wr * 64 + fr, 16 * fq), a8o1 = lds_byte(wr * 64 + fr, 16 * fq + 8), b8o0 = lds_byte(wc * 32 + fr, 16 * fq), b8o1 = lds_byte(wc * 32 + fr, 16 * fq + 8);
    Unit cur, nxt; int ui = 0;
    if (!S.next(0, cur)) return;
    Acc acc;
#pragma unroll
    for (int a = 0; a < 2; ++a)
#pragma unroll
        for (int b = 0; b < 2; ++b)
#pragma unroll
            for (int m = 0; m < 4; ++m)
#pragma unroll
                for (int n = 0; n < 2; ++n) acc[a][b][m][n] = (f32x4){0.f, 0.f, 0.f, 0.f};
    bf16x8 At[4][2], B0[2][2], B1[2][2]; v8i_t At8[4], B08[2], B18[2]; const int scw_ = SC_W, scx_ = 0x7f7f7f7f;
    unsigned vC[2][2], vN[2][2];
    PG8_VOFFA(cur, vC);
    const char* cA = cur.A; const char* cB = cur.B;
    PG8_STAGE(PG8_SB(0, 0), cB, voffB); PG8_STAGE(PG8_SB(0, 1), cB + hstep, voffB); PG8_STAGE(PG8_SA(0, 0), cA, vC[0]); PG8_STAGE(PG8_SA(0, 1), cA, vC[1]);
    if (wr == 1) PG8_BAR;
    PG8_WAIT_V(2); PG8_BAR;
    PG8_STAGE(PG8_SB(1, 0), cB + kstep, voffB); PG8_STAGE(PG8_SA(1, 0), cA + kstep, vC[0]); PG8_STAGE(PG8_SB(1, 1), cB + hstep + kstep, voffB);
    PG8_WAIT_V(6); PG8_BAR;
    for (;;) {
        const bool has_next = S.next(ui + 1, nxt);
        if (!has_next) nxt = cur;
        PG8_VOFFA(nxt, vN);
        const char* nA = nxt.A; const char* nB = nxt.B;
#pragma unroll 1
        for (int t = 0; t < nt; t += 2) {
            const bool last = (t == nt - 2);
            const char* a1 = cA + (size_t)(t + 1) * kstep;
            const char* a2 = last ? nA : cA + (size_t)(t + 2) * kstep; const char* b2 = last ? nB : cB + (size_t)(t + 2) * kstep;
            const char* a3 = a2 + kstep; const char* b3 = b2 + kstep;
            unsigned vS[2][2];
#pragma unroll
            for (int h = 0; h < 2; ++h)
#pragma unroll
                for (int i = 0; i < 2; ++i) vS[h][i] = last ? vN[h][i] : vC[h][i];
            PG8_LDB(B0, 0, 0); PG8_LDB(B1, 0, 1); PG8_SCHED; PG8_LDA(At, 0, 0); PG8_STAGE(PG8_SA(1, 1), a1, vC[1]);
            PG8_WAIT_V(8); PG8_WAIT_L(0); PG8_BAR; PG8_MMA(0, 0, At, B0); PG8_MMA(0, 1, At, B1); PG8_BAR; PG8_SCHED;
            PG8_LDA(At, 0, 1); PG8_STAGE(PG8_SB(0, 0), b2, voffB); PG8_STAGE(PG8_SB(0, 1), b2 + hstep, voffB); PG8_STAGE(PG8_SA(0, 0), a2, vS[0]);
            PG8_WAIT_V(8); PG8_WAIT_L(0); PG8_BAR; PG8_MMA(1, 0, At, B0); PG8_MMA(1, 1, At, B1); PG8_BAR; PG8_SCHED;
            PG8_LDB(B0, 1, 0); PG8_LDB(B1, 1, 1); PG8_SCHED; PG8_LDA(At, 1, 0); PG8_STAGE(PG8_SA(0, 1), a2, vS[1]);
            PG8_WAIT_V(8); PG8_WAIT_L(0); PG8_BAR; PG8_MMA(0, 0, At, B0); PG8_MMA(0, 1, At, B1); PG8_BAR; PG8_SCHED;
            PG8_LDA(At, 1, 1); PG8_STAGE(PG8_SB(1, 0), b3, voffB); PG8_STAGE(PG8_SB(1, 1), b3 + hstep, voffB); PG8_STAGE(PG8_SA(1, 0), a3, vS[0]);
            PG8_WAIT_V(8); PG8_WAIT_L(0); PG8_BAR; PG8_MMA(1, 0, At, B0); PG8_MMA(1, 1, At, B1); PG8_BAR; PG8_SCHED;
        }
        if constexpr (F8) asm volatile("s_nop 15\n\ts_nop 15" ::: "memory");
        if constexpr (ALIGN_EPI) { if (wr == 0) PG8_BAR; }
        if constexpr (!Epi::AFTER_DRAIN) { E(acc, cur, wr, wc, fr, fq); }
        if (!has_next) break;
#pragma unroll
        for (int a = 0; a < 2; ++a)
#pragma unroll
            for (int b = 0; b < 2; ++b)
#pragma unroll
                for (int m = 0; m < 4; ++m)
#pragma unroll
                    for (int n = 0; n < 2; ++n) acc[a][b][m][n] = (f32x4){0.f, 0.f, 0.f, 0.f};
        cur = nxt; cA = nA; cB = nB; ++ui;
#pragma unroll
        for (int h = 0; h < 2; ++h)
#pragma unroll
            for (int i = 0; i < 2; ++i) vC[h][i] = vN[h][i];
        if constexpr (ALIGN_EPI) { if (wr == 1) PG8_BAR; }
    }
    PG8_WAIT_V(0);
    if constexpr (!ALIGN_EPI) { if (wr == 0) PG8_BAR; }
    PG8_BAR;
    if constexpr (Epi::AFTER_DRAIN) { E.fused(acc, cur, wr, wc, fr, fq, lds, wid, lane); }
}
struct DenseOrder {
    int nM, nN, nwg, G, c; const char* A; const char* B; size_t a_tile, b_tile; int a_col_tile;
    int pn_per_ablk;
    int skew_h, skew_a, skew_b;
    __device__ void init(int Mr, int N, int G_, int c_, const void* A_, const void* B_, int lda, int K, int pnpa = 0, int acolbytes = 0, int esz = 2) {
        nM = Mr / BM; nN = N / BM; nwg = nM * nN; G = G_; c = c_; A = (const char*)A_; B = (const char*)B_; a_tile = (size_t)BM * lda * esz; b_tile = (size_t)BM * K * esz; pn_per_ablk = pnpa; a_col_tile = acolbytes; skew_h = 0; skew_a = 0; skew_b = 0; }
    __device__ bool next(int i, Unit& u) const {
        long L = (long)i * G + c;
        if (skew_h > 0) { if (c < skew_h) { if (i >= skew_a) return false; L = (long)c * skew_a + i; } else { if (i >= skew_b) return false; L = (long)skew_h * skew_a + (long)(c - skew_h) * skew_b + i; } }
        if (L >= nwg) return false;
        int wgid = (int)L; { const int q = nwg / 8, r = nwg % 8, xcd = wgid % 8, off = wgid / 8; wgid = (xcd < r ? xcd * (q + 1) : r * (q + 1) + (xcd - r) * q) + off; }
        const int WGM = 8, nig = WGM * nN, gid = wgid / nig, fm = gid * WGM, gsz = (nM - fm) < WGM ? (nM - fm) : WGM;
        u.pm = fm + ((wgid % nig) % gsz); u.pn = (wgid % nig) / gsz;
        u.A = A + (size_t)u.pm * a_tile + (pn_per_ablk ? (size_t)(u.pn / pn_per_ablk) * a_col_tile : 0); u.B = B + (size_t)u.pn * b_tile; u.gat = nullptr; u.valid = 256; u.x0 = 0; u.x1 = 0; return true;
    }
};
struct OneOrder {
    int first, nN; const char* A; const char* B; size_t a_tile, b_tile; int a_col_tile; int c; int total;
    __device__ bool next(int i, Unit& u) const {
        if (i > 0) return false; const int L = first + c; if (L >= total) return false;
        u.pm = L / nN; u.pn = L % nN; u.A = A + (size_t)u.pm * a_tile + (size_t)(u.pn >> 1) * a_col_tile; u.B = B + (size_t)u.pn * b_tile; u.gat = nullptr; u.valid = 256; u.x0 = 0; u.x1 = 0; return true; }
};
struct MoeOrder {
    const volatile LAS int* tpre; const volatile LAS int* cnt; int ncol; int G, c; const char* A; const char* B; size_t b_exp; size_t b_tile; const int* lists; int gather; size_t a_tile;
    __device__ bool next(int i, Unit& u) const {
        const int L = i * G + c; const int ntile = __builtin_amdgcn_readfirstlane(tpre[32]); if (L >= ntile * ncol) return false;
        const int T = L / ncol, pn = L % ncol; const int e = __builtin_amdgcn_readfirstlane(tpre[80 + T]);
        const int rt = __builtin_amdgcn_readfirstlane(T - tpre[e]); int valid = cnt[e] - rt * 256; valid = __builtin_amdgcn_readfirstlane(valid > 256 ? 256 : valid);
        u.pm = T; u.pn = pn; u.x0 = e; u.x1 = rt; u.valid = valid; u.B = B + (size_t)e * b_exp + (size_t)pn * b_tile;
        if (gather) { u.A = A; u.gat = lists + (size_t)e * M + rt * 256; } else { u.A = A + (size_t)T * a_tile; u.gat = nullptr; }
        return true; }
};

__device__ __forceinline__ u32x4 pack8(f32x4 a, f32x4 b) { u32x4 w; w.x = pk2(a[0], a[1]); w.y = pk2(a[2], a[3]); w.z = pk2(b[0], b[1]); w.w = pk2(b[2], b[3]); return w; }
__device__ __forceinline__ float dot4(f32x4 a) { return (a[0] * a[0] + a[1] * a[1]) + (a[2] * a[2] + a[3] * a[3]); }

struct EpiProj {
    static constexpr bool PERM = true, AFTER_DRAIN = false;
    bf16_t *XR, *GR, *QC, *KVC, *GA, *GB, *HALO; float *KPE, *ssq_q, *ssq_kv;
    __device__ __forceinline__ void operator()(const Acc& acc, const Unit& u, int wr, int wc, int fr, int fq) const {
        const int pn = u.pn, rowb = u.pm * BM + wr * 64 + fr;
        if (pn == 20) {
            if (wc == 0) {
#pragma unroll
                for (int ai = 0; ai < 2; ++ai)
#pragma unroll
                    for (int m = 0; m < 4; ++m) { float* p = KPE + (size_t)(rowb + ai * HALF + m * 16) * 32 + 8 * fq; *(f32x4*)p = acc[ai][0][m][0]; *(f32x4*)(p + 4) = acc[ai][0][m][1]; }
            }
            return;
        }
        bf16_t* dst; int ldc, colt, act = 0; float* ssq = nullptr; int nslot = 0, slot = 0;
        if (pn < 4) { dst = XR; ldc = 1024; colt = pn * 256; }
        else if (pn < 8) { dst = GR; ldc = 1024; colt = (pn - 4) * 256; act = 1; }
        else if (pn < 11) { dst = QC; ldc = 768; colt = (pn - 8) * 256; ssq = ssq_q; nslot = 12; slot = (pn - 8) * 4 + wc; act = 3; }
        else if (pn == 11) { dst = KVC; ldc = 256; colt = 0; ssq = ssq_kv; nslot = 4; slot = wc; act = 3; }
        else if (pn < 16) { dst = GA; ldc = 1024; colt = (pn - 12) * 256; act = 2; }
        else { dst = GB; ldc = 1024; colt = (pn - 16) * 256; act = 2; }
        const int col0 = colt + wc * 32 + 8 * fq;
#pragma unroll
        for (int ai = 0; ai < 2; ++ai)
#pragma unroll
            for (int m = 0; m < 4; ++m) {
                const int row = rowb + ai * HALF + m * 16; float ss = 0.f;
#pragma unroll
                for (int bj = 0; bj < 2; ++bj) {
                    f32x4 v0 = acc[ai][bj][m][0], v1 = acc[ai][bj][m][1];
                    if (ssq) ss += dot4(v0) + dot4(v1);
                    if (act == 1) {
#pragma unroll
                        for (int e = 0; e < 4; ++e) { v0[e] = fgelu(v0[e]); v1[e] = fgelu(v1[e]); }
                    } else if (act == 2) {
#pragma unroll
                        for (int e = 0; e < 4; ++e) { v0[e] = fsigm(v0[e]); v1[e] = fsigm(v1[e]); }
                    }
                    if (act == 3) { u32x2 w8; int w_ = __builtin_amdgcn_cvt_pk_fp8_f32(v0[0], v0[1], 0, false); w8.x = (unsigned)__builtin_amdgcn_cvt_pk_fp8_f32(v0[2], v0[3], w_, true);
                        w_ = __builtin_amdgcn_cvt_pk_fp8_f32(v1[0], v1[1], 0, false); w8.y = (unsigned)__builtin_amdgcn_cvt_pk_fp8_f32(v1[2], v1[3], w_, true);
                        *(u32x2*)((unsigned char*)dst + (size_t)row * ldc + col0 + bj * HALF) = w8; }
                    else *(u32x4*)(dst + (size_t)row * ldc + col0 + bj * HALF) = pack8(v0, v1);
                }
                if (ssq) { ss += __shfl_xor(ss, 16); ss += __shfl_xor(ss, 32); if (fq == 0) ssq[(size_t)row * nslot + slot] = ss; }
            }
        if (pn < 4 && wr == 1 && fr >= 13) {
#pragma unroll
            for (int bj = 0; bj < 2; ++bj) *(u32x4*)(HALO + ((size_t)u.pm * 3 + (fr - 13)) * 1024 + col0 + bj * HALF) = pack8(acc[1][bj][3][0], acc[1][bj][3][1]);
        }
    }
};

struct EpiQ {
    static constexpr bool PERM = true, AFTER_DRAIN = false;
    bf16_t* Q; const float* ssq_q;
    __device__ __forceinline__ void operator()(const Acc& acc, const Unit& u, int wr, int wc, int fr, int fq) const {
        const int rowb = u.pm * BM + wr * 64 + fr, col0 = u.pn * BM + wc * 32 + 8 * fq;
#pragma unroll
        for (int ai = 0; ai < 2; ++ai)
#pragma unroll
            for (int m = 0; m < 4; ++m) {
                const int row = rowb + ai * HALF + m * 16; const float rs = ssq_q[row];
#pragma unroll
                for (int bj = 0; bj < 2; ++bj) *(u32x4*)(Q + (size_t)row * 1536 + col0 + bj * HALF) = pack8(acc[ai][bj][m][0] * rs, acc[ai][bj][m][1] * rs);
            }
    }
};

struct EpiKV {
    static constexpr bool PERM = true, AFTER_DRAIN = false;
    unsigned char* KIMG; unsigned char* VIMG; const float* ssq_kv; const float* kssq; const float* KPER; const float* kg;
    __device__ __forceinline__ void operator()(const Acc& acc, const Unit& u, int wr, int wc, int fr, int fq) const {
        asm volatile("" : "+v"(fr), "+v"(fq));
        const int rowb = u.pm * BM + wr * 64 + fr, h = 2 * u.pn + (wc & 1);
        if (wc < 2) {
            f32x4 g[2][2];
#pragma unroll
            for (int bj = 0; bj < 2; ++bj)
#pragma unroll
                for (int n = 0; n < 2; ++n) g[bj][n] = *(const f32x4*)(kg + 32 * bj + 8 * fq + 4 * n);
#pragma unroll
            for (int am = 0; am < 8; ++am) { const int ai = am >> 2;
                f32x4 kr[4][2];
#pragma unroll
                for (int m = (am & 3); m < (am & 3) + 1; ++m) { const float* kp_ = KPER + (size_t)(rowb + ai * HALF + m * 16) * 32 + 8 * fq; kr[m][0] = *(const f32x4*)kp_; kr[m][1] = *(const f32x4*)(kp_ + 4); }
#pragma unroll
                for (int m = (am & 3); m < (am & 3) + 1; ++m) {
                    const int row = rowb + ai * HALF + m * 16; const float rs = ssq_kv[row], ksq = kssq[row];
                    f32x4 v[2][2]; float ss = 0.f;
#pragma unroll
                    for (int bj = 0; bj < 2; ++bj)
#pragma unroll
                        for (int n = 0; n < 2; ++n) { v[bj][n] = acc[ai][bj][m][n] * rs; ss += dot4(v[bj][n]); }
                    ss += __shfl_xor(ss, 16); ss += __shfl_xor(ss, 32);
                    const float rk = rsqrtf((ss + ksq) * (1.f / 96.f) + EPS);
#if MK_FP8K
                    unsigned char* img = KIMG + ((size_t)h * 256 + (row >> 6)) * 8192;
#pragma unroll
                    for (int bj = 0; bj < 2; ++bj) { const f32x4 x0 = v[bj][0] * g[bj][0] * rk, x1 = v[bj][1] * g[bj][1] * rk; u32x2 w;
                        int w0 = __builtin_amdgcn_cvt_pk_fp8_f32(x0[0], x0[1], 0, false); w0 = __builtin_amdgcn_cvt_pk_fp8_f32(x0[2], x0[3], w0, true);
                        int w1 = __builtin_amdgcn_cvt_pk_fp8_f32(x1[0], x1[1], 0, false); w1 = __builtin_amdgcn_cvt_pk_fp8_f32(x1[2], x1[3], w1, true);
                        w.x = (unsigned)w0; w.y = (unsigned)w1;
                        *(u32x2*)(img + ((row & 63) >> 5) * 2048 + bj * 1024 + (fq >> 1) * 512 + (row & 31) * 16 + 8 * (fq & 1)) = w; }
                    *(u32x4*)(img + 4096 + fq * 1024 + (row & 63) * 16) = pack8(kr[m][0] * rk, kr[m][1] * rk);
#else
                    unsigned char* img = KIMG + ((size_t)h * 256 + (row >> 6)) * 12288 + (row & 63) * 16;
#pragma unroll
                    for (int bj = 0; bj < 2; ++bj) *(u32x4*)(img + (4 * bj + fq) * 1024) = pack8(v[bj][0] * g[bj][0] * rk, v[bj][1] * g[bj][1] * rk);
                    *(u32x4*)(img + (8 + fq) * 1024) = pack8(kr[m][0] * rk, kr[m][1] * rk);
#endif
                }
                asm volatile("" ::: "memory");
            }
        } else {
#if MK_FP8V
#pragma unroll
            for (int ai = 0; ai < 2; ++ai)
#pragma unroll
                for (int m = 0; m < 4; ++m) {
                    const int row = rowb + ai * HALF + m * 16; const float rs = ssq_kv[row]; const int key = row & 63, kk = key & 31;
                    unsigned char* img = VIMG + ((size_t)h * 256 + (row >> 6)) * 4096 + ((kk >> 2) & 1) * 1024 + (key >> 5) * 512 + ((kk & 3) + 4 * (kk >> 3)) + fq * 128;
#pragma unroll
                    for (int bj = 0; bj < 2; ++bj) { const f32x4 v0 = acc[ai][bj][m][0] * rs, v1 = acc[ai][bj][m][1] * rs;
                        unsigned w0 = (unsigned)__builtin_amdgcn_cvt_pk_fp8_f32(v0[0], v0[1], 0, false); w0 = (unsigned)__builtin_amdgcn_cvt_pk_fp8_f32(v0[2], v0[3], (int)w0, true);
                        unsigned w1 = (unsigned)__builtin_amdgcn_cvt_pk_fp8_f32(v1[0], v1[1], 0, false); w1 = (unsigned)__builtin_amdgcn_cvt_pk_fp8_f32(v1[2], v1[3], (int)w1, true);
                        unsigned char* p = img + bj * 2048;
                        p[0] = (unsigned char)w0; p[16] = (unsigned char)(w0 >> 8); p[32] = (unsigned char)(w0 >> 16); p[48] = (unsigned char)(w0 >> 24);
                        p[64] = (unsigned char)w1; p[80] = (unsigned char)(w1 >> 8); p[96] = (unsigned char)(w1 >> 16); p[112] = (unsigned char)(w1 >> 24); }
                }
#else
#pragma unroll
            for (int ai = 0; ai < 2; ++ai)
#pragma unroll
                for (int m = 0; m < 4; ++m) {
                    const int row = rowb + ai * HALF + m * 16; const float rs = ssq_kv[row]; const int key = row & 63;
                    unsigned char* img = VIMG + ((size_t)h * 256 + (row >> 6)) * 8192 + (key >> 4) * 1024 + (key & 15) * 64 + fq * 16;
#pragma unroll
                    for (int bj = 0; bj < 2; ++bj) *(u32x4*)(img + bj * 4096) = pack8(acc[ai][bj][m][0] * rs, acc[ai][bj][m][1] * rs);
                }
#endif
        }
    }
};

template <bool DRY> struct EpiLruT {
    static constexpr bool PERM = false, AFTER_DRAIN = true;
    const bf16_t* XA; const float *ba, *bx, *lam; bf16_t* GRio; bf16_t* GAio; float* HEND; float* AEND;
    __device__ __forceinline__ void fused(Acc& acc, const Unit& u, int wr, int wc, int fr, int fq, LAS unsigned char* lds, int wid, int lane) const {
        int tid = threadIdx.x; asm volatile("" : "+v"(tid));
        const int chb = 256 * (u.pn >> 1) + 128 * (u.pn & 1);
        LAS unsigned* S = (LAS unsigned*)lds;
        {
            f32x4 vba[2], vbx[2], vsp[2];
#pragma unroll
            for (int n = 0; n < 2; ++n) { const int c = chb + 32 * wc + 16 * n + 4 * fq; vba[n] = *(const f32x4*)(ba + c); vbx[n] = *(const f32x4*)(bx + c); const f32x4 l4 = *(const f32x4*)(lam + c);
#pragma unroll
                for (int e = 0; e < 4; ++e) vsp[n][e] = -8.f * LOG2E * log1pf(expf(-l4[e])); }
#pragma unroll
            for (int am = 0; am < 4; ++am) { const int ai = am >> 1;
                u32x2 xw[4][2];
#pragma unroll
                for (int m = 2 * (am & 1); m < 2 * (am & 1) + 2; ++m)
#pragma unroll
                    for (int n = 0; n < 2; ++n) xw[m][n] = *(const u32x2*)((const char*)XA + (unsigned)((((unsigned)(u.pm * BM + ai * HALF + wr * 64 + m * 16 + fr)) * 1024u + (unsigned)(chb + 32 * wc + 16 * n + 4 * fq)) * 2u));
#pragma unroll
                for (int m = 2 * (am & 1); m < 2 * (am & 1) + 2; ++m) {
                    const int r = ai * HALF + wr * 64 + m * 16 + fr;
#pragma unroll
                    for (int n = 0; n < 2; ++n) {
                        const int x0 = 32 * wc + 16 * n + 4 * fq;
                        const float xa[4] = {lo2f(xw[m][n].x), hi2f(xw[m][n].x), lo2f(xw[m][n].y), hi2f(xw[m][n].y)}; u32x4 o;
#pragma unroll
                        for (int e = 0; e < 4; ++e) {
                            const float rr = fsigm(acc[ai][0][m][n][e] + vba[n][e]), ii = fsigm(acc[ai][1][m][n][e] + vbx[n][e]);
                            const float la2 = rr * vsp[n][e]; const float a2 = fexp2(2.f * la2); const float mult = sqrtf(fmaxf(1.f - a2, 0.f));
                            o[e] = pk2(mult * ii * xa[e], la2);
                        }
                        *(LAS u32x4*)(S + r * 132 + x0) = o;
                    }
                }
                asm volatile("" ::: "memory");
            }
        }
        const int cp = tid & 63, sg = tid >> 6, c0 = 2 * cp; LAS f32x4* X = (LAS f32x4*)(lds + LDS_XCH);
        const unsigned gb32 = ((unsigned)(u.pm * BM) * 1024u + (unsigned)(chb + c0)) * 2u;
        asm volatile("" ::: "memory");
        unsigned gr[32], ga[32];
#pragma unroll
        for (int j = 0; j < 32; ++j) { const unsigned ob = gb32 + (unsigned)(sg * 32 + j) * 2048u; gr[j] = *(const unsigned*)((const char*)GRio + ob); ga[j] = *(const unsigned*)((const char*)GAio + ob); }
        LDS_WAIT(); __builtin_amdgcn_s_barrier(); asm volatile("" ::: "memory");
        float h0 = 0.f, h1 = 0.f, s0 = 0.f, s1 = 0.f;
#pragma unroll 8
        for (int j = 0; j < 32; ++j) { const int r = sg * 32 + j; const u32x2 w = *(const LAS u32x2*)(S + r * 132 + c0);
            const float l0 = hi2f(w.x), l1 = hi2f(w.y); h0 = fexp2(l0) * h0 + lo2f(w.x); h1 = fexp2(l1) * h1 + lo2f(w.y); s0 += l0; s1 += l1; }
        X[sg * 64 + cp] = (f32x4){h0, s0, h1, s1};
        LDS_WAIT(); __builtin_amdgcn_s_barrier(); asm volatile("" ::: "memory");
        h0 = 0.f; h1 = 0.f; s0 = 0.f; s1 = 0.f;
        for (int q = 0; q < sg; ++q) { const f32x4 x = X[q * 64 + cp]; h0 = fexp2(x[1]) * h0 + x[0]; s0 += x[1]; h1 = fexp2(x[3]) * h1 + x[2]; s1 += x[3]; }
#pragma unroll
        for (int j = 0; j < 32; ++j) { const int r = sg * 32 + j; const u32x2 w = *(const LAS u32x2*)(S + r * 132 + c0);
            const float l0 = hi2f(w.x), l1 = hi2f(w.y); h0 = fexp2(l0) * h0 + lo2f(w.x); h1 = fexp2(l1) * h1 + lo2f(w.y); s0 += l0; s1 += l1;
            const unsigned ob = gb32 + (unsigned)r * 2048u;
            const float g0 = lo2f(gr[j]) * lo2f(ga[j]), g1 = hi2f(gr[j]) * hi2f(ga[j]);
            const unsigned o1_ = pk2(h0 * g0, h1 * g1), o2_ = pk2(fexp2(s0) * g0, fexp2(s1) * g1); if (DRY) asm volatile("" :: "v"(o1_), "v"(o2_)); else { *(unsigned*)((char*)GRio + ob) = o1_; *(unsigned*)((char*)GAio + ob) = o2_; }
            if ((j & 3) == 3) asm volatile("" ::: "memory"); }
        if (sg == 7 && !DRY) { *(f32x2*)(HEND + (size_t)u.pm * 1024 + chb + c0) = (f32x2){h0, h1}; *(f32x2*)(AEND + (size_t)u.pm * 1024 + chb + c0) = (f32x2){fexp2(s0), fexp2(s1)}; }
        LDS_WAIT(); __builtin_amdgcn_s_barrier(); asm volatile("" ::: "memory");
    }
};

struct EpiWout {
    static constexpr bool PERM = true, AFTER_DRAIN = false;
    const float* x; float* out; bf16_t* HB; float* ssq_h;
    __device__ __forceinline__ void operator()(const Acc& acc, const Unit& u, int wr, int wc, int fr, int fq) const {
        const int rowb = u.pm * BM + wr * 64 + fr, col0 = u.pn * BM + wc * 32 + 8 * fq;
#pragma unroll
        for (int ai = 0; ai < 2; ++ai)
#pragma unroll
            for (int m = 0; m < 4; ++m) {
                const int row = rowb + ai * HALF + m * 16; float ss = 0.f;
#pragma unroll
                for (int bj = 0; bj < 2; ++bj) { const size_t o = (size_t)row * 1024 + col0 + bj * HALF;
                    const f32x4 h0 = *(const f32x4*)(x + o) + acc[ai][bj][m][0], h1 = *(const f32x4*)(x + o + 4) + acc[ai][bj][m][1];
                    ss += dot4(h0) + dot4(h1); *(f32x4*)(out + o) = h0; *(f32x4*)(out + o + 4) = h1;
                    { u32x2 w8; int w_ = __builtin_amdgcn_cvt_pk_fp8_f32(h0[0], h0[1], 0, false); w8.x = (unsigned)__builtin_amdgcn_cvt_pk_fp8_f32(h0[2], h0[3], w_, true); w_ = __builtin_amdgcn_cvt_pk_fp8_f32(h1[0], h1[1], 0, false); w8.y = (unsigned)__builtin_amdgcn_cvt_pk_fp8_f32(h1[2], h1[3], w_, true);
                      *(u32x2*)((unsigned char*)HB + o) = w8; } }
                ss += __shfl_xor(ss, 16); ss += __shfl_xor(ss, 32); if (fq == 0) ssq_h[(size_t)row * 16 + u.pn * 4 + wc] = ss;
            }
    }
};

struct EpiMoeGU {
    static constexpr bool PERM = false, AFTER_DRAIN = false;
    bf16_t* HID; const float* ssq_h; const int* lists;
    __device__ __forceinline__ void operator()(const Acc& acc, const Unit& u, int wr, int wc, int fr, int fq) const {
        const int rb = wr * 64 + fr; float rsv[2][4];
#pragma unroll
        for (int ai = 0; ai < 2; ++ai)
#pragma unroll
            for (int m = 0; m < 4; ++m) { const int r = rb + ai * HALF + m * 16; rsv[ai][m] = (r < u.valid) ? ssq_h[lists[(size_t)u.x0 * M + u.x1 * 256 + r]] : 0.f; }
#pragma unroll
        for (int ai = 0; ai < 2; ++ai)
#pragma unroll
            for (int m = 0; m < 4; ++m) {
                const int r = rb + ai * HALF + m * 16;
                if (r < u.valid) {
                    const float rs = rsv[ai][m];
#pragma unroll
                    for (int n = 0; n < 2; ++n) { f32x4 g = acc[ai][0][m][n] * rs, up = acc[ai][1][m][n] * rs, hb;
#pragma unroll
                        for (int e = 0; e < 4; ++e) hb[e] = g[e] * fsigm(g[e]) * up[e];
                        int w_ = __builtin_amdgcn_cvt_pk_fp8_f32(hb[0], hb[1], 0, false); w_ = __builtin_amdgcn_cvt_pk_fp8_f32(hb[2], hb[3], w_, true);
                        *(unsigned*)((char*)HID + (unsigned)(((unsigned)u.pm * 256u + (unsigned)r) * 256u + 128u * (unsigned)u.pn + 32u * (unsigned)wc + 16u * (unsigned)n + 4u * (unsigned)fq)) = (unsigned)w_; }
                }
            }
    }
};
struct EpiMoeDown {
    static constexpr bool PERM = true, AFTER_DRAIN = false;
    bf16_t* Y; const float* cwl;
    __device__ __forceinline__ void operator()(const Acc& acc, const Unit& u, int wr, int wc, int fr, int fq) const {
        asm volatile("" : "+v"(fr), "+v"(fq));
        const int rb = wr * 64 + fr, col0 = u.pn * BM + wc * 32 + 8 * fq;
#pragma unroll
        for (int ai = 0; ai < 2; ++ai) {
            float cwv[4];
#pragma unroll
            for (int m = 0; m < 4; ++m) { const int r = rb + ai * HALF + m * 16; cwv[m] = (r < u.valid) ? cwl[(size_t)u.x0 * M + u.x1 * 256 + r] * 8.f : 0.f; }
#pragma unroll
            for (int m = 0; m < 4; ++m) {
                const int r = rb + ai * HALF + m * 16;
                if (r < u.valid) { const float cw = cwv[m];
#pragma unroll
                    for (int bj = 0; bj < 2; ++bj) { const f32x4 y0 = acc[ai][bj][m][0] * cw, y1 = acc[ai][bj][m][1] * cw; u32x2 w8;
                        int w_ = __builtin_amdgcn_cvt_pk_fp8_f32(y0[0], y0[1], 0, false); w8.x = (unsigned)__builtin_amdgcn_cvt_pk_fp8_f32(y0[2], y0[3], w_, true);
                        w_ = __builtin_amdgcn_cvt_pk_fp8_f32(y1[0], y1[1], 0, false); w8.y = (unsigned)__builtin_amdgcn_cvt_pk_fp8_f32(y1[2], y1[3], w_, true);
                        *(u32x2*)((char*)Y + (unsigned)(((unsigned)u.pm * 256u + (unsigned)r) * 1024u + (unsigned)(col0 + bj * HALF))) = w8; } }
            }
            asm volatile("" ::: "memory");
        }
    }
};
#define LANE_NOW() ({ int t__ = threadIdx.x; asm volatile("" : "+v"(t__)); t__ & 63; })
struct Frame {
    LAS unsigned char* lds; volatile LAS unsigned* MISC; gu32* ctl;
    int tid, lane, wave, vcu, G;
    void* const* in_dummy;
};
struct Args { const void* in[26]; float* out; unsigned char* ws; int ph_lo, ph_hi; };
typedef const __attribute__((address_space(4))) Args& CArgs;

__device__ __forceinline__ int crow(int r, int hi) { return (r & 3) + 8 * (r >> 2) + 4 * hi; }
__device__ __forceinline__ void tr_item(const float* W, int ldn, int ns0, bf16_t* WT, int K, int nd0, int k0, const float* kscale, LAS float* scr, int lane, int ncols = 64, int nwrite = 64, float f8mul = 0.f) {
    const int c4 = (lane & 15) * 4, kr = lane >> 4;
    f32x4 v[16];
#pragma unroll
    for (int i = 0; i < 16; ++i) { const int kk = 4 * i + kr; v[i] = (c4 < ncols) ? *(const f32x4*)(W + (size_t)(k0 + kk) * ldn + ns0 + c4) : (f32x4){0.f, 0.f, 0.f, 0.f}; }
#pragma unroll
    for (int i = 0; i < 16; ++i) { const int kk = 4 * i + kr; f32x4 x = v[i]; if (kscale) x = x * kscale[k0 + kk];
        LAS float* p = scr + kk * 65 + c4; p[0] = x[0]; p[1] = x[1]; p[2] = x[2]; p[3] = x[3]; }
    LDS_WAIT(); asm volatile("" ::: "memory");
    const int c = lane & 7;
#pragma unroll
    for (int j = 0; j < 8; ++j) { const int n = (lane >> 3) + 8 * j; if (n >= nwrite) break; const LAS float* sp = scr + (8 * c) * 65 + n;
        if (f8mul != 0.f) { u32x2 o8; int w_ = __builtin_amdgcn_cvt_pk_fp8_f32(sp[0 * 65] * f8mul, sp[1 * 65] * f8mul, 0, false); o8.x = (unsigned)__builtin_amdgcn_cvt_pk_fp8_f32(sp[2 * 65] * f8mul, sp[3 * 65] * f8mul, w_, true);
            w_ = __builtin_amdgcn_cvt_pk_fp8_f32(sp[4 * 65] * f8mul, sp[5 * 65] * f8mul, 0, false); o8.y = (unsigned)__builtin_amdgcn_cvt_pk_fp8_f32(sp[6 * 65] * f8mul, sp[7 * 65] * f8mul, w_, true);
            *(u32x2*)((unsigned char*)WT + (size_t)(nd0 + n) * K + k0 + 8 * c) = o8; continue; }
        u32x4 o; o.x = pk2(sp[0 * 65], sp[1 * 65]); o.y = pk2(sp[2 * 65], sp[3 * 65]); o.z = pk2(sp[4 * 65], sp[5 * 65]); o.w = pk2(sp[6 * 65], sp[7 * 65]);
        *(u32x4*)(WT + (size_t)(nd0 + n) * K + k0 + 8 * c) = o; }
    LDS_WAIT(); asm volatile("" ::: "memory");
}

__device__ __forceinline__ void p0_prologue(Frame& F, CArgs a) {
    LAS float* scr = (LAS float*)(F.lds + F.wave * 16640);
    const int gw = F.vcu * NWAVES + F.wave, NGW = F.G * NWAVES, lane = LANE_NOW();
    unsigned char* ws = a.ws;
    const float* w_in = (const float*)a.in[3];
    bf16_t* WIN = (bf16_t*)(ws + WS_WIN); bf16_t* WUQ = (bf16_t*)(ws + WS_WUQ); bf16_t* WUKV = (bf16_t*)(ws + WS_WUKV); bf16_t* WLRU = (bf16_t*)(ws + WS_WLRU); bf16_t* WOUT = (bf16_t*)(ws + WS_WOUT);
    constexpr int I_IN = 16 * 81, I_UQ = 12 * 24, I_UKV = 4 * 32, I_LRU = 4 * 32, I_OUT = 16 * 16, NITEMS = I_IN + I_UQ + I_UKV + I_LRU + I_OUT;
    for (int it = gw; it < NITEMS; it += NGW) {
        int r = it;
        if (r < I_IN) { const int kb = r / 81, nb = r % 81, nd0 = 64 * nb, k0 = 64 * kb;
            if (nd0 < 5120) tr_item(w_in, 5152, nd0 < 3072 ? nd0 : nd0 + 32, WIN, 1024, nd0, k0, nullptr, scr, lane);
            else tr_item(w_in, 5152, 3072, WIN, 1024, nd0, k0, nullptr, scr, lane, 32, 32);
            continue; }
        r -= I_IN;
        if (r < I_UQ) { const int kb = r / 24, nb = r % 24; tr_item((const float*)a.in[12], 1536, 64 * nb, WUQ, 768, 64 * nb, 64 * kb, (const float*)a.in[11], scr, lane, 64, 64, 32.f); continue; }
        r -= I_UQ;
        if (r < I_UKV) { const int kb = r / 32, nb = r % 32, nd0 = 64 * nb, pn = nd0 >> 8, bj = (nd0 >> 7) & 1, wcp = (nd0 >> 6) & 1;
#pragma unroll 1
            for (int hh = 0; hh < 2; ++hh) tr_item((const float*)a.in[14], 2048, (2 * pn + hh) * 128 + wcp * 64 + 32 * bj, WUKV, 256, nd0 + 32 * hh, 64 * kb, (const float*)a.in[13], scr, lane, 32, 32, 16.f);
            continue; }
        r -= I_UKV;
        if (r < I_LRU) { const int kb = r / 32, nb = r % 32, nd0 = 64 * nb, pn = nd0 >> 8, bj = (nd0 >> 7) & 1, xb = nd0 & 127, blk = pn >> 1;
            tr_item((const float*)a.in[bj ? 8 : 6] + (size_t)blk * 65536, 256, 128 * (pn & 1) + xb, WLRU, 256, nd0, 64 * kb, nullptr, scr, lane); continue; }
        r -= I_LRU;
        { const int kb = r / 16, nb = r % 16; tr_item((const float*)a.in[17], 1024, 64 * nb, WOUT, 1024, 64 * nb, 64 * kb, nullptr, scr, lane); }
    }
    const float* x = (const float*)a.in[0]; const float* gm = (const float*)a.in[2]; bf16_t* XN = (bf16_t*)(ws + WS_R1);
    f32x4 g4[4];
#pragma unroll
    for (int j = 0; j < 4; ++j) g4[j] = *(const f32x4*)(gm + 4 * lane + 256 * j);
    for (int m = gw; m < M; m += NGW) {
        const f32x4* xr = (const f32x4*)(x + (size_t)m * D) + lane; f32x4 v[4]; float s = 0.f;
#pragma unroll
        for (int j = 0; j < 4; ++j) { v[j] = xr[64 * j]; s += dot4(v[j]); }
        const float rstd = rsqrtf(wave_sum(s) * (1.f / 1024.f) + EPS);
        u32x2* o8 = (u32x2*)(XN + (size_t)m * D) + lane;
#pragma unroll
        for (int j = 0; j < 4; ++j) { const f32x4 y = v[j] * rstd * g4[j]; u32x2 w; w.x = pk2(y[0], y[1]); w.y = pk2(y[2], y[3]); o8[64 * j] = w; }
    }
    const int gt = F.vcu * NTHREADS + F.tid, NGT = F.G * NTHREADS;
    const int* pos = (const int*)a.in[1]; float* CS = (float*)(ws + WS_CS);
    for (int i = gt; i < M * 16; i += NGT) { const int t = i >> 4, j = i & 15; const float fr = powf(10000.f, -(float)j / 16.f); const float ang = (float)pos[t] * fr; CS[t * 32 + j] = cosf(ang); CS[t * 32 + 16 + j] = sinf(ang); }
    float* WR = (float*)(ws + WS_MISC + MISC_WR); const float* gf = (const float*)a.in[18]; const float* wg = (const float*)a.in[19]; const float* we = (const float*)a.in[21];
    for (int i = gt; i < 36 * 1024; i += NGT) { const int j = i >> 10, k = i & 1023; WR[i] = (j < 4 ? wg[k * 4 + j] : we[k * 32 + (j - 4)]) * gf[k]; }
}

__device__ __forceinline__ void moe_weight_convert(Frame& F, CArgs a, int part, int lo, int nblk) {
    LAS float* scr = (LAS float*)(F.lds + F.wave * 16640);
    const int gw = lo * NWAVES + F.wave, NGW = nblk * NWAVES, lane = LANE_NOW();
    bf16_t* WGU = (bf16_t*)(a.ws + WS_WGU); bf16_t* WDN = (bf16_t*)(a.ws + WS_WDN); const float* gf = (const float*)a.in[18];
    constexpr int I_GU = 32 * 16 * 8, I_DN = 32 * 4 * 16;
    for (int it = (part == 0 ? gw : I_GU + gw); it < (part == 0 ? I_GU : I_GU + I_DN); it += NGW) {
        if (it < I_GU) { const int e = it >> 7, r = it & 127, kb = r >> 3, nb = r & 7, nd0 = 64 * nb, pn = nd0 >> 8, bj = (nd0 >> 7) & 1, xb = nd0 & 127;
            tr_item((const float*)a.in[bj ? 24 : 23] + (size_t)e * 262144, 256, 128 * pn + xb, (bf16_t*)((unsigned char*)WGU + (size_t)e * 524288), 1024, nd0, 64 * kb, gf, scr, lane, 64, 64, 32.f); }
        else { const int r0 = it - I_GU, e = r0 >> 6, r = r0 & 63, kb = r >> 4, nb = r & 15;
            tr_item((const float*)a.in[25] + (size_t)e * 262144, 1024, 64 * nb, (bf16_t*)((unsigned char*)WDN + (size_t)e * 262144), 256, 64 * nb, 64 * kb, nullptr, scr, lane, 64, 64, 16.f); }
    }
}

template <bool DRY> __device__ __forceinline__ void p2a_conv(Frame& F, CArgs a) {
    unsigned char* ws = a.ws; bf16_t* XR = (bf16_t*)(ws + WS_XR); const bf16_t* HALO = (const bf16_t*)(ws + WS_MISC + MISC_HALO);
    const float* cw = (const float*)a.in[4]; const float* cb = (const float*)a.in[5];
    for (int b = F.vcu; b < 256; b += F.G) {
        const int pm = b >> 2, cg = b & 3, cp = F.tid & 127, sg = F.tid >> 7, c = cg * 256 + 2 * cp, base = pm * 256 + sg * 64;
        float h0[3], h1[3];
#pragma unroll
        for (int i = 0; i < 3; ++i) { unsigned w = 0u;
            if (sg == 0) { if (pm > 0) w = *(const unsigned*)(HALO + ((size_t)(pm - 1) * 3 + i) * 1024 + c); }
            else w = *(const unsigned*)(XR + (size_t)(base - 3 + i) * 1024 + c);
            h0[i] = lo2f(w); h1[i] = hi2f(w); }
        VM_WAIT(); __syncthreads();
        float w0[4], w1[4];
#pragma unroll
        for (int k = 0; k < 4; ++k) { w0[k] = cw[k * 1024 + c]; w1[k] = cw[k * 1024 + c + 1]; }
        const float b0 = cb[c], b1 = cb[c + 1];
        for (int j0 = 0; j0 < 64; j0 += 8) {
            unsigned xw[8];
#pragma unroll
            for (int j = 0; j < 8; ++j) xw[j] = *(const unsigned*)(XR + (size_t)(base + j0 + j) * 1024 + c);
#pragma unroll
            for (int j = 0; j < 8; ++j) { const float x0 = lo2f(xw[j]), x1 = hi2f(xw[j]);
                const float y0 = b0 + w0[0] * h0[0] + w0[1] * h0[1] + w0[2] * h0[2] + w0[3] * x0, y1 = b1 + w1[0] * h1[0] + w1[1] * h1[1] + w1[2] * h1[2] + w1[3] * x1;
                h0[0] = h0[1]; h0[1] = h0[2]; h0[2] = x0; h1[0] = h1[1]; h1[1] = h1[2]; h1[2] = x1;
                const unsigned yw_ = pk2(y0, y1); if (DRY) asm volatile("" :: "v"(yw_)); else *(unsigned*)(XR + (size_t)(base + j0 + j) * 1024 + c) = yw_; }
        }
        __syncthreads();
    }
    if (!DRY && F.wave < 4) {
        const float* PQ = (const float*)(ws + WS_SSQP); const float* PKV = (const float*)(ws + WS_SSQP + SSQP_KV); float* RQ = (float*)(ws + WS_CTL + CTL_SSQ_Q); float* RKV = (float*)(ws + WS_CTL + CTL_SSQ_KV);
        float* KPE = (float*)(ws + WS_KPE); const float* CS = (const float*)(ws + WS_CS); float* KSSQ = (float*)(ws + WS_MISC + MISC_KSSQ); const float* kg = (const float*)a.in[16];
        const bf16_t* XN = (const bf16_t*)(ws + WS_R1); const bf16_t* WK = (const bf16_t*)(ws + WS_WIN) + (size_t)5120 * 1024;
        const int lane = LANE_NOW(), r16 = lane & 15, q4 = lane >> 4; LAS float* kl = (LAS float*)(F.lds + F.wave * 4096);
        for (int rb = F.vcu * 4 + F.wave; rb < M / 16; rb += F.G * 4) {
            const bf16_t* ap = XN + (size_t)(rb * 16 + r16) * 1024 + 8 * q4; const bf16_t* bp0 = WK + (size_t)r16 * 1024 + 8 * q4; const bf16_t* bp1 = bp0 + 16 * 1024;
            f32x4 acc0 = {0.f, 0.f, 0.f, 0.f}, acc1 = acc0;
#pragma unroll 8
            for (int s32 = 0; s32 < 32; ++s32) { const bf16x8 av = *(const bf16x8*)(ap + 32 * s32), b0 = *(const bf16x8*)(bp0 + 32 * s32), b1 = *(const bf16x8*)(bp1 + 32 * s32);
                acc0 = __builtin_amdgcn_mfma_f32_16x16x32_bf16(av, b0, acc0, 0, 0, 0); acc1 = __builtin_amdgcn_mfma_f32_16x16x32_bf16(av, b1, acc1, 0, 0, 0); }
#pragma unroll
            for (int i2 = 0; i2 < 4; ++i2) { kl[(4 * q4 + i2) * 33 + r16] = acc0[i2]; kl[(4 * q4 + i2) * 33 + 16 + r16] = acc1[i2]; }
            LDS_WAIT();
            if (lane < 16) {
                const int row = rb * 16 + lane; float kp[32]; float ss = 0.f;
#pragma unroll
                for (int j2 = 0; j2 < 32; ++j2) { kp[j2] = kl[lane * 33 + j2]; ss += kp[j2] * kp[j2]; }
                KSSQ[row] = ss;
                { const f32x4 a0 = *(const f32x4*)(PQ + (size_t)row * 12), a1 = *(const f32x4*)(PQ + (size_t)row * 12 + 4), a2 = *(const f32x4*)(PQ + (size_t)row * 12 + 8), b0 = *(const f32x4*)(PKV + (size_t)row * 4);
                  const float sq = ((a0[0] + a0[1]) + (a0[2] + a0[3])) + ((a1[0] + a1[1]) + (a1[2] + a1[3])) + ((a2[0] + a2[1]) + (a2[2] + a2[3])), sk = (b0[0] + b0[1]) + (b0[2] + b0[3]);
                  RQ[row] = rsqrtf(sq * (1.f / 768.f) + EPS); RKV[row] = rsqrtf(sk * (1.f / 256.f) + EPS); }
#pragma unroll
                for (int i = 0; i < 4; ++i) { const f32x4 g1 = *(const f32x4*)(kg + 64 + 4 * i), g2 = *(const f32x4*)(kg + 80 + 4 * i), cs = *(const f32x4*)(CS + (size_t)row * 32 + 4 * i), sn = *(const f32x4*)(CS + (size_t)row * 32 + 16 + 4 * i);
                    f32x4 o1, o2;
#pragma unroll
                    for (int e = 0; e < 4; ++e) { const float k1 = kp[4 * i + e] * g1[e], k2 = kp[16 + 4 * i + e] * g2[e]; o1[e] = k1 * cs[e] - k2 * sn[e]; o2[e] = k1 * sn[e] + k2 * cs[e]; }
                    *(f32x4*)(KPE + (size_t)row * 32 + 4 * i) = o1; *(f32x4*)(KPE + (size_t)row * 32 + 16 + 4 * i) = o2; }
            }
            LDS_WAIT();
        }
    }
}

__device__ __forceinline__ void glds16(const void* gsrc, unsigned lds_dst) { unsigned keep;
    asm volatile("s_mov_b32 %0, m0\n\ts_mov_b32 m0, %2\n\ts_nop 0\n\tglobal_load_lds_dwordx4 %1, off\n\ts_mov_b32 m0, %0" : "=&s"(keep) : "v"(gsrc), "s"(lds_dst) : "memory"); }
__device__ __forceinline__ void glds16s(const void* sbase, unsigned voff, unsigned lds_dst) { unsigned keep;
    asm volatile("s_mov_b32 %0, m0\n\ts_mov_b32 m0, %3\n\ts_nop 0\n\tglobal_load_lds_dwordx4 %1, %2\n\ts_mov_b32 m0, %0" : "=&s"(keep) : "v"(voff), "s"(sbase), "s"(lds_dst) : "memory"); }
__device__ __forceinline__ void glds12(const void* gsrc, unsigned lds_dst) { unsigned keep;
    asm volatile("s_mov_b32 %0, m0\n\ts_mov_b32 m0, %2\n\ts_nop 0\n\tglobal_load_lds_dwordx3 %1, off\n\ts_mov_b32 m0, %0" : "=&s"(keep) : "v"(gsrc), "s"(lds_dst) : "memory"); }
#define AWAIT_BAR(N) asm volatile("s_waitcnt vmcnt(" #N ") lgkmcnt(0)\n\ts_barrier" ::: "memory")
constexpr int AT_K = 0, AT_V = 24576, AT_WS = 40960, AT_OST = 43008, AT_END = 75776;
constexpr float C2 = 0.10206207261596575f * 1.4426950408889634f;

__device__ __forceinline__ void attn_unit_v1(int h, int qb, CArgs a, const LAS float* carry, LAS unsigned char* shm) {
    const int tid = threadIdx.x, lane = tid & 63, r32 = lane & 31, hi = lane >> 5; const int wid = __builtin_amdgcn_readfirstlane(tid >> 6);
    unsigned char* ws = a.ws;
    const bf16_t* QRAW = (const bf16_t*)(ws + WS_R1); const unsigned char* KI = ws + WS_KIMG + (size_t)h * 256 * 12288; const unsigned char* VI = (const unsigned char*)a.out + 32 * MiB + (size_t)h * 256 * 8192;
    const float* CS = (const float*)(ws + WS_CS); const float* qg = (const float*)a.in[15];
    const int q0 = qb * 256, rowq = q0 + wid * 32 + r32;
    const unsigned lds0 = (unsigned)(uintptr_t)shm;
    LAS float* wsf = (LAS float*)(shm + AT_WS) + wid * 64;
    bf16x8 qr[6];
    {
        const bf16_t* qp = QRAW + (size_t)rowq * 1536 + h * 96 + hi * 8;
        u32x4 raw[6]; float qv[6][8]; float ss = 0.f;
#pragma unroll
        for (int d0 = 0; d0 < 6; ++d0) raw[d0] = *(const u32x4*)(qp + d0 * 16);
#pragma unroll
        for (int d0 = 0; d0 < 6; ++d0)
#pragma unroll
            for (int j = 0; j < 4; ++j) { qv[d0][2 * j] = lo2f(raw[d0][j]); qv[d0][2 * j + 1] = hi2f(raw[d0][j]); ss += qv[d0][2 * j] * qv[d0][2 * j] + qv[d0][2 * j + 1] * qv[d0][2 * j + 1]; }
        ss += __shfl_xor(ss, 32);
        const float rs = rsqrtf(ss * (1.f / 96.f) + EPS);
#pragma unroll
        for (int d0 = 0; d0 < 6; ++d0) { const f32x4 g0 = *(const f32x4*)(qg + d0 * 16 + hi * 8), g1 = *(const f32x4*)(qg + d0 * 16 + hi * 8 + 4);
#pragma unroll
            for (int j = 0; j < 4; ++j) { qv[d0][j] *= rs * g0[j]; qv[d0][4 + j] *= rs * g1[j]; } }
        const f32x4 c0 = *(const f32x4*)(CS + (size_t)rowq * 32 + hi * 8), c1 = *(const f32x4*)(CS + (size_t)rowq * 32 + hi * 8 + 4), s0 = *(const f32x4*)(CS + (size_t)rowq * 32 + 16 + hi * 8), s1 = *(const f32x4*)(CS + (size_t)rowq * 32 + 16 + hi * 8 + 4);
#pragma unroll
        for (int j = 0; j < 8; ++j) { const float cs = j < 4 ? c0[j & 3] : c1[j & 3], sn = j < 4 ? s0[j & 3] : s1[j & 3]; const float x1 = qv[4][j], x2 = qv[5][j]; qv[4][j] = x1 * cs - x2 * sn; qv[5][j] = x1 * sn + x2 * cs; }
#pragma unroll
        for (int d0 = 0; d0 < 6; ++d0) { u32x4 w;
#pragma unroll
            for (int j = 0; j < 4; ++j) w[j] = pk2(qv[d0][2 * j] * C2, qv[d0][2 * j + 1] * C2);
            qr[d0] = __builtin_bit_cast(bf16x8, w); }
    }
    const int NT = 4 * qb + 4, mylast = 4 * qb + (wid >> 1);
#define AT_DMA(t, buf) do { const unsigned char* kt_ = KI + (size_t)(t) * 12288 + wid * 1024 + lane * 16; const unsigned kd_ = lds0 + AT_K + (buf) * 12288 + wid * 1024; \
        glds16(kt_, (unsigned)__builtin_amdgcn_readfirstlane(kd_)); if (wid < 4) glds16(kt_ + 8192, (unsigned)__builtin_amdgcn_readfirstlane(kd_ + 8192)); \
        glds16(VI + (size_t)(t) * 8192 + wid * 1024 + lane * 16, (unsigned)__builtin_amdgcn_readfirstlane(lds0 + AT_V + (buf) * 8192 + wid * 1024)); } while (0)
#define AT_WAIT1() do { if (wid < 4) asm volatile("s_waitcnt vmcnt(3)" ::: "memory"); else asm volatile("s_waitcnt vmcnt(2)" ::: "memory"); asm volatile("s_waitcnt lgkmcnt(0)\n\ts_barrier" ::: "memory"); } while (0)
    float m_run = -1e30f, l_run = 0.f; f32x16 o[2]; o[0] = f32x16{}; o[1] = f32x16{};
    AT_DMA(0, 0);
    for (int t = 0; t < NT; ++t) {
        const int buf = t & 1;
        if (t + 1 < NT) { AT_DMA(t + 1, buf ^ 1); AT_WAIT1(); } else { AWAIT_BAR(0); }
        if (t <= mylast) {
            const LAS unsigned char* kb = shm + AT_K + buf * 12288 + hi * 1024 + r32 * 16;
            f32x16 p0 = f32x16{}, p1 = f32x16{};
#pragma unroll
            for (int d0 = 0; d0 < 6; ++d0) { const bf16x8 b0 = *(const LAS bf16x8*)(kb + d0 * 2048), b1 = *(const LAS bf16x8*)(kb + d0 * 2048 + 512);
                p0 = __builtin_amdgcn_mfma_f32_32x32x16_bf16(b0, qr[d0], p0, 0, 0, 0); p1 = __builtin_amdgcn_mfma_f32_32x32x16_bf16(b1, qr[d0], p1, 0, 0, 0); }
            float rm = fmaxf(p0[0], p1[0]);
#pragma unroll
            for (int r = 1; r < 16; ++r) rm = fmaxf(rm, fmaxf(p0[r], p1[r]));
            rm = fmaxf(rm, __shfl_xor(rm, 32));
            const float mn = fmaxf(m_run, rm), alpha = fexp2(m_run - mn); m_run = mn;
            float ps = 0.f;
#pragma unroll
            for (int r = 0; r < 16; ++r) { p0[r] = fexp2(p0[r] - mn); p1[r] = fexp2(p1[r] - mn); ps += p0[r] + p1[r]; }
            l_run = l_run * alpha + ps;
            if (__any(alpha != 1.f)) {
                if (hi == 0) wsf[r32] = alpha;
                LDS_WAIT();
#pragma unroll
                for (int r = 0; r < 16; ++r) { const float f = wsf[crow(r, hi)]; o[0][r] *= f; o[1][r] *= f; }
            }
            u32x4 pw[4];
#pragma unroll
            for (int j = 0; j < 4; ++j) { pw[0][j] = pk2(p0[2 * j], p0[2 * j + 1]); pw[1][j] = pk2(p0[8 + 2 * j], p0[8 + 2 * j + 1]); pw[2][j] = pk2(p1[2 * j], p1[2 * j + 1]); pw[3][j] = pk2(p1[8 + 2 * j], p1[8 + 2 * j + 1]); }
            const LAS unsigned char* vb = shm + AT_V + buf * 8192 + ((lane >> 4) & 1) * 32 + (lane & 3) * 8 + (4 * hi + ((lane & 15) >> 2)) * 64;
#pragma unroll
            for (int d0 = 0; d0 < 2; ++d0)
#pragma unroll
                for (int ks = 0; ks < 4; ++ks) {
                    typedef short v4i16_t __attribute__((ext_vector_type(4)));
                    const s16x4 lo = __builtin_bit_cast(s16x4, __builtin_amdgcn_ds_read_tr16_b64_v4i16((LAS v4i16_t*)(vb + d0 * 4096 + ks * 1024)));
                    const s16x4 hh = __builtin_bit_cast(s16x4, __builtin_amdgcn_ds_read_tr16_b64_v4i16((LAS v4i16_t*)(vb + d0 * 4096 + ks * 1024 + 512)));
                    const bf16x8 vf = (bf16x8){lo[0], lo[1], lo[2], lo[3], hh[0], hh[1], hh[2], hh[3]};
                    o[d0] = __builtin_amdgcn_mfma_f32_32x32x16_bf16(__builtin_bit_cast(bf16x8, pw[ks]), vf, o[d0], 0, 0, 0);
                }
        }
        asm volatile("s_waitcnt lgkmcnt(0)\n\ts_barrier" ::: "memory");
    }
#undef AT_DMA
#undef AT_WAIT1
    l_run += __shfl_xor(l_run, 32);
    if (hi == 0) wsf[32 + r32] = l_run;
    LDS_WAIT();
    LAS bf16_t* stg = (LAS bf16_t*)(shm + AT_OST) + wid * 2048;
#pragma unroll
    for (int r = 0; r < 16; ++r) { const int orow = crow(r, hi); const float il = frcp(wsf[32 + orow]);
#pragma unroll
        for (int d0 = 0; d0 < 2; ++d0) stg[orow * 64 + d0 * 32 + r32] = (bf16_t)f2bf(o[d0][r] * il); }
    LDS_WAIT();
    const bf16_t* GB = (const bf16_t*)a.out; const bf16_t* HL = (const bf16_t*)(ws + WS_GR); const bf16_t* AC = (const bf16_t*)(ws + WS_GA); bf16_t* MG = (bf16_t*)(ws + WS_XR);
#pragma unroll
    for (int i = 0; i < 4; ++i) { const int row = i * 8 + (lane >> 3), ch = lane & 7; const u32x4 yv = *(const LAS u32x4*)(stg + row * 64 + ch * 8);
        const size_t go = (size_t)(q0 + wid * 32 + row) * 1024 + h * 64 + ch * 8;
        const u32x4 gb = *(const u32x4*)(GB + go), hl = *(const u32x4*)(HL + go), ac = *(const u32x4*)(AC + go); u32x4 w;
#pragma unroll
        for (int j = 0; j < 4; ++j) { const float c0 = carry[ch * 8 + 2 * j], c1 = carry[ch * 8 + 2 * j + 1];
            w[j] = pk2(lo2f(yv[j]) * lo2f(gb[j]) + lo2f(hl[j]) + lo2f(ac[j]) * c0, hi2f(yv[j]) * hi2f(gb[j]) + hi2f(hl[j]) + hi2f(ac[j]) * c1); }
        *(u32x4*)(MG + go) = w; }
    asm volatile("s_waitcnt lgkmcnt(0)\n\ts_barrier" ::: "memory");
}


constexpr int A2_K = 0, A2_V = 36864, A2_WS = 61440, A2_OST = 63488;
#define A2_MF(a_, b_, c_) __builtin_amdgcn_mfma_f32_32x32x16_bf16(a_, b_, c_, 0, 0, 0)
#define A2_SB() __builtin_amdgcn_sched_barrier(0)
#define A2_PIN(x) asm volatile("" : "+v"(x))
#define A2_KF(d0, blk) ((ABL == 5) ? qr[(d0)] : *(const LAS bf16x8*)(kp + (d0) * 2048 + (blk) * 512))
typedef short v4i16_t __attribute__((ext_vector_type(4)));
#define A2_VT(off) __builtin_bit_cast(s16x4, __builtin_amdgcn_ds_read_tr16_b64_v4i16((LAS v4i16_t*)(vp + (off))))
#define A2_VJ(lo_, hi_, j) do { if (ABL == 5) { lo_ = (s16x4){qr[0][0], qr[0][1], qr[1][2], qr[1][3]}; hi_ = (s16x4){qr[2][0], qr[2][1], qr[3][2], qr[3][3]}; } else { lo_ = A2_VT(((j) & 1) * 4096 + ((j) >> 1) * 1024); hi_ = A2_VT(((j) & 1) * 4096 + ((j) >> 1) * 1024 + 512); } } while (0)
#define A2_VF(lo_, hi_) ((bf16x8){lo_[0], lo_[1], lo_[2], lo_[3], hi_[0], hi_[1], hi_[2], hi_[3]})
#define A2_EX(x) ((ABL == 2) ? (x) : fexp2(x))
#define A2_E3(P, b) do { P[b] = A2_EX(P[b]); P[(b) + 1] = A2_EX(P[(b) + 1]); P[(b) + 2] = A2_EX(P[(b) + 2]); } while (0)
#define A2_E2(P, b) do { P[b] = A2_EX(P[b]); P[(b) + 1] = A2_EX(P[(b) + 1]); } while (0)
#define A2_PK2(W, j, P, b) do { W[j] = pk2(P[b], P[(b) + 1]); W[(j) + 1] = pk2(P[(b) + 2], P[(b) + 3]); } while (0)
#define A2_S4(P, b) do { if (ABL != 2) { sacc += P[b]; sacc += P[(b) + 1]; sacc += P[(b) + 2]; sacc += P[(b) + 3]; } } while (0)

template <int ABL> __device__ __forceinline__ void attn_unit_v2(int h, int qb, CArgs a, const LAS float* carry, LAS unsigned char* shm) {
    const int tid = threadIdx.x, lane = tid & 63, r32 = lane & 31, hi = lane >> 5; const int wid = __builtin_amdgcn_readfirstlane(tid >> 6);
    unsigned char* ws = a.ws;
    const bf16_t* QRAW = (const bf16_t*)(ws + WS_R1); const unsigned char* KI = ws + WS_KIMG + (size_t)h * 256 * 12288; const unsigned char* VI = (const unsigned char*)a.out + 32 * MiB + (size_t)h * 256 * 8192;
    const float* CS = (const float*)(ws + WS_CS); const float* qg = (const float*)a.in[15];
    const int q0 = qb * 256, rowq = q0 + wid * 32 + r32;
    const unsigned lds0 = (unsigned)(uintptr_t)shm;
    LAS float* wsf = (LAS float*)(shm + A2_WS) + wid * 64;
    const int NT = 4 * qb + 4, mylast = 4 * qb + (wid >> 1);
    const unsigned char* ksrc = KI + wid * 1024 + lane * 16; const unsigned char* vsrc = VI + wid * 1024 + lane * 16;
    const unsigned kdst = lds0 + A2_K + wid * 1024, vdst = lds0 + A2_V + wid * 1024;
#define A2_DMAK(t, slot) do { if (ABL == 3) break; glds16(ksrc + (size_t)(t) * 12288, (unsigned)__builtin_amdgcn_readfirstlane(kdst + (slot) * 12288)); \
        if (wid < 4) glds16(ksrc + (size_t)(t) * 12288 + 8192, (unsigned)__builtin_amdgcn_readfirstlane(kdst + (slot) * 12288 + 8192)); } while (0)
#define A2_DMAV(t, slot) do { if (ABL != 3) glds16(vsrc + (size_t)(t) * 8192, (unsigned)__builtin_amdgcn_readfirstlane(vdst + (slot) * 8192)); } while (0)
#define A2_WAITFULL() do { if (wid < 4) asm volatile("s_waitcnt vmcnt(3)" ::: "memory"); else asm volatile("s_waitcnt vmcnt(2)" ::: "memory"); } while (0)
#define A2_BAR() do { if (ABL == 1) asm volatile("s_waitcnt lgkmcnt(0)" ::: "memory"); else asm volatile("s_waitcnt lgkmcnt(0)\n\ts_barrier" ::: "memory"); } while (0)
    bf16x8 qr[6];
    {
        const bf16_t* qp = QRAW + (size_t)rowq * 1536 + h * 96 + hi * 8;
        u32x4 raw[6]; float qv[6][8]; float ss = 0.f;
#pragma unroll
        for (int d0 = 0; d0 < 6; ++d0) raw[d0] = *(const u32x4*)(qp + d0 * 16);
        A2_DMAK(0, 0); A2_DMAV(0, 0); A2_DMAK(1, 1); A2_DMAV(1, 1); A2_DMAK(2, 2);
#pragma unroll
        for (int d0 = 0; d0 < 6; ++d0)
#pragma unroll
            for (int j = 0; j < 4; ++j) { qv[d0][2 * j] = lo2f(raw[d0][j]); qv[d0][2 * j + 1] = hi2f(raw[d0][j]); ss += qv[d0][2 * j] * qv[d0][2 * j] + qv[d0][2 * j + 1] * qv[d0][2 * j + 1]; }
        ss += __shfl_xor(ss, 32);
        const float rs = rsqrtf(ss * (1.f / 96.f) + EPS);
#pragma unroll
        for (int d0 = 0; d0 < 6; ++d0) { const f32x4 g0 = *(const f32x4*)(qg + d0 * 16 + hi * 8), g1 = *(const f32x4*)(qg + d0 * 16 + hi * 8 + 4);
#pragma unroll
            for (int j = 0; j < 4; ++j) { qv[d0][j] *= rs * g0[j]; qv[d0][4 + j] *= rs * g1[j]; } }
        const f32x4 c0 = *(const f32x4*)(CS + (size_t)rowq * 32 + hi * 8), c1 = *(const f32x4*)(CS + (size_t)rowq * 32 + hi * 8 + 4), s0 = *(const f32x4*)(CS + (size_t)rowq * 32 + 16 + hi * 8), s1 = *(const f32x4*)(CS + (size_t)rowq * 32 + 16 + hi * 8 + 4);
#pragma unroll
        for (int j = 0; j < 8; ++j) { const float cs = j < 4 ? c0[j & 3] : c1[j & 3], sn = j < 4 ? s0[j & 3] : s1[j & 3]; const float x1 = qv[4][j], x2 = qv[5][j]; qv[4][j] = x1 * cs - x2 * sn; qv[5][j] = x1 * sn + x2 * cs; }
#pragma unroll
        for (int d0 = 0; d0 < 6; ++d0) { u32x4 w;
#pragma unroll
            for (int j = 0; j < 4; ++j) w[j] = pk2(qv[d0][2 * j] * C2, qv[d0][2 * j + 1] * C2);
            qr[d0] = __builtin_bit_cast(bf16x8, w); }
    }
    if (wid >= 4) __builtin_amdgcn_s_setprio(1);
    float lsum = 0.f; f32x16 o[2]; o[0] = f32x16{}; o[1] = f32x16{};
    f32x16 pA0, pA1, pB0, pB1;
    if (wid < 4) asm volatile("s_waitcnt vmcnt(6)" ::: "memory"); else asm volatile("s_waitcnt vmcnt(4)" ::: "memory");
    A2_BAR();
    {
        const LAS unsigned char* kp = shm + A2_K + hi * 1024 + r32 * 16;
        pA0 = f32x16{}; pA1 = f32x16{};
#pragma unroll
        for (int d0 = 0; d0 < 6; ++d0) { pA0 = A2_MF(A2_KF(d0, 0), qr[d0], pA0); pA1 = A2_MF(A2_KF(d0, 1), qr[d0], pA1); }
    }
    int sk_next = 12288, sv_cur = 0;
#define A2_STEP(C0, C1, N0, N1, t, HASN) do { \
        const LAS unsigned char* kp = shm + A2_K + sk_next + hi * 1024 + r32 * 16; const LAS unsigned char* vp = shm + A2_V + sv_cur + ((lane >> 4) & 1) * 32 + (lane & 3) * 8 + (4 * hi + ((lane & 15) >> 2)) * 64; \
        bf16x8 k0, k1, k2; s16x4 vl0, vh0, vl1, vh1, vl2, vh2; u32x4 w0, w1, w2, w3; float sacc = 0.f; \
        A2_SB(); \
        if (HASN) { k0 = A2_KF(0, 0); k1 = A2_KF(0, 1); k2 = A2_KF(1, 0); A2_SB(); \
            N0 = A2_MF(k0, qr[0], (f32x16{})); k0 = A2_KF(1, 1); A2_E3(C0, 0);  A2_PIN(C0); A2_SB(); \
            N1 = A2_MF(k1, qr[0], (f32x16{})); k1 = A2_KF(2, 0); A2_E3(C0, 3);  A2_PIN(C0); A2_SB(); \
            N0 = A2_MF(k2, qr[1], N0);         k2 = A2_KF(2, 1); A2_E3(C0, 6);  A2_PIN(C0); A2_SB(); \
            N1 = A2_MF(k0, qr[1], N1);         k0 = A2_KF(3, 0); A2_E3(C0, 9);  A2_PIN(C0); A2_SB(); \
            N0 = A2_MF(k1, qr[2], N0);         k1 = A2_KF(3, 1); A2_E3(C0, 12); A2_PIN(C0); A2_SB(); \
            N1 = A2_MF(k2, qr[2], N1);         k2 = A2_KF(4, 0); C0[15] = A2_EX(C0[15]); A2_E2(C1, 0); A2_PIN(C0); A2_PIN(C1); A2_SB(); \
            N0 = A2_MF(k0, qr[3], N0);         k0 = A2_KF(4, 1); A2_E3(C1, 2);  A2_PIN(C1); A2_SB(); \
            N1 = A2_MF(k1, qr[3], N1);         k1 = A2_KF(5, 0); A2_E3(C1, 5);  A2_PIN(C1); A2_SB(); \
            N0 = A2_MF(k2, qr[4], N0);         k2 = A2_KF(5, 1); A2_E2(C1, 8);  A2_PK2(w0, 0, C0, 0);  A2_PIN(C1); A2_PIN(w0); A2_SB(); \
            N1 = A2_MF(k0, qr[4], N1);                           A2_E2(C1, 10); A2_PK2(w0, 2, C0, 4);  A2_PIN(C1); A2_PIN(w0); A2_SB(); \
            N0 = A2_MF(k1, qr[5], N0);         A2_VJ(vl0, vh0, 0); A2_E2(C1, 12); A2_PK2(w1, 0, C0, 8);  A2_PIN(C1); A2_PIN(w1); A2_SB(); \
            N1 = A2_MF(k2, qr[5], N1);         A2_VJ(vl1, vh1, 1); A2_E2(C1, 14); A2_PK2(w1, 2, C0, 12); A2_PIN(C1); A2_PIN(w1); A2_SB(); \
        } else { \
            _Pragma("unroll") for (int r_ = 0; r_ < 16; ++r_) { C0[r_] = A2_EX(C0[r_]); C1[r_] = A2_EX(C1[r_]); } \
            A2_PK2(w0, 0, C0, 0); A2_PK2(w0, 2, C0, 4); A2_PK2(w1, 0, C0, 8); A2_PK2(w1, 2, C0, 12); A2_VJ(vl0, vh0, 0); A2_VJ(vl1, vh1, 1); A2_SB(); \
        } \
        if ((t) > mylast) { w0 = (u32x4){0u, 0u, 0u, 0u}; w1 = w0; C0 = f32x16{}; C1 = f32x16{}; } \
        o[0] = A2_MF(__builtin_bit_cast(bf16x8, w0), A2_VF(vl0, vh0), o[0]); A2_VJ(vl2, vh2, 2); A2_PK2(w2, 0, C1, 0);  A2_S4(C0, 0);  A2_PIN(w2); A2_PIN(sacc); A2_SB(); \
        o[1] = A2_MF(__builtin_bit_cast(bf16x8, w0), A2_VF(vl1, vh1), o[1]); A2_VJ(vl0, vh0, 3); A2_PK2(w2, 2, C1, 4);  A2_S4(C0, 4);  A2_PIN(w2); A2_PIN(sacc); A2_SB(); \
        o[0] = A2_MF(__builtin_bit_cast(bf16x8, w1), A2_VF(vl2, vh2), o[0]); A2_VJ(vl1, vh1, 4); A2_PK2(w3, 0, C1, 8);  A2_S4(C0, 8);  A2_PIN(w3); A2_PIN(sacc); A2_SB(); \
        o[1] = A2_MF(__builtin_bit_cast(bf16x8, w1), A2_VF(vl0, vh0), o[1]); A2_VJ(vl2, vh2, 5); A2_PK2(w3, 2, C1, 12); A2_S4(C0, 12); A2_PIN(w3); A2_PIN(sacc); A2_SB(); \
        o[0] = A2_MF(__builtin_bit_cast(bf16x8, w2), A2_VF(vl1, vh1), o[0]); A2_VJ(vl0, vh0, 6); A2_S4(C1, 0);  A2_PIN(sacc); A2_SB(); \
        o[1] = A2_MF(__builtin_bit_cast(bf16x8, w2), A2_VF(vl2, vh2), o[1]); A2_VJ(vl1, vh1, 7); A2_S4(C1, 4);  A2_PIN(sacc); A2_SB(); \
        o[0] = A2_MF(__builtin_bit_cast(bf16x8, w3), A2_VF(vl0, vh0), o[0]); A2_S4(C1, 8);  A2_PIN(sacc); A2_SB(); \
        o[1] = A2_MF(__builtin_bit_cast(bf16x8, w3), A2_VF(vl1, vh1), o[1]); A2_S4(C1, 12); A2_PIN(sacc); A2_SB(); \
        lsum += sacc; \
        sk_next = (sk_next == 24576) ? 0 : sk_next + 12288; sv_cur = (sv_cur == 16384) ? 0 : sv_cur + 8192; \
    } while (0)
#define A2_TOP(t) do { const int t_ = (t); if (t_ - 1 <= NT - 4) { A2_WAITFULL(); } else if (t_ - 1 == NT - 3) { asm volatile("s_waitcnt vmcnt(1)" ::: "memory"); } else { asm volatile("s_waitcnt vmcnt(0)" ::: "memory"); } \
        A2_BAR(); if (t_ + 3 < NT) { glds16(kg3, (unsigned)__builtin_amdgcn_readfirstlane(kdst + dk)); if (wid < 4) glds16(kg3 + 8192, (unsigned)__builtin_amdgcn_readfirstlane(kdst + dk + 8192)); } \
        if (t_ + 2 < NT) glds16(vg2, (unsigned)__builtin_amdgcn_readfirstlane(vdst + dv)); \
        kg3 += 12288; vg2 += 8192; dk = (dk == 24576u) ? 0u : dk + 12288u; dv = (dv == 16384u) ? 0u : dv + 8192u; } while (0)
    const unsigned char* kg3 = ksrc + 3 * 12288; const unsigned char* vg2 = vsrc + 2 * 8192; unsigned dk = 0u, dv = 16384u;
    int t = 0;
    for (; t + 2 < NT; t += 2) {
        A2_TOP(t);     A2_STEP(pA0, pA1, pB0, pB1, t, true);
        A2_TOP(t + 1); A2_STEP(pB0, pB1, pA0, pA1, t + 1, true);
    }
    A2_TOP(t);     A2_STEP(pA0, pA1, pB0, pB1, t, true);
    A2_TOP(t + 1); A2_STEP(pB0, pB1, pA0, pA1, t + 1, false);
#undef A2_STEP
#undef A2_TOP
    __builtin_amdgcn_s_setprio(0);
    lsum += __shfl_xor(lsum, 32);
    if (hi == 0) wsf[32 + r32] = lsum;
    LDS_WAIT();
    LAS bf16_t* stg = (LAS bf16_t*)(shm + A2_OST) + wid * 2048;
#pragma unroll
    for (int r = 0; r < 16; ++r) { const int orow = crow(r, hi); const float il = frcp(wsf[32 + orow]);
#pragma unroll
        for (int d0 = 0; d0 < 2; ++d0) stg[orow * 64 + d0 * 32 + r32] = (bf16_t)f2bf(o[d0][r] * il); }
    LDS_WAIT();
    const bf16_t* GB = (const bf16_t*)a.out; const bf16_t* HL = (const bf16_t*)(ws + WS_GR); const bf16_t* AC = (const bf16_t*)(ws + WS_GA); bf16_t* MG = (bf16_t*)(ws + WS_XR);
#pragma unroll
    for (int i = 0; i < 4; ++i) { const int row = i * 8 + (lane >> 3), ch = lane & 7; const u32x4 yv = *(const LAS u32x4*)(stg + row * 64 + ch * 8);
        const size_t go = (size_t)(q0 + wid * 32 + row) * 1024 + h * 64 + ch * 8;
        const u32x4 gb = *(const u32x4*)(GB + go), hl = *(const u32x4*)(HL + go), ac = *(const u32x4*)(AC + go); u32x4 w;
#pragma unroll
        for (int j = 0; j < 4; ++j) { const float c0 = carry[ch * 8 + 2 * j], c1 = carry[ch * 8 + 2 * j + 1];
            w[j] = pk2(lo2f(yv[j]) * lo2f(gb[j]) + lo2f(hl[j]) + lo2f(ac[j]) * c0, hi2f(yv[j]) * hi2f(gb[j]) + hi2f(hl[j]) + hi2f(ac[j]) * c1); }
        *(u32x4*)(MG + go) = w; }
    asm volatile("s_waitcnt vmcnt(0) lgkmcnt(0)\n\ts_barrier" ::: "memory");
#undef A2_DMAK
#undef A2_DMAV
#undef A2_WAITFULL
#undef A2_BAR
}


typedef int v8i __attribute__((ext_vector_type(8)));
constexpr int A4_K = 0, A4_V = 36864, A4_WS = 53248, A4_OST = 55296;
#define A4_PVM(pw_, vf_, acc_) __builtin_amdgcn_mfma_scale_f32_32x32x64_f8f6f4(pw_, vf_, acc_, 0, 0, 0, 0x7f7f7f7f, 0, 0x7f7f7f7f)
#define A4_CV(W, j, P, b) do { int w_ = __builtin_amdgcn_cvt_pk_fp8_f32(P[b], P[(b) + 1], 0, false); W[j] = __builtin_amdgcn_cvt_pk_fp8_f32(P[(b) + 2], P[(b) + 3], w_, true); } while (0)
#define A4_VLD(vf_, d0) do { const u32x4 x0_ = *(const LAS u32x4*)(vp + (d0) * 2048), x1_ = *(const LAS u32x4*)(vp + (d0) * 2048 + 512); \
        vf_ = (v8i){(int)x0_[0], (int)x0_[1], (int)x0_[2], (int)x0_[3], (int)x1_[0], (int)x1_[1], (int)x1_[2], (int)x1_[3]}; } while (0)

__device__ __forceinline__ void attn_unit_v4(int h, int qb, CArgs a, const LAS float* carry, LAS unsigned char* shm) {
    constexpr int ABL = 0;
    const int tid = threadIdx.x, lane = tid & 63, r32 = lane & 31, hi = lane >> 5; const int wid = __builtin_amdgcn_readfirstlane(tid >> 6);
    unsigned char* ws = a.ws;
    const bf16_t* QRAW = (const bf16_t*)(ws + WS_R1); const unsigned char* KI = ws + WS_KIMG + (size_t)h * 256 * 12288; const unsigned char* VI = (const unsigned char*)a.out + 32 * MiB + (size_t)h * 256 * 4096;
    const float* CS = (const float*)(ws + WS_CS); const float* qg = (const float*)a.in[15];
    const int q0 = qb * 256, rowq = q0 + wid * 32 + r32;
    const unsigned lds0 = (unsigned)(uintptr_t)shm;
    LAS float* wsf = (LAS float*)(shm + A4_WS) + wid * 64;
    const int NT = 4 * qb + 4, mylast = 4 * qb + (wid >> 1);
    const unsigned char* ksrc = KI + wid * 1024 + lane * 16; const unsigned char* vsrc = VI + wid * 1024 + lane * 16;
    const unsigned kdst = lds0 + A4_K + wid * 1024, vdst = lds0 + A4_V + wid * 1024;
#define A4_DMAK(t, slot) do { glds16(ksrc + (size_t)(t) * 12288, (unsigned)__builtin_amdgcn_readfirstlane(kdst + (slot) * 12288)); \
        if (wid < 4) glds16(ksrc + (size_t)(t) * 12288 + 8192, (unsigned)__builtin_amdgcn_readfirstlane(kdst + (slot) * 12288 + 8192)); } while (0)
#define A4_DMAV(t, slot) do { if (wid < 4) glds16(vsrc + (size_t)(t) * 4096, (unsigned)__builtin_amdgcn_readfirstlane(vdst + (slot) * 4096)); } while (0)
#define A4_BAR() asm volatile("s_waitcnt lgkmcnt(0)\n\ts_barrier" ::: "memory")
    bf16x8 qr[6];
    {
        const bf16_t* qp = QRAW + (size_t)rowq * 1536 + h * 96 + hi * 8;
        u32x4 raw[6]; float qv[6][8]; float ss = 0.f;
#pragma unroll
        for (int d0 = 0; d0 < 6; ++d0) raw[d0] = *(const u32x4*)(qp + d0 * 16);
        A4_DMAK(0, 0); A4_DMAV(0, 0); A4_DMAK(1, 1); A4_DMAV(1, 1); A4_DMAK(2, 2);
#pragma unroll
        for (int d0 = 0; d0 < 6; ++d0)
#pragma unroll
            for (int j = 0; j < 4; ++j) { qv[d0][2 * j] = lo2f(raw[d0][j]); qv[d0][2 * j + 1] = hi2f(raw[d0][j]); ss += qv[d0][2 * j] * qv[d0][2 * j] + qv[d0][2 * j + 1] * qv[d0][2 * j + 1]; }
        ss += __shfl_xor(ss, 32);
        const float rs = rsqrtf(ss * (1.f / 96.f) + EPS);
#pragma unroll
        for (int d0 = 0; d0 < 6; ++d0) { const f32x4 g0 = *(const f32x4*)(qg + d0 * 16 + hi * 8), g1 = *(const f32x4*)(qg + d0 * 16 + hi * 8 + 4);
#pragma unroll
            for (int j = 0; j < 4; ++j) { qv[d0][j] *= rs * g0[j]; qv[d0][4 + j] *= rs * g1[j]; } }
        const f32x4 c0 = *(const f32x4*)(CS + (size_t)rowq * 32 + hi * 8), c1 = *(const f32x4*)(CS + (size_t)rowq * 32 + hi * 8 + 4), s0 = *(const f32x4*)(CS + (size_t)rowq * 32 + 16 + hi * 8), s1 = *(const f32x4*)(CS + (size_t)rowq * 32 + 16 + hi * 8 + 4);
#pragma unroll
        for (int j = 0; j < 8; ++j) { const float cs = j < 4 ? c0[j & 3] : c1[j & 3], sn = j < 4 ? s0[j & 3] : s1[j & 3]; const float x1 = qv[4][j], x2 = qv[5][j]; qv[4][j] = x1 * cs - x2 * sn; qv[5][j] = x1 * sn + x2 * cs; }
#pragma unroll
        for (int d0 = 0; d0 < 6; ++d0) { u32x4 w;
#pragma unroll
            for (int j = 0; j < 4; ++j) w[j] = pk2(qv[d0][2 * j] * C2, qv[d0][2 * j + 1] * C2);
            qr[d0] = __builtin_bit_cast(bf16x8, w); }
    }
    if (wid >= 4) __builtin_amdgcn_s_setprio(1);
    float lsum = 0.f; f32x16 o[2]; o[0] = f32x16{}; o[1] = f32x16{};
    f32x16 pA0, pA1, pB0, pB1, negm; v8i pwo = (v8i){0, 0, 0, 0, 0, 0, 0, 0};
    if (wid < 4) asm volatile("s_waitcnt vmcnt(6)" ::: "memory"); else asm volatile("s_waitcnt vmcnt(2)" ::: "memory");
    A4_BAR();
    {
        const LAS unsigned char* kp = shm + A4_K + hi * 1024 + r32 * 16;
        pA0 = f32x16{}; pA1 = f32x16{};
#pragma unroll
        for (int d0 = 0; d0 < 6; ++d0) { pA0 = A2_MF(A2_KF(d0, 0), qr[d0], pA0); pA1 = A2_MF(A2_KF(d0, 1), qr[d0], pA1); }
        float rm = fmaxf(pA0[0], pA1[0]);
#pragma unroll
        for (int r = 1; r < 16; ++r) rm = fmaxf(rm, fmaxf(pA0[r], pA1[r]));
        rm = fmaxf(rm, __shfl_xor(rm, 32));
        const float nb = 64.f - rm;
#pragma unroll
        for (int r = 0; r < 16; ++r) { pA0[r] += nb; pA1[r] += nb; negm[r] = nb; }
        asm volatile("" : "+v"(negm));
    }
    int sk_next = 12288, sv_prev = 12288;
#define A4_STEP(C0, C1, N0, N1, t, HASN, HASP) do { \
        const LAS unsigned char* kp = shm + A4_K + sk_next + hi * 1024 + r32 * 16; const LAS unsigned char* vp = shm + A4_V + sv_prev + hi * 1024 + r32 * 16; \
        bf16x8 k0, k1, k2; v8i vfa, vfb, pwn; float sacc = 0.f; \
        A2_SB(); \
        if (HASN) { k0 = A2_KF(0, 0); k1 = A2_KF(0, 1); k2 = A2_KF(1, 0); if (HASP) A4_VLD(vfa, 0); A2_SB(); \
            N0 = A2_MF(k0, qr[0], negm); k0 = A2_KF(1, 1); A3E3(C0, 0);  A2_PIN(C0); A2_SB(); \
            N1 = A2_MF(k1, qr[0], negm); k1 = A2_KF(2, 0); A3E3(C0, 3);  A2_PIN(C0); A2_SB(); \
            N0 = A2_MF(k2, qr[1], N0);   k2 = A2_KF(2, 1); A3E3(C0, 6);  A2_PIN(C0); A2_SB(); \
            N1 = A2_MF(k0, qr[1], N1);   k0 = A2_KF(3, 0); A3E3(C0, 9);  A2_PIN(C0); A2_SB(); \
            if (HASP) { o[0] = A4_PVM(pwo, vfa, o[0]); A4_VLD(vfb, 1); } A4_CV(pwn, 0, C0, 0); A4_CV(pwn, 1, C0, 4); A3S4(C0, 0); A3S4(C0, 4); A2_PIN(pwn); A2_PIN(sacc); A2_SB(); \
            N0 = A2_MF(k1, qr[2], N0);   k1 = A2_KF(3, 1); A3E3(C0, 12); A2_PIN(C0); A2_SB(); \
            N1 = A2_MF(k2, qr[2], N1);   k2 = A2_KF(4, 0); C0[15] = fexp2(C0[15]); A3E2(C1, 0); A2_PIN(C0); A2_PIN(C1); A2_SB(); \
            N0 = A2_MF(k0, qr[3], N0);   k0 = A2_KF(4, 1); A3E3(C1, 2);  A2_PIN(C1); A2_SB(); \
            N1 = A2_MF(k1, qr[3], N1);   k1 = A2_KF(5, 0); A3E3(C1, 5);  A2_PIN(C1); A2_SB(); \
            if (HASP) { o[1] = A4_PVM(pwo, vfb, o[1]); } A4_CV(pwn, 2, C0, 8); A4_CV(pwn, 3, C0, 12); A4_CV(pwn, 4, C1, 0); A4_CV(pwn, 5, C1, 4); A3S4(C0, 8); A3S4(C0, 12); A3S4(C1, 0); A3S4(C1, 4); A2_PIN(pwn); A2_PIN(sacc); A2_SB(); \
            N0 = A2_MF(k2, qr[4], N0);   k2 = A2_KF(5, 1); A3E3(C1, 8);  A2_PIN(C1); A2_SB(); \
            N1 = A2_MF(k0, qr[4], N1);                      A3E3(C1, 11); A2_PIN(C1); A2_SB(); \
            N0 = A2_MF(k1, qr[5], N0);                      A3E2(C1, 14); A4_CV(pwn, 6, C1, 8); A3S4(C1, 8); A2_PIN(C1); A2_PIN(pwn); A2_PIN(sacc); A2_SB(); \
            N1 = A2_MF(k2, qr[5], N1);                      A4_CV(pwn, 7, C1, 12); A3S4(C1, 12); A2_PIN(pwn); A2_PIN(sacc); A2_SB(); \
        } else { \
            if (HASP) { A4_VLD(vfa, 0); A4_VLD(vfb, 1); } \
            _Pragma("unroll") for (int r_ = 0; r_ < 16; ++r_) { C0[r_] = fexp2(C0[r_]); C1[r_] = fexp2(C1[r_]); } \
            if (HASP) { o[0] = A4_PVM(pwo, vfa, o[0]); o[1] = A4_PVM(pwo, vfb, o[1]); } \
            A4_CV(pwn, 0, C0, 0); A4_CV(pwn, 1, C0, 4); A4_CV(pwn, 2, C0, 8); A4_CV(pwn, 3, C0, 12); A4_CV(pwn, 4, C1, 0); A4_CV(pwn, 5, C1, 4); A4_CV(pwn, 6, C1, 8); A4_CV(pwn, 7, C1, 12); \
            A3S4(C0, 0); A3S4(C0, 4); A3S4(C0, 8); A3S4(C0, 12); A3S4(C1, 0); A3S4(C1, 4); A3S4(C1, 8); A3S4(C1, 12); A2_SB(); \
        } \
        if ((t) > mylast) { pwn = (v8i){0, 0, 0, 0, 0, 0, 0, 0}; sacc = 0.f; } \
        pwo = pwn; lsum += sacc; \
        sk_next = (sk_next == 24576) ? 0 : sk_next + 12288; sv_prev = (sv_prev == 12288) ? 0 : sv_prev + 4096; \
    } while (0)
#define A3E3(P, b) do { P[b] = fexp2(P[b]); P[(b) + 1] = fexp2(P[(b) + 1]); P[(b) + 2] = fexp2(P[(b) + 2]); } while (0)
#define A3E2(P, b) do { P[b] = fexp2(P[b]); P[(b) + 1] = fexp2(P[(b) + 1]); } while (0)
#define A3S4(P, b) do { sacc += P[b]; sacc += P[(b) + 1]; sacc += P[(b) + 2]; sacc += P[(b) + 3]; } while (0)
#define A4_TOP(t) do { const int t_ = (t); \
        if (t_ - 1 <= NT - 4) { if (wid < 4) asm volatile("s_waitcnt vmcnt(3)" ::: "memory"); else asm volatile("s_waitcnt vmcnt(1)" ::: "memory"); } \
        else if (t_ - 1 == NT - 3 && wid < 4) { asm volatile("s_waitcnt vmcnt(1)" ::: "memory"); } else { asm volatile("s_waitcnt vmcnt(0)" ::: "memory"); } \
        A4_BAR(); if (t_ + 3 < NT) { glds16(kg3, (unsigned)__builtin_amdgcn_readfirstlane(kdst + dk)); if (wid < 4) glds16(kg3 + 8192, (unsigned)__builtin_amdgcn_readfirstlane(kdst + dk + 8192)); } \
        if (t_ + 2 < NT && wid < 4) glds16(vg2, (unsigned)__builtin_amdgcn_readfirstlane(vdst + dv)); \
        kg3 += 12288; vg2 += 4096; dk = (dk == 24576u) ? 0u : dk + 12288u; dv = (dv == 12288u) ? 0u : dv + 4096u; } while (0)
    const unsigned char* kg3 = ksrc + 3 * 12288; const unsigned char* vg2 = vsrc + 2 * 4096; unsigned dk = 0u, dv = 8192u;
    A4_TOP(0); A4_STEP(pA0, pA1, pB0, pB1, 0, true, false);
    A4_TOP(1); A4_STEP(pB0, pB1, pA0, pA1, 1, true, true);
    int t = 2;
    for (; t + 2 < NT; t += 2) {
        A4_TOP(t);     A4_STEP(pA0, pA1, pB0, pB1, t, true, true);
        A4_TOP(t + 1); A4_STEP(pB0, pB1, pA0, pA1, t + 1, true, true);
    }
    A4_TOP(t);     A4_STEP(pA0, pA1, pB0, pB1, t, true, true);
    A4_TOP(t + 1); A4_STEP(pB0, pB1, pA0, pA1, t + 1, false, true);
    {
        const LAS unsigned char* vp = shm + A4_V + sv_prev + hi * 1024 + r32 * 16; v8i vfa, vfb;
        A4_VLD(vfa, 0); A4_VLD(vfb, 1); o[0] = A4_PVM(pwo, vfa, o[0]); o[1] = A4_PVM(pwo, vfb, o[1]);
    }
#undef A4_STEP
#undef A4_TOP
#undef A3E3
#undef A3E2
#undef A3S4
    __builtin_amdgcn_s_setprio(0);
    lsum += __shfl_xor(lsum, 32);
    if (hi == 0) wsf[32 + r32] = lsum;
    LDS_WAIT();
    LAS bf16_t* stg = (LAS bf16_t*)(shm + A4_OST) + wid * 2048;
#pragma unroll
    for (int r = 0; r < 16; ++r) { const int orow = crow(r, hi); const float il = frcp(wsf[32 + orow]);
#pragma unroll
        for (int d0 = 0; d0 < 2; ++d0) stg[orow * 64 + d0 * 32 + r32] = (bf16_t)f2bf(o[d0][r] * il); }
    LDS_WAIT();
    const bf16_t* GB = (const bf16_t*)a.out; const bf16_t* HL = (const bf16_t*)(ws + WS_GR); const bf16_t* AC = (const bf16_t*)(ws + WS_GA); bf16_t* MG = (bf16_t*)(ws + WS_XR);
#pragma unroll
    for (int i = 0; i < 4; ++i) { const int row = i * 8 + (lane >> 3), ch = lane & 7; const u32x4 yv = *(const LAS u32x4*)(stg + row * 64 + ch * 8);
        const size_t go = (size_t)(q0 + wid * 32 + row) * 1024 + h * 64 + ch * 8;
        const u32x4 gb = *(const u32x4*)(GB + go), hl = *(const u32x4*)(HL + go), ac = *(const u32x4*)(AC + go); u32x4 w;
#pragma unroll
        for (int j = 0; j < 4; ++j) { const float c0 = carry[ch * 8 + 2 * j], c1 = carry[ch * 8 + 2 * j + 1];
            w[j] = pk2(lo2f(yv[j]) * lo2f(gb[j]) + lo2f(hl[j]) + lo2f(ac[j]) * c0, hi2f(yv[j]) * hi2f(gb[j]) + hi2f(hl[j]) + hi2f(ac[j]) * c1); }
        *(u32x4*)(MG + go) = w; }
    asm volatile("s_waitcnt vmcnt(0) lgkmcnt(0)\n\ts_barrier" ::: "memory");
#undef A4_DMAK
#undef A4_DMAV
#undef A4_BAR
}


constexpr int A5_K = 0, A5_V = 24576, A5_WS = 40960, A5_OST = 43008;
#define A5_QKM(k8_, q8_, c_) __builtin_amdgcn_mfma_scale_f32_32x32x64_f8f6f4(k8_, q8_, c_, 0, 0, 0, 0x7f7f7f7f, 0, 0x7f7f7f7f)
#define A5_K8(kf_, kb) do { const u32x4 x0_ = *(const LAS u32x4*)(kp + (kb) * 2048), x1_ = *(const LAS u32x4*)(kp + (kb) * 2048 + 512); \
        kf_ = (v8i){(int)x0_[0], (int)x0_[1], (int)x0_[2], (int)x0_[3], (int)x1_[0], (int)x1_[1], (int)x1_[2], (int)x1_[3]}; } while (0)
#define A5_KR(d0r, kb) (*(const LAS bf16x8*)(kp + 4096 + (d0r) * 2048 + (kb) * 512))

#ifndef MK_LATEDMA
#define MK_LATEDMA 0
#endif
#ifndef MK_KD
#define MK_KD 2
#endif
#ifndef MK_VD
#define MK_VD 1
#endif
template <int ABL> __device__ __forceinline__ void attn_unit_v5(int h, int qb, CArgs a, const LAS float* carry, LAS unsigned char* shm) {
    int tid = threadIdx.x; asm volatile("" : "+v"(tid));
    const int lane = tid & 63, r32 = lane & 31, hi = lane >> 5; const int wid = __builtin_amdgcn_readfirstlane(tid >> 6);
    unsigned char* ws = a.ws;
    const bf16_t* QRAW = (const bf16_t*)(ws + WS_R1); const unsigned char* KI = ws + WS_KIMG + (size_t)h * 256 * 8192; const unsigned char* VI = (const unsigned char*)a.out + 32 * MiB + (size_t)h * 256 * 4096;
    const float* CS = (const float*)(ws + WS_CS); const float* qg = (const float*)a.in[15];
    const int q0 = qb * 256, rowq = q0 + wid * 32 + r32;
    const unsigned lds0 = (unsigned)(uintptr_t)shm;
    const int NT = 4 * qb + 4, mylast = 4 * qb + (wid >> 1);
    const unsigned char* ksrc = KI + wid * 1024 + lane * 16; const unsigned char* vsrc = VI + wid * 1024 + lane * 16;
    constexpr int KD = MK_KD, VD = MK_VD, A5_K = 0, A5_V = KD * 8192, A5_WS = A5_V + (VD + 2) * 4096, A5_OST = A5_WS + 2048;
    const unsigned kdst = lds0 + A5_K + wid * 1024, vdst = lds0 + A5_V + wid * 1024;
#define A5_DMAK(t, slot) glds16(ksrc + (size_t)(t) * 8192, (unsigned)__builtin_amdgcn_readfirstlane(kdst + (slot) * 8192))
#define A5_DMAV(t, slot) do { if (wid < 4) glds16(vsrc + (size_t)(t) * 4096, (unsigned)__builtin_amdgcn_readfirstlane(vdst + (slot) * 4096)); } while (0)
#define A5_BAR() asm volatile("s_waitcnt lgkmcnt(0)\n\ts_barrier" ::: "memory")
#define A5_VMW(n_) do { const int vw_ = (n_); if (vw_ >= 7) asm volatile("s_waitcnt vmcnt(7)" ::: "memory"); else if (vw_ == 6) asm volatile("s_waitcnt vmcnt(6)" ::: "memory"); else if (vw_ == 5) asm volatile("s_waitcnt vmcnt(5)" ::: "memory"); else if (vw_ == 4) asm volatile("s_waitcnt vmcnt(4)" ::: "memory"); \
        else if (vw_ == 3) asm volatile("s_waitcnt vmcnt(3)" ::: "memory"); else if (vw_ == 2) asm volatile("s_waitcnt vmcnt(2)" ::: "memory"); else if (vw_ == 1) asm volatile("s_waitcnt vmcnt(1)" ::: "memory"); else asm volatile("s_waitcnt vmcnt(0)" ::: "memory"); } while (0)
    v8i q8; bf16x8 qr4, qr5;
    {
        const bf16_t* qp = QRAW + (size_t)rowq * 1536 + h * 96;
        u32x4 rawn[4], rawr[2]; float qn[32], qv4[8], qv5[8]; float ss = 0.f;
#pragma unroll
        for (int i = 0; i < 4; ++i) rawn[i] = *(const u32x4*)(qp + 32 * hi + 8 * i);
        rawr[0] = *(const u32x4*)(qp + 64 + 8 * hi); rawr[1] = *(const u32x4*)(qp + 80 + 8 * hi);
        f32x4 gq[8];
#pragma unroll
        for (int i = 0; i < 8; ++i) gq[i] = *(const f32x4*)(qg + 32 * hi + 4 * i);
        const f32x4 g0 = *(const f32x4*)(qg + 64 + hi * 8), g1 = *(const f32x4*)(qg + 64 + hi * 8 + 4), g2 = *(const f32x4*)(qg + 80 + hi * 8), g3 = *(const f32x4*)(qg + 80 + hi * 8 + 4);
        const f32x4 c0 = *(const f32x4*)(CS + (size_t)rowq * 32 + hi * 8), c1 = *(const f32x4*)(CS + (size_t)rowq * 32 + hi * 8 + 4), s0 = *(const f32x4*)(CS + (size_t)rowq * 32 + 16 + hi * 8), s1 = *(const f32x4*)(CS + (size_t)rowq * 32 + 16 + hi * 8 + 4);
#pragma unroll
        for (int tp = -KD; tp < 0; ++tp) { A5_DMAK(tp + KD, tp + KD); if (tp + VD >= 0) A5_DMAV(tp + VD, tp + VD); }
#pragma unroll
        for (int i = 0; i < 4; ++i)
#pragma unroll
            for (int j = 0; j < 4; ++j) { qn[8 * i + 2 * j] = lo2f(rawn[i][j]); qn[8 * i + 2 * j + 1] = hi2f(rawn[i][j]); }
#pragma unroll
        for (int j = 0; j < 4; ++j) { qv4[2 * j] = lo2f(rawr[0][j]); qv4[2 * j + 1] = hi2f(rawr[0][j]); qv5[2 * j] = lo2f(rawr[1][j]); qv5[2 * j + 1] = hi2f(rawr[1][j]); }
#pragma unroll
        for (int j = 0; j < 32; ++j) ss += qn[j] * qn[j];
#pragma unroll
        for (int j = 0; j < 8; ++j) ss += qv4[j] * qv4[j] + qv5[j] * qv5[j];
        ss += __shfl_xor(ss, 32);
        const float rs = rsqrtf(ss * (1.f / 96.f) + EPS);
#pragma unroll
        for (int i = 0; i < 8; ++i) { const f32x4 g = gq[i];
#pragma unroll
            for (int e = 0; e < 4; ++e) qn[4 * i + e] *= rs * g[e] * 1.1779544f; }
        {
#pragma unroll
          for (int j = 0; j < 4; ++j) { qv4[j] *= rs * g0[j]; qv4[4 + j] *= rs * g1[j]; qv5[j] *= rs * g2[j]; qv5[4 + j] *= rs * g3[j]; } }
#pragma unroll
        for (int j = 0; j < 8; ++j) { const float cs = j < 4 ? c0[j & 3] : c1[j & 3], sn = j < 4 ? s0[j & 3] : s1[j & 3]; const float x1 = qv4[j], x2 = qv5[j]; qv4[j] = x1 * cs - x2 * sn; qv5[j] = x1 * sn + x2 * cs; }
#pragma unroll
        for (int v = 0; v < 8; ++v) { const int w_ = __builtin_amdgcn_cvt_pk_fp8_f32(qn[4 * v], qn[4 * v + 1], 0, false); q8[v] = __builtin_amdgcn_cvt_pk_fp8_f32(qn[4 * v + 2], qn[4 * v + 3], w_, true); }
        u32x4 w4, w5;
#pragma unroll
        for (int j = 0; j < 4; ++j) { w4[j] = pk2(qv4[2 * j] * (8.f * C2), qv4[2 * j + 1] * (8.f * C2)); w5[j] = pk2(qv5[2 * j] * (8.f * C2), qv5[2 * j + 1] * (8.f * C2)); }
        qr4 = __builtin_bit_cast(bf16x8, w4); qr5 = __builtin_bit_cast(bf16x8, w5);
    }
    if (wid >= 4) __builtin_amdgcn_s_setprio(1);
    f32x16 o[2]; o[0] = f32x16{}; o[1] = f32x16{}; f32x4 lsum = {0.f, 0.f, 0.f, 0.f};
    f32x16 pA0, pA1, pB0, pB1, negm; v8i pwo = (v8i){0, 0, 0, 0, 0, 0, 0, 0};
    int onev = ((((lane >> 4) & 1) != 0) == ((lane & 15) >= 8)) ? 0x38383838 : 0; asm volatile("" : "+v"(onev));
    const v8i ones8 = (v8i){onev, onev, onev, onev, onev, onev, onev, onev};
#define A5_SUM(pw_) lsum = __builtin_amdgcn_mfma_scale_f32_16x16x128_f8f6f4(pw_, ones8, lsum, 0, 0, 0, 0x7f7f7f7f, 0, 0x7f7f7f7f)
    A5_VMW((KD - 1) + (wid < 4 ? VD : 0));
    A5_BAR();
    {
        const LAS unsigned char* kp = shm + A5_K + hi * 1024 + r32 * 16; v8i ka, kb8;
        A5_K8(ka, 0); A5_K8(kb8, 1);
        pA0 = A5_QKM(ka, q8, (f32x16{})); pA1 = A5_QKM(kb8, q8, (f32x16{}));
        pA0 = A2_MF(A5_KR(0, 0), qr4, pA0); pA1 = A2_MF(A5_KR(0, 1), qr4, pA1); pA0 = A2_MF(A5_KR(1, 0), qr5, pA0); pA1 = A2_MF(A5_KR(1, 1), qr5, pA1);
        float rm = fmaxf(pA0[0], pA1[0]);
#pragma unroll
        for (int r = 1; r < 16; ++r) rm = fmaxf(rm, fmaxf(pA0[r], pA1[r]));
        rm = fmaxf(rm, __shfl_xor(rm, 32));
        const float nb = 64.f - rm;
#pragma unroll
        for (int r = 0; r < 16; ++r) { pA0[r] += nb; pA1[r] += nb; negm[r] = nb; }
        asm volatile("" : "+v"(negm));
    }
    int sk_next = 8192, sv_prev = (VD + 1) * 4096;
#define A5_CVU(W, j, P, b) do { if (ABL == 4) { W[j] = pwo[j]; break; } unsigned w_ = __builtin_amdgcn_cvt_pk_u8_f32(P[b], 0, 0u); w_ = __builtin_amdgcn_cvt_pk_u8_f32(P[(b) + 1], 1, w_); w_ = __builtin_amdgcn_cvt_pk_u8_f32(P[(b) + 2], 2, w_); W[j] = (int)__builtin_amdgcn_cvt_pk_u8_f32(P[(b) + 3], 3, w_); } while (0)
#define A5_STEP(C0, C1, N0, N1, t, HASN, HASP) do { \
        const LAS unsigned char* kp = shm + A5_K + sk_next + hi * 1024 + r32 * 16; const LAS unsigned char* vp = shm + A5_V + sv_prev + hi * 1024 + r32 * 16; \
        v8i ka, kb8, vfa, vfb, pwn; bf16x8 r0, r1, r2, r3; \
        A2_SB(); \
        if (HASN) { A5_K8(ka, 0); A5_K8(kb8, 1); r0 = A5_KR(0, 0); r1 = A5_KR(0, 1); A2_SB(); \
            N0 = A5_QKM(ka, q8, negm);  r2 = A5_KR(1, 0); r3 = A5_KR(1, 1); if (HASP) A4_VLD(vfa, 0); A5_CVU(pwn, 0, C0, 0); A5_CVU(pwn, 1, C0, 4); A2_PIN(pwn); A2_SB(); \
            N1 = A5_QKM(kb8, q8, negm); if (HASP) A4_VLD(vfb, 1); if (MK_LATEDMA) A5_ISSUEK(t); A5_CVU(pwn, 2, C0, 8); A5_CVU(pwn, 3, C0, 12); A2_PIN(pwn); A2_SB(); \
            if (ABL != 5) N0 = A2_MF(r0, qr4, N0); A5_CVU(pwn, 4, C1, 0); A2_PIN(pwn); A2_SB(); \
            if (ABL != 5) N1 = A2_MF(r1, qr4, N1); A5_CVU(pwn, 5, C1, 4); A2_PIN(pwn); A2_SB(); \
            if (HASP) { o[0] = A4_PVM(pwo, vfa, o[0]); } if (MK_LATEDMA) A5_ISSUEV(t); A5_CVU(pwn, 6, C1, 8); A5_CVU(pwn, 7, C1, 12); A2_PIN(pwn); A2_SB(); \
            if (ABL != 5) N0 = A2_MF(r2, qr5, N0); A2_SB(); \
            if (ABL != 5) N1 = A2_MF(r3, qr5, N1); A2_SB(); \
            if (HASP) { o[1] = A4_PVM(pwo, vfb, o[1]); } A2_SB(); \
            if (HASP && ABL != 2) { A5_SUM(pwo); } A2_SB(); \
        } else { \
            if (HASP) { A4_VLD(vfa, 0); A4_VLD(vfb, 1); } \
            A5_CVU(pwn, 0, C0, 0); A5_CVU(pwn, 1, C0, 4); A5_CVU(pwn, 2, C0, 8); A5_CVU(pwn, 3, C0, 12); A5_CVU(pwn, 4, C1, 0); A5_CVU(pwn, 5, C1, 4); A5_CVU(pwn, 6, C1, 8); A5_CVU(pwn, 7, C1, 12); \
            if (HASP) { o[0] = A4_PVM(pwo, vfa, o[0]); o[1] = A4_PVM(pwo, vfb, o[1]); A5_SUM(pwo); } A2_SB(); \
        } \
        if ((t) > mylast) { pwn = (v8i){0, 0, 0, 0, 0, 0, 0, 0}; } \
        pwo = pwn; \
        sk_next = (sk_next == (KD - 1) * 8192) ? 0 : sk_next + 8192; sv_prev = (sv_prev == (VD + 1) * 4096) ? 0 : sv_prev + 4096; \
    } while (0)
#define A5_TOP(t) do { const int t_ = (t); int c_ = 0; \
        _Pragma("unroll") for (int b_ = 1; b_ <= KD - 2; ++b_) { c_ += (t_ - b_ + KD < NT) ? 1 : 0; if (wid < 4) c_ += (t_ - b_ + VD < NT) ? 1 : 0; } \
        A5_VMW(c_); \
        if (ABL != 3) A5_BAR(); if (!MK_LATEDMA) { A5_ISSUEK(t_); A5_ISSUEV(t_); } } while (0)
#define A5_ISSUEK(t_) do { if ((t_) + KD < NT) glds16(kg3, (unsigned)__builtin_amdgcn_readfirstlane(kdst + dk)); kg3 += 8192; dk = (dk == (KD - 1) * 8192u) ? 0u : dk + 8192u; } while (0)
#define A5_ISSUEV(t_) do { if ((t_) + VD < NT && wid < 4) glds16(vg2, (unsigned)__builtin_amdgcn_readfirstlane(vdst + dv)); vg2 += 4096; dv = (dv == (VD + 1) * 4096u) ? 0u : dv + 4096u; } while (0)
    const unsigned char* kg3 = ksrc + KD * 8192; const unsigned char* vg2 = vsrc + VD * 4096; unsigned dk = 0u, dv = VD * 4096u;
    A5_TOP(0); A5_STEP(pA0, pA1, pB0, pB1, 0, true, false);
    A5_TOP(1); A5_STEP(pB0, pB1, pA0, pA1, 1, true, true);
    int t = 2;
    for (; t + 2 < NT; t += 2) {
        A5_TOP(t);     A5_STEP(pA0, pA1, pB0, pB1, t, true, true);
        A5_TOP(t + 1); A5_STEP(pB0, pB1, pA0, pA1, t + 1, true, true);
    }
    A5_TOP(t);     A5_STEP(pA0, pA1, pB0, pB1, t, true, true);
    A5_TOP(t + 1); A5_STEP(pB0, pB1, pA0, pA1, t + 1, false, true);
    {
        const LAS unsigned char* vp = shm + A5_V + sv_prev + hi * 1024 + r32 * 16; v8i vfa, vfb;
        A4_VLD(vfa, 0); A4_VLD(vfb, 1); o[0] = A4_PVM(pwo, vfa, o[0]); o[1] = A4_PVM(pwo, vfb, o[1]); A5_SUM(pwo);
    }
#undef A5_STEP
#undef A5_TOP
#undef A5_ISSUEK
#undef A5_ISSUEV
#undef A5_CVU
#undef A5_SUM
    __builtin_amdgcn_s_setprio(0);
    LAS float* sums = (LAS float*)(shm + A5_WS) + wid * 64;
    if ((lane & 7) == 0) *(LAS f32x4*)(sums + ((lane & 8) ? 16 : 0) + 4 * (lane >> 4)) = lsum;
    LDS_WAIT();
    f32x4 ls4[4];
#pragma unroll
    for (int g = 0; g < 4; ++g) ls4[g] = *(const LAS f32x4*)(sums + 8 * g + 4 * hi);
    LAS bf16_t* stg = (LAS bf16_t*)(shm + A5_OST) + wid * 2048;
#pragma unroll
    for (int r = 0; r < 16; ++r) { const int orow = crow(r, hi); const float il = frcp(ls4[r >> 2][r & 3]);
#pragma unroll
        for (int d0 = 0; d0 < 2; ++d0) stg[orow * 64 + d0 * 32 + r32] = (bf16_t)f2bf(o[d0][r] * il); }
    LDS_WAIT();
    const bf16_t* GB = (const bf16_t*)a.out; const bf16_t* HL = (const bf16_t*)(ws + WS_GR); const bf16_t* AC = (const bf16_t*)(ws + WS_GA); bf16_t* MG = (bf16_t*)(ws + WS_XR);
#pragma unroll
    for (int i = 0; i < 4; ++i) { const int row = i * 8 + (lane >> 3), ch = lane & 7; const u32x4 yv = *(const LAS u32x4*)(stg + row * 64 + ch * 8);
        const size_t go = (size_t)(q0 + wid * 32 + row) * 1024 + h * 64 + ch * 8;
        const u32x4 gb = *(const u32x4*)(GB + go), hl = *(const u32x4*)(HL + go), ac = *(const u32x4*)(AC + go); u32x4 w;
#pragma unroll
        for (int j = 0; j < 4; ++j) { const float c0 = carry[ch * 8 + 2 * j], c1 = carry[ch * 8 + 2 * j + 1];
            w[j] = pk2(lo2f(yv[j]) * lo2f(gb[j]) + lo2f(hl[j]) + lo2f(ac[j]) * c0, hi2f(yv[j]) * hi2f(gb[j]) + hi2f(hl[j]) + hi2f(ac[j]) * c1); }
        *(u32x4*)(MG + go) = w; }
    asm volatile("s_waitcnt vmcnt(0) lgkmcnt(0)\n\ts_barrier" ::: "memory");
#undef A5_DMAK
#undef A5_DMAV
#undef A5_BAR
#undef A5_VMW
}

#ifndef MK_V7
#define MK_V7 1
#endif
#ifndef MK_PFVD
#define MK_PFVD 1
#endif
#ifndef MK_PF
#define MK_PF 0
#endif
#ifndef MK_PRIO
#define MK_PRIO 1
#endif
template <int ABL> __device__ __forceinline__ void attn_block_v7(int h, int s_, CArgs a, const LAS float* carry4, LAS unsigned char* shm) {
    int tid = threadIdx.x; asm volatile("" : "+v"(tid));
    const int lane0 = tid & 63; const int wid = __builtin_amdgcn_readfirstlane(tid >> 6);
    unsigned char* ws = a.ws;
    const bf16_t* QRAW = (const bf16_t*)(ws + WS_R1); const unsigned char* KI = ws + WS_KIMG + (size_t)h * 256 * 8192; const unsigned char* VI = (const unsigned char*)a.out + 32 * MiB + (size_t)h * 256 * 4096;
    const float* CS = (const float*)(ws + WS_CS); const float* qg = (const float*)a.in[15];
    const unsigned lds0 = (unsigned)(uintptr_t)shm;
    constexpr int KD = MK_PF ? 3 : MK_KD, VD = MK_PF ? MK_PFVD : MK_VD, A5_K = 0, A5_V = KD * 8192, A5_WS = A5_V + (VD + 2) * 4096, A5_OST = A5_WS + 2048, A5_G = A5_OST + 8 * 4096;
    const unsigned kdst = lds0 + A5_K + wid * 1024, vdst = lds0 + A5_V + wid * 1024;
#define A5_DMAK(t, slot) glds16(ksrc_ + (size_t)(t) * 8192, (unsigned)__builtin_amdgcn_readfirstlane(kdst + (slot) * 8192))
#define A5_DMAV(t, slot) do { if (wid < 4) glds16(vsrc_ + (size_t)(t) * 4096, (unsigned)__builtin_amdgcn_readfirstlane(vdst + (slot) * 4096)); } while (0)
#define A5_BAR() asm volatile("s_waitcnt lgkmcnt(0)\n\ts_barrier" ::: "memory")
#define A5_VMW(n_) do { const int vw_ = (n_); if (vw_ >= 7) asm volatile("s_waitcnt vmcnt(7)" ::: "memory"); else if (vw_ == 6) asm volatile("s_waitcnt vmcnt(6)" ::: "memory"); else if (vw_ == 5) asm volatile("s_waitcnt vmcnt(5)" ::: "memory"); else if (vw_ == 4) asm volatile("s_waitcnt vmcnt(4)" ::: "memory"); \
        else if (vw_ == 3) asm volatile("s_waitcnt vmcnt(3)" ::: "memory"); else if (vw_ == 2) asm volatile("s_waitcnt vmcnt(2)" ::: "memory"); else if (vw_ == 1) asm volatile("s_waitcnt vmcnt(1)" ::: "memory"); else asm volatile("s_waitcnt vmcnt(0)" ::: "memory"); } while (0)
    LAS float* gl = (LAS float*)(shm + A5_G);
    if (tid < 96) gl[tid] = qg[tid];
    u32x4 rawn[4], rawr[2];
#define A7_LOADQ(qb_, L_) do { const int r32 = (L_) & 31, hi = (L_) >> 5; const unsigned char* ksrc_ = KI + wid * 1024 + (L_) * 16; const unsigned char* vsrc_ = VI + wid * 1024 + (L_) * 16; const int rq_ = (qb_) * 256 + wid * 32 + r32; const bf16_t* qp = QRAW + (size_t)rq_ * 1536 + h * 96; \
        _Pragma("unroll") for (int i_ = 0; i_ < 4; ++i_) rawn[i_] = *(const u32x4*)(qp + 32 * hi + 8 * i_); \
        rawr[0] = *(const u32x4*)(qp + 64 + 8 * hi); rawr[1] = *(const u32x4*)(qp + 80 + 8 * hi); \
        _Pragma("unroll") for (int tp = -KD; tp < 0; ++tp) { A5_DMAK(tp + KD, tp + KD); if (tp + VD >= 0) A5_DMAV(tp + VD, tp + VD); } } while (0)
    A7_LOADQ(s_, lane0);
    A5_BAR();
#pragma unroll 1
    for (int ui = 0; ui < 4; ++ui) {
    int lane = lane0; asm volatile("" : "+v"(lane));
    const int r32 = lane & 31, hi = lane >> 5;
    const unsigned char* ksrc = KI + wid * 1024; const unsigned char* vsrc = VI + wid * 1024; const unsigned loff = (unsigned)lane * 16u;
    int onev = ((((lane >> 4) & 1) != 0) == ((lane & 15) >= 8)) ? 0x38383838 : 0; asm volatile("" : "+v"(onev));
    const v8i ones8 = (v8i){onev, onev, onev, onev, onev, onev, onev, onev};
#define A5_SUM(pw_) lsum = __builtin_amdgcn_mfma_scale_f32_16x16x128_f8f6f4(pw_, ones8, lsum, 0, 0, 0, 0x7f7f7f7f, 0, 0x7f7f7f7f)
    const int qb = ((ui & 2) ? 32 : 0) + ((ui & 1) ? 31 - s_ : s_);
    const int q0 = qb * 256; const int NT = 4 * qb + 4, mylast = 4 * qb + (wid >> 1);
    const LAS float* carry = carry4 + ui * 64;
    v8i q8; bf16x8 qr4, qr5;
    {
        const int rowq = q0 + wid * 32 + r32;
        const f32x4 c0 = *(const f32x4*)(CS + (size_t)rowq * 32 + hi * 8), c1 = *(const f32x4*)(CS + (size_t)rowq * 32 + hi * 8 + 4), s0 = *(const f32x4*)(CS + (size_t)rowq * 32 + 16 + hi * 8), s1 = *(const f32x4*)(CS + (size_t)rowq * 32 + 16 + hi * 8 + 4);
        float qn[32], qv4[8], qv5[8]; float ss = 0.f;
        f32x4 gq[8];
#pragma unroll
        for (int i = 0; i < 8; ++i) gq[i] = *(const LAS f32x4*)(gl + 32 * hi + 4 * i);
        const f32x4 g0 = *(const LAS f32x4*)(gl + 64 + hi * 8), g1 = *(const LAS f32x4*)(gl + 64 + hi * 8 + 4), g2 = *(const LAS f32x4*)(gl + 80 + hi * 8), g3 = *(const LAS f32x4*)(gl + 80 + hi * 8 + 4);
#pragma unroll
        for (int i = 0; i < 4; ++i)
#pragma unroll
            for (int j = 0; j < 4; ++j) { qn[8 * i + 2 * j] = lo2f(rawn[i][j]); qn[8 * i + 2 * j + 1] = hi2f(rawn[i][j]); }
#pragma unroll
        for (int j = 0; j < 4; ++j) { qv4[2 * j] = lo2f(rawr[0][j]); qv4[2 * j + 1] = hi2f(rawr[0][j]); qv5[2 * j] = lo2f(rawr[1][j]); qv5[2 * j + 1] = hi2f(rawr[1][j]); }
#pragma unroll
        for (int j = 0; j < 32; ++j) ss += qn[j] * qn[j];
#pragma unroll
        for (int j = 0; j < 8; ++j) ss += qv4[j] * qv4[j] + qv5[j] * qv5[j];
        ss += __shfl_xor(ss, 32);
        const float rs = rsqrtf(ss * (1.f / 96.f) + EPS);
#pragma unroll
        for (int i = 0; i < 8; ++i) { const f32x4 g = gq[i];
#pragma unroll
            for (int e = 0; e < 4; ++e) qn[4 * i + e] *= rs * g[e] * 1.1779544f; }
        {
#pragma unroll
          for (int j = 0; j < 4; ++j) { qv4[j] *= rs * g0[j]; qv4[4 + j] *= rs * g1[j]; qv5[j] *= rs * g2[j]; qv5[4 + j] *= rs * g3[j]; } }
#pragma unroll
        for (int j = 0; j < 8; ++j) { const float cs = j < 4 ? c0[j & 3] : c1[j & 3], sn = j < 4 ? s0[j & 3] : s1[j & 3]; const float x1 = qv4[j], x2 = qv5[j]; qv4[j] = x1 * cs - x2 * sn; qv5[j] = x1 * sn + x2 * cs; }
#pragma unroll
        for (int v = 0; v < 8; ++v) { const int w_ = __builtin_amdgcn_cvt_pk_fp8_f32(qn[4 * v], qn[4 * v + 1], 0, false); q8[v] = __builtin_amdgcn_cvt_pk_fp8_f32(qn[4 * v + 2], qn[4 * v + 3], w_, true); }
        u32x4 w4, w5;
#pragma unroll
        for (int j = 0; j < 4; ++j) { w4[j] = pk2(qv4[2 * j] * (8.f * C2), qv4[2 * j + 1] * (8.f * C2)); w5[j] = pk2(qv5[2 * j] * (8.f * C2), qv5[2 * j + 1] * (8.f * C2)); }
        qr4 = __builtin_bit_cast(bf16x8, w4); qr5 = __builtin_bit_cast(bf16x8, w5);
    }
    if (MK_PRIO == 1 ? wid >= 4 : MK_PRIO == 2 ? wid < 4 : false) __builtin_amdgcn_s_setprio(1);
    f32x16 o[2]; o[0] = f32x16{}; o[1] = f32x16{}; f32x4 lsum = {0.f, 0.f, 0.f, 0.f};
    f32x16 pA0, pA1, pB0, pB1, negm; v8i pwo = (v8i){0, 0, 0, 0, 0, 0, 0, 0};
    A5_VMW((MK_PF ? KD - 2 : KD - 1) + (wid < 4 ? VD : 0));
    A5_BAR();
    {
        const LAS unsigned char* kp = shm + A5_K + hi * 1024 + r32 * 16; v8i ka, kb8;
        A5_K8(ka, 0); A5_K8(kb8, 1);
        pA0 = A5_QKM(ka, q8, (f32x16{})); pA1 = A5_QKM(kb8, q8, (f32x16{}));
        pA0 = A2_MF(A5_KR(0, 0), qr4, pA0); pA1 = A2_MF(A5_KR(0, 1), qr4, pA1); pA0 = A2_MF(A5_KR(1, 0), qr5, pA0); pA1 = A2_MF(A5_KR(1, 1), qr5, pA1);
        float rm = fmaxf(pA0[0], pA1[0]);
#pragma unroll
        for (int r = 1; r < 16; ++r) rm = fmaxf(rm, fmaxf(pA0[r], pA1[r]));
        rm = fmaxf(rm, __shfl_xor(rm, 32));
        const float nb = 64.f - rm;
#pragma unroll
        for (int r = 0; r < 16; ++r) { pA0[r] += nb; pA1[r] += nb; negm[r] = nb; }
        asm volatile("" : "+v"(negm));
    }
#if MK_PF
    v8i ka;
    { const LAS unsigned char* kp = shm + A5_K + 8192 + hi * 1024 + r32 * 16; A5_K8(ka, 0); }
    int sk_pf = 16384;
#endif
    int sk_next = 8192, sv_prev = (VD + 1) * 4096; v8i kst = q8; bf16x8 rst = qr4; if (ABL == 7) { asm volatile("" : "+v"(kst), "+v"(rst)); }
#define A5_CVU(W, j, P, b) do { if (ABL == 4) { W[j] = pwo[j]; break; } unsigned w_ = __builtin_amdgcn_cvt_pk_u8_f32(P[b], 0, 0u); w_ = __builtin_amdgcn_cvt_pk_u8_f32(P[(b) + 1], 1, w_); w_ = __builtin_amdgcn_cvt_pk_u8_f32(P[(b) + 2], 2, w_); W[j] = (int)__builtin_amdgcn_cvt_pk_u8_f32(P[(b) + 3], 3, w_); } while (0)
#define A5_STEP(C0, C1, N0, N1, t, HASN, HASP, HASN2) do { \
        const LAS unsigned char* kp = shm + A5_K + sk_next + hi * 1024 + r32 * 16; const LAS unsigned char* vp = shm + A5_V + sv_prev + hi * 1024 + r32 * 16; \
        v8i ka = kst, kb8 = kst, vfa = kst, vfb = kst, pwn; bf16x8 r0 = rst, r1 = rst, r2 = rst, r3 = rst; \
        A2_SB(); \
        if (HASN) { if (ABL != 7) { A5_K8(ka, 0); A5_K8(kb8, 1); r0 = A5_KR(0, 0); r1 = A5_KR(0, 1); } A2_SB(); \
            N0 = A5_QKM(ka, q8, negm);  if (ABL != 7) { r2 = A5_KR(1, 0); r3 = A5_KR(1, 1); if (HASP) A4_VLD(vfa, 0); } A5_CVU(pwn, 0, C0, 0); A5_CVU(pwn, 1, C0, 4); A2_PIN(pwn); A2_SB(); \
            N1 = A5_QKM(kb8, q8, negm); if (HASP && ABL != 7) A4_VLD(vfb, 1); if (MK_LATEDMA) A5_ISSUEK(t); A5_CVU(pwn, 2, C0, 8); A5_CVU(pwn, 3, C0, 12); A2_PIN(pwn); A2_SB(); \
            if (ABL != 5) N0 = A2_MF(r0, qr4, N0); A5_CVU(pwn, 4, C1, 0); A2_PIN(pwn); A2_SB(); \
            if (ABL != 5) N1 = A2_MF(r1, qr4, N1); A5_CVU(pwn, 5, C1, 4); A2_PIN(pwn); A2_SB(); \
            if (HASP) { o[0] = A4_PVM(pwo, vfa, o[0]); } if (MK_LATEDMA) A5_ISSUEV(t); A5_CVU(pwn, 6, C1, 8); A5_CVU(pwn, 7, C1, 12); A2_PIN(pwn); A2_SB(); \
            if (ABL != 5) N0 = A2_MF(r2, qr5, N0); A2_SB(); \
            if (ABL != 5) N1 = A2_MF(r3, qr5, N1); A2_SB(); \
            if (HASP) { o[1] = A4_PVM(pwo, vfb, o[1]); } A2_SB(); \
            if (HASP && ABL != 2) { A5_SUM(pwo); } A2_SB(); \
        } else { \
            if (HASP) { A4_VLD(vfa, 0); A4_VLD(vfb, 1); } \
            A5_CVU(pwn, 0, C0, 0); A5_CVU(pwn, 1, C0, 4); A5_CVU(pwn, 2, C0, 8); A5_CVU(pwn, 3, C0, 12); A5_CVU(pwn, 4, C1, 0); A5_CVU(pwn, 5, C1, 4); A5_CVU(pwn, 6, C1, 8); A5_CVU(pwn, 7, C1, 12); \
            if (HASP) { o[0] = A4_PVM(pwo, vfa, o[0]); o[1] = A4_PVM(pwo, vfb, o[1]); A5_SUM(pwo); } A2_SB(); \
        } \
        if ((t) > mylast) { pwn = (v8i){0, 0, 0, 0, 0, 0, 0, 0}; } \
        pwo = pwn; \
        sk_next = (sk_next == (KD - 1) * 8192) ? 0 : sk_next + 8192; sv_prev = (sv_prev == (VD + 1) * 4096) ? 0 : sv_prev + 4096; \
    } while (0)
#if MK_PF
#undef A5_STEP
#define A5_STEP(C0, C1, N0, N1, t, HASN, HASP, HASN2) do { \
        const LAS unsigned char* kp = shm + A5_K + sk_next + hi * 1024 + r32 * 16; const LAS unsigned char* vp = shm + A5_V + sv_prev + hi * 1024 + r32 * 16;        \
        v8i kb8, vfa, vfb, pwn; bf16x8 r0, r1, r2, r3; \
        A2_SB(); \
        if (HASN) { A5_K8(kb8, 1); r0 = A5_KR(0, 0); r1 = A5_KR(0, 1); A2_SB(); \
            N0 = A5_QKM(ka, q8, negm);  r2 = A5_KR(1, 0); r3 = A5_KR(1, 1); if (HASP) A4_VLD(vfa, 0); A5_CVU(pwn, 0, C0, 0); A5_CVU(pwn, 1, C0, 4); A2_PIN(pwn); A2_SB(); \
            N1 = A5_QKM(kb8, q8, negm); if (HASP) A4_VLD(vfb, 1); if (HASN2) { const LAS unsigned char* kp = shm + A5_K + sk_pf + hi * 1024 + r32 * 16; A5_K8(ka, 0); } A5_CVU(pwn, 2, C0, 8); A5_CVU(pwn, 3, C0, 12); A2_PIN(pwn); A2_SB(); \
            N0 = A2_MF(r0, qr4, N0); A5_CVU(pwn, 4, C1, 0); A2_PIN(pwn); A2_SB(); \
            N1 = A2_MF(r1, qr4, N1); A5_CVU(pwn, 5, C1, 4); A2_PIN(pwn); A2_SB(); \
            if (HASP) { o[0] = A4_PVM(pwo, vfa, o[0]); } A5_CVU(pwn, 6, C1, 8); A5_CVU(pwn, 7, C1, 12); A2_PIN(pwn); A2_SB(); \
            N0 = A2_MF(r2, qr5, N0); A2_SB(); \
            N1 = A2_MF(r3, qr5, N1); A2_SB(); \
            if (HASP) { o[1] = A4_PVM(pwo, vfb, o[1]); } A2_SB(); \
            if (HASP) { A5_SUM(pwo); } A2_SB(); \
        } else { \
            if (HASP) { A4_VLD(vfa, 0); A4_VLD(vfb, 1); } \
            A5_CVU(pwn, 0, C0, 0); A5_CVU(pwn, 1, C0, 4); A5_CVU(pwn, 2, C0, 8); A5_CVU(pwn, 3, C0, 12); A5_CVU(pwn, 4, C1, 0); A5_CVU(pwn, 5, C1, 4); A5_CVU(pwn, 6, C1, 8); A5_CVU(pwn, 7, C1, 12); \
            if (HASP) { o[0] = A4_PVM(pwo, vfa, o[0]); o[1] = A4_PVM(pwo, vfb, o[1]); A5_SUM(pwo); } A2_SB(); \
        } \
        if ((t) > mylast) { pwn = (v8i){0, 0, 0, 0, 0, 0, 0, 0}; } \
        pwo = pwn; \
        sk_next = (sk_next == (KD - 1) * 8192) ? 0 : sk_next + 8192; sv_prev = (sv_prev == (VD + 1) * 4096) ? 0 : sv_prev + 4096; sk_pf = (sk_pf == (KD - 1) * 8192) ? 0 : sk_pf + 8192; \
    } while (0)
#endif
#define A5_TOP(t) do { const int t_ = (t); int c_ = 0; \
        if (!MK_PF) { _Pragma("unroll") for (int b_ = 1; b_ <= KD - 2; ++b_) { c_ += (t_ - b_ + KD < NT) ? 1 : 0; if (wid < 4) c_ += (t_ - b_ + VD < NT) ? 1 : 0; } } \
        A5_VMW(c_); \
        if (ABL != 3) A5_BAR(); if (!MK_LATEDMA) { A5_ISSUEK(t_); A5_ISSUEV(t_); } } while (0)
#define A5_ISSUEK(t_) do { if ((t_) + KD < NT && ABL != 6) glds16s(kg3, loff, (unsigned)__builtin_amdgcn_readfirstlane(kdst + dk)); kg3 += 8192; dk = (dk == (KD - 1) * 8192u) ? 0u : dk + 8192u; } while (0)
#define A5_ISSUEV(t_) do { if ((t_) + VD < NT && wid < 4 && ABL != 6) glds16s(vg2, loff, (unsigned)__builtin_amdgcn_readfirstlane(vdst + dv)); vg2 += 4096; dv = (dv == (VD + 1) * 4096u) ? 0u : dv + 4096u; } while (0)
    const unsigned char* kg3 = ksrc + KD * 8192; const unsigned char* vg2 = vsrc + VD * 4096; unsigned dk = 0u, dv = VD * 4096u;
    A5_TOP(0); A5_STEP(pA0, pA1, pB0, pB1, 0, true, false, true);
    A5_TOP(1); A5_STEP(pB0, pB1, pA0, pA1, 1, true, true, true);
    int t = 2;
    for (; t + 2 < NT; t += 2) {
        A5_TOP(t);     A5_STEP(pA0, pA1, pB0, pB1, t, true, true, true);
        A5_TOP(t + 1); A5_STEP(pB0, pB1, pA0, pA1, t + 1, true, true, true);
    }
    A5_TOP(t);     A5_STEP(pA0, pA1, pB0, pB1, t, true, true, false);
    A5_TOP(t + 1); A5_STEP(pB0, pB1, pA0, pA1, t + 1, false, true, false);
#if 0
#else
    {
        const LAS unsigned char* vp = shm + A5_V + sv_prev + hi * 1024 + r32 * 16; v8i vfa, vfb;
        A4_VLD(vfa, 0); A4_VLD(vfb, 1); o[0] = A4_PVM(pwo, vfa, o[0]); o[1] = A4_PVM(pwo, vfb, o[1]); A5_SUM(pwo);
    }
#endif
#undef A5_STEP
#undef A5_TOP
#undef A5_ISSUEK
#undef A5_ISSUEV
#undef A5_CVU
    __builtin_amdgcn_s_setprio(0);
    A5_BAR();
    int lane_e = lane; asm volatile("" : "+v"(lane_e));
    const int r32e = lane_e & 31, hie = lane_e >> 5;
    if (ui < 3) { const int qbn = (((ui + 1) & 2) ? 32 : 0) + (((ui + 1) & 1) ? 31 - s_ : s_); A7_LOADQ(qbn, lane_e); }
    LAS float* sums = (LAS float*)(shm + A5_WS) + wid * 64;
    if ((lane_e & 7) == 0) *(LAS f32x4*)(sums + ((lane_e & 8) ? 16 : 0) + 4 * (lane_e >> 4)) = lsum;
    LDS_WAIT();
    f32x4 ls4[4];
#pragma unroll
    for (int g = 0; g < 4; ++g) ls4[g] = *(const LAS f32x4*)(sums + 8 * g + 4 * hie);
    LAS bf16_t* stg = (LAS bf16_t*)(shm + A5_OST) + wid * 2048;
#pragma unroll
    for (int r = 0; r < 16; ++r) { const int orow = crow(r, hie); const float il = frcp(ls4[r >> 2][r & 3]);
#pragma unroll
        for (int d0 = 0; d0 < 2; ++d0) stg[orow * 64 + d0 * 32 + r32e] = (bf16_t)f2bf(o[d0][r] * il); }
    LDS_WAIT();
    const bf16_t* GB = (const bf16_t*)a.out; const bf16_t* HL = (const bf16_t*)(ws + WS_GR); const bf16_t* AC = (const bf16_t*)(ws + WS_GA); bf16_t* MG = (bf16_t*)(ws + WS_XR);
#pragma unroll
    for (int i = 0; i < 4; ++i) { const int row = i * 8 + (lane_e >> 3), ch = lane_e & 7; const u32x4 yv = *(const LAS u32x4*)(stg + row * 64 + ch * 8);
        const size_t go = (size_t)(q0 + wid * 32 + row) * 1024 + h * 64 + ch * 8;
        const u32x4 gb = *(const u32x4*)(GB + go), hl = *(const u32x4*)(HL + go), ac = *(const u32x4*)(AC + go); u32x4 w;
#pragma unroll
        for (int j = 0; j < 4; ++j) { const float c0 = carry[ch * 8 + 2 * j], c1 = carry[ch * 8 + 2 * j + 1];
            w[j] = pk2(lo2f(yv[j]) * lo2f(gb[j]) + lo2f(hl[j]) + lo2f(ac[j]) * c0, hi2f(yv[j]) * hi2f(gb[j]) + hi2f(hl[j]) + hi2f(ac[j]) * c1); }
        *(u32x4*)(MG + go) = w; }
    A2_PIN(rawr[0]); A2_PIN(rawr[1]); A2_PIN(rawn[0]); A2_PIN(rawn[1]); A2_PIN(rawn[2]); A2_PIN(rawn[3]);
    }
#undef A5_SUM
#undef A7_LOADQ
    asm volatile("s_waitcnt vmcnt(0) lgkmcnt(0)\n\ts_barrier" ::: "memory");
#undef A5_DMAK
#undef A5_DMAV
#undef A5_BAR
#undef A5_VMW
}

#ifndef MK_V6
#define MK_V6 0
#endif
#ifndef MK_MIDBAR
#define MK_MIDBAR 0
#endif
constexpr int A6_K = 0, A6_V = 49152, A6_WS = 73728, A6_OST = 75776;
template <int ABL> __device__ __forceinline__ void attn_unit_v6(int h, int qb, CArgs a, const LAS float* carry, LAS unsigned char* shm) {
    int tid = threadIdx.x; asm volatile("" : "+v"(tid));
    const int lane = tid & 63, r32 = lane & 31, hi = lane >> 5; const int wid = __builtin_amdgcn_readfirstlane(tid >> 6);
    unsigned char* ws = a.ws;
    const bf16_t* QRAW = (const bf16_t*)(ws + WS_R1); const unsigned char* KI = ws + WS_KIMG + (size_t)h * 256 * 8192; const unsigned char* VI = (const unsigned char*)a.out + 32 * MiB + (size_t)h * 256 * 4096;
    const float* CS = (const float*)(ws + WS_CS); const float* qg = (const float*)a.in[15];
    const int q0 = qb * 256, rowq = q0 + wid * 32 + r32;
    const unsigned lds0 = (unsigned)(uintptr_t)shm;
    const int NT = 4 * qb + 4, mylast = 4 * qb + (wid >> 1);
    const unsigned char* ksrc = KI + wid * 1024 + lane * 16; const unsigned char* vsrc = VI + (wid >> 2) * 4096 + (wid & 3) * 1024 + lane * 16;
    const unsigned kdst = lds0 + A6_K + wid * 1024, vdst = lds0 + A6_V + (wid >> 2) * 4096 + (wid & 3) * 1024;
#define A5_DMAK(t, slot) glds16(ksrc + (size_t)(t) * 8192, (unsigned)__builtin_amdgcn_readfirstlane(kdst + (slot) * 8192))
#define A5_DMAV(t, slot) glds16(vsrc + (size_t)(t) * 4096, (unsigned)__builtin_amdgcn_readfirstlane(vdst + (slot) * 4096))
#define A5_BAR() asm volatile("s_waitcnt lgkmcnt(0)\n\ts_barrier" ::: "memory")
    v8i q8; bf16x8 qr4, qr5;
    {
        const bf16_t* qp = QRAW + (size_t)rowq * 1536 + h * 96;
        u32x4 rawn[4], rawr[2]; float qn[32], qv4[8], qv5[8]; float ss = 0.f;
#pragma unroll
        for (int i = 0; i < 4; ++i) rawn[i] = *(const u32x4*)(qp + 32 * hi + 8 * i);
        rawr[0] = *(const u32x4*)(qp + 64 + 8 * hi); rawr[1] = *(const u32x4*)(qp + 80 + 8 * hi);
        A5_DMAK(0, 0); A5_DMAK(1, 1); A5_DMAK(2, 2); A5_DMAK(3, 3); A5_DMAV(0, 0);
#pragma unroll
        for (int i = 0; i < 4; ++i)
#pragma unroll
            for (int j = 0; j < 4; ++j) { qn[8 * i + 2 * j] = lo2f(rawn[i][j]); qn[8 * i + 2 * j + 1] = hi2f(rawn[i][j]); }
#pragma unroll
        for (int j = 0; j < 4; ++j) { qv4[2 * j] = lo2f(rawr[0][j]); qv4[2 * j + 1] = hi2f(rawr[0][j]); qv5[2 * j] = lo2f(rawr[1][j]); qv5[2 * j + 1] = hi2f(rawr[1][j]); }
#pragma unroll
        for (int j = 0; j < 32; ++j) ss += qn[j] * qn[j];
#pragma unroll
        for (int j = 0; j < 8; ++j) ss += qv4[j] * qv4[j] + qv5[j] * qv5[j];
        ss += __shfl_xor(ss, 32);
        const float rs = rsqrtf(ss * (1.f / 96.f) + EPS);
#pragma unroll
        for (int i = 0; i < 8; ++i) { const f32x4 g = *(const f32x4*)(qg + 32 * hi + 4 * i);
#pragma unroll
            for (int e = 0; e < 4; ++e) qn[4 * i + e] *= rs * g[e] * 1.1779544f; }
        { const f32x4 g0 = *(const f32x4*)(qg + 64 + hi * 8), g1 = *(const f32x4*)(qg + 64 + hi * 8 + 4), g2 = *(const f32x4*)(qg + 80 + hi * 8), g3 = *(const f32x4*)(qg + 80 + hi * 8 + 4);
#pragma unroll
          for (int j = 0; j < 4; ++j) { qv4[j] *= rs * g0[j]; qv4[4 + j] *= rs * g1[j]; qv5[j] *= rs * g2[j]; qv5[4 + j] *= rs * g3[j]; } }
        const f32x4 c0 = *(const f32x4*)(CS + (size_t)rowq * 32 + hi * 8), c1 = *(const f32x4*)(CS + (size_t)rowq * 32 + hi * 8 + 4), s0 = *(const f32x4*)(CS + (size_t)rowq * 32 + 16 + hi * 8), s1 = *(const f32x4*)(CS + (size_t)rowq * 32 + 16 + hi * 8 + 4);
#pragma unroll
        for (int j = 0; j < 8; ++j) { const float cs = j < 4 ? c0[j & 3] : c1[j & 3], sn = j < 4 ? s0[j & 3] : s1[j & 3]; const float x1 = qv4[j], x2 = qv5[j]; qv4[j] = x1 * cs - x2 * sn; qv5[j] = x1 * sn + x2 * cs; }
#pragma unroll
        for (int v = 0; v < 8; ++v) { const int w_ = __builtin_amdgcn_cvt_pk_fp8_f32(qn[4 * v], qn[4 * v + 1], 0, false); q8[v] = __builtin_amdgcn_cvt_pk_fp8_f32(qn[4 * v + 2], qn[4 * v + 3], w_, true); }
        u32x4 w4, w5;
#pragma unroll
        for (int j = 0; j < 4; ++j) { w4[j] = pk2(qv4[2 * j] * (8.f * C2), qv4[2 * j + 1] * (8.f * C2)); w5[j] = pk2(qv5[2 * j] * (8.f * C2), qv5[2 * j + 1] * (8.f * C2)); }
        qr4 = __builtin_bit_cast(bf16x8, w4); qr5 = __builtin_bit_cast(bf16x8, w5);
    }
    if (wid >= 4) __builtin_amdgcn_s_setprio(1);
    f32x16 o[2]; o[0] = f32x16{}; o[1] = f32x16{}; f32x4 lsum = {0.f, 0.f, 0.f, 0.f};
    f32x16 pA0, pA1, pB0, pB1, negm; v8i pwo = (v8i){0, 0, 0, 0, 0, 0, 0, 0};
    int onev = ((((lane >> 4) & 1) != 0) == ((lane & 15) >= 8)) ? 0x38383838 : 0; asm volatile("" : "+v"(onev));
    const v8i ones8 = (v8i){onev, onev, onev, onev, onev, onev, onev, onev};
#define A5_SUM(pw_) lsum = __builtin_amdgcn_mfma_scale_f32_16x16x128_f8f6f4(pw_, ones8, lsum, 0, 0, 0, 0x7f7f7f7f, 0, 0x7f7f7f7f)
    asm volatile("s_waitcnt vmcnt(3)" ::: "memory");
    A5_BAR();
    if (NT > 5) { A5_DMAK(4, 4); A5_DMAK(5, 5); } A5_DMAV(2, 2);
    {
        const LAS unsigned char* kp = shm + A6_K + hi * 1024 + r32 * 16; v8i ka, kb8;
        A5_K8(ka, 0); A5_K8(kb8, 1);
        pA0 = A5_QKM(ka, q8, (f32x16{})); pA1 = A5_QKM(kb8, q8, (f32x16{}));
        pA0 = A2_MF(A5_KR(0, 0), qr4, pA0); pA1 = A2_MF(A5_KR(0, 1), qr4, pA1); pA0 = A2_MF(A5_KR(1, 0), qr5, pA0); pA1 = A2_MF(A5_KR(1, 1), qr5, pA1);
        float rm = fmaxf(pA0[0], pA1[0]);
#pragma unroll
        for (int r = 1; r < 16; ++r) rm = fmaxf(rm, fmaxf(pA0[r], pA1[r]));
        rm = fmaxf(rm, __shfl_xor(rm, 32));
        const float nb = 64.f - rm;
#pragma unroll
        for (int r = 0; r < 16; ++r) { pA0[r] += nb; pA1[r] += nb; negm[r] = nb; }
        asm volatile("" : "+v"(negm));
    }
    int sk_next = 8192, sv_prev = 20480;
#define A5_CVU(W, j, P, b) do { if (ABL == 4) { W[j] = pwo[j]; break; } unsigned w_ = __builtin_amdgcn_cvt_pk_u8_f32(P[b], 0, 0u); w_ = __builtin_amdgcn_cvt_pk_u8_f32(P[(b) + 1], 1, w_); w_ = __builtin_amdgcn_cvt_pk_u8_f32(P[(b) + 2], 2, w_); W[j] = (int)__builtin_amdgcn_cvt_pk_u8_f32(P[(b) + 3], 3, w_); } while (0)
#define A5_STEP(C0, C1, N0, N1, t, HASN, HASP) do { \
        const LAS unsigned char* kp = shm + A6_K + sk_next + hi * 1024 + r32 * 16; const LAS unsigned char* vp = shm + A6_V + sv_prev + hi * 1024 + r32 * 16; \
        v8i ka, kb8, vfa, vfb, pwn; bf16x8 r0, r1, r2, r3; \
        A2_SB(); \
        if (HASN) { A5_K8(ka, 0); A5_K8(kb8, 1); r0 = A5_KR(0, 0); r1 = A5_KR(0, 1); A2_SB(); \
            N0 = A5_QKM(ka, q8, negm);  r2 = A5_KR(1, 0); r3 = A5_KR(1, 1); if (HASP) A4_VLD(vfa, 0); A5_CVU(pwn, 0, C0, 0); A5_CVU(pwn, 1, C0, 4); A2_PIN(pwn); A2_SB(); \
            N1 = A5_QKM(kb8, q8, negm); if (HASP) A4_VLD(vfb, 1); A5_CVU(pwn, 2, C0, 8); A5_CVU(pwn, 3, C0, 12); A2_PIN(pwn); A2_SB(); \
            if (ABL != 5) N0 = A2_MF(r0, qr4, N0); A5_CVU(pwn, 4, C1, 0); A2_PIN(pwn); A2_SB(); \
            if (ABL != 5) N1 = A2_MF(r1, qr4, N1); A5_CVU(pwn, 5, C1, 4); A2_PIN(pwn); A2_SB(); \
            if (HASP) { o[0] = A4_PVM(pwo, vfa, o[0]); } A5_CVU(pwn, 6, C1, 8); A5_CVU(pwn, 7, C1, 12); A2_PIN(pwn); A2_SB(); \
            if (ABL != 5) N0 = A2_MF(r2, qr5, N0); A2_SB(); \
            if (ABL != 5) N1 = A2_MF(r3, qr5, N1); A2_SB(); \
            if (HASP) { o[1] = A4_PVM(pwo, vfb, o[1]); } A2_SB(); \
            if (HASP && ABL != 2) { A5_SUM(pwo); } A2_SB(); \
        } else { \
            if (HASP) { A4_VLD(vfa, 0); A4_VLD(vfb, 1); } \
            A5_CVU(pwn, 0, C0, 0); A5_CVU(pwn, 1, C0, 4); A5_CVU(pwn, 2, C0, 8); A5_CVU(pwn, 3, C0, 12); A5_CVU(pwn, 4, C1, 0); A5_CVU(pwn, 5, C1, 4); A5_CVU(pwn, 6, C1, 8); A5_CVU(pwn, 7, C1, 12); \
            if (HASP) { o[0] = A4_PVM(pwo, vfa, o[0]); o[1] = A4_PVM(pwo, vfb, o[1]); A5_SUM(pwo); } A2_SB(); \
        } \
        if ((t) > mylast) { pwn = (v8i){0, 0, 0, 0, 0, 0, 0, 0}; } \
        pwo = pwn; \
        sk_next = (sk_next == 40960) ? 0 : sk_next + 8192; sv_prev = (sv_prev == 20480) ? 0 : sv_prev + 4096; \
    } while (0)
#define A5_TOP(t) do { const int t_ = (t); \
        if (t_ + 4 < NT) asm volatile("s_waitcnt vmcnt(3)" ::: "memory"); else if (t_ + 2 < NT) asm volatile("s_waitcnt vmcnt(1)" ::: "memory"); else asm volatile("s_waitcnt vmcnt(0)" ::: "memory"); \
        if (ABL != 3) A5_BAR(); \
        if (t_ + 6 < NT) { glds16(kg5, (unsigned)__builtin_amdgcn_readfirstlane(kdst + dk)); glds16(kg5 + 8192, (unsigned)__builtin_amdgcn_readfirstlane(kdst + dk + 8192u)); } \
        if (t_ + 4 < NT) glds16(vg3, (unsigned)__builtin_amdgcn_readfirstlane(vdst + dv)); \
        kg5 += 16384; vg3 += 8192; dk = (dk == 32768u) ? 0u : dk + 16384u; dv = (dv == 16384u) ? 0u : dv + 8192u; } while (0)
    const unsigned char* kg5 = ksrc + 6 * 8192; const unsigned char* vg3 = vsrc + 4 * 4096; unsigned dk = 0u, dv = 16384u;
    A5_STEP(pA0, pA1, pB0, pB1, 0, true, false);
    int t = 1;
    for (; t + 2 < NT; t += 2) {
        A5_TOP(t);
        A5_STEP(pB0, pB1, pA0, pA1, t, true, true);
        if (MK_MIDBAR) A5_BAR();
        A5_STEP(pA0, pA1, pB0, pB1, t + 1, true, true);
    }
    A5_TOP(t); A5_STEP(pB0, pB1, pA0, pA1, t, false, true);
    {
        const LAS unsigned char* vp = shm + A6_V + sv_prev + hi * 1024 + r32 * 16; v8i vfa, vfb;
        A4_VLD(vfa, 0); A4_VLD(vfb, 1); o[0] = A4_PVM(pwo, vfa, o[0]); o[1] = A4_PVM(pwo, vfb, o[1]); A5_SUM(pwo);
    }
#undef A5_STEP
#undef A5_TOP
#undef A5_CVU
#undef A5_SUM
    __builtin_amdgcn_s_setprio(0);
    LAS float* sums = (LAS float*)(shm + A6_WS) + wid * 64;
    if ((lane & 7) == 0) *(LAS f32x4*)(sums + ((lane & 8) ? 16 : 0) + 4 * (lane >> 4)) = lsum;
    LDS_WAIT();
    f32x4 ls4[4];
#pragma unroll
    for (int g = 0; g < 4; ++g) ls4[g] = *(const LAS f32x4*)(sums + 8 * g + 4 * hi);
    LAS bf16_t* stg = (LAS bf16_t*)(shm + A6_OST) + wid * 2048;
#pragma unroll
    for (int r = 0; r < 16; ++r) { const int orow = crow(r, hi); const float il = frcp(ls4[r >> 2][r & 3]);
#pragma unroll
        for (int d0 = 0; d0 < 2; ++d0) stg[orow * 64 + d0 * 32 + r32] = (bf16_t)f2bf(o[d0][r] * il); }
    LDS_WAIT();
    const bf16_t* GB = (const bf16_t*)a.out; const bf16_t* HL = (const bf16_t*)(ws + WS_GR); const bf16_t* AC = (const bf16_t*)(ws + WS_GA); bf16_t* MG = (bf16_t*)(ws + WS_XR);
#pragma unroll
    for (int i = 0; i < 4; ++i) { const int row = i * 8 + (lane >> 3), ch = lane & 7; const u32x4 yv = *(const LAS u32x4*)(stg + row * 64 + ch * 8);
        const size_t go = (size_t)(q0 + wid * 32 + row) * 1024 + h * 64 + ch * 8;
        const u32x4 gb = *(const u32x4*)(GB + go), hl = *(const u32x4*)(HL + go), ac = *(const u32x4*)(AC + go); u32x4 w;
#pragma unroll
        for (int j = 0; j < 4; ++j) { const float c0 = carry[ch * 8 + 2 * j], c1 = carry[ch * 8 + 2 * j + 1];
            w[j] = pk2(lo2f(yv[j]) * lo2f(gb[j]) + lo2f(hl[j]) + lo2f(ac[j]) * c0, hi2f(yv[j]) * hi2f(gb[j]) + hi2f(hl[j]) + hi2f(ac[j]) * c1); }
        *(u32x4*)(MG + go) = w; }
    asm volatile("s_waitcnt vmcnt(0) lgkmcnt(0)\n\ts_barrier" ::: "memory");
#undef A5_DMAK
#undef A5_DMAV
#undef A5_BAR
}

template <int ABL> __device__ __forceinline__ void p3_attention(Frame& F, CArgs a) {
    if (ABL == 9) {
        f32x16 c0 = f32x16{}, c1 = f32x16{}, c2 = f32x16{}, c3 = f32x16{}; f32x4 c4 = {0.f, 0.f, 0.f, 0.f};
        v8i x = (v8i){(int)F.tid, 1, 2, 3, 4, 5, 6, 7}; bf16x8 y = __builtin_bit_cast(bf16x8, (u32x4){(unsigned)F.tid, 1u, 2u, 3u});
#pragma unroll 1
        for (int it = 0; it < 520; ++it) {
            c0 = __builtin_amdgcn_mfma_scale_f32_32x32x64_f8f6f4(x, x, c0, 0, 0, 0, 0x7f7f7f7f, 0, 0x7f7f7f7f); c1 = __builtin_amdgcn_mfma_scale_f32_32x32x64_f8f6f4(x, x, c1, 0, 0, 0, 0x7f7f7f7f, 0, 0x7f7f7f7f);
            c2 = __builtin_amdgcn_mfma_f32_32x32x16_bf16(y, y, c2, 0, 0, 0); c3 = __builtin_amdgcn_mfma_f32_32x32x16_bf16(y, y, c3, 0, 0, 0);
            c0 = __builtin_amdgcn_mfma_scale_f32_32x32x64_f8f6f4(x, x, c0, 0, 0, 0, 0x7f7f7f7f, 0, 0x7f7f7f7f);
            c2 = __builtin_amdgcn_mfma_f32_32x32x16_bf16(y, y, c2, 0, 0, 0); c3 = __builtin_amdgcn_mfma_f32_32x32x16_bf16(y, y, c3, 0, 0, 0);
            c1 = __builtin_amdgcn_mfma_scale_f32_32x32x64_f8f6f4(x, x, c1, 0, 0, 0, 0x7f7f7f7f, 0, 0x7f7f7f7f);
            c4 = __builtin_amdgcn_mfma_scale_f32_16x16x128_f8f6f4(x, x, c4, 0, 0, 0, 0x7f7f7f7f, 0, 0x7f7f7f7f);
        }
        asm volatile("" :: "v"(c0), "v"(c1), "v"(c2), "v"(c3), "v"(c4));
        return;
    }
    const int head = (F.vcu >> 4) & 15, s = F.vcu & 15; const int qbs[4] = {s, 31 - s, 32 + s, 63 - s};
    LAS float* carry = (LAS float*)(F.lds + LDS_XCH);
    if (F.wave == 0) {
        const float* HEND = (const float*)(a.ws + WS_MISC + MISC_HEND); const float* AEND = (const float*)(a.ws + WS_MISC + MISC_AEND); const int c = head * 64 + LANE_NOW(); float cr = 0.f;
        for (int k = 0; k < 64; ++k) {
#pragma unroll
            for (int i = 0; i < 4; ++i) if (k == qbs[i]) carry[i * 64 + LANE_NOW()] = cr;
            cr = AEND[(size_t)k * 1024 + c] * cr + HEND[(size_t)k * 1024 + c];
        }
    }
    LDS_WAIT(); __syncthreads();
    if (F.vcu < 256)
        if (MK_FP8V && MK_FP8K && MK_V7) attn_block_v7<ABL>(head, s, a, carry, F.lds); else
        for (int i = 0; i < 4; ++i) { if (MK_FP8V && MK_FP8K && MK_V6) attn_unit_v6<ABL>(head, qbs[i], a, carry + i * 64, F.lds); else if (MK_FP8V && MK_FP8K) attn_unit_v5<ABL>(head, qbs[i], a, carry + i * 64, F.lds); else if (MK_FP8V) attn_unit_v4(head, qbs[i], a, carry + i * 64, F.lds); else attn_unit_v2<ABL>(head, qbs[i], a, carry + i * 64, F.lds); }
}

template <bool DRY> __device__ __forceinline__ void p6_route(Frame& F, CArgs a) {
    unsigned char* ws = a.ws; const float* H = a.out; const float* WR = (const float*)(ws + WS_MISC + MISC_WR);
    float* RH = (float*)(ws + WS_CTL + CTL_SSQ_H); const float* PH = (const float*)(ws + WS_SSQP + SSQP_H);
    const float* bg = (const float*)a.in[20]; const float* be = (const float*)a.in[22];
    unsigned* cnt = (unsigned*)(ws + WS_CTL) + CW_CNT; int* lists = (int*)(ws + WS_LIST); float* cwl = (float*)(ws + WS_LIST + 2 * MiB); unsigned* tokinfo = (unsigned*)(ws + WS_MISC + MISC_TOK);
    const int lane = LANE_NOW(), r = lane & 15, kq = lane >> 4, w4 = F.wave & 3, kh = F.wave >> 2;
    LAS float* lg = (LAS float*)F.lds + F.wave * (16 * 48);
    for (int rb0 = F.vcu * 4; rb0 < M / 16; rb0 += F.G * 4) {
        const int rb_ = rb0 + w4, rb = rb_ < M / 16 ? rb_ : M / 16 - 1;
        const float* hp = H + (size_t)(rb * 16 + r) * 1024 + 4 * kq + 512 * kh;
        const int c0 = r, c1 = 16 + r, c2 = (32 + r < 36) ? 32 + r : 35;
        const float* w0 = WR + (size_t)c0 * 1024 + 4 * kq + 512 * kh; const float* w1 = WR + (size_t)c1 * 1024 + 4 * kq + 512 * kh; const float* w2 = WR + (size_t)c2 * 1024 + 4 * kq + 512 * kh;
        f32x4 acc0 = {0.f, 0.f, 0.f, 0.f}, acc1 = acc0, acc2 = acc0;
#pragma unroll 8
        for (int S = 0; S < 32; ++S) {
            const f32x4 av = *(const f32x4*)(hp + 16 * S), b0 = *(const f32x4*)(w0 + 16 * S), b1 = *(const f32x4*)(w1 + 16 * S), b2 = *(const f32x4*)(w2 + 16 * S);
#pragma unroll
            for (int s4 = 0; s4 < 4; ++s4) { acc0 = __builtin_amdgcn_mfma_f32_16x16x4f32(av[s4], b0[s4], acc0, 0, 0, 0); acc1 = __builtin_amdgcn_mfma_f32_16x16x4f32(av[s4], b1[s4], acc1, 0, 0, 0); acc2 = __builtin_amdgcn_mfma_f32_16x16x4f32(av[s4], b2[s4], acc2, 0, 0, 0); }
        }
#pragma unroll
        for (int i = 0; i < 4; ++i) { lg[(4 * kq + i) * 48 + r] = acc0[i]; lg[(4 * kq + i) * 48 + 16 + r] = acc1[i]; lg[(4 * kq + i) * 48 + 32 + r] = acc2[i]; }
        LDS_WAIT(); __syncthreads();
        if (kh == 0 && lane < 16 && rb_ < M / 16) {
            const int tok = rb * 16 + lane; const float* pp = PH + (size_t)tok * 16; const f32x4 a0 = *(const f32x4*)pp, a1 = *(const f32x4*)(pp + 4), a2 = *(const f32x4*)(pp + 8), a3 = *(const f32x4*)(pp + 12);
            const float sh = (((a0[0] + a0[1]) + (a0[2] + a0[3])) + ((a1[0] + a1[1]) + (a1[2] + a1[3]))) + (((a2[0] + a2[1]) + (a2[2] + a2[3])) + ((a3[0] + a3[1]) + (a3[2] + a3[3])));
            const float rs = rsqrtf(sh * (1.f / 1024.f) + EPS);
            const LAS float* lr = lg + lane * 48; const LAS float* lr2 = lr + 4 * (16 * 48);
            float gl[4];
#pragma unroll
            for (int q = 0; q < 4; ++q) gl[q] = (lr[q] + lr2[q]) * rs + bg[q];
            int g = 0; float mx = gl[0];
#pragma unroll
            for (int q = 1; q < 4; ++q) if (gl[q] > mx) { mx = gl[q]; g = q; }
            float den = 0.f;
#pragma unroll
            for (int q = 0; q < 4; ++q) den += expf(gl[q] - mx);
            const float pg = 1.f / den;
            float v1 = -INFINITY, v2 = -INFINITY; int i1 = 0, i2 = 0;
#pragma unroll
            for (int q = 0; q < 8; ++q) { const float v = (lr[4 + g * 8 + q] + lr2[4 + g * 8 + q]) * rs + be[g * 8 + q];
                if (v > v1) { v2 = v1; i2 = i1; v1 = v; i1 = q; } else if (v > v2) { v2 = v; i2 = q; } }
            const float e2 = expf(v2 - v1), s1 = 1.f / (1.f + e2), s2 = e2 * s1; const int e1 = g * 8 + i1, eb = g * 8 + i2;
            if (DRY) { asm volatile("" :: "v"(s1 + s2 + pg), "v"(e1 + eb)); }
            else {
                RH[tok] = rs;
                const unsigned sl1 = atomicAdd(cnt + e1, 1u), sl2 = atomicAdd(cnt + eb, 1u);
                lists[(size_t)e1 * M + sl1] = tok; cwl[(size_t)e1 * M + sl1] = pg * s1; lists[(size_t)eb * M + sl2] = tok; cwl[(size_t)eb * M + sl2] = pg * s2;
                tokinfo[tok * 2] = ((unsigned)e1 << 16) | sl1; tokinfo[tok * 2 + 1] = ((unsigned)eb << 16) | sl2;
            }
        }
        LDS_WAIT(); __syncthreads();
    }
}

__device__ __forceinline__ void moe_prefix(Frame& F, CArgs a, volatile LAS int* tpre, volatile LAS int* cnts) {
    const unsigned* cnt = (const unsigned*)(a.ws + WS_CTL) + CW_CNT;
    if (F.wave == 0) {
        int ln = threadIdx.x; asm volatile("" : "+v"(ln)); ln &= 63; const int e = ln & 31; const int c = (int)__hip_atomic_load(cnt + e, RLX_AGENT); const int nt_ = (c + 255) >> 8; int inc = nt_;
#pragma unroll
        for (int d = 1; d < 32; d <<= 1) { const int v = __shfl_up(inc, d); if (e >= d) inc += v; }
        const int exc = inc - nt_;
        if (ln < 32) { tpre[e] = exc; cnts[e] = c; for (int q = 0; q < nt_; ++q) tpre[80 + exc + q] = e; if (e == 31) tpre[32] = inc; }
    }
    LDS_WAIT(); __syncthreads();
}

template <bool DRY> __device__ __forceinline__ void p8_final(Frame& F, CArgs a, const volatile LAS int* tpre) {
    float* out = a.out; const unsigned char* Y = (const unsigned char*)(a.ws + WS_Y); const unsigned* tokinfo = (const unsigned*)(a.ws + WS_MISC + MISC_TOK);
    const int gw = F.vcu * NWAVES + F.wave, NGW = F.G * NWAVES, lane = LANE_NOW();
    for (int tok = gw; tok < M; tok += NGW) {
        const unsigned i0 = tokinfo[tok * 2], i1 = tokinfo[tok * 2 + 1];
        const size_t s0 = (size_t)tpre[i0 >> 16] * 256 + (i0 & 0xffffu), s1 = (size_t)tpre[i1 >> 16] * 256 + (i1 & 0xffffu);
        const size_t c = 16 * lane; const u32x4 y0 = *(const u32x4*)(Y + s0 * 1024 + c), y1 = *(const u32x4*)(Y + s1 * 1024 + c);
#pragma unroll
        for (int q = 0; q < 4; ++q) { f32x4 h = *(const f32x4*)(out + (size_t)tok * 1024 + c + 4 * q);
            const f32x2 a01 = __builtin_amdgcn_cvt_pk_f32_fp8((int)y0[q], false), a23 = __builtin_amdgcn_cvt_pk_f32_fp8((int)y0[q], true), b01 = __builtin_amdgcn_cvt_pk_f32_fp8((int)y1[q], false), b23 = __builtin_amdgcn_cvt_pk_f32_fp8((int)y1[q], true);
            h[0] += (a01[0] + b01[0]) * 0.125f; h[1] += (a01[1] + b01[1]) * 0.125f; h[2] += (a23[0] + b23[0]) * 0.125f; h[3] += (a23[1] + b23[1]) * 0.125f;
            if (DRY) asm volatile("" :: "v"(h)); else *(f32x4*)(out + (size_t)tok * 1024 + c + 4 * q) = h; }
    }
}
constexpr int NPHASE = 10;
#ifndef MK_ONE_LAUNCH
#define MK_ONE_LAUNCH 1
#endif
#ifndef MK_DRY
#define MK_DRY 0
#endif
__global__ void __launch_bounds__(NTHREADS, 2) mega(Args a) {
    extern __shared__ __attribute__((aligned(16))) unsigned char lds_raw[];
    Frame F;
    F.lds = (LAS unsigned char*)lds_raw; F.MISC = (volatile LAS unsigned*)(F.lds + MISC_OFF);
    F.tid = threadIdx.x; F.lane = F.tid & 63; F.wave = __builtin_amdgcn_readfirstlane(F.tid >> 6);
    F.G = gridDim.x; { const int bx = blockIdx.x; F.vcu = (F.G % 8 == 0) ? (bx % 8) * (F.G / 8) + bx / 8 : bx; }
    const __attribute__((address_space(4))) Args* ap0 = (const __attribute__((address_space(4))) Args*)__builtin_amdgcn_kernarg_segment_ptr();
#define KA() (*({ const __attribute__((address_space(4))) Args* p_ = ap0; asm volatile("" : "+s"(p_)); p_; }))
    unsigned char* ws = a.ws; F.ctl = (gu32*)(ws + WS_CTL);
    for (int u = F.tid; u < (LDS_BYTES - LDSCTL_OFF) / 4; u += NTHREADS) ((LAS unsigned*)(F.lds + LDSCTL_OFF))[u] = 0u;
    __syncthreads();
    const int lo = a.ph_lo, hi = a.ph_hi;
    XcdBarrier bar; bar.bar = (unsigned*)(F.ctl + CW_BAR); bar.x = 0; bar.st = nullptr;
    if (hi - lo > 1) bar = xcd_barrier_post((unsigned*)(F.ctl + CW_BAR), F.MISC + 8);
#ifndef PH_MASK
#define PH_MASK 0x3ff
#endif
#define IN(k) (((PH_MASK >> (k)) & 1) && lo <= (k) && (k) < hi)
#ifdef MK_STAMPS
#define STAMP(k) do { if (blockIdx.x == 0 && F.tid == 0) ((unsigned long long*)(ws + WS_CTL + 400000))[k] = __builtin_amdgcn_s_memrealtime(); } while (0)
#else
#define STAMP(k) do {} while (0)
#endif
#ifndef MK_DOUBLE_MASK
#define MK_DOUBLE_MASK 0
#endif
#define REP(k) for (int rep_ = 0; rep_ < (((MK_DOUBLE_MASK >> (k)) & 1) ? 2 : 1); ++rep_)
#define SEAM(k) do { if (IN(k) && IN((k) + 1)) xcd_barrier(bar); STAMP((k) + 1); } while (0)
    volatile LAS int* tpre = (volatile LAS int*)(F.lds + LDS_XCH + 8192); volatile LAS int* cnts = tpre + 40;
    const int bx = (int)blockIdx.x;

    STAMP(0);
    if (IN(0)) REP(0) { p0_prologue(F, KA()); SEAM(0); }
    if (IN(1) && MK_DRY == 1) {
        DenseOrder S; S.init(M, 5120, F.G, bx, ws + WS_R1, ws + WS_WIN, 1024, 1024);
        EpiProj E{(bf16_t*)(ws + WS_XR), (bf16_t*)(ws + WS_GR), (bf16_t*)(ws + WS_QC), (bf16_t*)(ws + WS_KVC), (bf16_t*)(ws + WS_GA), (bf16_t*)KA().out, (bf16_t*)(ws + WS_MISC + MISC_HALO), (float*)(ws + WS_KPE), (float*)(ws + WS_SSQP), (float*)(ws + WS_SSQP + SSQP_KV)};
        gemm_phase<EpiProj, DenseOrder, true>(F.lds, 1024, 1024, S, E);
        xcd_barrier(bar);
    }
    if (IN(6) && MK_DRY == 60) { moe_weight_convert(F, KA(), 0, F.vcu, F.G); xcd_barrier(bar); }
    if (IN(1)) REP(1) {
        DenseOrder S; S.init(M, 5120, F.G, bx, ws + WS_R1, ws + WS_WIN, 1024, 1024);
        EpiProj E{(bf16_t*)(ws + WS_XR), (bf16_t*)(ws + WS_GR), (bf16_t*)(ws + WS_QC), (bf16_t*)(ws + WS_KVC), (bf16_t*)(ws + WS_GA), (bf16_t*)KA().out, (bf16_t*)(ws + WS_MISC + MISC_HALO), (float*)(ws + WS_KPE), (float*)(ws + WS_SSQP), (float*)(ws + WS_SSQP + SSQP_KV)};
        gemm_phase<EpiProj, DenseOrder, true>(F.lds, 1024, 1024, S, E);
        SEAM(1);
    }
    if (IN(2)) { if (MK_DRY == 2) { p2a_conv<true>(F, KA()); xcd_barrier(bar); } p2a_conv<false>(F, KA()); SEAM(2); }
    if (IN(3)) {
        typedef EpiLruT<false> EpiLru;
#define P3_LRU() do { EpiLru EL{(const bf16_t*)(ws + WS_XR), (const float*)KA().in[7], (const float*)KA().in[9], (const float*)KA().in[10], (bf16_t*)(ws + WS_GR), (bf16_t*)(ws + WS_GA), (float*)(ws + WS_MISC + MISC_HEND), (float*)(ws + WS_MISC + MISC_AEND)}; \
            for (int half = 0; half < 2; ++half) { OneOrder S{half * F.G, 8, (const char*)(ws + WS_XR), (const char*)(ws + WS_WLRU), (size_t)256 * 1024 * 2, (size_t)256 * 256 * 2, 512, bx, 512}; \
                gemm_phase<EpiLru, OneOrder, false>(F.lds, 256, 1024, S, EL); } } while (0)
#define P3_QKV() do { \
            { DenseOrder S; S.init(M, 1536, F.G, bx, ws + WS_QC, ws + WS_WUQ, 768, 768, 0, 0, 1); EpiQ E{(bf16_t*)(ws + WS_R1), (float*)(ws + WS_CTL + CTL_SSQ_Q)}; gemm_phase<EpiQ, DenseOrder, true, true, 0x7a7a7a7a>(F.lds, 768, 768, S, E); } \
            { DenseOrder S; S.init(M, 2048, F.G, bx, ws + WS_KVC, ws + WS_WUKV, 256, 256, 0, 0, 1); if (F.G == 256) { S.skew_h = 128; S.skew_a = 1; S.skew_b = 3; } \
              EpiKV E{ws + WS_KIMG, (unsigned char*)KA().out + 32 * MiB, (float*)(ws + WS_CTL + CTL_SSQ_KV), (const float*)(ws + WS_MISC + MISC_KSSQ), (const float*)(ws + WS_KPE), (const float*)KA().in[16]}; \
              gemm_phase<EpiKV, DenseOrder, true, true, 0x7b7b7b7b>(F.lds, 256, 256, S, E); } } while (0)
        if (MK_DRY == 3) { typedef EpiLruT<true> EpiLruD;
            EpiLruD EL{(const bf16_t*)(ws + WS_XR), (const float*)KA().in[7], (const float*)KA().in[9], (const float*)KA().in[10], (bf16_t*)(ws + WS_GR), (bf16_t*)(ws + WS_GA), (float*)(ws + WS_MISC + MISC_HEND), (float*)(ws + WS_MISC + MISC_AEND)};
#ifndef MK_DRY3
#define MK_DRY3 3
#endif
            if (bx & 1) { if (MK_DRY3 & 1) for (int half = 0; half < 2; ++half) { OneOrder S{half * F.G, 8, (const char*)(ws + WS_XR), (const char*)(ws + WS_WLRU), (size_t)256 * 1024 * 2, (size_t)256 * 256 * 2, 512, bx, 512}; gemm_phase<EpiLruD, OneOrder, false>(F.lds, 256, 1024, S, EL); } if (MK_DRY3 & 2) P3_QKV(); }
            else { if (MK_DRY3 & 2) P3_QKV(); if (MK_DRY3 & 1) for (int half = 0; half < 2; ++half) { OneOrder S{half * F.G, 8, (const char*)(ws + WS_XR), (const char*)(ws + WS_WLRU), (size_t)256 * 1024 * 2, (size_t)256 * 256 * 2, 512, bx, 512}; gemm_phase<EpiLruD, OneOrder, false>(F.lds, 256, 1024, S, EL); } }
            xcd_barrier(bar); }
        if (bx & 1) { P3_LRU(); P3_QKV(); } else { P3_QKV(); P3_LRU(); }
#undef P3_LRU
#undef P3_QKV
        SEAM(3);
    }
#ifndef MK_ABL
#define MK_ABL 0
#endif
    if (IN(4)) { if (MK_ABL) { p3_attention<MK_ABL>(F, KA()); xcd_barrier(bar); } p3_attention<0>(F, KA()); SEAM(4); }
    if (IN(5)) REP(5) {
        DenseOrder S; S.init(M, 1024, F.G, bx, ws + WS_XR, ws + WS_WOUT, 1024, 1024);
        EpiWout E{(const float*)KA().in[0], KA().out, (bf16_t*)(ws + WS_GR), (float*)(ws + WS_SSQP + SSQP_H)};
        gemm_phase<EpiWout, DenseOrder, true>(F.lds, 1024, 1024, S, E);
        SEAM(5);
    }
    if (IN(6)) { if (MK_DRY == 6) { p6_route<true>(F, KA()); xcd_barrier(bar); } if (MK_DRY == 61) { moe_weight_convert(F, KA(), 0, F.vcu, F.G); xcd_barrier(bar); } if (MK_DRY == 62) { moe_weight_convert(F, KA(), 1, F.vcu, F.G); xcd_barrier(bar); } p6_route<false>(F, KA()); moe_weight_convert(F, KA(), 0, F.vcu, F.G); SEAM(6); }
    if (IN(7) && MK_DRY == 7) {
        moe_prefix(F, KA(), tpre, cnts);
        MoeOrder S{tpre, cnts, 2, F.G, bx, (const char*)(ws + WS_GR), (const char*)(ws + WS_WGU), (size_t)512 * 1024, (size_t)256 * 1024, (const int*)(ws + WS_LIST), 1, 0};
        EpiMoeGU E{(bf16_t*)(ws + WS_GA), (float*)(ws + WS_CTL + CTL_SSQ_H), (const int*)(ws + WS_LIST)};
        gemm_phase<EpiMoeGU, MoeOrder, true, true, 0x7a7a7a7a>(F.lds, 1024, 1024, S, E);
        xcd_barrier(bar);
    }
    if (IN(8) && MK_DRY == 8) {
        moe_prefix(F, KA(), tpre, cnts);
        MoeOrder S{tpre, cnts, 4, F.G, bx, (const char*)(ws + WS_GA), (const char*)(ws + WS_WDN), (size_t)1024 * 256, (size_t)256 * 256, (const int*)(ws + WS_LIST), 0, (size_t)256 * 256};
        EpiMoeDown E{(bf16_t*)(ws + WS_Y), (const float*)(ws + WS_LIST + 2 * MiB)};
        gemm_phase<EpiMoeDown, MoeOrder, true, true, 0x7b7b7b7b>(F.lds, 256, 256, S, E);
        xcd_barrier(bar);
    }
    if (IN(7)) REP(7) {
        moe_prefix(F, KA(), tpre, cnts);
        MoeOrder S{tpre, cnts, 2, F.G, bx, (const char*)(ws + WS_GR), (const char*)(ws + WS_WGU), (size_t)512 * 1024, (size_t)256 * 1024, (const int*)(ws + WS_LIST), 1, 0};
        EpiMoeGU E{(bf16_t*)(ws + WS_GA), (float*)(ws + WS_CTL + CTL_SSQ_H), (const int*)(ws + WS_LIST)};
        gemm_phase<EpiMoeGU, MoeOrder, true, true, 0x7a7a7a7a>(F.lds, 1024, 1024, S, E);
        { const int nG = 2 * tpre[32], heavy = nG > F.G ? (nG - F.G < F.G ? nG - F.G : F.G - 1) : 0;
          if (bx >= heavy) moe_weight_convert(F, KA(), 1, bx - heavy, F.G - heavy); }
        SEAM(7);
    }
    if (IN(8)) REP(8) {
        if (!IN(7)) moe_prefix(F, KA(), tpre, cnts);
        MoeOrder S{tpre, cnts, 4, F.G, bx, (const char*)(ws + WS_GA), (const char*)(ws + WS_WDN), (size_t)1024 * 256, (size_t)256 * 256, (const int*)(ws + WS_LIST), 0, (size_t)256 * 256};
        EpiMoeDown E{(bf16_t*)(ws + WS_Y), (const float*)(ws + WS_LIST + 2 * MiB)};
        gemm_phase<EpiMoeDown, MoeOrder, true, true, 0x7b7b7b7b>(F.lds, 256, 256, S, E);
        SEAM(8);
    }
    if (IN(9)) { if (!IN(8)) moe_prefix(F, KA(), tpre, cnts); if (MK_DRY == 9) { p8_final<true>(F, KA(), tpre); xcd_barrier(bar); } p8_final<false>(F, KA(), tpre); VM_WAIT(); STAMP(10); }
#undef IN
#undef SEAM
}

[[maybe_unused]] static void launch(void* const* d_in, float* d_out, unsigned char* ws, hipStream_t stream, int one_launch) {
    static int grid = 0;
    if (grid == 0) {
        int dev = 0, cus = 0;
        if (hipGetDevice(&dev) != hipSuccess || hipDeviceGetAttribute(&cus, hipDeviceAttributeMultiprocessorCount, dev) != hipSuccess) { fprintf(stderr, "device query failed\n"); grid = -1; return; }
        if (hipFuncSetAttribute((const void*)mega, hipFuncAttributeMaxDynamicSharedMemorySize, LDS_BYTES) != hipSuccess) { fprintf(stderr, "hipFuncSetAttribute failed\n"); grid = -1; return; }
        (void)hipGetLastError();
        grid = cus;
        if (grid != 256) fprintf(stderr, "warning: %d CUs (kernel built for 256)\n", grid);
    }
    if (grid < 0) return;
    (void)hipMemsetAsync(ws + WS_CTL + CW_BAR * 4, 0, (size_t)(CW_CNT - CW_BAR) * 4 + 256, stream);
    Args a{};
    for (int i = 0; i < 26; ++i) a.in[i] = d_in[i];
    a.out = d_out; a.ws = ws;
    if (one_launch) { a.ph_lo = 0; a.ph_hi = NPHASE; hipLaunchKernelGGL(mega, dim3(grid), dim3(NTHREADS), LDS_BYTES, stream, a); }
    else for (int p = 0; p < NPHASE; ++p) { a.ph_lo = p; a.ph_hi = p + 1; hipLaunchKernelGGL(mega, dim3(grid), dim3(NTHREADS), LDS_BYTES, stream, a); }
}
}
extern "C" void kernel_launch(void* const* d_in, const int* in_sizes, int n_in, void* d_out, int out_size, void* d_ws, size_t ws_size, hipStream_t stream) {
    (void)in_sizes; (void)n_in; (void)out_size; (void)ws_size;
    mk::launch(d_in, (float*)d_out, (unsigned char*)d_ws, stream, MK_ONE_LAUNCH);
}
```

```cpp
#include <hip/hip_runtime.h>
#include <hip/hip_bf16.h>
#include <cstdint>
#include <cstdio>
#include <cmath>
namespace mk {
#define LAS __attribute__((address_space(3)))
#define GAS __attribute__((address_space(1)))
typedef unsigned short bf16_t;
typedef short bf16x8 __attribute__((ext_vector_type(8)));
typedef short s16x4 __attribute__((ext_vector_type(4)));
typedef float f32x2 __attribute__((ext_vector_type(2)));
typedef float f32x4 __attribute__((ext_vector_type(4)));
typedef float f32x16 __attribute__((ext_vector_type(16)));
typedef unsigned u32x2 __attribute__((ext_vector_type(2)));
typedef unsigned u32x4 __attribute__((ext_vector_type(4)));
typedef GAS unsigned gu32;

#ifndef MK_FP8V
#define MK_FP8V 1
#endif
#ifndef MK_FP8K
#define MK_FP8K 1
#endif
constexpr int M = 16384, D = 1024, NWAVES = 8, NTHREADS = 512;
constexpr float EPS = 1e-6f, LOG2E = 1.4426950408889634f;
constexpr size_t MiB = 1u << 20;
constexpr size_t WS_CTL = 0, CTL_BYTES = 1 * MiB;
constexpr size_t WS_WIN = 1 * MiB, WS_WUQ = 12 * MiB, WS_WUKV = 15 * MiB, WS_WLRU = 16 * MiB, WS_WOUT = 17 * MiB;
constexpr size_t WS_CS = 19 * MiB, WS_KPE = 21 * MiB, WS_MISC = 23 * MiB, WS_LIST = 25 * MiB;
constexpr size_t WS_R1 = 29 * MiB, WS_XR = 77 * MiB, WS_GR = 109 * MiB, WS_GA = 141 * MiB, WS_QC = 173 * MiB, WS_KVC = 197 * MiB, WS_KIMG = 205 * MiB, WS_DBG = 253 * MiB;
constexpr size_t MISC_HALO = 0, MISC_HEND = 512 * 1024, MISC_AEND = 768 * 1024, MISC_KSSQ = 1024 * 1024, MISC_WR = 1152 * 1024, MISC_TOK = 1408 * 1024;
constexpr size_t WS_SSQP = 253 * MiB, SSQP_KV = 786432, SSQP_H = 1048576;
constexpr size_t WS_Y = WS_QC;
constexpr size_t WS_WGU = WS_R1, WS_WDN = WS_R1 + 32 * MiB;
constexpr int CW_TMO = 0, CW_CODE = 1, CW_BAR = 4096, CW_CNT = 8192;
constexpr size_t CTL_SSQ_Q = 65536, CTL_SSQ_KV = 131072, CTL_SSQ_H = 196608;
constexpr int RING_BYTES = 131072, LDS_XCH = 135168  , LDSCTL_OFF = 147456, MISC_OFF = LDSCTL_OFF + 320, LDS_BYTES = 163840;

#define RLX_AGENT __ATOMIC_RELAXED, __HIP_MEMORY_SCOPE_AGENT
#define LDS_WAIT() asm volatile("s_waitcnt lgkmcnt(0)" ::: "memory")
#define VM_WAIT() asm volatile("s_waitcnt vmcnt(0)" ::: "memory")
__device__ __forceinline__ float bf2f(unsigned v) { return __uint_as_float(v << 16); }
__device__ __forceinline__ unsigned f2bf(float f) { unsigned u = __float_as_uint(f); return (u + 0x7fffu + ((u >> 16) & 1u)) >> 16; }
__device__ __forceinline__ unsigned pk2(float lo, float hi) { typedef __bf16 bf16x2_t __attribute__((ext_vector_type(2))); f32x2 v = {lo, hi}; bf16x2_t b = __builtin_convertvector(v, bf16x2_t); return __builtin_bit_cast(unsigned, b); }
__device__ __forceinline__ float lo2f(unsigned w) { return __uint_as_float(w << 16); }
__device__ __forceinline__ float hi2f(unsigned w) { return __uint_as_float(w & 0xffff0000u); }
__device__ __forceinline__ float fexp2(float x) { return __builtin_amdgcn_exp2f(x); }
__device__ __forceinline__ float frcp(float x) { return __builtin_amdgcn_rcpf(x); }
__device__ __forceinline__ float fsigm(float x) { return frcp(1.f + fexp2(-x * LOG2E)); }
__device__ __forceinline__ float fgelu(float x) { const float u = 0.7978845608028654f * (x + 0.044715f * x * x * x); return x * frcp(1.f + fexp2(-2.f * LOG2E * u)); }
__device__ __forceinline__ float wave_sum(float v) {
#pragma unroll
    for (int o = 1; o < 64; o <<= 1) v += __shfl_xor(v, o);
    return v;
}

#define XB_TMO      128
#define XB_XCNT(j)  (256  + 64 * (j))
#define XB_XSUB(j)  (1280 + 64 * (j))
#define XB_XGEN(j)  (2304 + 64 * (j))
#define XB_TOP      3328
#define XB_TOPGEN   3392
#define XCD_BAR_WORDS 3456
#define XB_SPIN_CAP (1u << 18)
__device__ __forceinline__ unsigned xb_ld(unsigned* p)              { return __hip_atomic_load(p, __ATOMIC_RELAXED, __HIP_MEMORY_SCOPE_AGENT); }
__device__ __forceinline__ unsigned xb_add(unsigned* p, unsigned v) { return __hip_atomic_fetch_add(p, v, __ATOMIC_RELAXED, __HIP_MEMORY_SCOPE_AGENT); }
__device__ __forceinline__ unsigned xb_xcc_id() { return (unsigned)__builtin_amdgcn_s_getreg((3 << 11) | 20) & 0xFu; }
#define XB_SPIN(cond, bar) do { unsigned _sp = 0; while (cond) { __builtin_amdgcn_s_sleep(1); \
    if ((++_sp & 255u) == 0u) { if (xb_ld(&(bar)[XB_TMO])) break; if (_sp > XB_SPIN_CAP) { atomicAdd(&(bar)[XB_TMO], 1u); break; } } } } while (0)
struct XcdBarrier { unsigned* bar; unsigned x; volatile LAS unsigned* st; };
__device__ __forceinline__ XcdBarrier xcd_barrier_post(unsigned* bar, volatile LAS unsigned* st) {
    XcdBarrier b; b.bar = bar; b.x = xb_xcc_id(); b.st = st;
    if (threadIdx.x == 0) (void)xb_add(&bar[XB_XCNT(b.x)], 1u);
    return b;
}
__device__ __forceinline__ void xcd_barrier_complete(unsigned* bar, unsigned x, unsigned& nloc, unsigned& nx) {
    const unsigned G = gridDim.x * gridDim.y * gridDim.z;
    unsigned sum, cnt, mine, sp = 0u;
    for (;;) {
        sum = 0u; cnt = 0u; mine = 0u;
#pragma unroll
        for (unsigned j = 0; j < 16; ++j) { const unsigned c = xb_ld(&bar[XB_XCNT(j)]); sum += c; cnt += (c > 0u) ? 1u : 0u; mine = (j == x) ? c : mine; }
        if (sum == G) break;
        __builtin_amdgcn_s_sleep(1);
        if ((++sp & 255u) == 0u) { if (xb_ld(&bar[XB_TMO])) break; if (sp > XB_SPIN_CAP) { atomicAdd(&bar[XB_TMO], 1u); break; } }
    }
    nloc = mine > 0u ? mine : 1u; nx = cnt > 0u ? cnt : 1u;
}
__device__ __forceinline__ void xcd_barrier(const XcdBarrier& b) {
    asm volatile("s_waitcnt vmcnt(0)" ::: "memory");
    __syncthreads();
    if (threadIdx.x == 0) {
        unsigned* bar = b.bar;
        __builtin_amdgcn_s_waitcnt(0);
        unsigned nloc = b.st[0], nx = b.st[1];
        if (nloc == 0u) { xcd_barrier_complete(bar, b.x, nloc, nx); b.st[0] = nloc; b.st[1] = nx; }
        const unsigned old = xb_add(&bar[XB_XSUB(b.x)], 1u);
        const unsigned gen = old / nloc;
        if (old + 1u == (gen + 1u) * nloc) {
            __builtin_amdgcn_fence(__ATOMIC_RELEASE, "agent");
            asm volatile("s_waitcnt vmcnt(0)" ::: "memory");
            const unsigned og = xb_add(&bar[XB_TOP], 1u);
            const unsigned tg = og / nx;
            if (og + 1u == (tg + 1u) * nx) xb_add(&bar[XB_TOPGEN], 1u);
            else XB_SPIN(xb_ld(&bar[XB_TOPGEN]) == tg, bar);
            __builtin_amdgcn_fence(__ATOMIC_ACQUIRE, "agent");
            xb_add(&bar[XB_XGEN(b.x)], 1u);
            asm volatile("s_waitcnt vmcnt(0)" ::: "memory");
        } else {
            XB_SPIN(xb_ld(&bar[XB_XGEN(b.x)]) == gen, bar);
            __builtin_amdgcn_fence(__ATOMIC_ACQUIRE, "agent");
            asm volatile("s_waitcnt vmcnt(0)" ::: "memory");
        }
    }
    __syncthreads();
}

constexpr int BM = 256, BK = 64, HALF = 128, HTB = HALF * BK * 2, STAGE_BYTES = 8 * HTB;
__device__ __forceinline__ int lds_byte(int r, int c) { const int st = (r >> 4) * 2 + (c >> 5), rr = r & 15, cc = c & 31, ob = rr * 64 + cc * 2; return st * 1024 + (ob ^ (((ob >> 9) & 1) << 5)); }
__device__ __forceinline__ void stage_rc(int b, int& R, int& C) { const int st = b / 1024, sb = b % 1024, swz = sb ^ (((sb >> 9) & 1) << 5); R = (st >> 1) * 16 + swz / 64; C = (st & 1) * 32 + (swz % 64) / 2; }
__device__ __forceinline__ int perm32(int rho) { const int n = rho >> 4, i = rho & 15; return 8 * (i >> 2) + 4 * n + (i & 3); }

struct Unit { int pm, pn; const char* A; const char* B; const int* gat; int valid; int x0, x1; };
typedef f32x4 Acc[2][2][4][2];

#define PG8_SA(b, h) (((b) * 2 + (h)) * HTB)
#define PG8_SB(b, h) ((4 + (b) * 2 + (h)) * HTB)
#define PG8_STAGE(bufoff, gbase, voff) do { _Pragma("unroll") for (int _i = 0; _i < 2; ++_i) \
        __builtin_amdgcn_global_load_lds((const unsigned*)((const char*)(gbase) + (voff)[_i]), (LAS unsigned*)(lds + (bufoff) + ldsw + _i * 8192), 16, 0, 0); } while (0)
#define PG8_LDA(dst, b, h) do { if constexpr (F8) { _Pragma("unroll") for (int m = 0; m < 4; ++m) { const u32x4 x0_ = *(const LAS u32x4*)(lds + PG8_SA(b, h) + a8o0 + m * 2048), x1_ = *(const LAS u32x4*)(lds + PG8_SA(b, h) + a8o1 + m * 2048); \
            dst##8[m] = __builtin_bit_cast(v8i_t, __builtin_shufflevector(x0_, x1_, 0, 1, 2, 3, 4, 5, 6, 7)); } } \
        else { _Pragma("unroll") for (int m = 0; m < 4; ++m) _Pragma("unroll") for (int k = 0; k < 2; ++k) dst[m][k] = *(const LAS bf16x8*)(lds + PG8_SA(b, h) + aoff + m * 2048 + k * 1024); } } while (0)
#define PG8_LDB(dst, b, h) do { if constexpr (F8) { _Pragma("unroll") for (int n = 0; n < 2; ++n) { const u32x4 x0_ = *(const LAS u32x4*)(lds + PG8_SB(b, h) + b8o0 + n * 2048), x1_ = *(const LAS u32x4*)(lds + PG8_SB(b, h) + b8o1 + n * 2048); \
            dst##8[n] = __builtin_bit_cast(v8i_t, __builtin_shufflevector(x0_, x1_, 0, 1, 2, 3, 4, 5, 6, 7)); } } \
        else { _Pragma("unroll") for (int n = 0; n < 2; ++n) _Pragma("unroll") for (int k = 0; k < 2; ++k) dst[n][k] = *(const LAS bf16x8*)(lds + PG8_SB(b, h) + boff + n * 2048 + k * 1024); } } while (0)
#define PG8_MMA(ai, bj, At, Bt) do { __builtin_amdgcn_s_setprio(1); if constexpr (F8) { _Pragma("unroll") for (int m = 0; m < 4; ++m) _Pragma("unroll") for (int n = 0; n < 2; ++n) \
            asm volatile("v_mfma_scale_f32_16x16x128_f8f6f4 %0, %1, %2, %0, %3, %4 op_sel_hi:[0,0,0]" : "+v"(acc[ai][bj][m][n]) : "v"(Bt##8[n]), "v"(At##8[m]), "v"(scw_), "v"(scx_)); } \
        else { _Pragma("unroll") for (int m = 0; m < 4; ++m) _Pragma("unroll") for (int n = 0; n < 2; ++n) _Pragma("unroll") for (int k = 0; k < 2; ++k) \
            acc[ai][bj][m][n] = __builtin_amdgcn_mfma_f32_16x16x32_bf16(Bt[n][k], At[m][k], acc[ai][bj][m][n], 0, 0, 0); } __builtin_amdgcn_s_setprio(0); } while (0)
#define PG8_WAIT_V(n) asm volatile("s_waitcnt vmcnt(" #n ")" ::: "memory")
#define PG8_WAIT_L(n) asm volatile("s_waitcnt lgkmcnt(" #n ")" ::: "memory")
#define PG8_BAR __builtin_amdgcn_s_barrier()
#define PG8_SCHED __builtin_amdgcn_sched_barrier(0)
#define PG8_VOFFA(u, vo) do { _Pragma("unroll") for (int _h = 0; _h < 2; ++_h) _Pragma("unroll") for (int _i = 0; _i < 2; ++_i) { const int _row = _h * HALF + Ra[_i]; \
        const int _ri = (u).gat ? (_row < (u).valid ? (u).gat[_row] : 0) : _row; vo[_h][_i] = F8 ? (unsigned)(_ri * lda + 2 * Ca[_i]) : (unsigned)(_ri * lda + Ca[_i]) * 2u; } } while (0)

typedef int v8i_t __attribute__((ext_vector_type(8)));
template <class Epi, class Sched, bool ALIGN_EPI, bool F8 = false, int SC_W = 0x7f7f7f7f>
__device__ __forceinline__ void gemm_phase(LAS unsigned char* lds, const int K, const int lda, const Sched& S, const Epi& E) {
    int tid_ = threadIdx.x; asm volatile("" : "+v"(tid_));
    const int tid = tid_, wid = __builtin_amdgcn_readfirstlane(tid >> 6), lane = tid & 63, wr = wid >> 2, wc = wid & 3, fr = lane & 15, fq = lane >> 4;
    const int nt = F8 ? K / 128 : K / BK;
    int Ra[2], Ca[2]; unsigned voffB[2];
#pragma unroll
    for (int i = 0; i < 2; ++i) { int R, C; stage_rc(tid * 16 + i * 8192, R, C); const int Rb = Epi::PERM ? ((R & ~31) + perm32(R & 31)) : R; Ra[i] = R; Ca[i] = C; voffB[i] = F8 ? (unsigned)(Rb * K + 2 * C) : (unsigned)(Rb * K + C) * 2u; }
    const size_t kstep = (size_t)(BK * 2);
    const size_t hstep = F8 ? (size_t)HALF * K : (size_t)HALF * K * 2;
    const unsigned ldsw = (unsigned)wid * 1024u;
    const int aoff = lds_byte(wr * 64 + fr, fq * 8), boff = lds_byte(wc * 32 + fr, fq * 8);
    const int a8o0 = lds_byte(wr * 64 + fr, 16 * fq), a8o1 = lds_byte(wr * 64 + fr, 16 * fq + 8), b8o0 = lds_byte(wc * 32 + fr, 16 * fq), b8o1 = lds_byte(wc * 32 + fr, 16 * fq + 8);
    Unit cur, nxt; int ui = 0;
    if (!S.next(0, cur)) return;
    Acc acc;
#pragma unroll
    for (int a = 0; a < 2; ++a)
#pragma unroll
        for (int b = 0; b < 2; ++b)
#pragma unroll
            for (int m = 0; m < 4; ++m)
#pragma unroll
                for (int n = 0; n < 2; ++n) acc[a][b][m][n] = (f32x4){0.f, 0.f, 0.f, 0.f};
    bf16x8 At[4][2], B0[2][2], B1[2][2]; v8i_t At8[4], B08[2], B18[2]; const int scw_ = SC_W, scx_ = 0x7f7f7f7f;
    unsigned vC[2][2], vN[2][2];
    PG8_VOFFA(cur, vC);
    const char* cA = cur.A; const char* cB = cur.B;
    PG8_STAGE(PG8_SB(0, 0), cB, voffB); PG8_STAGE(PG8_SB(0, 1), cB + hstep, voffB); PG8_STAGE(PG8_SA(0, 0), cA, vC[0]); PG8_STAGE(PG8_SA(0, 1), cA, vC[1]);
    if (wr == 1) PG8_BAR;
    PG8_WAIT_V(2); PG8_BAR;
    PG8_STAGE(PG8_SB(1, 0), cB + kstep, voffB); PG8_STAGE(PG8_SA(1, 0), cA + kstep, vC[0]); PG8_STAGE(PG8_SB(1, 1), cB + hstep + kstep, voffB);
    PG8_WAIT_V(6); PG8_BAR;
    for (;;) {
        const bool has_next = S.next(ui + 1, nxt);
        if (!has_next) nxt = cur;
        PG8_VOFFA(nxt, vN);
        const char* nA = nxt.A; const char* nB = nxt.B;
#pragma unroll 1
        for (int t = 0; t < nt; t += 2) {
            const bool last = (t == nt - 2);
            const char* a1 = cA + (size_t)(t + 1) * kstep;
            const char* a2 = last ? nA : cA + (size_t)(t + 2) * kstep; const char* b2 = last ? nB : cB + (size_t)(t + 2) * kstep;
            const char* a3 = a2 + kstep; const char* b3 = b2 + kstep;
            unsigned vS[2][2];
#pragma unroll
            for (int h = 0; h < 2; ++h)
#pragma unroll
                for (int i = 0; i < 2; ++i) vS[h][i] = last ? vN[h][i] : vC[h][i];
            PG8_LDB(B0, 0, 0); PG8_LDB(B1, 0, 1); PG8_SCHED; PG8_LDA(At, 0, 0); PG8_STAGE(PG8_SA(1, 1), a1, vC[1]);
            PG8_WAIT_V(8); PG8_WAIT_L(0); PG8_BAR; PG8_MMA(0, 0, At, B0); PG8_MMA(0, 1, At, B1); PG8_BAR; PG8_SCHED;
            PG8_LDA(At, 0, 1); PG8_STAGE(PG8_SB(0, 0), b2, voffB); PG8_STAGE(PG8_SB(0, 1), b2 + hstep, voffB); PG8_STAGE(PG8_SA(0, 0), a2, vS[0]);
            PG8_WAIT_V(8); PG8_WAIT_L(0); PG8_BAR; PG8_MMA(1, 0, At, B0); PG8_MMA(1, 1, At, B1); PG8_BAR; PG8_SCHED;
            PG8_LDB(B0, 1, 0); PG8_LDB(B1, 1, 1); PG8_SCHED; PG8_LDA(At, 1, 0); PG8_STAGE(PG8_SA(0, 1), a2, vS[1]);
            PG8_WAIT_V(8); PG8_WAIT_L(0); PG8_BAR; PG8_MMA(0, 0, At, B0); PG8_MMA(0, 1, At, B1); PG8_BAR; PG8_SCHED;
            PG8_LDA(At, 1, 1); PG8_STAGE(PG8_SB(1, 0), b3, voffB); PG8_STAGE(PG8_SB(1, 1), b3 + hstep, voffB); PG8_STAGE(PG8_SA(1, 0), a3, vS[0]);
            PG8_WAIT_V(8); PG8_WAIT_L(0); PG8_BAR; PG8_MMA(1, 0, At, B0); PG8_MMA(1, 1, At, B1); PG8_BAR; PG8_SCHED;
        }
        if constexpr (F8) asm volatile("s_nop 15\n\ts_nop 15" ::: "memory");
        if constexpr (ALIGN_EPI) { if (wr == 0) PG8_BAR; }
        if constexpr (!Epi::AFTER_DRAIN) { E(acc, cur, wr, wc, fr, fq); }
        if (!has_next) break;
#pragma unroll
        for (int a = 0; a < 2; ++a)
#pragma unroll
            for (int b = 0; b < 2; ++b)
#pragma unroll
                for (int m = 0; m < 4; ++m)
#pragma unroll
                    for (int n = 0; n < 2; ++n) acc[a][b][m][n] = (f32x4){0.f, 0.f, 0.f, 0.f};
        cur = nxt; cA = nA; cB = nB; ++ui;
#pragma unroll
        for (int h = 0; h < 2; ++h)
#pragma unroll
            for (int i = 0; i < 2; ++i) vC[h][i] = vN[h][i];
        if constexpr (ALIGN_EPI) { if (wr == 1) PG8_BAR; }
    }
    PG8_WAIT_V(0);
    if constexpr (!ALIGN_EPI) { if (wr == 0) PG8_BAR; }
    PG8_BAR;
    if constexpr (Epi::AFTER_DRAIN) { E.fused(acc, cur, wr, wc, fr, fq, lds, wid, lane); }
}
struct DenseOrder {
    int nM, nN, nwg, G, c; const char* A; const char* B; size_t a_tile, b_tile; int a_col_tile;
    int pn_per_ablk;
    int skew_h, skew_a, skew_b;
    __device__ void init(int Mr, int N, int G_, int c_, const void* A_, const void* B_, int lda, int K, int pnpa = 0, int acolbytes = 0, int esz = 2) {
        nM = Mr / BM; nN = N / BM; nwg = nM * nN; G = G_; c = c_; A = (const char*)A_; B = (const char*)B_; a_tile = (size_t)BM * lda * esz; b_tile = (size_t)BM * K * esz; pn_per_ablk = pnpa; a_col_tile = acolbytes; skew_h = 0; skew_a = 0; skew_b = 0; }
    __device__ bool next(int i, Unit& u) const {
        long L = (long)i * G + c;
        if (skew_h > 0) { if (c < skew_h) { if (i >= skew_a) return false; L = (long)c * skew_a + i; } else { if (i >= skew_b) return false; L = (long)skew_h * skew_a + (long)(c - skew_h) * skew_b + i; } }
        if (L >= nwg) return false;
        int wgid = (int)L; { const int q = nwg / 8, r = nwg % 8, xcd = wgid % 8, off = wgid / 8; wgid = (xcd < r ? xcd * (q + 1) : r * (q + 1) + (xcd - r) * q) + off; }
        const int WGM = 8, nig = WGM * nN, gid = wgid / nig, fm = gid * WGM, gsz = (nM - fm) < WGM ? (nM - fm) : WGM;
        u.pm = fm + ((wgid % nig) % gsz); u.pn = (wgid % nig) / gsz;
        u.A = A + (size_t)u.pm * a_tile + (pn_per_ablk ? (size_t)(u.pn / pn_per_ablk) * a_col_tile : 0); u.B = B + (size_t)u.pn * b_tile; u.gat = nullptr; u.valid = 256; u.x0 = 0; u.x1 = 0; return true;
    }
};
struct OneOrder {
    int first, nN; const char* A; const char* B; size_t a_tile, b_tile; int a_col_tile; int c; int total;
    __device__ bool next(int i, Unit& u) const {
        if (i > 0) return false; const int L = first + c; if (L >= total) return false;
        u.pm = L / nN; u.pn = L % nN; u.A = A + (size_t)u.pm * a_tile + (size_t)(u.pn >> 1) * a_col_tile; u.B = B + (size_t)u.pn * b_tile; u.gat = nullptr; u.valid = 256; u.x0 = 0; u.x1 = 0; return true; }
};
struct MoeOrder {
    const volatile LAS int* tpre; const volatile LAS int* cnt; int ncol; int G, c; const char* A; const char* B; size_t b_exp; size_t b_tile; const int* lists; int gather; size_t a_tile;
    __device__ bool next(int i, Unit& u) const {
        const int L = i * G + c; const int ntile = __builtin_amdgcn_readfirstlane(tpre[32]); if (L >= ntile * ncol) return false;
        const int T = L / ncol, pn = L % ncol; const int e = __builtin_amdgcn_readfirstlane(tpre[80 + T]);
        const int rt = __builtin_amdgcn_readfirstlane(T - tpre[e]); int valid = cnt[e] - rt * 256; valid = __builtin_amdgcn_readfirstlane(valid > 256 ? 256 : valid);
        u.pm = T; u.pn = pn; u.x0 = e; u.x1 = rt; u.valid = valid; u.B = B + (size_t)e * b_exp + (size_t)pn * b_tile;
        if (gather) { u.A = A; u.gat = lists + (size_t)e * M + rt * 256; } else { u.A = A + (size_t)T * a_tile; u.gat = nullptr; }
        return true; }
};

__device__ __forceinline__ u32x4 pack8(f32x4 a, f32x4 b) { u32x4 w; w.x = pk2(a[0], a[1]); w.y = pk2(a[2], a[3]); w.z = pk2(b[0], b[1]); w.w = pk2(b[2], b[3]); return w; }
__device__ __forceinline__ float dot4(f32x4 a) { return (a[0] * a[0] + a[1] * a[1]) + (a[2] * a[2] + a[3] * a[3]); }

struct EpiProj {
    static constexpr bool PERM = true, AFTER_DRAIN = false;
    bf16_t *XR, *GR, *QC, *KVC, *GA, *GB, *HALO; float *KPE, *ssq_q, *ssq_kv;
    __device__ __forceinline__ void operator()(const Acc& acc, const Unit& u, int wr, int wc, int fr, int fq) const {
        const int pn = u.pn, rowb = u.pm * BM + wr * 64 + fr;
        if (pn == 20) {
            if (wc == 0) {
#pragma unroll
                for (int ai = 0; ai < 2; ++ai)
#pragma unroll
                    for (int m = 0; m < 4; ++m) { float* p = KPE + (size_t)(rowb + ai * HALF + m * 16) * 32 + 8 * fq; *(f32x4*)p = acc[ai][0][m][0]; *(f32x4*)(p + 4) = acc[ai][0][m][1]; }
            }
            return;
        }
        bf16_t* dst; int ldc, colt, act = 0; float* ssq = nullptr; int nslot = 0, slot = 0;
        if (pn < 4) { dst = XR; ldc = 1024; colt = pn * 256; }
        else if (pn < 8) { dst = GR; ldc = 1024; colt = (pn - 4) * 256; act = 1; }
        else if (pn < 11) { dst = QC; ldc = 768; colt = (pn - 8) * 256; ssq = ssq_q; nslot = 12; slot = (pn - 8) * 4 + wc; act = 3; }
        else if (pn == 11) { dst = KVC; ldc = 256; colt = 0; ssq = ssq_kv; nslot = 4; slot = wc; act = 3; }
        else if (pn < 16) { dst = GA; ldc = 1024; colt = (pn - 12) * 256; act = 2; }
        else { dst = GB; ldc = 1024; colt = (pn - 16) * 256; act = 2; }
        const int col0 = colt + wc * 32 + 8 * fq;
#pragma unroll
        for (int ai = 0; ai < 2; ++ai)
#pragma unroll
            for (int m = 0; m < 4; ++m) {
                const int row = rowb + ai * HALF + m * 16; float ss = 0.f;
#pragma unroll
                for (int bj = 0; bj < 2; ++bj) {
                    f32x4 v0 = acc[ai][bj][m][0], v1 = acc[ai][bj][m][1];
                    if (ssq) ss += dot4(v0) + dot4(v1);
                    if (act == 1) {
#pragma unroll
                        for (int e = 0; e < 4; ++e) { v0[e] = fgelu(v0[e]); v1[e] = fgelu(v1[e]); }
                    } else if (act == 2) {
#pragma unroll
                        for (int e = 0; e < 4; ++e) { v0[e] = fsigm(v0[e]); v1[e] = fsigm(v1[e]); }
                    }
                    if (act == 3) { u32x2 w8; int w_ = __builtin_amdgcn_cvt_pk_fp8_f32(v0[0], v0[1], 0, false); w8.x = (unsigned)__builtin_amdgcn_cvt_pk_fp8_f32(v0[2], v0[3], w_, true);
                        w_ = __builtin_amdgcn_cvt_pk_fp8_f32(v1[0], v1[1], 0, false); w8.y = (unsigned)__builtin_amdgcn_cvt_pk_fp8_f32(v1[2], v1[3], w_, true);
                        *(u32x2*)((unsigned char*)dst + (size_t)row * ldc + col0 + bj * HALF) = w8; }
                    else *(u32x4*)(dst + (size_t)row * ldc + col0 + bj * HALF) = pack8(v0, v1);
                }
                if (ssq) { ss += __shfl_xor(ss, 16); ss += __shfl_xor(ss, 32); if (fq == 0) ssq[(size_t)row * nslot + slot] = ss; }
            }
        if (pn < 4 && wr == 1 && fr >= 13) {
#pragma unroll
            for (int bj = 0; bj < 2; ++bj) *(u32x4*)(HALO + ((size_t)u.pm * 3 + (fr - 13)) * 1024 + col0 + bj * HALF) = pack8(acc[1][bj][3][0], acc[1][bj][3][1]);
        }
    }
};

struct EpiQ {
    static constexpr bool PERM = true, AFTER_DRAIN = false;
    bf16_t* Q; const float* ssq_q;
    __device__ __forceinline__ void operator()(const Acc& acc, const Unit& u, int wr, int wc, int fr, int fq) const {
        const int rowb = u.pm * BM + wr * 64 + fr, col0 = u.pn * BM + wc * 32 + 8 * fq;
#pragma unroll
        for (int ai = 0; ai < 2; ++ai)
#pragma unroll
            for (int m = 0; m < 4; ++m) {
                const int row = rowb + ai * HALF + m * 16; const float rs = ssq_q[row];
#pragma unroll
                for (int bj = 0; bj < 2; ++bj) *(u32x4*)(Q + (size_t)row * 1536 + col0 + bj * HALF) = pack8(acc[ai][bj][m][0] * rs, acc[ai][bj][m][1] * rs);
            }
    }
};

struct EpiKV {
    static constexpr bool PERM = true, AFTER_DRAIN = false;
    unsigned char* KIMG; unsigned char* VIMG; const float* ssq_kv; const float* kssq; const float* KPER; const float* kg;
    __device__ __forceinline__ void operator()(const Acc& acc, const Unit& u, int wr, int wc, int fr, int fq) const {
        asm volatile("" : "+v"(fr), "+v"(fq));
        const int rowb = u.pm * BM + wr * 64 + fr, h = 2 * u.pn + (wc & 1);
        if (wc < 2) {
            f32x4 g[2][2];
#pragma unroll
            for (int bj = 0; bj < 2; ++bj)
#pragma unroll
                for (int n = 0; n < 2; ++n) g[bj][n] = *(const f32x4*)(kg + 32 * bj + 8 * fq + 4 * n);
#pragma unroll
            for (int am = 0; am < 8; ++am) { const int ai = am >> 2;
                f32x4 kr[4][2];
#pragma unroll
                for (int m = (am & 3); m < (am & 3) + 1; ++m) { const float* kp_ = KPER + (size_t)(rowb + ai * HALF + m * 16) * 32 + 8 * fq; kr[m][0] = *(const f32x4*)kp_; kr[m][1] = *(const f32x4*)(kp_ + 4); }
#pragma unroll
                for (int m = (am & 3); m < (am & 3) + 1; ++m) {
                    const int row = rowb + ai * HALF + m * 16; const float rs = ssq_kv[row], ksq = kssq[row];
                    f32x4 v[2][2]; float ss = 0.f;
#pragma unroll
                    for (int bj = 0; bj < 2; ++bj)
#pragma unroll
                        for (int n = 0; n < 2; ++n) { v[bj][n] = acc[ai][bj][m][n] * rs; ss += dot4(v[bj][n]); }
                    ss += __shfl_xor(ss, 16); ss += __shfl_xor(ss, 32);
                    const float rk = rsqrtf((ss + ksq) * (1.f / 96.f) + EPS);
#if MK_FP8K
                    unsigned char* img = KIMG + ((size_t)h * 256 + (row >> 6)) * 8192;
#pragma unroll
                    for (int bj = 0; bj < 2; ++bj) { const f32x4 x0 = v[bj][0] * g[bj][0] * rk, x1 = v[bj][1] * g[bj][1] * rk; u32x2 w;
                        int w0 = __builtin_amdgcn_cvt_pk_fp8_f32(x0[0], x0[1], 0, false); w0 = __builtin_amdgcn_cvt_pk_fp8_f32(x0[2], x0[3], w0, true);
                        int w1 = __builtin_amdgcn_cvt_pk_fp8_f32(x1[0], x1[1], 0, false); w1 = __builtin_amdgcn_cvt_pk_fp8_f32(x1[2], x1[3], w1, true);
                        w.x = (unsigned)w0; w.y = (unsigned)w1;
                        *(u32x2*)(img + ((row & 63) >> 5) * 2048 + bj * 1024 + (fq >> 1) * 512 + (row & 31) * 16 + 8 * (fq & 1)) = w; }
                    *(u32x4*)(img + 4096 + fq * 1024 + (row & 63) * 16) = pack8(kr[m][0] * rk, kr[m][1] * rk);
#else
                    unsigned char* img = KIMG + ((size_t)h * 256 + (row >> 6)) * 12288 + (row & 63) * 16;
#pragma unroll
                    for (int bj = 0; bj < 2; ++bj) *(u32x4*)(img + (4 * bj + fq) * 1024) = pack8(v[bj][0] * g[bj][0] * rk, v[bj][1] * g[bj][1] * rk);
                    *(u32x4*)(img + (8 + fq) * 1024) = pack8(kr[m][0] * rk, kr[m][1] * rk);
#endif
                }
                asm volatile("" ::: "memory");
            }
        } else {
#if MK_FP8V
#pragma unroll
            for (int ai = 0; ai < 2; ++ai)
#pragma unroll
                for (int m = 0; m < 4; ++m) {
                    const int row = rowb + ai * HALF + m * 16; const float rs = ssq_kv[row]; const int key = row & 63, kk = key & 31;
                    unsigned char* img = VIMG + ((size_t)h * 256 + (row >> 6)) * 4096 + ((kk >> 2) & 1) * 1024 + (key >> 5) * 512 + ((kk & 3) + 4 * (kk >> 3)) + fq * 128;
#pragma unroll
                    for (int bj = 0; bj < 2; ++bj) { const f32x4 v0 = acc[ai][bj][m][0] * rs, v1 = acc[ai][bj][m][1] * rs;
                        unsigned w0 = (unsigned)__builtin_amdgcn_cvt_pk_fp8_f32(v0[0], v0[1], 0, false); w0 = (unsigned)__builtin_amdgcn_cvt_pk_fp8_f32(v0[2], v0[3], (int)w0, true);
                        unsigned w1 = (unsigned)__builtin_amdgcn_cvt_pk_fp8_f32(v1[0], v1[1], 0, false); w1 = (unsigned)__builtin_amdgcn_cvt_pk_fp8_f32(v1[2], v1[3], (int)w1, true);
                        unsigned char* p = img + bj * 2048;
                        p[0] = (unsigned char)w0; p[16] = (unsigned char)(w0 >> 8); p[32] = (unsigned char)(w0 >> 16); p[48] = (unsigned char)(w0 >> 24);
                        p[64] = (unsigned char)w1; p[80] = (unsigned char)(w1 >> 8); p[96] = (unsigned char)(w1 >> 16); p[112] = (unsigned char)(w1 >> 24); }
                }
#else
#pragma unroll
            for (int ai = 0; ai < 2; ++ai)
#pragma unroll
                for (int m = 0; m < 4; ++m) {
                    const int row = rowb + ai * HALF + m * 16; const float rs = ssq_kv[row]; const int key = row & 63;
                    unsigned char* img = VIMG + ((size_t)h * 256 + (row >> 6)) * 8192 + (key >> 4) * 1024 + (key & 15) * 64 + fq * 16;
#pragma unroll
                    for (int bj = 0; bj < 2; ++bj) *(u32x4*)(img + bj * 4096) = pack8(acc[ai][bj][m][0] * rs, acc[ai][bj][m][1] * rs);
                }
#endif
        }
    }
};

template <bool DRY> struct EpiLruT {
    static constexpr bool PERM = false, AFTER_DRAIN = true;
    const bf16_t* XA; const float *ba, *bx, *lam; bf16_t* GRio; bf16_t* GAio; float* HEND; float* AEND;
    __device__ __forceinline__ void fused(Acc& acc, const Unit& u, int wr, int wc, int fr, int fq, LAS unsigned char* lds, int wid, int lane) const {
        int tid = threadIdx.x; asm volatile("" : "+v"(tid));
        const int chb = 256 * (u.pn >> 1) + 128 * (u.pn & 1);
        LAS unsigned* S = (LAS unsigned*)lds;
        {
            f32x4 vba[2], vbx[2], vsp[2];
#pragma unroll
            for (int n = 0; n < 2; ++n) { const int c = chb + 32 * wc + 16 * n + 4 * fq; vba[n] = *(const f32x4*)(ba + c); vbx[n] = *(const f32x4*)(bx + c); const f32x4 l4 = *(const f32x4*)(lam + c);
#pragma unroll
                for (int e = 0; e < 4; ++e) vsp[n][e] = -8.f * LOG2E * log1pf(expf(-l4[e])); }
#pragma unroll
            for (int am = 0; am < 4; ++am) { const int ai = am >> 1;
                u32x2 xw[4][2];
#pragma unroll
                for (int m = 2 * (am & 1); m < 2 * (am & 1) + 2; ++m)
#pragma unroll
                    for (int n = 0; n < 2; ++n) xw[m][n] = *(const u32x2*)((const char*)XA + (unsigned)((((unsigned)(u.pm * BM + ai * HALF + wr * 64 + m * 16 + fr)) * 1024u + (unsigned)(chb + 32 * wc + 16 * n + 4 * fq)) * 2u));
#pragma unroll
                for (int m = 2 * (am & 1); m < 2 * (am & 1) + 2; ++m) {
                    const int r = ai * HALF + wr * 64 + m * 16 + fr;
#pragma unroll
                    for (int n = 0; n < 2; ++n) {
                        const int x0 = 32 * wc + 16 * n + 4 * fq;
                        const float xa[4] = {lo2f(xw[m][n].x), hi2f(xw[m][n].x), lo2f(xw[m][n].y), hi2f(xw[m][n].y)}; u32x4 o;
#pragma unroll
                        for (int e = 0; e < 4; ++e) {
                            const float rr = fsigm(acc[ai][0][m][n][e] + vba[n][e]), ii = fsigm(acc[ai][1][m][n][e] + vbx[n][e]);
                            const float la2 = rr * vsp[n][e]; const float a2 = fexp2(2.f * la2); const float mult = sqrtf(fmaxf(1.f - a2, 0.f));
                            o[e] = pk2(mult * ii * xa[e], la2);
                        }
                        *(LAS u32x4*)(S + r * 132 + x0) = o;
                    }
                }
                asm volatile("" ::: "memory");
            }
        }
        const int cp = tid & 63, sg = tid >> 6, c0 = 2 * cp; LAS f32x4* X = (LAS f32x4*)(lds + LDS_XCH);
        const unsigned gb32 = ((unsigned)(u.pm * BM) * 1024u + (unsigned)(chb + c0)) * 2u;
        asm volatile("" ::: "memory");
        unsigned gr[32], ga[32];
#pragma unroll
        for (int j = 0; j < 32; ++j) { const unsigned ob = gb32 + (unsigned)(sg * 32 + j) * 2048u; gr[j] = *(const unsigned*)((const char*)GRio + ob); ga[j] = *(const unsigned*)((const char*)GAio + ob); }
        LDS_WAIT(); __builtin_amdgcn_s_barrier(); asm volatile("" ::: "memory");
        float h0 = 0.f, h1 = 0.f, s0 = 0.f, s1 = 0.f;
#pragma unroll 8
        for (int j = 0; j < 32; ++j) { const int r = sg * 32 + j; const u32x2 w = *(const LAS u32x2*)(S + r * 132 + c0);
            const float l0 = hi2f(w.x), l1 = hi2f(w.y); h0 = fexp2(l0) * h0 + lo2f(w.x); h1 = fexp2(l1) * h1 + lo2f(w.y); s0 += l0; s1 += l1; }
        X[sg * 64 + cp] = (f32x4){h0, s0, h1, s1};
        LDS_WAIT(); __builtin_amdgcn_s_barrier(); asm volatile("" ::: "memory");
        h0 = 0.f; h1 = 0.f; s0 = 0.f; s1 = 0.f;
        for (int q = 0; q < sg; ++q) { const f32x4 x = X[q * 64 + cp]; h0 = fexp2(x[1]) * h0 + x[0]; s0 += x[1]; h1 = fexp2(x[3]) * h1 + x[2]; s1 += x[3]; }
#pragma unroll
        for (int j = 0; j < 32; ++j) { const int r = sg * 32 + j; const u32x2 w = *(const LAS u32x2*)(S + r * 132 + c0);
            const float l0 = hi2f(w.x), l1 = hi2f(w.y); h0 = fexp2(l0) * h0 + lo2f(w.x); h1 = fexp2(l1) * h1 + lo2f(w.y); s0 += l0; s1 += l1;
            const unsigned ob = gb32 + (unsigned)r * 2048u;
            const float g0 = lo2f(gr[j]) * lo2f(ga[j]), g1 = hi2f(gr[j]) * hi2f(ga[j]);
            const unsigned o1_ = pk2(h0 * g0, h1 * g1), o2_ = pk2(fexp2(s0) * g0, fexp2(s1) * g1); if (DRY) asm volatile("" :: "v"(o1_), "v"(o2_)); else { *(unsigned*)((char*)GRio + ob) = o1_; *(unsigned*)((char*)GAio + ob) = o2_; }
            if ((j & 3) == 3) asm volatile("" ::: "memory"); }
        if (sg == 7 && !DRY) { *(f32x2*)(HEND + (size_t)u.pm * 1024 + chb + c0) = (f32x2){h0, h1}; *(f32x2*)(AEND + (size_t)u.pm * 1024 + chb + c0) = (f32x2){fexp2(s0), fexp2(s1)}; }
        LDS_WAIT(); __builtin_amdgcn_s_barrier(); asm volatile("" ::: "memory");
    }
};

struct EpiWout {
    static constexpr bool PERM = true, AFTER_DRAIN = false;
    const float* x; float* out; bf16_t* HB; float* ssq_h;
    __device__ __forceinline__ void operator()(const Acc& acc, const Unit& u, int wr, int wc, int fr, int fq) const {
        const int rowb = u.pm * BM + wr * 64 + fr, col0 = u.pn * BM + wc * 32 + 8 * fq;
#pragma unroll
        for (int ai = 0; ai < 2; ++ai)
#pragma unroll
            for (int m = 0; m < 4; ++m) {
                const int row = rowb + ai * HALF + m * 16; float ss = 0.f;
#pragma unroll
                for (int bj = 0; bj < 2; ++bj) { const size_t o = (size_t)row * 1024 + col0 + bj * HALF;
                    const f32x4 h0 = *(const f32x4*)(x + o) + acc[ai][bj][m][0], h1 = *(const f32x4*)(x + o + 4) + acc[ai][bj][m][1];
                    ss += dot4(h0) + dot4(h1); *(f32x4*)(out + o) = h0; *(f32x4*)(out + o + 4) = h1;
                    { u32x2 w8; int w_ = __builtin_amdgcn_cvt_pk_fp8_f32(h0[0], h0[1], 0, false); w8.x = (unsigned)__builtin_amdgcn_cvt_pk_fp8_f32(h0[2], h0[3], w_, true); w_ = __builtin_amdgcn_cvt_pk_fp8_f32(h1[0], h1[1], 0, false); w8.y = (unsigned)__builtin_amdgcn_cvt_pk_fp8_f32(h1[2], h1[3], w_, true);
                      *(u32x2*)((unsigned char*)HB + o) = w8; } }
                ss += __shfl_xor(ss, 16); ss += __shfl_xor(ss, 32); if (fq == 0) ssq_h[(size_t)row * 16 + u.pn * 4 + wc] = ss;
            }
    }
};

struct EpiMoeGU {
    static constexpr bool PERM = false, AFTER_DRAIN = false;
    bf16_t* HID; const float* ssq_h; const int* lists;
    __device__ __forceinline__ void operator()(const Acc& acc, const Unit& u, int wr, int wc, int fr, int fq) const {
        const int rb = wr * 64 + fr; float rsv[2][4];
#pragma unroll
        for (int ai = 0; ai < 2; ++ai)
#pragma unroll
            for (int m = 0; m < 4; ++m) { const int r = rb + ai * HALF + m * 16; rsv[ai][m] = (r < u.valid) ? ssq_h[lists[(size_t)u.x0 * M + u.x1 * 256 + r]] : 0.f; }
#pragma unroll
        for (int ai = 0; ai < 2; ++ai)
#pragma unroll
            for (int m = 0; m < 4; ++m) {
                const int r = rb + ai * HALF + m * 16;
                if (r < u.valid) {
                    const float rs = rsv[ai][m];
#pragma unroll
                    for (int n = 0; n < 2; ++n) { f32x4 g = acc[ai][0][m][n] * rs, up = acc[ai][1][m][n] * rs, hb;
#pragma unroll
                        for (int e = 0; e < 4; ++e) hb[e] = g[e] * fsigm(g[e]) * up[e];
                        int w_ = __builtin_amdgcn_cvt_pk_fp8_f32(hb[0], hb[1], 0, false); w_ = __builtin_amdgcn_cvt_pk_fp8_f32(hb[2], hb[3], w_, true);
                        *(unsigned*)((char*)HID + (unsigned)(((unsigned)u.pm * 256u + (unsigned)r) * 256u + 128u * (unsigned)u.pn + 32u * (unsigned)wc + 16u * (unsigned)n + 4u * (unsigned)fq)) = (unsigned)w_; }
                }
            }
    }
};
struct EpiMoeDown {
    static constexpr bool PERM = true, AFTER_DRAIN = false;
    bf16_t* Y; const float* cwl;
    __device__ __forceinline__ void operator()(const Acc& acc, const Unit& u, int wr, int wc, int fr, int fq) const {
        asm volatile("" : "+v"(fr), "+v"(fq));
        const int rb = wr * 64 + fr, col0 = u.pn * BM + wc * 32 + 8 * fq;
#pragma unroll
        for (int ai = 0; ai < 2; ++ai) {
            float cwv[4];
#pragma unroll
            for (int m = 0; m < 4; ++m) { const int r = rb + ai * HALF + m * 16; cwv[m] = (r < u.valid) ? cwl[(size_t)u.x0 * M + u.x1 * 256 + r] * 8.f : 0.f; }
#pragma unroll
            for (int m = 0; m < 4; ++m) {
                const int r = rb + ai * HALF + m * 16;
                if (r < u.valid) { const float cw = cwv[m];
#pragma unroll
                    for (int bj = 0; bj < 2; ++bj) { const f32x4 y0 = acc[ai][bj][m][0] * cw, y1 = acc[ai][bj][m][1] * cw; u32x2 w8;
                        int w_ = __builtin_amdgcn_cvt_pk_fp8_f32(y0[0], y0[1], 0, false); w8.x = (unsigned)__builtin_amdgcn_cvt_pk_fp8_f32(y0[2], y0[3], w_, true);
                        w_ = __builtin_amdgcn_cvt_pk_fp8_f32(y1[0], y1[1], 0, false); w8.y = (unsigned)__builtin_amdgcn_cvt_pk_fp8_f32(y1[2], y1[3], w_, true);
                        *(u32x2*)((char*)Y + (unsigned)(((unsigned)u.pm * 256u + (unsigned)r) * 1024u + (unsigned)(col0 + bj * HALF))) = w8; } }
            }
            asm volatile("" ::: "memory");
        }
    }
};
#define LANE_NOW() ({ int t__ = threadIdx.x; asm volatile("" : "+v"(t__)); t__ & 63; })
struct Frame {
    LAS unsigned char* lds; volatile LAS unsigned* MISC; gu32* ctl;
    int tid, lane, wave, vcu, G;
    void* const* in_dummy;
};
struct Args { const void* in[26]; float* out; unsigned char* ws; int ph_lo, ph_hi; };
typedef const __attribute__((address_space(4))) Args& CArgs;

__device__ __forceinline__ int crow(int r, int hi) { return (r & 3) + 8 * (r >> 2) + 4 * hi; }
__device__ __forceinline__ void tr_item(const float* W, int ldn, int ns0, bf16_t* WT, int K, int nd0, int k0, const float* kscale, LAS float* scr, int lane, int ncols = 64, int nwrite = 64, float f8mul = 0.f) {
    const int c4 = (lane & 15) * 4, kr = lane >> 4;
    f32x4 v[16];
#pragma unroll
    for (int i = 0; i < 16; ++i) { const int kk = 4 * i + kr; v[i] = (c4 < ncols) ? *(const f32x4*)(W + (size_t)(k0 + kk) * ldn + ns0 + c4) : (f32x4){0.f, 0.f, 0.f, 0.f}; }
#pragma unroll
    for (int i = 0; i < 16; ++i) { const int kk = 4 * i + kr; f32x4 x = v[i]; if (kscale) x = x * kscale[k0 + kk];
        LAS float* p = scr + kk * 65 + c4; p[0] = x[0]; p[1] = x[1]; p[2] = x[2]; p[3] = x[3]; }
    LDS_WAIT(); asm volatile("" ::: "memory");
    const int c = lane & 7;
#pragma unroll
    for (int j = 0; j < 8; ++j) { const int n = (lane >> 3) + 8 * j; if (n >= nwrite) break; const LAS float* sp = scr + (8 * c) * 65 + n;
        if (f8mul != 0.f) { u32x2 o8; int w_ = __builtin_amdgcn_cvt_pk_fp8_f32(sp[0 * 65] * f8mul, sp[1 * 65] * f8mul, 0, false); o8.x = (unsigned)__builtin_amdgcn_cvt_pk_fp8_f32(sp[2 * 65] * f8mul, sp[3 * 65] * f8mul, w_, true);
            w_ = __builtin_amdgcn_cvt_pk_fp8_f32(sp[4 * 65] * f8mul, sp[5 * 65] * f8mul, 0, false); o8.y = (unsigned)__builtin_amdgcn_cvt_pk_fp8_f32(sp[6 * 65] * f8mul, sp[7 * 65] * f8mul, w_, true);
            *(u32x2*)((unsigned char*)WT + (size_t)(nd0 + n) * K + k0 + 8 * c) = o8; continue; }
        u32x4 o; o.x = pk2(sp[0 * 65], sp[1 * 65]); o.y = pk2(sp[2 * 65], sp[3 * 65]); o.z = pk2(sp[4 * 65], sp[5 * 65]); o.w = pk2(sp[6 * 65], sp[7 * 65]);
        *(u32x4*)(WT + (size_t)(nd0 + n) * K + k0 + 8 * c) = o; }
    LDS_WAIT(); asm volatile("" ::: "memory");
}

__device__ __forceinline__ void p0_prologue(Frame& F, CArgs a) {
    LAS float* scr = (LAS float*)(F.lds + F.wave * 16640);
    const int gw = F.vcu * NWAVES + F.wave, NGW = F.G * NWAVES, lane = LANE_NOW();
    unsigned char* ws = a.ws;
    const float* w_in = (const float*)a.in[3];
    bf16_t* WIN = (bf16_t*)(ws + WS_WIN); bf16_t* WUQ = (bf16_t*)(ws + WS_WUQ); bf16_t* WUKV = (bf16_t*)(ws + WS_WUKV); bf16_t* WLRU = (bf16_t*)(ws + WS_WLRU); bf16_t* WOUT = (bf16_t*)(ws + WS_WOUT);
    constexpr int I_IN = 16 * 81, I_UQ = 12 * 24, I_UKV = 4 * 32, I_LRU = 4 * 32, I_OUT = 16 * 16, NITEMS = I_IN + I_UQ + I_UKV + I_LRU + I_OUT;
    for (int it = gw; it < NITEMS; it += NGW) {
        int r = it;
        if (r < I_IN) { const int kb = r / 81, nb = r % 81, nd0 = 64 * nb, k0 = 64 * kb;
            if (nd0 < 5120) tr_item(w_in, 5152, nd0 < 3072 ? nd0 : nd0 + 32, WIN, 1024, nd0, k0, nullptr, scr, lane);
            else tr_item(w_in, 5152, 3072, WIN, 1024, nd0, k0, nullptr, scr, lane, 32, 32);
            continue; }
        r -= I_IN;
        if (r < I_UQ) { const int kb = r / 24, nb = r % 24; tr_item((const float*)a.in[12], 1536, 64 * nb, WUQ, 768, 64 * nb, 64 * kb, (const float*)a.in[11], scr, lane, 64, 64, 32.f); continue; }
        r -= I_UQ;
        if (r < I_UKV) { const int kb = r / 32, nb = r % 32, nd0 = 64 * nb, pn = nd0 >> 8, bj = (nd0 >> 7) & 1, wcp = (nd0 >> 6) & 1;
#pragma unroll 1
            for (int hh = 0; hh < 2; ++hh) tr_item((const float*)a.in[14], 2048, (2 * pn + hh) * 128 + wcp * 64 + 32 * bj, WUKV, 256, nd0 + 32 * hh, 64 * kb, (const float*)a.in[13], scr, lane, 32, 32, 16.f);
            continue; }
        r -= I_UKV;
        if (r < I_LRU) { const int kb = r / 32, nb = r % 32, nd0 = 64 * nb, pn = nd0 >> 8, bj = (nd0 >> 7) & 1, xb = nd0 & 127, blk = pn >> 1;
            tr_item((const float*)a.in[bj ? 8 : 6] + (size_t)blk * 65536, 256, 128 * (pn & 1) + xb, WLRU, 256, nd0, 64 * kb, nullptr, scr, lane); continue; }
        r -= I_LRU;
        { const int kb = r / 16, nb = r % 16; tr_item((const float*)a.in[17], 1024, 64 * nb, WOUT, 1024, 64 * nb, 64 * kb, nullptr, scr, lane); }
    }
    const float* x = (const float*)a.in[0]; const float* gm = (const float*)a.in[2]; bf16_t* XN = (bf16_t*)(ws + WS_R1);
    f32x4 g4[4];
#pragma unroll
    for (int j = 0; j < 4; ++j) g4[j] = *(const f32x4*)(gm + 4 * lane + 256 * j);
    for (int m = gw; m < M; m += NGW) {
        const f32x4* xr = (const f32x4*)(x + (size_t)m * D) + lane; f32x4 v[4]; float s = 0.f;
#pragma unroll
        for (int j = 0; j < 4; ++j) { v[j] = xr[64 * j]; s += dot4(v[j]); }
        const float rstd = rsqrtf(wave_sum(s) * (1.f / 1024.f) + EPS);
        u32x2* o8 = (u32x2*)(XN + (size_t)m * D) + lane;
#pragma unroll
        for (int j = 0; j < 4; ++j) { const f32x4 y = v[j] * rstd * g4[j]; u32x2 w; w.x = pk2(y[0], y[1]); w.y = pk2(y[2], y[3]); o8[64 * j] = w; }
    }
    const int gt = F.vcu * NTHREADS + F.tid, NGT = F.G * NTHREADS;
    const int* pos = (const int*)a.in[1]; float* CS = (float*)(ws + WS_CS);
    for (int i = gt; i < M * 16; i += NGT) { const int t = i >> 4, j = i & 15; const float fr = powf(10000.f, -(float)j / 16.f); const float ang = (float)pos[t] * fr; CS[t * 32 + j] = cosf(ang); CS[t * 32 + 16 + j] = sinf(ang); }
    float* WR = (float*)(ws + WS_MISC + MISC_WR); const float* gf = (const float*)a.in[18]; const float* wg = (const float*)a.in[19]; const float* we = (const float*)a.in[21];
    for (int i = gt; i < 36 * 1024; i += NGT) { const int j = i >> 10, k = i & 1023; WR[i] = (j < 4 ? wg[k * 4 + j] : we[k * 32 + (j - 4)]) * gf[k]; }
}

__device__ __forceinline__ void moe_weight_convert(Frame& F, CArgs a, int part, int lo, int nblk) {
    LAS float* scr = (LAS float*)(F.lds + F.wave * 16640);
    const int gw = lo * NWAVES + F.wave, NGW = nblk * NWAVES, lane = LANE_NOW();
    bf16_t* WGU = (bf16_t*)(a.ws + WS_WGU); bf16_t* WDN = (bf16_t*)(a.ws + WS_WDN); const float* gf = (const float*)a.in[18];
    constexpr int I_GU = 32 * 16 * 8, I_DN = 32 * 4 * 16;
    for (int it = (part == 0 ? gw : I_GU + gw); it < (part == 0 ? I_GU : I_GU + I_DN); it += NGW) {
        if (it < I_GU) { const int e = it >> 7, r = it & 127, kb = r >> 3, nb = r & 7, nd0 = 64 * nb, pn = nd0 >> 8, bj = (nd0 >> 7) & 1, xb = nd0 & 127;
            tr_item((const float*)a.in[bj ? 24 : 23] + (size_t)e * 262144, 256, 128 * pn + xb, (bf16_t*)((unsigned char*)WGU + (size_t)e * 524288), 1024, nd0, 64 * kb, gf, scr, lane, 64, 64, 32.f); }
        else { const int r0 = it - I_GU, e = r0 >> 6, r = r0 & 63, kb = r >> 4, nb = r & 15;
            tr_item((const float*)a.in[25] + (size_t)e * 262144, 1024, 64 * nb, (bf16_t*)((unsigned char*)WDN + (size_t)e * 262144), 256, 64 * nb, 64 * kb, nullptr, scr, lane, 64, 64, 16.f); }
    }
}

template <bool DRY> __device__ __forceinline__ void p2a_conv(Frame& F, CArgs a) {
    unsigned char* ws = a.ws; bf16_t* XR = (bf16_t*)(ws + WS_XR); const bf16_t* HALO = (const bf16_t*)(ws + WS_MISC + MISC_HALO);
    const float* cw = (const float*)a.in[4]; const float* cb = (const float*)a.in[5];
    for (int b = F.vcu; b < 256; b += F.G) {
        const int pm = b >> 2, cg = b & 3, cp = F.tid & 127, sg = F.tid >> 7, c = cg * 256 + 2 * cp, base = pm * 256 + sg * 64;
        float h0[3], h1[3];
#pragma unroll
        for (int i = 0; i < 3; ++i) { unsigned w = 0u;
            if (sg == 0) { if (pm > 0) w = *(const unsigned*)(HALO + ((size_t)(pm - 1) * 3 + i) * 1024 + c); }
            else w = *(const unsigned*)(XR + (size_t)(base - 3 + i) * 1024 + c);
            h0[i] = lo2f(w); h1[i] = hi2f(w); }
        VM_WAIT(); __syncthreads();
        float w0[4], w1[4];
#pragma unroll
        for (int k = 0; k < 4; ++k) { w0[k] = cw[k * 1024 + c]; w1[k] = cw[k * 1024 + c + 1]; }
        const float b0 = cb[c], b1 = cb[c + 1];
        for (int j0 = 0; j0 < 64; j0 += 8) {
            unsigned xw[8];
#pragma unroll
            for (int j = 0; j < 8; ++j) xw[j] = *(const unsigned*)(XR + (size_t)(base + j0 + j) * 1024 + c);
#pragma unroll
            for (int j = 0; j < 8; ++j) { const float x0 = lo2f(xw[j]), x1 = hi2f(xw[j]);
                const float y0 = b0 + w0[0] * h0[0] + w0[1] * h0[1] + w0[2] * h0[2] + w0[3] * x0, y1 = b1 + w1[0] * h1[0] + w1[1] * h1[1] + w1[2] * h1[2] + w1[3] * x1;
                h0[0] = h0[1]; h0[1] = h0[2]; h0[2] = x0; h1[0] = h1[1]; h1[1] = h1[2]; h1[2] = x1;
                const unsigned yw_ = pk2(y0, y1); if (DRY) asm volatile("" :: "v"(yw_)); else *(unsigned*)(XR + (size_t)(base + j0 + j) * 1024 + c) = yw_; }
        }
        __syncthreads();
    }
    if (!DRY && F.wave < 4) {
        const float* PQ = (const float*)(ws + WS_SSQP); const float* PKV = (const float*)(ws + WS_SSQP + SSQP_KV); float* RQ = (float*)(ws + WS_CTL + CTL_SSQ_Q); float* RKV = (float*)(ws + WS_CTL + CTL_SSQ_KV);
        float* KPE = (float*)(ws + WS_KPE); const float* CS = (const float*)(ws + WS_CS); float* KSSQ = (float*)(ws + WS_MISC + MISC_KSSQ); const float* kg = (const float*)a.in[16];
        const bf16_t* XN = (const bf16_t*)(ws + WS_R1); const bf16_t* WK = (const bf16_t*)(ws + WS_WIN) + (size_t)5120 * 1024;
        const int lane = LANE_NOW(), r16 = lane & 15, q4 = lane >> 4; LAS float* kl = (LAS float*)(F.lds + F.wave * 4096);
        for (int rb = F.vcu * 4 + F.wave; rb < M / 16; rb += F.G * 4) {
            const bf16_t* ap = XN + (size_t)(rb * 16 + r16) * 1024 + 8 * q4; const bf16_t* bp0 = WK + (size_t)r16 * 1024 + 8 * q4; const bf16_t* bp1 = bp0 + 16 * 1024;
            f32x4 acc0 = {0.f, 0.f, 0.f, 0.f}, acc1 = acc0;
#pragma unroll 8
            for (int s32 = 0; s32 < 32; ++s32) { const bf16x8 av = *(const bf16x8*)(ap + 32 * s32), b0 = *(const bf16x8*)(bp0 + 32 * s32), b1 = *(const bf16x8*)(bp1 + 32 * s32);
                acc0 = __builtin_amdgcn_mfma_f32_16x16x32_bf16(av, b0, acc0, 0, 0, 0); acc1 = __builtin_amdgcn_mfma_f32_16x16x32_bf16(av, b1, acc1, 0, 0, 0); }
#pragma unroll
            for (int i2 = 0; i2 < 4; ++i2) { kl[(4 * q4 + i2) * 33 + r16] = acc0[i2]; kl[(4 * q4 + i2) * 33 + 16 + r16] = acc1[i2]; }
            LDS_WAIT();
            if (lane < 16) {
                const int row = rb * 16 + lane; float kp[32]; float ss = 0.f;
#pragma unroll
                for (int j2 = 0; j2 < 32; ++j2) { kp[j2] = kl[lane * 33 + j2]; ss += kp[j2] * kp[j2]; }
                KSSQ[row] = ss;
                { const f32x4 a0 = *(const f32x4*)(PQ + (size_t)row * 12), a1 = *(const f32x4*)(PQ + (size_t)row * 12 + 4), a2 = *(const f32x4*)(PQ + (size_t)row * 12 + 8), b0 = *(const f32x4*)(PKV + (size_t)row * 4);
                  const float sq = ((a0[0] + a0[1]) + (a0[2] + a0[3])) + ((a1[0] + a1[1]) + (a1[2] + a1[3])) + ((a2[0] + a2[1]) + (a2[2] + a2[3])), sk = (b0[0] + b0[1]) + (b0[2] + b0[3]);
                  RQ[row] = rsqrtf(sq * (1.f / 768.f) + EPS); RKV[row] = rsqrtf(sk * (1.f / 256.f) + EPS); }
#pragma unroll
                for (int i = 0; i < 4; ++i) { const f32x4 g1 = *(const f32x4*)(kg + 64 + 4 * i), g2 = *(const f32x4*)(kg + 80 + 4 * i), cs = *(const f32x4*)(CS + (size_t)row * 32 + 4 * i), sn = *(const f32x4*)(CS + (size_t)row * 32 + 16 + 4 * i);
                    f32x4 o1, o2;
#pragma unroll
                    for (int e = 0; e < 4; ++e) { const float k1 = kp[4 * i + e] * g1[e], k2 = kp[16 + 4 * i + e] * g2[e]; o1[e] = k1 * cs[e] - k2 * sn[e]; o2[e] = k1 * sn[e] + k2 * cs[e]; }
                    *(f32x4*)(KPE + (size_t)row * 32 + 4 * i) = o1; *(f32x4*)(KPE + (size_t)row * 32 + 16 + 4 * i) = o2; }
            }
            LDS_WAIT();
        }
    }
}

__device__ __forceinline__ void glds16(const void* gsrc, unsigned lds_dst) { unsigned keep;
    asm volatile("s_mov_b32 %0, m0\n\ts_mov_b32 m0, %2\n\ts_nop 0\n\tglobal_load_lds_dwordx4 %1, off\n\ts_mov_b32 m0, %0" : "=&s"(keep) : "v"(gsrc), "s"(lds_dst) : "memory"); }
__device__ __forceinline__ void glds16s(const void* sbase, unsigned voff, unsigned lds_dst) { unsigned keep;
    asm volatile("s_mov_b32 %0, m0\n\ts_mov_b32 m0, %3\n\ts_nop 0\n\tglobal_load_lds_dwordx4 %1, %2\n\ts_mov_b32 m0, %0" : "=&s"(keep) : "v"(voff), "s"(sbase), "s"(lds_dst) : "memory"); }
__device__ __forceinline__ void glds12(const void* gsrc, unsigned lds_dst) { unsigned keep;
    asm volatile("s_mov_b32 %0, m0\n\ts_mov_b32 m0, %2\n\ts_nop 0\n\tglobal_load_lds_dwordx3 %1, off\n\ts_mov_b32 m0, %0" : "=&s"(keep) : "v"(gsrc), "s"(lds_dst) : "memory"); }
#define AWAIT_BAR(N) asm volatile("s_waitcnt vmcnt(" #N ") lgkmcnt(0)\n\ts_barrier" ::: "memory")
constexpr int AT_K = 0, AT_V = 24576, AT_WS = 40960, AT_OST = 43008, AT_END = 75776;
constexpr float C2 = 0.10206207261596575f * 1.4426950408889634f;

__device__ __forceinline__ void attn_unit_v1(int h, int qb, CArgs a, const LAS float* carry, LAS unsigned char* shm) {
    const int tid = threadIdx.x, lane = tid & 63, r32 = lane & 31, hi = lane >> 5; const int wid = __builtin_amdgcn_readfirstlane(tid >> 6);
    unsigned char* ws = a.ws;
    const bf16_t* QRAW = (const bf16_t*)(ws + WS_R1); const unsigned char* KI = ws + WS_KIMG + (size_t)h * 256 * 12288; const unsigned char* VI = (const unsigned char*)a.out + 32 * MiB + (size_t)h * 256 * 8192;
    const float* CS = (const float*)(ws + WS_CS); const float* qg = (const float*)a.in[15];
    const int q0 = qb * 256, rowq = q0 + wid * 32 + r32;
    const unsigned lds0 = (unsigned)(uintptr_t)shm;
    LAS float* wsf = (LAS float*)(shm + AT_WS) + wid * 64;
    bf16x8 qr[6];
    {
        const bf16_t* qp = QRAW + (size_t)rowq * 1536 + h * 96 + hi * 8;
        u32x4 raw[6]; float qv[6][8]; float ss = 0.f;
#pragma unroll
        for (int d0 = 0; d0 < 6; ++d0) raw[d0] = *(const u32x4*)(qp + d0 * 16);
#pragma unroll
        for (int d0 = 0; d0 < 6; ++d0)
#pragma unroll
            for (int j = 0; j < 4; ++j) { qv[d0][2 * j] = lo2f(raw[d0][j]); qv[d0][2 * j + 1] = hi2f(raw[d0][j]); ss += qv[d0][2 * j] * qv[d0][2 * j] + qv[d0][2 * j + 1] * qv[d0][2 * j + 1]; }
        ss += __shfl_xor(ss, 32);
        const float rs = rsqrtf(ss * (1.f / 96.f) + EPS);
#pragma unroll
        for (int d0 = 0; d0 < 6; ++d0) { const f32x4 g0 = *(const f32x4*)(qg + d0 * 16 + hi * 8), g1 = *(const f32x4*)(qg + d0 * 16 + hi * 8 + 4);
#pragma unroll
            for (int j = 0; j < 4; ++j) { qv[d0][j] *= rs * g0[j]; qv[d0][4 + j] *= rs * g1[j]; } }
        const f32x4 c0 = *(const f32x4*)(CS + (size_t)rowq * 32 + hi * 8), c1 = *(const f32x4*)(CS + (size_t)rowq * 32 + hi * 8 + 4), s0 = *(const f32x4*)(CS + (size_t)rowq * 32 + 16 + hi * 8), s1 = *(const f32x4*)(CS + (size_t)rowq * 32 + 16 + hi * 8 + 4);
#pragma unroll
        for (int j = 0; j < 8; ++j) { const float cs = j < 4 ? c0[j & 3] : c1[j & 3], sn = j < 4 ? s0[j & 3] : s1[j & 3]; const float x1 = qv[4][j], x2 = qv[5][j]; qv[4][j] = x1 * cs - x2 * sn; qv[5][j] = x1 * sn + x2 * cs; }
#pragma unroll
        for (int d0 = 0; d0 < 6; ++d0) { u32x4 w;
#pragma unroll
            for (int j = 0; j < 4; ++j) w[j] = pk2(qv[d0][2 * j] * C2, qv[d0][2 * j + 1] * C2);
            qr[d0] = __builtin_bit_cast(bf16x8, w); }
    }
    const int NT = 4 * qb + 4, mylast = 4 * qb + (wid >> 1);
#define AT_DMA(t, buf) do { const unsigned char* kt_ = KI + (size_t)(t) * 12288 + wid * 1024 + lane * 16; const unsigned kd_ = lds0 + AT_K + (buf) * 12288 + wid * 1024; \
        glds16(kt_, (unsigned)__builtin_amdgcn_readfirstlane(kd_)); if (wid < 4) glds16(kt_ + 8192, (unsigned)__builtin_amdgcn_readfirstlane(kd_ + 8192)); \
        glds16(VI + (size_t)(t) * 8192 + wid * 1024 + lane * 16, (unsigned)__builtin_amdgcn_readfirstlane(lds0 + AT_V + (buf) * 8192 + wid * 1024)); } while (0)
#define AT_WAIT1() do { if (wid < 4) asm volatile("s_waitcnt vmcnt(3)" ::: "memory"); else asm volatile("s_waitcnt vmcnt(2)" ::: "memory"); asm volatile("s_waitcnt lgkmcnt(0)\n\ts_barrier" ::: "memory"); } while (0)
    float m_run = -1e30f, l_run = 0.f; f32x16 o[2]; o[0] = f32x16{}; o[1] = f32x16{};
    AT_DMA(0, 0);
    for (int t = 0; t < NT; ++t) {
        const int buf = t & 1;
        if (t + 1 < NT) { AT_DMA(t + 1, buf ^ 1); AT_WAIT1(); } else { AWAIT_BAR(0); }
        if (t <= mylast) {
            const LAS unsigned char* kb = shm + AT_K + buf * 12288 + hi * 1024 + r32 * 16;
            f32x16 p0 = f32x16{}, p1 = f32x16{};
#pragma unroll
            for (int d0 = 0; d0 < 6; ++d0) { const bf16x8 b0 = *(const LAS bf16x8*)(kb + d0 * 2048), b1 = *(const LAS bf16x8*)(kb + d0 * 2048 + 512);
                p0 = __builtin_amdgcn_mfma_f32_32x32x16_bf16(b0, qr[d0], p0, 0, 0, 0); p1 = __builtin_amdgcn_mfma_f32_32x32x16_bf16(b1, qr[d0], p1, 0, 0, 0); }
            float rm = fmaxf(p0[0], p1[0]);
#pragma unroll
            for (int r = 1; r < 16; ++r) rm = fmaxf(rm, fmaxf(p0[r], p1[r]));
            rm = fmaxf(rm, __shfl_xor(rm, 32));
            const float mn = fmaxf(m_run, rm), alpha = fexp2(m_run - mn); m_run = mn;
            float ps = 0.f;
#pragma unroll
            for (int r = 0; r < 16; ++r) { p0[r] = fexp2(p0[r] - mn); p1[r] = fexp2(p1[r] - mn); ps += p0[r] + p1[r]; }
            l_run = l_run * alpha + ps;
            if (__any(alpha != 1.f)) {
                if (hi == 0) wsf[r32] = alpha;
                LDS_WAIT();
#pragma unroll
                for (int r = 0; r < 16; ++r) { const float f = wsf[crow(r, hi)]; o[0][r] *= f; o[1][r] *= f; }
            }
            u32x4 pw[4];
#pragma unroll
            for (int j = 0; j < 4; ++j) { pw[0][j] = pk2(p0[2 * j], p0[2 * j + 1]); pw[1][j] = pk2(p0[8 + 2 * j], p0[8 + 2 * j + 1]); pw[2][j] = pk2(p1[2 * j], p1[2 * j + 1]); pw[3][j] = pk2(p1[8 + 2 * j], p1[8 + 2 * j + 1]); }
            const LAS unsigned char* vb = shm + AT_V + buf * 8192 + ((lane >> 4) & 1) * 32 + (lane & 3) * 8 + (4 * hi + ((lane & 15) >> 2)) * 64;
#pragma unroll
            for (int d0 = 0; d0 < 2; ++d0)
#pragma unroll
                for (int ks = 0; ks < 4; ++ks) {
                    typedef short v4i16_t __attribute__((ext_vector_type(4)));
                    const s16x4 lo = __builtin_bit_cast(s16x4, __builtin_amdgcn_ds_read_tr16_b64_v4i16((LAS v4i16_t*)(vb + d0 * 4096 + ks * 1024)));
                    const s16x4 hh = __builtin_bit_cast(s16x4, __builtin_amdgcn_ds_read_tr16_b64_v4i16((LAS v4i16_t*)(vb + d0 * 4096 + ks * 1024 + 512)));
                    const bf16x8 vf = (bf16x8){lo[0], lo[1], lo[2], lo[3], hh[0], hh[1], hh[2], hh[3]};
                    o[d0] = __builtin_amdgcn_mfma_f32_32x32x16_bf16(__builtin_bit_cast(bf16x8, pw[ks]), vf, o[d0], 0, 0, 0);
                }
        }
        asm volatile("s_waitcnt lgkmcnt(0)\n\ts_barrier" ::: "memory");
    }
#undef AT_DMA
#undef AT_WAIT1
    l_run += __shfl_xor(l_run, 32);
    if (hi == 0) wsf[32 + r32] = l_run;
    LDS_WAIT();
    LAS bf16_t* stg = (LAS bf16_t*)(shm + AT_OST) + wid * 2048;
#pragma unroll
    for (int r = 0; r < 16; ++r) { const int orow = crow(r, hi); const float il = frcp(wsf[32 + orow]);
#pragma unroll
        for (int d0 = 0; d0 < 2; ++d0) stg[orow * 64 + d0 * 32 + r32] = (bf16_t)f2bf(o[d0][r] * il); }
    LDS_WAIT();
    const bf16_t* GB = (const bf16_t*)a.out; const bf16_t* HL = (const bf16_t*)(ws + WS_GR); const bf16_t* AC = (const bf16_t*)(ws + WS_GA); bf16_t* MG = (bf16_t*)(ws + WS_XR);
#pragma unroll
    for (int i = 0; i < 4; ++i) { const int row = i * 8 + (lane >> 3), ch = lane & 7; const u32x4 yv = *(const LAS u32x4*)(stg + row * 64 + ch * 8);
        const size_t go = (size_t)(q0 + wid * 32 + row) * 1024 + h * 64 + ch * 8;
        const u32x4 gb = *(const u32x4*)(GB + go), hl = *(const u32x4*)(HL + go), ac = *(const u32x4*)(AC + go); u32x4 w;
#pragma unroll
        for (int j = 0; j < 4; ++j) { const float c0 = carry[ch * 8 + 2 * j], c1 = carry[ch * 8 + 2 * j + 1];
            w[j] = pk2(lo2f(yv[j]) * lo2f(gb[j]) + lo2f(hl[j]) + lo2f(ac[j]) * c0, hi2f(yv[j]) * hi2f(gb[j]) + hi2f(hl[j]) + hi2f(ac[j]) * c1); }
        *(u32x4*)(MG + go) = w; }
    asm volatile("s_waitcnt lgkmcnt(0)\n\ts_barrier" ::: "memory");
}


constexpr int A2_K = 0, A2_V = 36864, A2_WS = 61440, A2_OST = 63488;
#define A2_MF(a_, b_, c_) __builtin_amdgcn_mfma_f32_32x32x16_bf16(a_, b_, c_, 0, 0, 0)
#define A2_SB() __builtin_amdgcn_sched_barrier(0)
#define A2_PIN(x) asm volatile("" : "+v"(x))
#define A2_KF(d0, blk) ((ABL == 5) ? qr[(d0)] : *(const LAS bf16x8*)(kp + (d0) * 2048 + (blk) * 512))
typedef short v4i16_t __attribute__((ext_vector_type(4)));
#define A2_VT(off) __builtin_bit_cast(s16x4, __builtin_amdgcn_ds_read_tr16_b64_v4i16((LAS v4i16_t*)(vp + (off))))
#define A2_VJ(lo_, hi_, j) do { if (ABL == 5) { lo_ = (s16x4){qr[0][0], qr[0][1], qr[1][2], qr[1][3]}; hi_ = (s16x4){qr[2][0], qr[2][1], qr[3][2], qr[3][3]}; } else { lo_ = A2_VT(((j) & 1) * 4096 + ((j) >> 1) * 1024); hi_ = A2_VT(((j) & 1) * 4096 + ((j) >> 1) * 1024 + 512); } } while (0)
#define A2_VF(lo_, hi_) ((bf16x8){lo_[0], lo_[1], lo_[2], lo_[3], hi_[0], hi_[1], hi_[2], hi_[3]})
#define A2_EX(x) ((ABL == 2) ? (x) : fexp2(x))
#define A2_E3(P, b) do { P[b] = A2_EX(P[b]); P[(b) + 1] = A2_EX(P[(b) + 1]); P[(b) + 2] = A2_EX(P[(b) + 2]); } while (0)
#define A2_E2(P, b) do { P[b] = A2_EX(P[b]); P[(b) + 1] = A2_EX(P[(b) + 1]); } while (0)
#define A2_PK2(W, j, P, b) do { W[j] = pk2(P[b], P[(b) + 1]); W[(j) + 1] = pk2(P[(b) + 2], P[(b) + 3]); } while (0)
#define A2_S4(P, b) do { if (ABL != 2) { sacc += P[b]; sacc += P[(b) + 1]; sacc += P[(b) + 2]; sacc += P[(b) + 3]; } } while (0)

template <int ABL> __device__ __forceinline__ void attn_unit_v2(int h, int qb, CArgs a, const LAS float* carry, LAS unsigned char* shm) {
    const int tid = threadIdx.x, lane = tid & 63, r32 = lane & 31, hi = lane >> 5; const int wid = __builtin_amdgcn_readfirstlane(tid >> 6);
    unsigned char* ws = a.ws;
    const bf16_t* QRAW = (const bf16_t*)(ws + WS_R1); const unsigned char* KI = ws + WS_KIMG + (size_t)h * 256 * 12288; const unsigned char* VI = (const unsigned char*)a.out + 32 * MiB + (size_t)h * 256 * 8192;
    const float* CS = (const float*)(ws + WS_CS); const float* qg = (const float*)a.in[15];
    const int q0 = qb * 256, rowq = q0 + wid * 32 + r32;
    const unsigned lds0 = (unsigned)(uintptr_t)shm;
    LAS float* wsf = (LAS float*)(shm + A2_WS) + wid * 64;
    const int NT = 4 * qb + 4, mylast = 4 * qb + (wid >> 1);
    const unsigned char* ksrc = KI + wid * 1024 + lane * 16; const unsigned char* vsrc = VI + wid * 1024 + lane * 16;
    const unsigned kdst = lds0 + A2_K + wid * 1024, vdst = lds0 + A2_V + wid * 1024;
#define A2_DMAK(t, slot) do { if (ABL == 3) break; glds16(ksrc + (size_t)(t) * 12288, (unsigned)__builtin_amdgcn_readfirstlane(kdst + (slot) * 12288)); \
        if (wid < 4) glds16(ksrc + (size_t)(t) * 12288 + 8192, (unsigned)__builtin_amdgcn_readfirstlane(kdst + (slot) * 12288 + 8192)); } while (0)
#define A2_DMAV(t, slot) do { if (ABL != 3) glds16(vsrc + (size_t)(t) * 8192, (unsigned)__builtin_amdgcn_readfirstlane(vdst + (slot) * 8192)); } while (0)
#define A2_WAITFULL() do { if (wid < 4) asm volatile("s_waitcnt vmcnt(3)" ::: "memory"); else asm volatile("s_waitcnt vmcnt(2)" ::: "memory"); } while (0)
#define A2_BAR() do { if (ABL == 1) asm volatile("s_waitcnt lgkmcnt(0)" ::: "memory"); else asm volatile("s_waitcnt lgkmcnt(0)\n\ts_barrier" ::: "memory"); } while (0)
    bf16x8 qr[6];
    {
        const bf16_t* qp = QRAW + (size_t)rowq * 1536 + h * 96 + hi * 8;
        u32x4 raw[6]; float qv[6][8]; float ss = 0.f;
#pragma unroll
        for (int d0 = 0; d0 < 6; ++d0) raw[d0] = *(const u32x4*)(qp + d0 * 16);
        A2_DMAK(0, 0); A2_DMAV(0, 0); A2_DMAK(1, 1); A2_DMAV(1, 1); A2_DMAK(2, 2);
#pragma unroll
        for (int d0 = 0; d0 < 6; ++d0)
#pragma unroll
            for (int j = 0; j < 4; ++j) { qv[d0][2 * j] = lo2f(raw[d0][j]); qv[d0][2 * j + 1] = hi2f(raw[d0][j]); ss += qv[d0][2 * j] * qv[d0][2 * j] + qv[d0][2 * j + 1] * qv[d0][2 * j + 1]; }
        ss += __shfl_xor(ss, 32);
        const float rs = rsqrtf(ss * (1.f / 96.f) + EPS);
#pragma unroll
        for (int d0 = 0; d0 < 6; ++d0) { const f32x4 g0 = *(const f32x4*)(qg + d0 * 16 + hi * 8), g1 = *(const f32x4*)(qg + d0 * 16 + hi * 8 + 4);
#pragma unroll
            for (int j = 0; j < 4; ++j) { qv[d0][j] *= rs * g0[j]; qv[d0][4 + j] *= rs * g1[j]; } }
        const f32x4 c0 = *(const f32x4*)(CS + (size_t)rowq * 32 + hi * 8), c1 = *(const f32x4*)(CS + (size_t)rowq * 32 + hi * 8 + 4), s0 = *(const f32x4*)(CS + (size_t)rowq * 32 + 16 + hi * 8), s1 = *(const f32x4*)(CS + (size_t)rowq * 32 + 16 + hi * 8 + 4);
#pragma unroll
        for (int j = 0; j < 8; ++j) { const float cs = j < 4 ? c0[j & 3] : c1[j & 3], sn = j < 4 ? s0[j & 3] : s1[j & 3]; const float x1 = qv[4][j], x2 = qv[5][j]; qv[4][j] = x1 * cs - x2 * sn; qv[5][j] = x1 * sn + x2 * cs; }
#pragma unroll
        for (int d0 = 0; d0 < 6; ++d0) { u32x4 w;
#pragma unroll
            for (int j = 0; j < 4; ++j) w[j] = pk2(qv[d0][2 * j] * C2, qv[d0][2 * j + 1] * C2);
            qr[d0] = __builtin_bit_cast(bf16x8, w); }
    }
    if (wid >= 4) __builtin_amdgcn_s_setprio(1);
    float lsum = 0.f; f32x16 o[2]; o[0] = f32x16{}; o[1] = f32x16{};
    f32x16 pA0, pA1, pB0, pB1;
    if (wid < 4) asm volatile("s_waitcnt vmcnt(6)" ::: "memory"); else asm volatile("s_waitcnt vmcnt(4)" ::: "memory");
    A2_BAR();
    {
        const LAS unsigned char* kp = shm + A2_K + hi * 1024 + r32 * 16;
        pA0 = f32x16{}; pA1 = f32x16{};
#pragma unroll
        for (int d0 = 0; d0 < 6; ++d0) { pA0 = A2_MF(A2_KF(d0, 0), qr[d0], pA0); pA1 = A2_MF(A2_KF(d0, 1), qr[d0], pA1); }
    }
    int sk_next = 12288, sv_cur = 0;
#define A2_STEP(C0, C1, N0, N1, t, HASN) do { \
        const LAS unsigned char* kp = shm + A2_K + sk_next + hi * 1024 + r32 * 16; const LAS unsigned char* vp = shm + A2_V + sv_cur + ((lane >> 4) & 1) * 32 + (lane & 3) * 8 + (4 * hi + ((lane & 15) >> 2)) * 64; \
        bf16x8 k0, k1, k2; s16x4 vl0, vh0, vl1, vh1, vl2, vh2; u32x4 w0, w1, w2, w3; float sacc = 0.f; \
        A2_SB(); \
        if (HASN) { k0 = A2_KF(0, 0); k1 = A2_KF(0, 1); k2 = A2_KF(1, 0); A2_SB(); \
            N0 = A2_MF(k0, qr[0], (f32x16{})); k0 = A2_KF(1, 1); A2_E3(C0, 0);  A2_PIN(C0); A2_SB(); \
            N1 = A2_MF(k1, qr[0], (f32x16{})); k1 = A2_KF(2, 0); A2_E3(C0, 3);  A2_PIN(C0); A2_SB(); \
            N0 = A2_MF(k2, qr[1], N0);         k2 = A2_KF(2, 1); A2_E3(C0, 6);  A2_PIN(C0); A2_SB(); \
            N1 = A2_MF(k0, qr[1], N1);         k0 = A2_KF(3, 0); A2_E3(C0, 9);  A2_PIN(C0); A2_SB(); \
            N0 = A2_MF(k1, qr[2], N0);         k1 = A2_KF(3, 1); A2_E3(C0, 12); A2_PIN(C0); A2_SB(); \
            N1 = A2_MF(k2, qr[2], N1);         k2 = A2_KF(4, 0); C0[15] = A2_EX(C0[15]); A2_E2(C1, 0); A2_PIN(C0); A2_PIN(C1); A2_SB(); \
            N0 = A2_MF(k0, qr[3], N0);         k0 = A2_KF(4, 1); A2_E3(C1, 2);  A2_PIN(C1); A2_SB(); \
            N1 = A2_MF(k1, qr[3], N1);         k1 = A2_KF(5, 0); A2_E3(C1, 5);  A2_PIN(C1); A2_SB(); \
            N0 = A2_MF(k2, qr[4], N0);         k2 = A2_KF(5, 1); A2_E2(C1, 8);  A2_PK2(w0, 0, C0, 0);  A2_PIN(C1); A2_PIN(w0); A2_SB(); \
            N1 = A2_MF(k0, qr[4], N1);                           A2_E2(C1, 10); A2_PK2(w0, 2, C0, 4);  A2_PIN(C1); A2_PIN(w0); A2_SB(); \
            N0 = A2_MF(k1, qr[5], N0);         A2_VJ(vl0, vh0, 0); A2_E2(C1, 12); A2_PK2(w1, 0, C0, 8);  A2_PIN(C1); A2_PIN(w1); A2_SB(); \
            N1 = A2_MF(k2, qr[5], N1);         A2_VJ(vl1, vh1, 1); A2_E2(C1, 14); A2_PK2(w1, 2, C0, 12); A2_PIN(C1); A2_PIN(w1); A2_SB(); \
        } else { \
            _Pragma("unroll") for (int r_ = 0; r_ < 16; ++r_) { C0[r_] = A2_EX(C0[r_]); C1[r_] = A2_EX(C1[r_]); } \
            A2_PK2(w0, 0, C0, 0); A2_PK2(w0, 2, C0, 4); A2_PK2(w1, 0, C0, 8); A2_PK2(w1, 2, C0, 12); A2_VJ(vl0, vh0, 0); A2_VJ(vl1, vh1, 1); A2_SB(); \
        } \
        if ((t) > mylast) { w0 = (u32x4){0u, 0u, 0u, 0u}; w1 = w0; C0 = f32x16{}; C1 = f32x16{}; } \
        o[0] = A2_MF(__builtin_bit_cast(bf16x8, w0), A2_VF(vl0, vh0), o[0]); A2_VJ(vl2, vh2, 2); A2_PK2(w2, 0, C1, 0);  A2_S4(C0, 0);  A2_PIN(w2); A2_PIN(sacc); A2_SB(); \
        o[1] = A2_MF(__builtin_bit_cast(bf16x8, w0), A2_VF(vl1, vh1), o[1]); A2_VJ(vl0, vh0, 3); A2_PK2(w2, 2, C1, 4);  A2_S4(C0, 4);  A2_PIN(w2); A2_PIN(sacc); A2_SB(); \
        o[0] = A2_MF(__builtin_bit_cast(bf16x8, w1), A2_VF(vl2, vh2), o[0]); A2_VJ(vl1, vh1, 4); A2_PK2(w3, 0, C1, 8);  A2_S4(C0, 8);  A2_PIN(w3); A2_PIN(sacc); A2_SB(); \
        o[1] = A2_MF(__builtin_bit_cast(bf16x8, w1), A2_VF(vl0, vh0), o[1]); A2_VJ(vl2, vh2, 5); A2_PK2(w3, 2, C1, 12); A2_S4(C0, 12); A2_PIN(w3); A2_PIN(sacc); A2_SB(); \
        o[0] = A2_MF(__builtin_bit_cast(bf16x8, w2), A2_VF(vl1, vh1), o[0]); A2_VJ(vl0, vh0, 6); A2_S4(C1, 0);  A2_PIN(sacc); A2_SB(); \
        o[1] = A2_MF(__builtin_bit_cast(bf16x8, w2), A2_VF(vl2, vh2), o[1]); A2_VJ(vl1, vh1, 7); A2_S4(C1, 4);  A2_PIN(sacc); A2_SB(); \
        o[0] = A2_MF(__builtin_bit_cast(bf16x8, w3), A2_VF(vl0, vh0), o[0]); A2_S4(C1, 8);  A2_PIN(sacc); A2_SB(); \
        o[1] = A2_MF(__builtin_bit_cast(bf16x8, w3), A2_VF(vl1, vh1), o[1]); A2_S4(C1, 12); A2_PIN(sacc); A2_SB(); \
        lsum += sacc; \
        sk_next = (sk_next == 24576) ? 0 : sk_next + 12288; sv_cur = (sv_cur == 16384) ? 0 : sv_cur + 8192; \
    } while (0)
#define A2_TOP(t) do { const int t_ = (t); if (t_ - 1 <= NT - 4) { A2_WAITFULL(); } else if (t_ - 1 == NT - 3) { asm volatile("s_waitcnt vmcnt(1)" ::: "memory"); } else { asm volatile("s_waitcnt vmcnt(0)" ::: "memory"); } \
        A2_BAR(); if (t_ + 3 < NT) { glds16(kg3, (unsigned)__builtin_amdgcn_readfirstlane(kdst + dk)); if (wid < 4) glds16(kg3 + 8192, (unsigned)__builtin_amdgcn_readfirstlane(kdst + dk + 8192)); } \
        if (t_ + 2 < NT) glds16(vg2, (unsigned)__builtin_amdgcn_readfirstlane(vdst + dv)); \
        kg3 += 12288; vg2 += 8192; dk = (dk == 24576u) ? 0u : dk + 12288u; dv = (dv == 16384u) ? 0u : dv + 8192u; } while (0)
    const unsigned char* kg3 = ksrc + 3 * 12288; const unsigned char* vg2 = vsrc + 2 * 8192; unsigned dk = 0u, dv = 16384u;
    int t = 0;
    for (; t + 2 < NT; t += 2) {
        A2_TOP(t);     A2_STEP(pA0, pA1, pB0, pB1, t, true);
        A2_TOP(t + 1); A2_STEP(pB0, pB1, pA0, pA1, t + 1, true);
    }
    A2_TOP(t);     A2_STEP(pA0, pA1, pB0, pB1, t, true);
    A2_TOP(t + 1); A2_STEP(pB0, pB1, pA0, pA1, t + 1, false);
#undef A2_STEP
#undef A2_TOP
    __builtin_amdgcn_s_setprio(0);
    lsum += __shfl_xor(lsum, 32);
    if (hi == 0) wsf[32 + r32] = lsum;
    LDS_WAIT();
    LAS bf16_t* stg = (LAS bf16_t*)(shm + A2_OST) + wid * 2048;
#pragma unroll
    for (int r = 0; r < 16; ++r) { const int orow = crow(r, hi); const float il = frcp(wsf[32 + orow]);
#pragma unroll
        for (int d0 = 0; d0 < 2; ++d0) stg[orow * 64 + d0 * 32 + r32] = (bf16_t)f2bf(o[d0][r] * il); }
    LDS_WAIT();
    const bf16_t* GB = (const bf16_t*)a.out; const bf16_t* HL = (const bf16_t*)(ws + WS_GR); const bf16_t* AC = (const bf16_t*)(ws + WS_GA); bf16_t* MG = (bf16_t*)(ws + WS_XR);
#pragma unroll
    for (int i = 0; i < 4; ++i) { const int row = i * 8 + (lane >> 3), ch = lane & 7; const u32x4 yv = *(const LAS u32x4*)(stg + row * 64 + ch * 8);
        const size_t go = (size_t)(q0 + wid * 32 + row) * 1024 + h * 64 + ch * 8;
        const u32x4 gb = *(const u32x4*)(GB + go), hl = *(const u32x4*)(HL + go), ac = *(const u32x4*)(AC + go); u32x4 w;
#pragma unroll
        for (int j = 0; j < 4; ++j) { const float c0 = carry[ch * 8 + 2 * j], c1 = carry[ch * 8 + 2 * j + 1];
            w[j] = pk2(lo2f(yv[j]) * lo2f(gb[j]) + lo2f(hl[j]) + lo2f(ac[j]) * c0, hi2f(yv[j]) * hi2f(gb[j]) + hi2f(hl[j]) + hi2f(ac[j]) * c1); }
        *(u32x4*)(MG + go) = w; }
    asm volatile("s_waitcnt vmcnt(0) lgkmcnt(0)\n\ts_barrier" ::: "memory");
#undef A2_DMAK
#undef A2_DMAV
#undef A2_WAITFULL
#undef A2_BAR
}


typedef int v8i __attribute__((ext_vector_type(8)));
constexpr int A4_K = 0, A4_V = 36864, A4_WS = 53248, A4_OST = 55296;
#define A4_PVM(pw_, vf_, acc_) __builtin_amdgcn_mfma_scale_f32_32x32x64_f8f6f4(pw_, vf_, acc_, 0, 0, 0, 0x7f7f7f7f, 0, 0x7f7f7f7f)
#define A4_CV(W, j, P, b) do { int w_ = __builtin_amdgcn_cvt_pk_fp8_f32(P[b], P[(b) + 1], 0, false); W[j] = __builtin_amdgcn_cvt_pk_fp8_f32(P[(b) + 2], P[(b) + 3], w_, true); } while (0)
#define A4_VLD(vf_, d0) do { const u32x4 x0_ = *(const LAS u32x4*)(vp + (d0) * 2048), x1_ = *(const LAS u32x4*)(vp + (d0) * 2048 + 512); \
        vf_ = (v8i){(int)x0_[0], (int)x0_[1], (int)x0_[2], (int)x0_[3], (int)x1_[0], (int)x1_[1], (int)x1_[2], (int)x1_[3]}; } while (0)

__device__ __forceinline__ void attn_unit_v4(int h, int qb, CArgs a, const LAS float* carry, LAS unsigned char* shm) {
    constexpr int ABL = 0;
    const int tid = threadIdx.x, lane = tid & 63, r32 = lane & 31, hi = lane >> 5; const int wid = __builtin_amdgcn_readfirstlane(tid >> 6);
    unsigned char* ws = a.ws;
    const bf16_t* QRAW = (const bf16_t*)(ws + WS_R1); const unsigned char* KI = ws + WS_KIMG + (size_t)h * 256 * 12288; const unsigned char* VI = (const unsigned char*)a.out + 32 * MiB + (size_t)h * 256 * 4096;
    const float* CS = (const float*)(ws + WS_CS); const float* qg = (const float*)a.in[15];
    const int q0 = qb * 256, rowq = q0 + wid * 32 + r32;
    const unsigned lds0 = (unsigned)(uintptr_t)shm;
    LAS float* wsf = (LAS float*)(shm + A4_WS) + wid * 64;
    const int NT = 4 * qb + 4, mylast = 4 * qb + (wid >> 1);
    const unsigned char* ksrc = KI + wid * 1024 + lane * 16; const unsigned char* vsrc = VI + wid * 1024 + lane * 16;
    const unsigned kdst = lds0 + A4_K + wid * 1024, vdst = lds0 + A4_V + wid * 1024;
#define A4_DMAK(t, slot) do { glds16(ksrc + (size_t)(t) * 12288, (unsigned)__builtin_amdgcn_readfirstlane(kdst + (slot) * 12288)); \
        if (wid < 4) glds16(ksrc + (size_t)(t) * 12288 + 8192, (unsigned)__builtin_amdgcn_readfirstlane(kdst + (slot) * 12288 + 8192)); } while (0)
#define A4_DMAV(t, slot) do { if (wid < 4) glds16(vsrc + (size_t)(t) * 4096, (unsigned)__builtin_amdgcn_readfirstlane(vdst + (slot) * 4096)); } while (0)
#define A4_BAR() asm volatile("s_waitcnt lgkmcnt(0)\n\ts_barrier" ::: "memory")
    bf16x8 qr[6];
    {
        const bf16_t* qp = QRAW + (size_t)rowq * 1536 + h * 96 + hi * 8;
        u32x4 raw[6]; float qv[6][8]; float ss = 0.f;
#pragma unroll
        for (int d0 = 0; d0 < 6; ++d0) raw[d0] = *(const u32x4*)(qp + d0 * 16);
        A4_DMAK(0, 0); A4_DMAV(0, 0); A4_DMAK(1, 1); A4_DMAV(1, 1); A4_DMAK(2, 2);
#pragma unroll
        for (int d0 = 0; d0 < 6; ++d0)
#pragma unroll
            for (int j = 0; j < 4; ++j) { qv[d0][2 * j] = lo2f(raw[d0][j]); qv[d0][2 * j + 1] = hi2f(raw[d0][j]); ss += qv[d0][2 * j] * qv[d0][2 * j] + qv[d0][2 * j + 1] * qv[d0][2 * j + 1]; }
        ss += __shfl_xor(ss, 32);
        const float rs = rsqrtf(ss * (1.f / 96.f) + EPS);
#pragma unroll
        for (int d0 = 0; d0 < 6; ++d0) { const f32x4 g0 = *(const f32x4*)(qg + d0 * 16 + hi * 8), g1 = *(const f32x4*)(qg + d0 * 16 + hi * 8 + 4);
#pragma unroll
            for (int j = 0; j < 4; ++j) { qv[d0][j] *= rs * g0[j]; qv[d0][4 + j] *= rs * g1[j]; } }
        const f32x4 c0 = *(const f32x4*)(CS + (size_t)rowq * 32 + hi * 8), c1 = *(const f32x4*)(CS + (size_t)rowq * 32 + hi * 8 + 4), s0 = *(const f32x4*)(CS + (size_t)rowq * 32 + 16 + hi * 8), s1 = *(const f32x4*)(CS + (size_t)rowq * 32 + 16 + hi * 8 + 4);
#pragma unroll
        for (int j = 0; j < 8; ++j) { const float cs = j < 4 ? c0[j & 3] : c1[j & 3], sn = j < 4 ? s0[j & 3] : s1[j & 3]; const float x1 = qv[4][j], x2 = qv[5][j]; qv[4][j] = x1 * cs - x2 * sn; qv[5][j] = x1 * sn + x2 * cs; }
#pragma unroll
        for (int d0 = 0; d0 < 6; ++d0) { u32x4 w;
#pragma unroll
            for (int j = 0; j < 4; ++j) w[j] = pk2(qv[d0][2 * j] * C2, qv[d0][2 * j + 1] * C2);
            qr[d0] = __builtin_bit_cast(bf16x8, w); }
    }
    if (wid >= 4) __builtin_amdgcn_s_setprio(1);
    float lsum = 0.f; f32x16 o[2]; o[0] = f32x16{}; o[1] = f32x16{};
    f32x16 pA0, pA1, pB0, pB1, negm; v8i pwo = (v8i){0, 0, 0, 0, 0, 0, 0, 0};
    if (wid < 4) asm volatile("s_waitcnt vmcnt(6)" ::: "memory"); else asm volatile("s_waitcnt vmcnt(2)" ::: "memory");
    A4_BAR();
    {
        const LAS unsigned char* kp = shm + A4_K + hi * 1024 + r32 * 16;
        pA0 = f32x16{}; pA1 = f32x16{};
#pragma unroll
        for (int d0 = 0; d0 < 6; ++d0) { pA0 = A2_MF(A2_KF(d0, 0), qr[d0], pA0); pA1 = A2_MF(A2_KF(d0, 1), qr[d0], pA1); }
        float rm = fmaxf(pA0[0], pA1[0]);
#pragma unroll
        for (int r = 1; r < 16; ++r) rm = fmaxf(rm, fmaxf(pA0[r], pA1[r]));
        rm = fmaxf(rm, __shfl_xor(rm, 32));
        const float nb = 64.f - rm;
#pragma unroll
        for (int r = 0; r < 16; ++r) { pA0[r] += nb; pA1[r] += nb; negm[r] = nb; }
        asm volatile("" : "+v"(negm));
    }
    int sk_next = 12288, sv_prev = 12288;
#define A4_STEP(C0, C1, N0, N1, t, HASN, HASP) do { \
        const LAS unsigned char* kp = shm + A4_K + sk_next + hi * 1024 + r32 * 16; const LAS unsigned char* vp = shm + A4_V + sv_prev + hi * 1024 + r32 * 16; \
        bf16x8 k0, k1, k2; v8i vfa, vfb, pwn; float sacc = 0.f; \
        A2_SB(); \
        if (HASN) { k0 = A2_KF(0, 0); k1 = A2_KF(0, 1); k2 = A2_KF(1, 0); if (HASP) A4_VLD(vfa, 0); A2_SB(); \
            N0 = A2_MF(k0, qr[0], negm); k0 = A2_KF(1, 1); A3E3(C0, 0);  A2_PIN(C0); A2_SB(); \
            N1 = A2_MF(k1, qr[0], negm); k1 = A2_KF(2, 0); A3E3(C0, 3);  A2_PIN(C0); A2_SB(); \
            N0 = A2_MF(k2, qr[1], N0);   k2 = A2_KF(2, 1); A3E3(C0, 6);  A2_PIN(C0); A2_SB(); \
            N1 = A2_MF(k0, qr[1], N1);   k0 = A2_KF(3, 0); A3E3(C0, 9);  A2_PIN(C0); A2_SB(); \
            if (HASP) { o[0] = A4_PVM(pwo, vfa, o[0]); A4_VLD(vfb, 1); } A4_CV(pwn, 0, C0, 0); A4_CV(pwn, 1, C0, 4); A3S4(C0, 0); A3S4(C0, 4); A2_PIN(pwn); A2_PIN(sacc); A2_SB(); \
            N0 = A2_MF(k1, qr[2], N0);   k1 = A2_KF(3, 1); A3E3(C0, 12); A2_PIN(C0); A2_SB(); \
            N1 = A2_MF(k2, qr[2], N1);   k2 = A2_KF(4, 0); C0[15] = fexp2(C0[15]); A3E2(C1, 0); A2_PIN(C0); A2_PIN(C1); A2_SB(); \
            N0 = A2_MF(k0, qr[3], N0);   k0 = A2_KF(4, 1); A3E3(C1, 2);  A2_PIN(C1); A2_SB(); \
            N1 = A2_MF(k1, qr[3], N1);   k1 = A2_KF(5, 0); A3E3(C1, 5);  A2_PIN(C1); A2_SB(); \
            if (HASP) { o[1] = A4_PVM(pwo, vfb, o[1]); } A4_CV(pwn, 2, C0, 8); A4_CV(pwn, 3, C0, 12); A4_CV(pwn, 4, C1, 0); A4_CV(pwn, 5, C1, 4); A3S4(C0, 8); A3S4(C0, 12); A3S4(C1, 0); A3S4(C1, 4); A2_PIN(pwn); A2_PIN(sacc); A2_SB(); \
            N0 = A2_MF(k2, qr[4], N0);   k2 = A2_KF(5, 1); A3E3(C1, 8);  A2_PIN(C1); A2_SB(); \
            N1 = A2_MF(k0, qr[4], N1);                      A3E3(C1, 11); A2_PIN(C1); A2_SB(); \
            N0 = A2_MF(k1, qr[5], N0);                      A3E2(C1, 14); A4_CV(pwn, 6, C1, 8); A3S4(C1, 8); A2_PIN(C1); A2_PIN(pwn); A2_PIN(sacc); A2_SB(); \
            N1 = A2_MF(k2, qr[5], N1);                      A4_CV(pwn, 7, C1, 12); A3S4(C1, 12); A2_PIN(pwn); A2_PIN(sacc); A2_SB(); \
        } else { \
            if (HASP) { A4_VLD(vfa, 0); A4_VLD(vfb, 1); } \
            _Pragma("unroll") for (int r_ = 0; r_ < 16; ++r_) { C0[r_] = fexp2(C0[r_]); C1[r_] = fexp2(C1[r_]); } \
            if (HASP) { o[0] = A4_PVM(pwo, vfa, o[0]); o[1] = A4_PVM(pwo, vfb, o[1]); } \
            A4_CV(pwn, 0, C0, 0); A4_CV(pwn, 1, C0, 4); A4_CV(pwn, 2, C0, 8); A4_CV(pwn, 3, C0, 12); A4_CV(pwn, 4, C1, 0); A4_CV(pwn, 5, C1, 4); A4_CV(pwn, 6, C1, 8); A4_CV(pwn, 7, C1, 12); \
            A3S4(C0, 0); A3S4(C0, 4); A3S4(C0, 8); A3S4(C0, 12); A3S4(C1, 0); A3S4(C1, 4); A3S4(C1, 8); A3S4(C1, 12); A2_SB(); \
        } \
        if ((t) > mylast) { pwn = (v8i){0, 0, 0, 0, 0, 0, 0, 0}; sacc = 0.f; } \
        pwo = pwn; lsum += sacc; \
        sk_next = (sk_next == 24576) ? 0 : sk_next + 12288; sv_prev = (sv_prev == 12288) ? 0 : sv_prev + 4096; \
    } while (0)
#define A3E3(P, b) do { P[b] = fexp2(P[b]); P[(b) + 1] = fexp2(P[(b) + 1]); P[(b) + 2] = fexp2(P[(b) + 2]); } while (0)
#define A3E2(P, b) do { P[b] = fexp2(P[b]); P[(b) + 1] = fexp2(P[(b) + 1]); } while (0)
#define A3S4(P, b) do { sacc += P[b]; sacc += P[(b) + 1]; sacc += P[(b) + 2]; sacc += P[(b) + 3]; } while (0)
#define A4_TOP(t) do { const int t_ = (t); \
        if (t_ - 1 <= NT - 4) { if (wid < 4) asm volatile("s_waitcnt vmcnt(3)" ::: "memory"); else asm volatile("s_waitcnt vmcnt(1)" ::: "memory"); } \
        else if (t_ - 1 == NT - 3 && wid < 4) { asm volatile("s_waitcnt vmcnt(1)" ::: "memory"); } else { asm volatile("s_waitcnt vmcnt(0)" ::: "memory"); } \
        A4_BAR(); if (t_ + 3 < NT) { glds16(kg3, (unsigned)__builtin_amdgcn_readfirstlane(kdst + dk)); if (wid < 4) glds16(kg3 + 8192, (unsigned)__builtin_amdgcn_readfirstlane(kdst + dk + 8192)); } \
        if (t_ + 2 < NT && wid < 4) glds16(vg2, (unsigned)__builtin_amdgcn_readfirstlane(vdst + dv)); \
        kg3 += 12288; vg2 += 4096; dk = (dk == 24576u) ? 0u : dk + 12288u; dv = (dv == 12288u) ? 0u : dv + 4096u; } while (0)
    const unsigned char* kg3 = ksrc + 3 * 12288; const unsigned char* vg2 = vsrc + 2 * 4096; unsigned dk = 0u, dv = 8192u;
    A4_TOP(0); A4_STEP(pA0, pA1, pB0, pB1, 0, true, false);
    A4_TOP(1); A4_STEP(pB0, pB1, pA0, pA1, 1, true, true);
    int t = 2;
    for (; t + 2 < NT; t += 2) {
        A4_TOP(t);     A4_STEP(pA0, pA1, pB0, pB1, t, true, true);
        A4_TOP(t + 1); A4_STEP(pB0, pB1, pA0, pA1, t + 1, true, true);
    }
    A4_TOP(t);     A4_STEP(pA0, pA1, pB0, pB1, t, true, true);
    A4_TOP(t + 1); A4_STEP(pB0, pB1, pA0, pA1, t + 1, false, true);
    {
        const LAS unsigned char* vp = shm + A4_V + sv_prev + hi * 1024 + r32 * 16; v8i vfa, vfb;
        A4_VLD(vfa, 0); A4_VLD(vfb, 1); o[0] = A4_PVM(pwo, vfa, o[0]); o[1] = A4_PVM(pwo, vfb, o[1]);
    }
#undef A4_STEP
#undef A4_TOP
#undef A3E3
#undef A3E2
#undef A3S4
    __builtin_amdgcn_s_setprio(0);
    lsum += __shfl_xor(lsum, 32);
    if (hi == 0) wsf[32 + r32] = lsum;
    LDS_WAIT();
    LAS bf16_t* stg = (LAS bf16_t*)(shm + A4_OST) + wid * 2048;
#pragma unroll
    for (int r = 0; r < 16; ++r) { const int orow = crow(r, hi); const float il = frcp(wsf[32 + orow]);
#pragma unroll
        for (int d0 = 0; d0 < 2; ++d0) stg[orow * 64 + d0 * 32 + r32] = (bf16_t)f2bf(o[d0][r] * il); }
    LDS_WAIT();
    const bf16_t* GB = (const bf16_t*)a.out; const bf16_t* HL = (const bf16_t*)(ws + WS_GR); const bf16_t* AC = (const bf16_t*)(ws + WS_GA); bf16_t* MG = (bf16_t*)(ws + WS_XR);
#pragma unroll
    for (int i = 0; i < 4; ++i) { const int row = i * 8 + (lane >> 3), ch = lane & 7; const u32x4 yv = *(const LAS u32x4*)(stg + row * 64 + ch * 8);
        const size_t go = (size_t)(q0 + wid * 32 + row) * 1024 + h * 64 + ch * 8;
        const u32x4 gb = *(const u32x4*)(GB + go), hl = *(const u32x4*)(HL + go), ac = *(const u32x4*)(AC + go); u32x4 w;
#pragma unroll
        for (int j = 0; j < 4; ++j) { const float c0 = carry[ch * 8 + 2 * j], c1 = carry[ch * 8 + 2 * j + 1];
            w[j] = pk2(lo2f(yv[j]) * lo2f(gb[j]) + lo2f(hl[j]) + lo2f(ac[j]) * c0, hi2f(yv[j]) * hi2f(gb[j]) + hi2f(hl[j]) + hi2f(ac[j]) * c1); }
        *(u32x4*)(MG + go) = w; }
    asm volatile("s_waitcnt vmcnt(0) lgkmcnt(0)\n\ts_barrier" ::: "memory");
#undef A4_DMAK
#undef A4_DMAV
#undef A4_BAR
}


constexpr int A5_K = 0, A5_V = 24576, A5_WS = 40960, A5_OST = 43008;
#define A5_QKM(k8_, q8_, c_) __builtin_amdgcn_mfma_scale_f32_32x32x64_f8f6f4(k8_, q8_, c_, 0, 0, 0, 0x7f7f7f7f, 0, 0x7f7f7f7f)
#define A5_K8(kf_, kb) do { const u32x4 x0_ = *(const LAS u32x4*)(kp + (kb) * 2048), x1_ = *(const LAS u32x4*)(kp + (kb) * 2048 + 512); \
        kf_ = (v8i){(int)x0_[0], (int)x0_[1], (int)x0_[2], (int)x0_[3], (int)x1_[0], (int)x1_[1], (int)x1_[2], (int)x1_[3]}; } while (0)
#define A5_KR(d0r, kb) (*(const LAS bf16x8*)(kp + 4096 + (d0r) * 2048 + (kb) * 512))

#ifndef MK_LATEDMA
#define MK_LATEDMA 0
#endif
#ifndef MK_KD
#define MK_KD 2
#endif
#ifndef MK_VD
#define MK_VD 1
#endif
template <int ABL> __device__ __forceinline__ void attn_unit_v5(int h, int qb, CArgs a, const LAS float* carry, LAS unsigned char* shm) {
    int tid = threadIdx.x; asm volatile("" : "+v"(tid));
    const int lane = tid & 63, r32 = lane & 31, hi = lane >> 5; const int wid = __builtin_amdgcn_readfirstlane(tid >> 6);
    unsigned char* ws = a.ws;
    const bf16_t* QRAW = (const bf16_t*)(ws + WS_R1); const unsigned char* KI = ws + WS_KIMG + (size_t)h * 256 * 8192; const unsigned char* VI = (const unsigned char*)a.out + 32 * MiB + (size_t)h * 256 * 4096;
    const float* CS = (const float*)(ws + WS_CS); const float* qg = (const float*)a.in[15];
    const int q0 = qb * 256, rowq = q0 + wid * 32 + r32;
    const unsigned lds0 = (unsigned)(uintptr_t)shm;
    const int NT = 4 * qb + 4, mylast = 4 * qb + (wid >> 1);
    const unsigned char* ksrc = KI + wid * 1024 + lane * 16; const unsigned char* vsrc = VI + wid * 1024 + lane * 16;
    constexpr int KD = MK_KD, VD = MK_VD, A5_K = 0, A5_V = KD * 8192, A5_WS = A5_V + (VD + 2) * 4096, A5_OST = A5_WS + 2048;
    const unsigned kdst = lds0 + A5_K + wid * 1024, vdst = lds0 + A5_V + wid * 1024;
#define A5_DMAK(t, slot) glds16(ksrc + (size_t)(t) * 8192, (unsigned)__builtin_amdgcn_readfirstlane(kdst + (slot) * 8192))
#define A5_DMAV(t, slot) do { if (wid < 4) glds16(vsrc + (size_t)(t) * 4096, (unsigned)__builtin_amdgcn_readfirstlane(vdst + (slot) * 4096)); } while (0)
#define A5_BAR() asm volatile("s_waitcnt lgkmcnt(0)\n\ts_barrier" ::: "memory")
#define A5_VMW(n_) do { const int vw_ = (n_); if (vw_ >= 7) asm volatile("s_waitcnt vmcnt(7)" ::: "memory"); else if (vw_ == 6) asm volatile("s_waitcnt vmcnt(6)" ::: "memory"); else if (vw_ == 5) asm volatile("s_waitcnt vmcnt(5)" ::: "memory"); else if (vw_ == 4) asm volatile("s_waitcnt vmcnt(4)" ::: "memory"); \
        else if (vw_ == 3) asm volatile("s_waitcnt vmcnt(3)" ::: "memory"); else if (vw_ == 2) asm volatile("s_waitcnt vmcnt(2)" ::: "memory"); else if (vw_ == 1) asm volatile("s_waitcnt vmcnt(1)" ::: "memory"); else asm volatile("s_waitcnt vmcnt(0)" ::: "memory"); } while (0)
    v8i q8; bf16x8 qr4, qr5;
    {
        const bf16_t* qp = QRAW + (size_t)rowq * 1536 + h * 96;
        u32x4 rawn[4], rawr[2]; float qn[32], qv4[8], qv5[8]; float ss = 0.f;
#pragma unroll
        for (int i = 0; i < 4; ++i) rawn[i] = *(const u32x4*)(qp + 32 * hi + 8 * i);
        rawr[0] = *(const u32x4*)(qp + 64 + 8 * hi); rawr[1] = *(const u32x4*)(qp + 80 + 8 * hi);
        f32x4 gq[8];
#pragma unroll
        for (int i = 0; i < 8; ++i) gq[i] = *(const f32x4*)(qg + 32 * hi + 4 * i);
        const f32x4 g0 = *(const f32x4*)(qg + 64 + hi * 8), g1 = *(const f32x4*)(qg + 64 + hi * 8 + 4), g2 = *(const f32x4*)(qg + 80 + hi * 8), g3 = *(const f32x4*)(qg + 80 + hi * 8 + 4);
        const f32x4 c0 = *(const f32x4*)(CS + (size_t)rowq * 32 + hi * 8), c1 = *(const f32x4*)(CS + (size_t)rowq * 32 + hi * 8 + 4), s0 = *(const f32x4*)(CS + (size_t)rowq * 32 + 16 + hi * 8), s1 = *(const f32x4*)(CS + (size_t)rowq * 32 + 16 + hi * 8 + 4);
#pragma unroll
        for (int tp = -KD; tp < 0; ++tp) { A5_DMAK(tp + KD, tp + KD); if (tp + VD >= 0) A5_DMAV(tp + VD, tp + VD); }
#pragma unroll
        for (int i = 0; i < 4; ++i)
#pragma unroll
            for (int j = 0; j < 4; ++j) { qn[8 * i + 2 * j] = lo2f(rawn[i][j]); qn[8 * i + 2 * j + 1] = hi2f(rawn[i][j]); }
#pragma unroll
        for (int j = 0; j < 4; ++j) { qv4[2 * j] = lo2f(rawr[0][j]); qv4[2 * j + 1] = hi2f(rawr[0][j]); qv5[2 * j] = lo2f(rawr[1][j]); qv5[2 * j + 1] = hi2f(rawr[1][j]); }
#pragma unroll
        for (int j = 0; j < 32; ++j) ss += qn[j] * qn[j];
#pragma unroll
        for (int j = 0; j < 8; ++j) ss += qv4[j] * qv4[j] + qv5[j] * qv5[j];
        ss += __shfl_xor(ss, 32);
        const float rs = rsqrtf(ss * (1.f / 96.f) + EPS);
#pragma unroll
        for (int i = 0; i < 8; ++i) { const f32x4 g = gq[i];
#pragma unroll
            for (int e = 0; e < 4; ++e) qn[4 * i + e] *= rs * g[e] * 1.1779544f; }
        {
#pragma unroll
          for (int j = 0; j < 4; ++j) { qv4[j] *= rs * g0[j]; qv4[4 + j] *= rs * g1[j]; qv5[j] *= rs * g2[j]; qv5[4 + j] *= rs * g3[j]; } }
#pragma unroll
        for (int j = 0; j < 8; ++j) { const float cs = j < 4 ? c0[j & 3] : c1[j & 3], sn = j < 4 ? s0[j & 3] : s1[j & 3]; const float x1 = qv4[j], x2 = qv5[j]; qv4[j] = x1 * cs - x2 * sn; qv5[j] = x1 * sn + x2 * cs; }
#pragma unroll
        for (int v = 0; v < 8; ++v) { const int w_ = __builtin_amdgcn_cvt_pk_fp8_f32(qn[4 * v], qn[4 * v + 1], 0, false); q8[v] = __builtin_amdgcn_cvt_pk_fp8_f32(qn[4 * v + 2], qn[4 * v + 3], w_, true); }
        u32x4 w4, w5;
#pragma unroll
        for (int j = 0; j < 4; ++j) { w4[j] = pk2(qv4[2 * j] * (8.f * C2), qv4[2 * j + 1] * (8.f * C2)); w5[j] = pk2(qv5[2 * j] * (8.f * C2), qv5[2 * j + 1] * (8.f * C2)); }
        qr4 = __builtin_bit_cast(bf16x8, w4); qr5 = __builtin_bit_cast(bf16x8, w5);
    }
    if (wid >= 4) __builtin_amdgcn_s_setprio(1);
    f32x16 o[2]; o[0] = f32x16{}; o[1] = f32x16{}; f32x4 lsum = {0.f, 0.f, 0.f, 0.f};
    f32x16 pA0, pA1, pB0, pB1, negm; v8i pwo = (v8i){0, 0, 0, 0, 0, 0, 0, 0};
    int onev = ((((lane >> 4) & 1) != 0) == ((lane & 15) >= 8)) ? 0x38383838 : 0; asm volatile("" : "+v"(onev));
    const v8i ones8 = (v8i){onev, onev, onev, onev, onev, onev, onev, onev};
#define A5_SUM(pw_) lsum = __builtin_amdgcn_mfma_scale_f32_16x16x128_f8f6f4(pw_, ones8, lsum, 0, 0, 0, 0x7f7f7f7f, 0, 0x7f7f7f7f)
    A5_VMW((KD - 1) + (wid < 4 ? VD : 0));
    A5_BAR();
    {
        const LAS unsigned char* kp = shm + A5_K + hi * 1024 + r32 * 16; v8i ka, kb8;
        A5_K8(ka, 0); A5_K8(kb8, 1);
        pA0 = A5_QKM(ka, q8, (f32x16{})); pA1 = A5_QKM(kb8, q8, (f32x16{}));
        pA0 = A2_MF(A5_KR(0, 0), qr4, pA0); pA1 = A2_MF(A5_KR(0, 1), qr4, pA1); pA0 = A2_MF(A5_KR(1, 0), qr5, pA0); pA1 = A2_MF(A5_KR(1, 1), qr5, pA1);
        float rm = fmaxf(pA0[0], pA1[0]);
#pragma unroll
        for (int r = 1; r < 16; ++r) rm = fmaxf(rm, fmaxf(pA0[r], pA1[r]));
        rm = fmaxf(rm, __shfl_xor(rm, 32));
        const float nb = 64.f - rm;
#pragma unroll
        for (int r = 0; r < 16; ++r) { pA0[r] += nb; pA1[r] += nb; negm[r] = nb; }
        asm volatile("" : "+v"(negm));
    }
    int sk_next = 8192, sv_prev = (VD + 1) * 4096;
#define A5_CVU(W, j, P, b) do { if (ABL == 4) { W[j] = pwo[j]; break; } unsigned w_ = __builtin_amdgcn_cvt_pk_u8_f32(P[b], 0, 0u); w_ = __builtin_amdgcn_cvt_pk_u8_f32(P[(b) + 1], 1, w_); w_ = __builtin_amdgcn_cvt_pk_u8_f32(P[(b) + 2], 2, w_); W[j] = (int)__builtin_amdgcn_cvt_pk_u8_f32(P[(b) + 3], 3, w_); } while (0)
#define A5_STEP(C0, C1, N0, N1, t, HASN, HASP) do { \
        const LAS unsigned char* kp = shm + A5_K + sk_next + hi * 1024 + r32 * 16; const LAS unsigned char* vp = shm + A5_V + sv_prev + hi * 1024 + r32 * 16; \
        v8i ka, kb8, vfa, vfb, pwn; bf16x8 r0, r1, r2, r3; \
        A2_SB(); \
        if (HASN) { A5_K8(ka, 0); A5_K8(kb8, 1); r0 = A5_KR(0, 0); r1 = A5_KR(0, 1); A2_SB(); \
            N0 = A5_QKM(ka, q8, negm);  r2 = A5_KR(1, 0); r3 = A5_KR(1, 1); if (HASP) A4_VLD(vfa, 0); A5_CVU(pwn, 0, C0, 0); A5_CVU(pwn, 1, C0, 4); A2_PIN(pwn); A2_SB(); \
            N1 = A5_QKM(kb8, q8, negm); if (HASP) A4_VLD(vfb, 1); if (MK_LATEDMA) A5_ISSUEK(t); A5_CVU(pwn, 2, C0, 8); A5_CVU(pwn, 3, C0, 12); A2_PIN(pwn); A2_SB(); \
            if (ABL != 5) N0 = A2_MF(r0, qr4, N0); A5_CVU(pwn, 4, C1, 0); A2_PIN(pwn); A2_SB(); \
            if (ABL != 5) N1 = A2_MF(r1, qr4, N1); A5_CVU(pwn, 5, C1, 4); A2_PIN(pwn); A2_SB(); \
            if (HASP) { o[0] = A4_PVM(pwo, vfa, o[0]); } if (MK_LATEDMA) A5_ISSUEV(t); A5_CVU(pwn, 6, C1, 8); A5_CVU(pwn, 7, C1, 12); A2_PIN(pwn); A2_SB(); \
            if (ABL != 5) N0 = A2_MF(r2, qr5, N0); A2_SB(); \
            if (ABL != 5) N1 = A2_MF(r3, qr5, N1); A2_SB(); \
            if (HASP) { o[1] = A4_PVM(pwo, vfb, o[1]); } A2_SB(); \
            if (HASP && ABL != 2) { A5_SUM(pwo); } A2_SB(); \
        } else { \
            if (HASP) { A4_VLD(vfa, 0); A4_VLD(vfb, 1); } \
            A5_CVU(pwn, 0, C0, 0); A5_CVU(pwn, 1, C0, 4); A5_CVU(pwn, 2, C0, 8); A5_CVU(pwn, 3, C0, 12); A5_CVU(pwn, 4, C1, 0); A5_CVU(pwn, 5, C1, 4); A5_CVU(pwn, 6, C1, 8); A5_CVU(pwn, 7, C1, 12); \
            if (HASP) { o[0] = A4_PVM(pwo, vfa, o[0]); o[1] = A4_PVM(pwo, vfb, o[1]); A5_SUM(pwo); } A2_SB(); \
        } \
        if ((t) > mylast) { pwn = (v8i){0, 0, 0, 0, 0, 0, 0, 0}; } \
        pwo = pwn; \
        sk_next = (sk_next == (KD - 1) * 8192) ? 0 : sk_next + 8192; sv_prev = (sv_prev == (VD + 1) * 4096) ? 0 : sv_prev + 4096; \
    } while (0)
#define A5_TOP(t) do { const int t_ = (t); int c_ = 0; \
        _Pragma("unroll") for (int b_ = 1; b_ <= KD - 2; ++b_) { c_ += (t_ - b_ + KD < NT) ? 1 : 0; if (wid < 4) c_ += (t_ - b_ + VD < NT) ? 1 : 0; } \
        A5_VMW(c_); \
        if (ABL != 3) A5_BAR(); if (!MK_LATEDMA) { A5_ISSUEK(t_); A5_ISSUEV(t_); } } while (0)
#define A5_ISSUEK(t_) do { if ((t_) + KD < NT) glds16(kg3, (unsigned)__builtin_amdgcn_readfirstlane(kdst + dk)); kg3 += 8192; dk = (dk == (KD - 1) * 8192u) ? 0u : dk + 8192u; } while (0)
#define A5_ISSUEV(t_) do { if ((t_) + VD < NT && wid < 4) glds16(vg2, (unsigned)__builtin_amdgcn_readfirstlane(vdst + dv)); vg2 += 4096; dv = (dv == (VD + 1) * 4096u) ? 0u : dv + 4096u; } while (0)
    const unsigned char* kg3 = ksrc + KD * 8192; const unsigned char* vg2 = vsrc + VD * 4096; unsigned dk = 0u, dv = VD * 4096u;
    A5_TOP(0); A5_STEP(pA0, pA1, pB0, pB1, 0, true, false);
    A5_TOP(1); A5_STEP(pB0, pB1, pA0, pA1, 1, true, true);
    int t = 2;
    for (; t + 2 < NT; t += 2) {
        A5_TOP(t);     A5_STEP(pA0, pA1, pB0, pB1, t, true, true);
        A5_TOP(t + 1); A5_STEP(pB0, pB1, pA0, pA1, t + 1, true, true);
    }
    A5_TOP(t);     A5_STEP(pA0, pA1, pB0, pB1, t, true, true);
    A5_TOP(t + 1); A5_STEP(pB0, pB1, pA0, pA1, t + 1, false, true);
    {
        const LAS unsigned char* vp = shm + A5_V + sv_prev + hi * 1024 + r32 * 16; v8i vfa, vfb;
        A4_VLD(vfa, 0); A4_VLD(vfb, 1); o[0] = A4_PVM(pwo, vfa, o[0]); o[1] = A4_PVM(pwo, vfb, o[1]); A5_SUM(pwo);
    }
#undef A5_STEP
#undef A5_TOP
#undef A5_ISSUEK
#undef A5_ISSUEV
#undef A5_CVU
#undef A5_SUM
    __builtin_amdgcn_s_setprio(0);
    LAS float* sums = (LAS float*)(shm + A5_WS) + wid * 64;
    if ((lane & 7) == 0) *(LAS f32x4*)(sums + ((lane & 8) ? 16 : 0) + 4 * (lane >> 4)) = lsum;
    LDS_WAIT();
    f32x4 ls4[4];
#pragma unroll
    for (int g = 0; g < 4; ++g) ls4[g] = *(const LAS f32x4*)(sums + 8 * g + 4 * hi);
    LAS bf16_t* stg = (LAS bf16_t*)(shm + A5_OST) + wid * 2048;
#pragma unroll
    for (int r = 0; r < 16; ++r) { const int orow = crow(r, hi); const float il = frcp(ls4[r >> 2][r & 3]);
#pragma unroll
        for (int d0 = 0; d0 < 2; ++d0) stg[orow * 64 + d0 * 32 + r32] = (bf16_t)f2bf(o[d0][r] * il); }
    LDS_WAIT();
    const bf16_t* GB = (const bf16_t*)a.out; const bf16_t* HL = (const bf16_t*)(ws + WS_GR); const bf16_t* AC = (const bf16_t*)(ws + WS_GA); bf16_t* MG = (bf16_t*)(ws + WS_XR);
#pragma unroll
    for (int i = 0; i < 4; ++i) { const int row = i * 8 + (lane >> 3), ch = lane & 7; const u32x4 yv = *(const LAS u32x4*)(stg + row * 64 + ch * 8);
        const size_t go = (size_t)(q0 + wid * 32 + row) * 1024 + h * 64 + ch * 8;
        const u32x4 gb = *(const u32x4*)(GB + go), hl = *(const u32x4*)(HL + go), ac = *(const u32x4*)(AC + go); u32x4 w;
#pragma unroll
        for (int j = 0; j < 4; ++j) { const float c0 = carry[ch * 8 + 2 * j], c1 = carry[ch * 8 + 2 * j + 1];
            w[j] = pk2(lo2f(yv[j]) * lo2f(gb[j]) + lo2f(hl[j]) + lo2f(ac[j]) * c0, hi2f(yv[j]) * hi2f(gb[j]) + hi2f(hl[j]) + hi2f(ac[j]) * c1); }
        *(u32x4*)(MG + go) = w; }
    asm volatile("s_waitcnt vmcnt(0) lgkmcnt(0)\n\ts_barrier" ::: "memory");
#undef A5_DMAK
#undef A5_DMAV
#undef A5_BAR
#undef A5_VMW
}

#ifndef MK_V7
#define MK_V7 1
#endif
#ifndef MK_PFVD
#define MK_PFVD 1
#endif
#ifndef MK_PF
#define MK_PF 0
#endif
#ifndef MK_PRIO
#define MK_PRIO 1
#endif
#ifndef MK_VW
#define MK_VW 0
#endif
#ifndef MK_PVF
#define MK_PVF 0
#endif
template <int ABL> __device__ __forceinline__ void attn_block_v7(int h, int s_, CArgs a, const LAS float* carry4, LAS unsigned char* shm) {
    int tid = threadIdx.x; asm volatile("" : "+v"(tid));
    const int lane0 = tid & 63; const int wid = __builtin_amdgcn_readfirstlane(tid >> 6);
    unsigned char* ws = a.ws;
    const bf16_t* QRAW = (const bf16_t*)(ws + WS_R1); const unsigned char* KI = ws + WS_KIMG + (size_t)h * 256 * 8192; const unsigned char* VI = (const unsigned char*)a.out + 32 * MiB + (size_t)h * 256 * 4096;
    const float* CS = (const float*)(ws + WS_CS); const float* qg = (const float*)a.in[15];
    const unsigned lds0 = (unsigned)(uintptr_t)shm; const bool vwave = MK_VW ? (wid >= 4) : (wid < 4); const int wv = wid & 3;
    constexpr int KD = MK_PF ? 3 : MK_KD, VD = MK_PF ? MK_PFVD : MK_VD, A5_K = 0, A5_V = KD * 8192, A5_WS = A5_V + (VD + 2) * 4096, A5_OST = A5_WS + 2048, A5_G = A5_OST + 8 * 4096;
    const unsigned kdst = lds0 + A5_K + wid * 1024, vdst = lds0 + A5_V + wv * 1024;
#define A5_DMAK(t, slot) glds16(ksrc_ + (size_t)(t) * 8192, (unsigned)__builtin_amdgcn_readfirstlane(kdst + (slot) * 8192))
#define A5_DMAV(t, slot) do { if (vwave) glds16(vsrc_ + (size_t)(t) * 4096, (unsigned)__builtin_amdgcn_readfirstlane(vdst + (slot) * 4096)); } while (0)
#define A5_BAR() asm volatile("s_waitcnt lgkmcnt(0)\n\ts_barrier" ::: "memory")
#define A5_VMW(n_) do { const int vw_ = (n_); if (vw_ >= 7) asm volatile("s_waitcnt vmcnt(7)" ::: "memory"); else if (vw_ == 6) asm volatile("s_waitcnt vmcnt(6)" ::: "memory"); else if (vw_ == 5) asm volatile("s_waitcnt vmcnt(5)" ::: "memory"); else if (vw_ == 4) asm volatile("s_waitcnt vmcnt(4)" ::: "memory"); \
        else if (vw_ == 3) asm volatile("s_waitcnt vmcnt(3)" ::: "memory"); else if (vw_ == 2) asm volatile("s_waitcnt vmcnt(2)" ::: "memory"); else if (vw_ == 1) asm volatile("s_waitcnt vmcnt(1)" ::: "memory"); else asm volatile("s_waitcnt vmcnt(0)" ::: "memory"); } while (0)
    LAS float* gl = (LAS float*)(shm + A5_G);
    if (tid < 96) gl[tid] = qg[tid];
    u32x4 rawn[4], rawr[2];
#define A7_LOADQ(qb_, L_) do { const int r32 = (L_) & 31, hi = (L_) >> 5; const unsigned char* ksrc_ = KI + wid * 1024 + (L_) * 16; const unsigned char* vsrc_ = VI + wv * 1024 + (L_) * 16; const int rq_ = (qb_) * 256 + wid * 32 + r32; const bf16_t* qp = QRAW + (size_t)rq_ * 1536 + h * 96; \
        _Pragma("unroll") for (int i_ = 0; i_ < 4; ++i_) rawn[i_] = *(const u32x4*)(qp + 32 * hi + 8 * i_); \
        rawr[0] = *(const u32x4*)(qp + 64 + 8 * hi); rawr[1] = *(const u32x4*)(qp + 80 + 8 * hi); \
        _Pragma("unroll") for (int tp = -KD; tp < 0; ++tp) { A5_DMAK(tp + KD, tp + KD); if (tp + VD >= 0) A5_DMAV(tp + VD, tp + VD); } } while (0)
    A7_LOADQ(s_, lane0);
    A5_BAR();
#pragma unroll 1
    for (int ui = 0; ui < 4; ++ui) {
    int lane = lane0; asm volatile("" : "+v"(lane));
    const int r32 = lane & 31, hi = lane >> 5;
    const unsigned char* ksrc = KI + wid * 1024; const unsigned char* vsrc = VI + wv * 1024; const unsigned loff = (unsigned)lane * 16u;
    int onev = ((((lane >> 4) & 1) != 0) == ((lane & 15) >= 8)) ? 0x38383838 : 0; asm volatile("" : "+v"(onev));
    const v8i ones8 = (v8i){onev, onev, onev, onev, onev, onev, onev, onev};
#define A5_SUM(pw_) lsum = __builtin_amdgcn_mfma_scale_f32_16x16x128_f8f6f4(pw_, ones8, lsum, 0, 0, 0, 0x7f7f7f7f, 0, 0x7f7f7f7f)
    const int qb = ((ui & 2) ? 32 : 0) + ((ui & 1) ? 31 - s_ : s_);
    const int q0 = qb * 256; const int NT = 4 * qb + 4, mylast = 4 * qb + (wid >> 1);
    const LAS float* carry = carry4 + ui * 64;
    v8i q8; bf16x8 qr4, qr5;
    {
        const int rowq = q0 + wid * 32 + r32;
        const f32x4 c0 = *(const f32x4*)(CS + (size_t)rowq * 32 + hi * 8), c1 = *(const f32x4*)(CS + (size_t)rowq * 32 + hi * 8 + 4), s0 = *(const f32x4*)(CS + (size_t)rowq * 32 + 16 + hi * 8), s1 = *(const f32x4*)(CS + (size_t)rowq * 32 + 16 + hi * 8 + 4);
        float qn[32], qv4[8], qv5[8]; float ss = 0.f;
        f32x4 gq[8];
#pragma unroll
        for (int i = 0; i < 8; ++i) gq[i] = *(const LAS f32x4*)(gl + 32 * hi + 4 * i);
        const f32x4 g0 = *(const LAS f32x4*)(gl + 64 + hi * 8), g1 = *(const LAS f32x4*)(gl + 64 + hi * 8 + 4), g2 = *(const LAS f32x4*)(gl + 80 + hi * 8), g3 = *(const LAS f32x4*)(gl + 80 + hi * 8 + 4);
#pragma unroll
        for (int i = 0; i < 4; ++i)
#pragma unroll
            for (int j = 0; j < 4; ++j) { qn[8 * i + 2 * j] = lo2f(rawn[i][j]); qn[8 * i + 2 * j + 1] = hi2f(rawn[i][j]); }
#pragma unroll
        for (int j = 0; j < 4; ++j) { qv4[2 * j] = lo2f(rawr[0][j]); qv4[2 * j + 1] = hi2f(rawr[0][j]); qv5[2 * j] = lo2f(rawr[1][j]); qv5[2 * j + 1] = hi2f(rawr[1][j]); }
#pragma unroll
        for (int j = 0; j < 32; ++j) ss += qn[j] * qn[j];
#pragma unroll
        for (int j = 0; j < 8; ++j) ss += qv4[j] * qv4[j] + qv5[j] * qv5[j];
        ss += __shfl_xor(ss, 32);
        const float rs = rsqrtf(ss * (1.f / 96.f) + EPS);
#pragma unroll
        for (int i = 0; i < 8; ++i) { const f32x4 g = gq[i];
#pragma unroll
            for (int e = 0; e < 4; ++e) qn[4 * i + e] *= rs * g[e] * 1.1779544f; }
        {
#pragma unroll
          for (int j = 0; j < 4; ++j) { qv4[j] *= rs * g0[j]; qv4[4 + j] *= rs * g1[j]; qv5[j] *= rs * g2[j]; qv5[4 + j] *= rs * g3[j]; } }
#pragma unroll
        for (int j = 0; j < 8; ++j) { const float cs = j < 4 ? c0[j & 3] : c1[j & 3], sn = j < 4 ? s0[j & 3] : s1[j & 3]; const float x1 = qv4[j], x2 = qv5[j]; qv4[j] = x1 * cs - x2 * sn; qv5[j] = x1 * sn + x2 * cs; }
#pragma unroll
        for (int v = 0; v < 8; ++v) { const int w_ = __builtin_amdgcn_cvt_pk_fp8_f32(qn[4 * v], qn[4 * v + 1], 0, false); q8[v] = __builtin_amdgcn_cvt_pk_fp8_f32(qn[4 * v + 2], qn[4 * v + 3], w_, true); }
        u32x4 w4, w5;
#pragma unroll
        for (int j = 0; j < 4; ++j) { w4[j] = pk2(qv4[2 * j] * (8.f * C2), qv4[2 * j + 1] * (8.f * C2)); w5[j] = pk2(qv5[2 * j] * (8.f * C2), qv5[2 * j + 1] * (8.f * C2)); }
        qr4 = __builtin_bit_cast(bf16x8, w4); qr5 = __builtin_bit_cast(bf16x8, w5);
    }
    if (MK_PRIO == 1 ? wid >= 4 : MK_PRIO == 2 ? vwave : false) __builtin_amdgcn_s_setprio(1);
    f32x16 o[2]; o[0] = f32x16{}; o[1] = f32x16{}; f32x4 lsum = {0.f, 0.f, 0.f, 0.f};
    f32x16 pA0, pA1, pB0, pB1, negm; v8i pwo = (v8i){0, 0, 0, 0, 0, 0, 0, 0};
    A5_VMW((MK_PF ? KD - 2 : KD - 1) + (vwave ? VD : 0));
    A5_BAR();
    {
        const LAS unsigned char* kp = shm + A5_K + hi * 1024 + r32 * 16; v8i ka, kb8;
        A5_K8(ka, 0); A5_K8(kb8, 1);
        pA0 = A5_QKM(ka, q8, (f32x16{})); pA1 = A5_QKM(kb8, q8, (f32x16{}));
        pA0 = A2_MF(A5_KR(0, 0), qr4, pA0); pA1 = A2_MF(A5_KR(0, 1), qr4, pA1); pA0 = A2_MF(A5_KR(1, 0), qr5, pA0); pA1 = A2_MF(A5_KR(1, 1), qr5, pA1);
        float rm = fmaxf(pA0[0], pA1[0]);
#pragma unroll
        for (int r = 1; r < 16; ++r) rm = fmaxf(rm, fmaxf(pA0[r], pA1[r]));
        rm = fmaxf(rm, __shfl_xor(rm, 32));
        const float nb = 64.f - rm;
#pragma unroll
        for (int r = 0; r < 16; ++r) { pA0[r] += nb; pA1[r] += nb; negm[r] = nb; }
        asm volatile("" : "+v"(negm));
    }
#if MK_PF
    v8i ka;
    { const LAS unsigned char* kp = shm + A5_K + 8192 + hi * 1024 + r32 * 16; A5_K8(ka, 0); }
    int sk_pf = 16384;
#endif
#if MK_PVF
    v8i vfa = q8, vfb = q8; int sv_cur = 0;
#endif
    int sk_next = 8192, sv_prev = (VD + 1) * 4096; v8i kst = q8; bf16x8 rst = qr4; if (ABL == 7) { asm volatile("" : "+v"(kst), "+v"(rst)); }
#define A5_CVU(W, j, P, b) do { if (ABL == 4) { W[j] = pwo[j]; break; } unsigned w_ = __builtin_amdgcn_cvt_pk_u8_f32(P[b], 0, 0u); w_ = __builtin_amdgcn_cvt_pk_u8_f32(P[(b) + 1], 1, w_); w_ = __builtin_amdgcn_cvt_pk_u8_f32(P[(b) + 2], 2, w_); W[j] = (int)__builtin_amdgcn_cvt_pk_u8_f32(P[(b) + 3], 3, w_); } while (0)
#define A5_STEP(C0, C1, N0, N1, t, HASN, HASP, HASN2) do { \
        const LAS unsigned char* kp = shm + A5_K + sk_next + hi * 1024 + r32 * 16; const LAS unsigned char* vp = shm + A5_V + sv_prev + hi * 1024 + r32 * 16; \
        v8i ka = kst, kb8 = kst, vfa = kst, vfb = kst, pwn; bf16x8 r0 = rst, r1 = rst, r2 = rst, r3 = rst; \
        A2_SB(); \
        if (HASN) { if (ABL != 7) { A5_K8(ka, 0); A5_K8(kb8, 1); r0 = A5_KR(0, 0); r1 = A5_KR(0, 1); } A2_SB(); \
            N0 = A5_QKM(ka, q8, negm);  if (ABL != 7) { r2 = A5_KR(1, 0); r3 = A5_KR(1, 1); if (HASP) A4_VLD(vfa, 0); } A5_CVU(pwn, 0, C0, 0); A5_CVU(pwn, 1, C0, 4); A2_PIN(pwn); A2_SB(); \
            N1 = A5_QKM(kb8, q8, negm); if (HASP && ABL != 7) A4_VLD(vfb, 1); if (MK_LATEDMA) A5_ISSUEK(t); A5_CVU(pwn, 2, C0, 8); A5_CVU(pwn, 3, C0, 12); A2_PIN(pwn); A2_SB(); \
            if (ABL != 5) N0 = A2_MF(r0, qr4, N0); A5_CVU(pwn, 4, C1, 0); A2_PIN(pwn); A2_SB(); \
            if (ABL != 5) N1 = A2_MF(r1, qr4, N1); A5_CVU(pwn, 5, C1, 4); A2_PIN(pwn); A2_SB(); \
            if (HASP) { o[0] = A4_PVM(pwo, vfa, o[0]); } if (MK_LATEDMA) A5_ISSUEV(t); A5_CVU(pwn, 6, C1, 8); A5_CVU(pwn, 7, C1, 12); A2_PIN(pwn); A2_SB(); \
            if (ABL != 5) N0 = A2_MF(r2, qr5, N0); A2_SB(); \
            if (ABL != 5) N1 = A2_MF(r3, qr5, N1); A2_SB(); \
            if (HASP) { o[1] = A4_PVM(pwo, vfb, o[1]); } A2_SB(); \
            if (HASP && ABL != 2) { A5_SUM(pwo); } A2_SB(); \
        } else { \
            if (HASP) { A4_VLD(vfa, 0); A4_VLD(vfb, 1); } \
            A5_CVU(pwn, 0, C0, 0); A5_CVU(pwn, 1, C0, 4); A5_CVU(pwn, 2, C0, 8); A5_CVU(pwn, 3, C0, 12); A5_CVU(pwn, 4, C1, 0); A5_CVU(pwn, 5, C1, 4); A5_CVU(pwn, 6, C1, 8); A5_CVU(pwn, 7, C1, 12); \
            if (HASP) { o[0] = A4_PVM(pwo, vfa, o[0]); o[1] = A4_PVM(pwo, vfb, o[1]); A5_SUM(pwo); } A2_SB(); \
        } \
        if ((t) > mylast) { pwn = (v8i){0, 0, 0, 0, 0, 0, 0, 0}; } \
        pwo = pwn; \
        sk_next = (sk_next == (KD - 1) * 8192) ? 0 : sk_next + 8192; sv_prev = (sv_prev == (VD + 1) * 4096) ? 0 : sv_prev + 4096; \
    } while (0)
#if MK_PF
#undef A5_STEP
#define A5_STEP(C0, C1, N0, N1, t, HASN, HASP, HASN2) do { \
        const LAS unsigned char* kp = shm + A5_K + sk_next + hi * 1024 + r32 * 16; const LAS unsigned char* vp = shm + A5_V + sv_prev + hi * 1024 + r32 * 16;        \
        v8i kb8, vfa, vfb, pwn; bf16x8 r0, r1, r2, r3; \
        A2_SB(); \
        if (HASN) { A5_K8(kb8, 1); r0 = A5_KR(0, 0); r1 = A5_KR(0, 1); A2_SB(); \
            N0 = A5_QKM(ka, q8, negm);  r2 = A5_KR(1, 0); r3 = A5_KR(1, 1); if (HASP) A4_VLD(vfa, 0); A5_CVU(pwn, 0, C0, 0); A5_CVU(pwn, 1, C0, 4); A2_PIN(pwn); A2_SB(); \
            N1 = A5_QKM(kb8, q8, negm); if (HASP) A4_VLD(vfb, 1); if (HASN2) { const LAS unsigned char* kp = shm + A5_K + sk_pf + hi * 1024 + r32 * 16; A5_K8(ka, 0); } A5_CVU(pwn, 2, C0, 8); A5_CVU(pwn, 3, C0, 12); A2_PIN(pwn); A2_SB(); \
            N0 = A2_MF(r0, qr4, N0); A5_CVU(pwn, 4, C1, 0); A2_PIN(pwn); A2_SB(); \
            N1 = A2_MF(r1, qr4, N1); A5_CVU(pwn, 5, C1, 4); A2_PIN(pwn); A2_SB(); \
            if (HASP) { o[0] = A4_PVM(pwo, vfa, o[0]); } A5_CVU(pwn, 6, C1, 8); A5_CVU(pwn, 7, C1, 12); A2_PIN(pwn); A2_SB(); \
            N0 = A2_MF(r2, qr5, N0); A2_SB(); \
            N1 = A2_MF(r3, qr5, N1); A2_SB(); \
            if (HASP) { o[1] = A4_PVM(pwo, vfb, o[1]); } A2_SB(); \
            if (HASP) { A5_SUM(pwo); } A2_SB(); \
        } else { \
            if (HASP) { A4_VLD(vfa, 0); A4_VLD(vfb, 1); } \
            A5_CVU(pwn, 0, C0, 0); A5_CVU(pwn, 1, C0, 4); A5_CVU(pwn, 2, C0, 8); A5_CVU(pwn, 3, C0, 12); A5_CVU(pwn, 4, C1, 0); A5_CVU(pwn, 5, C1, 4); A5_CVU(pwn, 6, C1, 8); A5_CVU(pwn, 7, C1, 12); \
            if (HASP) { o[0] = A4_PVM(pwo, vfa, o[0]); o[1] = A4_PVM(pwo, vfb, o[1]); A5_SUM(pwo); } A2_SB(); \
        } \
        if ((t) > mylast) { pwn = (v8i){0, 0, 0, 0, 0, 0, 0, 0}; } \
        pwo = pwn; \
        sk_next = (sk_next == (KD - 1) * 8192) ? 0 : sk_next + 8192; sv_prev = (sv_prev == (VD + 1) * 4096) ? 0 : sv_prev + 4096; sk_pf = (sk_pf == (KD - 1) * 8192) ? 0 : sk_pf + 8192; \
    } while (0)
#endif
#if MK_PVF
#undef A5_STEP
#define A5_STEP(C0, C1, N0, N1, t, HASN, HASP, HASN2) do { \
        const LAS unsigned char* kp = shm + A5_K + sk_next + hi * 1024 + r32 * 16; const LAS unsigned char* vp = shm + A5_V + sv_cur + hi * 1024 + r32 * 16;        \
        v8i ka, kb8, pwn; bf16x8 r0, r1, r2, r3; \
        A2_SB(); \
        if (HASN) { A5_K8(ka, 0); A5_K8(kb8, 1); r0 = A5_KR(0, 0); r1 = A5_KR(0, 1); A2_SB(); \
            if (HASP) { o[0] = A4_PVM(pwo, vfa, o[0]); } r2 = A5_KR(1, 0); r3 = A5_KR(1, 1); A5_CVU(pwn, 0, C0, 0); A5_CVU(pwn, 1, C0, 4); A2_PIN(pwn); A2_SB(); \
            if (HASP) { o[1] = A4_PVM(pwo, vfb, o[1]); } A5_CVU(pwn, 2, C0, 8); A5_CVU(pwn, 3, C0, 12); A2_PIN(pwn); A2_SB(); \
            if (HASP) { A5_SUM(pwo); } A5_CVU(pwn, 4, C1, 0); A2_PIN(pwn); A2_SB(); \
            N0 = A5_QKM(ka, q8, negm);  A4_VLD(vfa, 0); A5_CVU(pwn, 5, C1, 4); A5_CVU(pwn, 6, C1, 8); A2_PIN(pwn); A2_SB(); \
            N1 = A5_QKM(kb8, q8, negm); A4_VLD(vfb, 1); A5_CVU(pwn, 7, C1, 12); A2_PIN(pwn); A2_SB(); \
            N0 = A2_MF(r0, qr4, N0); A2_SB(); \
            N1 = A2_MF(r1, qr4, N1); A2_SB(); \
            N0 = A2_MF(r2, qr5, N0); A2_SB(); \
            N1 = A2_MF(r3, qr5, N1); A2_SB(); \
        } else { \
            A5_CVU(pwn, 0, C0, 0); A5_CVU(pwn, 1, C0, 4); A5_CVU(pwn, 2, C0, 8); A5_CVU(pwn, 3, C0, 12); A5_CVU(pwn, 4, C1, 0); A5_CVU(pwn, 5, C1, 4); A5_CVU(pwn, 6, C1, 8); A5_CVU(pwn, 7, C1, 12); \
            if (HASP) { o[0] = A4_PVM(pwo, vfa, o[0]); o[1] = A4_PVM(pwo, vfb, o[1]); A5_SUM(pwo); } A2_SB(); \
            A4_VLD(vfa, 0); A4_VLD(vfb, 1); A2_SB(); \
        } \
        if ((t) > mylast) { pwn = (v8i){0, 0, 0, 0, 0, 0, 0, 0}; } \
        pwo = pwn; \
        sk_next = (sk_next == (KD - 1) * 8192) ? 0 : sk_next + 8192; sv_cur = (sv_cur == (VD + 1) * 4096) ? 0 : sv_cur + 4096; \
    } while (0)
#endif
#define A5_TOP(t) do { const int t_ = (t); int c_ = 0; \
        if (!MK_PF) { _Pragma("unroll") for (int b_ = 1; b_ <= KD - 2; ++b_) { c_ += (t_ - b_ + KD < NT) ? 1 : 0; if (vwave) c_ += (t_ - b_ + VD < NT) ? 1 : 0; } } \
        A5_VMW(c_); \
        if (ABL != 3) A5_BAR(); if (!MK_LATEDMA) { A5_ISSUEK(t_); A5_ISSUEV(t_); } } while (0)
#define A5_ISSUEK(t_) do { if ((t_) + KD < NT && ABL != 6) glds16s(kg3, loff, (unsigned)__builtin_amdgcn_readfirstlane(kdst + dk)); kg3 += 8192; dk = (dk == (KD - 1) * 8192u) ? 0u : dk + 8192u; } while (0)
#define A5_ISSUEV(t_) do { if ((t_) + VD < NT && vwave && ABL != 6) glds16s(vg2, loff, (unsigned)__builtin_amdgcn_readfirstlane(vdst + dv)); vg2 += 4096; dv = (dv == (VD + 1) * 4096u) ? 0u : dv + 4096u; } while (0)
    const unsigned char* kg3 = ksrc + KD * 8192; const unsigned char* vg2 = vsrc + VD * 4096; unsigned dk = 0u, dv = VD * 4096u;
    A5_TOP(0); A5_STEP(pA0, pA1, pB0, pB1, 0, true, false, true);
    A5_TOP(1); A5_STEP(pB0, pB1, pA0, pA1, 1, true, true, true);
    int t = 2;
    for (; t + 2 < NT; t += 2) {
        A5_TOP(t);     A5_STEP(pA0, pA1, pB0, pB1, t, true, true, true);
        A5_TOP(t + 1); A5_STEP(pB0, pB1, pA0, pA1, t + 1, true, true, true);
    }
    A5_TOP(t);     A5_STEP(pA0, pA1, pB0, pB1, t, true, true, false);
    A5_TOP(t + 1); A5_STEP(pB0, pB1, pA0, pA1, t + 1, false, true, false);
#if MK_PVF
    { o[0] = A4_PVM(pwo, vfa, o[0]); o[1] = A4_PVM(pwo, vfb, o[1]); A5_SUM(pwo); }
#else
    {
        const LAS unsigned char* vp = shm + A5_V + sv_prev + hi * 1024 + r32 * 16; v8i vfa, vfb;
        A4_VLD(vfa, 0); A4_VLD(vfb, 1); o[0] = A4_PVM(pwo, vfa, o[0]); o[1] = A4_PVM(pwo, vfb, o[1]); A5_SUM(pwo);
    }
#endif
#undef A5_STEP
#undef A5_TOP
#undef A5_ISSUEK
#undef A5_ISSUEV
#undef A5_CVU
    __builtin_amdgcn_s_setprio(0);
    A5_BAR();
    int lane_e = lane; asm volatile("" : "+v"(lane_e));
    const int r32e = lane_e & 31, hie = lane_e >> 5;
    if (ui < 3) { const int qbn = (((ui + 1) & 2) ? 32 : 0) + (((ui + 1) & 1) ? 31 - s_ : s_); A7_LOADQ(qbn, lane_e); }
    LAS float* sums = (LAS float*)(shm + A5_WS) + wid * 64;
    if ((lane_e & 7) == 0) *(LAS f32x4*)(sums + ((lane_e & 8) ? 16 : 0) + 4 * (lane_e >> 4)) = lsum;
    LDS_WAIT();
    f32x4 ls4[4];
#pragma unroll
    for (int g = 0; g < 4; ++g) ls4[g] = *(const LAS f32x4*)(sums + 8 * g + 4 * hie);
    LAS bf16_t* stg = (LAS bf16_t*)(shm + A5_OST) + wid * 2048;
#pragma unroll
    for (int r = 0; r < 16; ++r) { const int orow = crow(r, hie); const float il = frcp(ls4[r >> 2][r & 3]);
#pragma unroll
        for (int d0 = 0; d0 < 2; ++d0) stg[orow * 64 + d0 * 32 + r32e] = (bf16_t)f2bf(o[d0][r] * il); }
    LDS_WAIT();
    const bf16_t* GB = (const bf16_t*)a.out; const bf16_t* HL = (const bf16_t*)(ws + WS_GR); const bf16_t* AC = (const bf16_t*)(ws + WS_GA); bf16_t* MG = (bf16_t*)(ws + WS_XR);
#pragma unroll
    for (int i = 0; i < 4; ++i) { const int row = i * 8 + (lane_e >> 3), ch = lane_e & 7; const u32x4 yv = *(const LAS u32x4*)(stg + row * 64 + ch * 8);
        const size_t go = (size_t)(q0 + wid * 32 + row) * 1024 + h * 64 + ch * 8;
        const u32x4 gb = *(const u32x4*)(GB + go), hl = *(const u32x4*)(HL + go), ac = *(const u32x4*)(AC + go); u32x4 w;
#pragma unroll
        for (int j = 0; j < 4; ++j) { const float c0 = carry[ch * 8 + 2 * j], c1 = carry[ch * 8 + 2 * j + 1];
            w[j] = pk2(lo2f(yv[j]) * lo2f(gb[j]) + lo2f(hl[j]) + lo2f(ac[j]) * c0, hi2f(yv[j]) * hi2f(gb[j]) + hi2f(hl[j]) + hi2f(ac[j]) * c1); }
        *(u32x4*)(MG + go) = w; }
    A2_PIN(rawr[0]); A2_PIN(rawr[1]); A2_PIN(rawn[0]); A2_PIN(rawn[1]); A2_PIN(rawn[2]); A2_PIN(rawn[3]);
    }
#undef A5_SUM
#undef A7_LOADQ
    asm volatile("s_waitcnt vmcnt(0) lgkmcnt(0)\n\ts_barrier" ::: "memory");
#undef A5_DMAK
#undef A5_DMAV
#undef A5_BAR
#undef A5_VMW
}

#ifndef MK_V6
#define MK_V6 0
#endif
#ifndef MK_MIDBAR
#define MK_MIDBAR 0
#endif
constexpr int A6_K = 0, A6_V = 49152, A6_WS = 73728, A6_OST = 75776;
template <int ABL> __device__ __forceinline__ void attn_unit_v6(int h, int qb, CArgs a, const LAS float* carry, LAS unsigned char* shm) {
    int tid = threadIdx.x; asm volatile("" : "+v"(tid));
    const int lane = tid & 63, r32 = lane & 31, hi = lane >> 5; const int wid = __builtin_amdgcn_readfirstlane(tid >> 6);
    unsigned char* ws = a.ws;
    const bf16_t* QRAW = (const bf16_t*)(ws + WS_R1); const unsigned char* KI = ws + WS_KIMG + (size_t)h * 256 * 8192; const unsigned char* VI = (const unsigned char*)a.out + 32 * MiB + (size_t)h * 256 * 4096;
    const float* CS = (const float*)(ws + WS_CS); const float* qg = (const float*)a.in[15];
    const int q0 = qb * 256, rowq = q0 + wid * 32 + r32;
    const unsigned lds0 = (unsigned)(uintptr_t)shm;
    const int NT = 4 * qb + 4, mylast = 4 * qb + (wid >> 1);
    const unsigned char* ksrc = KI + wid * 1024 + lane * 16; const unsigned char* vsrc = VI + (wid >> 2) * 4096 + (wid & 3) * 1024 + lane * 16;
    const unsigned kdst = lds0 + A6_K + wid * 1024, vdst = lds0 + A6_V + (wid >> 2) * 4096 + (wid & 3) * 1024;
#define A5_DMAK(t, slot) glds16(ksrc + (size_t)(t) * 8192, (unsigned)__builtin_amdgcn_readfirstlane(kdst + (slot) * 8192))
#define A5_DMAV(t, slot) glds16(vsrc + (size_t)(t) * 4096, (unsigned)__builtin_amdgcn_readfirstlane(vdst + (slot) * 4096))
#define A5_BAR() asm volatile("s_waitcnt lgkmcnt(0)\n\ts_barrier" ::: "memory")
    v8i q8; bf16x8 qr4, qr5;
    {
        const bf16_t* qp = QRAW + (size_t)rowq * 1536 + h * 96;
        u32x4 rawn[4], rawr[2]; float qn[32], qv4[8], qv5[8]; float ss = 0.f;
#pragma unroll
        for (int i = 0; i < 4; ++i) rawn[i] = *(const u32x4*)(qp + 32 * hi + 8 * i);
        rawr[0] = *(const u32x4*)(qp + 64 + 8 * hi); rawr[1] = *(const u32x4*)(qp + 80 + 8 * hi);
        A5_DMAK(0, 0); A5_DMAK(1, 1); A5_DMAK(2, 2); A5_DMAK(3, 3); A5_DMAV(0, 0);
#pragma unroll
        for (int i = 0; i < 4; ++i)
#pragma unroll
            for (int j = 0; j < 4; ++j) { qn[8 * i + 2 * j] = lo2f(rawn[i][j]); qn[8 * i + 2 * j + 1] = hi2f(rawn[i][j]); }
#pragma unroll
        for (int j = 0; j < 4; ++j) { qv4[2 * j] = lo2f(rawr[0][j]); qv4[2 * j + 1] = hi2f(rawr[0][j]); qv5[2 * j] = lo2f(rawr[1][j]); qv5[2 * j + 1] = hi2f(rawr[1][j]); }
#pragma unroll
        for (int j = 0; j < 32; ++j) ss += qn[j] * qn[j];
#pragma unroll
        for (int j = 0; j < 8; ++j) ss += qv4[j] * qv4[j] + qv5[j] * qv5[j];
        ss += __shfl_xor(ss, 32);
        const float rs = rsqrtf(ss * (1.f / 96.f) + EPS);
#pragma unroll
        for (int i = 0; i < 8; ++i) { const f32x4 g = *(const f32x4*)(qg + 32 * hi + 4 * i);
#pragma unroll
            for (int e = 0; e < 4; ++e) qn[4 * i + e] *= rs * g[e] * 1.1779544f; }
        { const f32x4 g0 = *(const f32x4*)(qg + 64 + hi * 8), g1 = *(const f32x4*)(qg + 64 + hi * 8 + 4), g2 = *(const f32x4*)(qg + 80 + hi * 8), g3 = *(const f32x4*)(qg + 80 + hi * 8 + 4);
#pragma unroll
          for (int j = 0; j < 4; ++j) { qv4[j] *= rs * g0[j]; qv4[4 + j] *= rs * g1[j]; qv5[j] *= rs * g2[j]; qv5[4 + j] *= rs * g3[j]; } }
        const f32x4 c0 = *(const f32x4*)(CS + (size_t)rowq * 32 + hi * 8), c1 = *(const f32x4*)(CS + (size_t)rowq * 32 + hi * 8 + 4), s0 = *(const f32x4*)(CS + (size_t)rowq * 32 + 16 + hi * 8), s1 = *(const f32x4*)(CS + (size_t)rowq * 32 + 16 + hi * 8 + 4);
#pragma unroll
        for (int j = 0; j < 8; ++j) { const float cs = j < 4 ? c0[j & 3] : c1[j & 3], sn = j < 4 ? s0[j & 3] : s1[j & 3]; const float x1 = qv4[j], x2 = qv5[j]; qv4[j] = x1 * cs - x2 * sn; qv5[j] = x1 * sn + x2 * cs; }
#pragma unroll
        for (int v = 0; v < 8; ++v) { const int w_ = __builtin_amdgcn_cvt_pk_fp8_f32(qn[4 * v], qn[4 * v + 1], 0, false); q8[v] = __builtin_amdgcn_cvt_pk_fp8_f32(qn[4 * v + 2], qn[4 * v + 3], w_, true); }
        u32x4 w4, w5;
#pragma unroll
        for (int j = 0; j < 4; ++j) { w4[j] = pk2(qv4[2 * j] * (8.f * C2), qv4[2 * j + 1] * (8.f * C2)); w5[j] = pk2(qv5[2 * j] * (8.f * C2), qv5[2 * j + 1] * (8.f * C2)); }
        qr4 = __builtin_bit_cast(bf16x8, w4); qr5 = __builtin_bit_cast(bf16x8, w5);
    }
    if (wid >= 4) __builtin_amdgcn_s_setprio(1);
    f32x16 o[2]; o[0] = f32x16{}; o[1] = f32x16{}; f32x4 lsum = {0.f, 0.f, 0.f, 0.f};
    f32x16 pA0, pA1, pB0, pB1, negm; v8i pwo = (v8i){0, 0, 0, 0, 0, 0, 0, 0};
    int onev = ((((lane >> 4) & 1) != 0) == ((lane & 15) >= 8)) ? 0x38383838 : 0; asm volatile("" : "+v"(onev));
    const v8i ones8 = (v8i){onev, onev, onev, onev, onev, onev, onev, onev};
#define A5_SUM(pw_) lsum = __builtin_amdgcn_mfma_scale_f32_16x16x128_f8f6f4(pw_, ones8, lsum, 0, 0, 0, 0x7f7f7f7f, 0, 0x7f7f7f7f)
    asm volatile("s_waitcnt vmcnt(3)" ::: "memory");
    A5_BAR();
    if (NT > 5) { A5_DMAK(4, 4); A5_DMAK(5, 5); } A5_DMAV(2, 2);
    {
        const LAS unsigned char* kp = shm + A6_K + hi * 1024 + r32 * 16; v8i ka, kb8;
        A5_K8(ka, 0); A5_K8(kb8, 1);
        pA0 = A5_QKM(ka, q8, (f32x16{})); pA1 = A5_QKM(kb8, q8, (f32x16{}));
        pA0 = A2_MF(A5_KR(0, 0), qr4, pA0); pA1 = A2_MF(A5_KR(0, 1), qr4, pA1); pA0 = A2_MF(A5_KR(1, 0), qr5, pA0); pA1 = A2_MF(A5_KR(1, 1), qr5, pA1);
        float rm = fmaxf(pA0[0], pA1[0]);
#pragma unroll
        for (int r = 1; r < 16; ++r) rm = fmaxf(rm, fmaxf(pA0[r], pA1[r]));
        rm = fmaxf(rm, __shfl_xor(rm, 32));
        const float nb = 64.f - rm;
#pragma unroll
        for (int r = 0; r < 16; ++r) { pA0[r] += nb; pA1[r] += nb; negm[r] = nb; }
        asm volatile("" : "+v"(negm));
    }
    int sk_next = 8192, sv_prev = 20480;
#define A5_CVU(W, j, P, b) do { if (ABL == 4) { W[j] = pwo[j]; break; } unsigned w_ = __builtin_amdgcn_cvt_pk_u8_f32(P[b], 0, 0u); w_ = __builtin_amdgcn_cvt_pk_u8_f32(P[(b) + 1], 1, w_); w_ = __builtin_amdgcn_cvt_pk_u8_f32(P[(b) + 2], 2, w_); W[j] = (int)__builtin_amdgcn_cvt_pk_u8_f32(P[(b) + 3], 3, w_); } while (0)
#define A5_STEP(C0, C1, N0, N1, t, HASN, HASP) do { \
        const LAS unsigned char* kp = shm + A6_K + sk_next + hi * 1024 + r32 * 16; const LAS unsigned char* vp = shm + A6_V + sv_prev + hi * 1024 + r32 * 16; \
        v8i ka, kb8, vfa, vfb, pwn; bf16x8 r0, r1, r2, r3; \
        A2_SB(); \
        if (HASN) { A5_K8(ka, 0); A5_K8(kb8, 1); r0 = A5_KR(0, 0); r1 = A5_KR(0, 1); A2_SB(); \
            N0 = A5_QKM(ka, q8, negm);  r2 = A5_KR(1, 0); r3 = A5_KR(1, 1); if (HASP) A4_VLD(vfa, 0); A5_CVU(pwn, 0, C0, 0); A5_CVU(pwn, 1, C0, 4); A2_PIN(pwn); A2_SB(); \
            N1 = A5_QKM(kb8, q8, negm); if (HASP) A4_VLD(vfb, 1); A5_CVU(pwn, 2, C0, 8); A5_CVU(pwn, 3, C0, 12); A2_PIN(pwn); A2_SB(); \
            if (ABL != 5) N0 = A2_MF(r0, qr4, N0); A5_CVU(pwn, 4, C1, 0); A2_PIN(pwn); A2_SB(); \
            if (ABL != 5) N1 = A2_MF(r1, qr4, N1); A5_CVU(pwn, 5, C1, 4); A2_PIN(pwn); A2_SB(); \
            if (HASP) { o[0] = A4_PVM(pwo, vfa, o[0]); } A5_CVU(pwn, 6, C1, 8); A5_CVU(pwn, 7, C1, 12); A2_PIN(pwn); A2_SB(); \
            if (ABL != 5) N0 = A2_MF(r2, qr5, N0); A2_SB(); \
            if (ABL != 5) N1 = A2_MF(r3, qr5, N1); A2_SB(); \
            if (HASP) { o[1] = A4_PVM(pwo, vfb, o[1]); } A2_SB(); \
            if (HASP && ABL != 2) { A5_SUM(pwo); } A2_SB(); \
        } else { \
            if (HASP) { A4_VLD(vfa, 0); A4_VLD(vfb, 1); } \
            A5_CVU(pwn, 0, C0, 0); A5_CVU(pwn, 1, C0, 4); A5_CVU(pwn, 2, C0, 8); A5_CVU(pwn, 3, C0, 12); A5_CVU(pwn, 4, C1, 0); A5_CVU(pwn, 5, C1, 4); A5_CVU(pwn, 6, C1, 8); A5_CVU(pwn, 7, C1, 12); \
            if (HASP) { o[0] = A4_PVM(pwo, vfa, o[0]); o[1] = A4_PVM(pwo, vfb, o[1]); A5_SUM(pwo); } A2_SB(); \
        } \
        if ((t) > mylast) { pwn = (v8i){0, 0, 0, 0, 0, 0, 0, 0}; } \
        pwo = pwn; \
        sk_next = (sk_next == 40960) ? 0 : sk_next + 8192; sv_prev = (sv_prev == 20480) ? 0 : sv_prev + 4096; \
    } while (0)
#define A5_TOP(t) do { const int t_ = (t); \
        if (t_ + 4 < NT) asm volatile("s_waitcnt vmcnt(3)" ::: "memory"); else if (t_ + 2 < NT) asm volatile("s_waitcnt vmcnt(1)" ::: "memory"); else asm volatile("s_waitcnt vmcnt(0)" ::: "memory"); \
        if (ABL != 3) A5_BAR(); \
        if (t_ + 6 < NT) { glds16(kg5, (unsigned)__builtin_amdgcn_readfirstlane(kdst + dk)); glds16(kg5 + 8192, (unsigned)__builtin_amdgcn_readfirstlane(kdst + dk + 8192u)); } \
        if (t_ + 4 < NT) glds16(vg3, (unsigned)__builtin_amdgcn_readfirstlane(vdst + dv)); \
        kg5 += 16384; vg3 += 8192; dk = (dk == 32768u) ? 0u : dk + 16384u; dv = (dv == 16384u) ? 0u : dv + 8192u; } while (0)
    const unsigned char* kg5 = ksrc + 6 * 8192; const unsigned char* vg3 = vsrc + 4 * 4096; unsigned dk = 0u, dv = 16384u;
    A5_STEP(pA0, pA1, pB0, pB1, 0, true, false);
    int t = 1;
    for (; t + 2 < NT; t += 2) {
        A5_TOP(t);
        A5_STEP(pB0, pB1, pA0, pA1, t, true, true);
        if (MK_MIDBAR) A5_BAR();
        A5_STEP(pA0, pA1, pB0, pB1, t + 1, true, true);
    }
    A5_TOP(t); A5_STEP(pB0, pB1, pA0, pA1, t, false, true);
    {
        const LAS unsigned char* vp = shm + A6_V + sv_prev + hi * 1024 + r32 * 16; v8i vfa, vfb;
        A4_VLD(vfa, 0); A4_VLD(vfb, 1); o[0] = A4_PVM(pwo, vfa, o[0]); o[1] = A4_PVM(pwo, vfb, o[1]); A5_SUM(pwo);
    }
#undef A5_STEP
#undef A5_TOP
#undef A5_CVU
#undef A5_SUM
    __builtin_amdgcn_s_setprio(0);
    LAS float* sums = (LAS float*)(shm + A6_WS) + wid * 64;
    if ((lane & 7) == 0) *(LAS f32x4*)(sums + ((lane & 8) ? 16 : 0) + 4 * (lane >> 4)) = lsum;
    LDS_WAIT();
    f32x4 ls4[4];
#pragma unroll
    for (int g = 0; g < 4; ++g) ls4[g] = *(const LAS f32x4*)(sums + 8 * g + 4 * hi);
    LAS bf16_t* stg = (LAS bf16_t*)(shm + A6_OST) + wid * 2048;
#pragma unroll
    for (int r = 0; r < 16; ++r) { const int orow = crow(r, hi); const float il = frcp(ls4[r >> 2][r & 3]);
#pragma unroll
        for (int d0 = 0; d0 < 2; ++d0) stg[orow * 64 + d0 * 32 + r32] = (bf16_t)f2bf(o[d0][r] * il); }
    LDS_WAIT();
    const bf16_t* GB = (const bf16_t*)a.out; const bf16_t* HL = (const bf16_t*)(ws + WS_GR); const bf16_t* AC = (const bf16_t*)(ws + WS_GA); bf16_t* MG = (bf16_t*)(ws + WS_XR);
#pragma unroll
    for (int i = 0; i < 4; ++i) { const int row = i * 8 + (lane >> 3), ch = lane & 7; const u32x4 yv = *(const LAS u32x4*)(stg + row * 64 + ch * 8);
        const size_t go = (size_t)(q0 + wid * 32 + row) * 1024 + h * 64 + ch * 8;
        const u32x4 gb = *(const u32x4*)(GB + go), hl = *(const u32x4*)(HL + go), ac = *(const u32x4*)(AC + go); u32x4 w;
#pragma unroll
        for (int j = 0; j < 4; ++j) { const float c0 = carry[ch * 8 + 2 * j], c1 = carry[ch * 8 + 2 * j + 1];
            w[j] = pk2(lo2f(yv[j]) * lo2f(gb[j]) + lo2f(hl[j]) + lo2f(ac[j]) * c0, hi2f(yv[j]) * hi2f(gb[j]) + hi2f(hl[j]) + hi2f(ac[j]) * c1); }
        *(u32x4*)(MG + go) = w; }
    asm volatile("s_waitcnt vmcnt(0) lgkmcnt(0)\n\ts_barrier" ::: "memory");
#undef A5_DMAK
#undef A5_DMAV
#undef A5_BAR
}

template <int ABL> __device__ __forceinline__ void p3_attention(Frame& F, CArgs a) {
    if (ABL == 9) {
        f32x16 c0 = f32x16{}, c1 = f32x16{}, c2 = f32x16{}, c3 = f32x16{}; f32x4 c4 = {0.f, 0.f, 0.f, 0.f};
        v8i x = (v8i){(int)F.tid, 1, 2, 3, 4, 5, 6, 7}; bf16x8 y = __builtin_bit_cast(bf16x8, (u32x4){(unsigned)F.tid, 1u, 2u, 3u});
#pragma unroll 1
        for (int it = 0; it < 520; ++it) {
            c0 = __builtin_amdgcn_mfma_scale_f32_32x32x64_f8f6f4(x, x, c0, 0, 0, 0, 0x7f7f7f7f, 0, 0x7f7f7f7f); c1 = __builtin_amdgcn_mfma_scale_f32_32x32x64_f8f6f4(x, x, c1, 0, 0, 0, 0x7f7f7f7f, 0, 0x7f7f7f7f);
            c2 = __builtin_amdgcn_mfma_f32_32x32x16_bf16(y, y, c2, 0, 0, 0); c3 = __builtin_amdgcn_mfma_f32_32x32x16_bf16(y, y, c3, 0, 0, 0);
            c0 = __builtin_amdgcn_mfma_scale_f32_32x32x64_f8f6f4(x, x, c0, 0, 0, 0, 0x7f7f7f7f, 0, 0x7f7f7f7f);
            c2 = __builtin_amdgcn_mfma_f32_32x32x16_bf16(y, y, c2, 0, 0, 0); c3 = __builtin_amdgcn_mfma_f32_32x32x16_bf16(y, y, c3, 0, 0, 0);
            c1 = __builtin_amdgcn_mfma_scale_f32_32x32x64_f8f6f4(x, x, c1, 0, 0, 0, 0x7f7f7f7f, 0, 0x7f7f7f7f);
            c4 = __builtin_amdgcn_mfma_scale_f32_16x16x128_f8f6f4(x, x, c4, 0, 0, 0, 0x7f7f7f7f, 0, 0x7f7f7f7f);
        }
        asm volatile("" :: "v"(c0), "v"(c1), "v"(c2), "v"(c3), "v"(c4));
        return;
    }
    const int head = (F.vcu >> 4) & 15, s = F.vcu & 15; const int qbs[4] = {s, 31 - s, 32 + s, 63 - s};
    LAS float* carry = (LAS float*)(F.lds + LDS_XCH);
    if (F.wave == 0) {
        const float* HEND = (const float*)(a.ws + WS_MISC + MISC_HEND); const float* AEND = (const float*)(a.ws + WS_MISC + MISC_AEND); const int c = head * 64 + LANE_NOW(); float cr = 0.f;
        for (int k = 0; k < 64; ++k) {
#pragma unroll
            for (int i = 0; i < 4; ++i) if (k == qbs[i]) carry[i * 64 + LANE_NOW()] = cr;
            cr = AEND[(size_t)k * 1024 + c] * cr + HEND[(size_t)k * 1024 + c];
        }
    }
    LDS_WAIT(); __syncthreads();
    if (F.vcu < 256)
        if (MK_FP8V && MK_FP8K && MK_V7) attn_block_v7<ABL>(head, s, a, carry, F.lds); else
        for (int i = 0; i < 4; ++i) { if (MK_FP8V && MK_FP8K && MK_V6) attn_unit_v6<ABL>(head, qbs[i], a, carry + i * 64, F.lds); else if (MK_FP8V && MK_FP8K) attn_unit_v5<ABL>(head, qbs[i], a, carry + i * 64, F.lds); else if (MK_FP8V) attn_unit_v4(head, qbs[i], a, carry + i * 64, F.lds); else attn_unit_v2<ABL>(head, qbs[i], a, carry + i * 64, F.lds); }
}

template <bool DRY> __device__ __forceinline__ void p6_route(Frame& F, CArgs a) {
    unsigned char* ws = a.ws; const float* H = a.out; const float* WR = (const float*)(ws + WS_MISC + MISC_WR);
    float* RH = (float*)(ws + WS_CTL + CTL_SSQ_H); const float* PH = (const float*)(ws + WS_SSQP + SSQP_H);
    const float* bg = (const float*)a.in[20]; const float* be = (const float*)a.in[22];
    unsigned* cnt = (unsigned*)(ws + WS_CTL) + CW_CNT; int* lists = (int*)(ws + WS_LIST); float* cwl = (float*)(ws + WS_LIST + 2 * MiB); unsigned* tokinfo = (unsigned*)(ws + WS_MISC + MISC_TOK);
    const int lane = LANE_NOW(), r = lane & 15, kq = lane >> 4, w4 = F.wave & 3, kh = F.wave >> 2;
    LAS float* lg = (LAS float*)F.lds + F.wave * (16 * 48);
    for (int rb0 = F.vcu * 4; rb0 < M / 16; rb0 += F.G * 4) {
        const int rb_ = rb0 + w4, rb = rb_ < M / 16 ? rb_ : M / 16 - 1;
        const float* hp = H + (size_t)(rb * 16 + r) * 1024 + 4 * kq + 512 * kh;
        const int c0 = r, c1 = 16 + r, c2 = (32 + r < 36) ? 32 + r : 35;
        const float* w0 = WR + (size_t)c0 * 1024 + 4 * kq + 512 * kh; const float* w1 = WR + (size_t)c1 * 1024 + 4 * kq + 512 * kh; const float* w2 = WR + (size_t)c2 * 1024 + 4 * kq + 512 * kh;
        f32x4 acc0 = {0.f, 0.f, 0.f, 0.f}, acc1 = acc0, acc2 = acc0;
#pragma unroll 8
        for (int S = 0; S < 32; ++S) {
            const f32x4 av = *(const f32x4*)(hp + 16 * S), b0 = *(const f32x4*)(w0 + 16 * S), b1 = *(const f32x4*)(w1 + 16 * S), b2 = *(const f32x4*)(w2 + 16 * S);
#pragma unroll
            for (int s4 = 0; s4 < 4; ++s4) { acc0 = __builtin_amdgcn_mfma_f32_16x16x4f32(av[s4], b0[s4], acc0, 0, 0, 0); acc1 = __builtin_amdgcn_mfma_f32_16x16x4f32(av[s4], b1[s4], acc1, 0, 0, 0); acc2 = __builtin_amdgcn_mfma_f32_16x16x4f32(av[s4], b2[s4], acc2, 0, 0, 0); }
        }
#pragma unroll
        for (int i = 0; i < 4; ++i) { lg[(4 * kq + i) * 48 + r] = acc0[i]; lg[(4 * kq + i) * 48 + 16 + r] = acc1[i]; lg[(4 * kq + i) * 48 + 32 + r] = acc2[i]; }
        LDS_WAIT(); __syncthreads();
        if (kh == 0 && lane < 16 && rb_ < M / 16) {
            const int tok = rb * 16 + lane; const float* pp = PH + (size_t)tok * 16; const f32x4 a0 = *(const f32x4*)pp, a1 = *(const f32x4*)(pp + 4), a2 = *(const f32x4*)(pp + 8), a3 = *(const f32x4*)(pp + 12);
            const float sh = (((a0[0] + a0[1]) + (a0[2] + a0[3])) + ((a1[0] + a1[1]) + (a1[2] + a1[3]))) + (((a2[0] + a2[1]) + (a2[2] + a2[3])) + ((a3[0] + a3[1]) + (a3[2] + a3[3])));
            const float rs = rsqrtf(sh * (1.f / 1024.f) + EPS);
            const LAS float* lr = lg + lane * 48; const LAS float* lr2 = lr + 4 * (16 * 48);
            float gl[4];
#pragma unroll
            for (int q = 0; q < 4; ++q) gl[q] = (lr[q] + lr2[q]) * rs + bg[q];
            int g = 0; float mx = gl[0];
#pragma unroll
            for (int q = 1; q < 4; ++q) if (gl[q] > mx) { mx = gl[q]; g = q; }
            float den = 0.f;
#pragma unroll
            for (int q = 0; q < 4; ++q) den += expf(gl[q] - mx);
            const float pg = 1.f / den;
            float v1 = -INFINITY, v2 = -INFINITY; int i1 = 0, i2 = 0;
#pragma unroll
            for (int q = 0; q < 8; ++q) { const float v = (lr[4 + g * 8 + q] + lr2[4 + g * 8 + q]) * rs + be[g * 8 + q];
                if (v > v1) { v2 = v1; i2 = i1; v1 = v; i1 = q; } else if (v > v2) { v2 = v; i2 = q; } }
            const float e2 = expf(v2 - v1), s1 = 1.f / (1.f + e2), s2 = e2 * s1; const int e1 = g * 8 + i1, eb = g * 8 + i2;
            if (DRY) { asm volatile("" :: "v"(s1 + s2 + pg), "v"(e1 + eb)); }
            else {
                RH[tok] = rs;
                const unsigned sl1 = atomicAdd(cnt + e1, 1u), sl2 = atomicAdd(cnt + eb, 1u);
                lists[(size_t)e1 * M + sl1] = tok; cwl[(size_t)e1 * M + sl1] = pg * s1; lists[(size_t)eb * M + sl2] = tok; cwl[(size_t)eb * M + sl2] = pg * s2;
                tokinfo[tok * 2] = ((unsigned)e1 << 16) | sl1; tokinfo[tok * 2 + 1] = ((unsigned)eb << 16) | sl2;
            }
        }
        LDS_WAIT(); __syncthreads();
    }
}

__device__ __forceinline__ void moe_prefix(Frame& F, CArgs a, volatile LAS int* tpre, volatile LAS int* cnts) {
    const unsigned* cnt = (const unsigned*)(a.ws + WS_CTL) + CW_CNT;
    if (F.wave == 0) {
        int ln = threadIdx.x; asm volatile("" : "+v"(ln)); ln &= 63; const int e = ln & 31; const int c = (int)__hip_atomic_load(cnt + e, RLX_AGENT); const int nt_ = (c + 255) >> 8; int inc = nt_;
#pragma unroll
        for (int d = 1; d < 32; d <<= 1) { const int v = __shfl_up(inc, d); if (e >= d) inc += v; }
        const int exc = inc - nt_;
        if (ln < 32) { tpre[e] = exc; cnts[e] = c; for (int q = 0; q < nt_; ++q) tpre[80 + exc + q] = e; if (e == 31) tpre[32] = inc; }
    }
    LDS_WAIT(); __syncthreads();
}

template <bool DRY> __device__ __forceinline__ void p8_final(Frame& F, CArgs a, const volatile LAS int* tpre) {
    float* out = a.out; const unsigned char* Y = (const unsigned char*)(a.ws + WS_Y); const unsigned* tokinfo = (const unsigned*)(a.ws + WS_MISC + MISC_TOK);
    const int gw = F.vcu * NWAVES + F.wave, NGW = F.G * NWAVES, lane = LANE_NOW();
    for (int tok = gw; tok < M; tok += NGW) {
        const unsigned i0 = tokinfo[tok * 2], i1 = tokinfo[tok * 2 + 1];
        const size_t s0 = (size_t)tpre[i0 >> 16] * 256 + (i0 & 0xffffu), s1 = (size_t)tpre[i1 >> 16] * 256 + (i1 & 0xffffu);
        const size_t c = 16 * lane; const u32x4 y0 = *(const u32x4*)(Y + s0 * 1024 + c), y1 = *(const u32x4*)(Y + s1 * 1024 + c);
#pragma unroll
        for (int q = 0; q < 4; ++q) { f32x4 h = *(const f32x4*)(out + (size_t)tok * 1024 + c + 4 * q);
            const f32x2 a01 = __builtin_amdgcn_cvt_pk_f32_fp8((int)y0[q], false), a23 = __builtin_amdgcn_cvt_pk_f32_fp8((int)y0[q], true), b01 = __builtin_amdgcn_cvt_pk_f32_fp8((int)y1[q], false), b23 = __builtin_amdgcn_cvt_pk_f32_fp8((int)y1[q], true);
            h[0] += (a01[0] + b01[0]) * 0.125f; h[1] += (a01[1] + b01[1]) * 0.125f; h[2] += (a23[0] + b23[0]) * 0.125f; h[3] += (a23[1] + b23[1]) * 0.125f;
            if (DRY) asm volatile("" :: "v"(h)); else *(f32x4*)(out + (size_t)tok * 1024 + c + 4 * q) = h; }
    }
}
constexpr int NPHASE = 10;
#ifndef MK_ONE_LAUNCH
#define MK_ONE_LAUNCH 1
#endif
#ifndef MK_DRY
#define MK_DRY 0
#endif
__global__ void __launch_bounds__(NTHREADS, 2) mega(Args a) {
    extern __shared__ __attribute__((aligned(16))) unsigned char lds_raw[];
    Frame F;
    F.lds = (LAS unsigned char*)lds_raw; F.MISC = (volatile LAS unsigned*)(F.lds + MISC_OFF);
    F.tid = threadIdx.x; F.lane = F.tid & 63; F.wave = __builtin_amdgcn_readfirstlane(F.tid >> 6);
    F.G = gridDim.x; { const int bx = blockIdx.x; F.vcu = (F.G % 8 == 0) ? (bx % 8) * (F.G / 8) + bx / 8 : bx; }
    const __attribute__((address_space(4))) Args* ap0 = (const __attribute__((address_space(4))) Args*)__builtin_amdgcn_kernarg_segment_ptr();
#define KA() (*({ const __attribute__((address_space(4))) Args* p_ = ap0; asm volatile("" : "+s"(p_)); p_; }))
    unsigned char* ws = a.ws; F.ctl = (gu32*)(ws + WS_CTL);
    for (int u = F.tid; u < (LDS_BYTES - LDSCTL_OFF) / 4; u += NTHREADS) ((LAS unsigned*)(F.lds + LDSCTL_OFF))[u] = 0u;
    __syncthreads();
    const int lo = a.ph_lo, hi = a.ph_hi;
    XcdBarrier bar; bar.bar = (unsigned*)(F.ctl + CW_BAR); bar.x = 0; bar.st = nullptr;
    if (hi - lo > 1) bar = xcd_barrier_post((unsigned*)(F.ctl + CW_BAR), F.MISC + 8);
#ifndef PH_MASK
#define PH_MASK 0x3ff
#endif
#define IN(k) (((PH_MASK >> (k)) & 1) && lo <= (k) && (k) < hi)
#ifdef MK_STAMPS
#define STAMP(k) do { if (blockIdx.x == 0 && F.tid == 0) ((unsigned long long*)(ws + WS_CTL + 400000))[k] = __builtin_amdgcn_s_memrealtime(); } while (0)
#else
#define STAMP(k) do {} while (0)
#endif
#ifndef MK_DOUBLE_MASK
#define MK_DOUBLE_MASK 0
#endif
#define REP(k) for (int rep_ = 0; rep_ < (((MK_DOUBLE_MASK >> (k)) & 1) ? 2 : 1); ++rep_)
#define SEAM(k) do { if (IN(k) && IN((k) + 1)) xcd_barrier(bar); STAMP((k) + 1); } while (0)
    volatile LAS int* tpre = (volatile LAS int*)(F.lds + LDS_XCH + 8192); volatile LAS int* cnts = tpre + 40;
    const int bx = (int)blockIdx.x;
#ifndef MK_CXV
#define MK_CXV 1
#endif
    const int cx = MK_CXV ? F.vcu : bx;

    STAMP(0);
    if (IN(0)) REP(0) { p0_prologue(F, KA()); SEAM(0); }
    if (IN(1) && MK_DRY == 1) {
        DenseOrder S; S.init(M, 5120, F.G, bx, ws + WS_R1, ws + WS_WIN, 1024, 1024);
        EpiProj E{(bf16_t*)(ws + WS_XR), (bf16_t*)(ws + WS_GR), (bf16_t*)(ws + WS_QC), (bf16_t*)(ws + WS_KVC), (bf16_t*)(ws + WS_GA), (bf16_t*)KA().out, (bf16_t*)(ws + WS_MISC + MISC_HALO), (float*)(ws + WS_KPE), (float*)(ws + WS_SSQP), (float*)(ws + WS_SSQP + SSQP_KV)};
        gemm_phase<EpiProj, DenseOrder, true>(F.lds, 1024, 1024, S, E);
        xcd_barrier(bar);
    }
    if (IN(6) && MK_DRY == 60) { moe_weight_convert(F, KA(), 0, F.vcu, F.G); xcd_barrier(bar); }
    if (IN(1)) REP(1) {
        DenseOrder S; S.init(M, 5120, F.G, bx, ws + WS_R1, ws + WS_WIN, 1024, 1024);
        EpiProj E{(bf16_t*)(ws + WS_XR), (bf16_t*)(ws + WS_GR), (bf16_t*)(ws + WS_QC), (bf16_t*)(ws + WS_KVC), (bf16_t*)(ws + WS_GA), (bf16_t*)KA().out, (bf16_t*)(ws + WS_MISC + MISC_HALO), (float*)(ws + WS_KPE), (float*)(ws + WS_SSQP), (float*)(ws + WS_SSQP + SSQP_KV)};
        gemm_phase<EpiProj, DenseOrder, true>(F.lds, 1024, 1024, S, E);
        SEAM(1);
    }
    if (IN(2)) { if (MK_DRY == 2) { p2a_conv<true>(F, KA()); xcd_barrier(bar); } p2a_conv<false>(F, KA()); SEAM(2); }
    if (IN(3)) {
        typedef EpiLruT<false> EpiLru;
#define P3_LRU() do { EpiLru EL{(const bf16_t*)(ws + WS_XR), (const float*)KA().in[7], (const float*)KA().in[9], (const float*)KA().in[10], (bf16_t*)(ws + WS_GR), (bf16_t*)(ws + WS_GA), (float*)(ws + WS_MISC + MISC_HEND), (float*)(ws + WS_MISC + MISC_AEND)}; \
            for (int half = 0; half < 2; ++half) { OneOrder S{half * F.G, 8, (const char*)(ws + WS_XR), (const char*)(ws + WS_WLRU), (size_t)256 * 1024 * 2, (size_t)256 * 256 * 2, 512, cx, 512}; \
                gemm_phase<EpiLru, OneOrder, false>(F.lds, 256, 1024, S, EL); } } while (0)
#define P3_QKV() do { \
            { DenseOrder S; S.init(M, 1536, F.G, bx, ws + WS_QC, ws + WS_WUQ, 768, 768, 0, 0, 1); EpiQ E{(bf16_t*)(ws + WS_R1), (float*)(ws + WS_CTL + CTL_SSQ_Q)}; gemm_phase<EpiQ, DenseOrder, true, true, 0x7a7a7a7a>(F.lds, 768, 768, S, E); } \
            { DenseOrder S; S.init(M, 2048, F.G, bx, ws + WS_KVC, ws + WS_WUKV, 256, 256, 0, 0, 1); if (F.G == 256) { S.skew_h = 128; S.skew_a = 1; S.skew_b = 3; } \
              EpiKV E{ws + WS_KIMG, (unsigned char*)KA().out + 32 * MiB, (float*)(ws + WS_CTL + CTL_SSQ_KV), (const float*)(ws + WS_MISC + MISC_KSSQ), (const float*)(ws + WS_KPE), (const float*)KA().in[16]}; \
              gemm_phase<EpiKV, DenseOrder, true, true, 0x7b7b7b7b>(F.lds, 256, 256, S, E); } } while (0)
        if (MK_DRY == 3) { typedef EpiLruT<true> EpiLruD;
            EpiLruD EL{(const bf16_t*)(ws + WS_XR), (const float*)KA().in[7], (const float*)KA().in[9], (const float*)KA().in[10], (bf16_t*)(ws + WS_GR), (bf16_t*)(ws + WS_GA), (float*)(ws + WS_MISC + MISC_HEND), (float*)(ws + WS_MISC + MISC_AEND)};
#ifndef MK_DRY3
#define MK_DRY3 3
#endif
            if (bx & 1) { if (MK_DRY3 & 1) for (int half = 0; half < 2; ++half) { OneOrder S{half * F.G, 8, (const char*)(ws + WS_XR), (const char*)(ws + WS_WLRU), (size_t)256 * 1024 * 2, (size_t)256 * 256 * 2, 512, cx, 512}; gemm_phase<EpiLruD, OneOrder, false>(F.lds, 256, 1024, S, EL); } if (MK_DRY3 & 2) P3_QKV(); }
            else { if (MK_DRY3 & 2) P3_QKV(); if (MK_DRY3 & 1) for (int half = 0; half < 2; ++half) { OneOrder S{half * F.G, 8, (const char*)(ws + WS_XR), (const char*)(ws + WS_WLRU), (size_t)256 * 1024 * 2, (size_t)256 * 256 * 2, 512, cx, 512}; gemm_phase<EpiLruD, OneOrder, false>(F.lds, 256, 1024, S, EL); } }
            xcd_barrier(bar); }
        if (bx & 1) { P3_LRU(); P3_QKV(); } else { P3_QKV(); P3_LRU(); }
#undef P3_LRU
#undef P3_QKV
        SEAM(3);
    }
#ifndef MK_ABL
#define MK_ABL 0
#endif
    if (IN(4)) { if (MK_ABL) { p3_attention<MK_ABL>(F, KA()); xcd_barrier(bar); } p3_attention<0>(F, KA()); SEAM(4); }
    if (IN(5)) REP(5) {
        DenseOrder S; S.init(M, 1024, F.G, bx, ws + WS_XR, ws + WS_WOUT, 1024, 1024);
        EpiWout E{(const float*)KA().in[0], KA().out, (bf16_t*)(ws + WS_GR), (float*)(ws + WS_SSQP + SSQP_H)};
        gemm_phase<EpiWout, DenseOrder, true>(F.lds, 1024, 1024, S, E);
        SEAM(5);
    }
    if (IN(6)) { if (MK_DRY == 6) { p6_route<true>(F, KA()); xcd_barrier(bar); } if (MK_DRY == 61) { moe_weight_convert(F, KA(), 0, F.vcu, F.G); xcd_barrier(bar); } if (MK_DRY == 62) { moe_weight_convert(F, KA(), 1, F.vcu, F.G); xcd_barrier(bar); } p6_route<false>(F, KA()); moe_weight_convert(F, KA(), 0, F.vcu, F.G); SEAM(6); }
    if (IN(7) && MK_DRY == 7) {
        moe_prefix(F, KA(), tpre, cnts);
        MoeOrder S{tpre, cnts, 2, F.G, cx, (const char*)(ws + WS_GR), (const char*)(ws + WS_WGU), (size_t)512 * 1024, (size_t)256 * 1024, (const int*)(ws + WS_LIST), 1, 0};
        EpiMoeGU E{(bf16_t*)(ws + WS_GA), (float*)(ws + WS_CTL + CTL_SSQ_H), (const int*)(ws + WS_LIST)};
        gemm_phase<EpiMoeGU, MoeOrder, true, true, 0x7a7a7a7a>(F.lds, 1024, 1024, S, E);
        xcd_barrier(bar);
    }
    if (IN(8) && MK_DRY == 8) {
        moe_prefix(F, KA(), tpre, cnts);
        MoeOrder S{tpre, cnts, 4, F.G, cx, (const char*)(ws + WS_GA), (const char*)(ws + WS_WDN), (size_t)1024 * 256, (size_t)256 * 256, (const int*)(ws + WS_LIST), 0, (size_t)256 * 256};
        EpiMoeDown E{(bf16_t*)(ws + WS_Y), (const float*)(ws + WS_LIST + 2 * MiB)};
        gemm_phase<EpiMoeDown, MoeOrder, true, true, 0x7b7b7b7b>(F.lds, 256, 256, S, E);
        xcd_barrier(bar);
    }
    if (IN(7)) REP(7) {
        moe_prefix(F, KA(), tpre, cnts);
        MoeOrder S{tpre, cnts, 2, F.G, cx, (const char*)(ws + WS_GR), (const char*)(ws + WS_WGU), (size_t)512 * 1024, (size_t)256 * 1024, (const int*)(ws + WS_LIST), 1, 0};
        EpiMoeGU E{(bf16_t*)(ws + WS_GA), (float*)(ws + WS_CTL + CTL_SSQ_H), (const int*)(ws + WS_LIST)};
        gemm_phase<EpiMoeGU, MoeOrder, true, true, 0x7a7a7a7a>(F.lds, 1024, 1024, S, E);
        { const int nG = 2 * tpre[32], heavy = nG > F.G ? (nG - F.G < F.G ? nG - F.G : F.G - 1) : 0;
          if (cx >= heavy) moe_weight_convert(F, KA(), 1, cx - heavy, F.G - heavy); }
        SEAM(7);
    }
    if (IN(8)) REP(8) {
        if (!IN(7)) moe_prefix(F, KA(), tpre, cnts);
        MoeOrder S{tpre, cnts, 4, F.G, cx, (const char*)(ws + WS_GA), (const char*)(ws + WS_WDN), (size_t)1024 * 256, (size_t)256 * 256, (const int*)(ws + WS_LIST), 0, (size_t)256 * 256};
        EpiMoeDown E{(bf16_t*)(ws + WS_Y), (const float*)(ws + WS_LIST + 2 * MiB)};
        gemm_phase<EpiMoeDown, MoeOrder, true, true, 0x7b7b7b7b>(F.lds, 256, 256, S, E);
        SEAM(8);
    }
    if (IN(9)) { if (!IN(8)) moe_prefix(F, KA(), tpre, cnts); if (MK_DRY == 9) { p8_final<true>(F, KA(), tpre); xcd_barrier(bar); } p8_final<false>(F, KA(), tpre); VM_WAIT(); STAMP(10); }
#undef IN
#undef SEAM
}

[[maybe_unused]] static void launch(void* const* d_in, float* d_out, unsigned char* ws, hipStream_t stream, int one_launch) {
    static int grid = 0;
    if (grid == 0) {
        int dev = 0, cus = 0;
        if (hipGetDevice(&dev) != hipSuccess || hipDeviceGetAttribute(&cus, hipDeviceAttributeMultiprocessorCount, dev) != hipSuccess) { fprintf(stderr, "device query failed\n"); grid = -1; return; }
        if (hipFuncSetAttribute((const void*)mega, hipFuncAttributeMaxDynamicSharedMemorySize, LDS_BYTES) != hipSuccess) { fprintf(stderr, "hipFuncSetAttribute failed\n"); grid = -1; return; }
        (void)hipGetLastError();
        grid = cus;
        if (grid != 256) fprintf(stderr, "warning: %d CUs (kernel built for 256)\n", grid);
    }
    if (grid < 0) return;
    (void)hipMemsetAsync(ws + WS_CTL + CW_BAR * 4, 0, (size_t)(CW_CNT - CW_BAR) * 4 + 256, stream);
    Args a{};
    for (int i = 0; i < 26; ++i) a.in[i] = d_in[i];
    a.out = d_out; a.ws = ws;
    if (one_launch) { a.ph_lo = 0; a.ph_hi = NPHASE; hipLaunchKernelGGL(mega, dim3(grid), dim3(NTHREADS), LDS_BYTES, stream, a); }
    else for (int p = 0; p < NPHASE; ++p) { a.ph_lo = p; a.ph_hi = p + 1; hipLaunchKernelGGL(mega, dim3(grid), dim3(NTHREADS), LDS_BYTES, stream, a); }
}
}
extern "C" void kernel_launch(void* const* d_in, const int* in_sizes, int n_in, void* d_out, int out_size, void* d_ws, size_t ws_size, hipStream_t stream) {
    (void)in_sizes; (void)n_in; (void)out_size; (void)ws_size;
    mk::launch(d_in, (float*)d_out, (unsigned char*)d_ws, stream, MK_ONE_LAUNCH);
}
```

```cpp
#include <hip/hip_runtime.h>
#include <hip/hip_bf16.h>
#include <cstdint>
#include <cstdio>
#include <cmath>
namespace mk {
#define LAS __attribute__((address_space(3)))
#define GAS __attribute__((address_space(1)))
typedef unsigned short bf16_t;
typedef short bf16x8 __attribute__((ext_vector_type(8)));
typedef short s16x4 __attribute__((ext_vector_type(4)));
typedef float f32x2 __attribute__((ext_vector_type(2)));
typedef float f32x4 __attribute__((ext_vector_type(4)));
typedef float f32x16 __attribute__((ext_vector_type(16)));
typedef unsigned u32x2 __attribute__((ext_vector_type(2)));
typedef unsigned u32x4 __attribute__((ext_vector_type(4)));
typedef GAS unsigned gu32;

#ifndef MK_FP8V
#define MK_FP8V 1
#endif
#ifndef MK_FP8K
#define MK_FP8K 1
#endif
constexpr int M = 16384, D = 1024, NWAVES = 8, NTHREADS = 512;
constexpr float EPS = 1e-6f, LOG2E = 1.4426950408889634f;
constexpr size_t MiB = 1u << 20;
constexpr size_t WS_CTL = 0, CTL_BYTES = 1 * MiB;
constexpr size_t WS_WIN = 1 * MiB, WS_WUQ = 12 * MiB, WS_WUKV = 15 * MiB, WS_WLRU = 16 * MiB, WS_WOUT = 17 * MiB;
constexpr size_t WS_CS = 19 * MiB, WS_KPE = 21 * MiB, WS_MISC = 23 * MiB, WS_LIST = 25 * MiB;
constexpr size_t WS_R1 = 29 * MiB, WS_XR = 77 * MiB, WS_GR = 109 * MiB, WS_GA = 141 * MiB, WS_QC = 173 * MiB, WS_KVC = 197 * MiB, WS_KIMG = 205 * MiB, WS_DBG = 253 * MiB;
constexpr size_t MISC_HALO = 0, MISC_HEND = 512 * 1024, MISC_AEND = 768 * 1024, MISC_KSSQ = 1024 * 1024, MISC_WR = 1152 * 1024, MISC_TOK = 1408 * 1024;
constexpr size_t WS_SSQP = 253 * MiB, SSQP_KV = 786432, SSQP_H = 1048576;
constexpr size_t WS_Y = WS_QC;
constexpr size_t WS_WGU = WS_R1, WS_WDN = WS_R1 + 32 * MiB;
constexpr int CW_TMO = 0, CW_CODE = 1, CW_BAR = 4096, CW_CNT = 8192;
constexpr size_t CTL_SSQ_Q = 65536, CTL_SSQ_KV = 131072, CTL_SSQ_H = 196608;
constexpr int RING_BYTES = 131072, LDS_XCH = 135168  , LDSCTL_OFF = 147456, MISC_OFF = LDSCTL_OFF + 320, LDS_BYTES = 163840;

#define RLX_AGENT __ATOMIC_RELAXED, __HIP_MEMORY_SCOPE_AGENT
#define LDS_WAIT() asm volatile("s_waitcnt lgkmcnt(0)" ::: "memory")
#define VM_WAIT() asm volatile("s_waitcnt vmcnt(0)" ::: "memory")
__device__ __forceinline__ float bf2f(unsigned v) { return __uint_as_float(v << 16); }
__device__ __forceinline__ unsigned f2bf(float f) { unsigned u = __float_as_uint(f); return (u + 0x7fffu + ((u >> 16) & 1u)) >> 16; }
__device__ __forceinline__ unsigned pk2(float lo, float hi) { typedef __bf16 bf16x2_t __attribute__((ext_vector_type(2))); f32x2 v = {lo, hi}; bf16x2_t b = __builtin_convertvector(v, bf16x2_t); return __builtin_bit_cast(unsigned, b); }
__device__ __forceinline__ float lo2f(unsigned w) { return __uint_as_float(w << 16); }
__device__ __forceinline__ float hi2f(unsigned w) { return __uint_as_float(w & 0xffff0000u); }
__device__ __forceinline__ float fexp2(float x) { return __builtin_amdgcn_exp2f(x); }
__device__ __forceinline__ float frcp(float x) { return __builtin_amdgcn_rcpf(x); }
__device__ __forceinline__ float fsigm(float x) { return frcp(1.f + fexp2(-x * LOG2E)); }
__device__ __forceinline__ float fgelu(float x) { const float u = 0.7978845608028654f * (x + 0.044715f * x * x * x); return x * frcp(1.f + fexp2(-2.f * LOG2E * u)); }
__device__ __forceinline__ float wave_sum(float v) {
#pragma unroll
    for (int o = 1; o < 64; o <<= 1) v += __shfl_xor(v, o);
    return v;
}

#define XB_TMO      128
#define XB_XCNT(j)  (256  + 64 * (j))
#define XB_XSUB(j)  (1280 + 64 * (j))
#define XB_XGEN(j)  (2304 + 64 * (j))
#define XB_TOP      3328
#define XB_TOPGEN   3392
#define XCD_BAR_WORDS 3456
#define XB_SPIN_CAP (1u << 18)
__device__ __forceinline__ unsigned xb_ld(unsigned* p)              { return __hip_atomic_load(p, __ATOMIC_RELAXED, __HIP_MEMORY_SCOPE_AGENT); }
__device__ __forceinline__ unsigned xb_add(unsigned* p, unsigned v) { return __hip_atomic_fetch_add(p, v, __ATOMIC_RELAXED, __HIP_MEMORY_SCOPE_AGENT); }
__device__ __forceinline__ unsigned xb_xcc_id() { return (unsigned)__builtin_amdgcn_s_getreg((3 << 11) | 20) & 0xFu; }
#define XB_SPIN(cond, bar) do { unsigned _sp = 0; while (cond) { __builtin_amdgcn_s_sleep(1); \
    if ((++_sp & 255u) == 0u) { if (xb_ld(&(bar)[XB_TMO])) break; if (_sp > XB_SPIN_CAP) { atomicAdd(&(bar)[XB_TMO], 1u); break; } } } } while (0)
struct XcdBarrier { unsigned* bar; unsigned x; volatile LAS unsigned* st; };
__device__ __forceinline__ XcdBarrier xcd_barrier_post(unsigned* bar, volatile LAS unsigned* st) {
    XcdBarrier b; b.bar = bar; b.x = xb_xcc_id(); b.st = st;
    if (threadIdx.x == 0) (void)xb_add(&bar[XB_XCNT(b.x)], 1u);
    return b;
}
__device__ __forceinline__ void xcd_barrier_complete(unsigned* bar, unsigned x, unsigned& nloc, unsigned& nx) {
    const unsigned G = gridDim.x * gridDim.y * gridDim.z;
    unsigned sum, cnt, mine, sp = 0u;
    for (;;) {
        sum = 0u; cnt = 0u; mine = 0u;
#pragma unroll
        for (unsigned j = 0; j < 16; ++j) { const unsigned c = xb_ld(&bar[XB_XCNT(j)]); sum += c; cnt += (c > 0u) ? 1u : 0u; mine = (j == x) ? c : mine; }
        if (sum == G) break;
        __builtin_amdgcn_s_sleep(1);
        if ((++sp & 255u) == 0u) { if (xb_ld(&bar[XB_TMO])) break; if (sp > XB_SPIN_CAP) { atomicAdd(&bar[XB_TMO], 1u); break; } }
    }
    nloc = mine > 0u ? mine : 1u; nx = cnt > 0u ? cnt : 1u;
}
__device__ __forceinline__ void xcd_barrier(const XcdBarrier& b) {
    asm volatile("s_waitcnt vmcnt(0)" ::: "memory");
    __syncthreads();
    if (threadIdx.x == 0) {
        unsigned* bar = b.bar;
        __builtin_amdgcn_s_waitcnt(0);
        unsigned nloc = b.st[0], nx = b.st[1];
        if (nloc == 0u) { xcd_barrier_complete(bar, b.x, nloc, nx); b.st[0] = nloc; b.st[1] = nx; }
        const unsigned old = xb_add(&bar[XB_XSUB(b.x)], 1u);
        const unsigned gen = old / nloc;
        if (old + 1u == (gen + 1u) * nloc) {
            __builtin_amdgcn_fence(__ATOMIC_RELEASE, "agent");
            asm volatile("s_waitcnt vmcnt(0)" ::: "memory");
            const unsigned og = xb_add(&bar[XB_TOP], 1u);
            const unsigned tg = og / nx;
            if (og + 1u == (tg + 1u) * nx) xb_add(&bar[XB_TOPGEN], 1u);
            else XB_SPIN(xb_ld(&bar[XB_TOPGEN]) == tg, bar);
            __builtin_amdgcn_fence(__ATOMIC_ACQUIRE, "agent");
            xb_add(&bar[XB_XGEN(b.x)], 1u);
            asm volatile("s_waitcnt vmcnt(0)" ::: "memory");
        } else {
            XB_SPIN(xb_ld(&bar[XB_XGEN(b.x)]) == gen, bar);
            __builtin_amdgcn_fence(__ATOMIC_ACQUIRE, "agent");
            asm volatile("s_waitcnt vmcnt(0)" ::: "memory");
        }
    }
    __syncthreads();
}

constexpr int BM = 256, BK = 64, HALF = 128, HTB = HALF * BK * 2, STAGE_BYTES = 8 * HTB;
__device__ __forceinline__ int lds_byte(int r, int c) { const int st = (r >> 4) * 2 + (c >> 5), rr = r & 15, cc = c & 31, ob = rr * 64 + cc * 2; return st * 1024 + (ob ^ (((ob >> 9) & 1) << 5)); }
__device__ __forceinline__ void stage_rc(int b, int& R, int& C) { const int st = b / 1024, sb = b % 1024, swz = sb ^ (((sb >> 9) & 1) << 5); R = (st >> 1) * 16 + swz / 64; C = (st & 1) * 32 + (swz % 64) / 2; }
__device__ __forceinline__ int perm32(int rho) { const int n = rho >> 4, i = rho & 15; return 8 * (i >> 2) + 4 * n + (i & 3); }

struct Unit { int pm, pn; const char* A; const char* B; const int* gat; int valid; int x0, x1; };
typedef f32x4 Acc[2][2][4][2];

#define PG8_SA(b, h) (((b) * 2 + (h)) * HTB)
#define PG8_SB(b, h) ((4 + (b) * 2 + (h)) * HTB)
#define PG8_STAGE(bufoff, gbase, voff) do { _Pragma("unroll") for (int _i = 0; _i < 2; ++_i) \
        __builtin_amdgcn_global_load_lds((const unsigned*)((const char*)(gbase) + (voff)[_i]), (LAS unsigned*)(lds + (bufoff) + ldsw + _i * 8192), 16, 0, 0); } while (0)
#define PG8_LDA(dst, b, h) do { if constexpr (F8) { _Pragma("unroll") for (int m = 0; m < 4; ++m) { const u32x4 x0_ = *(const LAS u32x4*)(lds + PG8_SA(b, h) + a8o0 + m * 2048), x1_ = *(const LAS u32x4*)(lds + PG8_SA(b, h) + a8o1 + m * 2048); \
            dst##8[m] = __builtin_bit_cast(v8i_t, __builtin_shufflevector(x0_, x1_, 0, 1, 2, 3, 4, 5, 6, 7)); } } \
        else { _Pragma("unroll") for (int m = 0; m < 4; ++m) _Pragma("unroll") for (int k = 0; k < 2; ++k) dst[m][k] = *(const LAS bf16x8*)(lds + PG8_SA(b, h) + aoff + m * 2048 + k * 1024); } } while (0)
#define PG8_LDB(dst, b, h) do { if constexpr (F8) { _Pragma("unroll") for (int n = 0; n < 2; ++n) { const u32x4 x0_ = *(const LAS u32x4*)(lds + PG8_SB(b, h) + b8o0 + n * 2048), x1_ = *(const LAS u32x4*)(lds + PG8_SB(b, h) + b8o1 + n * 2048); \
            dst##8[n] = __builtin_bit_cast(v8i_t, __builtin_shufflevector(x0_, x1_, 0, 1, 2, 3, 4, 5, 6, 7)); } } \
        else { _Pragma("unroll") for (int n = 0; n < 2; ++n) _Pragma("unroll") for (int k = 0; k < 2; ++k) dst[n][k] = *(const LAS bf16x8*)(lds + PG8_SB(b, h) + boff + n * 2048 + k * 1024); } } while (0)
#define PG8_MMA(ai, bj, At, Bt) do { __builtin_amdgcn_s_setprio(1); if constexpr (F8) { _Pragma("unroll") for (int m = 0; m < 4; ++m) _Pragma("unroll") for (int n = 0; n < 2; ++n) \
            asm volatile("v_mfma_scale_f32_16x16x128_f8f6f4 %0, %1, %2, %0, %3, %4 op_sel_hi:[0,0,0]" : "+v"(acc[ai][bj][m][n]) : "v"(Bt##8[n]), "v"(At##8[m]), "v"(scw_), "v"(scx_)); } \
        else { _Pragma("unroll") for (int m = 0; m < 4; ++m) _Pragma("unroll") for (int n = 0; n < 2; ++n) _Pragma("unroll") for (int k = 0; k < 2; ++k) \
            acc[ai][bj][m][n] = __builtin_amdgcn_mfma_f32_16x16x32_bf16(Bt[n][k], At[m][k], acc[ai][bj][m][n], 0, 0, 0); } __builtin_amdgcn_s_setprio(0); } while (0)
#define PG8_WAIT_V(n) asm volatile("s_waitcnt vmcnt(" #n ")" ::: "memory")
#define PG8_WAIT_L(n) asm volatile("s_waitcnt lgkmcnt(" #n ")" ::: "memory")
#define PG8_BAR __builtin_amdgcn_s_barrier()
#define PG8_SCHED __builtin_amdgcn_sched_barrier(0)
#define PG8_VOFFA(u, vo) do { _Pragma("unroll") for (int _h = 0; _h < 2; ++_h) _Pragma("unroll") for (int _i = 0; _i < 2; ++_i) { const int _row = _h * HALF + Ra[_i]; \
        const int _ri = (u).gat ? (_row < (u).valid ? (u).gat[_row] : 0) : _row; vo[_h][_i] = F8 ? (unsigned)(_ri * lda + 2 * Ca[_i]) : (unsigned)(_ri * lda + Ca[_i]) * 2u; } } while (0)

typedef int v8i_t __attribute__((ext_vector_type(8)));
template <class Epi, class Sched, bool ALIGN_EPI, bool F8 = false, int SC_W = 0x7f7f7f7f>
__device__ __forceinline__ void gemm_phase(LAS unsigned char* lds, const int K, const int lda, const Sched& S, const Epi& E) {
    int tid_ = threadIdx.x; asm volatile("" : "+v"(tid_));
    const int tid = tid_, wid = __builtin_amdgcn_readfirstlane(tid >> 6), lane = tid & 63, wr = wid >> 2, wc = wid & 3, fr = lane & 15, fq = lane >> 4;
    const int nt = F8 ? K / 128 : K / BK;
    int Ra[2], Ca[2]; unsigned voffB[2];
#pragma unroll
    for (int i = 0; i < 2; ++i) { int R, C; stage_rc(tid * 16 + i * 8192, R, C); const int Rb = Epi::PERM ? ((R & ~31) + perm32(R & 31)) : R; Ra[i] = R; Ca[i] = C; voffB[i] = F8 ? (unsigned)(Rb * K + 2 * C) : (unsigned)(Rb * K + C) * 2u; }
    const size_t kstep = (size_t)(BK * 2);
    const size_t hstep = F8 ? (size_t)HALF * K : (size_t)HALF * K * 2;
    const unsigned ldsw = (unsigned)wid * 1024u;
    const int aoff = lds_byte(wr * 64 + fr, fq * 8), boff = lds_byte(wc * 32 + fr, fq * 8);
    const int a8o0 = lds_byte(wr * 64 + fr, 16 * fq), a8o1 = lds_byte(wr * 64 + fr, 16 * fq + 8), b8o0 = lds_byte(wc * 32 + fr, 16 * fq), b8o1 = lds_byte(wc * 32 + fr, 16 * fq + 8);
    Unit cur, nxt; int ui = 0;
    if (!S.next(0, cur)) return;
    Acc acc;
#pragma unroll
    for (int a = 0; a < 2; ++a)
#pragma unroll
        for (int b = 0; b < 2; ++b)
#pragma unroll
            for (int m = 0; m < 4; ++m)
#pragma unroll
                for (int n = 0; n < 2; ++n) acc[a][b][m][n] = (f32x4){0.f, 0.f, 0.f, 0.f};
    bf16x8 At[4][2], B0[2][2], B1[2][2]; v8i_t At8[4], B08[2], B18[2]; const int scw_ = SC_W, scx_ = 0x7f7f7f7f;
    unsigned vC[2][2], vN[2][2];
    PG8_VOFFA(cur, vC);
    const char* cA = cur.A; const char* cB = cur.B;
    PG8_STAGE(PG8_SB(0, 0), cB, voffB); PG8_STAGE(PG8_SB(0, 1), cB + hstep, voffB); PG8_STAGE(PG8_SA(0, 0), cA, vC[0]); PG8_STAGE(PG8_SA(0, 1), cA, vC[1]);
    if (wr == 1) PG8_BAR;
    PG8_WAIT_V(2); PG8_BAR;
    PG8_STAGE(PG8_SB(1, 0), cB + kstep, voffB); PG8_STAGE(PG8_SA(1, 0), cA + kstep, vC[0]); PG8_STAGE(PG8_SB(1, 1), cB + hstep + kstep, voffB);
    PG8_WAIT_V(6); PG8_BAR;
    for (;;) {
        const bool has_next = S.next(ui + 1, nxt);
        if (!has_next) nxt = cur;
        PG8_VOFFA(nxt, vN);
        const char* nA = nxt.A; const char* nB = nxt.B;
#pragma unroll 1
        for (int t = 0; t < nt; t += 2) {
            const bool last = (t == nt - 2);
            const char* a1 = cA + (size_t)(t + 1) * kstep;
            const char* a2 = last ? nA : cA + (size_t)(t + 2) * kstep; const char* b2 = last ? nB : cB + (size_t)(t + 2) * kstep;
            const char* a3 = a2 + kstep; const char* b3 = b2 + kstep;
            unsigned vS[2][2];
#pragma unroll
            for (int h = 0; h < 2; ++h)
#pragma unroll
                for (int i = 0; i < 2; ++i) vS[h][i] = last ? vN[h][i] : vC[h][i];
            PG8_LDB(B0, 0, 0); PG8_LDB(B1, 0, 1); PG8_SCHED; PG8_LDA(At, 0, 0); PG8_STAGE(PG8_SA(1, 1), a1, vC[1]);
            PG8_WAIT_V(8); PG8_WAIT_L(0); PG8_BAR; PG8_MMA(0, 0, At, B0); PG8_MMA(0, 1, At, B1); PG8_BAR; PG8_SCHED;
            PG8_LDA(At, 0, 1); PG8_STAGE(PG8_SB(0, 0), b2, voffB); PG8_STAGE(PG8_SB(0, 1), b2 + hstep, voffB); PG8_STAGE(PG8_SA(0, 0), a2, vS[0]);
            PG8_WAIT_V(8); PG8_WAIT_L(0); PG8_BAR; PG8_MMA(1, 0, At, B0); PG8_MMA(1, 1, At, B1); PG8_BAR; PG8_SCHED;
            PG8_LDB(B0, 1, 0); PG8_LDB(B1, 1, 1); PG8_SCHED; PG8_LDA(At, 1, 0); PG8_STAGE(PG8_SA(0, 1), a2, vS[1]);
            PG8_WAIT_V(8); PG8_WAIT_L(0); PG8_BAR; PG8_MMA(0, 0, At, B0); PG8_MMA(0, 1, At, B1); PG8_BAR; PG8_SCHED;
            PG8_LDA(At, 1, 1); PG8_STAGE(PG8_SB(1, 0), b3, voffB); PG8_STAGE(PG8_SB(1, 1), b3 + hstep, voffB); PG8_STAGE(PG8_SA(1, 0), a3, vS[0]);
            PG8_WAIT_V(8); PG8_WAIT_L(0); PG8_BAR; PG8_MMA(1, 0, At, B0); PG8_MMA(1, 1, At, B1); PG8_BAR; PG8_SCHED;
        }
        if constexpr (F8) asm volatile("s_nop 15\n\ts_nop 15" ::: "memory");
        if constexpr (ALIGN_EPI) { if (wr == 0) PG8_BAR; }
        if constexpr (!Epi::AFTER_DRAIN) { E(acc, cur, wr, wc, fr, fq); }
        if (!has_next) break;
#pragma unroll
        for (int a = 0; a < 2; ++a)
#pragma unroll
            for (int b = 0; b < 2; ++b)
#pragma unroll
                for (int m = 0; m < 4; ++m)
#pragma unroll
                    for (int n = 0; n < 2; ++n) acc[a][b][m][n] = (f32x4){0.f, 0.f, 0.f, 0.f};
        cur = nxt; cA = nA; cB = nB; ++ui;
#pragma unroll
        for (int h = 0; h < 2; ++h)
#pragma unroll
            for (int i = 0; i < 2; ++i) vC[h][i] = vN[h][i];
        if constexpr (ALIGN_EPI) { if (wr == 1) PG8_BAR; }
    }
    PG8_WAIT_V(0);
    if constexpr (!ALIGN_EPI) { if (wr == 0) PG8_BAR; }
    PG8_BAR;
    if constexpr (Epi::AFTER_DRAIN) { E.fused(acc, cur, wr, wc, fr, fq, lds, wid, lane); }
}
struct DenseOrder {
    int nM, nN, nwg, G, c; const char* A; const char* B; size_t a_tile, b_tile; int a_col_tile;
    int pn_per_ablk;
    int skew_h, skew_a, skew_b;
    __device__ void init(int Mr, int N, int G_, int c_, const void* A_, const void* B_, int lda, int K, int pnpa = 0, int acolbytes = 0, int esz = 2) {
        nM = Mr / BM; nN = N / BM; nwg = nM * nN; G = G_; c = c_; A = (const char*)A_; B = (const char*)B_; a_tile = (size_t)BM * lda * esz; b_tile = (size_t)BM * K * esz; pn_per_ablk = pnpa; a_col_tile = acolbytes; skew_h = 0; skew_a = 0; skew_b = 0; }
    __device__ bool next(int i, Unit& u) const {
        long L = (long)i * G + c;
        if (skew_h > 0) { if (c < skew_h) { if (i >= skew_a) return false; L = (long)c * skew_a + i; } else { if (i >= skew_b) return false; L = (long)skew_h * skew_a + (long)(c - skew_h) * skew_b + i; } }
        if (L >= nwg) return false;
        int wgid = (int)L; { const int q = nwg / 8, r = nwg % 8, xcd = wgid % 8, off = wgid / 8; wgid = (xcd < r ? xcd * (q + 1) : r * (q + 1) + (xcd - r) * q) + off; }
        const int WGM = 8, nig = WGM * nN, gid = wgid / nig, fm = gid * WGM, gsz = (nM - fm) < WGM ? (nM - fm) : WGM;
        u.pm = fm + ((wgid % nig) % gsz); u.pn = (wgid % nig) / gsz;
        u.A = A + (size_t)u.pm * a_tile + (pn_per_ablk ? (size_t)(u.pn / pn_per_ablk) * a_col_tile : 0); u.B = B + (size_t)u.pn * b_tile; u.gat = nullptr; u.valid = 256; u.x0 = 0; u.x1 = 0; return true;
    }
};
struct OneOrder {
    int first, nN; const char* A; const char* B; size_t a_tile, b_tile; int a_col_tile; int c; int total;
    __device__ bool next(int i, Unit& u) const {
        if (i > 0) return false; const int L = first + c; if (L >= total) return false;
        u.pm = L / nN; u.pn = L % nN; u.A = A + (size_t)u.pm * a_tile + (size_t)(u.pn >> 1) * a_col_tile; u.B = B + (size_t)u.pn * b_tile; u.gat = nullptr; u.valid = 256; u.x0 = 0; u.x1 = 0; return true; }
};
struct MoeOrder {
    const volatile LAS int* tpre; const volatile LAS int* cnt; int ncol; int G, c; const char* A; const char* B; size_t b_exp; size_t b_tile; const int* lists; int gather; size_t a_tile;
    __device__ bool next(int i, Unit& u) const {
        const int L = i * G + c; const int ntile = __builtin_amdgcn_readfirstlane(tpre[32]); if (L >= ntile * ncol) return false;
        const int T = L / ncol, pn = L % ncol; const int e = __builtin_amdgcn_readfirstlane(tpre[80 + T]);
        const int rt = __builtin_amdgcn_readfirstlane(T - tpre[e]); int valid = cnt[e] - rt * 256; valid = __builtin_amdgcn_readfirstlane(valid > 256 ? 256 : valid);
        u.pm = T; u.pn = pn; u.x0 = e; u.x1 = rt; u.valid = valid; u.B = B + (size_t)e * b_exp + (size_t)pn * b_tile;
        if (gather) { u.A = A; u.gat = lists + (size_t)e * M + rt * 256; } else { u.A = A + (size_t)T * a_tile; u.gat = nullptr; }
        return true; }
};

__device__ __forceinline__ u32x4 pack8(f32x4 a, f32x4 b) { u32x4 w; w.x = pk2(a[0], a[1]); w.y = pk2(a[2], a[3]); w.z = pk2(b[0], b[1]); w.w = pk2(b[2], b[3]); return w; }
__device__ __forceinline__ float dot4(f32x4 a) { return (a[0] * a[0] + a[1] * a[1]) + (a[2] * a[2] + a[3] * a[3]); }

struct EpiProj {
    static constexpr bool PERM = true, AFTER_DRAIN = false;
    bf16_t *XR, *GR, *QC, *KVC, *GA, *GB, *HALO; float *KPE, *ssq_q, *ssq_kv;
    __device__ __forceinline__ void operator()(const Acc& acc, const Unit& u, int wr, int wc, int fr, int fq) const {
        const int pn = u.pn, rowb = u.pm * BM + wr * 64 + fr;
        if (pn == 20) {
            if (wc == 0) {
#pragma unroll
                for (int ai = 0; ai < 2; ++ai)
#pragma unroll
                    for (int m = 0; m < 4; ++m) { float* p = KPE + (size_t)(rowb + ai * HALF + m * 16) * 32 + 8 * fq; *(f32x4*)p = acc[ai][0][m][0]; *(f32x4*)(p + 4) = acc[ai][0][m][1]; }
            }
            return;
        }
        bf16_t* dst; int ldc, colt, act = 0; float* ssq = nullptr; int nslot = 0, slot = 0;
        if (pn < 4) { dst = XR; ldc = 1024; colt = pn * 256; }
        else if (pn < 8) { dst = GR; ldc = 1024; colt = (pn - 4) * 256; act = 1; }
        else if (pn < 11) { dst = QC; ldc = 768; colt = (pn - 8) * 256; ssq = ssq_q; nslot = 12; slot = (pn - 8) * 4 + wc; act = 3; }
        else if (pn == 11) { dst = KVC; ldc = 256; colt = 0; ssq = ssq_kv; nslot = 4; slot = wc; act = 3; }
        else if (pn < 16) { dst = GA; ldc = 1024; colt = (pn - 12) * 256; act = 2; }
        else { dst = GB; ldc = 1024; colt = (pn - 16) * 256; act = 2; }
        const int col0 = colt + wc * 32 + 8 * fq;
#pragma unroll
        for (int ai = 0; ai < 2; ++ai)
#pragma unroll
            for (int m = 0; m < 4; ++m) {
                const int row = rowb + ai * HALF + m * 16; float ss = 0.f;
#pragma unroll
                for (int bj = 0; bj < 2; ++bj) {
                    f32x4 v0 = acc[ai][bj][m][0], v1 = acc[ai][bj][m][1];
                    if (ssq) ss += dot4(v0) + dot4(v1);
                    if (act == 1) {
#pragma unroll
                        for (int e = 0; e < 4; ++e) { v0[e] = fgelu(v0[e]); v1[e] = fgelu(v1[e]); }
                    } else if (act == 2) {
#pragma unroll
                        for (int e = 0; e < 4; ++e) { v0[e] = fsigm(v0[e]); v1[e] = fsigm(v1[e]); }
                    }
                    if (act == 3) { u32x2 w8; int w_ = __builtin_amdgcn_cvt_pk_fp8_f32(v0[0], v0[1], 0, false); w8.x = (unsigned)__builtin_amdgcn_cvt_pk_fp8_f32(v0[2], v0[3], w_, true);
                        w_ = __builtin_amdgcn_cvt_pk_fp8_f32(v1[0], v1[1], 0, false); w8.y = (unsigned)__builtin_amdgcn_cvt_pk_fp8_f32(v1[2], v1[3], w_, true);
                        *(u32x2*)((unsigned char*)dst + (size_t)row * ldc + col0 + bj * HALF) = w8; }
                    else *(u32x4*)(dst + (size_t)row * ldc + col0 + bj * HALF) = pack8(v0, v1);
                }
                if (ssq) { ss += __shfl_xor(ss, 16); ss += __shfl_xor(ss, 32); if (fq == 0) ssq[(size_t)row * nslot + slot] = ss; }
            }
        if (pn < 4 && wr == 1 && fr >= 13) {
#pragma unroll
            for (int bj = 0; bj < 2; ++bj) *(u32x4*)(HALO + ((size_t)u.pm * 3 + (fr - 13)) * 1024 + col0 + bj * HALF) = pack8(acc[1][bj][3][0], acc[1][bj][3][1]);
        }
    }
};

struct EpiQ {
    static constexpr bool PERM = true, AFTER_DRAIN = false;
    bf16_t* Q; const float* ssq_q;
    __device__ __forceinline__ void operator()(const Acc& acc, const Unit& u, int wr, int wc, int fr, int fq) const {
        const int rowb = u.pm * BM + wr * 64 + fr, col0 = u.pn * BM + wc * 32 + 8 * fq;
#pragma unroll
        for (int ai = 0; ai < 2; ++ai)
#pragma unroll
            for (int m = 0; m < 4; ++m) {
                const int row = rowb + ai * HALF + m * 16; const float rs = ssq_q[row];
#pragma unroll
                for (int bj = 0; bj < 2; ++bj) *(u32x4*)(Q + (size_t)row * 1536 + col0 + bj * HALF) = pack8(acc[ai][bj][m][0] * rs, acc[ai][bj][m][1] * rs);
            }
    }
};

extern __shared__ __attribute__((aligned(16))) unsigned char kv_lds_raw[];
__device__ __forceinline__ LAS unsigned char* kv_stage_lds() { return (LAS unsigned char*)kv_lds_raw + RING_BYTES; }
struct EpiKV {
    static constexpr bool PERM = true, AFTER_DRAIN = false;
    unsigned char* KIMG; unsigned char* VIMG; const float* ssq_kv; const float* kssq; const float* KPER; const float* kg;
    __device__ __forceinline__ void operator()(const Acc& acc, const Unit& u, int wr, int wc, int fr, int fq) const {
        asm volatile("" : "+v"(fr), "+v"(fq));
        const int rowb = u.pm * BM + wr * 64 + fr, h = 2 * u.pn + (wc & 1);
        if (wc < 2) {
            f32x4 g[2][2];
#pragma unroll
            for (int bj = 0; bj < 2; ++bj)
#pragma unroll
                for (int n = 0; n < 2; ++n) g[bj][n] = *(const f32x4*)(kg + 32 * bj + 8 * fq + 4 * n);
#pragma unroll
            for (int am = 0; am < 8; ++am) { const int ai = am >> 2;
                f32x4 kr[4][2];
#pragma unroll
                for (int m = (am & 3); m < (am & 3) + 1; ++m) { const float* kp_ = KPER + (size_t)(rowb + ai * HALF + m * 16) * 32 + 8 * fq; kr[m][0] = *(const f32x4*)kp_; kr[m][1] = *(const f32x4*)(kp_ + 4); }
#pragma unroll
                for (int m = (am & 3); m < (am & 3) + 1; ++m) {
                    const int row = rowb + ai * HALF + m * 16; const float rs = ssq_kv[row], ksq = kssq[row];
                    f32x4 v[2][2]; float ss = 0.f;
#pragma unroll
                    for (int bj = 0; bj < 2; ++bj)
#pragma unroll
                        for (int n = 0; n < 2; ++n) { v[bj][n] = acc[ai][bj][m][n] * rs; ss += dot4(v[bj][n]); }
                    ss += __shfl_xor(ss, 16); ss += __shfl_xor(ss, 32);
                    const float rk = rsqrtf((ss + ksq) * (1.f / 96.f) + EPS);
#if MK_FP8K
                    unsigned char* img = KIMG + ((size_t)h * 256 + (row >> 6)) * 8192;
#pragma unroll
                    for (int bj = 0; bj < 2; ++bj) { const f32x4 x0 = v[bj][0] * g[bj][0] * rk, x1 = v[bj][1] * g[bj][1] * rk; u32x2 w;
                        int w0 = __builtin_amdgcn_cvt_pk_fp8_f32(x0[0], x0[1], 0, false); w0 = __builtin_amdgcn_cvt_pk_fp8_f32(x0[2], x0[3], w0, true);
                        int w1 = __builtin_amdgcn_cvt_pk_fp8_f32(x1[0], x1[1], 0, false); w1 = __builtin_amdgcn_cvt_pk_fp8_f32(x1[2], x1[3], w1, true);
                        w.x = (unsigned)w0; w.y = (unsigned)w1;
                        *(u32x2*)(img + ((row & 63) >> 5) * 2048 + bj * 1024 + (fq >> 1) * 512 + (row & 31) * 16 + 8 * (fq & 1)) = w; }
                    *(u32x4*)(img + 4096 + fq * 1024 + (row & 63) * 16) = pack8(kr[m][0] * rk, kr[m][1] * rk);
#else
                    unsigned char* img = KIMG + ((size_t)h * 256 + (row >> 6)) * 12288 + (row & 63) * 16;
#pragma unroll
                    for (int bj = 0; bj < 2; ++bj) *(u32x4*)(img + (4 * bj + fq) * 1024) = pack8(v[bj][0] * g[bj][0] * rk, v[bj][1] * g[bj][1] * rk);
                    *(u32x4*)(img + (8 + fq) * 1024) = pack8(kr[m][0] * rk, kr[m][1] * rk);
#endif
                }
                asm volatile("" ::: "memory");
            }
        } else {
#if MK_FP8V
            LAS unsigned char* stg = (LAS unsigned char*)kv_stage_lds() + (wr * 2 + (wc - 2)) * 4096;
#pragma unroll
            for (int ai = 0; ai < 2; ++ai) {
#pragma unroll
                for (int m = 0; m < 4; ++m) {
                    const int row = rowb + ai * HALF + m * 16; const float rs = ssq_kv[row]; const int key = row & 63, kk = key & 31;
                    LAS unsigned char* img = stg + ((kk >> 2) & 1) * 1024 + (key >> 5) * 512 + ((kk & 3) + 4 * (kk >> 3)) + fq * 128;
#pragma unroll
                    for (int bj = 0; bj < 2; ++bj) { const f32x4 v0 = acc[ai][bj][m][0] * rs, v1 = acc[ai][bj][m][1] * rs;
                        unsigned w0 = (unsigned)__builtin_amdgcn_cvt_pk_fp8_f32(v0[0], v0[1], 0, false); w0 = (unsigned)__builtin_amdgcn_cvt_pk_fp8_f32(v0[2], v0[3], (int)w0, true);
                        unsigned w1 = (unsigned)__builtin_amdgcn_cvt_pk_fp8_f32(v1[0], v1[1], 0, false); w1 = (unsigned)__builtin_amdgcn_cvt_pk_fp8_f32(v1[2], v1[3], (int)w1, true);
                        LAS unsigned char* p = img + bj * 2048;
                        p[0] = (unsigned char)w0; p[16] = (unsigned char)(w0 >> 8); p[32] = (unsigned char)(w0 >> 16); p[48] = (unsigned char)(w0 >> 24);
                        p[64] = (unsigned char)w1; p[80] = (unsigned char)(w1 >> 8); p[96] = (unsigned char)(w1 >> 16); p[112] = (unsigned char)(w1 >> 24); }
                }
                LDS_WAIT();
                unsigned char* tile = VIMG + ((size_t)h * 256 + ((u.pm * BM + wr * 64 + ai * HALF) >> 6)) * 4096; const int ln = fr + 16 * fq;
#pragma unroll
                for (int i = 0; i < 4; ++i) *(u32x4*)(tile + i * 1024 + ln * 16) = *(const LAS u32x4*)(stg + i * 1024 + ln * 16);
            }
#else
#pragma unroll
            for (int ai = 0; ai < 2; ++ai)
#pragma unroll
                for (int m = 0; m < 4; ++m) {
                    const int row = rowb + ai * HALF + m * 16; const float rs = ssq_kv[row]; const int key = row & 63;
                    unsigned char* img = VIMG + ((size_t)h * 256 + (row >> 6)) * 8192 + (key >> 4) * 1024 + (key & 15) * 64 + fq * 16;
#pragma unroll
                    for (int bj = 0; bj < 2; ++bj) *(u32x4*)(img + bj * 4096) = pack8(acc[ai][bj][m][0] * rs, acc[ai][bj][m][1] * rs);
                }
#endif
        }
    }
};

template <bool DRY> struct EpiLruT {
    static constexpr bool PERM = false, AFTER_DRAIN = true;
    const bf16_t* XA; const float *ba, *bx, *lam; bf16_t* GRio; bf16_t* GAio; float* HEND; float* AEND;
    __device__ __forceinline__ void fused(Acc& acc, const Unit& u, int wr, int wc, int fr, int fq, LAS unsigned char* lds, int wid, int lane) const {
        int tid = threadIdx.x; asm volatile("" : "+v"(tid));
        const int chb = 256 * (u.pn >> 1) + 128 * (u.pn & 1);
        LAS unsigned* S = (LAS unsigned*)lds;
        {
            f32x4 vba[2], vbx[2], vsp[2];
#pragma unroll
            for (int n = 0; n < 2; ++n) { const int c = chb + 32 * wc + 16 * n + 4 * fq; vba[n] = *(const f32x4*)(ba + c); vbx[n] = *(const f32x4*)(bx + c); const f32x4 l4 = *(const f32x4*)(lam + c);
#pragma unroll
                for (int e = 0; e < 4; ++e) vsp[n][e] = -8.f * LOG2E * log1pf(expf(-l4[e])); }
#pragma unroll
            for (int am = 0; am < 4; ++am) { const int ai = am >> 1;
                u32x2 xw[4][2];
#pragma unroll
                for (int m = 2 * (am & 1); m < 2 * (am & 1) + 2; ++m)
#pragma unroll
                    for (int n = 0; n < 2; ++n) xw[m][n] = *(const u32x2*)((const char*)XA + (unsigned)((((unsigned)(u.pm * BM + ai * HALF + wr * 64 + m * 16 + fr)) * 1024u + (unsigned)(chb + 32 * wc + 16 * n + 4 * fq)) * 2u));
#pragma unroll
                for (int m = 2 * (am & 1); m < 2 * (am & 1) + 2; ++m) {
                    const int r = ai * HALF + wr * 64 + m * 16 + fr;
#pragma unroll
                    for (int n = 0; n < 2; ++n) {
                        const int x0 = 32 * wc + 16 * n + 4 * fq;
                        const float xa[4] = {lo2f(xw[m][n].x), hi2f(xw[m][n].x), lo2f(xw[m][n].y), hi2f(xw[m][n].y)}; u32x4 o;
#pragma unroll
                        for (int e = 0; e < 4; ++e) {
                            const float rr = fsigm(acc[ai][0][m][n][e] + vba[n][e]), ii = fsigm(acc[ai][1][m][n][e] + vbx[n][e]);
                            const float la2 = rr * vsp[n][e]; const float a2 = fexp2(2.f * la2); const float mult = sqrtf(fmaxf(1.f - a2, 0.f));
                            o[e] = pk2(mult * ii * xa[e], la2);
                        }
                        *(LAS u32x4*)(S + r * 132 + x0) = o;
                    }
                }
                asm volatile("" ::: "memory");
            }
        }
        const int cp = tid & 63, sg = tid >> 6, c0 = 2 * cp; LAS f32x4* X = (LAS f32x4*)(lds + LDS_XCH);
        const unsigned gb32 = ((unsigned)(u.pm * BM) * 1024u + (unsigned)(chb + c0)) * 2u;
        asm volatile("" ::: "memory");
        unsigned gr[32], ga[32];
#pragma unroll
        for (int j = 0; j < 32; ++j) { const unsigned ob = gb32 + (unsigned)(sg * 32 + j) * 2048u; gr[j] = *(const unsigned*)((const char*)GRio + ob); ga[j] = *(const unsigned*)((const char*)GAio + ob); }
        LDS_WAIT(); __builtin_amdgcn_s_barrier(); asm volatile("" ::: "memory");
        float h0 = 0.f, h1 = 0.f, s0 = 0.f, s1 = 0.f;
#pragma unroll 8
        for (int j = 0; j < 32; ++j) { const int r = sg * 32 + j; const u32x2 w = *(const LAS u32x2*)(S + r * 132 + c0);
            const float l0 = hi2f(w.x), l1 = hi2f(w.y); h0 = fexp2(l0) * h0 + lo2f(w.x); h1 = fexp2(l1) * h1 + lo2f(w.y); s0 += l0; s1 += l1; }
        X[sg * 64 + cp] = (f32x4){h0, s0, h1, s1};
        LDS_WAIT(); __builtin_amdgcn_s_barrier(); asm volatile("" ::: "memory");
        h0 = 0.f; h1 = 0.f; s0 = 0.f; s1 = 0.f;
        for (int q = 0; q < sg; ++q) { const f32x4 x = X[q * 64 + cp]; h0 = fexp2(x[1]) * h0 + x[0]; s0 += x[1]; h1 = fexp2(x[3]) * h1 + x[2]; s1 += x[3]; }
#pragma unroll
        for (int j = 0; j < 32; ++j) { const int r = sg * 32 + j; const u32x2 w = *(const LAS u32x2*)(S + r * 132 + c0);
            const float l0 = hi2f(w.x), l1 = hi2f(w.y); h0 = fexp2(l0) * h0 + lo2f(w.x); h1 = fexp2(l1) * h1 + lo2f(w.y); s0 += l0; s1 += l1;
            const unsigned ob = gb32 + (unsigned)r * 2048u;
            const float g0 = lo2f(gr[j]) * lo2f(ga[j]), g1 = hi2f(gr[j]) * hi2f(ga[j]);
            const unsigned o1_ = pk2(h0 * g0, h1 * g1), o2_ = pk2(fexp2(s0) * g0, fexp2(s1) * g1); if (DRY) asm volatile("" :: "v"(o1_), "v"(o2_)); else { *(unsigned*)((char*)GRio + ob) = o1_; *(unsigned*)((char*)GAio + ob) = o2_; }
            if ((j & 3) == 3) asm volatile("" ::: "memory"); }
        if (sg == 7 && !DRY) { *(f32x2*)(HEND + (size_t)u.pm * 1024 + chb + c0) = (f32x2){h0, h1}; *(f32x2*)(AEND + (size_t)u.pm * 1024 + chb + c0) = (f32x2){fexp2(s0), fexp2(s1)}; }
        LDS_WAIT(); __builtin_amdgcn_s_barrier(); asm volatile("" ::: "memory");
    }
};

struct EpiWout {
    static constexpr bool PERM = true, AFTER_DRAIN = false;
    const float* x; float* out; bf16_t* HB; float* ssq_h;
    __device__ __forceinline__ void operator()(const Acc& acc, const Unit& u, int wr, int wc, int fr, int fq) const {
        const int rowb = u.pm * BM + wr * 64 + fr, col0 = u.pn * BM + wc * 32 + 8 * fq;
#pragma unroll
        for (int ai = 0; ai < 2; ++ai)
#pragma unroll
            for (int m = 0; m < 4; ++m) {
                const int row = rowb + ai * HALF + m * 16; float ss = 0.f;
#pragma unroll
                for (int bj = 0; bj < 2; ++bj) { const size_t o = (size_t)row * 1024 + col0 + bj * HALF;
                    const f32x4 h0 = *(const f32x4*)(x + o) + acc[ai][bj][m][0], h1 = *(const f32x4*)(x + o + 4) + acc[ai][bj][m][1];
                    ss += dot4(h0) + dot4(h1); *(f32x4*)(out + o) = h0; *(f32x4*)(out + o + 4) = h1;
                    { u32x2 w8; int w_ = __builtin_amdgcn_cvt_pk_fp8_f32(h0[0], h0[1], 0, false); w8.x = (unsigned)__builtin_amdgcn_cvt_pk_fp8_f32(h0[2], h0[3], w_, true); w_ = __builtin_amdgcn_cvt_pk_fp8_f32(h1[0], h1[1], 0, false); w8.y = (unsigned)__builtin_amdgcn_cvt_pk_fp8_f32(h1[2], h1[3], w_, true);
                      *(u32x2*)((unsigned char*)HB + o) = w8; } }
                ss += __shfl_xor(ss, 16); ss += __shfl_xor(ss, 32); if (fq == 0) ssq_h[(size_t)row * 16 + u.pn * 4 + wc] = ss;
            }
    }
};

struct EpiMoeGU {
    static constexpr bool PERM = false, AFTER_DRAIN = false;
    bf16_t* HID; const float* ssq_h; const int* lists;
    __device__ __forceinline__ void operator()(const Acc& acc, const Unit& u, int wr, int wc, int fr, int fq) const {
        const int rb = wr * 64 + fr; float rsv[2][4];
#pragma unroll
        for (int ai = 0; ai < 2; ++ai)
#pragma unroll
            for (int m = 0; m < 4; ++m) { const int r = rb + ai * HALF + m * 16; rsv[ai][m] = (r < u.valid) ? ssq_h[lists[(size_t)u.x0 * M + u.x1 * 256 + r]] : 0.f; }
#pragma unroll
        for (int ai = 0; ai < 2; ++ai)
#pragma unroll
            for (int m = 0; m < 4; ++m) {
                const int r = rb + ai * HALF + m * 16;
                if (r < u.valid) {
                    const float rs = rsv[ai][m];
#pragma unroll
                    for (int n = 0; n < 2; ++n) { f32x4 g = acc[ai][0][m][n] * rs, up = acc[ai][1][m][n] * rs, hb;
#pragma unroll
                        for (int e = 0; e < 4; ++e) hb[e] = g[e] * fsigm(g[e]) * up[e];
                        int w_ = __builtin_amdgcn_cvt_pk_fp8_f32(hb[0], hb[1], 0, false); w_ = __builtin_amdgcn_cvt_pk_fp8_f32(hb[2], hb[3], w_, true);
                        *(unsigned*)((char*)HID + (unsigned)(((unsigned)u.pm * 256u + (unsigned)r) * 256u + 128u * (unsigned)u.pn + 32u * (unsigned)wc + 16u * (unsigned)n + 4u * (unsigned)fq)) = (unsigned)w_; }
                }
            }
    }
};
struct EpiMoeDown {
    static constexpr bool PERM = true, AFTER_DRAIN = false;
    bf16_t* Y; const float* cwl;
    __device__ __forceinline__ void operator()(const Acc& acc, const Unit& u, int wr, int wc, int fr, int fq) const {
        asm volatile("" : "+v"(fr), "+v"(fq));
        const int rb = wr * 64 + fr, col0 = u.pn * BM + wc * 32 + 8 * fq;
#pragma unroll
        for (int ai = 0; ai < 2; ++ai) {
            float cwv[4];
#pragma unroll
            for (int m = 0; m < 4; ++m) { const int r = rb + ai * HALF + m * 16; cwv[m] = (r < u.valid) ? cwl[(size_t)u.x0 * M + u.x1 * 256 + r] * 8.f : 0.f; }
#pragma unroll
            for (int m = 0; m < 4; ++m) {
                const int r = rb + ai * HALF + m * 16;
                if (r < u.valid) { const float cw = cwv[m];
#pragma unroll
                    for (int bj = 0; bj < 2; ++bj) { const f32x4 y0 = acc[ai][bj][m][0] * cw, y1 = acc[ai][bj][m][1] * cw; u32x2 w8;
                        int w_ = __builtin_amdgcn_cvt_pk_fp8_f32(y0[0], y0[1], 0, false); w8.x = (unsigned)__builtin_amdgcn_cvt_pk_fp8_f32(y0[2], y0[3], w_, true);
                        w_ = __builtin_amdgcn_cvt_pk_fp8_f32(y1[0], y1[1], 0, false); w8.y = (unsigned)__builtin_amdgcn_cvt_pk_fp8_f32(y1[2], y1[3], w_, true);
                        *(u32x2*)((char*)Y + (unsigned)(((unsigned)u.pm * 256u + (unsigned)r) * 1024u + (unsigned)(col0 + bj * HALF))) = w8; } }
            }
            asm volatile("" ::: "memory");
        }
    }
};
#define LANE_NOW() ({ int t__ = threadIdx.x; asm volatile("" : "+v"(t__)); t__ & 63; })
struct Frame {
    LAS unsigned char* lds; volatile LAS unsigned* MISC; gu32* ctl;
    int tid, lane, wave, vcu, G;
    void* const* in_dummy;
};
struct Args { const void* in[26]; float* out; unsigned char* ws; int ph_lo, ph_hi; };
typedef const __attribute__((address_space(4))) Args& CArgs;

__device__ __forceinline__ int crow(int r, int hi) { return (r & 3) + 8 * (r >> 2) + 4 * hi; }
__device__ __forceinline__ void tr_item(const float* W, int ldn, int ns0, bf16_t* WT, int K, int nd0, int k0, const float* kscale, LAS float* scr, int lane, int ncols = 64, int nwrite = 64, float f8mul = 0.f) {
    const int c4 = (lane & 15) * 4, kr = lane >> 4;
    f32x4 v[16];
#pragma unroll
    for (int i = 0; i < 16; ++i) { const int kk = 4 * i + kr; v[i] = (c4 < ncols) ? *(const f32x4*)(W + (size_t)(k0 + kk) * ldn + ns0 + c4) : (f32x4){0.f, 0.f, 0.f, 0.f}; }
#pragma unroll
    for (int i = 0; i < 16; ++i) { const int kk = 4 * i + kr; f32x4 x = v[i]; if (kscale) x = x * kscale[k0 + kk];
        LAS float* p = scr + kk * 65 + c4; p[0] = x[0]; p[1] = x[1]; p[2] = x[2]; p[3] = x[3]; }
    LDS_WAIT(); asm volatile("" ::: "memory");
    const int c = lane & 7;
#pragma unroll
    for (int j = 0; j < 8; ++j) { const int n = (lane >> 3) + 8 * j; if (n >= nwrite) break; const LAS float* sp = scr + (8 * c) * 65 + n;
        if (f8mul != 0.f) { u32x2 o8; int w_ = __builtin_amdgcn_cvt_pk_fp8_f32(sp[0 * 65] * f8mul, sp[1 * 65] * f8mul, 0, false); o8.x = (unsigned)__builtin_amdgcn_cvt_pk_fp8_f32(sp[2 * 65] * f8mul, sp[3 * 65] * f8mul, w_, true);
            w_ = __builtin_amdgcn_cvt_pk_fp8_f32(sp[4 * 65] * f8mul, sp[5 * 65] * f8mul, 0, false); o8.y = (unsigned)__builtin_amdgcn_cvt_pk_fp8_f32(sp[6 * 65] * f8mul, sp[7 * 65] * f8mul, w_, true);
            *(u32x2*)((unsigned char*)WT + (size_t)(nd0 + n) * K + k0 + 8 * c) = o8; continue; }
        u32x4 o; o.x = pk2(sp[0 * 65], sp[1 * 65]); o.y = pk2(sp[2 * 65], sp[3 * 65]); o.z = pk2(sp[4 * 65], sp[5 * 65]); o.w = pk2(sp[6 * 65], sp[7 * 65]);
        *(u32x4*)(WT + (size_t)(nd0 + n) * K + k0 + 8 * c) = o; }
    LDS_WAIT(); asm volatile("" ::: "memory");
}

__device__ __forceinline__ void p0_prologue(Frame& F, CArgs a) {
    LAS float* scr = (LAS float*)(F.lds + F.wave * 16640);
    const int gw = F.vcu * NWAVES + F.wave, NGW = F.G * NWAVES, lane = LANE_NOW();
    unsigned char* ws = a.ws;
    const float* w_in = (const float*)a.in[3];
    bf16_t* WIN = (bf16_t*)(ws + WS_WIN); bf16_t* WUQ = (bf16_t*)(ws + WS_WUQ); bf16_t* WUKV = (bf16_t*)(ws + WS_WUKV); bf16_t* WLRU = (bf16_t*)(ws + WS_WLRU); bf16_t* WOUT = (bf16_t*)(ws + WS_WOUT);
    constexpr int I_IN = 16 * 81, I_UQ = 12 * 24, I_UKV = 4 * 32, I_LRU = 4 * 32, I_OUT = 16 * 16, NITEMS = I_IN + I_UQ + I_UKV + I_LRU + I_OUT;
    for (int it = gw; it < NITEMS; it += NGW) {
        int r = it;
        if (r < I_IN) { const int kb = r / 81, nb = r % 81, nd0 = 64 * nb, k0 = 64 * kb;
            if (nd0 < 5120) tr_item(w_in, 5152, nd0 < 3072 ? nd0 : nd0 + 32, WIN, 1024, nd0, k0, nullptr, scr, lane);
            else tr_item(w_in, 5152, 3072, WIN, 1024, nd0, k0, nullptr, scr, lane, 32, 32);
            continue; }
        r -= I_IN;
        if (r < I_UQ) { const int kb = r / 24, nb = r % 24; tr_item((const float*)a.in[12], 1536, 64 * nb, WUQ, 768, 64 * nb, 64 * kb, (const float*)a.in[11], scr, lane, 64, 64, 32.f); continue; }
        r -= I_UQ;
        if (r < I_UKV) { const int kb = r / 32, nb = r % 32, nd0 = 64 * nb, pn = nd0 >> 8, bj = (nd0 >> 7) & 1, wcp = (nd0 >> 6) & 1;
#pragma unroll 1
            for (int hh = 0; hh < 2; ++hh) tr_item((const float*)a.in[14], 2048, (2 * pn + hh) * 128 + wcp * 64 + 32 * bj, WUKV, 256, nd0 + 32 * hh, 64 * kb, (const float*)a.in[13], scr, lane, 32, 32, 16.f);
            continue; }
        r -= I_UKV;
        if (r < I_LRU) { const int kb = r / 32, nb = r % 32, nd0 = 64 * nb, pn = nd0 >> 8, bj = (nd0 >> 7) & 1, xb = nd0 & 127, blk = pn >> 1;
            tr_item((const float*)a.in[bj ? 8 : 6] + (size_t)blk * 65536, 256, 128 * (pn & 1) + xb, WLRU, 256, nd0, 64 * kb, nullptr, scr, lane); continue; }
        r -= I_LRU;
        { const int kb = r / 16, nb = r % 16; tr_item((const float*)a.in[17], 1024, 64 * nb, WOUT, 1024, 64 * nb, 64 * kb, nullptr, scr, lane); }
    }
    const float* x = (const float*)a.in[0]; const float* gm = (const float*)a.in[2]; bf16_t* XN = (bf16_t*)(ws + WS_R1);
    f32x4 g4[4];
#pragma unroll
    for (int j = 0; j < 4; ++j) g4[j] = *(const f32x4*)(gm + 4 * lane + 256 * j);
    for (int m = gw; m < M; m += NGW) {
        const f32x4* xr = (const f32x4*)(x + (size_t)m * D) + lane; f32x4 v[4]; float s = 0.f;
#pragma unroll
        for (int j = 0; j < 4; ++j) { v[j] = xr[64 * j]; s += dot4(v[j]); }
        const float rstd = rsqrtf(wave_sum(s) * (1.f / 1024.f) + EPS);
        u32x2* o8 = (u32x2*)(XN + (size_t)m * D) + lane;
#pragma unroll
        for (int j = 0; j < 4; ++j) { const f32x4 y = v[j] * rstd * g4[j]; u32x2 w; w.x = pk2(y[0], y[1]); w.y = pk2(y[2], y[3]); o8[64 * j] = w; }
    }
    const int gt = F.vcu * NTHREADS + F.tid, NGT = F.G * NTHREADS;
    const int* pos = (const int*)a.in[1]; float* CS = (float*)(ws + WS_CS);
    for (int i = gt; i < M * 16; i += NGT) { const int t = i >> 4, j = i & 15; const float fr = powf(10000.f, -(float)j / 16.f); const float ang = (float)pos[t] * fr; CS[t * 32 + j] = cosf(ang); CS[t * 32 + 16 + j] = sinf(ang); }
    float* WR = (float*)(ws + WS_MISC + MISC_WR); const float* gf = (const float*)a.in[18]; const float* wg = (const float*)a.in[19]; const float* we = (const float*)a.in[21];
    for (int i = gt; i < 36 * 1024; i += NGT) { const int j = i >> 10, k = i & 1023; WR[i] = (j < 4 ? wg[k * 4 + j] : we[k * 32 + (j - 4)]) * gf[k]; }
}

__device__ __forceinline__ void moe_weight_convert(Frame& F, CArgs a, int part, int lo, int nblk) {
    LAS float* scr = (LAS float*)(F.lds + F.wave * 16640);
    const int gw = lo * NWAVES + F.wave, NGW = nblk * NWAVES, lane = LANE_NOW();
    bf16_t* WGU = (bf16_t*)(a.ws + WS_WGU); bf16_t* WDN = (bf16_t*)(a.ws + WS_WDN); const float* gf = (const float*)a.in[18];
    constexpr int I_GU = 32 * 16 * 8, I_DN = 32 * 4 * 16;
    for (int it = (part == 0 ? gw : I_GU + gw); it < (part == 0 ? I_GU : I_GU + I_DN); it += NGW) {
        if (it < I_GU) { const int e = it >> 7, r = it & 127, kb = r >> 3, nb = r & 7, nd0 = 64 * nb, pn = nd0 >> 8, bj = (nd0 >> 7) & 1, xb = nd0 & 127;
            tr_item((const float*)a.in[bj ? 24 : 23] + (size_t)e * 262144, 256, 128 * pn + xb, (bf16_t*)((unsigned char*)WGU + (size_t)e * 524288), 1024, nd0, 64 * kb, gf, scr, lane, 64, 64, 32.f); }
        else { const int r0 = it - I_GU, e = r0 >> 6, r = r0 & 63, kb = r >> 4, nb = r & 15;
            tr_item((const float*)a.in[25] + (size_t)e * 262144, 1024, 64 * nb, (bf16_t*)((unsigned char*)WDN + (size_t)e * 262144), 256, 64 * nb, 64 * kb, nullptr, scr, lane, 64, 64, 16.f); }
    }
}

template <bool DRY> __device__ __forceinline__ void p2a_conv(Frame& F, CArgs a) {
    unsigned char* ws = a.ws; bf16_t* XR = (bf16_t*)(ws + WS_XR); const bf16_t* HALO = (const bf16_t*)(ws + WS_MISC + MISC_HALO);
    const float* cw = (const float*)a.in[4]; const float* cb = (const float*)a.in[5];
    for (int b = F.vcu; b < 256; b += F.G) {
        const int pm = b >> 2, cg = b & 3, cp = F.tid & 127, sg = F.tid >> 7, c = cg * 256 + 2 * cp, base = pm * 256 + sg * 64;
        float h0[3], h1[3];
#pragma unroll
        for (int i = 0; i < 3; ++i) { unsigned w = 0u;
            if (sg == 0) { if (pm > 0) w = *(const unsigned*)(HALO + ((size_t)(pm - 1) * 3 + i) * 1024 + c); }
            else w = *(const unsigned*)(XR + (size_t)(base - 3 + i) * 1024 + c);
            h0[i] = lo2f(w); h1[i] = hi2f(w); }
        VM_WAIT(); __syncthreads();
        float w0[4], w1[4];
#pragma unroll
        for (int k = 0; k < 4; ++k) { w0[k] = cw[k * 1024 + c]; w1[k] = cw[k * 1024 + c + 1]; }
        const float b0 = cb[c], b1 = cb[c + 1];
        for (int j0 = 0; j0 < 64; j0 += 8) {
            unsigned xw[8];
#pragma unroll
            for (int j = 0; j < 8; ++j) xw[j] = *(const unsigned*)(XR + (size_t)(base + j0 + j) * 1024 + c);
#pragma unroll
            for (int j = 0; j < 8; ++j) { const float x0 = lo2f(xw[j]), x1 = hi2f(xw[j]);
                const float y0 = b0 + w0[0] * h0[0] + w0[1] * h0[1] + w0[2] * h0[2] + w0[3] * x0, y1 = b1 + w1[0] * h1[0] + w1[1] * h1[1] + w1[2] * h1[2] + w1[3] * x1;
                h0[0] = h0[1]; h0[1] = h0[2]; h0[2] = x0; h1[0] = h1[1]; h1[1] = h1[2]; h1[2] = x1;
                const unsigned yw_ = pk2(y0, y1); if (DRY) asm volatile("" :: "v"(yw_)); else *(unsigned*)(XR + (size_t)(base + j0 + j) * 1024 + c) = yw_; }
        }
        __syncthreads();
    }
    if (!DRY && F.wave < 4) {
        const float* PQ = (const float*)(ws + WS_SSQP); const float* PKV = (const float*)(ws + WS_SSQP + SSQP_KV); float* RQ = (float*)(ws + WS_CTL + CTL_SSQ_Q); float* RKV = (float*)(ws + WS_CTL + CTL_SSQ_KV);
        float* KPE = (float*)(ws + WS_KPE); const float* CS = (const float*)(ws + WS_CS); float* KSSQ = (float*)(ws + WS_MISC + MISC_KSSQ); const float* kg = (const float*)a.in[16];
        const bf16_t* XN = (const bf16_t*)(ws + WS_R1); const bf16_t* WK = (const bf16_t*)(ws + WS_WIN) + (size_t)5120 * 1024;
        const int lane = LANE_NOW(), r16 = lane & 15, q4 = lane >> 4; LAS float* kl = (LAS float*)(F.lds + F.wave * 4096);
        for (int rb = F.vcu * 4 + F.wave; rb < M / 16; rb += F.G * 4) {
            const bf16_t* ap = XN + (size_t)(rb * 16 + r16) * 1024 + 8 * q4; const bf16_t* bp0 = WK + (size_t)r16 * 1024 + 8 * q4; const bf16_t* bp1 = bp0 + 16 * 1024;
            f32x4 acc0 = {0.f, 0.f, 0.f, 0.f}, acc1 = acc0;
#pragma unroll 8
            for (int s32 = 0; s32 < 32; ++s32) { const bf16x8 av = *(const bf16x8*)(ap + 32 * s32), b0 = *(const bf16x8*)(bp0 + 32 * s32), b1 = *(const bf16x8*)(bp1 + 32 * s32);
                acc0 = __builtin_amdgcn_mfma_f32_16x16x32_bf16(av, b0, acc0, 0, 0, 0); acc1 = __builtin_amdgcn_mfma_f32_16x16x32_bf16(av, b1, acc1, 0, 0, 0); }
#pragma unroll
            for (int i2 = 0; i2 < 4; ++i2) { kl[(4 * q4 + i2) * 33 + r16] = acc0[i2]; kl[(4 * q4 + i2) * 33 + 16 + r16] = acc1[i2]; }
            LDS_WAIT();
            if (lane < 16) {
                const int row = rb * 16 + lane; float kp[32]; float ss = 0.f;
#pragma unroll
                for (int j2 = 0; j2 < 32; ++j2) { kp[j2] = kl[lane * 33 + j2]; ss += kp[j2] * kp[j2]; }
                KSSQ[row] = ss;
                { const f32x4 a0 = *(const f32x4*)(PQ + (size_t)row * 12), a1 = *(const f32x4*)(PQ + (size_t)row * 12 + 4), a2 = *(const f32x4*)(PQ + (size_t)row * 12 + 8), b0 = *(const f32x4*)(PKV + (size_t)row * 4);
                  const float sq = ((a0[0] + a0[1]) + (a0[2] + a0[3])) + ((a1[0] + a1[1]) + (a1[2] + a1[3])) + ((a2[0] + a2[1]) + (a2[2] + a2[3])), sk = (b0[0] + b0[1]) + (b0[2] + b0[3]);
                  RQ[row] = rsqrtf(sq * (1.f / 768.f) + EPS); RKV[row] = rsqrtf(sk * (1.f / 256.f) + EPS); }
#pragma unroll
                for (int i = 0; i < 4; ++i) { const f32x4 g1 = *(const f32x4*)(kg + 64 + 4 * i), g2 = *(const f32x4*)(kg + 80 + 4 * i), cs = *(const f32x4*)(CS + (size_t)row * 32 + 4 * i), sn = *(const f32x4*)(CS + (size_t)row * 32 + 16 + 4 * i);
                    f32x4 o1, o2;
#pragma unroll
                    for (int e = 0; e < 4; ++e) { const float k1 = kp[4 * i + e] * g1[e], k2 = kp[16 + 4 * i + e] * g2[e]; o1[e] = k1 * cs[e] - k2 * sn[e]; o2[e] = k1 * sn[e] + k2 * cs[e]; }
                    *(f32x4*)(KPE + (size_t)row * 32 + 4 * i) = o1; *(f32x4*)(KPE + (size_t)row * 32 + 16 + 4 * i) = o2; }
            }
            LDS_WAIT();
        }
    }
}

__device__ __forceinline__ void glds16(const void* gsrc, unsigned lds_dst) { unsigned keep;
    asm volatile("s_mov_b32 %0, m0\n\ts_mov_b32 m0, %2\n\ts_nop 0\n\tglobal_load_lds_dwordx4 %1, off\n\ts_mov_b32 m0, %0" : "=&s"(keep) : "v"(gsrc), "s"(lds_dst) : "memory"); }
__device__ __forceinline__ void glds16s(const void* sbase, unsigned voff, unsigned lds_dst) { unsigned keep;
    asm volatile("s_mov_b32 %0, m0\n\ts_mov_b32 m0, %3\n\ts_nop 0\n\tglobal_load_lds_dwordx4 %1, %2\n\ts_mov_b32 m0, %0" : "=&s"(keep) : "v"(voff), "s"(sbase), "s"(lds_dst) : "memory"); }
__device__ __forceinline__ void glds12(const void* gsrc, unsigned lds_dst) { unsigned keep;
    asm volatile("s_mov_b32 %0, m0\n\ts_mov_b32 m0, %2\n\ts_nop 0\n\tglobal_load_lds_dwordx3 %1, off\n\ts_mov_b32 m0, %0" : "=&s"(keep) : "v"(gsrc), "s"(lds_dst) : "memory"); }
#define AWAIT_BAR(N) asm volatile("s_waitcnt vmcnt(" #N ") lgkmcnt(0)\n\ts_barrier" ::: "memory")
constexpr int AT_K = 0, AT_V = 24576, AT_WS = 40960, AT_OST = 43008, AT_END = 75776;
constexpr float C2 = 0.10206207261596575f * 1.4426950408889634f;

__device__ __forceinline__ void attn_unit_v1(int h, int qb, CArgs a, const LAS float* carry, LAS unsigned char* shm) {
    const int tid = threadIdx.x, lane = tid & 63, r32 = lane & 31, hi = lane >> 5; const int wid = __builtin_amdgcn_readfirstlane(tid >> 6);
    unsigned char* ws = a.ws;
    const bf16_t* QRAW = (const bf16_t*)(ws + WS_R1); const unsigned char* KI = ws + WS_KIMG + (size_t)h * 256 * 12288; const unsigned char* VI = (const unsigned char*)a.out + 32 * MiB + (size_t)h * 256 * 8192;
    const float* CS = (const float*)(ws + WS_CS); const float* qg = (const float*)a.in[15];
    const int q0 = qb * 256, rowq = q0 + wid * 32 + r32;
    const unsigned lds0 = (unsigned)(uintptr_t)shm;
    LAS float* wsf = (LAS float*)(shm + AT_WS) + wid * 64;
    bf16x8 qr[6];
    {
        const bf16_t* qp = QRAW + (size_t)rowq * 1536 + h * 96 + hi * 8;
        u32x4 raw[6]; float qv[6][8]; float ss = 0.f;
#pragma unroll
        for (int d0 = 0; d0 < 6; ++d0) raw[d0] = *(const u32x4*)(qp + d0 * 16);
#pragma unroll
        for (int d0 = 0; d0 < 6; ++d0)
#pragma unroll
            for (int j = 0; j < 4; ++j) { qv[d0][2 * j] = lo2f(raw[d0][j]); qv[d0][2 * j + 1] = hi2f(raw[d0][j]); ss += qv[d0][2 * j] * qv[d0][2 * j] + qv[d0][2 * j + 1] * qv[d0][2 * j + 1]; }
        ss += __shfl_xor(ss, 32);
        const float rs = rsqrtf(ss * (1.f / 96.f) + EPS);
#pragma unroll
        for (int d0 = 0; d0 < 6; ++d0) { const f32x4 g0 = *(const f32x4*)(qg + d0 * 16 + hi * 8), g1 = *(const f32x4*)(qg + d0 * 16 + hi * 8 + 4);
#pragma unroll
            for (int j = 0; j < 4; ++j) { qv[d0][j] *= rs * g0[j]; qv[d0][4 + j] *= rs * g1[j]; } }
        const f32x4 c0 = *(const f32x4*)(CS + (size_t)rowq * 32 + hi * 8), c1 = *(const f32x4*)(CS + (size_t)rowq * 32 + hi * 8 + 4), s0 = *(const f32x4*)(CS + (size_t)rowq * 32 + 16 + hi * 8), s1 = *(const f32x4*)(CS + (size_t)rowq * 32 + 16 + hi * 8 + 4);
#pragma unroll
        for (int j = 0; j < 8; ++j) { const float cs = j < 4 ? c0[j & 3] : c1[j & 3], sn = j < 4 ? s0[j & 3] : s1[j & 3]; const float x1 = qv[4][j], x2 = qv[5][j]; qv[4][j] = x1 * cs - x2 * sn; qv[5][j] = x1 * sn + x2 * cs; }
#pragma unroll
        for (int d0 = 0; d0 < 6; ++d0) { u32x4 w;
#pragma unroll
            for (int j = 0; j < 4; ++j) w[j] = pk2(qv[d0][2 * j] * C2, qv[d0][2 * j + 1] * C2);
            qr[d0] = __builtin_bit_cast(bf16x8, w); }
    }
    const int NT = 4 * qb + 4, mylast = 4 * qb + (wid >> 1);
#define AT_DMA(t, buf) do { const unsigned char* kt_ = KI + (size_t)(t) * 12288 + wid * 1024 + lane * 16; const unsigned kd_ = lds0 + AT_K + (buf) * 12288 + wid * 1024; \
        glds16(kt_, (unsigned)__builtin_amdgcn_readfirstlane(kd_)); if (wid < 4) glds16(kt_ + 8192, (unsigned)__builtin_amdgcn_readfirstlane(kd_ + 8192)); \
        glds16(VI + (size_t)(t) * 8192 + wid * 1024 + lane * 16, (unsigned)__builtin_amdgcn_readfirstlane(lds0 + AT_V + (buf) * 8192 + wid * 1024)); } while (0)
#define AT_WAIT1() do { if (wid < 4) asm volatile("s_waitcnt vmcnt(3)" ::: "memory"); else asm volatile("s_waitcnt vmcnt(2)" ::: "memory"); asm volatile("s_waitcnt lgkmcnt(0)\n\ts_barrier" ::: "memory"); } while (0)
    float m_run = -1e30f, l_run = 0.f; f32x16 o[2]; o[0] = f32x16{}; o[1] = f32x16{};
    AT_DMA(0, 0);
    for (int t = 0; t < NT; ++t) {
        const int buf = t & 1;
        if (t + 1 < NT) { AT_DMA(t + 1, buf ^ 1); AT_WAIT1(); } else { AWAIT_BAR(0); }
        if (t <= mylast) {
            const LAS unsigned char* kb = shm + AT_K + buf * 12288 + hi * 1024 + r32 * 16;
            f32x16 p0 = f32x16{}, p1 = f32x16{};
#pragma unroll
            for (int d0 = 0; d0 < 6; ++d0) { const bf16x8 b0 = *(const LAS bf16x8*)(kb + d0 * 2048), b1 = *(const LAS bf16x8*)(kb + d0 * 2048 + 512);
                p0 = __builtin_amdgcn_mfma_f32_32x32x16_bf16(b0, qr[d0], p0, 0, 0, 0); p1 = __builtin_amdgcn_mfma_f32_32x32x16_bf16(b1, qr[d0], p1, 0, 0, 0); }
            float rm = fmaxf(p0[0], p1[0]);
#pragma unroll
            for (int r = 1; r < 16; ++r) rm = fmaxf(rm, fmaxf(p0[r], p1[r]));
            rm = fmaxf(rm, __shfl_xor(rm, 32));
            const float mn = fmaxf(m_run, rm), alpha = fexp2(m_run - mn); m_run = mn;
            float ps = 0.f;
#pragma unroll
            for (int r = 0; r < 16; ++r) { p0[r] = fexp2(p0[r] - mn); p1[r] = fexp2(p1[r] - mn); ps += p0[r] + p1[r]; }
            l_run = l_run * alpha + ps;
            if (__any(alpha != 1.f)) {
                if (hi == 0) wsf[r32] = alpha;
                LDS_WAIT();
#pragma unroll
                for (int r = 0; r < 16; ++r) { const float f = wsf[crow(r, hi)]; o[0][r] *= f; o[1][r] *= f; }
            }
            u32x4 pw[4];
#pragma unroll
            for (int j = 0; j < 4; ++j) { pw[0][j] = pk2(p0[2 * j], p0[2 * j + 1]); pw[1][j] = pk2(p0[8 + 2 * j], p0[8 + 2 * j + 1]); pw[2][j] = pk2(p1[2 * j], p1[2 * j + 1]); pw[3][j] = pk2(p1[8 + 2 * j], p1[8 + 2 * j + 1]); }
            const LAS unsigned char* vb = shm + AT_V + buf * 8192 + ((lane >> 4) & 1) * 32 + (lane & 3) * 8 + (4 * hi + ((lane & 15) >> 2)) * 64;
#pragma unroll
            for (int d0 = 0; d0 < 2; ++d0)
#pragma unroll
                for (int ks = 0; ks < 4; ++ks) {
                    typedef short v4i16_t __attribute__((ext_vector_type(4)));
                    const s16x4 lo = __builtin_bit_cast(s16x4, __builtin_amdgcn_ds_read_tr16_b64_v4i16((LAS v4i16_t*)(vb + d0 * 4096 + ks * 1024)));
                    const s16x4 hh = __builtin_bit_cast(s16x4, __builtin_amdgcn_ds_read_tr16_b64_v4i16((LAS v4i16_t*)(vb + d0 * 4096 + ks * 1024 + 512)));
                    const bf16x8 vf = (bf16x8){lo[0], lo[1], lo[2], lo[3], hh[0], hh[1], hh[2], hh[3]};
                    o[d0] = __builtin_amdgcn_mfma_f32_32x32x16_bf16(__builtin_bit_cast(bf16x8, pw[ks]), vf, o[d0], 0, 0, 0);
                }
        }
        asm volatile("s_waitcnt lgkmcnt(0)\n\ts_barrier" ::: "memory");
    }
#undef AT_DMA
#undef AT_WAIT1
    l_run += __shfl_xor(l_run, 32);
    if (hi == 0) wsf[32 + r32] = l_run;
    LDS_WAIT();
    LAS bf16_t* stg = (LAS bf16_t*)(shm + AT_OST) + wid * 2048;
#pragma unroll
    for (int r = 0; r < 16; ++r) { const int orow = crow(r, hi); const float il = frcp(wsf[32 + orow]);
#pragma unroll
        for (int d0 = 0; d0 < 2; ++d0) stg[orow * 64 + d0 * 32 + r32] = (bf16_t)f2bf(o[d0][r] * il); }
    LDS_WAIT();
    const bf16_t* GB = (const bf16_t*)a.out; const bf16_t* HL = (const bf16_t*)(ws + WS_GR); const bf16_t* AC = (const bf16_t*)(ws + WS_GA); bf16_t* MG = (bf16_t*)(ws + WS_XR);
#pragma unroll
    for (int i = 0; i < 4; ++i) { const int row = i * 8 + (lane >> 3), ch = lane & 7; const u32x4 yv = *(const LAS u32x4*)(stg + row * 64 + ch * 8);
        const size_t go = (size_t)(q0 + wid * 32 + row) * 1024 + h * 64 + ch * 8;
        const u32x4 gb = *(const u32x4*)(GB + go), hl = *(const u32x4*)(HL + go), ac = *(const u32x4*)(AC + go); u32x4 w;
#pragma unroll
        for (int j = 0; j < 4; ++j) { const float c0 = carry[ch * 8 + 2 * j], c1 = carry[ch * 8 + 2 * j + 1];
            w[j] = pk2(lo2f(yv[j]) * lo2f(gb[j]) + lo2f(hl[j]) + lo2f(ac[j]) * c0, hi2f(yv[j]) * hi2f(gb[j]) + hi2f(hl[j]) + hi2f(ac[j]) * c1); }
        *(u32x4*)(MG + go) = w; }
    asm volatile("s_waitcnt lgkmcnt(0)\n\ts_barrier" ::: "memory");
}


constexpr int A2_K = 0, A2_V = 36864, A2_WS = 61440, A2_OST = 63488;
#define A2_MF(a_, b_, c_) __builtin_amdgcn_mfma_f32_32x32x16_bf16(a_, b_, c_, 0, 0, 0)
#define A2_SB() __builtin_amdgcn_sched_barrier(0)
#define A2_PIN(x) asm volatile("" : "+v"(x))
#define A2_KF(d0, blk) ((ABL == 5) ? qr[(d0)] : *(const LAS bf16x8*)(kp + (d0) * 2048 + (blk) * 512))
typedef short v4i16_t __attribute__((ext_vector_type(4)));
#define A2_VT(off) __builtin_bit_cast(s16x4, __builtin_amdgcn_ds_read_tr16_b64_v4i16((LAS v4i16_t*)(vp + (off))))
#define A2_VJ(lo_, hi_, j) do { if (ABL == 5) { lo_ = (s16x4){qr[0][0], qr[0][1], qr[1][2], qr[1][3]}; hi_ = (s16x4){qr[2][0], qr[2][1], qr[3][2], qr[3][3]}; } else { lo_ = A2_VT(((j) & 1) * 4096 + ((j) >> 1) * 1024); hi_ = A2_VT(((j) & 1) * 4096 + ((j) >> 1) * 1024 + 512); } } while (0)
#define A2_VF(lo_, hi_) ((bf16x8){lo_[0], lo_[1], lo_[2], lo_[3], hi_[0], hi_[1], hi_[2], hi_[3]})
#define A2_EX(x) ((ABL == 2) ? (x) : fexp2(x))
#define A2_E3(P, b) do { P[b] = A2_EX(P[b]); P[(b) + 1] = A2_EX(P[(b) + 1]); P[(b) + 2] = A2_EX(P[(b) + 2]); } while (0)
#define A2_E2(P, b) do { P[b] = A2_EX(P[b]); P[(b) + 1] = A2_EX(P[(b) + 1]); } while (0)
#define A2_PK2(W, j, P, b) do { W[j] = pk2(P[b], P[(b) + 1]); W[(j) + 1] = pk2(P[(b) + 2], P[(b) + 3]); } while (0)
#define A2_S4(P, b) do { if (ABL != 2) { sacc += P[b]; sacc += P[(b) + 1]; sacc += P[(b) + 2]; sacc += P[(b) + 3]; } } while (0)

template <int ABL> __device__ __forceinline__ void attn_unit_v2(int h, int qb, CArgs a, const LAS float* carry, LAS unsigned char* shm) {
    const int tid = threadIdx.x, lane = tid & 63, r32 = lane & 31, hi = lane >> 5; const int wid = __builtin_amdgcn_readfirstlane(tid >> 6);
    unsigned char* ws = a.ws;
    const bf16_t* QRAW = (const bf16_t*)(ws + WS_R1); const unsigned char* KI = ws + WS_KIMG + (size_t)h * 256 * 12288; const unsigned char* VI = (const unsigned char*)a.out + 32 * MiB + (size_t)h * 256 * 8192;
    const float* CS = (const float*)(ws + WS_CS); const float* qg = (const float*)a.in[15];
    const int q0 = qb * 256, rowq = q0 + wid * 32 + r32;
    const unsigned lds0 = (unsigned)(uintptr_t)shm;
    LAS float* wsf = (LAS float*)(shm + A2_WS) + wid * 64;
    const int NT = 4 * qb + 4, mylast = 4 * qb + (wid >> 1);
    const unsigned char* ksrc = KI + wid * 1024 + lane * 16; const unsigned char* vsrc = VI + wid * 1024 + lane * 16;
    const unsigned kdst = lds0 + A2_K + wid * 1024, vdst = lds0 + A2_V + wid * 1024;
#define A2_DMAK(t, slot) do { if (ABL == 3) break; glds16(ksrc + (size_t)(t) * 12288, (unsigned)__builtin_amdgcn_readfirstlane(kdst + (slot) * 12288)); \
        if (wid < 4) glds16(ksrc + (size_t)(t) * 12288 + 8192, (unsigned)__builtin_amdgcn_readfirstlane(kdst + (slot) * 12288 + 8192)); } while (0)
#define A2_DMAV(t, slot) do { if (ABL != 3) glds16(vsrc + (size_t)(t) * 8192, (unsigned)__builtin_amdgcn_readfirstlane(vdst + (slot) * 8192)); } while (0)
#define A2_WAITFULL() do { if (wid < 4) asm volatile("s_waitcnt vmcnt(3)" ::: "memory"); else asm volatile("s_waitcnt vmcnt(2)" ::: "memory"); } while (0)
#define A2_BAR() do { if (ABL == 1) asm volatile("s_waitcnt lgkmcnt(0)" ::: "memory"); else asm volatile("s_waitcnt lgkmcnt(0)\n\ts_barrier" ::: "memory"); } while (0)
    bf16x8 qr[6];
    {
        const bf16_t* qp = QRAW + (size_t)rowq * 1536 + h * 96 + hi * 8;
        u32x4 raw[6]; float qv[6][8]; float ss = 0.f;
#pragma unroll
        for (int d0 = 0; d0 < 6; ++d0) raw[d0] = *(const u32x4*)(qp + d0 * 16);
        A2_DMAK(0, 0); A2_DMAV(0, 0); A2_DMAK(1, 1); A2_DMAV(1, 1); A2_DMAK(2, 2);
#pragma unroll
        for (int d0 = 0; d0 < 6; ++d0)
#pragma unroll
            for (int j = 0; j < 4; ++j) { qv[d0][2 * j] = lo2f(raw[d0][j]); qv[d0][2 * j + 1] = hi2f(raw[d0][j]); ss += qv[d0][2 * j] * qv[d0][2 * j] + qv[d0][2 * j + 1] * qv[d0][2 * j + 1]; }
        ss += __shfl_xor(ss, 32);
        const float rs = rsqrtf(ss * (1.f / 96.f) + EPS);
#pragma unroll
        for (int d0 = 0; d0 < 6; ++d0) { const f32x4 g0 = *(const f32x4*)(qg + d0 * 16 + hi * 8), g1 = *(const f32x4*)(qg + d0 * 16 + hi * 8 + 4);
#pragma unroll
            for (int j = 0; j < 4; ++j) { qv[d0][j] *= rs * g0[j]; qv[d0][4 + j] *= rs * g1[j]; } }
        const f32x4 c0 = *(const f32x4*)(CS + (size_t)rowq * 32 + hi * 8), c1 = *(const f32x4*)(CS + (size_t)rowq * 32 + hi * 8 + 4), s0 = *(const f32x4*)(CS + (size_t)rowq * 32 + 16 + hi * 8), s1 = *(const f32x4*)(CS + (size_t)rowq * 32 + 16 + hi * 8 + 4);
#pragma unroll
        for (int j = 0; j < 8; ++j) { const float cs = j < 4 ? c0[j & 3] : c1[j & 3], sn = j < 4 ? s0[j & 3] : s1[j & 3]; const float x1 = qv[4][j], x2 = qv[5][j]; qv[4][j] = x1 * cs - x2 * sn; qv[5][j] = x1 * sn + x2 * cs; }
#pragma unroll
        for (int d0 = 0; d0 < 6; ++d0) { u32x4 w;
#pragma unroll
            for (int j = 0; j < 4; ++j) w[j] = pk2(qv[d0][2 * j] * C2, qv[d0][2 * j + 1] * C2);
            qr[d0] = __builtin_bit_cast(bf16x8, w); }
    }
    if (wid >= 4) __builtin_amdgcn_s_setprio(1);
    float lsum = 0.f; f32x16 o[2]; o[0] = f32x16{}; o[1] = f32x16{};
    f32x16 pA0, pA1, pB0, pB1;
    if (wid < 4) asm volatile("s_waitcnt vmcnt(6)" ::: "memory"); else asm volatile("s_waitcnt vmcnt(4)" ::: "memory");
    A2_BAR();
    {
        const LAS unsigned char* kp = shm + A2_K + hi * 1024 + r32 * 16;
        pA0 = f32x16{}; pA1 = f32x16{};
#pragma unroll
        for (int d0 = 0; d0 < 6; ++d0) { pA0 = A2_MF(A2_KF(d0, 0), qr[d0], pA0); pA1 = A2_MF(A2_KF(d0, 1), qr[d0], pA1); }
    }
    int sk_next = 12288, sv_cur = 0;
#define A2_STEP(C0, C1, N0, N1, t, HASN) do { \
        const LAS unsigned char* kp = shm + A2_K + sk_next + hi * 1024 + r32 * 16; const LAS unsigned char* vp = shm + A2_V + sv_cur + ((lane >> 4) & 1) * 32 + (lane & 3) * 8 + (4 * hi + ((lane & 15) >> 2)) * 64; \
        bf16x8 k0, k1, k2; s16x4 vl0, vh0, vl1, vh1, vl2, vh2; u32x4 w0, w1, w2, w3; float sacc = 0.f; \
        A2_SB(); \
        if (HASN) { k0 = A2_KF(0, 0); k1 = A2_KF(0, 1); k2 = A2_KF(1, 0); A2_SB(); \
            N0 = A2_MF(k0, qr[0], (f32x16{})); k0 = A2_KF(1, 1); A2_E3(C0, 0);  A2_PIN(C0); A2_SB(); \
            N1 = A2_MF(k1, qr[0], (f32x16{})); k1 = A2_KF(2, 0); A2_E3(C0, 3);  A2_PIN(C0); A2_SB(); \
            N0 = A2_MF(k2, qr[1], N0);         k2 = A2_KF(2, 1); A2_E3(C0, 6);  A2_PIN(C0); A2_SB(); \
            N1 = A2_MF(k0, qr[1], N1);         k0 = A2_KF(3, 0); A2_E3(C0, 9);  A2_PIN(C0); A2_SB(); \
            N0 = A2_MF(k1, qr[2], N0);         k1 = A2_KF(3, 1); A2_E3(C0, 12); A2_PIN(C0); A2_SB(); \
            N1 = A2_MF(k2, qr[2], N1);         k2 = A2_KF(4, 0); C0[15] = A2_EX(C0[15]); A2_E2(C1, 0); A2_PIN(C0); A2_PIN(C1); A2_SB(); \
            N0 = A2_MF(k0, qr[3], N0);         k0 = A2_KF(4, 1); A2_E3(C1, 2);  A2_PIN(C1); A2_SB(); \
            N1 = A2_MF(k1, qr[3], N1);         k1 = A2_KF(5, 0); A2_E3(C1, 5);  A2_PIN(C1); A2_SB(); \
            N0 = A2_MF(k2, qr[4], N0);         k2 = A2_KF(5, 1); A2_E2(C1, 8);  A2_PK2(w0, 0, C0, 0);  A2_PIN(C1); A2_PIN(w0); A2_SB(); \
            N1 = A2_MF(k0, qr[4], N1);                           A2_E2(C1, 10); A2_PK2(w0, 2, C0, 4);  A2_PIN(C1); A2_PIN(w0); A2_SB(); \
            N0 = A2_MF(k1, qr[5], N0);         A2_VJ(vl0, vh0, 0); A2_E2(C1, 12); A2_PK2(w1, 0, C0, 8);  A2_PIN(C1); A2_PIN(w1); A2_SB(); \
            N1 = A2_MF(k2, qr[5], N1);         A2_VJ(vl1, vh1, 1); A2_E2(C1, 14); A2_PK2(w1, 2, C0, 12); A2_PIN(C1); A2_PIN(w1); A2_SB(); \
        } else { \
            _Pragma("unroll") for (int r_ = 0; r_ < 16; ++r_) { C0[r_] = A2_EX(C0[r_]); C1[r_] = A2_EX(C1[r_]); } \
            A2_PK2(w0, 0, C0, 0); A2_PK2(w0, 2, C0, 4); A2_PK2(w1, 0, C0, 8); A2_PK2(w1, 2, C0, 12); A2_VJ(vl0, vh0, 0); A2_VJ(vl1, vh1, 1); A2_SB(); \
        } \
        if ((t) > mylast) { w0 = (u32x4){0u, 0u, 0u, 0u}; w1 = w0; C0 = f32x16{}; C1 = f32x16{}; } \
        o[0] = A2_MF(__builtin_bit_cast(bf16x8, w0), A2_VF(vl0, vh0), o[0]); A2_VJ(vl2, vh2, 2); A2_PK2(w2, 0, C1, 0);  A2_S4(C0, 0);  A2_PIN(w2); A2_PIN(sacc); A2_SB(); \
        o[1] = A2_MF(__builtin_bit_cast(bf16x8, w0), A2_VF(vl1, vh1), o[1]); A2_VJ(vl0, vh0, 3); A2_PK2(w2, 2, C1, 4);  A2_S4(C0, 4);  A2_PIN(w2); A2_PIN(sacc); A2_SB(); \
        o[0] = A2_MF(__builtin_bit_cast(bf16x8, w1), A2_VF(vl2, vh2), o[0]); A2_VJ(vl1, vh1, 4); A2_PK2(w3, 0, C1, 8);  A2_S4(C0, 8);  A2_PIN(w3); A2_PIN(sacc); A2_SB(); \
        o[1] = A2_MF(__builtin_bit_cast(bf16x8, w1), A2_VF(vl0, vh0), o[1]); A2_VJ(vl2, vh2, 5); A2_PK2(w3, 2, C1, 12); A2_S4(C0, 12); A2_PIN(w3); A2_PIN(sacc); A2_SB(); \
        o[0] = A2_MF(__builtin_bit_cast(bf16x8, w2), A2_VF(vl1, vh1), o[0]); A2_VJ(vl0, vh0, 6); A2_S4(C1, 0);  A2_PIN(sacc); A2_SB(); \
        o[1] = A2_MF(__builtin_bit_cast(bf16x8, w2), A2_VF(vl2, vh2), o[1]); A2_VJ(vl1, vh1, 7); A2_S4(C1, 4);  A2_PIN(sacc); A2_SB(); \
        o[0] = A2_MF(__builtin_bit_cast(bf16x8, w3), A2_VF(vl0, vh0), o[0]); A2_S4(C1, 8);  A2_PIN(sacc); A2_SB(); \
        o[1] = A2_MF(__builtin_bit_cast(bf16x8, w3), A2_VF(vl1, vh1), o[1]); A2_S4(C1, 12); A2_PIN(sacc); A2_SB(); \
        lsum += sacc; \
        sk_next = (sk_next == 24576) ? 0 : sk_next + 12288; sv_cur = (sv_cur == 16384) ? 0 : sv_cur + 8192; \
    } while (0)
#define A2_TOP(t) do { const int t_ = (t); if (t_ - 1 <= NT - 4) { A2_WAITFULL(); } else if (t_ - 1 == NT - 3) { asm volatile("s_waitcnt vmcnt(1)" ::: "memory"); } else { asm volatile("s_waitcnt vmcnt(0)" ::: "memory"); } \
        A2_BAR(); if (t_ + 3 < NT) { glds16(kg3, (unsigned)__builtin_amdgcn_readfirstlane(kdst + dk)); if (wid < 4) glds16(kg3 + 8192, (unsigned)__builtin_amdgcn_readfirstlane(kdst + dk + 8192)); } \
        if (t_ + 2 < NT) glds16(vg2, (unsigned)__builtin_amdgcn_readfirstlane(vdst + dv)); \
        kg3 += 12288; vg2 += 8192; dk = (dk == 24576u) ? 0u : dk + 12288u; dv = (dv == 16384u) ? 0u : dv + 8192u; } while (0)
    const unsigned char* kg3 = ksrc + 3 * 12288; const unsigned char* vg2 = vsrc + 2 * 8192; unsigned dk = 0u, dv = 16384u;
    int t = 0;
    for (; t + 2 < NT; t += 2) {
        A2_TOP(t);     A2_STEP(pA0, pA1, pB0, pB1, t, true);
        A2_TOP(t + 1); A2_STEP(pB0, pB1, pA0, pA1, t + 1, true);
    }
    A2_TOP(t);     A2_STEP(pA0, pA1, pB0, pB1, t, true);
    A2_TOP(t + 1); A2_STEP(pB0, pB1, pA0, pA1, t + 1, false);
#undef A2_STEP
#undef A2_TOP
    __builtin_amdgcn_s_setprio(0);
    lsum += __shfl_xor(lsum, 32);
    if (hi == 0) wsf[32 + r32] = lsum;
    LDS_WAIT();
    LAS bf16_t* stg = (LAS bf16_t*)(shm + A2_OST) + wid * 2048;
#pragma unroll
    for (int r = 0; r < 16; ++r) { const int orow = crow(r, hi); const float il = frcp(wsf[32 + orow]);
#pragma unroll
        for (int d0 = 0; d0 < 2; ++d0) stg[orow * 64 + d0 * 32 + r32] = (bf16_t)f2bf(o[d0][r] * il); }
    LDS_WAIT();
    const bf16_t* GB = (const bf16_t*)a.out; const bf16_t* HL = (const bf16_t*)(ws + WS_GR); const bf16_t* AC = (const bf16_t*)(ws + WS_GA); bf16_t* MG = (bf16_t*)(ws + WS_XR);
#pragma unroll
    for (int i = 0; i < 4; ++i) { const int row = i * 8 + (lane >> 3), ch = lane & 7; const u32x4 yv = *(const LAS u32x4*)(stg + row * 64 + ch * 8);
        const size_t go = (size_t)(q0 + wid * 32 + row) * 1024 + h * 64 + ch * 8;
        const u32x4 gb = *(const u32x4*)(GB + go), hl = *(const u32x4*)(HL + go), ac = *(const u32x4*)(AC + go); u32x4 w;
#pragma unroll
        for (int j = 0; j < 4; ++j) { const float c0 = carry[ch * 8 + 2 * j], c1 = carry[ch * 8 + 2 * j + 1];
            w[j] = pk2(lo2f(yv[j]) * lo2f(gb[j]) + lo2f(hl[j]) + lo2f(ac[j]) * c0, hi2f(yv[j]) * hi2f(gb[j]) + hi2f(hl[j]) + hi2f(ac[j]) * c1); }
        *(u32x4*)(MG + go) = w; }
    asm volatile("s_waitcnt vmcnt(0) lgkmcnt(0)\n\ts_barrier" ::: "memory");
#undef A2_DMAK
#undef A2_DMAV
#undef A2_WAITFULL
#undef A2_BAR
}


typedef int v8i __attribute__((ext_vector_type(8)));
constexpr int A4_K = 0, A4_V = 36864, A4_WS = 53248, A4_OST = 55296;
#define A4_PVM(pw_, vf_, acc_) __builtin_amdgcn_mfma_scale_f32_32x32x64_f8f6f4(pw_, vf_, acc_, 0, 0, 0, 0x7f7f7f7f, 0, 0x7f7f7f7f)
#define A4_CV(W, j, P, b) do { int w_ = __builtin_amdgcn_cvt_pk_fp8_f32(P[b], P[(b) + 1], 0, false); W[j] = __builtin_amdgcn_cvt_pk_fp8_f32(P[(b) + 2], P[(b) + 3], w_, true); } while (0)
#define A4_VLD(vf_, d0) do { const u32x4 x0_ = *(const LAS u32x4*)(vp + (d0) * 2048), x1_ = *(const LAS u32x4*)(vp + (d0) * 2048 + 512); \
        vf_ = (v8i){(int)x0_[0], (int)x0_[1], (int)x0_[2], (int)x0_[3], (int)x1_[0], (int)x1_[1], (int)x1_[2], (int)x1_[3]}; } while (0)

__device__ __forceinline__ void attn_unit_v4(int h, int qb, CArgs a, const LAS float* carry, LAS unsigned char* shm) {
    constexpr int ABL = 0;
    const int tid = threadIdx.x, lane = tid & 63, r32 = lane & 31, hi = lane >> 5; const int wid = __builtin_amdgcn_readfirstlane(tid >> 6);
    unsigned char* ws = a.ws;
    const bf16_t* QRAW = (const bf16_t*)(ws + WS_R1); const unsigned char* KI = ws + WS_KIMG + (size_t)h * 256 * 12288; const unsigned char* VI = (const unsigned char*)a.out + 32 * MiB + (size_t)h * 256 * 4096;
    const float* CS = (const float*)(ws + WS_CS); const float* qg = (const float*)a.in[15];
    const int q0 = qb * 256, rowq = q0 + wid * 32 + r32;
    const unsigned lds0 = (unsigned)(uintptr_t)shm;
    LAS float* wsf = (LAS float*)(shm + A4_WS) + wid * 64;
    const int NT = 4 * qb + 4, mylast = 4 * qb + (wid >> 1);
    const unsigned char* ksrc = KI + wid * 1024 + lane * 16; const unsigned char* vsrc = VI + wid * 1024 + lane * 16;
    const unsigned kdst = lds0 + A4_K + wid * 1024, vdst = lds0 + A4_V + wid * 1024;
#define A4_DMAK(t, slot) do { glds16(ksrc + (size_t)(t) * 12288, (unsigned)__builtin_amdgcn_readfirstlane(kdst + (slot) * 12288)); \
        if (wid < 4) glds16(ksrc + (size_t)(t) * 12288 + 8192, (unsigned)__builtin_amdgcn_readfirstlane(kdst + (slot) * 12288 + 8192)); } while (0)
#define A4_DMAV(t, slot) do { if (wid < 4) glds16(vsrc + (size_t)(t) * 4096, (unsigned)__builtin_amdgcn_readfirstlane(vdst + (slot) * 4096)); } while (0)
#define A4_BAR() asm volatile("s_waitcnt lgkmcnt(0)\n\ts_barrier" ::: "memory")
    bf16x8 qr[6];
    {
        const bf16_t* qp = QRAW + (size_t)rowq * 1536 + h * 96 + hi * 8;
        u32x4 raw[6]; float qv[6][8]; float ss = 0.f;
#pragma unroll
        for (int d0 = 0; d0 < 6; ++d0) raw[d0] = *(const u32x4*)(qp + d0 * 16);
        A4_DMAK(0, 0); A4_DMAV(0, 0); A4_DMAK(1, 1); A4_DMAV(1, 1); A4_DMAK(2, 2);
#pragma unroll
        for (int d0 = 0; d0 < 6; ++d0)
#pragma unroll
            for (int j = 0; j < 4; ++j) { qv[d0][2 * j] = lo2f(raw[d0][j]); qv[d0][2 * j + 1] = hi2f(raw[d0][j]); ss += qv[d0][2 * j] * qv[d0][2 * j] + qv[d0][2 * j + 1] * qv[d0][2 * j + 1]; }
        ss += __shfl_xor(ss, 32);
        const float rs = rsqrtf(ss * (1.f / 96.f) + EPS);
#pragma unroll
        for (int d0 = 0; d0 < 6; ++d0) { const f32x4 g0 = *(const f32x4*)(qg + d0 * 16 + hi * 8), g1 = *(const f32x4*)(qg + d0 * 16 + hi * 8 + 4);
#pragma unroll
            for (int j = 0; j < 4; ++j) { qv[d0][j] *= rs * g0[j]; qv[d0][4 + j] *= rs * g1[j]; } }
        const f32x4 c0 = *(const f32x4*)(CS + (size_t)rowq * 32 + hi * 8), c1 = *(const f32x4*)(CS + (size_t)rowq * 32 + hi * 8 + 4), s0 = *(const f32x4*)(CS + (size_t)rowq * 32 + 16 + hi * 8), s1 = *(const f32x4*)(CS + (size_t)rowq * 32 + 16 + hi * 8 + 4);
#pragma unroll
        for (int j = 0; j < 8; ++j) { const float cs = j < 4 ? c0[j & 3] : c1[j & 3], sn = j < 4 ? s0[j & 3] : s1[j & 3]; const float x1 = qv[4][j], x2 = qv[5][j]; qv[4][j] = x1 * cs - x2 * sn; qv[5][j] = x1 * sn + x2 * cs; }
#pragma unroll
        for (int d0 = 0; d0 < 6; ++d0) { u32x4 w;
#pragma unroll
            for (int j = 0; j < 4; ++j) w[j] = pk2(qv[d0][2 * j] * C2, qv[d0][2 * j + 1] * C2);
            qr[d0] = __builtin_bit_cast(bf16x8, w); }
    }
    if (wid >= 4) __builtin_amdgcn_s_setprio(1);
    float lsum = 0.f; f32x16 o[2]; o[0] = f32x16{}; o[1] = f32x16{};
    f32x16 pA0, pA1, pB0, pB1, negm; v8i pwo = (v8i){0, 0, 0, 0, 0, 0, 0, 0};
    if (wid < 4) asm volatile("s_waitcnt vmcnt(6)" ::: "memory"); else asm volatile("s_waitcnt vmcnt(2)" ::: "memory");
    A4_BAR();
    {
        const LAS unsigned char* kp = shm + A4_K + hi * 1024 + r32 * 16;
        pA0 = f32x16{}; pA1 = f32x16{};
#pragma unroll
        for (int d0 = 0; d0 < 6; ++d0) { pA0 = A2_MF(A2_KF(d0, 0), qr[d0], pA0); pA1 = A2_MF(A2_KF(d0, 1), qr[d0], pA1); }
        float rm = fmaxf(pA0[0], pA1[0]);
#pragma unroll
        for (int r = 1; r < 16; ++r) rm = fmaxf(rm, fmaxf(pA0[r], pA1[r]));
        rm = fmaxf(rm, __shfl_xor(rm, 32));
        const float nb = 64.f - rm;
#pragma unroll
        for (int r = 0; r < 16; ++r) { pA0[r] += nb; pA1[r] += nb; negm[r] = nb; }
        asm volatile("" : "+v"(negm));
    }
    int sk_next = 12288, sv_prev = 12288;
#define A4_STEP(C0, C1, N0, N1, t, HASN, HASP) do { \
        const LAS unsigned char* kp = shm + A4_K + sk_next + hi * 1024 + r32 * 16; const LAS unsigned char* vp = shm + A4_V + sv_prev + hi * 1024 + r32 * 16; \
        bf16x8 k0, k1, k2; v8i vfa, vfb, pwn; float sacc = 0.f; \
        A2_SB(); \
        if (HASN) { k0 = A2_KF(0, 0); k1 = A2_KF(0, 1); k2 = A2_KF(1, 0); if (HASP) A4_VLD(vfa, 0); A2_SB(); \
            N0 = A2_MF(k0, qr[0], negm); k0 = A2_KF(1, 1); A3E3(C0, 0);  A2_PIN(C0); A2_SB(); \
            N1 = A2_MF(k1, qr[0], negm); k1 = A2_KF(2, 0); A3E3(C0, 3);  A2_PIN(C0); A2_SB(); \
            N0 = A2_MF(k2, qr[1], N0);   k2 = A2_KF(2, 1); A3E3(C0, 6);  A2_PIN(C0); A2_SB(); \
            N1 = A2_MF(k0, qr[1], N1);   k0 = A2_KF(3, 0); A3E3(C0, 9);  A2_PIN(C0); A2_SB(); \
            if (HASP) { o[0] = A4_PVM(pwo, vfa, o[0]); A4_VLD(vfb, 1); } A4_CV(pwn, 0, C0, 0); A4_CV(pwn, 1, C0, 4); A3S4(C0, 0); A3S4(C0, 4); A2_PIN(pwn); A2_PIN(sacc); A2_SB(); \
            N0 = A2_MF(k1, qr[2], N0);   k1 = A2_KF(3, 1); A3E3(C0, 12); A2_PIN(C0); A2_SB(); \
            N1 = A2_MF(k2, qr[2], N1);   k2 = A2_KF(4, 0); C0[15] = fexp2(C0[15]); A3E2(C1, 0); A2_PIN(C0); A2_PIN(C1); A2_SB(); \
            N0 = A2_MF(k0, qr[3], N0);   k0 = A2_KF(4, 1); A3E3(C1, 2);  A2_PIN(C1); A2_SB(); \
            N1 = A2_MF(k1, qr[3], N1);   k1 = A2_KF(5, 0); A3E3(C1, 5);  A2_PIN(C1); A2_SB(); \
            if (HASP) { o[1] = A4_PVM(pwo, vfb, o[1]); } A4_CV(pwn, 2, C0, 8); A4_CV(pwn, 3, C0, 12); A4_CV(pwn, 4, C1, 0); A4_CV(pwn, 5, C1, 4); A3S4(C0, 8); A3S4(C0, 12); A3S4(C1, 0); A3S4(C1, 4); A2_PIN(pwn); A2_PIN(sacc); A2_SB(); \
            N0 = A2_MF(k2, qr[4], N0);   k2 = A2_KF(5, 1); A3E3(C1, 8);  A2_PIN(C1); A2_SB(); \
            N1 = A2_MF(k0, qr[4], N1);                      A3E3(C1, 11); A2_PIN(C1); A2_SB(); \
            N0 = A2_MF(k1, qr[5], N0);                      A3E2(C1, 14); A4_CV(pwn, 6, C1, 8); A3S4(C1, 8); A2_PIN(C1); A2_PIN(pwn); A2_PIN(sacc); A2_SB(); \
            N1 = A2_MF(k2, qr[5], N1);                      A4_CV(pwn, 7, C1, 12); A3S4(C1, 12); A2_PIN(pwn); A2_PIN(sacc); A2_SB(); \
        } else { \
            if (HASP) { A4_VLD(vfa, 0); A4_VLD(vfb, 1); } \
            _Pragma("unroll") for (int r_ = 0; r_ < 16; ++r_) { C0[r_] = fexp2(C0[r_]); C1[r_] = fexp2(C1[r_]); } \
            if (HASP) { o[0] = A4_PVM(pwo, vfa, o[0]); o[1] = A4_PVM(pwo, vfb, o[1]); } \
            A4_CV(pwn, 0, C0, 0); A4_CV(pwn, 1, C0, 4); A4_CV(pwn, 2, C0, 8); A4_CV(pwn, 3, C0, 12); A4_CV(pwn, 4, C1, 0); A4_CV(pwn, 5, C1, 4); A4_CV(pwn, 6, C1, 8); A4_CV(pwn, 7, C1, 12); \
            A3S4(C0, 0); A3S4(C0, 4); A3S4(C0, 8); A3S4(C0, 12); A3S4(C1, 0); A3S4(C1, 4); A3S4(C1, 8); A3S4(C1, 12); A2_SB(); \
        } \
        if ((t) > mylast) { pwn = (v8i){0, 0, 0, 0, 0, 0, 0, 0}; sacc = 0.f; } \
        pwo = pwn; lsum += sacc; \
        sk_next = (sk_next == 24576) ? 0 : sk_next + 12288; sv_prev = (sv_prev == 12288) ? 0 : sv_prev + 4096; \
    } while (0)
#define A3E3(P, b) do { P[b] = fexp2(P[b]); P[(b) + 1] = fexp2(P[(b) + 1]); P[(b) + 2] = fexp2(P[(b) + 2]); } while (0)
#define A3E2(P, b) do { P[b] = fexp2(P[b]); P[(b) + 1] = fexp2(P[(b) + 1]); } while (0)
#define A3S4(P, b) do { sacc += P[b]; sacc += P[(b) + 1]; sacc += P[(b) + 2]; sacc += P[(b) + 3]; } while (0)
#define A4_TOP(t) do { const int t_ = (t); \
        if (t_ - 1 <= NT - 4) { if (wid < 4) asm volatile("s_waitcnt vmcnt(3)" ::: "memory"); else asm volatile("s_waitcnt vmcnt(1)" ::: "memory"); } \
        else if (t_ - 1 == NT - 3 && wid < 4) { asm volatile("s_waitcnt vmcnt(1)" ::: "memory"); } else { asm volatile("s_waitcnt vmcnt(0)" ::: "memory"); } \
        A4_BAR(); if (t_ + 3 < NT) { glds16(kg3, (unsigned)__builtin_amdgcn_readfirstlane(kdst + dk)); if (wid < 4) glds16(kg3 + 8192, (unsigned)__builtin_amdgcn_readfirstlane(kdst + dk + 8192)); } \
        if (t_ + 2 < NT && wid < 4) glds16(vg2, (unsigned)__builtin_amdgcn_readfirstlane(vdst + dv)); \
        kg3 += 12288; vg2 += 4096; dk = (dk == 24576u) ? 0u : dk + 12288u; dv = (dv == 12288u) ? 0u : dv + 4096u; } while (0)
    const unsigned char* kg3 = ksrc + 3 * 12288; const unsigned char* vg2 = vsrc + 2 * 4096; unsigned dk = 0u, dv = 8192u;
    A4_TOP(0); A4_STEP(pA0, pA1, pB0, pB1, 0, true, false);
    A4_TOP(1); A4_STEP(pB0, pB1, pA0, pA1, 1, true, true);
    int t = 2;
    for (; t + 2 < NT; t += 2) {
        A4_TOP(t);     A4_STEP(pA0, pA1, pB0, pB1, t, true, true);
        A4_TOP(t + 1); A4_STEP(pB0, pB1, pA0, pA1, t + 1, true, true);
    }
    A4_TOP(t);     A4_STEP(pA0, pA1, pB0, pB1, t, true, true);
    A4_TOP(t + 1); A4_STEP(pB0, pB1, pA0, pA1, t + 1, false, true);
    {
        const LAS unsigned char* vp = shm + A4_V + sv_prev + hi * 1024 + r32 * 16; v8i vfa, vfb;
        A4_VLD(vfa, 0); A4_VLD(vfb, 1); o[0] = A4_PVM(pwo, vfa, o[0]); o[1] = A4_PVM(pwo, vfb, o[1]);
    }
#undef A4_STEP
#undef A4_TOP
#undef A3E3
#undef A3E2
#undef A3S4
    __builtin_amdgcn_s_setprio(0);
    lsum += __shfl_xor(lsum, 32);
    if (hi == 0) wsf[32 + r32] = lsum;
    LDS_WAIT();
    LAS bf16_t* stg = (LAS bf16_t*)(shm + A4_OST) + wid * 2048;
#pragma unroll
    for (int r = 0; r < 16; ++r) { const int orow = crow(r, hi); const float il = frcp(wsf[32 + orow]);
#pragma unroll
        for (int d0 = 0; d0 < 2; ++d0) stg[orow * 64 + d0 * 32 + r32] = (bf16_t)f2bf(o[d0][r] * il); }
    LDS_WAIT();
    const bf16_t* GB = (const bf16_t*)a.out; const bf16_t* HL = (const bf16_t*)(ws + WS_GR); const bf16_t* AC = (const bf16_t*)(ws + WS_GA); bf16_t* MG = (bf16_t*)(ws + WS_XR);
#pragma unroll
    for (int i = 0; i < 4; ++i) { const int row = i * 8 + (lane >> 3), ch = lane & 7; const u32x4 yv = *(const LAS u32x4*)(stg + row * 64 + ch * 8);
        const size_t go = (size_t)(q0 + wid * 32 + row) * 1024 + h * 64 + ch * 8;
        const u32x4 gb = *(const u32x4*)(GB + go), hl = *(const u32x4*)(HL + go), ac = *(const u32x4*)(AC + go); u32x4 w;
#pragma unroll
        for (int j = 0; j < 4; ++j) { const float c0 = carry[ch * 8 + 2 * j], c1 = carry[ch * 8 + 2 * j + 1];
            w[j] = pk2(lo2f(yv[j]) * lo2f(gb[j]) + lo2f(hl[j]) + lo2f(ac[j]) * c0, hi2f(yv[j]) * hi2f(gb[j]) + hi2f(hl[j]) + hi2f(ac[j]) * c1); }
        *(u32x4*)(MG + go) = w; }
    asm volatile("s_waitcnt vmcnt(0) lgkmcnt(0)\n\ts_barrier" ::: "memory");
#undef A4_DMAK
#undef A4_DMAV
#undef A4_BAR
}


constexpr int A5_K = 0, A5_V = 24576, A5_WS = 40960, A5_OST = 43008;
#define A5_QKM(k8_, q8_, c_) __builtin_amdgcn_mfma_scale_f32_32x32x64_f8f6f4(k8_, q8_, c_, 0, 0, 0, 0x7f7f7f7f, 0, 0x7f7f7f7f)
#define A5_K8(kf_, kb) do { const u32x4 x0_ = *(const LAS u32x4*)(kp + (kb) * 2048), x1_ = *(const LAS u32x4*)(kp + (kb) * 2048 + 512); \
        kf_ = (v8i){(int)x0_[0], (int)x0_[1], (int)x0_[2], (int)x0_[3], (int)x1_[0], (int)x1_[1], (int)x1_[2], (int)x1_[3]}; } while (0)
#define A5_KR(d0r, kb) (*(const LAS bf16x8*)(kp + 4096 + (d0r) * 2048 + (kb) * 512))

#ifndef MK_LATEDMA
#define MK_LATEDMA 0
#endif
#ifndef MK_KD
#define MK_KD 2
#endif
#ifndef MK_VD
#define MK_VD 1
#endif
template <int ABL> __device__ __forceinline__ void attn_unit_v5(int h, int qb, CArgs a, const LAS float* carry, LAS unsigned char* shm) {
    int tid = threadIdx.x; asm volatile("" : "+v"(tid));
    const int lane = tid & 63, r32 = lane & 31, hi = lane >> 5; const int wid = __builtin_amdgcn_readfirstlane(tid >> 6);
    unsigned char* ws = a.ws;
    const bf16_t* QRAW = (const bf16_t*)(ws + WS_R1); const unsigned char* KI = ws + WS_KIMG + (size_t)h * 256 * 8192; const unsigned char* VI = (const unsigned char*)a.out + 32 * MiB + (size_t)h * 256 * 4096;
    const float* CS = (const float*)(ws + WS_CS); const float* qg = (const float*)a.in[15];
    const int q0 = qb * 256, rowq = q0 + wid * 32 + r32;
    const unsigned lds0 = (unsigned)(uintptr_t)shm;
    const int NT = 4 * qb + 4, mylast = 4 * qb + (wid >> 1);
    const unsigned char* ksrc = KI + wid * 1024 + lane * 16; const unsigned char* vsrc = VI + wid * 1024 + lane * 16;
    constexpr int KD = MK_KD, VD = MK_VD, A5_K = 0, A5_V = KD * 8192, A5_WS = A5_V + (VD + 2) * 4096, A5_OST = A5_WS + 2048;
    const unsigned kdst = lds0 + A5_K + wid * 1024, vdst = lds0 + A5_V + wid * 1024;
#define A5_DMAK(t, slot) glds16(ksrc + (size_t)(t) * 8192, (unsigned)__builtin_amdgcn_readfirstlane(kdst + (slot) * 8192))
#define A5_DMAV(t, slot) do { if (wid < 4) glds16(vsrc + (size_t)(t) * 4096, (unsigned)__builtin_amdgcn_readfirstlane(vdst + (slot) * 4096)); } while (0)
#define A5_BAR() asm volatile("s_waitcnt lgkmcnt(0)\n\ts_barrier" ::: "memory")
#define A5_VMW(n_) do { const int vw_ = (n_); if (vw_ >= 7) asm volatile("s_waitcnt vmcnt(7)" ::: "memory"); else if (vw_ == 6) asm volatile("s_waitcnt vmcnt(6)" ::: "memory"); else if (vw_ == 5) asm volatile("s_waitcnt vmcnt(5)" ::: "memory"); else if (vw_ == 4) asm volatile("s_waitcnt vmcnt(4)" ::: "memory"); \
        else if (vw_ == 3) asm volatile("s_waitcnt vmcnt(3)" ::: "memory"); else if (vw_ == 2) asm volatile("s_waitcnt vmcnt(2)" ::: "memory"); else if (vw_ == 1) asm volatile("s_waitcnt vmcnt(1)" ::: "memory"); else asm volatile("s_waitcnt vmcnt(0)" ::: "memory"); } while (0)
    v8i q8; bf16x8 qr4, qr5;
    {
        const bf16_t* qp = QRAW + (size_t)rowq * 1536 + h * 96;
        u32x4 rawn[4], rawr[2]; float qn[32], qv4[8], qv5[8]; float ss = 0.f;
#pragma unroll
        for (int i = 0; i < 4; ++i) rawn[i] = *(const u32x4*)(qp + 32 * hi + 8 * i);
        rawr[0] = *(const u32x4*)(qp + 64 + 8 * hi); rawr[1] = *(const u32x4*)(qp + 80 + 8 * hi);
        f32x4 gq[8];
#pragma unroll
        for (int i = 0; i < 8; ++i) gq[i] = *(const f32x4*)(qg + 32 * hi + 4 * i);
        const f32x4 g0 = *(const f32x4*)(qg + 64 + hi * 8), g1 = *(const f32x4*)(qg + 64 + hi * 8 + 4), g2 = *(const f32x4*)(qg + 80 + hi * 8), g3 = *(const f32x4*)(qg + 80 + hi * 8 + 4);
        const f32x4 c0 = *(const f32x4*)(CS + (size_t)rowq * 32 + hi * 8), c1 = *(const f32x4*)(CS + (size_t)rowq * 32 + hi * 8 + 4), s0 = *(const f32x4*)(CS + (size_t)rowq * 32 + 16 + hi * 8), s1 = *(const f32x4*)(CS + (size_t)rowq * 32 + 16 + hi * 8 + 4);
#pragma unroll
        for (int tp = -KD; tp < 0; ++tp) { A5_DMAK(tp + KD, tp + KD); if (tp + VD >= 0) A5_DMAV(tp + VD, tp + VD); }
#pragma unroll
        for (int i = 0; i < 4; ++i)
#pragma unroll
            for (int j = 0; j < 4; ++j) { qn[8 * i + 2 * j] = lo2f(rawn[i][j]); qn[8 * i + 2 * j + 1] = hi2f(rawn[i][j]); }
#pragma unroll
        for (int j = 0; j < 4; ++j) { qv4[2 * j] = lo2f(rawr[0][j]); qv4[2 * j + 1] = hi2f(rawr[0][j]); qv5[2 * j] = lo2f(rawr[1][j]); qv5[2 * j + 1] = hi2f(rawr[1][j]); }
#pragma unroll
        for (int j = 0; j < 32; ++j) ss += qn[j] * qn[j];
#pragma unroll
        for (int j = 0; j < 8; ++j) ss += qv4[j] * qv4[j] + qv5[j] * qv5[j];
        ss += __shfl_xor(ss, 32);
        const float rs = rsqrtf(ss * (1.f / 96.f) + EPS);
#pragma unroll
        for (int i = 0; i < 8; ++i) { const f32x4 g = gq[i];
#pragma unroll
            for (int e = 0; e < 4; ++e) qn[4 * i + e] *= rs * g[e] * 1.1779544f; }
        {
#pragma unroll
          for (int j = 0; j < 4; ++j) { qv4[j] *= rs * g0[j]; qv4[4 + j] *= rs * g1[j]; qv5[j] *= rs * g2[j]; qv5[4 + j] *= rs * g3[j]; } }
#pragma unroll
        for (int j = 0; j < 8; ++j) { const float cs = j < 4 ? c0[j & 3] : c1[j & 3], sn = j < 4 ? s0[j & 3] : s1[j & 3]; const float x1 = qv4[j], x2 = qv5[j]; qv4[j] = x1 * cs - x2 * sn; qv5[j] = x1 * sn + x2 * cs; }
#pragma unroll
        for (int v = 0; v < 8; ++v) { const int w_ = __builtin_amdgcn_cvt_pk_fp8_f32(qn[4 * v], qn[4 * v + 1], 0, false); q8[v] = __builtin_amdgcn_cvt_pk_fp8_f32(qn[4 * v + 2], qn[4 * v + 3], w_, true); }
        u32x4 w4, w5;
#pragma unroll
        for (int j = 0; j < 4; ++j) { w4[j] = pk2(qv4[2 * j] * (8.f * C2), qv4[2 * j + 1] * (8.f * C2)); w5[j] = pk2(qv5[2 * j] * (8.f * C2), qv5[2 * j + 1] * (8.f * C2)); }
        qr4 = __builtin_bit_cast(bf16x8, w4); qr5 = __builtin_bit_cast(bf16x8, w5);
    }
    if (wid >= 4) __builtin_amdgcn_s_setprio(1);
    f32x16 o[2]; o[0] = f32x16{}; o[1] = f32x16{}; f32x4 lsum = {0.f, 0.f, 0.f, 0.f};
    f32x16 pA0, pA1, pB0, pB1, negm; v8i pwo = (v8i){0, 0, 0, 0, 0, 0, 0, 0};
    int onev = ((((lane >> 4) & 1) != 0) == ((lane & 15) >= 8)) ? 0x38383838 : 0; asm volatile("" : "+v"(onev));
    const v8i ones8 = (v8i){onev, onev, onev, onev, onev, onev, onev, onev};
#define A5_SUM(pw_) lsum = __builtin_amdgcn_mfma_scale_f32_16x16x128_f8f6f4(pw_, ones8, lsum, 0, 0, 0, 0x7f7f7f7f, 0, 0x7f7f7f7f)
    A5_VMW((KD - 1) + (wid < 4 ? VD : 0));
    A5_BAR();
    {
        const LAS unsigned char* kp = shm + A5_K + hi * 1024 + r32 * 16; v8i ka, kb8;
        A5_K8(ka, 0); A5_K8(kb8, 1);
        pA0 = A5_QKM(ka, q8, (f32x16{})); pA1 = A5_QKM(kb8, q8, (f32x16{}));
        pA0 = A2_MF(A5_KR(0, 0), qr4, pA0); pA1 = A2_MF(A5_KR(0, 1), qr4, pA1); pA0 = A2_MF(A5_KR(1, 0), qr5, pA0); pA1 = A2_MF(A5_KR(1, 1), qr5, pA1);
        float rm = fmaxf(pA0[0], pA1[0]);
#pragma unroll
        for (int r = 1; r < 16; ++r) rm = fmaxf(rm, fmaxf(pA0[r], pA1[r]));
        rm = fmaxf(rm, __shfl_xor(rm, 32));
        const float nb = 64.f - rm;
#pragma unroll
        for (int r = 0; r < 16; ++r) { pA0[r] += nb; pA1[r] += nb; negm[r] = nb; }
        asm volatile("" : "+v"(negm));
    }
    int sk_next = 8192, sv_prev = (VD + 1) * 4096;
#define A5_CVU(W, j, P, b) do { if (ABL == 4) { W[j] = pwo[j]; break; } unsigned w_ = __builtin_amdgcn_cvt_pk_u8_f32(P[b], 0, 0u); w_ = __builtin_amdgcn_cvt_pk_u8_f32(P[(b) + 1], 1, w_); w_ = __builtin_amdgcn_cvt_pk_u8_f32(P[(b) + 2], 2, w_); W[j] = (int)__builtin_amdgcn_cvt_pk_u8_f32(P[(b) + 3], 3, w_); } while (0)
#define A5_STEP(C0, C1, N0, N1, t, HASN, HASP) do { \
        const LAS unsigned char* kp = shm + A5_K + sk_next + hi * 1024 + r32 * 16; const LAS unsigned char* vp = shm + A5_V + sv_prev + hi * 1024 + r32 * 16; \
        v8i ka, kb8, vfa, vfb, pwn; bf16x8 r0, r1, r2, r3; \
        A2_SB(); \
        if (HASN) { A5_K8(ka, 0); A5_K8(kb8, 1); r0 = A5_KR(0, 0); r1 = A5_KR(0, 1); A2_SB(); \
            N0 = A5_QKM(ka, q8, negm);  r2 = A5_KR(1, 0); r3 = A5_KR(1, 1); if (HASP) A4_VLD(vfa, 0); A5_CVU(pwn, 0, C0, 0); A5_CVU(pwn, 1, C0, 4); A2_PIN(pwn); A2_SB(); \
            N1 = A5_QKM(kb8, q8, negm); if (HASP) A4_VLD(vfb, 1); if (MK_LATEDMA) A5_ISSUEK(t); A5_CVU(pwn, 2, C0, 8); A5_CVU(pwn, 3, C0, 12); A2_PIN(pwn); A2_SB(); \
            if (ABL != 5) N0 = A2_MF(r0, qr4, N0); A5_CVU(pwn, 4, C1, 0); A2_PIN(pwn); A2_SB(); \
            if (ABL != 5) N1 = A2_MF(r1, qr4, N1); A5_CVU(pwn, 5, C1, 4); A2_PIN(pwn); A2_SB(); \
            if (HASP) { o[0] = A4_PVM(pwo, vfa, o[0]); } if (MK_LATEDMA) A5_ISSUEV(t); A5_CVU(pwn, 6, C1, 8); A5_CVU(pwn, 7, C1, 12); A2_PIN(pwn); A2_SB(); \
            if (ABL != 5) N0 = A2_MF(r2, qr5, N0); A2_SB(); \
            if (ABL != 5) N1 = A2_MF(r3, qr5, N1); A2_SB(); \
            if (HASP) { o[1] = A4_PVM(pwo, vfb, o[1]); } A2_SB(); \
            if (HASP && ABL != 2) { A5_SUM(pwo); } A2_SB(); \
        } else { \
            if (HASP) { A4_VLD(vfa, 0); A4_VLD(vfb, 1); } \
            A5_CVU(pwn, 0, C0, 0); A5_CVU(pwn, 1, C0, 4); A5_CVU(pwn, 2, C0, 8); A5_CVU(pwn, 3, C0, 12); A5_CVU(pwn, 4, C1, 0); A5_CVU(pwn, 5, C1, 4); A5_CVU(pwn, 6, C1, 8); A5_CVU(pwn, 7, C1, 12); \
            if (HASP) { o[0] = A4_PVM(pwo, vfa, o[0]); o[1] = A4_PVM(pwo, vfb, o[1]); A5_SUM(pwo); } A2_SB(); \
        } \
        if ((t) > mylast) { pwn = (v8i){0, 0, 0, 0, 0, 0, 0, 0}; } \
        pwo = pwn; \
        sk_next = (sk_next == (KD - 1) * 8192) ? 0 : sk_next + 8192; sv_prev = (sv_prev == (VD + 1) * 4096) ? 0 : sv_prev + 4096; \
    } while (0)
#define A5_TOP(t) do { const int t_ = (t); int c_ = 0; \
        _Pragma("unroll") for (int b_ = 1; b_ <= KD - 2; ++b_) { c_ += (t_ - b_ + KD < NT) ? 1 : 0; if (wid < 4) c_ += (t_ - b_ + VD < NT) ? 1 : 0; } \
        A5_VMW(c_); \
        if (ABL != 3) A5_BAR(); if (!MK_LATEDMA) { A5_ISSUEK(t_); A5_ISSUEV(t_); } } while (0)
#define A5_ISSUEK(t_) do { if ((t_) + KD < NT) glds16(kg3, (unsigned)__builtin_amdgcn_readfirstlane(kdst + dk)); kg3 += 8192; dk = (dk == (KD - 1) * 8192u) ? 0u : dk + 8192u; } while (0)
#define A5_ISSUEV(t_) do { if ((t_) + VD < NT && wid < 4) glds16(vg2, (unsigned)__builtin_amdgcn_readfirstlane(vdst + dv)); vg2 += 4096; dv = (dv == (VD + 1) * 4096u) ? 0u : dv + 4096u; } while (0)
    const unsigned char* kg3 = ksrc + KD * 8192; const unsigned char* vg2 = vsrc + VD * 4096; unsigned dk = 0u, dv = VD * 4096u;
    A5_TOP(0); A5_STEP(pA0, pA1, pB0, pB1, 0, true, false);
    A5_TOP(1); A5_STEP(pB0, pB1, pA0, pA1, 1, true, true);
    int t = 2;
    for (; t + 2 < NT; t += 2) {
        A5_TOP(t);     A5_STEP(pA0, pA1, pB0, pB1, t, true, true);
        A5_TOP(t + 1); A5_STEP(pB0, pB1, pA0, pA1, t + 1, true, true);
    }
    A5_TOP(t);     A5_STEP(pA0, pA1, pB0, pB1, t, true, true);
    A5_TOP(t + 1); A5_STEP(pB0, pB1, pA0, pA1, t + 1, false, true);
    {
        const LAS unsigned char* vp = shm + A5_V + sv_prev + hi * 1024 + r32 * 16; v8i vfa, vfb;
        A4_VLD(vfa, 0); A4_VLD(vfb, 1); o[0] = A4_PVM(pwo, vfa, o[0]); o[1] = A4_PVM(pwo, vfb, o[1]); A5_SUM(pwo);
    }
#undef A5_STEP
#undef A5_TOP
#undef A5_ISSUEK
#undef A5_ISSUEV
#undef A5_CVU
#undef A5_SUM
    __builtin_amdgcn_s_setprio(0);
    LAS float* sums = (LAS float*)(shm + A5_WS) + wid * 64;
    if ((lane & 7) == 0) *(LAS f32x4*)(sums + ((lane & 8) ? 16 : 0) + 4 * (lane >> 4)) = lsum;
    LDS_WAIT();
    f32x4 ls4[4];
#pragma unroll
    for (int g = 0; g < 4; ++g) ls4[g] = *(const LAS f32x4*)(sums + 8 * g + 4 * hi);
    LAS bf16_t* stg = (LAS bf16_t*)(shm + A5_OST) + wid * 2048;
#pragma unroll
    for (int r = 0; r < 16; ++r) { const int orow = crow(r, hi); const float il = frcp(ls4[r >> 2][r & 3]);
#pragma unroll
        for (int d0 = 0; d0 < 2; ++d0) stg[orow * 64 + d0 * 32 + r32] = (bf16_t)f2bf(o[d0][r] * il); }
    LDS_WAIT();
    const bf16_t* GB = (const bf16_t*)a.out; const bf16_t* HL = (const bf16_t*)(ws + WS_GR); const bf16_t* AC = (const bf16_t*)(ws + WS_GA); bf16_t* MG = (bf16_t*)(ws + WS_XR);
#pragma unroll
    for (int i = 0; i < 4; ++i) { const int row = i * 8 + (lane >> 3), ch = lane & 7; const u32x4 yv = *(const LAS u32x4*)(stg + row * 64 + ch * 8);
        const size_t go = (size_t)(q0 + wid * 32 + row) * 1024 + h * 64 + ch * 8;
        const u32x4 gb = *(const u32x4*)(GB + go), hl = *(const u32x4*)(HL + go), ac = *(const u32x4*)(AC + go); u32x4 w;
#pragma unroll
        for (int j = 0; j < 4; ++j) { const float c0 = carry[ch * 8 + 2 * j], c1 = carry[ch * 8 + 2 * j + 1];
            w[j] = pk2(lo2f(yv[j]) * lo2f(gb[j]) + lo2f(hl[j]) + lo2f(ac[j]) * c0, hi2f(yv[j]) * hi2f(gb[j]) + hi2f(hl[j]) + hi2f(ac[j]) * c1); }
        *(u32x4*)(MG + go) = w; }
    asm volatile("s_waitcnt vmcnt(0) lgkmcnt(0)\n\ts_barrier" ::: "memory");
#undef A5_DMAK
#undef A5_DMAV
#undef A5_BAR
#undef A5_VMW
}

#ifndef MK_V7
#define MK_V7 1
#endif
#ifndef MK_PFVD
#define MK_PFVD 1
#endif
#ifndef MK_PF
#define MK_PF 0
#endif
#ifndef MK_PRIO
#define MK_PRIO 1
#endif
#ifndef MK_VW
#define MK_VW 0
#endif
#ifndef MK_PVF
#define MK_PVF 0
#endif
template <int ABL> __device__ __forceinline__ void attn_block_v7(int h, int s_, CArgs a, const LAS float* carry4, LAS unsigned char* shm) {
    int tid = threadIdx.x; asm volatile("" : "+v"(tid));
    const int lane0 = tid & 63; const int wid = __builtin_amdgcn_readfirstlane(tid >> 6);
    unsigned char* ws = a.ws;
    const bf16_t* QRAW = (const bf16_t*)(ws + WS_R1); const unsigned char* KI = ws + WS_KIMG + (size_t)h * 256 * 8192; const unsigned char* VI = (const unsigned char*)a.out + 32 * MiB + (size_t)h * 256 * 4096;
    const float* CS = (const float*)(ws + WS_CS); const float* qg = (const float*)a.in[15];
    const unsigned lds0 = (unsigned)(uintptr_t)shm; const bool vwave = MK_VW ? (wid >= 4) : (wid < 4); const int wv = wid & 3;
    constexpr int KD = MK_PF ? 3 : MK_KD, VD = MK_PF ? MK_PFVD : MK_VD, A5_K = 0, A5_V = KD * 8192, A5_WS = A5_V + (VD + 2) * 4096, A5_OST = A5_WS + 2048, A5_G = A5_OST + 8 * 4096;
    const unsigned kdst = lds0 + A5_K + wid * 1024, vdst = lds0 + A5_V + wv * 1024;
#define A5_DMAK(t, slot) glds16(ksrc_ + (size_t)(t) * 8192, (unsigned)__builtin_amdgcn_readfirstlane(kdst + (slot) * 8192))
#define A5_DMAV(t, slot) do { if (vwave) glds16(vsrc_ + (size_t)(t) * 4096, (unsigned)__builtin_amdgcn_readfirstlane(vdst + (slot) * 4096)); } while (0)
#define A5_BAR() asm volatile("s_waitcnt lgkmcnt(0)\n\ts_barrier" ::: "memory")
#define A5_VMW(n_) do { const int vw_ = (n_); if (vw_ >= 7) asm volatile("s_waitcnt vmcnt(7)" ::: "memory"); else if (vw_ == 6) asm volatile("s_waitcnt vmcnt(6)" ::: "memory"); else if (vw_ == 5) asm volatile("s_waitcnt vmcnt(5)" ::: "memory"); else if (vw_ == 4) asm volatile("s_waitcnt vmcnt(4)" ::: "memory"); \
        else if (vw_ == 3) asm volatile("s_waitcnt vmcnt(3)" ::: "memory"); else if (vw_ == 2) asm volatile("s_waitcnt vmcnt(2)" ::: "memory"); else if (vw_ == 1) asm volatile("s_waitcnt vmcnt(1)" ::: "memory"); else asm volatile("s_waitcnt vmcnt(0)" ::: "memory"); } while (0)
    LAS float* gl = (LAS float*)(shm + A5_G);
    if (tid < 96) gl[tid] = qg[tid];
    u32x4 rawn[4], rawr[2];
#define A7_LOADQ(qb_, L_) do { const int r32 = (L_) & 31, hi = (L_) >> 5; const unsigned char* ksrc_ = KI + wid * 1024 + (L_) * 16; const unsigned char* vsrc_ = VI + wv * 1024 + (L_) * 16; const int rq_ = (qb_) * 256 + wid * 32 + r32; const bf16_t* qp = QRAW + (size_t)rq_ * 1536 + h * 96; \
        _Pragma("unroll") for (int i_ = 0; i_ < 4; ++i_) rawn[i_] = *(const u32x4*)(qp + 32 * hi + 8 * i_); \
        rawr[0] = *(const u32x4*)(qp + 64 + 8 * hi); rawr[1] = *(const u32x4*)(qp + 80 + 8 * hi); \
        _Pragma("unroll") for (int tp = -KD; tp < 0; ++tp) { A5_DMAK(tp + KD, tp + KD); if (tp + VD >= 0) A5_DMAV(tp + VD, tp + VD); } } while (0)
    A7_LOADQ(s_, lane0);
    A5_BAR();
#pragma unroll 1
    for (int ui = 0; ui < 4; ++ui) {
    int lane = lane0; asm volatile("" : "+v"(lane));
    const int r32 = lane & 31, hi = lane >> 5;
    const unsigned char* ksrc = KI + wid * 1024; const unsigned char* vsrc = VI + wv * 1024; const unsigned loff = (unsigned)lane * 16u;
    int onev = ((((lane >> 4) & 1) != 0) == ((lane & 15) >= 8)) ? 0x38383838 : 0; asm volatile("" : "+v"(onev));
    const v8i ones8 = (v8i){onev, onev, onev, onev, onev, onev, onev, onev};
#define A5_SUM(pw_) lsum = __builtin_amdgcn_mfma_scale_f32_16x16x128_f8f6f4(pw_, ones8, lsum, 0, 0, 0, 0x7f7f7f7f, 0, 0x7f7f7f7f)
    const int qb = ((ui & 2) ? 32 : 0) + ((ui & 1) ? 31 - s_ : s_);
    const int q0 = qb * 256; const int NT = 4 * qb + 4, mylast = 4 * qb + (wid >> 1);
    const LAS float* carry = carry4 + ui * 64;
    v8i q8; bf16x8 qr4, qr5;
    {
        const int rowq = q0 + wid * 32 + r32;
        const f32x4 c0 = *(const f32x4*)(CS + (size_t)rowq * 32 + hi * 8), c1 = *(const f32x4*)(CS + (size_t)rowq * 32 + hi * 8 + 4), s0 = *(const f32x4*)(CS + (size_t)rowq * 32 + 16 + hi * 8), s1 = *(const f32x4*)(CS + (size_t)rowq * 32 + 16 + hi * 8 + 4);
        float qn[32], qv4[8], qv5[8]; float ss = 0.f;
        f32x4 gq[8];
#pragma unroll
        for (int i = 0; i < 8; ++i) gq[i] = *(const LAS f32x4*)(gl + 32 * hi + 4 * i);
        const f32x4 g0 = *(const LAS f32x4*)(gl + 64 + hi * 8), g1 = *(const LAS f32x4*)(gl + 64 + hi * 8 + 4), g2 = *(const LAS f32x4*)(gl + 80 + hi * 8), g3 = *(const LAS f32x4*)(gl + 80 + hi * 8 + 4);
#pragma unroll
        for (int i = 0; i < 4; ++i)
#pragma unroll
            for (int j = 0; j < 4; ++j) { qn[8 * i + 2 * j] = lo2f(rawn[i][j]); qn[8 * i + 2 * j + 1] = hi2f(rawn[i][j]); }
#pragma unroll
        for (int j = 0; j < 4; ++j) { qv4[2 * j] = lo2f(rawr[0][j]); qv4[2 * j + 1] = hi2f(rawr[0][j]); qv5[2 * j] = lo2f(rawr[1][j]); qv5[2 * j + 1] = hi2f(rawr[1][j]); }
#pragma unroll
        for (int j = 0; j < 32; ++j) ss += qn[j] * qn[j];
#pragma unroll
        for (int j = 0; j < 8; ++j) ss += qv4[j] * qv4[j] + qv5[j] * qv5[j];
        ss += __shfl_xor(ss, 32);
        const float rs = rsqrtf(ss * (1.f / 96.f) + EPS);
#pragma unroll
        for (int i = 0; i < 8; ++i) { const f32x4 g = gq[i];
#pragma unroll
            for (int e = 0; e < 4; ++e) qn[4 * i + e] *= rs * g[e] * 1.1779544f; }
        {
#pragma unroll
          for (int j = 0; j < 4; ++j) { qv4[j] *= rs * g0[j]; qv4[4 + j] *= rs * g1[j]; qv5[j] *= rs * g2[j]; qv5[4 + j] *= rs * g3[j]; } }
#pragma unroll
        for (int j = 0; j < 8; ++j) { const float cs = j < 4 ? c0[j & 3] : c1[j & 3], sn = j < 4 ? s0[j & 3] : s1[j & 3]; const float x1 = qv4[j], x2 = qv5[j]; qv4[j] = x1 * cs - x2 * sn; qv5[j] = x1 * sn + x2 * cs; }
#pragma unroll
        for (int v = 0; v < 8; ++v) { const int w_ = __builtin_amdgcn_cvt_pk_fp8_f32(qn[4 * v], qn[4 * v + 1], 0, false); q8[v] = __builtin_amdgcn_cvt_pk_fp8_f32(qn[4 * v + 2], qn[4 * v + 3], w_, true); }
        u32x4 w4, w5;
#pragma unroll
        for (int j = 0; j < 4; ++j) { w4[j] = pk2(qv4[2 * j] * (8.f * C2), qv4[2 * j + 1] * (8.f * C2)); w5[j] = pk2(qv5[2 * j] * (8.f * C2), qv5[2 * j + 1] * (8.f * C2)); }
        qr4 = __builtin_bit_cast(bf16x8, w4); qr5 = __builtin_bit_cast(bf16x8, w5);
    }
    if (MK_PRIO == 1 ? wid >= 4 : MK_PRIO == 2 ? vwave : false) __builtin_amdgcn_s_setprio(1);
    f32x16 o[2]; o[0] = f32x16{}; o[1] = f32x16{}; f32x4 lsum = {0.f, 0.f, 0.f, 0.f};
    f32x16 pA0, pA1, pB0, pB1, negm; v8i pwo = (v8i){0, 0, 0, 0, 0, 0, 0, 0};
    A5_VMW((MK_PF ? KD - 2 : KD - 1) + (vwave ? VD : 0));
    A5_BAR();
    {
        const LAS unsigned char* kp = shm + A5_K + hi * 1024 + r32 * 16; v8i ka, kb8;
        A5_K8(ka, 0); A5_K8(kb8, 1);
        pA0 = A5_QKM(ka, q8, (f32x16{})); pA1 = A5_QKM(kb8, q8, (f32x16{}));
        pA0 = A2_MF(A5_KR(0, 0), qr4, pA0); pA1 = A2_MF(A5_KR(0, 1), qr4, pA1); pA0 = A2_MF(A5_KR(1, 0), qr5, pA0); pA1 = A2_MF(A5_KR(1, 1), qr5, pA1);
        float rm = fmaxf(pA0[0], pA1[0]);
#pragma unroll
        for (int r = 1; r < 16; ++r) rm = fmaxf(rm, fmaxf(pA0[r], pA1[r]));
        rm = fmaxf(rm, __shfl_xor(rm, 32));
        const float nb = 64.f - rm;
#pragma unroll
        for (int r = 0; r < 16; ++r) { pA0[r] += nb; pA1[r] += nb; negm[r] = nb; }
        asm volatile("" : "+v"(negm));
    }
#if MK_PF
    v8i ka;
    { const LAS unsigned char* kp = shm + A5_K + 8192 + hi * 1024 + r32 * 16; A5_K8(ka, 0); }
    int sk_pf = 16384;
#endif
#if MK_PVF
    v8i vfa = q8, vfb = q8; int sv_cur = 0;
#endif
    int sk_next = 8192, sv_prev = (VD + 1) * 4096; v8i kst = q8; bf16x8 rst = qr4; if (ABL == 7) { asm volatile("" : "+v"(kst), "+v"(rst)); }
#define A5_CVU(W, j, P, b) do { if (ABL == 4) { W[j] = pwo[j]; break; } unsigned w_ = __builtin_amdgcn_cvt_pk_u8_f32(P[b], 0, 0u); w_ = __builtin_amdgcn_cvt_pk_u8_f32(P[(b) + 1], 1, w_); w_ = __builtin_amdgcn_cvt_pk_u8_f32(P[(b) + 2], 2, w_); W[j] = (int)__builtin_amdgcn_cvt_pk_u8_f32(P[(b) + 3], 3, w_); } while (0)
#define A5_STEP(C0, C1, N0, N1, t, HASN, HASP, HASN2) do { \
        const LAS unsigned char* kp = shm + A5_K + sk_next + hi * 1024 + r32 * 16; const LAS unsigned char* vp = shm + A5_V + sv_prev + hi * 1024 + r32 * 16; \
        v8i ka = kst, kb8 = kst, vfa = kst, vfb = kst, pwn; bf16x8 r0 = rst, r1 = rst, r2 = rst, r3 = rst; \
        A2_SB(); \
        if (HASN) { if (ABL != 7) { A5_K8(ka, 0); A5_K8(kb8, 1); r0 = A5_KR(0, 0); r1 = A5_KR(0, 1); } A2_SB(); \
            N0 = A5_QKM(ka, q8, negm);  if (ABL != 7) { r2 = A5_KR(1, 0); r3 = A5_KR(1, 1); if (HASP) A4_VLD(vfa, 0); } A5_CVU(pwn, 0, C0, 0); A5_CVU(pwn, 1, C0, 4); A2_PIN(pwn); A2_SB(); \
            N1 = A5_QKM(kb8, q8, negm); if (HASP && ABL != 7) A4_VLD(vfb, 1); if (MK_LATEDMA) A5_ISSUEK(t); A5_CVU(pwn, 2, C0, 8); A5_CVU(pwn, 3, C0, 12); A2_PIN(pwn); A2_SB(); \
            if (ABL != 5) N0 = A2_MF(r0, qr4, N0); A5_CVU(pwn, 4, C1, 0); A2_PIN(pwn); A2_SB(); \
            if (ABL != 5) N1 = A2_MF(r1, qr4, N1); A5_CVU(pwn, 5, C1, 4); A2_PIN(pwn); A2_SB(); \
            if (HASP) { o[0] = A4_PVM(pwo, vfa, o[0]); } if (MK_LATEDMA) A5_ISSUEV(t); A5_CVU(pwn, 6, C1, 8); A5_CVU(pwn, 7, C1, 12); A2_PIN(pwn); A2_SB(); \
            if (ABL != 5) N0 = A2_MF(r2, qr5, N0); A2_SB(); \
            if (ABL != 5) N1 = A2_MF(r3, qr5, N1); A2_SB(); \
            if (HASP) { o[1] = A4_PVM(pwo, vfb, o[1]); } A2_SB(); \
            if (HASP && ABL != 2) { A5_SUM(pwo); } A2_SB(); \
        } else { \
            if (HASP) { A4_VLD(vfa, 0); A4_VLD(vfb, 1); } \
            A5_CVU(pwn, 0, C0, 0); A5_CVU(pwn, 1, C0, 4); A5_CVU(pwn, 2, C0, 8); A5_CVU(pwn, 3, C0, 12); A5_CVU(pwn, 4, C1, 0); A5_CVU(pwn, 5, C1, 4); A5_CVU(pwn, 6, C1, 8); A5_CVU(pwn, 7, C1, 12); \
            if (HASP) { o[0] = A4_PVM(pwo, vfa, o[0]); o[1] = A4_PVM(pwo, vfb, o[1]); A5_SUM(pwo); } A2_SB(); \
        } \
        if ((t) > mylast) { pwn = (v8i){0, 0, 0, 0, 0, 0, 0, 0}; } \
        pwo = pwn; \
        sk_next = (sk_next == (KD - 1) * 8192) ? 0 : sk_next + 8192; sv_prev = (sv_prev == (VD + 1) * 4096) ? 0 : sv_prev + 4096; \
    } while (0)
#if MK_PF
#undef A5_STEP
#define A5_STEP(C0, C1, N0, N1, t, HASN, HASP, HASN2) do { \
        const LAS unsigned char* kp = shm + A5_K + sk_next + hi * 1024 + r32 * 16; const LAS unsigned char* vp = shm + A5_V + sv_prev + hi * 1024 + r32 * 16;        \
        v8i kb8, vfa, vfb, pwn; bf16x8 r0, r1, r2, r3; \
        A2_SB(); \
        if (HASN) { A5_K8(kb8, 1); r0 = A5_KR(0, 0); r1 = A5_KR(0, 1); A2_SB(); \
            N0 = A5_QKM(ka, q8, negm);  r2 = A5_KR(1, 0); r3 = A5_KR(1, 1); if (HASP) A4_VLD(vfa, 0); A5_CVU(pwn, 0, C0, 0); A5_CVU(pwn, 1, C0, 4); A2_PIN(pwn); A2_SB(); \
            N1 = A5_QKM(kb8, q8, negm); if (HASP) A4_VLD(vfb, 1); if (HASN2) { const LAS unsigned char* kp = shm + A5_K + sk_pf + hi * 1024 + r32 * 16; A5_K8(ka, 0); } A5_CVU(pwn, 2, C0, 8); A5_CVU(pwn, 3, C0, 12); A2_PIN(pwn); A2_SB(); \
            N0 = A2_MF(r0, qr4, N0); A5_CVU(pwn, 4, C1, 0); A2_PIN(pwn); A2_SB(); \
            N1 = A2_MF(r1, qr4, N1); A5_CVU(pwn, 5, C1, 4); A2_PIN(pwn); A2_SB(); \
            if (HASP) { o[0] = A4_PVM(pwo, vfa, o[0]); } A5_CVU(pwn, 6, C1, 8); A5_CVU(pwn, 7, C1, 12); A2_PIN(pwn); A2_SB(); \
            N0 = A2_MF(r2, qr5, N0); A2_SB(); \
            N1 = A2_MF(r3, qr5, N1); A2_SB(); \
            if (HASP) { o[1] = A4_PVM(pwo, vfb, o[1]); } A2_SB(); \
            if (HASP) { A5_SUM(pwo); } A2_SB(); \
        } else { \
            if (HASP) { A4_VLD(vfa, 0); A4_VLD(vfb, 1); } \
            A5_CVU(pwn, 0, C0, 0); A5_CVU(pwn, 1, C0, 4); A5_CVU(pwn, 2, C0, 8); A5_CVU(pwn, 3, C0, 12); A5_CVU(pwn, 4, C1, 0); A5_CVU(pwn, 5, C1, 4); A5_CVU(pwn, 6, C1, 8); A5_CVU(pwn, 7, C1, 12); \
            if (HASP) { o[0] = A4_PVM(pwo, vfa, o[0]); o[1] = A4_PVM(pwo, vfb, o[1]); A5_SUM(pwo); } A2_SB(); \
        } \
        if ((t) > mylast) { pwn = (v8i){0, 0, 0, 0, 0, 0, 0, 0}; } \
        pwo = pwn; \
        sk_next = (sk_next == (KD - 1) * 8192) ? 0 : sk_next + 8192; sv_prev = (sv_prev == (VD + 1) * 4096) ? 0 : sv_prev + 4096; sk_pf = (sk_pf == (KD - 1) * 8192) ? 0 : sk_pf + 8192; \
    } while (0)
#endif
#if MK_PVF
#undef A5_STEP
#define A5_STEP(C0, C1, N0, N1, t, HASN, HASP, HASN2) do { \
        const LAS unsigned char* kp = shm + A5_K + sk_next + hi * 1024 + r32 * 16; const LAS unsigned char* vp = shm + A5_V + sv_cur + hi * 1024 + r32 * 16;        \
        v8i ka, kb8, pwn; bf16x8 r0, r1, r2, r3; \
        A2_SB(); \
        if (HASN) { A5_K8(ka, 0); A5_K8(kb8, 1); r0 = A5_KR(0, 0); r1 = A5_KR(0, 1); A2_SB(); \
            if (HASP) { o[0] = A4_PVM(pwo, vfa, o[0]); } r2 = A5_KR(1, 0); r3 = A5_KR(1, 1); A5_CVU(pwn, 0, C0, 0); A5_CVU(pwn, 1, C0, 4); A2_PIN(pwn); A2_SB(); \
            if (HASP) { o[1] = A4_PVM(pwo, vfb, o[1]); } A5_CVU(pwn, 2, C0, 8); A5_CVU(pwn, 3, C0, 12); A2_PIN(pwn); A2_SB(); \
            if (HASP) { A5_SUM(pwo); } A5_CVU(pwn, 4, C1, 0); A2_PIN(pwn); A2_SB(); \
            N0 = A5_QKM(ka, q8, negm);  A4_VLD(vfa, 0); A5_CVU(pwn, 5, C1, 4); A5_CVU(pwn, 6, C1, 8); A2_PIN(pwn); A2_SB(); \
            N1 = A5_QKM(kb8, q8, negm); A4_VLD(vfb, 1); A5_CVU(pwn, 7, C1, 12); A2_PIN(pwn); A2_SB(); \
            N0 = A2_MF(r0, qr4, N0); A2_SB(); \
            N1 = A2_MF(r1, qr4, N1); A2_SB(); \
            N0 = A2_MF(r2, qr5, N0); A2_SB(); \
            N1 = A2_MF(r3, qr5, N1); A2_SB(); \
        } else { \
            A5_CVU(pwn, 0, C0, 0); A5_CVU(pwn, 1, C0, 4); A5_CVU(pwn, 2, C0, 8); A5_CVU(pwn, 3, C0, 12); A5_CVU(pwn, 4, C1, 0); A5_CVU(pwn, 5, C1, 4); A5_CVU(pwn, 6, C1, 8); A5_CVU(pwn, 7, C1, 12); \
            if (HASP) { o[0] = A4_PVM(pwo, vfa, o[0]); o[1] = A4_PVM(pwo, vfb, o[1]); A5_SUM(pwo); } A2_SB(); \
            A4_VLD(vfa, 0); A4_VLD(vfb, 1); A2_SB(); \
        } \
        if ((t) > mylast) { pwn = (v8i){0, 0, 0, 0, 0, 0, 0, 0}; } \
        pwo = pwn; \
        sk_next = (sk_next == (KD - 1) * 8192) ? 0 : sk_next + 8192; sv_cur = (sv_cur == (VD + 1) * 4096) ? 0 : sv_cur + 4096; \
    } while (0)
#endif
#define A5_TOP(t) do { const int t_ = (t); int c_ = 0; \
        if (!MK_PF) { _Pragma("unroll") for (int b_ = 1; b_ <= KD - 2; ++b_) { c_ += (t_ - b_ + KD < NT) ? 1 : 0; if (vwave) c_ += (t_ - b_ + VD < NT) ? 1 : 0; } } \
        A5_VMW(c_); \
        if (ABL != 3) A5_BAR(); if (!MK_LATEDMA) { A5_ISSUEK(t_); A5_ISSUEV(t_); } } while (0)
#define A5_ISSUEK(t_) do { if ((t_) + KD < NT && ABL != 6) glds16s(kg3, loff, (unsigned)__builtin_amdgcn_readfirstlane(kdst + dk)); kg3 += 8192; dk = (dk == (KD - 1) * 8192u) ? 0u : dk + 8192u; } while (0)
#define A5_ISSUEV(t_) do { if ((t_) + VD < NT && vwave && ABL != 6) glds16s(vg2, loff, (unsigned)__builtin_amdgcn_readfirstlane(vdst + dv)); vg2 += 4096; dv = (dv == (VD + 1) * 4096u) ? 0u : dv + 4096u; } while (0)
    const unsigned char* kg3 = ksrc + KD * 8192; const unsigned char* vg2 = vsrc + VD * 4096; unsigned dk = 0u, dv = VD * 4096u;
    A5_TOP(0); A5_STEP(pA0, pA1, pB0, pB1, 0, true, false, true);
    A5_TOP(1); A5_STEP(pB0, pB1, pA0, pA1, 1, true, true, true);
    int t = 2;
    for (; t + 2 < NT; t += 2) {
        A5_TOP(t);     A5_STEP(pA0, pA1, pB0, pB1, t, true, true, true);
        A5_TOP(t + 1); A5_STEP(pB0, pB1, pA0, pA1, t + 1, true, true, true);
    }
    A5_TOP(t);     A5_STEP(pA0, pA1, pB0, pB1, t, true, true, false);
    A5_TOP(t + 1); A5_STEP(pB0, pB1, pA0, pA1, t + 1, false, true, false);
#if MK_PVF
    { o[0] = A4_PVM(pwo, vfa, o[0]); o[1] = A4_PVM(pwo, vfb, o[1]); A5_SUM(pwo); }
#else
    {
        const LAS unsigned char* vp = shm + A5_V + sv_prev + hi * 1024 + r32 * 16; v8i vfa, vfb;
        A4_VLD(vfa, 0); A4_VLD(vfb, 1); o[0] = A4_PVM(pwo, vfa, o[0]); o[1] = A4_PVM(pwo, vfb, o[1]); A5_SUM(pwo);
    }
#endif
#undef A5_STEP
#undef A5_TOP
#undef A5_ISSUEK
#undef A5_ISSUEV
#undef A5_CVU
    __builtin_amdgcn_s_setprio(0);
    A5_BAR();
    int lane_e = lane; asm volatile("" : "+v"(lane_e));
    const int r32e = lane_e & 31, hie = lane_e >> 5;
    if (ui < 3) { const int qbn = (((ui + 1) & 2) ? 32 : 0) + (((ui + 1) & 1) ? 31 - s_ : s_); A7_LOADQ(qbn, lane_e); }
    LAS float* sums = (LAS float*)(shm + A5_WS) + wid * 64;
    if ((lane_e & 7) == 0) *(LAS f32x4*)(sums + ((lane_e & 8) ? 16 : 0) + 4 * (lane_e >> 4)) = lsum;
    LDS_WAIT();
    f32x4 ls4[4];
#pragma unroll
    for (int g = 0; g < 4; ++g) ls4[g] = *(const LAS f32x4*)(sums + 8 * g + 4 * hie);
    LAS bf16_t* stg = (LAS bf16_t*)(shm + A5_OST) + wid * 2048;
#pragma unroll
    for (int r = 0; r < 16; ++r) { const int orow = crow(r, hie); const float il = frcp(ls4[r >> 2][r & 3]);
#pragma unroll
        for (int d0 = 0; d0 < 2; ++d0) stg[orow * 64 + d0 * 32 + r32e] = (bf16_t)f2bf(o[d0][r] * il); }
    LDS_WAIT();
    const bf16_t* GB = (const bf16_t*)a.out; const bf16_t* HL = (const bf16_t*)(ws + WS_GR); const bf16_t* AC = (const bf16_t*)(ws + WS_GA); bf16_t* MG = (bf16_t*)(ws + WS_XR);
#pragma unroll
    for (int i = 0; i < 4; ++i) { const int row = i * 8 + (lane_e >> 3), ch = lane_e & 7; const u32x4 yv = *(const LAS u32x4*)(stg + row * 64 + ch * 8);
        const size_t go = (size_t)(q0 + wid * 32 + row) * 1024 + h * 64 + ch * 8;
        const u32x4 gb = *(const u32x4*)(GB + go), hl = *(const u32x4*)(HL + go), ac = *(const u32x4*)(AC + go); u32x4 w;
#pragma unroll
        for (int j = 0; j < 4; ++j) { const float c0 = carry[ch * 8 + 2 * j], c1 = carry[ch * 8 + 2 * j + 1];
            w[j] = pk2(lo2f(yv[j]) * lo2f(gb[j]) + lo2f(hl[j]) + lo2f(ac[j]) * c0, hi2f(yv[j]) * hi2f(gb[j]) + hi2f(hl[j]) + hi2f(ac[j]) * c1); }
        *(u32x4*)(MG + go) = w; }
    A2_PIN(rawr[0]); A2_PIN(rawr[1]); A2_PIN(rawn[0]); A2_PIN(rawn[1]); A2_PIN(rawn[2]); A2_PIN(rawn[3]);
    }
#undef A5_SUM
#undef A7_LOADQ
    asm volatile("s_waitcnt vmcnt(0) lgkmcnt(0)\n\ts_barrier" ::: "memory");
#undef A5_DMAK
#undef A5_DMAV
#undef A5_BAR
#undef A5_VMW
}

#ifndef MK_V6
#define MK_V6 0
#endif
#ifndef MK_MIDBAR
#define MK_MIDBAR 0
#endif
constexpr int A6_K = 0, A6_V = 49152, A6_WS = 73728, A6_OST = 75776;
template <int ABL> __device__ __forceinline__ void attn_unit_v6(int h, int qb, CArgs a, const LAS float* carry, LAS unsigned char* shm) {
    int tid = threadIdx.x; asm volatile("" : "+v"(tid));
    const int lane = tid & 63, r32 = lane & 31, hi = lane >> 5; const int wid = __builtin_amdgcn_readfirstlane(tid >> 6);
    unsigned char* ws = a.ws;
    const bf16_t* QRAW = (const bf16_t*)(ws + WS_R1); const unsigned char* KI = ws + WS_KIMG + (size_t)h * 256 * 8192; const unsigned char* VI = (const unsigned char*)a.out + 32 * MiB + (size_t)h * 256 * 4096;
    const float* CS = (const float*)(ws + WS_CS); const float* qg = (const float*)a.in[15];
    const int q0 = qb * 256, rowq = q0 + wid * 32 + r32;
    const unsigned lds0 = (unsigned)(uintptr_t)shm;
    const int NT = 4 * qb + 4, mylast = 4 * qb + (wid >> 1);
    const unsigned char* ksrc = KI + wid * 1024 + lane * 16; const unsigned char* vsrc = VI + (wid >> 2) * 4096 + (wid & 3) * 1024 + lane * 16;
    const unsigned kdst = lds0 + A6_K + wid * 1024, vdst = lds0 + A6_V + (wid >> 2) * 4096 + (wid & 3) * 1024;
#define A5_DMAK(t, slot) glds16(ksrc + (size_t)(t) * 8192, (unsigned)__builtin_amdgcn_readfirstlane(kdst + (slot) * 8192))
#define A5_DMAV(t, slot) glds16(vsrc + (size_t)(t) * 4096, (unsigned)__builtin_amdgcn_readfirstlane(vdst + (slot) * 4096))
#define A5_BAR() asm volatile("s_waitcnt lgkmcnt(0)\n\ts_barrier" ::: "memory")
    v8i q8; bf16x8 qr4, qr5;
    {
        const bf16_t* qp = QRAW + (size_t)rowq * 1536 + h * 96;
        u32x4 rawn[4], rawr[2]; float qn[32], qv4[8], qv5[8]; float ss = 0.f;
#pragma unroll
        for (int i = 0; i < 4; ++i) rawn[i] = *(const u32x4*)(qp + 32 * hi + 8 * i);
        rawr[0] = *(const u32x4*)(qp + 64 + 8 * hi); rawr[1] = *(const u32x4*)(qp + 80 + 8 * hi);
        A5_DMAK(0, 0); A5_DMAK(1, 1); A5_DMAK(2, 2); A5_DMAK(3, 3); A5_DMAV(0, 0);
#pragma unroll
        for (int i = 0; i < 4; ++i)
#pragma unroll
            for (int j = 0; j < 4; ++j) { qn[8 * i + 2 * j] = lo2f(rawn[i][j]); qn[8 * i + 2 * j + 1] = hi2f(rawn[i][j]); }
#pragma unroll
        for (int j = 0; j < 4; ++j) { qv4[2 * j] = lo2f(rawr[0][j]); qv4[2 * j + 1] = hi2f(rawr[0][j]); qv5[2 * j] = lo2f(rawr[1][j]); qv5[2 * j + 1] = hi2f(rawr[1][j]); }
#pragma unroll
        for (int j = 0; j < 32; ++j) ss += qn[j] * qn[j];
#pragma unroll
        for (int j = 0; j < 8; ++j) ss += qv4[j] * qv4[j] + qv5[j] * qv5[j];
        ss += __shfl_xor(ss, 32);
        const float rs = rsqrtf(ss * (1.f / 96.f) + EPS);
#pragma unroll
        for (int i = 0; i < 8; ++i) { const f32x4 g = *(const f32x4*)(qg + 32 * hi + 4 * i);
#pragma unroll
            for (int e = 0; e < 4; ++e) qn[4 * i + e] *= rs * g[e] * 1.1779544f; }
        { const f32x4 g0 = *(const f32x4*)(qg + 64 + hi * 8), g1 = *(const f32x4*)(qg + 64 + hi * 8 + 4), g2 = *(const f32x4*)(qg + 80 + hi * 8), g3 = *(const f32x4*)(qg + 80 + hi * 8 + 4);
#pragma unroll
          for (int j = 0; j < 4; ++j) { qv4[j] *= rs * g0[j]; qv4[4 + j] *= rs * g1[j]; qv5[j] *= rs * g2[j]; qv5[4 + j] *= rs * g3[j]; } }
        const f32x4 c0 = *(const f32x4*)(CS + (size_t)rowq * 32 + hi * 8), c1 = *(const f32x4*)(CS + (size_t)rowq * 32 + hi * 8 + 4), s0 = *(const f32x4*)(CS + (size_t)rowq * 32 + 16 + hi * 8), s1 = *(const f32x4*)(CS + (size_t)rowq * 32 + 16 + hi * 8 + 4);
#pragma unroll
        for (int j = 0; j < 8; ++j) { const float cs = j < 4 ? c0[j & 3] : c1[j & 3], sn = j < 4 ? s0[j & 3] : s1[j & 3]; const float x1 = qv4[j], x2 = qv5[j]; qv4[j] = x1 * cs - x2 * sn; qv5[j] = x1 * sn + x2 * cs; }
#pragma unroll
        for (int v = 0; v < 8; ++v) { const int w_ = __builtin_amdgcn_cvt_pk_fp8_f32(qn[4 * v], qn[4 * v + 1], 0, false); q8[v] = __builtin_amdgcn_cvt_pk_fp8_f32(qn[4 * v + 2], qn[4 * v + 3], w_, true); }
        u32x4 w4, w5;
#pragma unroll
        for (int j = 0; j < 4; ++j) { w4[j] = pk2(qv4[2 * j] * (8.f * C2), qv4[2 * j + 1] * (8.f * C2)); w5[j] = pk2(qv5[2 * j] * (8.f * C2), qv5[2 * j + 1] * (8.f * C2)); }
        qr4 = __builtin_bit_cast(bf16x8, w4); qr5 = __builtin_bit_cast(bf16x8, w5);
    }
    if (wid >= 4) __builtin_amdgcn_s_setprio(1);
    f32x16 o[2]; o[0] = f32x16{}; o[1] = f32x16{}; f32x4 lsum = {0.f, 0.f, 0.f, 0.f};
    f32x16 pA0, pA1, pB0, pB1, negm; v8i pwo = (v8i){0, 0, 0, 0, 0, 0, 0, 0};
    int onev = ((((lane >> 4) & 1) != 0) == ((lane & 15) >= 8)) ? 0x38383838 : 0; asm volatile("" : "+v"(onev));
    const v8i ones8 = (v8i){onev, onev, onev, onev, onev, onev, onev, onev};
#define A5_SUM(pw_) lsum = __builtin_amdgcn_mfma_scale_f32_16x16x128_f8f6f4(pw_, ones8, lsum, 0, 0, 0, 0x7f7f7f7f, 0, 0x7f7f7f7f)
    asm volatile("s_waitcnt vmcnt(3)" ::: "memory");
    A5_BAR();
    if (NT > 5) { A5_DMAK(4, 4); A5_DMAK(5, 5); } A5_DMAV(2, 2);
    {
        const LAS unsigned char* kp = shm + A6_K + hi * 1024 + r32 * 16; v8i ka, kb8;
        A5_K8(ka, 0); A5_K8(kb8, 1);
        pA0 = A5_QKM(ka, q8, (f32x16{})); pA1 = A5_QKM(kb8, q8, (f32x16{}));
        pA0 = A2_MF(A5_KR(0, 0), qr4, pA0); pA1 = A2_MF(A5_KR(0, 1), qr4, pA1); pA0 = A2_MF(A5_KR(1, 0), qr5, pA0); pA1 = A2_MF(A5_KR(1, 1), qr5, pA1);
        float rm = fmaxf(pA0[0], pA1[0]);
#pragma unroll
        for (int r = 1; r < 16; ++r) rm = fmaxf(rm, fmaxf(pA0[r], pA1[r]));
        rm = fmaxf(rm, __shfl_xor(rm, 32));
        const float nb = 64.f - rm;
#pragma unroll
        for (int r = 0; r < 16; ++r) { pA0[r] += nb; pA1[r] += nb; negm[r] = nb; }
        asm volatile("" : "+v"(negm));
    }
    int sk_next = 8192, sv_prev = 20480;
#define A5_CVU(W, j, P, b) do { if (ABL == 4) { W[j] = pwo[j]; break; } unsigned w_ = __builtin_amdgcn_cvt_pk_u8_f32(P[b], 0, 0u); w_ = __builtin_amdgcn_cvt_pk_u8_f32(P[(b) + 1], 1, w_); w_ = __builtin_amdgcn_cvt_pk_u8_f32(P[(b) + 2], 2, w_); W[j] = (int)__builtin_amdgcn_cvt_pk_u8_f32(P[(b) + 3], 3, w_); } while (0)
#define A5_STEP(C0, C1, N0, N1, t, HASN, HASP) do { \
        const LAS unsigned char* kp = shm + A6_K + sk_next + hi * 1024 + r32 * 16; const LAS unsigned char* vp = shm + A6_V + sv_prev + hi * 1024 + r32 * 16; \
        v8i ka, kb8, vfa, vfb, pwn; bf16x8 r0, r1, r2, r3; \
        A2_SB(); \
        if (HASN) { A5_K8(ka, 0); A5_K8(kb8, 1); r0 = A5_KR(0, 0); r1 = A5_KR(0, 1); A2_SB(); \
            N0 = A5_QKM(ka, q8, negm);  r2 = A5_KR(1, 0); r3 = A5_KR(1, 1); if (HASP) A4_VLD(vfa, 0); A5_CVU(pwn, 0, C0, 0); A5_CVU(pwn, 1, C0, 4); A2_PIN(pwn); A2_SB(); \
            N1 = A5_QKM(kb8, q8, negm); if (HASP) A4_VLD(vfb, 1); A5_CVU(pwn, 2, C0, 8); A5_CVU(pwn, 3, C0, 12); A2_PIN(pwn); A2_SB(); \
            if (ABL != 5) N0 = A2_MF(r0, qr4, N0); A5_CVU(pwn, 4, C1, 0); A2_PIN(pwn); A2_SB(); \
            if (ABL != 5) N1 = A2_MF(r1, qr4, N1); A5_CVU(pwn, 5, C1, 4); A2_PIN(pwn); A2_SB(); \
            if (HASP) { o[0] = A4_PVM(pwo, vfa, o[0]); } A5_CVU(pwn, 6, C1, 8); A5_CVU(pwn, 7, C1, 12); A2_PIN(pwn); A2_SB(); \
            if (ABL != 5) N0 = A2_MF(r2, qr5, N0); A2_SB(); \
            if (ABL != 5) N1 = A2_MF(r3, qr5, N1); A2_SB(); \
            if (HASP) { o[1] = A4_PVM(pwo, vfb, o[1]); } A2_SB(); \
            if (HASP && ABL != 2) { A5_SUM(pwo); } A2_SB(); \
        } else { \
            if (HASP) { A4_VLD(vfa, 0); A4_VLD(vfb, 1); } \
            A5_CVU(pwn, 0, C0, 0); A5_CVU(pwn, 1, C0, 4); A5_CVU(pwn, 2, C0, 8); A5_CVU(pwn, 3, C0, 12); A5_CVU(pwn, 4, C1, 0); A5_CVU(pwn, 5, C1, 4); A5_CVU(pwn, 6, C1, 8); A5_CVU(pwn, 7, C1, 12); \
            if (HASP) { o[0] = A4_PVM(pwo, vfa, o[0]); o[1] = A4_PVM(pwo, vfb, o[1]); A5_SUM(pwo); } A2_SB(); \
        } \
        if ((t) > mylast) { pwn = (v8i){0, 0, 0, 0, 0, 0, 0, 0}; } \
        pwo = pwn; \
        sk_next = (sk_next == 40960) ? 0 : sk_next + 8192; sv_prev = (sv_prev == 20480) ? 0 : sv_prev + 4096; \
    } while (0)
#define A5_TOP(t) do { const int t_ = (t); \
        if (t_ + 4 < NT) asm volatile("s_waitcnt vmcnt(3)" ::: "memory"); else if (t_ + 2 < NT) asm volatile("s_waitcnt vmcnt(1)" ::: "memory"); else asm volatile("s_waitcnt vmcnt(0)" ::: "memory"); \
        if (ABL != 3) A5_BAR(); \
        if (t_ + 6 < NT) { glds16(kg5, (unsigned)__builtin_amdgcn_readfirstlane(kdst + dk)); glds16(kg5 + 8192, (unsigned)__builtin_amdgcn_readfirstlane(kdst + dk + 8192u)); } \
        if (t_ + 4 < NT) glds16(vg3, (unsigned)__builtin_amdgcn_readfirstlane(vdst + dv)); \
        kg5 += 16384; vg3 += 8192; dk = (dk == 32768u) ? 0u : dk + 16384u; dv = (dv == 16384u) ? 0u : dv + 8192u; } while (0)
    const unsigned char* kg5 = ksrc + 6 * 8192; const unsigned char* vg3 = vsrc + 4 * 4096; unsigned dk = 0u, dv = 16384u;
    A5_STEP(pA0, pA1, pB0, pB1, 0, true, false);
    int t = 1;
    for (; t + 2 < NT; t += 2) {
        A5_TOP(t);
        A5_STEP(pB0, pB1, pA0, pA1, t, true, true);
        if (MK_MIDBAR) A5_BAR();
        A5_STEP(pA0, pA1, pB0, pB1, t + 1, true, true);
    }
    A5_TOP(t); A5_STEP(pB0, pB1, pA0, pA1, t, false, true);
    {
        const LAS unsigned char* vp = shm + A6_V + sv_prev + hi * 1024 + r32 * 16; v8i vfa, vfb;
        A4_VLD(vfa, 0); A4_VLD(vfb, 1); o[0] = A4_PVM(pwo, vfa, o[0]); o[1] = A4_PVM(pwo, vfb, o[1]); A5_SUM(pwo);
    }
#undef A5_STEP
#undef A5_TOP
#undef A5_CVU
#undef A5_SUM
    __builtin_amdgcn_s_setprio(0);
    LAS float* sums = (LAS float*)(shm + A6_WS) + wid * 64;
    if ((lane & 7) == 0) *(LAS f32x4*)(sums + ((lane & 8) ? 16 : 0) + 4 * (lane >> 4)) = lsum;
    LDS_WAIT();
    f32x4 ls4[4];
#pragma unroll
    for (int g = 0; g < 4; ++g) ls4[g] = *(const LAS f32x4*)(sums + 8 * g + 4 * hi);
    LAS bf16_t* stg = (LAS bf16_t*)(shm + A6_OST) + wid * 2048;
#pragma unroll
    for (int r = 0; r < 16; ++r) { const int orow = crow(r, hi); const float il = frcp(ls4[r >> 2][r & 3]);
#pragma unroll
        for (int d0 = 0; d0 < 2; ++d0) stg[orow * 64 + d0 * 32 + r32] = (bf16_t)f2bf(o[d0][r] * il); }
    LDS_WAIT();
    const bf16_t* GB = (const bf16_t*)a.out; const bf16_t* HL = (const bf16_t*)(ws + WS_GR); const bf16_t* AC = (const bf16_t*)(ws + WS_GA); bf16_t* MG = (bf16_t*)(ws + WS_XR);
#pragma unroll
    for (int i = 0; i < 4; ++i) { const int row = i * 8 + (lane >> 3), ch = lane & 7; const u32x4 yv = *(const LAS u32x4*)(stg + row * 64 + ch * 8);
        const size_t go = (size_t)(q0 + wid * 32 + row) * 1024 + h * 64 + ch * 8;
        const u32x4 gb = *(const u32x4*)(GB + go), hl = *(const u32x4*)(HL + go), ac = *(const u32x4*)(AC + go); u32x4 w;
#pragma unroll
        for (int j = 0; j < 4; ++j) { const float c0 = carry[ch * 8 + 2 * j], c1 = carry[ch * 8 + 2 * j + 1];
            w[j] = pk2(lo2f(yv[j]) * lo2f(gb[j]) + lo2f(hl[j]) + lo2f(ac[j]) * c0, hi2f(yv[j]) * hi2f(gb[j]) + hi2f(hl[j]) + hi2f(ac[j]) * c1); }
        *(u32x4*)(MG + go) = w; }
    asm volatile("s_waitcnt vmcnt(0) lgkmcnt(0)\n\ts_barrier" ::: "memory");
#undef A5_DMAK
#undef A5_DMAV
#undef A5_BAR
}

template <int ABL> __device__ __forceinline__ void p3_attention(Frame& F, CArgs a) {
    if (ABL == 9) {
        f32x16 c0 = f32x16{}, c1 = f32x16{}, c2 = f32x16{}, c3 = f32x16{}; f32x4 c4 = {0.f, 0.f, 0.f, 0.f};
        v8i x = (v8i){(int)F.tid, 1, 2, 3, 4, 5, 6, 7}; bf16x8 y = __builtin_bit_cast(bf16x8, (u32x4){(unsigned)F.tid, 1u, 2u, 3u});
#pragma unroll 1
        for (int it = 0; it < 520; ++it) {
            c0 = __builtin_amdgcn_mfma_scale_f32_32x32x64_f8f6f4(x, x, c0, 0, 0, 0, 0x7f7f7f7f, 0, 0x7f7f7f7f); c1 = __builtin_amdgcn_mfma_scale_f32_32x32x64_f8f6f4(x, x, c1, 0, 0, 0, 0x7f7f7f7f, 0, 0x7f7f7f7f);
            c2 = __builtin_amdgcn_mfma_f32_32x32x16_bf16(y, y, c2, 0, 0, 0); c3 = __builtin_amdgcn_mfma_f32_32x32x16_bf16(y, y, c3, 0, 0, 0);
            c0 = __builtin_amdgcn_mfma_scale_f32_32x32x64_f8f6f4(x, x, c0, 0, 0, 0, 0x7f7f7f7f, 0, 0x7f7f7f7f);
            c2 = __builtin_amdgcn_mfma_f32_32x32x16_bf16(y, y, c2, 0, 0, 0); c3 = __builtin_amdgcn_mfma_f32_32x32x16_bf16(y, y, c3, 0, 0, 0);
            c1 = __builtin_amdgcn_mfma_scale_f32_32x32x64_f8f6f4(x, x, c1, 0, 0, 0, 0x7f7f7f7f, 0, 0x7f7f7f7f);
            c4 = __builtin_amdgcn_mfma_scale_f32_16x16x128_f8f6f4(x, x, c4, 0, 0, 0, 0x7f7f7f7f, 0, 0x7f7f7f7f);
        }
        asm volatile("" :: "v"(c0), "v"(c1), "v"(c2), "v"(c3), "v"(c4));
        return;
    }
    const int head = (F.vcu >> 4) & 15, s = F.vcu & 15; const int qbs[4] = {s, 31 - s, 32 + s, 63 - s};
    LAS float* carry = (LAS float*)(F.lds + LDS_XCH);
    if (F.wave == 0) {
        const float* HEND = (const float*)(a.ws + WS_MISC + MISC_HEND); const float* AEND = (const float*)(a.ws + WS_MISC + MISC_AEND); const int c = head * 64 + LANE_NOW(); float cr = 0.f;
        for (int k = 0; k < 64; ++k) {
#pragma unroll
            for (int i = 0; i < 4; ++i) if (k == qbs[i]) carry[i * 64 + LANE_NOW()] = cr;
            cr = AEND[(size_t)k * 1024 + c] * cr + HEND[(size_t)k * 1024 + c];
        }
    }
    LDS_WAIT(); __syncthreads();
    if (F.vcu < 256)
        if (MK_FP8V && MK_FP8K && MK_V7) attn_block_v7<ABL>(head, s, a, carry, F.lds); else
        for (int i = 0; i < 4; ++i) { if (MK_FP8V && MK_FP8K && MK_V6) attn_unit_v6<ABL>(head, qbs[i], a, carry + i * 64, F.lds); else if (MK_FP8V && MK_FP8K) attn_unit_v5<ABL>(head, qbs[i], a, carry + i * 64, F.lds); else if (MK_FP8V) attn_unit_v4(head, qbs[i], a, carry + i * 64, F.lds); else attn_unit_v2<ABL>(head, qbs[i], a, carry + i * 64, F.lds); }
}

template <bool DRY> __device__ __forceinline__ void p6_route(Frame& F, CArgs a) {
    unsigned char* ws = a.ws; const float* H = a.out; const float* WR = (const float*)(ws + WS_MISC + MISC_WR);
    float* RH = (float*)(ws + WS_CTL + CTL_SSQ_H); const float* PH = (const float*)(ws + WS_SSQP + SSQP_H);
    const float* bg = (const float*)a.in[20]; const float* be = (const float*)a.in[22];
    unsigned* cnt = (unsigned*)(ws + WS_CTL) + CW_CNT; int* lists = (int*)(ws + WS_LIST); float* cwl = (float*)(ws + WS_LIST + 2 * MiB); unsigned* tokinfo = (unsigned*)(ws + WS_MISC + MISC_TOK);
    const int lane = LANE_NOW(), r = lane & 15, kq = lane >> 4, w4 = F.wave & 3, kh = F.wave >> 2;
    LAS float* lg = (LAS float*)F.lds + F.wave * (16 * 48);
    for (int rb0 = F.vcu * 4; rb0 < M / 16; rb0 += F.G * 4) {
        const int rb_ = rb0 + w4, rb = rb_ < M / 16 ? rb_ : M / 16 - 1;
        const float* hp = H + (size_t)(rb * 16 + r) * 1024 + 4 * kq + 512 * kh;
        const int c0 = r, c1 = 16 + r, c2 = (32 + r < 36) ? 32 + r : 35;
        const float* w0 = WR + (size_t)c0 * 1024 + 4 * kq + 512 * kh; const float* w1 = WR + (size_t)c1 * 1024 + 4 * kq + 512 * kh; const float* w2 = WR + (size_t)c2 * 1024 + 4 * kq + 512 * kh;
        f32x4 acc0 = {0.f, 0.f, 0.f, 0.f}, acc1 = acc0, acc2 = acc0;
#pragma unroll 8
        for (int S = 0; S < 32; ++S) {
            const f32x4 av = *(const f32x4*)(hp + 16 * S), b0 = *(const f32x4*)(w0 + 16 * S), b1 = *(const f32x4*)(w1 + 16 * S), b2 = *(const f32x4*)(w2 + 16 * S);
#pragma unroll
            for (int s4 = 0; s4 < 4; ++s4) { acc0 = __builtin_amdgcn_mfma_f32_16x16x4f32(av[s4], b0[s4], acc0, 0, 0, 0); acc1 = __builtin_amdgcn_mfma_f32_16x16x4f32(av[s4], b1[s4], acc1, 0, 0, 0); acc2 = __builtin_amdgcn_mfma_f32_16x16x4f32(av[s4], b2[s4], acc2, 0, 0, 0); }
        }
#pragma unroll
        for (int i = 0; i < 4; ++i) { lg[(4 * kq + i) * 48 + r] = acc0[i]; lg[(4 * kq + i) * 48 + 16 + r] = acc1[i]; lg[(4 * kq + i) * 48 + 32 + r] = acc2[i]; }
        LDS_WAIT(); __syncthreads();
        if (kh == 0 && lane < 16 && rb_ < M / 16) {
            const int tok = rb * 16 + lane; const float* pp = PH + (size_t)tok * 16; const f32x4 a0 = *(const f32x4*)pp, a1 = *(const f32x4*)(pp + 4), a2 = *(const f32x4*)(pp + 8), a3 = *(const f32x4*)(pp + 12);
            const float sh = (((a0[0] + a0[1]) + (a0[2] + a0[3])) + ((a1[0] + a1[1]) + (a1[2] + a1[3]))) + (((a2[0] + a2[1]) + (a2[2] + a2[3])) + ((a3[0] + a3[1]) + (a3[2] + a3[3])));
            const float rs = rsqrtf(sh * (1.f / 1024.f) + EPS);
            const LAS float* lr = lg + lane * 48; const LAS float* lr2 = lr + 4 * (16 * 48);
            float gl[4];
#pragma unroll
            for (int q = 0; q < 4; ++q) gl[q] = (lr[q] + lr2[q]) * rs + bg[q];
            int g = 0; float mx = gl[0];
#pragma unroll
            for (int q = 1; q < 4; ++q) if (gl[q] > mx) { mx = gl[q]; g = q; }
            float den = 0.f;
#pragma unroll
            for (int q = 0; q < 4; ++q) den += expf(gl[q] - mx);
            const float pg = 1.f / den;
            float v1 = -INFINITY, v2 = -INFINITY; int i1 = 0, i2 = 0;
#pragma unroll
            for (int q = 0; q < 8; ++q) { const float v = (lr[4 + g * 8 + q] + lr2[4 + g * 8 + q]) * rs + be[g * 8 + q];
                if (v > v1) { v2 = v1; i2 = i1; v1 = v; i1 = q; } else if (v > v2) { v2 = v; i2 = q; } }
            const float e2 = expf(v2 - v1), s1 = 1.f / (1.f + e2), s2 = e2 * s1; const int e1 = g * 8 + i1, eb = g * 8 + i2;
            if (DRY) { asm volatile("" :: "v"(s1 + s2 + pg), "v"(e1 + eb)); }
            else {
                RH[tok] = rs;
                const unsigned sl1 = atomicAdd(cnt + e1, 1u), sl2 = atomicAdd(cnt + eb, 1u);
                lists[(size_t)e1 * M + sl1] = tok; cwl[(size_t)e1 * M + sl1] = pg * s1; lists[(size_t)eb * M + sl2] = tok; cwl[(size_t)eb * M + sl2] = pg * s2;
                tokinfo[tok * 2] = ((unsigned)e1 << 16) | sl1; tokinfo[tok * 2 + 1] = ((unsigned)eb << 16) | sl2;
            }
        }
        LDS_WAIT(); __syncthreads();
    }
}

__device__ __forceinline__ void moe_prefix(Frame& F, CArgs a, volatile LAS int* tpre, volatile LAS int* cnts) {
    const unsigned* cnt = (const unsigned*)(a.ws + WS_CTL) + CW_CNT;
    if (F.wave == 0) {
        int ln = threadIdx.x; asm volatile("" : "+v"(ln)); ln &= 63; const int e = ln & 31; const int c = (int)__hip_atomic_load(cnt + e, RLX_AGENT); const int nt_ = (c + 255) >> 8; int inc = nt_;
#pragma unroll
        for (int d = 1; d < 32; d <<= 1) { const int v = __shfl_up(inc, d); if (e >= d) inc += v; }
        const int exc = inc - nt_;
        if (ln < 32) { tpre[e] = exc; cnts[e] = c; for (int q = 0; q < nt_; ++q) tpre[80 + exc + q] = e; if (e == 31) tpre[32] = inc; }
    }
    LDS_WAIT(); __syncthreads();
}

template <bool DRY> __device__ __forceinline__ void p8_final(Frame& F, CArgs a, const volatile LAS int* tpre) {
    float* out = a.out; const unsigned char* Y = (const unsigned char*)(a.ws + WS_Y); const unsigned* tokinfo = (const unsigned*)(a.ws + WS_MISC + MISC_TOK);
    const int gw = F.vcu * NWAVES + F.wave, NGW = F.G * NWAVES, lane = LANE_NOW();
    for (int tok = gw; tok < M; tok += NGW) {
        const unsigned i0 = tokinfo[tok * 2], i1 = tokinfo[tok * 2 + 1];
        const size_t s0 = (size_t)tpre[i0 >> 16] * 256 + (i0 & 0xffffu), s1 = (size_t)tpre[i1 >> 16] * 256 + (i1 & 0xffffu);
        const size_t c = 16 * lane; const u32x4 y0 = *(const u32x4*)(Y + s0 * 1024 + c), y1 = *(const u32x4*)(Y + s1 * 1024 + c);
#pragma unroll
        for (int q = 0; q < 4; ++q) { f32x4 h = *(const f32x4*)(out + (size_t)tok * 1024 + c + 4 * q);
            const f32x2 a01 = __builtin_amdgcn_cvt_pk_f32_fp8((int)y0[q], false), a23 = __builtin_amdgcn_cvt_pk_f32_fp8((int)y0[q], true), b01 = __builtin_amdgcn_cvt_pk_f32_fp8((int)y1[q], false), b23 = __builtin_amdgcn_cvt_pk_f32_fp8((int)y1[q], true);
            h[0] += (a01[0] + b01[0]) * 0.125f; h[1] += (a01[1] + b01[1]) * 0.125f; h[2] += (a23[0] + b23[0]) * 0.125f; h[3] += (a23[1] + b23[1]) * 0.125f;
            if (DRY) asm volatile("" :: "v"(h)); else *(f32x4*)(out + (size_t)tok * 1024 + c + 4 * q) = h; }
    }
}
constexpr int NPHASE = 10;
#ifndef MK_ONE_LAUNCH
#define MK_ONE_LAUNCH 1
#endif
#ifndef MK_DRY
#define MK_DRY 0
#endif
__global__ void __launch_bounds__(NTHREADS, 2) mega(Args a) {
    extern __shared__ __attribute__((aligned(16))) unsigned char lds_raw[];
    Frame F;
    F.lds = (LAS unsigned char*)lds_raw; F.MISC = (volatile LAS unsigned*)(F.lds + MISC_OFF);
    F.tid = threadIdx.x; F.lane = F.tid & 63; F.wave = __builtin_amdgcn_readfirstlane(F.tid >> 6);
    F.G = gridDim.x; { const int bx = blockIdx.x; F.vcu = (F.G % 8 == 0) ? (bx % 8) * (F.G / 8) + bx / 8 : bx; }
    const __attribute__((address_space(4))) Args* ap0 = (const __attribute__((address_space(4))) Args*)__builtin_amdgcn_kernarg_segment_ptr();
#define KA() (*({ const __attribute__((address_space(4))) Args* p_ = ap0; asm volatile("" : "+s"(p_)); p_; }))
    unsigned char* ws = a.ws; F.ctl = (gu32*)(ws + WS_CTL);
    for (int u = F.tid; u < (LDS_BYTES - LDSCTL_OFF) / 4; u += NTHREADS) ((LAS unsigned*)(F.lds + LDSCTL_OFF))[u] = 0u;
    __syncthreads();
    const int lo = a.ph_lo, hi = a.ph_hi;
    XcdBarrier bar; bar.bar = (unsigned*)(F.ctl + CW_BAR); bar.x = 0; bar.st = nullptr;
    if (hi - lo > 1) bar = xcd_barrier_post((unsigned*)(F.ctl + CW_BAR), F.MISC + 8);
#ifndef PH_MASK
#define PH_MASK 0x3ff
#endif
#define IN(k) (((PH_MASK >> (k)) & 1) && lo <= (k) && (k) < hi)
#ifdef MK_STAMPS
#define STAMP(k) do { if (blockIdx.x == 0 && F.tid == 0) ((unsigned long long*)(ws + WS_CTL + 400000))[k] = __builtin_amdgcn_s_memrealtime(); } while (0)
#else
#define STAMP(k) do {} while (0)
#endif
#ifndef MK_DOUBLE_MASK
#define MK_DOUBLE_MASK 0
#endif
#define REP(k) for (int rep_ = 0; rep_ < (((MK_DOUBLE_MASK >> (k)) & 1) ? 2 : 1); ++rep_)
#ifndef MK_XBAR
#define MK_XBAR 0
#endif
#define SEAM(k) do { if (IN(k) && IN((k) + 1)) { xcd_barrier(bar); if (MK_XBAR && (k) == 4) { for (int xb_ = 0; xb_ < 8; ++xb_) xcd_barrier(bar); } } STAMP((k) + 1); } while (0)
    volatile LAS int* tpre = (volatile LAS int*)(F.lds + LDS_XCH + 8192); volatile LAS int* cnts = tpre + 40;
    const int bx = (int)blockIdx.x;
#ifndef MK_CXV
#define MK_CXV 1
#endif
    const int cx = MK_CXV ? F.vcu : bx;

    STAMP(0);
    if (IN(0)) REP(0) { p0_prologue(F, KA()); SEAM(0); }
    if (IN(1) && MK_DRY == 1) {
        DenseOrder S; S.init(M, 5120, F.G, bx, ws + WS_R1, ws + WS_WIN, 1024, 1024);
        EpiProj E{(bf16_t*)(ws + WS_XR), (bf16_t*)(ws + WS_GR), (bf16_t*)(ws + WS_QC), (bf16_t*)(ws + WS_KVC), (bf16_t*)(ws + WS_GA), (bf16_t*)KA().out, (bf16_t*)(ws + WS_MISC + MISC_HALO), (float*)(ws + WS_KPE), (float*)(ws + WS_SSQP), (float*)(ws + WS_SSQP + SSQP_KV)};
        gemm_phase<EpiProj, DenseOrder, true>(F.lds, 1024, 1024, S, E);
        xcd_barrier(bar);
    }
    if (IN(6) && MK_DRY == 60) { moe_weight_convert(F, KA(), 0, F.vcu, F.G); xcd_barrier(bar); }
    if (IN(1)) REP(1) {
        DenseOrder S; S.init(M, 5120, F.G, bx, ws + WS_R1, ws + WS_WIN, 1024, 1024);
        EpiProj E{(bf16_t*)(ws + WS_XR), (bf16_t*)(ws + WS_GR), (bf16_t*)(ws + WS_QC), (bf16_t*)(ws + WS_KVC), (bf16_t*)(ws + WS_GA), (bf16_t*)KA().out, (bf16_t*)(ws + WS_MISC + MISC_HALO), (float*)(ws + WS_KPE), (float*)(ws + WS_SSQP), (float*)(ws + WS_SSQP + SSQP_KV)};
        gemm_phase<EpiProj, DenseOrder, true>(F.lds, 1024, 1024, S, E);
        SEAM(1);
    }
    if (IN(2)) { if (MK_DRY == 2) { p2a_conv<true>(F, KA()); xcd_barrier(bar); } p2a_conv<false>(F, KA()); SEAM(2); }
    if (IN(3)) {
        typedef EpiLruT<false> EpiLru;
#define P3_LRU() do { EpiLru EL{(const bf16_t*)(ws + WS_XR), (const float*)KA().in[7], (const float*)KA().in[9], (const float*)KA().in[10], (bf16_t*)(ws + WS_GR), (bf16_t*)(ws + WS_GA), (float*)(ws + WS_MISC + MISC_HEND), (float*)(ws + WS_MISC + MISC_AEND)}; \
            for (int half = 0; half < 2; ++half) { OneOrder S{half * F.G, 8, (const char*)(ws + WS_XR), (const char*)(ws + WS_WLRU), (size_t)256 * 1024 * 2, (size_t)256 * 256 * 2, 512, cx, 512}; \
                gemm_phase<EpiLru, OneOrder, false>(F.lds, 256, 1024, S, EL); } } while (0)
#define P3_QKV() do { \
            { DenseOrder S; S.init(M, 1536, F.G, bx, ws + WS_QC, ws + WS_WUQ, 768, 768, 0, 0, 1); EpiQ E{(bf16_t*)(ws + WS_R1), (float*)(ws + WS_CTL + CTL_SSQ_Q)}; gemm_phase<EpiQ, DenseOrder, true, true, 0x7a7a7a7a>(F.lds, 768, 768, S, E); } \
            { DenseOrder S; S.init(M, 2048, F.G, bx, ws + WS_KVC, ws + WS_WUKV, 256, 256, 0, 0, 1); if (F.G == 256) { S.skew_h = 128; S.skew_a = 1; S.skew_b = 3; } \
              EpiKV E{ws + WS_KIMG, (unsigned char*)KA().out + 32 * MiB, (float*)(ws + WS_CTL + CTL_SSQ_KV), (const float*)(ws + WS_MISC + MISC_KSSQ), (const float*)(ws + WS_KPE), (const float*)KA().in[16]}; \
              gemm_phase<EpiKV, DenseOrder, true, true, 0x7b7b7b7b>(F.lds, 256, 256, S, E); } } while (0)
        if (MK_DRY == 3) { typedef EpiLruT<true> EpiLruD;
            EpiLruD EL{(const bf16_t*)(ws + WS_XR), (const float*)KA().in[7], (const float*)KA().in[9], (const float*)KA().in[10], (bf16_t*)(ws + WS_GR), (bf16_t*)(ws + WS_GA), (float*)(ws + WS_MISC + MISC_HEND), (float*)(ws + WS_MISC + MISC_AEND)};
#ifndef MK_DRY3
#define MK_DRY3 3
#endif
            if (bx & 1) { if (MK_DRY3 & 1) for (int half = 0; half < 2; ++half) { OneOrder S{half * F.G, 8, (const char*)(ws + WS_XR), (const char*)(ws + WS_WLRU), (size_t)256 * 1024 * 2, (size_t)256 * 256 * 2, 512, cx, 512}; gemm_phase<EpiLruD, OneOrder, false>(F.lds, 256, 1024, S, EL); } if (MK_DRY3 & 2) P3_QKV(); }
            else { if (MK_DRY3 & 2) P3_QKV(); if (MK_DRY3 & 1) for (int half = 0; half < 2; ++half) { OneOrder S{half * F.G, 8, (const char*)(ws + WS_XR), (const char*)(ws + WS_WLRU), (size_t)256 * 1024 * 2, (size_t)256 * 256 * 2, 512, cx, 512}; gemm_phase<EpiLruD, OneOrder, false>(F.lds, 256, 1024, S, EL); } }
            xcd_barrier(bar); }
        if (bx & 1) { P3_LRU(); P3_QKV(); } else { P3_QKV(); P3_LRU(); }
#undef P3_LRU
#undef P3_QKV
        SEAM(3);
    }
#ifndef MK_ABL
#define MK_ABL 0
#endif
    if (IN(4)) { if (MK_ABL) { p3_attention<MK_ABL>(F, KA()); xcd_barrier(bar); } p3_attention<0>(F, KA()); SEAM(4); }
    if (IN(5)) REP(5) {
        DenseOrder S; S.init(M, 1024, F.G, bx, ws + WS_XR, ws + WS_WOUT, 1024, 1024);
        EpiWout E{(const float*)KA().in[0], KA().out, (bf16_t*)(ws + WS_GR), (float*)(ws + WS_SSQP + SSQP_H)};
        gemm_phase<EpiWout, DenseOrder, true>(F.lds, 1024, 1024, S, E);
        SEAM(5);
    }
    if (IN(6)) { if (MK_DRY == 6) { p6_route<true>(F, KA()); xcd_barrier(bar); } if (MK_DRY == 61) { moe_weight_convert(F, KA(), 0, F.vcu, F.G); xcd_barrier(bar); } if (MK_DRY == 62) { moe_weight_convert(F, KA(), 1, F.vcu, F.G); xcd_barrier(bar); } p6_route<false>(F, KA()); moe_weight_convert(F, KA(), 0, F.vcu, F.G); SEAM(6); }
    if (IN(7) && MK_DRY == 7) {
        moe_prefix(F, KA(), tpre, cnts);
        MoeOrder S{tpre, cnts, 2, F.G, cx, (const char*)(ws + WS_GR), (const char*)(ws + WS_WGU), (size_t)512 * 1024, (size_t)256 * 1024, (const int*)(ws + WS_LIST), 1, 0};
        EpiMoeGU E{(bf16_t*)(ws + WS_GA), (float*)(ws + WS_CTL + CTL_SSQ_H), (const int*)(ws + WS_LIST)};
        gemm_phase<EpiMoeGU, MoeOrder, true, true, 0x7a7a7a7a>(F.lds, 1024, 1024, S, E);
        xcd_barrier(bar);
    }
    if (IN(8) && MK_DRY == 8) {
        moe_prefix(F, KA(), tpre, cnts);
        MoeOrder S{tpre, cnts, 4, F.G, cx, (const char*)(ws + WS_GA), (const char*)(ws + WS_WDN), (size_t)1024 * 256, (size_t)256 * 256, (const int*)(ws + WS_LIST), 0, (size_t)256 * 256};
        EpiMoeDown E{(bf16_t*)(ws + WS_Y), (const float*)(ws + WS_LIST + 2 * MiB)};
        gemm_phase<EpiMoeDown, MoeOrder, true, true, 0x7b7b7b7b>(F.lds, 256, 256, S, E);
        xcd_barrier(bar);
    }
    if (IN(7)) REP(7) {
        moe_prefix(F, KA(), tpre, cnts);
        MoeOrder S{tpre, cnts, 2, F.G, cx, (const char*)(ws + WS_GR), (const char*)(ws + WS_WGU), (size_t)512 * 1024, (size_t)256 * 1024, (const int*)(ws + WS_LIST), 1, 0};
        EpiMoeGU E{(bf16_t*)(ws + WS_GA), (float*)(ws + WS_CTL + CTL_SSQ_H), (const int*)(ws + WS_LIST)};
        gemm_phase<EpiMoeGU, MoeOrder, true, true, 0x7a7a7a7a>(F.lds, 1024, 1024, S, E);
        { const int nG = 2 * tpre[32], heavy = nG > F.G ? (nG - F.G < F.G ? nG - F.G : F.G - 1) : 0;
          if (cx >= heavy) moe_weight_convert(F, KA(), 1, cx - heavy, F.G - heavy); }
        SEAM(7);
    }
    if (IN(8)) REP(8) {
        if (!IN(7)) moe_prefix(F, KA(), tpre, cnts);
        MoeOrder S{tpre, cnts, 4, F.G, cx, (const char*)(ws + WS_GA), (const char*)(ws + WS_WDN), (size_t)1024 * 256, (size_t)256 * 256, (const int*)(ws + WS_LIST), 0, (size_t)256 * 256};
        EpiMoeDown E{(bf16_t*)(ws + WS_Y), (const float*)(ws + WS_LIST + 2 * MiB)};
        gemm_phase<EpiMoeDown, MoeOrder, true, true, 0x7b7b7b7b>(F.lds, 256, 256, S, E);
        SEAM(8);
    }
    if (IN(9)) { if (!IN(8)) moe_prefix(F, KA(), tpre, cnts); if (MK_DRY == 9) { p8_final<true>(F, KA(), tpre); xcd_barrier(bar); } p8_final<false>(F, KA(), tpre); VM_WAIT(); STAMP(10); }
#undef IN
#undef SEAM
}

[[maybe_unused]] static void launch(void* const* d_in, float* d_out, unsigned char* ws, hipStream_t stream, int one_launch) {
    static int grid = 0;
    if (grid == 0) {
        int dev = 0, cus = 0;
        if (hipGetDevice(&dev) != hipSuccess || hipDeviceGetAttribute(&cus, hipDeviceAttributeMultiprocessorCount, dev) != hipSuccess) { fprintf(stderr, "device query failed\n"); grid = -1; return; }
        if (hipFuncSetAttribute((const void*)mega, hipFuncAttributeMaxDynamicSharedMemorySize, LDS_BYTES) != hipSuccess) { fprintf(stderr, "hipFuncSetAttribute failed\n"); grid = -1; return; }
        (void)hipGetLastError();
        grid = cus;
        if (grid != 256) fprintf(stderr, "warning: %d CUs (kernel built for 256)\n", grid);
    }
    if (grid < 0) return;
    (void)hipMemsetAsync(ws + WS_CTL + CW_BAR * 4, 0, (size_t)(CW_CNT - CW_BAR) * 4 + 256, stream);
    Args a{};
    for (int i = 0; i < 26; ++i) a.in[i] = d_in[i];
    a.out = d_out; a.ws = ws;
    if (one_launch) { a.ph_lo = 0; a.ph_hi = NPHASE; hipLaunchKernelGGL(mega, dim3(grid), dim3(NTHREADS), LDS_BYTES, stream, a); }
    else for (int p = 0; p < NPHASE; ++p) { a.ph_lo = p; a.ph_hi = p + 1; hipLaunchKernelGGL(mega, dim3(grid), dim3(NTHREADS), LDS_BYTES, stream, a); }
}
}
extern "C" void kernel_launch(void* const* d_in, const int* in_sizes, int n_in, void* d_out, int out_size, void* d_ws, size_t ws_size, hipStream_t stream) {
    (void)in_sizes; (void)n_in; (void)out_size; (void)ws_size;
    mk::launch(d_in, (float*)d_out, (unsigned char*)d_ws, stream, MK_ONE_LAUNCH);
}
```

```cpp
#include <hip/hip_runtime.h>
#include <hip/hip_bf16.h>
#include <cstdint>
#include <cstdio>
#include <cmath>
namespace mk {
#define LAS __attribute__((address_space(3)))
#define GAS __attribute__((address_space(1)))
typedef unsigned short bf16_t;
typedef short bf16x8 __attribute__((ext_vector_type(8)));
typedef short s16x4 __attribute__((ext_vector_type(4)));
typedef float f32x2 __attribute__((ext_vector_type(2)));
typedef float f32x4 __attribute__((ext_vector_type(4)));
typedef float f32x16 __attribute__((ext_vector_type(16)));
typedef unsigned u32x2 __attribute__((ext_vector_type(2)));
typedef unsigned u32x4 __attribute__((ext_vector_type(4)));
typedef GAS unsigned gu32;

#ifndef MK_FP8V
#define MK_FP8V 1
#endif
#ifndef MK_FP8K
#define MK_FP8K 1
#endif
constexpr int M = 16384, D = 1024, NWAVES = 8, NTHREADS = 512;
constexpr float EPS = 1e-6f, LOG2E = 1.4426950408889634f;
constexpr size_t MiB = 1u << 20;
constexpr size_t WS_CTL = 0, CTL_BYTES = 1 * MiB;
constexpr size_t WS_WIN = 1 * MiB, WS_WUQ = 12 * MiB, WS_WUKV = 15 * MiB, WS_WLRU = 16 * MiB, WS_WOUT = 17 * MiB;
constexpr size_t WS_CS = 19 * MiB, WS_KPE = 21 * MiB, WS_MISC = 23 * MiB, WS_LIST = 25 * MiB;
constexpr size_t WS_R1 = 29 * MiB, WS_XR = 77 * MiB, WS_GR = 109 * MiB, WS_GA = 141 * MiB, WS_QC = 173 * MiB, WS_KVC = 197 * MiB, WS_KIMG = 205 * MiB, WS_DBG = 253 * MiB;
constexpr size_t MISC_HALO = 0, MISC_HEND = 512 * 1024, MISC_AEND = 768 * 1024, MISC_KSSQ = 1024 * 1024, MISC_WR = 1152 * 1024, MISC_TOK = 1408 * 1024;
constexpr size_t WS_SSQP = 253 * MiB, SSQP_KV = 786432, SSQP_H = 1048576;
constexpr size_t WS_Y = WS_QC;
constexpr size_t WS_WGU = WS_R1, WS_WDN = WS_R1 + 32 * MiB;
constexpr int CW_TMO = 0, CW_CODE = 1, CW_BAR = 4096, CW_CNT = 8192;
constexpr size_t CTL_SSQ_Q = 65536, CTL_SSQ_KV = 131072, CTL_SSQ_H = 196608;
constexpr int RING_BYTES = 131072, LDS_XCH = 135168  , LDSCTL_OFF = 147456, MISC_OFF = LDSCTL_OFF + 320, LDS_BYTES = 163840;

#define RLX_AGENT __ATOMIC_RELAXED, __HIP_MEMORY_SCOPE_AGENT
#define LDS_WAIT() asm volatile("s_waitcnt lgkmcnt(0)" ::: "memory")
#define VM_WAIT() asm volatile("s_waitcnt vmcnt(0)" ::: "memory")
__device__ __forceinline__ float bf2f(unsigned v) { return __uint_as_float(v << 16); }
__device__ __forceinline__ unsigned f2bf(float f) { unsigned u = __float_as_uint(f); return (u + 0x7fffu + ((u >> 16) & 1u)) >> 16; }
__device__ __forceinline__ unsigned pk2(float lo, float hi) { typedef __bf16 bf16x2_t __attribute__((ext_vector_type(2))); f32x2 v = {lo, hi}; bf16x2_t b = __builtin_convertvector(v, bf16x2_t); return __builtin_bit_cast(unsigned, b); }
__device__ __forceinline__ float lo2f(unsigned w) { return __uint_as_float(w << 16); }
__device__ __forceinline__ float hi2f(unsigned w) { return __uint_as_float(w & 0xffff0000u); }
__device__ __forceinline__ float fexp2(float x) { return __builtin_amdgcn_exp2f(x); }
__device__ __forceinline__ float frcp(float x) { return __builtin_amdgcn_rcpf(x); }
__device__ __forceinline__ float fsigm(float x) { return frcp(1.f + fexp2(-x * LOG2E)); }
__device__ __forceinline__ float fgelu(float x) { const float u = 0.7978845608028654f * (x + 0.044715f * x * x * x); return x * frcp(1.f + fexp2(-2.f * LOG2E * u)); }
__device__ __forceinline__ float wave_sum(float v) {
#pragma unroll
    for (int o = 1; o < 64; o <<= 1) v += __shfl_xor(v, o);
    return v;
}

#define XB_TMO      128
#define XB_XCNT(j)  (256  + 64 * (j))
#define XB_XSUB(j)  (1280 + 64 * (j))
#define XB_XGEN(j)  (2304 + 64 * (j))
#define XB_TOP      3328
#define XB_TOPGEN   3392
#define XCD_BAR_WORDS 3456
#define XB_SPIN_CAP (1u << 18)
__device__ __forceinline__ unsigned xb_ld(unsigned* p)              { return __hip_atomic_load(p, __ATOMIC_RELAXED, __HIP_MEMORY_SCOPE_AGENT); }
__device__ __forceinline__ unsigned xb_add(unsigned* p, unsigned v) { return __hip_atomic_fetch_add(p, v, __ATOMIC_RELAXED, __HIP_MEMORY_SCOPE_AGENT); }
__device__ __forceinline__ unsigned xb_xcc_id() { return (unsigned)__builtin_amdgcn_s_getreg((3 << 11) | 20) & 0xFu; }
#define XB_SPIN(cond, bar) do { unsigned _sp = 0; while (cond) { __builtin_amdgcn_s_sleep(1); \
    if ((++_sp & 255u) == 0u) { if (xb_ld(&(bar)[XB_TMO])) break; if (_sp > XB_SPIN_CAP) { atomicAdd(&(bar)[XB_TMO], 1u); break; } } } } while (0)
struct XcdBarrier { unsigned* bar; unsigned x; volatile LAS unsigned* st; };
__device__ __forceinline__ XcdBarrier xcd_barrier_post(unsigned* bar, volatile LAS unsigned* st) {
    XcdBarrier b; b.bar = bar; b.x = xb_xcc_id(); b.st = st;
    if (threadIdx.x == 0) (void)xb_add(&bar[XB_XCNT(b.x)], 1u);
    return b;
}
__device__ __forceinline__ void xcd_barrier_complete(unsigned* bar, unsigned x, unsigned& nloc, unsigned& nx) {
    const unsigned G = gridDim.x * gridDim.y * gridDim.z;
    unsigned sum, cnt, mine, sp = 0u;
    for (;;) {
        sum = 0u; cnt = 0u; mine = 0u;
#pragma unroll
        for (unsigned j = 0; j < 16; ++j) { const unsigned c = xb_ld(&bar[XB_XCNT(j)]); sum += c; cnt += (c > 0u) ? 1u : 0u; mine = (j == x) ? c : mine; }
        if (sum == G) break;
        __builtin_amdgcn_s_sleep(1);
        if ((++sp & 255u) == 0u) { if (xb_ld(&bar[XB_TMO])) break; if (sp > XB_SPIN_CAP) { atomicAdd(&bar[XB_TMO], 1u); break; } }
    }
    nloc = mine > 0u ? mine : 1u; nx = cnt > 0u ? cnt : 1u;
}
__device__ __forceinline__ void xcd_barrier(const XcdBarrier& b) {
    asm volatile("s_waitcnt vmcnt(0)" ::: "memory");
    __syncthreads();
    if (threadIdx.x == 0) {
        unsigned* bar = b.bar;
        __builtin_amdgcn_s_waitcnt(0);
        unsigned nloc = b.st[0], nx = b.st[1];
        if (nloc == 0u) { xcd_barrier_complete(bar, b.x, nloc, nx); b.st[0] = nloc; b.st[1] = nx; }
        const unsigned old = xb_add(&bar[XB_XSUB(b.x)], 1u);
        const unsigned gen = old / nloc;
        if (old + 1u == (gen + 1u) * nloc) {
            __builtin_amdgcn_fence(__ATOMIC_RELEASE, "agent");
            asm volatile("s_waitcnt vmcnt(0)" ::: "memory");
            const unsigned og = xb_add(&bar[XB_TOP], 1u);
            const unsigned tg = og / nx;
            if (og + 1u == (tg + 1u) * nx) xb_add(&bar[XB_TOPGEN], 1u);
            else XB_SPIN(xb_ld(&bar[XB_TOPGEN]) == tg, bar);
            __builtin_amdgcn_fence(__ATOMIC_ACQUIRE, "agent");
            xb_add(&bar[XB_XGEN(b.x)], 1u);
            asm volatile("s_waitcnt vmcnt(0)" ::: "memory");
        } else {
            XB_SPIN(xb_ld(&bar[XB_XGEN(b.x)]) == gen, bar);
            __builtin_amdgcn_fence(__ATOMIC_ACQUIRE, "agent");
            asm volatile("s_waitcnt vmcnt(0)" ::: "memory");
        }
    }
    __syncthreads();
}

constexpr int BM = 256, BK = 64, HALF = 128, HTB = HALF * BK * 2, STAGE_BYTES = 8 * HTB;
__device__ __forceinline__ int lds_byte(int r, int c) { const int st = (r >> 4) * 2 + (c >> 5), rr = r & 15, cc = c & 31, ob = rr * 64 + cc * 2; return st * 1024 + (ob ^ (((ob >> 9) & 1) << 5)); }
__device__ __forceinline__ void stage_rc(int b, int& R, int& C) { const int st = b / 1024, sb = b % 1024, swz = sb ^ (((sb >> 9) & 1) << 5); R = (st >> 1) * 16 + swz / 64; C = (st & 1) * 32 + (swz % 64) / 2; }
__device__ __forceinline__ int perm32(int rho) { const int n = rho >> 4, i = rho & 15; return 8 * (i >> 2) + 4 * n + (i & 3); }

struct Unit { int pm, pn; const char* A; const char* B; const int* gat; int valid; int x0, x1; };
typedef f32x4 Acc[2][2][4][2];

#define PG8_SA(b, h) (((b) * 2 + (h)) * HTB)
#define PG8_SB(b, h) ((4 + (b) * 2 + (h)) * HTB)
#define PG8_STAGE(bufoff, gbase, voff) do { _Pragma("unroll") for (int _i = 0; _i < 2; ++_i) \
        __builtin_amdgcn_global_load_lds((const unsigned*)((const char*)(gbase) + (voff)[_i]), (LAS unsigned*)(lds + (bufoff) + ldsw + _i * 8192), 16, 0, 0); } while (0)
#define PG8_LDA(dst, b, h) do { if constexpr (F8) { _Pragma("unroll") for (int m = 0; m < 4; ++m) { const u32x4 x0_ = *(const LAS u32x4*)(lds + PG8_SA(b, h) + a8o0 + m * 2048), x1_ = *(const LAS u32x4*)(lds + PG8_SA(b, h) + a8o1 + m * 2048); \
            dst##8[m] = __builtin_bit_cast(v8i_t, __builtin_shufflevector(x0_, x1_, 0, 1, 2, 3, 4, 5, 6, 7)); } } \
        else { _Pragma("unroll") for (int m = 0; m < 4; ++m) _Pragma("unroll") for (int k = 0; k < 2; ++k) dst[m][k] = *(const LAS bf16x8*)(lds + PG8_SA(b, h) + aoff + m * 2048 + k * 1024); } } while (0)
#define PG8_LDB(dst, b, h) do { if constexpr (F8) { _Pragma("unroll") for (int n = 0; n < 2; ++n) { const u32x4 x0_ = *(const LAS u32x4*)(lds + PG8_SB(b, h) + b8o0 + n * 2048), x1_ = *(const LAS u32x4*)(lds + PG8_SB(b, h) + b8o1 + n * 2048); \
            dst##8[n] = __builtin_bit_cast(v8i_t, __builtin_shufflevector(x0_, x1_, 0, 1, 2, 3, 4, 5, 6, 7)); } } \
        else { _Pragma("unroll") for (int n = 0; n < 2; ++n) _Pragma("unroll") for (int k = 0; k < 2; ++k) dst[n][k] = *(const LAS bf16x8*)(lds + PG8_SB(b, h) + boff + n * 2048 + k * 1024); } } while (0)
#define PG8_MMA(ai, bj, At, Bt) do { __builtin_amdgcn_s_setprio(1); if constexpr (F8) { _Pragma("unroll") for (int m = 0; m < 4; ++m) _Pragma("unroll") for (int n = 0; n < 2; ++n) \
            asm volatile("v_mfma_scale_f32_16x16x128_f8f6f4 %0, %1, %2, %0, %3, %4 op_sel_hi:[0,0,0]" : "+v"(acc[ai][bj][m][n]) : "v"(Bt##8[n]), "v"(At##8[m]), "v"(scw_), "v"(scx_)); } \
        else { _Pragma("unroll") for (int m = 0; m < 4; ++m) _Pragma("unroll") for (int n = 0; n < 2; ++n) _Pragma("unroll") for (int k = 0; k < 2; ++k) \
            acc[ai][bj][m][n] = __builtin_amdgcn_mfma_f32_16x16x32_bf16(Bt[n][k], At[m][k], acc[ai][bj][m][n], 0, 0, 0); } __builtin_amdgcn_s_setprio(0); } while (0)
#define PG8_WAIT_V(n) asm volatile("s_waitcnt vmcnt(" #n ")" ::: "memory")
#define PG8_WAIT_L(n) asm volatile("s_waitcnt lgkmcnt(" #n ")" ::: "memory")
#define PG8_BAR __builtin_amdgcn_s_barrier()
#define PG8_SCHED __builtin_amdgcn_sched_barrier(0)
#define PG8_VOFFA(u, vo) do { _Pragma("unroll") for (int _h = 0; _h < 2; ++_h) _Pragma("unroll") for (int _i = 0; _i < 2; ++_i) { const int _row = _h * HALF + Ra[_i]; \
        const int _ri = (u).gat ? (_row < (u).valid ? (u).gat[_row] : 0) : _row; vo[_h][_i] = F8 ? (unsigned)(_ri * lda + 2 * Ca[_i]) : (unsigned)(_ri * lda + Ca[_i]) * 2u; } } while (0)

typedef int v8i_t __attribute__((ext_vector_type(8)));
template <class Epi, class Sched, bool ALIGN_EPI, bool F8 = false, int SC_W = 0x7f7f7f7f>
__device__ __forceinline__ void gemm_phase(LAS unsigned char* lds, const int K, const int lda, const Sched& S, const Epi& E) {
    int tid_ = threadIdx.x; asm volatile("" : "+v"(tid_));
    const int tid = tid_, wid = __builtin_amdgcn_readfirstlane(tid >> 6), lane = tid & 63, wr = wid >> 2, wc = wid & 3, fr = lane & 15, fq = lane >> 4;
    const int nt = F8 ? K / 128 : K / BK;
    int Ra[2], Ca[2]; unsigned voffB[2];
#pragma unroll
    for (int i = 0; i < 2; ++i) { int R, C; stage_rc(tid * 16 + i * 8192, R, C); const int Rb = Epi::PERM ? ((R & ~31) + perm32(R & 31)) : R; Ra[i] = R; Ca[i] = C; voffB[i] = F8 ? (unsigned)(Rb * K + 2 * C) : (unsigned)(Rb * K + C) * 2u; }
    const size_t kstep = (size_t)(BK * 2);
    const size_t hstep = F8 ? (size_t)HALF * K : (size_t)HALF * K * 2;
    const unsigned ldsw = (unsigned)wid * 1024u;
    const int aoff = lds_byte(wr * 64 + fr, fq * 8), boff = lds_byte(wc * 32 + fr, fq * 8);
    const int a8o0 = lds_byte(wr * 64 + fr, 16 * fq), a8o1 = lds_byte(wr * 64 + fr, 16 * fq + 8), b8o0 = lds_byte(wc * 32 + fr, 16 * fq), b8o1 = lds_byte(wc * 32 + fr, 16 * fq + 8);
    Unit cur, nxt; int ui = 0;
    if (!S.next(0, cur)) return;
    Acc acc;
#pragma unroll
    for (int a = 0; a < 2; ++a)
#pragma unroll
        for (int b = 0; b < 2; ++b)
#pragma unroll
            for (int m = 0; m < 4; ++m)
#pragma unroll
                for (int n = 0; n < 2; ++n) acc[a][b][m][n] = (f32x4){0.f, 0.f, 0.f, 0.f};
    bf16x8 At[4][2], B0[2][2], B1[2][2]; v8i_t At8[4], B08[2], B18[2]; const int scw_ = SC_W, scx_ = 0x7f7f7f7f;
    unsigned vC[2][2], vN[2][2];
    PG8_VOFFA(cur, vC);
    const char* cA = cur.A; const char* cB = cur.B;
    PG8_STAGE(PG8_SB(0, 0), cB, voffB); PG8_STAGE(PG8_SB(0, 1), cB + hstep, voffB); PG8_STAGE(PG8_SA(0, 0), cA, vC[0]); PG8_STAGE(PG8_SA(0, 1), cA, vC[1]);
    if (wr == 1) PG8_BAR;
    PG8_WAIT_V(2); PG8_BAR;
    PG8_STAGE(PG8_SB(1, 0), cB + kstep, voffB); PG8_STAGE(PG8_SA(1, 0), cA + kstep, vC[0]); PG8_STAGE(PG8_SB(1, 1), cB + hstep + kstep, voffB);
    PG8_WAIT_V(6); PG8_BAR;
    for (;;) {
        const bool has_next = S.next(ui + 1, nxt);
        if (!has_next) nxt = cur;
        PG8_VOFFA(nxt, vN);
        const char* nA = nxt.A; const char* nB = nxt.B;
#pragma unroll 1
        for (int t = 0; t < nt; t += 2) {
            const bool last = (t == nt - 2);
            const char* a1 = cA + (size_t)(t + 1) * kstep;
            const char* a2 = last ? nA : cA + (size_t)(t + 2) * kstep; const char* b2 = last ? nB : cB + (size_t)(t + 2) * kstep;
            const char* a3 = a2 + kstep; const char* b3 = b2 + kstep;
            unsigned vS[2][2];
#pragma unroll
            for (int h = 0; h < 2; ++h)
#pragma unroll
                for (int i = 0; i < 2; ++i) vS[h][i] = last ? vN[h][i] : vC[h][i];
            PG8_LDB(B0, 0, 0); PG8_LDB(B1, 0, 1); PG8_SCHED; PG8_LDA(At, 0, 0); PG8_STAGE(PG8_SA(1, 1), a1, vC[1]);
            PG8_WAIT_V(8); PG8_WAIT_L(0); PG8_BAR; PG8_MMA(0, 0, At, B0); PG8_MMA(0, 1, At, B1); PG8_BAR; PG8_SCHED;
            PG8_LDA(At, 0, 1); PG8_STAGE(PG8_SB(0, 0), b2, voffB); PG8_STAGE(PG8_SB(0, 1), b2 + hstep, voffB); PG8_STAGE(PG8_SA(0, 0), a2, vS[0]);
            PG8_WAIT_V(8); PG8_WAIT_L(0); PG8_BAR; PG8_MMA(1, 0, At, B0); PG8_MMA(1, 1, At, B1); PG8_BAR; PG8_SCHED;
            PG8_LDB(B0, 1, 0); PG8_LDB(B1, 1, 1); PG8_SCHED; PG8_LDA(At, 1, 0); PG8_STAGE(PG8_SA(0, 1), a2, vS[1]);
            PG8_WAIT_V(8); PG8_WAIT_L(0); PG8_BAR; PG8_MMA(0, 0, At, B0); PG8_MMA(0, 1, At, B1); PG8_BAR; PG8_SCHED;
            PG8_LDA(At, 1, 1); PG8_STAGE(PG8_SB(1, 0), b3, voffB); PG8_STAGE(PG8_SB(1, 1), b3 + hstep, voffB); PG8_STAGE(PG8_SA(1, 0), a3, vS[0]);
            PG8_WAIT_V(8); PG8_WAIT_L(0); PG8_BAR; PG8_MMA(1, 0, At, B0); PG8_MMA(1, 1, At, B1); PG8_BAR; PG8_SCHED;
        }
        if constexpr (F8) asm volatile("s_nop 15\n\ts_nop 15" ::: "memory");
        if constexpr (ALIGN_EPI) { if (wr == 0) PG8_BAR; }
        if constexpr (!Epi::AFTER_DRAIN) { E(acc, cur, wr, wc, fr, fq); }
        if (!has_next) break;
#pragma unroll
        for (int a = 0; a < 2; ++a)
#pragma unroll
            for (int b = 0; b < 2; ++b)
#pragma unroll
                for (int m = 0; m < 4; ++m)
#pragma unroll
                    for (int n = 0; n < 2; ++n) acc[a][b][m][n] = (f32x4){0.f, 0.f, 0.f, 0.f};
        cur = nxt; cA = nA; cB = nB; ++ui;
#pragma unroll
        for (int h = 0; h < 2; ++h)
#pragma unroll
            for (int i = 0; i < 2; ++i) vC[h][i] = vN[h][i];
        if constexpr (ALIGN_EPI) { if (wr == 1) PG8_BAR; }
    }
    PG8_WAIT_V(0);
    if constexpr (!ALIGN_EPI) { if (wr == 0) PG8_BAR; }
    PG8_BAR;
    if constexpr (Epi::AFTER_DRAIN) { E.fused(acc, cur, wr, wc, fr, fq, lds, wid, lane); }
}
struct DenseOrder {
    int nM, nN, nwg, G, c; const char* A; const char* B; size_t a_tile, b_tile; int a_col_tile;
    int pn_per_ablk;
    int skew_h, skew_a, skew_b;
    __device__ void init(int Mr, int N, int G_, int c_, const void* A_, const void* B_, int lda, int K, int pnpa = 0, int acolbytes = 0, int esz = 2) {
        nM = Mr / BM; nN = N / BM; nwg = nM * nN; G = G_; c = c_; A = (const char*)A_; B = (const char*)B_; a_tile = (size_t)BM * lda * esz; b_tile = (size_t)BM * K * esz; pn_per_ablk = pnpa; a_col_tile = acolbytes; skew_h = 0; skew_a = 0; skew_b = 0; }
    __device__ bool next(int i, Unit& u) const {
        long L = (long)i * G + c;
        if (skew_h > 0) { if (c < skew_h) { if (i >= skew_a) return false; L = (long)c * skew_a + i; } else { if (i >= skew_b) return false; L = (long)skew_h * skew_a + (long)(c - skew_h) * skew_b + i; } }
        if (L >= nwg) return false;
        int wgid = (int)L; { const int q = nwg / 8, r = nwg % 8, xcd = wgid % 8, off = wgid / 8; wgid = (xcd < r ? xcd * (q + 1) : r * (q + 1) + (xcd - r) * q) + off; }
        const int WGM = 8, nig = WGM * nN, gid = wgid / nig, fm = gid * WGM, gsz = (nM - fm) < WGM ? (nM - fm) : WGM;
        u.pm = fm + ((wgid % nig) % gsz); u.pn = (wgid % nig) / gsz;
        u.A = A + (size_t)u.pm * a_tile + (pn_per_ablk ? (size_t)(u.pn / pn_per_ablk) * a_col_tile : 0); u.B = B + (size_t)u.pn * b_tile; u.gat = nullptr; u.valid = 256; u.x0 = 0; u.x1 = 0; return true;
    }
};
struct OneOrder {
    int first, nN; const char* A; const char* B; size_t a_tile, b_tile; int a_col_tile; int c; int total;
    __device__ bool next(int i, Unit& u) const {
        if (i > 0) return false; const int L = first + c; if (L >= total) return false;
        u.pm = L / nN; u.pn = L % nN; u.A = A + (size_t)u.pm * a_tile + (size_t)(u.pn >> 1) * a_col_tile; u.B = B + (size_t)u.pn * b_tile; u.gat = nullptr; u.valid = 256; u.x0 = 0; u.x1 = 0; return true; }
};
struct MoeOrder {
    const volatile LAS int* tpre; const volatile LAS int* cnt; int ncol; int G, c; const char* A; const char* B; size_t b_exp; size_t b_tile; const int* lists; int gather; size_t a_tile;
    __device__ bool next(int i, Unit& u) const {
        const int L = i * G + c; const int ntile = __builtin_amdgcn_readfirstlane(tpre[32]); if (L >= ntile * ncol) return false;
        const int T = L / ncol, pn = L % ncol; const int e = __builtin_amdgcn_readfirstlane(tpre[80 + T]);
        const int rt = __builtin_amdgcn_readfirstlane(T - tpre[e]); int valid = cnt[e] - rt * 256; valid = __builtin_amdgcn_readfirstlane(valid > 256 ? 256 : valid);
        u.pm = T; u.pn = pn; u.x0 = e; u.x1 = rt; u.valid = valid; u.B = B + (size_t)e * b_exp + (size_t)pn * b_tile;
        if (gather) { u.A = A; u.gat = lists + (size_t)e * M + rt * 256; } else { u.A = A + (size_t)T * a_tile; u.gat = nullptr; }
        return true; }
};

__device__ __forceinline__ u32x4 pack8(f32x4 a, f32x4 b) { u32x4 w; w.x = pk2(a[0], a[1]); w.y = pk2(a[2], a[3]); w.z = pk2(b[0], b[1]); w.w = pk2(b[2], b[3]); return w; }
__device__ __forceinline__ float dot4(f32x4 a) { return (a[0] * a[0] + a[1] * a[1]) + (a[2] * a[2] + a[3] * a[3]); }

struct EpiProj {
    static constexpr bool PERM = true, AFTER_DRAIN = false;
    bf16_t *XR, *GR, *QC, *KVC, *GA, *GB, *HALO; float *KPE, *ssq_q, *ssq_kv;
    __device__ __forceinline__ void operator()(const Acc& acc, const Unit& u, int wr, int wc, int fr, int fq) const {
        const int pn = u.pn, rowb = u.pm * BM + wr * 64 + fr;
        if (pn == 20) {
            if (wc == 0) {
#pragma unroll
                for (int ai = 0; ai < 2; ++ai)
#pragma unroll
                    for (int m = 0; m < 4; ++m) { float* p = KPE + (size_t)(rowb + ai * HALF + m * 16) * 32 + 8 * fq; *(f32x4*)p = acc[ai][0][m][0]; *(f32x4*)(p + 4) = acc[ai][0][m][1]; }
            }
            return;
        }
        bf16_t* dst; int ldc, colt, act = 0; float* ssq = nullptr; int nslot = 0, slot = 0;
        if (pn < 4) { dst = XR; ldc = 1024; colt = pn * 256; }
        else if (pn < 8) { dst = GR; ldc = 1024; colt = (pn - 4) * 256; act = 1; }
        else if (pn < 11) { dst = QC; ldc = 768; colt = (pn - 8) * 256; ssq = ssq_q; nslot = 12; slot = (pn - 8) * 4 + wc; act = 3; }
        else if (pn == 11) { dst = KVC; ldc = 256; colt = 0; ssq = ssq_kv; nslot = 4; slot = wc; act = 3; }
        else if (pn < 16) { dst = GA; ldc = 1024; colt = (pn - 12) * 256; act = 2; }
        else { dst = GB; ldc = 1024; colt = (pn - 16) * 256; act = 2; }
        const int col0 = colt + wc * 32 + 8 * fq;
#pragma unroll
        for (int ai = 0; ai < 2; ++ai)
#pragma unroll
            for (int m = 0; m < 4; ++m) {
                const int row = rowb + ai * HALF + m * 16; float ss = 0.f;
#pragma unroll
                for (int bj = 0; bj < 2; ++bj) {
                    f32x4 v0 = acc[ai][bj][m][0], v1 = acc[ai][bj][m][1];
                    if (ssq) ss += dot4(v0) + dot4(v1);
                    if (act == 1) {
#pragma unroll
                        for (int e = 0; e < 4; ++e) { v0[e] = fgelu(v0[e]); v1[e] = fgelu(v1[e]); }
                    } else if (act == 2) {
#pragma unroll
                        for (int e = 0; e < 4; ++e) { v0[e] = fsigm(v0[e]); v1[e] = fsigm(v1[e]); }
                    }
                    if (act == 3) { u32x2 w8; int w_ = __builtin_amdgcn_cvt_pk_fp8_f32(v0[0], v0[1], 0, false); w8.x = (unsigned)__builtin_amdgcn_cvt_pk_fp8_f32(v0[2], v0[3], w_, true);
                        w_ = __builtin_amdgcn_cvt_pk_fp8_f32(v1[0], v1[1], 0, false); w8.y = (unsigned)__builtin_amdgcn_cvt_pk_fp8_f32(v1[2], v1[3], w_, true);
                        *(u32x2*)((unsigned char*)dst + (size_t)row * ldc + col0 + bj * HALF) = w8; }
                    else *(u32x4*)(dst + (size_t)row * ldc + col0 + bj * HALF) = pack8(v0, v1);
                }
                if (ssq) { ss += __shfl_xor(ss, 16); ss += __shfl_xor(ss, 32); if (fq == 0) ssq[(size_t)row * nslot + slot] = ss; }
            }
        if (pn < 4 && wr == 1 && fr >= 13) {
#pragma unroll
            for (int bj = 0; bj < 2; ++bj) *(u32x4*)(HALO + ((size_t)u.pm * 3 + (fr - 13)) * 1024 + col0 + bj * HALF) = pack8(acc[1][bj][3][0], acc[1][bj][3][1]);
        }
    }
};

struct EpiQ {
    static constexpr bool PERM = true, AFTER_DRAIN = false;
    bf16_t* Q; const float* ssq_q;
    __device__ __forceinline__ void operator()(const Acc& acc, const Unit& u, int wr, int wc, int fr, int fq) const {
        const int rowb = u.pm * BM + wr * 64 + fr, col0 = u.pn * BM + wc * 32 + 8 * fq;
#pragma unroll
        for (int ai = 0; ai < 2; ++ai)
#pragma unroll
            for (int m = 0; m < 4; ++m) {
                const int row = rowb + ai * HALF + m * 16; const float rs = ssq_q[row];
#pragma unroll
                for (int bj = 0; bj < 2; ++bj) *(u32x4*)(Q + (size_t)row * 1536 + col0 + bj * HALF) = pack8(acc[ai][bj][m][0] * rs, acc[ai][bj][m][1] * rs);
            }
    }
};

extern __shared__ __attribute__((aligned(16))) unsigned char kv_lds_raw[];
__device__ __forceinline__ LAS unsigned char* kv_stage_lds() { return (LAS unsigned char*)kv_lds_raw + RING_BYTES; }
struct EpiNull {
    static constexpr bool PERM = true, AFTER_DRAIN = false;
    __device__ __forceinline__ void operator()(const Acc& acc, const Unit& u, int wr, int wc, int fr, int fq) const {
#pragma unroll
        for (int a = 0; a < 2; ++a)
#pragma unroll
            for (int b = 0; b < 2; ++b)
#pragma unroll
                for (int m = 0; m < 4; ++m)
#pragma unroll
                    for (int n = 0; n < 2; ++n) asm volatile("" :: "v"(acc[a][b][m][n]));
    }
};
#ifndef MK_KVCLOB
#define MK_KVCLOB 1
#endif
struct EpiKV {
    static constexpr bool PERM = true, AFTER_DRAIN = false;
    unsigned char* KIMG; unsigned char* VIMG; const float* ssq_kv; const float* kssq; const float* KPER; const float* kg;
    __device__ __forceinline__ void operator()(const Acc& acc, const Unit& u, int wr, int wc, int fr, int fq) const {
        asm volatile("" : "+v"(fr), "+v"(fq));
        const int rowb = u.pm * BM + wr * 64 + fr, h = 2 * u.pn + (wc & 1);
        if (wc < 2) {
            f32x4 g[2][2];
#pragma unroll
            for (int bj = 0; bj < 2; ++bj)
#pragma unroll
                for (int n = 0; n < 2; ++n) g[bj][n] = *(const f32x4*)(kg + 32 * bj + 8 * fq + 4 * n);
#pragma unroll
            for (int am = 0; am < 8; ++am) { const int ai = am >> 2;
                f32x4 kr[4][2];
#pragma unroll
                for (int m = (am & 3); m < (am & 3) + 1; ++m) { const float* kp_ = KPER + (size_t)(rowb + ai * HALF + m * 16) * 32 + 8 * fq; kr[m][0] = *(const f32x4*)kp_; kr[m][1] = *(const f32x4*)(kp_ + 4); }
#pragma unroll
                for (int m = (am & 3); m < (am & 3) + 1; ++m) {
                    const int row = rowb + ai * HALF + m * 16; const float rs = ssq_kv[row], ksq = kssq[row];
                    f32x4 v[2][2]; float ss = 0.f;
#pragma unroll
                    for (int bj = 0; bj < 2; ++bj)
#pragma unroll
                        for (int n = 0; n < 2; ++n) { v[bj][n] = acc[ai][bj][m][n] * rs; ss += dot4(v[bj][n]); }
                    ss += __shfl_xor(ss, 16); ss += __shfl_xor(ss, 32);
                    const float rk = rsqrtf((ss + ksq) * (1.f / 96.f) + EPS);
#if MK_FP8K
                    unsigned char* img = KIMG + ((size_t)h * 256 + (row >> 6)) * 8192;
#pragma unroll
                    for (int bj = 0; bj < 2; ++bj) { const f32x4 x0 = v[bj][0] * g[bj][0] * rk, x1 = v[bj][1] * g[bj][1] * rk; u32x2 w;
                        int w0 = __builtin_amdgcn_cvt_pk_fp8_f32(x0[0], x0[1], 0, false); w0 = __builtin_amdgcn_cvt_pk_fp8_f32(x0[2], x0[3], w0, true);
                        int w1 = __builtin_amdgcn_cvt_pk_fp8_f32(x1[0], x1[1], 0, false); w1 = __builtin_amdgcn_cvt_pk_fp8_f32(x1[2], x1[3], w1, true);
                        w.x = (unsigned)w0; w.y = (unsigned)w1;
                        *(u32x2*)(img + ((row & 63) >> 5) * 2048 + bj * 1024 + (fq >> 1) * 512 + (row & 31) * 16 + 8 * (fq & 1)) = w; }
                    *(u32x4*)(img + 4096 + fq * 1024 + (row & 63) * 16) = pack8(kr[m][0] * rk, kr[m][1] * rk);
#else
                    unsigned char* img = KIMG + ((size_t)h * 256 + (row >> 6)) * 12288 + (row & 63) * 16;
#pragma unroll
                    for (int bj = 0; bj < 2; ++bj) *(u32x4*)(img + (4 * bj + fq) * 1024) = pack8(v[bj][0] * g[bj][0] * rk, v[bj][1] * g[bj][1] * rk);
                    *(u32x4*)(img + (8 + fq) * 1024) = pack8(kr[m][0] * rk, kr[m][1] * rk);
#endif
                }
                if (MK_KVCLOB && (am & 3) == 3) asm volatile("" ::: "memory");
            }
        } else {
#if MK_FP8V
            LAS unsigned char* stg = (LAS unsigned char*)kv_stage_lds() + (wr * 2 + (wc - 2)) * 4096;
#pragma unroll
            for (int ai = 0; ai < 2; ++ai) {
#pragma unroll
                for (int m = 0; m < 4; ++m) {
                    const int row = rowb + ai * HALF + m * 16; const float rs = ssq_kv[row]; const int key = row & 63, kk = key & 31;
                    LAS unsigned char* img = stg + ((kk >> 2) & 1) * 1024 + (key >> 5) * 512 + ((kk & 3) + 4 * (kk >> 3)) + fq * 128;
#pragma unroll
                    for (int bj = 0; bj < 2; ++bj) { const f32x4 v0 = acc[ai][bj][m][0] * rs, v1 = acc[ai][bj][m][1] * rs;
                        unsigned w0 = (unsigned)__builtin_amdgcn_cvt_pk_fp8_f32(v0[0], v0[1], 0, false); w0 = (unsigned)__builtin_amdgcn_cvt_pk_fp8_f32(v0[2], v0[3], (int)w0, true);
                        unsigned w1 = (unsigned)__builtin_amdgcn_cvt_pk_fp8_f32(v1[0], v1[1], 0, false); w1 = (unsigned)__builtin_amdgcn_cvt_pk_fp8_f32(v1[2], v1[3], (int)w1, true);
                        LAS unsigned char* p = img + bj * 2048;
                        p[0] = (unsigned char)w0; p[16] = (unsigned char)(w0 >> 8); p[32] = (unsigned char)(w0 >> 16); p[48] = (unsigned char)(w0 >> 24);
                        p[64] = (unsigned char)w1; p[80] = (unsigned char)(w1 >> 8); p[96] = (unsigned char)(w1 >> 16); p[112] = (unsigned char)(w1 >> 24); }
                }
                LDS_WAIT();
                unsigned char* tile = VIMG + ((size_t)h * 256 + ((u.pm * BM + wr * 64 + ai * HALF) >> 6)) * 4096; const int ln = fr + 16 * fq;
#pragma unroll
                for (int i = 0; i < 4; ++i) *(u32x4*)(tile + i * 1024 + ln * 16) = *(const LAS u32x4*)(stg + i * 1024 + ln * 16);
            }
#else
#pragma unroll
            for (int ai = 0; ai < 2; ++ai)
#pragma unroll
                for (int m = 0; m < 4; ++m) {
                    const int row = rowb + ai * HALF + m * 16; const float rs = ssq_kv[row]; const int key = row & 63;
                    unsigned char* img = VIMG + ((size_t)h * 256 + (row >> 6)) * 8192 + (key >> 4) * 1024 + (key & 15) * 64 + fq * 16;
#pragma unroll
                    for (int bj = 0; bj < 2; ++bj) *(u32x4*)(img + bj * 4096) = pack8(acc[ai][bj][m][0] * rs, acc[ai][bj][m][1] * rs);
                }
#endif
        }
    }
};

template <bool DRY> struct EpiLruT {
    static constexpr bool PERM = false, AFTER_DRAIN = true;
    const bf16_t* XA; const float *ba, *bx, *lam; bf16_t* GRio; bf16_t* GAio; float* HEND; float* AEND;
    __device__ __forceinline__ void fused(Acc& acc, const Unit& u, int wr, int wc, int fr, int fq, LAS unsigned char* lds, int wid, int lane) const {
        int tid = threadIdx.x; asm volatile("" : "+v"(tid));
        const int chb = 256 * (u.pn >> 1) + 128 * (u.pn & 1);
        LAS unsigned* S = (LAS unsigned*)lds;
        {
            f32x4 vba[2], vbx[2], vsp[2];
#pragma unroll
            for (int n = 0; n < 2; ++n) { const int c = chb + 32 * wc + 16 * n + 4 * fq; vba[n] = *(const f32x4*)(ba + c); vbx[n] = *(const f32x4*)(bx + c); const f32x4 l4 = *(const f32x4*)(lam + c);
#pragma unroll
                for (int e = 0; e < 4; ++e) vsp[n][e] = -8.f * LOG2E * log1pf(expf(-l4[e])); }
#pragma unroll
            for (int am = 0; am < 4; ++am) { const int ai = am >> 1;
                u32x2 xw[4][2];
#pragma unroll
                for (int m = 2 * (am & 1); m < 2 * (am & 1) + 2; ++m)
#pragma unroll
                    for (int n = 0; n < 2; ++n) xw[m][n] = *(const u32x2*)((const char*)XA + (unsigned)((((unsigned)(u.pm * BM + ai * HALF + wr * 64 + m * 16 + fr)) * 1024u + (unsigned)(chb + 32 * wc + 16 * n + 4 * fq)) * 2u));
#pragma unroll
                for (int m = 2 * (am & 1); m < 2 * (am & 1) + 2; ++m) {
                    const int r = ai * HALF + wr * 64 + m * 16 + fr;
#pragma unroll
                    for (int n = 0; n < 2; ++n) {
                        const int x0 = 32 * wc + 16 * n + 4 * fq;
                        const float xa[4] = {lo2f(xw[m][n].x), hi2f(xw[m][n].x), lo2f(xw[m][n].y), hi2f(xw[m][n].y)}; u32x4 o;
#pragma unroll
                        for (int e = 0; e < 4; ++e) {
                            const float rr = fsigm(acc[ai][0][m][n][e] + vba[n][e]), ii = fsigm(acc[ai][1][m][n][e] + vbx[n][e]);
                            const float la2 = rr * vsp[n][e]; const float a2 = fexp2(2.f * la2); const float mult = sqrtf(fmaxf(1.f - a2, 0.f));
                            o[e] = pk2(mult * ii * xa[e], la2);
                        }
                        *(LAS u32x4*)(S + r * 132 + x0) = o;
                    }
                }
                asm volatile("" ::: "memory");
            }
        }
        const int cp = tid & 63, sg = tid >> 6, c0 = 2 * cp; LAS f32x4* X = (LAS f32x4*)(lds + LDS_XCH);
        const unsigned gb32 = ((unsigned)(u.pm * BM) * 1024u + (unsigned)(chb + c0)) * 2u;
        asm volatile("" ::: "memory");
        unsigned gr[32], ga[32];
#pragma unroll
        for (int j = 0; j < 32; ++j) { const unsigned ob = gb32 + (unsigned)(sg * 32 + j) * 2048u; gr[j] = *(const unsigned*)((const char*)GRio + ob); ga[j] = *(const unsigned*)((const char*)GAio + ob); }
        LDS_WAIT(); __builtin_amdgcn_s_barrier(); asm volatile("" ::: "memory");
        float h0 = 0.f, h1 = 0.f, s0 = 0.f, s1 = 0.f;
#pragma unroll 8
        for (int j = 0; j < 32; ++j) { const int r = sg * 32 + j; const u32x2 w = *(const LAS u32x2*)(S + r * 132 + c0);
            const float l0 = hi2f(w.x), l1 = hi2f(w.y); h0 = fexp2(l0) * h0 + lo2f(w.x); h1 = fexp2(l1) * h1 + lo2f(w.y); s0 += l0; s1 += l1; }
        X[sg * 64 + cp] = (f32x4){h0, s0, h1, s1};
        LDS_WAIT(); __builtin_amdgcn_s_barrier(); asm volatile("" ::: "memory");
        h0 = 0.f; h1 = 0.f; s0 = 0.f; s1 = 0.f;
        for (int q = 0; q < sg; ++q) { const f32x4 x = X[q * 64 + cp]; h0 = fexp2(x[1]) * h0 + x[0]; s0 += x[1]; h1 = fexp2(x[3]) * h1 + x[2]; s1 += x[3]; }
#pragma unroll
        for (int j = 0; j < 32; ++j) { const int r = sg * 32 + j; const u32x2 w = *(const LAS u32x2*)(S + r * 132 + c0);
            const float l0 = hi2f(w.x), l1 = hi2f(w.y); h0 = fexp2(l0) * h0 + lo2f(w.x); h1 = fexp2(l1) * h1 + lo2f(w.y); s0 += l0; s1 += l1;
            const unsigned ob = gb32 + (unsigned)r * 2048u;
            const float g0 = lo2f(gr[j]) * lo2f(ga[j]), g1 = hi2f(gr[j]) * hi2f(ga[j]);
            const unsigned o1_ = pk2(h0 * g0, h1 * g1), o2_ = pk2(fexp2(s0) * g0, fexp2(s1) * g1); if (DRY) asm volatile("" :: "v"(o1_), "v"(o2_)); else { *(unsigned*)((char*)GRio + ob) = o1_; *(unsigned*)((char*)GAio + ob) = o2_; }
            if ((j & 3) == 3) asm volatile("" ::: "memory"); }
        if (sg == 7 && !DRY) { *(f32x2*)(HEND + (size_t)u.pm * 1024 + chb + c0) = (f32x2){h0, h1}; *(f32x2*)(AEND + (size_t)u.pm * 1024 + chb + c0) = (f32x2){fexp2(s0), fexp2(s1)}; }
        LDS_WAIT(); __builtin_amdgcn_s_barrier(); asm volatile("" ::: "memory");
    }
};

struct EpiWout {
    static constexpr bool PERM = true, AFTER_DRAIN = false;
    const float* x; float* out; bf16_t* HB; float* ssq_h;
    __device__ __forceinline__ void operator()(const Acc& acc, const Unit& u, int wr, int wc, int fr, int fq) const {
        const int rowb = u.pm * BM + wr * 64 + fr, col0 = u.pn * BM + wc * 32 + 8 * fq;
#pragma unroll
        for (int ai = 0; ai < 2; ++ai)
#pragma unroll
            for (int m = 0; m < 4; ++m) {
                const int row = rowb + ai * HALF + m * 16; float ss = 0.f;
#pragma unroll
                for (int bj = 0; bj < 2; ++bj) { const size_t o = (size_t)row * 1024 + col0 + bj * HALF;
                    const f32x4 h0 = *(const f32x4*)(x + o) + acc[ai][bj][m][0], h1 = *(const f32x4*)(x + o + 4) + acc[ai][bj][m][1];
                    ss += dot4(h0) + dot4(h1); *(f32x4*)(out + o) = h0; *(f32x4*)(out + o + 4) = h1;
                    { u32x2 w8; int w_ = __builtin_amdgcn_cvt_pk_fp8_f32(h0[0], h0[1], 0, false); w8.x = (unsigned)__builtin_amdgcn_cvt_pk_fp8_f32(h0[2], h0[3], w_, true); w_ = __builtin_amdgcn_cvt_pk_fp8_f32(h1[0], h1[1], 0, false); w8.y = (unsigned)__builtin_amdgcn_cvt_pk_fp8_f32(h1[2], h1[3], w_, true);
                      *(u32x2*)((unsigned char*)HB + o) = w8; } }
                ss += __shfl_xor(ss, 16); ss += __shfl_xor(ss, 32); if (fq == 0) ssq_h[(size_t)row * 16 + u.pn * 4 + wc] = ss;
            }
    }
};

struct EpiMoeGU {
    static constexpr bool PERM = false, AFTER_DRAIN = false;
    bf16_t* HID; const float* ssq_h; const int* lists;
    __device__ __forceinline__ void operator()(const Acc& acc, const Unit& u, int wr, int wc, int fr, int fq) const {
        const int rb = wr * 64 + fr; float rsv[2][4];
#pragma unroll
        for (int ai = 0; ai < 2; ++ai)
#pragma unroll
            for (int m = 0; m < 4; ++m) { const int r = rb + ai * HALF + m * 16; rsv[ai][m] = (r < u.valid) ? ssq_h[lists[(size_t)u.x0 * M + u.x1 * 256 + r]] : 0.f; }
#pragma unroll
        for (int ai = 0; ai < 2; ++ai)
#pragma unroll
            for (int m = 0; m < 4; ++m) {
                const int r = rb + ai * HALF + m * 16;
                if (r < u.valid) {
                    const float rs = rsv[ai][m];
#pragma unroll
                    for (int n = 0; n < 2; ++n) { f32x4 g = acc[ai][0][m][n] * rs, up = acc[ai][1][m][n] * rs, hb;
#pragma unroll
                        for (int e = 0; e < 4; ++e) hb[e] = g[e] * fsigm(g[e]) * up[e];
                        int w_ = __builtin_amdgcn_cvt_pk_fp8_f32(hb[0], hb[1], 0, false); w_ = __builtin_amdgcn_cvt_pk_fp8_f32(hb[2], hb[3], w_, true);
                        *(unsigned*)((char*)HID + (unsigned)(((unsigned)u.pm * 256u + (unsigned)r) * 256u + 128u * (unsigned)u.pn + 32u * (unsigned)wc + 16u * (unsigned)n + 4u * (unsigned)fq)) = (unsigned)w_; }
                }
            }
    }
};
struct EpiMoeDown {
    static constexpr bool PERM = true, AFTER_DRAIN = false;
    bf16_t* Y; const float* cwl;
    __device__ __forceinline__ void operator()(const Acc& acc, const Unit& u, int wr, int wc, int fr, int fq) const {
        asm volatile("" : "+v"(fr), "+v"(fq));
        const int rb = wr * 64 + fr, col0 = u.pn * BM + wc * 32 + 8 * fq;
#pragma unroll
        for (int ai = 0; ai < 2; ++ai) {
            float cwv[4];
#pragma unroll
            for (int m = 0; m < 4; ++m) { const int r = rb + ai * HALF + m * 16; cwv[m] = (r < u.valid) ? cwl[(size_t)u.x0 * M + u.x1 * 256 + r] * 8.f : 0.f; }
#pragma unroll
            for (int m = 0; m < 4; ++m) {
                const int r = rb + ai * HALF + m * 16;
                if (r < u.valid) { const float cw = cwv[m];
#pragma unroll
                    for (int bj = 0; bj < 2; ++bj) { const f32x4 y0 = acc[ai][bj][m][0] * cw, y1 = acc[ai][bj][m][1] * cw; u32x2 w8;
                        int w_ = __builtin_amdgcn_cvt_pk_fp8_f32(y0[0], y0[1], 0, false); w8.x = (unsigned)__builtin_amdgcn_cvt_pk_fp8_f32(y0[2], y0[3], w_, true);
                        w_ = __builtin_amdgcn_cvt_pk_fp8_f32(y1[0], y1[1], 0, false); w8.y = (unsigned)__builtin_amdgcn_cvt_pk_fp8_f32(y1[2], y1[3], w_, true);
                        *(u32x2*)((char*)Y + (unsigned)(((unsigned)u.pm * 256u + (unsigned)r) * 1024u + (unsigned)(col0 + bj * HALF))) = w8; } }
            }
            asm volatile("" ::: "memory");
        }
    }
};
#define LANE_NOW() ({ int t__ = threadIdx.x; asm volatile("" : "+v"(t__)); t__ & 63; })
struct Frame {
    LAS unsigned char* lds; volatile LAS unsigned* MISC; gu32* ctl;
    int tid, lane, wave, vcu, G;
    void* const* in_dummy;
};
struct Args { const void* in[26]; float* out; unsigned char* ws; int ph_lo, ph_hi; };
typedef const __attribute__((address_space(4))) Args& CArgs;

__device__ __forceinline__ int crow(int r, int hi) { return (r & 3) + 8 * (r >> 2) + 4 * hi; }
__device__ __forceinline__ void tr_item(const float* W, int ldn, int ns0, bf16_t* WT, int K, int nd0, int k0, const float* kscale, LAS float* scr, int lane, int ncols = 64, int nwrite = 64, float f8mul = 0.f) {
    const int c4 = (lane & 15) * 4, kr = lane >> 4;
    f32x4 v[16];
#pragma unroll
    for (int i = 0; i < 16; ++i) { const int kk = 4 * i + kr; v[i] = (c4 < ncols) ? *(const f32x4*)(W + (size_t)(k0 + kk) * ldn + ns0 + c4) : (f32x4){0.f, 0.f, 0.f, 0.f}; }
#pragma unroll
    for (int i = 0; i < 16; ++i) { const int kk = 4 * i + kr; f32x4 x = v[i]; if (kscale) x = x * kscale[k0 + kk];
        LAS float* p = scr + kk * 65 + c4; p[0] = x[0]; p[1] = x[1]; p[2] = x[2]; p[3] = x[3]; }
    LDS_WAIT(); asm volatile("" ::: "memory");
    const int c = lane & 7;
#pragma unroll
    for (int j = 0; j < 8; ++j) { const int n = (lane >> 3) + 8 * j; if (n >= nwrite) break; const LAS float* sp = scr + (8 * c) * 65 + n;
        if (f8mul != 0.f) { u32x2 o8; int w_ = __builtin_amdgcn_cvt_pk_fp8_f32(sp[0 * 65] * f8mul, sp[1 * 65] * f8mul, 0, false); o8.x = (unsigned)__builtin_amdgcn_cvt_pk_fp8_f32(sp[2 * 65] * f8mul, sp[3 * 65] * f8mul, w_, true);
            w_ = __builtin_amdgcn_cvt_pk_fp8_f32(sp[4 * 65] * f8mul, sp[5 * 65] * f8mul, 0, false); o8.y = (unsigned)__builtin_amdgcn_cvt_pk_fp8_f32(sp[6 * 65] * f8mul, sp[7 * 65] * f8mul, w_, true);
            *(u32x2*)((unsigned char*)WT + (size_t)(nd0 + n) * K + k0 + 8 * c) = o8; continue; }
        u32x4 o; o.x = pk2(sp[0 * 65], sp[1 * 65]); o.y = pk2(sp[2 * 65], sp[3 * 65]); o.z = pk2(sp[4 * 65], sp[5 * 65]); o.w = pk2(sp[6 * 65], sp[7 * 65]);
        *(u32x4*)(WT + (size_t)(nd0 + n) * K + k0 + 8 * c) = o; }
    LDS_WAIT(); asm volatile("" ::: "memory");
}

__device__ __forceinline__ void p0_prologue(Frame& F, CArgs a) {
    LAS float* scr = (LAS float*)(F.lds + F.wave * 16640);
    const int gw = F.vcu * NWAVES + F.wave, NGW = F.G * NWAVES, lane = LANE_NOW();
    unsigned char* ws = a.ws;
    const float* w_in = (const float*)a.in[3];
    bf16_t* WIN = (bf16_t*)(ws + WS_WIN); bf16_t* WUQ = (bf16_t*)(ws + WS_WUQ); bf16_t* WUKV = (bf16_t*)(ws + WS_WUKV); bf16_t* WLRU = (bf16_t*)(ws + WS_WLRU); bf16_t* WOUT = (bf16_t*)(ws + WS_WOUT);
    constexpr int I_IN = 16 * 81, I_UQ = 12 * 24, I_UKV = 4 * 32, I_LRU = 4 * 32, I_OUT = 16 * 16, NITEMS = I_IN + I_UQ + I_UKV + I_LRU + I_OUT;
    for (int it = gw; it < NITEMS; it += NGW) {
        int r = it;
        if (r < I_IN) { const int kb = r / 81, nb = r % 81, nd0 = 64 * nb, k0 = 64 * kb;
            if (nd0 < 5120) tr_item(w_in, 5152, nd0 < 3072 ? nd0 : nd0 + 32, WIN, 1024, nd0, k0, nullptr, scr, lane);
            else tr_item(w_in, 5152, 3072, WIN, 1024, nd0, k0, nullptr, scr, lane, 32, 32);
            continue; }
        r -= I_IN;
        if (r < I_UQ) { const int kb = r / 24, nb = r % 24; tr_item((const float*)a.in[12], 1536, 64 * nb, WUQ, 768, 64 * nb, 64 * kb, (const float*)a.in[11], scr, lane, 64, 64, 32.f); continue; }
        r -= I_UQ;
        if (r < I_UKV) { const int kb = r / 32, nb = r % 32, nd0 = 64 * nb, pn = nd0 >> 8, bj = (nd0 >> 7) & 1, wcp = (nd0 >> 6) & 1;
#pragma unroll 1
            for (int hh = 0; hh < 2; ++hh) tr_item((const float*)a.in[14], 2048, (2 * pn + hh) * 128 + wcp * 64 + 32 * bj, WUKV, 256, nd0 + 32 * hh, 64 * kb, (const float*)a.in[13], scr, lane, 32, 32, 16.f);
            continue; }
        r -= I_UKV;
        if (r < I_LRU) { const int kb = r / 32, nb = r % 32, nd0 = 64 * nb, pn = nd0 >> 8, bj = (nd0 >> 7) & 1, xb = nd0 & 127, blk = pn >> 1;
            tr_item((const float*)a.in[bj ? 8 : 6] + (size_t)blk * 65536, 256, 128 * (pn & 1) + xb, WLRU, 256, nd0, 64 * kb, nullptr, scr, lane); continue; }
        r -= I_LRU;
        { const int kb = r / 16, nb = r % 16; tr_item((const float*)a.in[17], 1024, 64 * nb, WOUT, 1024, 64 * nb, 64 * kb, nullptr, scr, lane); }
    }
    const float* x = (const float*)a.in[0]; const float* gm = (const float*)a.in[2]; bf16_t* XN = (bf16_t*)(ws + WS_R1);
    f32x4 g4[4];
#pragma unroll
    for (int j = 0; j < 4; ++j) g4[j] = *(const f32x4*)(gm + 4 * lane + 256 * j);
    for (int m = gw; m < M; m += NGW) {
        const f32x4* xr = (const f32x4*)(x + (size_t)m * D) + lane; f32x4 v[4]; float s = 0.f;
#pragma unroll
        for (int j = 0; j < 4; ++j) { v[j] = xr[64 * j]; s += dot4(v[j]); }
        const float rstd = rsqrtf(wave_sum(s) * (1.f / 1024.f) + EPS);
        u32x2* o8 = (u32x2*)(XN + (size_t)m * D) + lane;
#pragma unroll
        for (int j = 0; j < 4; ++j) { const f32x4 y = v[j] * rstd * g4[j]; u32x2 w; w.x = pk2(y[0], y[1]); w.y = pk2(y[2], y[3]); o8[64 * j] = w; }
    }
    const int gt = F.vcu * NTHREADS + F.tid, NGT = F.G * NTHREADS;
    const int* pos = (const int*)a.in[1]; float* CS = (float*)(ws + WS_CS);
    for (int i = gt; i < M * 16; i += NGT) { const int t = i >> 4, j = i & 15; const float fr = powf(10000.f, -(float)j / 16.f); const float ang = (float)pos[t] * fr; CS[t * 32 + j] = cosf(ang); CS[t * 32 + 16 + j] = sinf(ang); }
    float* WR = (float*)(ws + WS_MISC + MISC_WR); const float* gf = (const float*)a.in[18]; const float* wg = (const float*)a.in[19]; const float* we = (const float*)a.in[21];
    for (int i = gt; i < 36 * 1024; i += NGT) { const int j = i >> 10, k = i & 1023; WR[i] = (j < 4 ? wg[k * 4 + j] : we[k * 32 + (j - 4)]) * gf[k]; }
}

__device__ __forceinline__ void moe_weight_convert(Frame& F, CArgs a, int part, int lo, int nblk) {
    LAS float* scr = (LAS float*)(F.lds + F.wave * 16640);
    const int gw = lo * NWAVES + F.wave, NGW = nblk * NWAVES, lane = LANE_NOW();
    bf16_t* WGU = (bf16_t*)(a.ws + WS_WGU); bf16_t* WDN = (bf16_t*)(a.ws + WS_WDN); const float* gf = (const float*)a.in[18];
    constexpr int I_GU = 32 * 16 * 8, I_DN = 32 * 4 * 16;
    for (int it = (part == 0 ? gw : I_GU + gw); it < (part == 0 ? I_GU : I_GU + I_DN); it += NGW) {
        if (it < I_GU) { const int e = it >> 7, r = it & 127, kb = r >> 3, nb = r & 7, nd0 = 64 * nb, pn = nd0 >> 8, bj = (nd0 >> 7) & 1, xb = nd0 & 127;
            tr_item((const float*)a.in[bj ? 24 : 23] + (size_t)e * 262144, 256, 128 * pn + xb, (bf16_t*)((unsigned char*)WGU + (size_t)e * 524288), 1024, nd0, 64 * kb, gf, scr, lane, 64, 64, 32.f); }
        else { const int r0 = it - I_GU, e = r0 >> 6, r = r0 & 63, kb = r >> 4, nb = r & 15;
            tr_item((const float*)a.in[25] + (size_t)e * 262144, 1024, 64 * nb, (bf16_t*)((unsigned char*)WDN + (size_t)e * 262144), 256, 64 * nb, 64 * kb, nullptr, scr, lane, 64, 64, 16.f); }
    }
}

template <bool DRY> __device__ __forceinline__ void p2a_conv(Frame& F, CArgs a) {
    unsigned char* ws = a.ws; bf16_t* XR = (bf16_t*)(ws + WS_XR); const bf16_t* HALO = (const bf16_t*)(ws + WS_MISC + MISC_HALO);
    const float* cw = (const float*)a.in[4]; const float* cb = (const float*)a.in[5];
    for (int b = F.vcu; b < 256; b += F.G) {
        const int pm = b >> 2, cg = b & 3, cp = F.tid & 127, sg = F.tid >> 7, c = cg * 256 + 2 * cp, base = pm * 256 + sg * 64;
        float h0[3], h1[3];
#pragma unroll
        for (int i = 0; i < 3; ++i) { unsigned w = 0u;
            if (sg == 0) { if (pm > 0) w = *(const unsigned*)(HALO + ((size_t)(pm - 1) * 3 + i) * 1024 + c); }
            else w = *(const unsigned*)(XR + (size_t)(base - 3 + i) * 1024 + c);
            h0[i] = lo2f(w); h1[i] = hi2f(w); }
        VM_WAIT(); __syncthreads();
        float w0[4], w1[4];
#pragma unroll
        for (int k = 0; k < 4; ++k) { w0[k] = cw[k * 1024 + c]; w1[k] = cw[k * 1024 + c + 1]; }
        const float b0 = cb[c], b1 = cb[c + 1];
        for (int j0 = 0; j0 < 64; j0 += 8) {
            unsigned xw[8];
#pragma unroll
            for (int j = 0; j < 8; ++j) xw[j] = *(const unsigned*)(XR + (size_t)(base + j0 + j) * 1024 + c);
#pragma unroll
            for (int j = 0; j < 8; ++j) { const float x0 = lo2f(xw[j]), x1 = hi2f(xw[j]);
                const float y0 = b0 + w0[0] * h0[0] + w0[1] * h0[1] + w0[2] * h0[2] + w0[3] * x0, y1 = b1 + w1[0] * h1[0] + w1[1] * h1[1] + w1[2] * h1[2] + w1[3] * x1;
                h0[0] = h0[1]; h0[1] = h0[2]; h0[2] = x0; h1[0] = h1[1]; h1[1] = h1[2]; h1[2] = x1;
                const unsigned yw_ = pk2(y0, y1); if (DRY) asm volatile("" :: "v"(yw_)); else *(unsigned*)(XR + (size_t)(base + j0 + j) * 1024 + c) = yw_; }
        }
        __syncthreads();
    }
    if (!DRY && F.wave < 4) {
        const float* PQ = (const float*)(ws + WS_SSQP); const float* PKV = (const float*)(ws + WS_SSQP + SSQP_KV); float* RQ = (float*)(ws + WS_CTL + CTL_SSQ_Q); float* RKV = (float*)(ws + WS_CTL + CTL_SSQ_KV);
        float* KPE = (float*)(ws + WS_KPE); const float* CS = (const float*)(ws + WS_CS); float* KSSQ = (float*)(ws + WS_MISC + MISC_KSSQ); const float* kg = (const float*)a.in[16];
        const bf16_t* XN = (const bf16_t*)(ws + WS_R1); const bf16_t* WK = (const bf16_t*)(ws + WS_WIN) + (size_t)5120 * 1024;
        const int lane = LANE_NOW(), r16 = lane & 15, q4 = lane >> 4; LAS float* kl = (LAS float*)(F.lds + F.wave * 4096);
        for (int rb = F.vcu * 4 + F.wave; rb < M / 16; rb += F.G * 4) {
            const bf16_t* ap = XN + (size_t)(rb * 16 + r16) * 1024 + 8 * q4; const bf16_t* bp0 = WK + (size_t)r16 * 1024 + 8 * q4; const bf16_t* bp1 = bp0 + 16 * 1024;
            f32x4 acc0 = {0.f, 0.f, 0.f, 0.f}, acc1 = acc0;
#pragma unroll 8
            for (int s32 = 0; s32 < 32; ++s32) { const bf16x8 av = *(const bf16x8*)(ap + 32 * s32), b0 = *(const bf16x8*)(bp0 + 32 * s32), b1 = *(const bf16x8*)(bp1 + 32 * s32);
                acc0 = __builtin_amdgcn_mfma_f32_16x16x32_bf16(av, b0, acc0, 0, 0, 0); acc1 = __builtin_amdgcn_mfma_f32_16x16x32_bf16(av, b1, acc1, 0, 0, 0); }
#pragma unroll
            for (int i2 = 0; i2 < 4; ++i2) { kl[(4 * q4 + i2) * 33 + r16] = acc0[i2]; kl[(4 * q4 + i2) * 33 + 16 + r16] = acc1[i2]; }
            LDS_WAIT();
            if (lane < 16) {
                const int row = rb * 16 + lane; float kp[32]; float ss = 0.f;
#pragma unroll
                for (int j2 = 0; j2 < 32; ++j2) { kp[j2] = kl[lane * 33 + j2]; ss += kp[j2] * kp[j2]; }
                KSSQ[row] = ss;
                { const f32x4 a0 = *(const f32x4*)(PQ + (size_t)row * 12), a1 = *(const f32x4*)(PQ + (size_t)row * 12 + 4), a2 = *(const f32x4*)(PQ + (size_t)row * 12 + 8), b0 = *(const f32x4*)(PKV + (size_t)row * 4);
                  const float sq = ((a0[0] + a0[1]) + (a0[2] + a0[3])) + ((a1[0] + a1[1]) + (a1[2] + a1[3])) + ((a2[0] + a2[1]) + (a2[2] + a2[3])), sk = (b0[0] + b0[1]) + (b0[2] + b0[3]);
                  RQ[row] = rsqrtf(sq * (1.f / 768.f) + EPS); RKV[row] = rsqrtf(sk * (1.f / 256.f) + EPS); }
#pragma unroll
                for (int i = 0; i < 4; ++i) { const f32x4 g1 = *(const f32x4*)(kg + 64 + 4 * i), g2 = *(const f32x4*)(kg + 80 + 4 * i), cs = *(const f32x4*)(CS + (size_t)row * 32 + 4 * i), sn = *(const f32x4*)(CS + (size_t)row * 32 + 16 + 4 * i);
                    f32x4 o1, o2;
#pragma unroll
                    for (int e = 0; e < 4; ++e) { const float k1 = kp[4 * i + e] * g1[e], k2 = kp[16 + 4 * i + e] * g2[e]; o1[e] = k1 * cs[e] - k2 * sn[e]; o2[e] = k1 * sn[e] + k2 * cs[e]; }
                    *(f32x4*)(KPE + (size_t)row * 32 + 4 * i) = o1; *(f32x4*)(KPE + (size_t)row * 32 + 16 + 4 * i) = o2; }
            }
            LDS_WAIT();
        }
    }
}

__device__ __forceinline__ void glds16(const void* gsrc, unsigned lds_dst) { unsigned keep;
    asm volatile("s_mov_b32 %0, m0\n\ts_mov_b32 m0, %2\n\ts_nop 0\n\tglobal_load_lds_dwordx4 %1, off\n\ts_mov_b32 m0, %0" : "=&s"(keep) : "v"(gsrc), "s"(lds_dst) : "memory"); }
__device__ __forceinline__ void glds16s(const void* sbase, unsigned voff, unsigned lds_dst) { unsigned keep;
    asm volatile("s_mov_b32 %0, m0\n\ts_mov_b32 m0, %3\n\ts_nop 0\n\tglobal_load_lds_dwordx4 %1, %2\n\ts_mov_b32 m0, %0" : "=&s"(keep) : "v"(voff), "s"(sbase), "s"(lds_dst) : "memory"); }
__device__ __forceinline__ void glds12(const void* gsrc, unsigned lds_dst) { unsigned keep;
    asm volatile("s_mov_b32 %0, m0\n\ts_mov_b32 m0, %2\n\ts_nop 0\n\tglobal_load_lds_dwordx3 %1, off\n\ts_mov_b32 m0, %0" : "=&s"(keep) : "v"(gsrc), "s"(lds_dst) : "memory"); }
#define AWAIT_BAR(N) asm volatile("s_waitcnt vmcnt(" #N ") lgkmcnt(0)\n\ts_barrier" ::: "memory")
constexpr int AT_K = 0, AT_V = 24576, AT_WS = 40960, AT_OST = 43008, AT_END = 75776;
constexpr float C2 = 0.10206207261596575f * 1.4426950408889634f;

__device__ __forceinline__ void attn_unit_v1(int h, int qb, CArgs a, const LAS float* carry, LAS unsigned char* shm) {
    const int tid = threadIdx.x, lane = tid & 63, r32 = lane & 31, hi = lane >> 5; const int wid = __builtin_amdgcn_readfirstlane(tid >> 6);
    unsigned char* ws = a.ws;
    const bf16_t* QRAW = (const bf16_t*)(ws + WS_R1); const unsigned char* KI = ws + WS_KIMG + (size_t)h * 256 * 12288; const unsigned char* VI = (const unsigned char*)a.out + 32 * MiB + (size_t)h * 256 * 8192;
    const float* CS = (const float*)(ws + WS_CS); const float* qg = (const float*)a.in[15];
    const int q0 = qb * 256, rowq = q0 + wid * 32 + r32;
    const unsigned lds0 = (unsigned)(uintptr_t)shm;
    LAS float* wsf = (LAS float*)(shm + AT_WS) + wid * 64;
    bf16x8 qr[6];
    {
        const bf16_t* qp = QRAW + (size_t)rowq * 1536 + h * 96 + hi * 8;
        u32x4 raw[6]; float qv[6][8]; float ss = 0.f;
#pragma unroll
        for (int d0 = 0; d0 < 6; ++d0) raw[d0] = *(const u32x4*)(qp + d0 * 16);
#pragma unroll
        for (int d0 = 0; d0 < 6; ++d0)
#pragma unroll
            for (int j = 0; j < 4; ++j) { qv[d0][2 * j] = lo2f(raw[d0][j]); qv[d0][2 * j + 1] = hi2f(raw[d0][j]); ss += qv[d0][2 * j] * qv[d0][2 * j] + qv[d0][2 * j + 1] * qv[d0][2 * j + 1]; }
        ss += __shfl_xor(ss, 32);
        const float rs = rsqrtf(ss * (1.f / 96.f) + EPS);
#pragma unroll
        for (int d0 = 0; d0 < 6; ++d0) { const f32x4 g0 = *(const f32x4*)(qg + d0 * 16 + hi * 8), g1 = *(const f32x4*)(qg + d0 * 16 + hi * 8 + 4);
#pragma unroll
            for (int j = 0; j < 4; ++j) { qv[d0][j] *= rs * g0[j]; qv[d0][4 + j] *= rs * g1[j]; } }
        const f32x4 c0 = *(const f32x4*)(CS + (size_t)rowq * 32 + hi * 8), c1 = *(const f32x4*)(CS + (size_t)rowq * 32 + hi * 8 + 4), s0 = *(const f32x4*)(CS + (size_t)rowq * 32 + 16 + hi * 8), s1 = *(const f32x4*)(CS + (size_t)rowq * 32 + 16 + hi * 8 + 4);
#pragma unroll
        for (int j = 0; j < 8; ++j) { const float cs = j < 4 ? c0[j & 3] : c1[j & 3], sn = j < 4 ? s0[j & 3] : s1[j & 3]; const float x1 = qv[4][j], x2 = qv[5][j]; qv[4][j] = x1 * cs - x2 * sn; qv[5][j] = x1 * sn + x2 * cs; }
#pragma unroll
        for (int d0 = 0; d0 < 6; ++d0) { u32x4 w;
#pragma unroll
            for (int j = 0; j < 4; ++j) w[j] = pk2(qv[d0][2 * j] * C2, qv[d0][2 * j + 1] * C2);
            qr[d0] = __builtin_bit_cast(bf16x8, w); }
    }
    const int NT = 4 * qb + 4, mylast = 4 * qb + (wid >> 1);
#define AT_DMA(t, buf) do { const unsigned char* kt_ = KI + (size_t)(t) * 12288 + wid * 1024 + lane * 16; const unsigned kd_ = lds0 + AT_K + (buf) * 12288 + wid * 1024; \
        glds16(kt_, (unsigned)__builtin_amdgcn_readfirstlane(kd_)); if (wid < 4) glds16(kt_ + 8192, (unsigned)__builtin_amdgcn_readfirstlane(kd_ + 8192)); \
        glds16(VI + (size_t)(t) * 8192 + wid * 1024 + lane * 16, (unsigned)__builtin_amdgcn_readfirstlane(lds0 + AT_V + (buf) * 8192 + wid * 1024)); } while (0)
#define AT_WAIT1() do { if (wid < 4) asm volatile("s_waitcnt vmcnt(3)" ::: "memory"); else asm volatile("s_waitcnt vmcnt(2)" ::: "memory"); asm volatile("s_waitcnt lgkmcnt(0)\n\ts_barrier" ::: "memory"); } while (0)
    float m_run = -1e30f, l_run = 0.f; f32x16 o[2]; o[0] = f32x16{}; o[1] = f32x16{};
    AT_DMA(0, 0);
    for (int t = 0; t < NT; ++t) {
        const int buf = t & 1;
        if (t + 1 < NT) { AT_DMA(t + 1, buf ^ 1); AT_WAIT1(); } else { AWAIT_BAR(0); }
        if (t <= mylast) {
            const LAS unsigned char* kb = shm + AT_K + buf * 12288 + hi * 1024 + r32 * 16;
            f32x16 p0 = f32x16{}, p1 = f32x16{};
#pragma unroll
            for (int d0 = 0; d0 < 6; ++d0) { const bf16x8 b0 = *(const LAS bf16x8*)(kb + d0 * 2048), b1 = *(const LAS bf16x8*)(kb + d0 * 2048 + 512);
                p0 = __builtin_amdgcn_mfma_f32_32x32x16_bf16(b0, qr[d0], p0, 0, 0, 0); p1 = __builtin_amdgcn_mfma_f32_32x32x16_bf16(b1, qr[d0], p1, 0, 0, 0); }
            float rm = fmaxf(p0[0], p1[0]);
#pragma unroll
            for (int r = 1; r < 16; ++r) rm = fmaxf(rm, fmaxf(p0[r], p1[r]));
            rm = fmaxf(rm, __shfl_xor(rm, 32));
            const float mn = fmaxf(m_run, rm), alpha = fexp2(m_run - mn); m_run = mn;
            float ps = 0.f;
#pragma unroll
            for (int r = 0; r < 16; ++r) { p0[r] = fexp2(p0[r] - mn); p1[r] = fexp2(p1[r] - mn); ps += p0[r] + p1[r]; }
            l_run = l_run * alpha + ps;
            if (__any(alpha != 1.f)) {
                if (hi == 0) wsf[r32] = alpha;
                LDS_WAIT();
#pragma unroll
                for (int r = 0; r < 16; ++r) { const float f = wsf[crow(r, hi)]; o[0][r] *= f; o[1][r] *= f; }
            }
            u32x4 pw[4];
#pragma unroll
            for (int j = 0; j < 4; ++j) { pw[0][j] = pk2(p0[2 * j], p0[2 * j + 1]); pw[1][j] = pk2(p0[8 + 2 * j], p0[8 + 2 * j + 1]); pw[2][j] = pk2(p1[2 * j], p1[2 * j + 1]); pw[3][j] = pk2(p1[8 + 2 * j], p1[8 + 2 * j + 1]); }
            const LAS unsigned char* vb = shm + AT_V + buf * 8192 + ((lane >> 4) & 1) * 32 + (lane & 3) * 8 + (4 * hi + ((lane & 15) >> 2)) * 64;
#pragma unroll
            for (int d0 = 0; d0 < 2; ++d0)
#pragma unroll
                for (int ks = 0; ks < 4; ++ks) {
                    typedef short v4i16_t __attribute__((ext_vector_type(4)));
                    const s16x4 lo = __builtin_bit_cast(s16x4, __builtin_amdgcn_ds_read_tr16_b64_v4i16((LAS v4i16_t*)(vb + d0 * 4096 + ks * 1024)));
                    const s16x4 hh = __builtin_bit_cast(s16x4, __builtin_amdgcn_ds_read_tr16_b64_v4i16((LAS v4i16_t*)(vb + d0 * 4096 + ks * 1024 + 512)));
                    const bf16x8 vf = (bf16x8){lo[0], lo[1], lo[2], lo[3], hh[0], hh[1], hh[2], hh[3]};
                    o[d0] = __builtin_amdgcn_mfma_f32_32x32x16_bf16(__builtin_bit_cast(bf16x8, pw[ks]), vf, o[d0], 0, 0, 0);
                }
        }
        asm volatile("s_waitcnt lgkmcnt(0)\n\ts_barrier" ::: "memory");
    }
#undef AT_DMA
#undef AT_WAIT1
    l_run += __shfl_xor(l_run, 32);
    if (hi == 0) wsf[32 + r32] = l_run;
    LDS_WAIT();
    LAS bf16_t* stg = (LAS bf16_t*)(shm + AT_OST) + wid * 2048;
#pragma unroll
    for (int r = 0; r < 16; ++r) { const int orow = crow(r, hi); const float il = frcp(wsf[32 + orow]);
#pragma unroll
        for (int d0 = 0; d0 < 2; ++d0) stg[orow * 64 + d0 * 32 + r32] = (bf16_t)f2bf(o[d0][r] * il); }
    LDS_WAIT();
    const bf16_t* GB = (const bf16_t*)a.out; const bf16_t* HL = (const bf16_t*)(ws + WS_GR); const bf16_t* AC = (const bf16_t*)(ws + WS_GA); bf16_t* MG = (bf16_t*)(ws + WS_XR);
#pragma unroll
    for (int i = 0; i < 4; ++i) { const int row = i * 8 + (lane >> 3), ch = lane & 7; const u32x4 yv = *(const LAS u32x4*)(stg + row * 64 + ch * 8);
        const size_t go = (size_t)(q0 + wid * 32 + row) * 1024 + h * 64 + ch * 8;
        const u32x4 gb = *(const u32x4*)(GB + go), hl = *(const u32x4*)(HL + go), ac = *(const u32x4*)(AC + go); u32x4 w;
#pragma unroll
        for (int j = 0; j < 4; ++j) { const float c0 = carry[ch * 8 + 2 * j], c1 = carry[ch * 8 + 2 * j + 1];
            w[j] = pk2(lo2f(yv[j]) * lo2f(gb[j]) + lo2f(hl[j]) + lo2f(ac[j]) * c0, hi2f(yv[j]) * hi2f(gb[j]) + hi2f(hl[j]) + hi2f(ac[j]) * c1); }
        *(u32x4*)(MG + go) = w; }
    asm volatile("s_waitcnt lgkmcnt(0)\n\ts_barrier" ::: "memory");
}


constexpr int A2_K = 0, A2_V = 36864, A2_WS = 61440, A2_OST = 63488;
#define A2_MF(a_, b_, c_) __builtin_amdgcn_mfma_f32_32x32x16_bf16(a_, b_, c_, 0, 0, 0)
#define A2_SB() __builtin_amdgcn_sched_barrier(0)
#define A2_PIN(x) asm volatile("" : "+v"(x))
#define A2_KF(d0, blk) ((ABL == 5) ? qr[(d0)] : *(const LAS bf16x8*)(kp + (d0) * 2048 + (blk) * 512))
typedef short v4i16_t __attribute__((ext_vector_type(4)));
#define A2_VT(off) __builtin_bit_cast(s16x4, __builtin_amdgcn_ds_read_tr16_b64_v4i16((LAS v4i16_t*)(vp + (off))))
#define A2_VJ(lo_, hi_, j) do { if (ABL == 5) { lo_ = (s16x4){qr[0][0], qr[0][1], qr[1][2], qr[1][3]}; hi_ = (s16x4){qr[2][0], qr[2][1], qr[3][2], qr[3][3]}; } else { lo_ = A2_VT(((j) & 1) * 4096 + ((j) >> 1) * 1024); hi_ = A2_VT(((j) & 1) * 4096 + ((j) >> 1) * 1024 + 512); } } while (0)
#define A2_VF(lo_, hi_) ((bf16x8){lo_[0], lo_[1], lo_[2], lo_[3], hi_[0], hi_[1], hi_[2], hi_[3]})
#define A2_EX(x) ((ABL == 2) ? (x) : fexp2(x))
#define A2_E3(P, b) do { P[b] = A2_EX(P[b]); P[(b) + 1] = A2_EX(P[(b) + 1]); P[(b) + 2] = A2_EX(P[(b) + 2]); } while (0)
#define A2_E2(P, b) do { P[b] = A2_EX(P[b]); P[(b) + 1] = A2_EX(P[(b) + 1]); } while (0)
#define A2_PK2(W, j, P, b) do { W[j] = pk2(P[b], P[(b) + 1]); W[(j) + 1] = pk2(P[(b) + 2], P[(b) + 3]); } while (0)
#define A2_S4(P, b) do { if (ABL != 2) { sacc += P[b]; sacc += P[(b) + 1]; sacc += P[(b) + 2]; sacc += P[(b) + 3]; } } while (0)

template <int ABL> __device__ __forceinline__ void attn_unit_v2(int h, int qb, CArgs a, const LAS float* carry, LAS unsigned char* shm) {
    const int tid = threadIdx.x, lane = tid & 63, r32 = lane & 31, hi = lane >> 5; const int wid = __builtin_amdgcn_readfirstlane(tid >> 6);
    unsigned char* ws = a.ws;
    const bf16_t* QRAW = (const bf16_t*)(ws + WS_R1); const unsigned char* KI = ws + WS_KIMG + (size_t)h * 256 * 12288; const unsigned char* VI = (const unsigned char*)a.out + 32 * MiB + (size_t)h * 256 * 8192;
    const float* CS = (const float*)(ws + WS_CS); const float* qg = (const float*)a.in[15];
    const int q0 = qb * 256, rowq = q0 + wid * 32 + r32;
    const unsigned lds0 = (unsigned)(uintptr_t)shm;
    LAS float* wsf = (LAS float*)(shm + A2_WS) + wid * 64;
    const int NT = 4 * qb + 4, mylast = 4 * qb + (wid >> 1);
    const unsigned char* ksrc = KI + wid * 1024 + lane * 16; const unsigned char* vsrc = VI + wid * 1024 + lane * 16;
    const unsigned kdst = lds0 + A2_K + wid * 1024, vdst = lds0 + A2_V + wid * 1024;
#define A2_DMAK(t, slot) do { if (ABL == 3) break; glds16(ksrc + (size_t)(t) * 12288, (unsigned)__builtin_amdgcn_readfirstlane(kdst + (slot) * 12288)); \
        if (wid < 4) glds16(ksrc + (size_t)(t) * 12288 + 8192, (unsigned)__builtin_amdgcn_readfirstlane(kdst + (slot) * 12288 + 8192)); } while (0)
#define A2_DMAV(t, slot) do { if (ABL != 3) glds16(vsrc + (size_t)(t) * 8192, (unsigned)__builtin_amdgcn_readfirstlane(vdst + (slot) * 8192)); } while (0)
#define A2_WAITFULL() do { if (wid < 4) asm volatile("s_waitcnt vmcnt(3)" ::: "memory"); else asm volatile("s_waitcnt vmcnt(2)" ::: "memory"); } while (0)
#define A2_BAR() do { if (ABL == 1) asm volatile("s_waitcnt lgkmcnt(0)" ::: "memory"); else asm volatile("s_waitcnt lgkmcnt(0)\n\ts_barrier" ::: "memory"); } while (0)
    bf16x8 qr[6];
    {
        const bf16_t* qp = QRAW + (size_t)rowq * 1536 + h * 96 + hi * 8;
        u32x4 raw[6]; float qv[6][8]; float ss = 0.f;
#pragma unroll
        for (int d0 = 0; d0 < 6; ++d0) raw[d0] = *(const u32x4*)(qp + d0 * 16);
        A2_DMAK(0, 0); A2_DMAV(0, 0); A2_DMAK(1, 1); A2_DMAV(1, 1); A2_DMAK(2, 2);
#pragma unroll
        for (int d0 = 0; d0 < 6; ++d0)
#pragma unroll
            for (int j = 0; j < 4; ++j) { qv[d0][2 * j] = lo2f(raw[d0][j]); qv[d0][2 * j + 1] = hi2f(raw[d0][j]); ss += qv[d0][2 * j] * qv[d0][2 * j] + qv[d0][2 * j + 1] * qv[d0][2 * j + 1]; }
        ss += __shfl_xor(ss, 32);
        const float rs = rsqrtf(ss * (1.f / 96.f) + EPS);
#pragma unroll
        for (int d0 = 0; d0 < 6; ++d0) { const f32x4 g0 = *(const f32x4*)(qg + d0 * 16 + hi * 8), g1 = *(const f32x4*)(qg + d0 * 16 + hi * 8 + 4);
#pragma unroll
            for (int j = 0; j < 4; ++j) { qv[d0][j] *= rs * g0[j]; qv[d0][4 + j] *= rs * g1[j]; } }
        const f32x4 c0 = *(const f32x4*)(CS + (size_t)rowq * 32 + hi * 8), c1 = *(const f32x4*)(CS + (size_t)rowq * 32 + hi * 8 + 4), s0 = *(const f32x4*)(CS + (size_t)rowq * 32 + 16 + hi * 8), s1 = *(const f32x4*)(CS + (size_t)rowq * 32 + 16 + hi * 8 + 4);
#pragma unroll
        for (int j = 0; j < 8; ++j) { const float cs = j < 4 ? c0[j & 3] : c1[j & 3], sn = j < 4 ? s0[j & 3] : s1[j & 3]; const float x1 = qv[4][j], x2 = qv[5][j]; qv[4][j] = x1 * cs - x2 * sn; qv[5][j] = x1 * sn + x2 * cs; }
#pragma unroll
        for (int d0 = 0; d0 < 6; ++d0) { u32x4 w;
#pragma unroll
            for (int j = 0; j < 4; ++j) w[j] = pk2(qv[d0][2 * j] * C2, qv[d0][2 * j + 1] * C2);
            qr[d0] = __builtin_bit_cast(bf16x8, w); }
    }
    if (wid >= 4) __builtin_amdgcn_s_setprio(1);
    float lsum = 0.f; f32x16 o[2]; o[0] = f32x16{}; o[1] = f32x16{};
    f32x16 pA0, pA1, pB0, pB1;
    if (wid < 4) asm volatile("s_waitcnt vmcnt(6)" ::: "memory"); else asm volatile("s_waitcnt vmcnt(4)" ::: "memory");
    A2_BAR();
    {
        const LAS unsigned char* kp = shm + A2_K + hi * 1024 + r32 * 16;
        pA0 = f32x16{}; pA1 = f32x16{};
#pragma unroll
        for (int d0 = 0; d0 < 6; ++d0) { pA0 = A2_MF(A2_KF(d0, 0), qr[d0], pA0); pA1 = A2_MF(A2_KF(d0, 1), qr[d0], pA1); }
    }
    int sk_next = 12288, sv_cur = 0;
#define A2_STEP(C0, C1, N0, N1, t, HASN) do { \
        const LAS unsigned char* kp = shm + A2_K + sk_next + hi * 1024 + r32 * 16; const LAS unsigned char* vp = shm + A2_V + sv_cur + ((lane >> 4) & 1) * 32 + (lane & 3) * 8 + (4 * hi + ((lane & 15) >> 2)) * 64; \
        bf16x8 k0, k1, k2; s16x4 vl0, vh0, vl1, vh1, vl2, vh2; u32x4 w0, w1, w2, w3; float sacc = 0.f; \
        A2_SB(); \
        if (HASN) { k0 = A2_KF(0, 0); k1 = A2_KF(0, 1); k2 = A2_KF(1, 0); A2_SB(); \
            N0 = A2_MF(k0, qr[0], (f32x16{})); k0 = A2_KF(1, 1); A2_E3(C0, 0);  A2_PIN(C0); A2_SB(); \
            N1 = A2_MF(k1, qr[0], (f32x16{})); k1 = A2_KF(2, 0); A2_E3(C0, 3);  A2_PIN(C0); A2_SB(); \
            N0 = A2_MF(k2, qr[1], N0);         k2 = A2_KF(2, 1); A2_E3(C0, 6);  A2_PIN(C0); A2_SB(); \
            N1 = A2_MF(k0, qr[1], N1);         k0 = A2_KF(3, 0); A2_E3(C0, 9);  A2_PIN(C0); A2_SB(); \
            N0 = A2_MF(k1, qr[2], N0);         k1 = A2_KF(3, 1); A2_E3(C0, 12); A2_PIN(C0); A2_SB(); \
            N1 = A2_MF(k2, qr[2], N1);         k2 = A2_KF(4, 0); C0[15] = A2_EX(C0[15]); A2_E2(C1, 0); A2_PIN(C0); A2_PIN(C1); A2_SB(); \
            N0 = A2_MF(k0, qr[3], N0);         k0 = A2_KF(4, 1); A2_E3(C1, 2);  A2_PIN(C1); A2_SB(); \
            N1 = A2_MF(k1, qr[3], N1);         k1 = A2_KF(5, 0); A2_E3(C1, 5);  A2_PIN(C1); A2_SB(); \
            N0 = A2_MF(k2, qr[4], N0);         k2 = A2_KF(5, 1); A2_E2(C1, 8);  A2_PK2(w0, 0, C0, 0);  A2_PIN(C1); A2_PIN(w0); A2_SB(); \
            N1 = A2_MF(k0, qr[4], N1);                           A2_E2(C1, 10); A2_PK2(w0, 2, C0, 4);  A2_PIN(C1); A2_PIN(w0); A2_SB(); \
            N0 = A2_MF(k1, qr[5], N0);         A2_VJ(vl0, vh0, 0); A2_E2(C1, 12); A2_PK2(w1, 0, C0, 8);  A2_PIN(C1); A2_PIN(w1); A2_SB(); \
            N1 = A2_MF(k2, qr[5], N1);         A2_VJ(vl1, vh1, 1); A2_E2(C1, 14); A2_PK2(w1, 2, C0, 12); A2_PIN(C1); A2_PIN(w1); A2_SB(); \
        } else { \
            _Pragma("unroll") for (int r_ = 0; r_ < 16; ++r_) { C0[r_] = A2_EX(C0[r_]); C1[r_] = A2_EX(C1[r_]); } \
            A2_PK2(w0, 0, C0, 0); A2_PK2(w0, 2, C0, 4); A2_PK2(w1, 0, C0, 8); A2_PK2(w1, 2, C0, 12); A2_VJ(vl0, vh0, 0); A2_VJ(vl1, vh1, 1); A2_SB(); \
        } \
        if ((t) > mylast) { w0 = (u32x4){0u, 0u, 0u, 0u}; w1 = w0; C0 = f32x16{}; C1 = f32x16{}; } \
        o[0] = A2_MF(__builtin_bit_cast(bf16x8, w0), A2_VF(vl0, vh0), o[0]); A2_VJ(vl2, vh2, 2); A2_PK2(w2, 0, C1, 0);  A2_S4(C0, 0);  A2_PIN(w2); A2_PIN(sacc); A2_SB(); \
        o[1] = A2_MF(__builtin_bit_cast(bf16x8, w0), A2_VF(vl1, vh1), o[1]); A2_VJ(vl0, vh0, 3); A2_PK2(w2, 2, C1, 4);  A2_S4(C0, 4);  A2_PIN(w2); A2_PIN(sacc); A2_SB(); \
        o[0] = A2_MF(__builtin_bit_cast(bf16x8, w1), A2_VF(vl2, vh2), o[0]); A2_VJ(vl1, vh1, 4); A2_PK2(w3, 0, C1, 8);  A2_S4(C0, 8);  A2_PIN(w3); A2_PIN(sacc); A2_SB(); \
        o[1] = A2_MF(__builtin_bit_cast(bf16x8, w1), A2_VF(vl0, vh0), o[1]); A2_VJ(vl2, vh2, 5); A2_PK2(w3, 2, C1, 12); A2_S4(C0, 12); A2_PIN(w3); A2_PIN(sacc); A2_SB(); \
        o[0] = A2_MF(__builtin_bit_cast(bf16x8, w2), A2_VF(vl1, vh1), o[0]); A2_VJ(vl0, vh0, 6); A2_S4(C1, 0);  A2_PIN(sacc); A2_SB(); \
        o[1] = A2_MF(__builtin_bit_cast(bf16x8, w2), A2_VF(vl2, vh2), o[1]); A2_VJ(vl1, vh1, 7); A2_S4(C1, 4);  A2_PIN(sacc); A2_SB(); \
        o[0] = A2_MF(__builtin_bit_cast(bf16x8, w3), A2_VF(vl0, vh0), o[0]); A2_S4(C1, 8);  A2_PIN(sacc); A2_SB(); \
        o[1] = A2_MF(__builtin_bit_cast(bf16x8, w3), A2_VF(vl1, vh1), o[1]); A2_S4(C1, 12); A2_PIN(sacc); A2_SB(); \
        lsum += sacc; \
        sk_next = (sk_next == 24576) ? 0 : sk_next + 12288; sv_cur = (sv_cur == 16384) ? 0 : sv_cur + 8192; \
    } while (0)
#define A2_TOP(t) do { const int t_ = (t); if (t_ - 1 <= NT - 4) { A2_WAITFULL(); } else if (t_ - 1 == NT - 3) { asm volatile("s_waitcnt vmcnt(1)" ::: "memory"); } else { asm volatile("s_waitcnt vmcnt(0)" ::: "memory"); } \
        A2_BAR(); if (t_ + 3 < NT) { glds16(kg3, (unsigned)__builtin_amdgcn_readfirstlane(kdst + dk)); if (wid < 4) glds16(kg3 + 8192, (unsigned)__builtin_amdgcn_readfirstlane(kdst + dk + 8192)); } \
        if (t_ + 2 < NT) glds16(vg2, (unsigned)__builtin_amdgcn_readfirstlane(vdst + dv)); \
        kg3 += 12288; vg2 += 8192; dk = (dk == 24576u) ? 0u : dk + 12288u; dv = (dv == 16384u) ? 0u : dv + 8192u; } while (0)
    const unsigned char* kg3 = ksrc + 3 * 12288; const unsigned char* vg2 = vsrc + 2 * 8192; unsigned dk = 0u, dv = 16384u;
    int t = 0;
    for (; t + 2 < NT; t += 2) {
        A2_TOP(t);     A2_STEP(pA0, pA1, pB0, pB1, t, true);
        A2_TOP(t + 1); A2_STEP(pB0, pB1, pA0, pA1, t + 1, true);
    }
    A2_TOP(t);     A2_STEP(pA0, pA1, pB0, pB1, t, true);
    A2_TOP(t + 1); A2_STEP(pB0, pB1, pA0, pA1, t + 1, false);
#undef A2_STEP
#undef A2_TOP
    __builtin_amdgcn_s_setprio(0);
    lsum += __shfl_xor(lsum, 32);
    if (hi == 0) wsf[32 + r32] = lsum;
    LDS_WAIT();
    LAS bf16_t* stg = (LAS bf16_t*)(shm + A2_OST) + wid * 2048;
#pragma unroll
    for (int r = 0; r < 16; ++r) { const int orow = crow(r, hi); const float il = frcp(wsf[32 + orow]);
#pragma unroll
        for (int d0 = 0; d0 < 2; ++d0) stg[orow * 64 + d0 * 32 + r32] = (bf16_t)f2bf(o[d0][r] * il); }
    LDS_WAIT();
    const bf16_t* GB = (const bf16_t*)a.out; const bf16_t* HL = (const bf16_t*)(ws + WS_GR); const bf16_t* AC = (const bf16_t*)(ws + WS_GA); bf16_t* MG = (bf16_t*)(ws + WS_XR);
#pragma unroll
    for (int i = 0; i < 4; ++i) { const int row = i * 8 + (lane >> 3), ch = lane & 7; const u32x4 yv = *(const LAS u32x4*)(stg + row * 64 + ch * 8);
        const size_t go = (size_t)(q0 + wid * 32 + row) * 1024 + h * 64 + ch * 8;
        const u32x4 gb = *(const u32x4*)(GB + go), hl = *(const u32x4*)(HL + go), ac = *(const u32x4*)(AC + go); u32x4 w;
#pragma unroll
        for (int j = 0; j < 4; ++j) { const float c0 = carry[ch * 8 + 2 * j], c1 = carry[ch * 8 + 2 * j + 1];
            w[j] = pk2(lo2f(yv[j]) * lo2f(gb[j]) + lo2f(hl[j]) + lo2f(ac[j]) * c0, hi2f(yv[j]) * hi2f(gb[j]) + hi2f(hl[j]) + hi2f(ac[j]) * c1); }
        *(u32x4*)(MG + go) = w; }
    asm volatile("s_waitcnt vmcnt(0) lgkmcnt(0)\n\ts_barrier" ::: "memory");
#undef A2_DMAK
#undef A2_DMAV
#undef A2_WAITFULL
#undef A2_BAR
}


typedef int v8i __attribute__((ext_vector_type(8)));
constexpr int A4_K = 0, A4_V = 36864, A4_WS = 53248, A4_OST = 55296;
#define A4_PVM(pw_, vf_, acc_) __builtin_amdgcn_mfma_scale_f32_32x32x64_f8f6f4(pw_, vf_, acc_, 0, 0, 0, 0x7f7f7f7f, 0, 0x7f7f7f7f)
#define A4_CV(W, j, P, b) do { int w_ = __builtin_amdgcn_cvt_pk_fp8_f32(P[b], P[(b) + 1], 0, false); W[j] = __builtin_amdgcn_cvt_pk_fp8_f32(P[(b) + 2], P[(b) + 3], w_, true); } while (0)
#define A4_VLD(vf_, d0) do { const u32x4 x0_ = *(const LAS u32x4*)(vp + (d0) * 2048), x1_ = *(const LAS u32x4*)(vp + (d0) * 2048 + 512); \
        vf_ = (v8i){(int)x0_[0], (int)x0_[1], (int)x0_[2], (int)x0_[3], (int)x1_[0], (int)x1_[1], (int)x1_[2], (int)x1_[3]}; } while (0)

__device__ __forceinline__ void attn_unit_v4(int h, int qb, CArgs a, const LAS float* carry, LAS unsigned char* shm) {
    constexpr int ABL = 0;
    const int tid = threadIdx.x, lane = tid & 63, r32 = lane & 31, hi = lane >> 5; const int wid = __builtin_amdgcn_readfirstlane(tid >> 6);
    unsigned char* ws = a.ws;
    const bf16_t* QRAW = (const bf16_t*)(ws + WS_R1); const unsigned char* KI = ws + WS_KIMG + (size_t)h * 256 * 12288; const unsigned char* VI = (const unsigned char*)a.out + 32 * MiB + (size_t)h * 256 * 4096;
    const float* CS = (const float*)(ws + WS_CS); const float* qg = (const float*)a.in[15];
    const int q0 = qb * 256, rowq = q0 + wid * 32 + r32;
    const unsigned lds0 = (unsigned)(uintptr_t)shm;
    LAS float* wsf = (LAS float*)(shm + A4_WS) + wid * 64;
    const int NT = 4 * qb + 4, mylast = 4 * qb + (wid >> 1);
    const unsigned char* ksrc = KI + wid * 1024 + lane * 16; const unsigned char* vsrc = VI + wid * 1024 + lane * 16;
    const unsigned kdst = lds0 + A4_K + wid * 1024, vdst = lds0 + A4_V + wid * 1024;
#define A4_DMAK(t, slot) do { glds16(ksrc + (size_t)(t) * 12288, (unsigned)__builtin_amdgcn_readfirstlane(kdst + (slot) * 12288)); \
        if (wid < 4) glds16(ksrc + (size_t)(t) * 12288 + 8192, (unsigned)__builtin_amdgcn_readfirstlane(kdst + (slot) * 12288 + 8192)); } while (0)
#define A4_DMAV(t, slot) do { if (wid < 4) glds16(vsrc + (size_t)(t) * 4096, (unsigned)__builtin_amdgcn_readfirstlane(vdst + (slot) * 4096)); } while (0)
#define A4_BAR() asm volatile("s_waitcnt lgkmcnt(0)\n\ts_barrier" ::: "memory")
    bf16x8 qr[6];
    {
        const bf16_t* qp = QRAW + (size_t)rowq * 1536 + h * 96 + hi * 8;
        u32x4 raw[6]; float qv[6][8]; float ss = 0.f;
#pragma unroll
        for (int d0 = 0; d0 < 6; ++d0) raw[d0] = *(const u32x4*)(qp + d0 * 16);
        A4_DMAK(0, 0); A4_DMAV(0, 0); A4_DMAK(1, 1); A4_DMAV(1, 1); A4_DMAK(2, 2);
#pragma unroll
        for (int d0 = 0; d0 < 6; ++d0)
#pragma unroll
            for (int j = 0; j < 4; ++j) { qv[d0][2 * j] = lo2f(raw[d0][j]); qv[d0][2 * j + 1] = hi2f(raw[d0][j]); ss += qv[d0][2 * j] * qv[d0][2 * j] + qv[d0][2 * j + 1] * qv[d0][2 * j + 1]; }
        ss += __shfl_xor(ss, 32);
        const float rs = rsqrtf(ss * (1.f / 96.f) + EPS);
#pragma unroll
        for (int d0 = 0; d0 < 6; ++d0) { const f32x4 g0 = *(const f32x4*)(qg + d0 * 16 + hi * 8), g1 = *(const f32x4*)(qg + d0 * 16 + hi * 8 + 4);
#pragma unroll
            for (int j = 0; j < 4; ++j) { qv[d0][j] *= rs * g0[j]; qv[d0][4 + j] *= rs * g1[j]; } }
        const f32x4 c0 = *(const f32x4*)(CS + (size_t)rowq * 32 + hi * 8), c1 = *(const f32x4*)(CS + (size_t)rowq * 32 + hi * 8 + 4), s0 = *(const f32x4*)(CS + (size_t)rowq * 32 + 16 + hi * 8), s1 = *(const f32x4*)(CS + (size_t)rowq * 32 + 16 + hi * 8 + 4);
#pragma unroll
        for (int j = 0; j < 8; ++j) { const float cs = j < 4 ? c0[j & 3] : c1[j & 3], sn = j < 4 ? s0[j & 3] : s1[j & 3]; const float x1 = qv[4][j], x2 = qv[5][j]; qv[4][j] = x1 * cs - x2 * sn; qv[5][j] = x1 * sn + x2 * cs; }
#pragma unroll
        for (int d0 = 0; d0 < 6; ++d0) { u32x4 w;
#pragma unroll
            for (int j = 0; j < 4; ++j) w[j] = pk2(qv[d0][2 * j] * C2, qv[d0][2 * j + 1] * C2);
            qr[d0] = __builtin_bit_cast(bf16x8, w); }
    }
    if (wid >= 4) __builtin_amdgcn_s_setprio(1);
    float lsum = 0.f; f32x16 o[2]; o[0] = f32x16{}; o[1] = f32x16{};
    f32x16 pA0, pA1, pB0, pB1, negm; v8i pwo = (v8i){0, 0, 0, 0, 0, 0, 0, 0};
    if (wid < 4) asm volatile("s_waitcnt vmcnt(6)" ::: "memory"); else asm volatile("s_waitcnt vmcnt(2)" ::: "memory");
    A4_BAR();
    {
        const LAS unsigned char* kp = shm + A4_K + hi * 1024 + r32 * 16;
        pA0 = f32x16{}; pA1 = f32x16{};
#pragma unroll
        for (int d0 = 0; d0 < 6; ++d0) { pA0 = A2_MF(A2_KF(d0, 0), qr[d0], pA0); pA1 = A2_MF(A2_KF(d0, 1), qr[d0], pA1); }
        float rm = fmaxf(pA0[0], pA1[0]);
#pragma unroll
        for (int r = 1; r < 16; ++r) rm = fmaxf(rm, fmaxf(pA0[r], pA1[r]));
        rm = fmaxf(rm, __shfl_xor(rm, 32));
        const float nb = 64.f - rm;
#pragma unroll
        for (int r = 0; r < 16; ++r) { pA0[r] += nb; pA1[r] += nb; negm[r] = nb; }
        asm volatile("" : "+v"(negm));
    }
    int sk_next = 12288, sv_prev = 12288;
#define A4_STEP(C0, C1, N0, N1, t, HASN, HASP) do { \
        const LAS unsigned char* kp = shm + A4_K + sk_next + hi * 1024 + r32 * 16; const LAS unsigned char* vp = shm + A4_V + sv_prev + hi * 1024 + r32 * 16; \
        bf16x8 k0, k1, k2; v8i vfa, vfb, pwn; float sacc = 0.f; \
        A2_SB(); \
        if (HASN) { k0 = A2_KF(0, 0); k1 = A2_KF(0, 1); k2 = A2_KF(1, 0); if (HASP) A4_VLD(vfa, 0); A2_SB(); \
            N0 = A2_MF(k0, qr[0], negm); k0 = A2_KF(1, 1); A3E3(C0, 0);  A2_PIN(C0); A2_SB(); \
            N1 = A2_MF(k1, qr[0], negm); k1 = A2_KF(2, 0); A3E3(C0, 3);  A2_PIN(C0); A2_SB(); \
            N0 = A2_MF(k2, qr[1], N0);   k2 = A2_KF(2, 1); A3E3(C0, 6);  A2_PIN(C0); A2_SB(); \
            N1 = A2_MF(k0, qr[1], N1);   k0 = A2_KF(3, 0); A3E3(C0, 9);  A2_PIN(C0); A2_SB(); \
            if (HASP) { o[0] = A4_PVM(pwo, vfa, o[0]); A4_VLD(vfb, 1); } A4_CV(pwn, 0, C0, 0); A4_CV(pwn, 1, C0, 4); A3S4(C0, 0); A3S4(C0, 4); A2_PIN(pwn); A2_PIN(sacc); A2_SB(); \
            N0 = A2_MF(k1, qr[2], N0);   k1 = A2_KF(3, 1); A3E3(C0, 12); A2_PIN(C0); A2_SB(); \
            N1 = A2_MF(k2, qr[2], N1);   k2 = A2_KF(4, 0); C0[15] = fexp2(C0[15]); A3E2(C1, 0); A2_PIN(C0); A2_PIN(C1); A2_SB(); \
            N0 = A2_MF(k0, qr[3], N0);   k0 = A2_KF(4, 1); A3E3(C1, 2);  A2_PIN(C1); A2_SB(); \
            N1 = A2_MF(k1, qr[3], N1);   k1 = A2_KF(5, 0); A3E3(C1, 5);  A2_PIN(C1); A2_SB(); \
            if (HASP) { o[1] = A4_PVM(pwo, vfb, o[1]); } A4_CV(pwn, 2, C0, 8); A4_CV(pwn, 3, C0, 12); A4_CV(pwn, 4, C1, 0); A4_CV(pwn, 5, C1, 4); A3S4(C0, 8); A3S4(C0, 12); A3S4(C1, 0); A3S4(C1, 4); A2_PIN(pwn); A2_PIN(sacc); A2_SB(); \
            N0 = A2_MF(k2, qr[4], N0);   k2 = A2_KF(5, 1); A3E3(C1, 8);  A2_PIN(C1); A2_SB(); \
            N1 = A2_MF(k0, qr[4], N1);                      A3E3(C1, 11); A2_PIN(C1); A2_SB(); \
            N0 = A2_MF(k1, qr[5], N0);                      A3E2(C1, 14); A4_CV(pwn, 6, C1, 8); A3S4(C1, 8); A2_PIN(C1); A2_PIN(pwn); A2_PIN(sacc); A2_SB(); \
            N1 = A2_MF(k2, qr[5], N1);                      A4_CV(pwn, 7, C1, 12); A3S4(C1, 12); A2_PIN(pwn); A2_PIN(sacc); A2_SB(); \
        } else { \
            if (HASP) { A4_VLD(vfa, 0); A4_VLD(vfb, 1); } \
            _Pragma("unroll") for (int r_ = 0; r_ < 16; ++r_) { C0[r_] = fexp2(C0[r_]); C1[r_] = fexp2(C1[r_]); } \
            if (HASP) { o[0] = A4_PVM(pwo, vfa, o[0]); o[1] = A4_PVM(pwo, vfb, o[1]); } \
            A4_CV(pwn, 0, C0, 0); A4_CV(pwn, 1, C0, 4); A4_CV(pwn, 2, C0, 8); A4_CV(pwn, 3, C0, 12); A4_CV(pwn, 4, C1, 0); A4_CV(pwn, 5, C1, 4); A4_CV(pwn, 6, C1, 8); A4_CV(pwn, 7, C1, 12); \
            A3S4(C0, 0); A3S4(C0, 4); A3S4(C0, 8); A3S4(C0, 12); A3S4(C1, 0); A3S4(C1, 4); A3S4(C1, 8); A3S4(C1, 12); A2_SB(); \
        } \
        if ((t) > mylast) { pwn = (v8i){0, 0, 0, 0, 0, 0, 0, 0}; sacc = 0.f; } \
        pwo = pwn; lsum += sacc; \
        sk_next = (sk_next == 24576) ? 0 : sk_next + 12288; sv_prev = (sv_prev == 12288) ? 0 : sv_prev + 4096; \
    } while (0)
#define A3E3(P, b) do { P[b] = fexp2(P[b]); P[(b) + 1] = fexp2(P[(b) + 1]); P[(b) + 2] = fexp2(P[(b) + 2]); } while (0)
#define A3E2(P, b) do { P[b] = fexp2(P[b]); P[(b) + 1] = fexp2(P[(b) + 1]); } while (0)
#define A3S4(P, b) do { sacc += P[b]; sacc += P[(b) + 1]; sacc += P[(b) + 2]; sacc += P[(b) + 3]; } while (0)
#define A4_TOP(t) do { const int t_ = (t); \
        if (t_ - 1 <= NT - 4) { if (wid < 4) asm volatile("s_waitcnt vmcnt(3)" ::: "memory"); else asm volatile("s_waitcnt vmcnt(1)" ::: "memory"); } \
        else if (t_ - 1 == NT - 3 && wid < 4) { asm volatile("s_waitcnt vmcnt(1)" ::: "memory"); } else { asm volatile("s_waitcnt vmcnt(0)" ::: "memory"); } \
        A4_BAR(); if (t_ + 3 < NT) { glds16(kg3, (unsigned)__builtin_amdgcn_readfirstlane(kdst + dk)); if (wid < 4) glds16(kg3 + 8192, (unsigned)__builtin_amdgcn_readfirstlane(kdst + dk + 8192)); } \
        if (t_ + 2 < NT && wid < 4) glds16(vg2, (unsigned)__builtin_amdgcn_readfirstlane(vdst + dv)); \
        kg3 += 12288; vg2 += 4096; dk = (dk == 24576u) ? 0u : dk + 12288u; dv = (dv == 12288u) ? 0u : dv + 4096u; } while (0)
    const unsigned char* kg3 = ksrc + 3 * 12288; const unsigned char* vg2 = vsrc + 2 * 4096; unsigned dk = 0u, dv = 8192u;
    A4_TOP(0); A4_STEP(pA0, pA1, pB0, pB1, 0, true, false);
    A4_TOP(1); A4_STEP(pB0, pB1, pA0, pA1, 1, true, true);
    int t = 2;
    for (; t + 2 < NT; t += 2) {
        A4_TOP(t);     A4_STEP(pA0, pA1, pB0, pB1, t, true, true);
        A4_TOP(t + 1); A4_STEP(pB0, pB1, pA0, pA1, t + 1, true, true);
    }
    A4_TOP(t);     A4_STEP(pA0, pA1, pB0, pB1, t, true, true);
    A4_TOP(t + 1); A4_STEP(pB0, pB1, pA0, pA1, t + 1, false, true);
    {
        const LAS unsigned char* vp = shm + A4_V + sv_prev + hi * 1024 + r32 * 16; v8i vfa, vfb;
        A4_VLD(vfa, 0); A4_VLD(vfb, 1); o[0] = A4_PVM(pwo, vfa, o[0]); o[1] = A4_PVM(pwo, vfb, o[1]);
    }
#undef A4_STEP
#undef A4_TOP
#undef A3E3
#undef A3E2
#undef A3S4
    __builtin_amdgcn_s_setprio(0);
    lsum += __shfl_xor(lsum, 32);
    if (hi == 0) wsf[32 + r32] = lsum;
    LDS_WAIT();
    LAS bf16_t* stg = (LAS bf16_t*)(shm + A4_OST) + wid * 2048;
#pragma unroll
    for (int r = 0; r < 16; ++r) { const int orow = crow(r, hi); const float il = frcp(wsf[32 + orow]);
#pragma unroll
        for (int d0 = 0; d0 < 2; ++d0) stg[orow * 64 + d0 * 32 + r32] = (bf16_t)f2bf(o[d0][r] * il); }
    LDS_WAIT();
    const bf16_t* GB = (const bf16_t*)a.out; const bf16_t* HL = (const bf16_t*)(ws + WS_GR); const bf16_t* AC = (const bf16_t*)(ws + WS_GA); bf16_t* MG = (bf16_t*)(ws + WS_XR);
#pragma unroll
    for (int i = 0; i < 4; ++i) { const int row = i * 8 + (lane >> 3), ch = lane & 7; const u32x4 yv = *(const LAS u32x4*)(stg + row * 64 + ch * 8);
        const size_t go = (size_t)(q0 + wid * 32 + row) * 1024 + h * 64 + ch * 8;
        const u32x4 gb = *(const u32x4*)(GB + go), hl = *(const u32x4*)(HL + go), ac = *(const u32x4*)(AC + go); u32x4 w;
#pragma unroll
        for (int j = 0; j < 4; ++j) { const float c0 = carry[ch * 8 + 2 * j], c1 = carry[ch * 8 + 2 * j + 1];
            w[j] = pk2(lo2f(yv[j]) * lo2f(gb[j]) + lo2f(hl[j]) + lo2f(ac[j]) * c0, hi2f(yv[j]) * hi2f(gb[j]) + hi2f(hl[j]) + hi2f(ac[j]) * c1); }
        *(u32x4*)(MG + go) = w; }
    asm volatile("s_waitcnt vmcnt(0) lgkmcnt(0)\n\ts_barrier" ::: "memory");
#undef A4_DMAK
#undef A4_DMAV
#undef A4_BAR
}


constexpr int A5_K = 0, A5_V = 24576, A5_WS = 40960, A5_OST = 43008;
#define A5_QKM(k8_, q8_, c_) __builtin_amdgcn_mfma_scale_f32_32x32x64_f8f6f4(k8_, q8_, c_, 0, 0, 0, 0x7f7f7f7f, 0, 0x7f7f7f7f)
#define A5_K8(kf_, kb) do { const u32x4 x0_ = *(const LAS u32x4*)(kp + (kb) * 2048), x1_ = *(const LAS u32x4*)(kp + (kb) * 2048 + 512); \
        kf_ = (v8i){(int)x0_[0], (int)x0_[1], (int)x0_[2], (int)x0_[3], (int)x1_[0], (int)x1_[1], (int)x1_[2], (int)x1_[3]}; } while (0)
#define A5_KR(d0r, kb) (*(const LAS bf16x8*)(kp + 4096 + (d0r) * 2048 + (kb) * 512))

#ifndef MK_LATEDMA
#define MK_LATEDMA 0
#endif
#ifndef MK_KD
#define MK_KD 2
#endif
#ifndef MK_VD
#define MK_VD 1
#endif
template <int ABL> __device__ __forceinline__ void attn_unit_v5(int h, int qb, CArgs a, const LAS float* carry, LAS unsigned char* shm) {
    int tid = threadIdx.x; asm volatile("" : "+v"(tid));
    const int lane = tid & 63, r32 = lane & 31, hi = lane >> 5; const int wid = __builtin_amdgcn_readfirstlane(tid >> 6);
    unsigned char* ws = a.ws;
    const bf16_t* QRAW = (const bf16_t*)(ws + WS_R1); const unsigned char* KI = ws + WS_KIMG + (size_t)h * 256 * 8192; const unsigned char* VI = (const unsigned char*)a.out + 32 * MiB + (size_t)h * 256 * 4096;
    const float* CS = (const float*)(ws + WS_CS); const float* qg = (const float*)a.in[15];
    const int q0 = qb * 256, rowq = q0 + wid * 32 + r32;
    const unsigned lds0 = (unsigned)(uintptr_t)shm;
    const int NT = 4 * qb + 4, mylast = 4 * qb + (wid >> 1);
    const unsigned char* ksrc = KI + wid * 1024 + lane * 16; const unsigned char* vsrc = VI + wid * 1024 + lane * 16;
    constexpr int KD = MK_KD, VD = MK_VD, A5_K = 0, A5_V = KD * 8192, A5_WS = A5_V + (VD + 2) * 4096, A5_OST = A5_WS + 2048;
    const unsigned kdst = lds0 + A5_K + wid * 1024, vdst = lds0 + A5_V + wid * 1024;
#define A5_DMAK(t, slot) glds16(ksrc + (size_t)(t) * 8192, (unsigned)__builtin_amdgcn_readfirstlane(kdst + (slot) * 8192))
#define A5_DMAV(t, slot) do { if (wid < 4) glds16(vsrc + (size_t)(t) * 4096, (unsigned)__builtin_amdgcn_readfirstlane(vdst + (slot) * 4096)); } while (0)
#define A5_BAR() asm volatile("s_waitcnt lgkmcnt(0)\n\ts_barrier" ::: "memory")
#define A5_VMW(n_) do { const int vw_ = (n_); if (vw_ >= 7) asm volatile("s_waitcnt vmcnt(7)" ::: "memory"); else if (vw_ == 6) asm volatile("s_waitcnt vmcnt(6)" ::: "memory"); else if (vw_ == 5) asm volatile("s_waitcnt vmcnt(5)" ::: "memory"); else if (vw_ == 4) asm volatile("s_waitcnt vmcnt(4)" ::: "memory"); \
        else if (vw_ == 3) asm volatile("s_waitcnt vmcnt(3)" ::: "memory"); else if (vw_ == 2) asm volatile("s_waitcnt vmcnt(2)" ::: "memory"); else if (vw_ == 1) asm volatile("s_waitcnt vmcnt(1)" ::: "memory"); else asm volatile("s_waitcnt vmcnt(0)" ::: "memory"); } while (0)
    v8i q8; bf16x8 qr4, qr5;
    {
        const bf16_t* qp = QRAW + (size_t)rowq * 1536 + h * 96;
        u32x4 rawn[4], rawr[2]; float qn[32], qv4[8], qv5[8]; float ss = 0.f;
#pragma unroll
        for (int i = 0; i < 4; ++i) rawn[i] = *(const u32x4*)(qp + 32 * hi + 8 * i);
        rawr[0] = *(const u32x4*)(qp + 64 + 8 * hi); rawr[1] = *(const u32x4*)(qp + 80 + 8 * hi);
        f32x4 gq[8];
#pragma unroll
        for (int i = 0; i < 8; ++i) gq[i] = *(const f32x4*)(qg + 32 * hi + 4 * i);
        const f32x4 g0 = *(const f32x4*)(qg + 64 + hi * 8), g1 = *(const f32x4*)(qg + 64 + hi * 8 + 4), g2 = *(const f32x4*)(qg + 80 + hi * 8), g3 = *(const f32x4*)(qg + 80 + hi * 8 + 4);
        const f32x4 c0 = *(const f32x4*)(CS + (size_t)rowq * 32 + hi * 8), c1 = *(const f32x4*)(CS + (size_t)rowq * 32 + hi * 8 + 4), s0 = *(const f32x4*)(CS + (size_t)rowq * 32 + 16 + hi * 8), s1 = *(const f32x4*)(CS + (size_t)rowq * 32 + 16 + hi * 8 + 4);
#pragma unroll
        for (int tp = -KD; tp < 0; ++tp) { A5_DMAK(tp + KD, tp + KD); if (tp + VD >= 0) A5_DMAV(tp + VD, tp + VD); }
#pragma unroll
        for (int i = 0; i < 4; ++i)
#pragma unroll
            for (int j = 0; j < 4; ++j) { qn[8 * i + 2 * j] = lo2f(rawn[i][j]); qn[8 * i + 2 * j + 1] = hi2f(rawn[i][j]); }
#pragma unroll
        for (int j = 0; j < 4; ++j) { qv4[2 * j] = lo2f(rawr[0][j]); qv4[2 * j + 1] = hi2f(rawr[0][j]); qv5[2 * j] = lo2f(rawr[1][j]); qv5[2 * j + 1] = hi2f(rawr[1][j]); }
#pragma unroll
        for (int j = 0; j < 32; ++j) ss += qn[j] * qn[j];
#pragma unroll
        for (int j = 0; j < 8; ++j) ss += qv4[j] * qv4[j] + qv5[j] * qv5[j];
        ss += __shfl_xor(ss, 32);
        const float rs = rsqrtf(ss * (1.f / 96.f) + EPS);
#pragma unroll
        for (int i = 0; i < 8; ++i) { const f32x4 g = gq[i];
#pragma unroll
            for (int e = 0; e < 4; ++e) qn[4 * i + e] *= rs * g[e] * 1.1779544f; }
        {
#pragma unroll
          for (int j = 0; j < 4; ++j) { qv4[j] *= rs * g0[j]; qv4[4 + j] *= rs * g1[j]; qv5[j] *= rs * g2[j]; qv5[4 + j] *= rs * g3[j]; } }
#pragma unroll
        for (int j = 0; j < 8; ++j) { const float cs = j < 4 ? c0[j & 3] : c1[j & 3], sn = j < 4 ? s0[j & 3] : s1[j & 3]; const float x1 = qv4[j], x2 = qv5[j]; qv4[j] = x1 * cs - x2 * sn; qv5[j] = x1 * sn + x2 * cs; }
#pragma unroll
        for (int v = 0; v < 8; ++v) { const int w_ = __builtin_amdgcn_cvt_pk_fp8_f32(qn[4 * v], qn[4 * v + 1], 0, false); q8[v] = __builtin_amdgcn_cvt_pk_fp8_f32(qn[4 * v + 2], qn[4 * v + 3], w_, true); }
        u32x4 w4, w5;
#pragma unroll
        for (int j = 0; j < 4; ++j) { w4[j] = pk2(qv4[2 * j] * (8.f * C2), qv4[2 * j + 1] * (8.f * C2)); w5[j] = pk2(qv5[2 * j] * (8.f * C2), qv5[2 * j + 1] * (8.f * C2)); }
        qr4 = __builtin_bit_cast(bf16x8, w4); qr5 = __builtin_bit_cast(bf16x8, w5);
    }
    if (wid >= 4) __builtin_amdgcn_s_setprio(1);
    f32x16 o[2]; o[0] = f32x16{}; o[1] = f32x16{}; f32x4 lsum = {0.f, 0.f, 0.f, 0.f};
    f32x16 pA0, pA1, pB0, pB1, negm; v8i pwo = (v8i){0, 0, 0, 0, 0, 0, 0, 0};
    int onev = ((((lane >> 4) & 1) != 0) == ((lane & 15) >= 8)) ? 0x38383838 : 0; asm volatile("" : "+v"(onev));
    const v8i ones8 = (v8i){onev, onev, onev, onev, onev, onev, onev, onev};
#define A5_SUM(pw_) lsum = __builtin_amdgcn_mfma_scale_f32_16x16x128_f8f6f4(pw_, ones8, lsum, 0, 0, 0, 0x7f7f7f7f, 0, 0x7f7f7f7f)
    A5_VMW((KD - 1) + (wid < 4 ? VD : 0));
    A5_BAR();
    {
        const LAS unsigned char* kp = shm + A5_K + hi * 1024 + r32 * 16; v8i ka, kb8;
        A5_K8(ka, 0); A5_K8(kb8, 1);
        pA0 = A5_QKM(ka, q8, (f32x16{})); pA1 = A5_QKM(kb8, q8, (f32x16{}));
        pA0 = A2_MF(A5_KR(0, 0), qr4, pA0); pA1 = A2_MF(A5_KR(0, 1), qr4, pA1); pA0 = A2_MF(A5_KR(1, 0), qr5, pA0); pA1 = A2_MF(A5_KR(1, 1), qr5, pA1);
        float rm = fmaxf(pA0[0], pA1[0]);
#pragma unroll
        for (int r = 1; r < 16; ++r) rm = fmaxf(rm, fmaxf(pA0[r], pA1[r]));
        rm = fmaxf(rm, __shfl_xor(rm, 32));
        const float nb = 64.f - rm;
#pragma unroll
        for (int r = 0; r < 16; ++r) { pA0[r] += nb; pA1[r] += nb; negm[r] = nb; }
        asm volatile("" : "+v"(negm));
    }
    int sk_next = 8192, sv_prev = (VD + 1) * 4096;
#define A5_CVU(W, j, P, b) do { if (ABL == 4) { W[j] = pwo[j]; break; } unsigned w_ = __builtin_amdgcn_cvt_pk_u8_f32(P[b], 0, 0u); w_ = __builtin_amdgcn_cvt_pk_u8_f32(P[(b) + 1], 1, w_); w_ = __builtin_amdgcn_cvt_pk_u8_f32(P[(b) + 2], 2, w_); W[j] = (int)__builtin_amdgcn_cvt_pk_u8_f32(P[(b) + 3], 3, w_); } while (0)
#define A5_STEP(C0, C1, N0, N1, t, HASN, HASP) do { \
        const LAS unsigned char* kp = shm + A5_K + sk_next + hi * 1024 + r32 * 16; const LAS unsigned char* vp = shm + A5_V + sv_prev + hi * 1024 + r32 * 16; \
        v8i ka, kb8, vfa, vfb, pwn; bf16x8 r0, r1, r2, r3; \
        A2_SB(); \
        if (HASN) { A5_K8(ka, 0); A5_K8(kb8, 1); r0 = A5_KR(0, 0); r1 = A5_KR(0, 1); A2_SB(); \
            N0 = A5_QKM(ka, q8, negm);  r2 = A5_KR(1, 0); r3 = A5_KR(1, 1); if (HASP) A4_VLD(vfa, 0); A5_CVU(pwn, 0, C0, 0); A5_CVU(pwn, 1, C0, 4); A2_PIN(pwn); A2_SB(); \
            N1 = A5_QKM(kb8, q8, negm); if (HASP) A4_VLD(vfb, 1); if (MK_LATEDMA) A5_ISSUEK(t); A5_CVU(pwn, 2, C0, 8); A5_CVU(pwn, 3, C0, 12); A2_PIN(pwn); A2_SB(); \
            if (ABL != 5) N0 = A2_MF(r0, qr4, N0); A5_CVU(pwn, 4, C1, 0); A2_PIN(pwn); A2_SB(); \
            if (ABL != 5) N1 = A2_MF(r1, qr4, N1); A5_CVU(pwn, 5, C1, 4); A2_PIN(pwn); A2_SB(); \
            if (HASP) { o[0] = A4_PVM(pwo, vfa, o[0]); } if (MK_LATEDMA) A5_ISSUEV(t); A5_CVU(pwn, 6, C1, 8); A5_CVU(pwn, 7, C1, 12); A2_PIN(pwn); A2_SB(); \
            if (ABL != 5) N0 = A2_MF(r2, qr5, N0); A2_SB(); \
            if (ABL != 5) N1 = A2_MF(r3, qr5, N1); A2_SB(); \
            if (HASP) { o[1] = A4_PVM(pwo, vfb, o[1]); } A2_SB(); \
            if (HASP && ABL != 2) { A5_SUM(pwo); } A2_SB(); \
        } else { \
            if (HASP) { A4_VLD(vfa, 0); A4_VLD(vfb, 1); } \
            A5_CVU(pwn, 0, C0, 0); A5_CVU(pwn, 1, C0, 4); A5_CVU(pwn, 2, C0, 8); A5_CVU(pwn, 3, C0, 12); A5_CVU(pwn, 4, C1, 0); A5_CVU(pwn, 5, C1, 4); A5_CVU(pwn, 6, C1, 8); A5_CVU(pwn, 7, C1, 12); \
            if (HASP) { o[0] = A4_PVM(pwo, vfa, o[0]); o[1] = A4_PVM(pwo, vfb, o[1]); A5_SUM(pwo); } A2_SB(); \
        } \
        if ((t) > mylast) { pwn = (v8i){0, 0, 0, 0, 0, 0, 0, 0}; } \
        pwo = pwn; \
        sk_next = (sk_next == (KD - 1) * 8192) ? 0 : sk_next + 8192; sv_prev = (sv_prev == (VD + 1) * 4096) ? 0 : sv_prev + 4096; \
    } while (0)
#define A5_TOP(t) do { const int t_ = (t); int c_ = 0; \
        _Pragma("unroll") for (int b_ = 1; b_ <= KD - 2; ++b_) { c_ += (t_ - b_ + KD < NT) ? 1 : 0; if (wid < 4) c_ += (t_ - b_ + VD < NT) ? 1 : 0; } \
        A5_VMW(c_); \
        if (ABL != 3) A5_BAR(); if (!MK_LATEDMA) { A5_ISSUEK(t_); A5_ISSUEV(t_); } } while (0)
#define A5_ISSUEK(t_) do { if ((t_) + KD < NT) glds16(kg3, (unsigned)__builtin_amdgcn_readfirstlane(kdst + dk)); kg3 += 8192; dk = (dk == (KD - 1) * 8192u) ? 0u : dk + 8192u; } while (0)
#define A5_ISSUEV(t_) do { if ((t_) + VD < NT && wid < 4) glds16(vg2, (unsigned)__builtin_amdgcn_readfirstlane(vdst + dv)); vg2 += 4096; dv = (dv == (VD + 1) * 4096u) ? 0u : dv + 4096u; } while (0)
    const unsigned char* kg3 = ksrc + KD * 8192; const unsigned char* vg2 = vsrc + VD * 4096; unsigned dk = 0u, dv = VD * 4096u;
    A5_TOP(0); A5_STEP(pA0, pA1, pB0, pB1, 0, true, false);
    A5_TOP(1); A5_STEP(pB0, pB1, pA0, pA1, 1, true, true);
    int t = 2;
    for (; t + 2 < NT; t += 2) {
        A5_TOP(t);     A5_STEP(pA0, pA1, pB0, pB1, t, true, true);
        A5_TOP(t + 1); A5_STEP(pB0, pB1, pA0, pA1, t + 1, true, true);
    }
    A5_TOP(t);     A5_STEP(pA0, pA1, pB0, pB1, t, true, true);
    A5_TOP(t + 1); A5_STEP(pB0, pB1, pA0, pA1, t + 1, false, true);
    {
        const LAS unsigned char* vp = shm + A5_V + sv_prev + hi * 1024 + r32 * 16; v8i vfa, vfb;
        A4_VLD(vfa, 0); A4_VLD(vfb, 1); o[0] = A4_PVM(pwo, vfa, o[0]); o[1] = A4_PVM(pwo, vfb, o[1]); A5_SUM(pwo);
    }
#undef A5_STEP
#undef A5_TOP
#undef A5_ISSUEK
#undef A5_ISSUEV
#undef A5_CVU
#undef A5_SUM
    __builtin_amdgcn_s_setprio(0);
    LAS float* sums = (LAS float*)(shm + A5_WS) + wid * 64;
    if ((lane & 7) == 0) *(LAS f32x4*)(sums + ((lane & 8) ? 16 : 0) + 4 * (lane >> 4)) = lsum;
    LDS_WAIT();
    f32x4 ls4[4];
#pragma unroll
    for (int g = 0; g < 4; ++g) ls4[g] = *(const LAS f32x4*)(sums + 8 * g + 4 * hi);
    LAS bf16_t* stg = (LAS bf16_t*)(shm + A5_OST) + wid * 2048;
#pragma unroll
    for (int r = 0; r < 16; ++r) { const int orow = crow(r, hi); const float il = frcp(ls4[r >> 2][r & 3]);
#pragma unroll
        for (int d0 = 0; d0 < 2; ++d0) stg[orow * 64 + d0 * 32 + r32] = (bf16_t)f2bf(o[d0][r] * il); }
    LDS_WAIT();
    const bf16_t* GB = (const bf16_t*)a.out; const bf16_t* HL = (const bf16_t*)(ws + WS_GR); const bf16_t* AC = (const bf16_t*)(ws + WS_GA); bf16_t* MG = (bf16_t*)(ws + WS_XR);
#pragma unroll
    for (int i = 0; i < 4; ++i) { const int row = i * 8 + (lane >> 3), ch = lane & 7; const u32x4 yv = *(const LAS u32x4*)(stg + row * 64 + ch * 8);
        const size_t go = (size_t)(q0 + wid * 32 + row) * 1024 + h * 64 + ch * 8;
        const u32x4 gb = *(const u32x4*)(GB + go), hl = *(const u32x4*)(HL + go), ac = *(const u32x4*)(AC + go); u32x4 w;
#pragma unroll
        for (int j = 0; j < 4; ++j) { const float c0 = carry[ch * 8 + 2 * j], c1 = carry[ch * 8 + 2 * j + 1];
            w[j] = pk2(lo2f(yv[j]) * lo2f(gb[j]) + lo2f(hl[j]) + lo2f(ac[j]) * c0, hi2f(yv[j]) * hi2f(gb[j]) + hi2f(hl[j]) + hi2f(ac[j]) * c1); }
        *(u32x4*)(MG + go) = w; }
    asm volatile("s_waitcnt vmcnt(0) lgkmcnt(0)\n\ts_barrier" ::: "memory");
#undef A5_DMAK
#undef A5_DMAV
#undef A5_BAR
#undef A5_VMW
}

#ifndef MK_V7
#define MK_V7 1
#endif
#ifndef MK_PFVD
#define MK_PFVD 1
#endif
#ifndef MK_PF
#define MK_PF 0
#endif
#ifndef MK_PRIO
#define MK_PRIO 1
#endif
#ifndef MK_VW
#define MK_VW 0
#endif
#ifndef MK_PVF
#define MK_PVF 0
#endif
template <int ABL> __device__ __forceinline__ void attn_block_v7(int h, int s_, CArgs a, const LAS float* carry4, LAS unsigned char* shm) {
    int tid = threadIdx.x; asm volatile("" : "+v"(tid));
    const int lane0 = tid & 63; const int wid = __builtin_amdgcn_readfirstlane(tid >> 6);
    unsigned char* ws = a.ws;
    const bf16_t* QRAW = (const bf16_t*)(ws + WS_R1); const unsigned char* KI = ws + WS_KIMG + (size_t)h * 256 * 8192; const unsigned char* VI = (const unsigned char*)a.out + 32 * MiB + (size_t)h * 256 * 4096;
    const float* CS = (const float*)(ws + WS_CS); const float* qg = (const float*)a.in[15];
    const unsigned lds0 = (unsigned)(uintptr_t)shm; const bool vwave = MK_VW ? (wid >= 4) : (wid < 4); const int wv = wid & 3;
    constexpr int KD = MK_PF ? 3 : MK_KD, VD = MK_PF ? MK_PFVD : MK_VD, A5_K = 0, A5_V = KD * 8192, A5_WS = A5_V + (VD + 2) * 4096, A5_OST = A5_WS + 2048, A5_G = A5_OST + 8 * 4096;
    const unsigned kdst = lds0 + A5_K + wid * 1024, vdst = lds0 + A5_V + wv * 1024;
#define A5_DMAK(t, slot) glds16(ksrc_ + (size_t)(t) * 8192, (unsigned)__builtin_amdgcn_readfirstlane(kdst + (slot) * 8192))
#define A5_DMAV(t, slot) do { if (vwave) glds16(vsrc_ + (size_t)(t) * 4096, (unsigned)__builtin_amdgcn_readfirstlane(vdst + (slot) * 4096)); } while (0)
#define A5_BAR() asm volatile("s_waitcnt lgkmcnt(0)\n\ts_barrier" ::: "memory")
#define A5_VMW(n_) do { const int vw_ = (n_); if (vw_ >= 7) asm volatile("s_waitcnt vmcnt(7)" ::: "memory"); else if (vw_ == 6) asm volatile("s_waitcnt vmcnt(6)" ::: "memory"); else if (vw_ == 5) asm volatile("s_waitcnt vmcnt(5)" ::: "memory"); else if (vw_ == 4) asm volatile("s_waitcnt vmcnt(4)" ::: "memory"); \
        else if (vw_ == 3) asm volatile("s_waitcnt vmcnt(3)" ::: "memory"); else if (vw_ == 2) asm volatile("s_waitcnt vmcnt(2)" ::: "memory"); else if (vw_ == 1) asm volatile("s_waitcnt vmcnt(1)" ::: "memory"); else asm volatile("s_waitcnt vmcnt(0)" ::: "memory"); } while (0)
    LAS float* gl = (LAS float*)(shm + A5_G);
    if (tid < 96) gl[tid] = qg[tid];
    u32x4 rawn[4], rawr[2];
#define A7_LOADQ(qb_, L_) do { const int r32 = (L_) & 31, hi = (L_) >> 5; const unsigned char* ksrc_ = KI + wid * 1024 + (L_) * 16; const unsigned char* vsrc_ = VI + wv * 1024 + (L_) * 16; const int rq_ = (qb_) * 256 + wid * 32 + r32; const bf16_t* qp = QRAW + (size_t)rq_ * 1536 + h * 96; \
        _Pragma("unroll") for (int i_ = 0; i_ < 4; ++i_) rawn[i_] = *(const u32x4*)(qp + 32 * hi + 8 * i_); \
        rawr[0] = *(const u32x4*)(qp + 64 + 8 * hi); rawr[1] = *(const u32x4*)(qp + 80 + 8 * hi); \
        _Pragma("unroll") for (int tp = -KD; tp < 0; ++tp) { A5_DMAK(tp + KD, tp + KD); if (tp + VD >= 0) A5_DMAV(tp + VD, tp + VD); } } while (0)
    A7_LOADQ(s_, lane0);
    A5_BAR();
#pragma unroll 1
    for (int ui = 0; ui < 4; ++ui) {
    int lane = lane0; asm volatile("" : "+v"(lane));
    const int r32 = lane & 31, hi = lane >> 5;
    const unsigned char* ksrc = KI + wid * 1024; const unsigned char* vsrc = VI + wv * 1024; const unsigned loff = (unsigned)lane * 16u;
    int onev = ((((lane >> 4) & 1) != 0) == ((lane & 15) >= 8)) ? 0x38383838 : 0; asm volatile("" : "+v"(onev));
    const v8i ones8 = (v8i){onev, onev, onev, onev, onev, onev, onev, onev};
#define A5_SUM(pw_) lsum = __builtin_amdgcn_mfma_scale_f32_16x16x128_f8f6f4(pw_, ones8, lsum, 0, 0, 0, 0x7f7f7f7f, 0, 0x7f7f7f7f)
    const int qb = ((ui & 2) ? 32 : 0) + ((ui & 1) ? 31 - s_ : s_);
    const int q0 = qb * 256; const int NT = 4 * qb + 4, mylast = 4 * qb + (wid >> 1);
    const LAS float* carry = carry4 + ui * 64;
    v8i q8; bf16x8 qr4, qr5;
    {
        const int rowq = q0 + wid * 32 + r32;
        const f32x4 c0 = *(const f32x4*)(CS + (size_t)rowq * 32 + hi * 8), c1 = *(const f32x4*)(CS + (size_t)rowq * 32 + hi * 8 + 4), s0 = *(const f32x4*)(CS + (size_t)rowq * 32 + 16 + hi * 8), s1 = *(const f32x4*)(CS + (size_t)rowq * 32 + 16 + hi * 8 + 4);
        float qn[32], qv4[8], qv5[8]; float ss = 0.f;
        f32x4 gq[8];
#pragma unroll
        for (int i = 0; i < 8; ++i) gq[i] = *(const LAS f32x4*)(gl + 32 * hi + 4 * i);
        const f32x4 g0 = *(const LAS f32x4*)(gl + 64 + hi * 8), g1 = *(const LAS f32x4*)(gl + 64 + hi * 8 + 4), g2 = *(const LAS f32x4*)(gl + 80 + hi * 8), g3 = *(const LAS f32x4*)(gl + 80 + hi * 8 + 4);
#pragma unroll
        for (int i = 0; i < 4; ++i)
#pragma unroll
            for (int j = 0; j < 4; ++j) { qn[8 * i + 2 * j] = lo2f(rawn[i][j]); qn[8 * i + 2 * j + 1] = hi2f(rawn[i][j]); }
#pragma unroll
        for (int j = 0; j < 4; ++j) { qv4[2 * j] = lo2f(rawr[0][j]); qv4[2 * j + 1] = hi2f(rawr[0][j]); qv5[2 * j] = lo2f(rawr[1][j]); qv5[2 * j + 1] = hi2f(rawr[1][j]); }
#pragma unroll
        for (int j = 0; j < 32; ++j) ss += qn[j] * qn[j];
#pragma unroll
        for (int j = 0; j < 8; ++j) ss += qv4[j] * qv4[j] + qv5[j] * qv5[j];
        ss += __shfl_xor(ss, 32);
        const float rs = rsqrtf(ss * (1.f / 96.f) + EPS);
#pragma unroll
        for (int i = 0; i < 8; ++i) { const f32x4 g = gq[i];
#pragma unroll
            for (int e = 0; e < 4; ++e) qn[4 * i + e] *= rs * g[e] * 1.1779544f; }
        {
#pragma unroll
          for (int j = 0; j < 4; ++j) { qv4[j] *= rs * g0[j]; qv4[4 + j] *= rs * g1[j]; qv5[j] *= rs * g2[j]; qv5[4 + j] *= rs * g3[j]; } }
#pragma unroll
        for (int j = 0; j < 8; ++j) { const float cs = j < 4 ? c0[j & 3] : c1[j & 3], sn = j < 4 ? s0[j & 3] : s1[j & 3]; const float x1 = qv4[j], x2 = qv5[j]; qv4[j] = x1 * cs - x2 * sn; qv5[j] = x1 * sn + x2 * cs; }
#pragma unroll
        for (int v = 0; v < 8; ++v) { const int w_ = __builtin_amdgcn_cvt_pk_fp8_f32(qn[4 * v], qn[4 * v + 1], 0, false); q8[v] = __builtin_amdgcn_cvt_pk_fp8_f32(qn[4 * v + 2], qn[4 * v + 3], w_, true); }
        u32x4 w4, w5;
#pragma unroll
        for (int j = 0; j < 4; ++j) { w4[j] = pk2(qv4[2 * j] * (8.f * C2), qv4[2 * j + 1] * (8.f * C2)); w5[j] = pk2(qv5[2 * j] * (8.f * C2), qv5[2 * j + 1] * (8.f * C2)); }
        qr4 = __builtin_bit_cast(bf16x8, w4); qr5 = __builtin_bit_cast(bf16x8, w5);
    }
    if (MK_PRIO == 1 ? wid >= 4 : MK_PRIO == 2 ? vwave : false) __builtin_amdgcn_s_setprio(1);
    f32x16 o[2]; o[0] = f32x16{}; o[1] = f32x16{}; f32x4 lsum = {0.f, 0.f, 0.f, 0.f};
    f32x16 pA0, pA1, pB0, pB1, negm; v8i pwo = (v8i){0, 0, 0, 0, 0, 0, 0, 0};
    A5_VMW((MK_PF ? KD - 2 : KD - 1) + (vwave ? VD : 0));
    A5_BAR();
    {
        const LAS unsigned char* kp = shm + A5_K + hi * 1024 + r32 * 16; v8i ka, kb8;
        A5_K8(ka, 0); A5_K8(kb8, 1);
        pA0 = A5_QKM(ka, q8, (f32x16{})); pA1 = A5_QKM(kb8, q8, (f32x16{}));
        pA0 = A2_MF(A5_KR(0, 0), qr4, pA0); pA1 = A2_MF(A5_KR(0, 1), qr4, pA1); pA0 = A2_MF(A5_KR(1, 0), qr5, pA0); pA1 = A2_MF(A5_KR(1, 1), qr5, pA1);
        float rm = fmaxf(pA0[0], pA1[0]);
#pragma unroll
        for (int r = 1; r < 16; ++r) rm = fmaxf(rm, fmaxf(pA0[r], pA1[r]));
        rm = fmaxf(rm, __shfl_xor(rm, 32));
        const float nb = 64.f - rm;
#pragma unroll
        for (int r = 0; r < 16; ++r) { pA0[r] += nb; pA1[r] += nb; negm[r] = nb; }
        asm volatile("" : "+v"(negm));
    }
#if MK_PF
    v8i ka;
    { const LAS unsigned char* kp = shm + A5_K + 8192 + hi * 1024 + r32 * 16; A5_K8(ka, 0); }
    int sk_pf = 16384;
#endif
#if MK_PVF
    v8i vfa = q8, vfb = q8; int sv_cur = 0;
#endif
    int sk_next = 8192, sv_prev = (VD + 1) * 4096; v8i kst = q8; bf16x8 rst = qr4; if (ABL == 7) { asm volatile("" : "+v"(kst), "+v"(rst)); }
#define A5_CVU(W, j, P, b) do { if (ABL == 4) { W[j] = pwo[j]; break; } unsigned w_ = __builtin_amdgcn_cvt_pk_u8_f32(P[b], 0, 0u); w_ = __builtin_amdgcn_cvt_pk_u8_f32(P[(b) + 1], 1, w_); w_ = __builtin_amdgcn_cvt_pk_u8_f32(P[(b) + 2], 2, w_); W[j] = (int)__builtin_amdgcn_cvt_pk_u8_f32(P[(b) + 3], 3, w_); } while (0)
#define A5_STEP(C0, C1, N0, N1, t, HASN, HASP, HASN2) do { \
        const LAS unsigned char* kp = shm + A5_K + sk_next + hi * 1024 + r32 * 16; const LAS unsigned char* vp = shm + A5_V + sv_prev + hi * 1024 + r32 * 16; \
        v8i ka = kst, kb8 = kst, vfa = kst, vfb = kst, pwn; bf16x8 r0 = rst, r1 = rst, r2 = rst, r3 = rst; \
        A2_SB(); \
        if (HASN) { if (ABL != 7) { A5_K8(ka, 0); A5_K8(kb8, 1); r0 = A5_KR(0, 0); r1 = A5_KR(0, 1); } A2_SB(); \
            N0 = A5_QKM(ka, q8, negm);  if (ABL != 7) { r2 = A5_KR(1, 0); r3 = A5_KR(1, 1); if (HASP) A4_VLD(vfa, 0); } A5_CVU(pwn, 0, C0, 0); A5_CVU(pwn, 1, C0, 4); A2_PIN(pwn); A2_SB(); \
            N1 = A5_QKM(kb8, q8, negm); if (HASP && ABL != 7) A4_VLD(vfb, 1); if (MK_LATEDMA) A5_ISSUEK(t); A5_CVU(pwn, 2, C0, 8); A5_CVU(pwn, 3, C0, 12); A2_PIN(pwn); A2_SB(); \
            if (ABL != 5) N0 = A2_MF(r0, qr4, N0); A5_CVU(pwn, 4, C1, 0); A2_PIN(pwn); A2_SB(); \
            if (ABL != 5) N1 = A2_MF(r1, qr4, N1); A5_CVU(pwn, 5, C1, 4); A2_PIN(pwn); A2_SB(); \
            if (HASP) { o[0] = A4_PVM(pwo, vfa, o[0]); } if (MK_LATEDMA) A5_ISSUEV(t); A5_CVU(pwn, 6, C1, 8); A5_CVU(pwn, 7, C1, 12); A2_PIN(pwn); A2_SB(); \
            if (ABL != 5) N0 = A2_MF(r2, qr5, N0); A2_SB(); \
            if (ABL != 5) N1 = A2_MF(r3, qr5, N1); A2_SB(); \
            if (HASP) { o[1] = A4_PVM(pwo, vfb, o[1]); } A2_SB(); \
            if (HASP && ABL != 2) { A5_SUM(pwo); } A2_SB(); \
        } else { \
            if (HASP) { A4_VLD(vfa, 0); A4_VLD(vfb, 1); } \
            A5_CVU(pwn, 0, C0, 0); A5_CVU(pwn, 1, C0, 4); A5_CVU(pwn, 2, C0, 8); A5_CVU(pwn, 3, C0, 12); A5_CVU(pwn, 4, C1, 0); A5_CVU(pwn, 5, C1, 4); A5_CVU(pwn, 6, C1, 8); A5_CVU(pwn, 7, C1, 12); \
            if (HASP) { o[0] = A4_PVM(pwo, vfa, o[0]); o[1] = A4_PVM(pwo, vfb, o[1]); A5_SUM(pwo); } A2_SB(); \
        } \
        if ((t) > mylast) { pwn = (v8i){0, 0, 0, 0, 0, 0, 0, 0}; } \
        pwo = pwn; \
        sk_next = (sk_next == (KD - 1) * 8192) ? 0 : sk_next + 8192; sv_prev = (sv_prev == (VD + 1) * 4096) ? 0 : sv_prev + 4096; \
    } while (0)
#if MK_PF
#undef A5_STEP
#define A5_STEP(C0, C1, N0, N1, t, HASN, HASP, HASN2) do { \
        const LAS unsigned char* kp = shm + A5_K + sk_next + hi * 1024 + r32 * 16; const LAS unsigned char* vp = shm + A5_V + sv_prev + hi * 1024 + r32 * 16;        \
        v8i kb8, vfa, vfb, pwn; bf16x8 r0, r1, r2, r3; \
        A2_SB(); \
        if (HASN) { A5_K8(kb8, 1); r0 = A5_KR(0, 0); r1 = A5_KR(0, 1); A2_SB(); \
            N0 = A5_QKM(ka, q8, negm);  r2 = A5_KR(1, 0); r3 = A5_KR(1, 1); if (HASP) A4_VLD(vfa, 0); A5_CVU(pwn, 0, C0, 0); A5_CVU(pwn, 1, C0, 4); A2_PIN(pwn); A2_SB(); \
            N1 = A5_QKM(kb8, q8, negm); if (HASP) A4_VLD(vfb, 1); if (HASN2) { const LAS unsigned char* kp = shm + A5_K + sk_pf + hi * 1024 + r32 * 16; A5_K8(ka, 0); } A5_CVU(pwn, 2, C0, 8); A5_CVU(pwn, 3, C0, 12); A2_PIN(pwn); A2_SB(); \
            N0 = A2_MF(r0, qr4, N0); A5_CVU(pwn, 4, C1, 0); A2_PIN(pwn); A2_SB(); \
            N1 = A2_MF(r1, qr4, N1); A5_CVU(pwn, 5, C1, 4); A2_PIN(pwn); A2_SB(); \
            if (HASP) { o[0] = A4_PVM(pwo, vfa, o[0]); } A5_CVU(pwn, 6, C1, 8); A5_CVU(pwn, 7, C1, 12); A2_PIN(pwn); A2_SB(); \
            N0 = A2_MF(r2, qr5, N0); A2_SB(); \
            N1 = A2_MF(r3, qr5, N1); A2_SB(); \
            if (HASP) { o[1] = A4_PVM(pwo, vfb, o[1]); } A2_SB(); \
            if (HASP) { A5_SUM(pwo); } A2_SB(); \
        } else { \
            if (HASP) { A4_VLD(vfa, 0); A4_VLD(vfb, 1); } \
            A5_CVU(pwn, 0, C0, 0); A5_CVU(pwn, 1, C0, 4); A5_CVU(pwn, 2, C0, 8); A5_CVU(pwn, 3, C0, 12); A5_CVU(pwn, 4, C1, 0); A5_CVU(pwn, 5, C1, 4); A5_CVU(pwn, 6, C1, 8); A5_CVU(pwn, 7, C1, 12); \
            if (HASP) { o[0] = A4_PVM(pwo, vfa, o[0]); o[1] = A4_PVM(pwo, vfb, o[1]); A5_SUM(pwo); } A2_SB(); \
        } \
        if ((t) > mylast) { pwn = (v8i){0, 0, 0, 0, 0, 0, 0, 0}; } \
        pwo = pwn; \
        sk_next = (sk_next == (KD - 1) * 8192) ? 0 : sk_next + 8192; sv_prev = (sv_prev == (VD + 1) * 4096) ? 0 : sv_prev + 4096; sk_pf = (sk_pf == (KD - 1) * 8192) ? 0 : sk_pf + 8192; \
    } while (0)
#endif
#if MK_PVF
#undef A5_STEP
#define A5_STEP(C0, C1, N0, N1, t, HASN, HASP, HASN2) do { \
        const LAS unsigned char* kp = shm + A5_K + sk_next + hi * 1024 + r32 * 16; const LAS unsigned char* vp = shm + A5_V + sv_cur + hi * 1024 + r32 * 16;        \
        v8i ka, kb8, pwn; bf16x8 r0, r1, r2, r3; \
        A2_SB(); \
        if (HASN) { A5_K8(ka, 0); A5_K8(kb8, 1); r0 = A5_KR(0, 0); r1 = A5_KR(0, 1); A2_SB(); \
            if (HASP) { o[0] = A4_PVM(pwo, vfa, o[0]); } r2 = A5_KR(1, 0); r3 = A5_KR(1, 1); A5_CVU(pwn, 0, C0, 0); A5_CVU(pwn, 1, C0, 4); A2_PIN(pwn); A2_SB(); \
            if (HASP) { o[1] = A4_PVM(pwo, vfb, o[1]); } A5_CVU(pwn, 2, C0, 8); A5_CVU(pwn, 3, C0, 12); A2_PIN(pwn); A2_SB(); \
            if (HASP) { A5_SUM(pwo); } A5_CVU(pwn, 4, C1, 0); A2_PIN(pwn); A2_SB(); \
            N0 = A5_QKM(ka, q8, negm);  A4_VLD(vfa, 0); A5_CVU(pwn, 5, C1, 4); A5_CVU(pwn, 6, C1, 8); A2_PIN(pwn); A2_SB(); \
            N1 = A5_QKM(kb8, q8, negm); A4_VLD(vfb, 1); A5_CVU(pwn, 7, C1, 12); A2_PIN(pwn); A2_SB(); \
            N0 = A2_MF(r0, qr4, N0); A2_SB(); \
            N1 = A2_MF(r1, qr4, N1); A2_SB(); \
            N0 = A2_MF(r2, qr5, N0); A2_SB(); \
            N1 = A2_MF(r3, qr5, N1); A2_SB(); \
        } else { \
            A5_CVU(pwn, 0, C0, 0); A5_CVU(pwn, 1, C0, 4); A5_CVU(pwn, 2, C0, 8); A5_CVU(pwn, 3, C0, 12); A5_CVU(pwn, 4, C1, 0); A5_CVU(pwn, 5, C1, 4); A5_CVU(pwn, 6, C1, 8); A5_CVU(pwn, 7, C1, 12); \
            if (HASP) { o[0] = A4_PVM(pwo, vfa, o[0]); o[1] = A4_PVM(pwo, vfb, o[1]); A5_SUM(pwo); } A2_SB(); \
            A4_VLD(vfa, 0); A4_VLD(vfb, 1); A2_SB(); \
        } \
        if ((t) > mylast) { pwn = (v8i){0, 0, 0, 0, 0, 0, 0, 0}; } \
        pwo = pwn; \
        sk_next = (sk_next == (KD - 1) * 8192) ? 0 : sk_next + 8192; sv_cur = (sv_cur == (VD + 1) * 4096) ? 0 : sv_cur + 4096; \
    } while (0)
#endif
#define A5_TOP(t) do { const int t_ = (t); int c_ = 0; \
        if (!MK_PF) { _Pragma("unroll") for (int b_ = 1; b_ <= KD - 2; ++b_) { c_ += (t_ - b_ + KD < NT) ? 1 : 0; if (vwave) c_ += (t_ - b_ + VD < NT) ? 1 : 0; } } \
        A5_VMW(c_); \
        if (ABL != 3) A5_BAR(); if (!MK_LATEDMA) { A5_ISSUEK(t_); A5_ISSUEV(t_); } } while (0)
#define A5_ISSUEK(t_) do { if ((t_) + KD < NT && ABL != 6) glds16s(kg3, loff, (unsigned)__builtin_amdgcn_readfirstlane(kdst + dk)); kg3 += 8192; dk = (dk == (KD - 1) * 8192u) ? 0u : dk + 8192u; } while (0)
#define A5_ISSUEV(t_) do { if ((t_) + VD < NT && vwave && ABL != 6) glds16s(vg2, loff, (unsigned)__builtin_amdgcn_readfirstlane(vdst + dv)); vg2 += 4096; dv = (dv == (VD + 1) * 4096u) ? 0u : dv + 4096u; } while (0)
    const unsigned char* kg3 = ksrc + KD * 8192; const unsigned char* vg2 = vsrc + VD * 4096; unsigned dk = 0u, dv = VD * 4096u;
    A5_TOP(0); A5_STEP(pA0, pA1, pB0, pB1, 0, true, false, true);
    A5_TOP(1); A5_STEP(pB0, pB1, pA0, pA1, 1, true, true, true);
    int t = 2;
    for (; t + 2 < NT; t += 2) {
        A5_TOP(t);     A5_STEP(pA0, pA1, pB0, pB1, t, true, true, true);
        A5_TOP(t + 1); A5_STEP(pB0, pB1, pA0, pA1, t + 1, true, true, true);
    }
    A5_TOP(t);     A5_STEP(pA0, pA1, pB0, pB1, t, true, true, false);
    A5_TOP(t + 1); A5_STEP(pB0, pB1, pA0, pA1, t + 1, false, true, false);
#if MK_PVF
    { o[0] = A4_PVM(pwo, vfa, o[0]); o[1] = A4_PVM(pwo, vfb, o[1]); A5_SUM(pwo); }
#else
    {
        const LAS unsigned char* vp = shm + A5_V + sv_prev + hi * 1024 + r32 * 16; v8i vfa, vfb;
        A4_VLD(vfa, 0); A4_VLD(vfb, 1); o[0] = A4_PVM(pwo, vfa, o[0]); o[1] = A4_PVM(pwo, vfb, o[1]); A5_SUM(pwo);
    }
#endif
#undef A5_STEP
#undef A5_TOP
#undef A5_ISSUEK
#undef A5_ISSUEV
#undef A5_CVU
    __builtin_amdgcn_s_setprio(0);
    A5_BAR();
    int lane_e = lane; asm volatile("" : "+v"(lane_e));
    const int r32e = lane_e & 31, hie = lane_e >> 5;
    if (ui < 3) { const int qbn = (((ui + 1) & 2) ? 32 : 0) + (((ui + 1) & 1) ? 31 - s_ : s_); A7_LOADQ(qbn, lane_e); }
    LAS float* sums = (LAS float*)(shm + A5_WS) + wid * 64;
    if ((lane_e & 7) == 0) *(LAS f32x4*)(sums + ((lane_e & 8) ? 16 : 0) + 4 * (lane_e >> 4)) = lsum;
    LDS_WAIT();
    f32x4 ls4[4];
#pragma unroll
    for (int g = 0; g < 4; ++g) ls4[g] = *(const LAS f32x4*)(sums + 8 * g + 4 * hie);
    LAS bf16_t* stg = (LAS bf16_t*)(shm + A5_OST) + wid * 2048;
#pragma unroll
    for (int r = 0; r < 16; ++r) { const int orow = crow(r, hie); const float il = frcp(ls4[r >> 2][r & 3]);
#pragma unroll
        for (int d0 = 0; d0 < 2; ++d0) stg[orow * 64 + d0 * 32 + r32e] = (bf16_t)f2bf(o[d0][r] * il); }
    LDS_WAIT();
    const bf16_t* GB = (const bf16_t*)a.out; const bf16_t* HL = (const bf16_t*)(ws + WS_GR); const bf16_t* AC = (const bf16_t*)(ws + WS_GA); bf16_t* MG = (bf16_t*)(ws + WS_XR);
#pragma unroll
    for (int i = 0; i < 4; ++i) { const int row = i * 8 + (lane_e >> 3), ch = lane_e & 7; const u32x4 yv = *(const LAS u32x4*)(stg + row * 64 + ch * 8);
        const size_t go = (size_t)(q0 + wid * 32 + row) * 1024 + h * 64 + ch * 8;
        const u32x4 gb = *(const u32x4*)(GB + go), hl = *(const u32x4*)(HL + go), ac = *(const u32x4*)(AC + go); u32x4 w;
#pragma unroll
        for (int j = 0; j < 4; ++j) { const float c0 = carry[ch * 8 + 2 * j], c1 = carry[ch * 8 + 2 * j + 1];
            w[j] = pk2(lo2f(yv[j]) * lo2f(gb[j]) + lo2f(hl[j]) + lo2f(ac[j]) * c0, hi2f(yv[j]) * hi2f(gb[j]) + hi2f(hl[j]) + hi2f(ac[j]) * c1); }
        *(u32x4*)(MG + go) = w; }
    A2_PIN(rawr[0]); A2_PIN(rawr[1]); A2_PIN(rawn[0]); A2_PIN(rawn[1]); A2_PIN(rawn[2]); A2_PIN(rawn[3]);
    }
#undef A5_SUM
#undef A7_LOADQ
    asm volatile("s_waitcnt vmcnt(0) lgkmcnt(0)\n\ts_barrier" ::: "memory");
#undef A5_DMAK
#undef A5_DMAV
#undef A5_BAR
#undef A5_VMW
}

#ifndef MK_V6
#define MK_V6 0
#endif
#ifndef MK_MIDBAR
#define MK_MIDBAR 0
#endif
constexpr int A6_K = 0, A6_V = 49152, A6_WS = 73728, A6_OST = 75776;
template <int ABL> __device__ __forceinline__ void attn_unit_v6(int h, int qb, CArgs a, const LAS float* carry, LAS unsigned char* shm) {
    int tid = threadIdx.x; asm volatile("" : "+v"(tid));
    const int lane = tid & 63, r32 = lane & 31, hi = lane >> 5; const int wid = __builtin_amdgcn_readfirstlane(tid >> 6);
    unsigned char* ws = a.ws;
    const bf16_t* QRAW = (const bf16_t*)(ws + WS_R1); const unsigned char* KI = ws + WS_KIMG + (size_t)h * 256 * 8192; const unsigned char* VI = (const unsigned char*)a.out + 32 * MiB + (size_t)h * 256 * 4096;
    const float* CS = (const float*)(ws + WS_CS); const float* qg = (const float*)a.in[15];
    const int q0 = qb * 256, rowq = q0 + wid * 32 + r32;
    const unsigned lds0 = (unsigned)(uintptr_t)shm;
    const int NT = 4 * qb + 4, mylast = 4 * qb + (wid >> 1);
    const unsigned char* ksrc = KI + wid * 1024 + lane * 16; const unsigned char* vsrc = VI + (wid >> 2) * 4096 + (wid & 3) * 1024 + lane * 16;
    const unsigned kdst = lds0 + A6_K + wid * 1024, vdst = lds0 + A6_V + (wid >> 2) * 4096 + (wid & 3) * 1024;
#define A5_DMAK(t, slot) glds16(ksrc + (size_t)(t) * 8192, (unsigned)__builtin_amdgcn_readfirstlane(kdst + (slot) * 8192))
#define A5_DMAV(t, slot) glds16(vsrc + (size_t)(t) * 4096, (unsigned)__builtin_amdgcn_readfirstlane(vdst + (slot) * 4096))
#define A5_BAR() asm volatile("s_waitcnt lgkmcnt(0)\n\ts_barrier" ::: "memory")
    v8i q8; bf16x8 qr4, qr5;
    {
        const bf16_t* qp = QRAW + (size_t)rowq * 1536 + h * 96;
        u32x4 rawn[4], rawr[2]; float qn[32], qv4[8], qv5[8]; float ss = 0.f;
#pragma unroll
        for (int i = 0; i < 4; ++i) rawn[i] = *(const u32x4*)(qp + 32 * hi + 8 * i);
        rawr[0] = *(const u32x4*)(qp + 64 + 8 * hi); rawr[1] = *(const u32x4*)(qp + 80 + 8 * hi);
        A5_DMAK(0, 0); A5_DMAK(1, 1); A5_DMAK(2, 2); A5_DMAK(3, 3); A5_DMAV(0, 0);
#pragma unroll
        for (int i = 0; i < 4; ++i)
#pragma unroll
            for (int j = 0; j < 4; ++j) { qn[8 * i + 2 * j] = lo2f(rawn[i][j]); qn[8 * i + 2 * j + 1] = hi2f(rawn[i][j]); }
#pragma unroll
        for (int j = 0; j < 4; ++j) { qv4[2 * j] = lo2f(rawr[0][j]); qv4[2 * j + 1] = hi2f(rawr[0][j]); qv5[2 * j] = lo2f(rawr[1][j]); qv5[2 * j + 1] = hi2f(rawr[1][j]); }
#pragma unroll
        for (int j = 0; j < 32; ++j) ss += qn[j] * qn[j];
#pragma unroll
        for (int j = 0; j < 8; ++j) ss += qv4[j] * qv4[j] + qv5[j] * qv5[j];
        ss += __shfl_xor(ss, 32);
        const float rs = rsqrtf(ss * (1.f / 96.f) + EPS);
#pragma unroll
        for (int i = 0; i < 8; ++i) { const f32x4 g = *(const f32x4*)(qg + 32 * hi + 4 * i);
#pragma unroll
            for (int e = 0; e < 4; ++e) qn[4 * i + e] *= rs * g[e] * 1.1779544f; }
        { const f32x4 g0 = *(const f32x4*)(qg + 64 + hi * 8), g1 = *(const f32x4*)(qg + 64 + hi * 8 + 4), g2 = *(const f32x4*)(qg + 80 + hi * 8), g3 = *(const f32x4*)(qg + 80 + hi * 8 + 4);
#pragma unroll
          for (int j = 0; j < 4; ++j) { qv4[j] *= rs * g0[j]; qv4[4 + j] *= rs * g1[j]; qv5[j] *= rs * g2[j]; qv5[4 + j] *= rs * g3[j]; } }
        const f32x4 c0 = *(const f32x4*)(CS + (size_t)rowq * 32 + hi * 8), c1 = *(const f32x4*)(CS + (size_t)rowq * 32 + hi * 8 + 4), s0 = *(const f32x4*)(CS + (size_t)rowq * 32 + 16 + hi * 8), s1 = *(const f32x4*)(CS + (size_t)rowq * 32 + 16 + hi * 8 + 4);
#pragma unroll
        for (int j = 0; j < 8; ++j) { const float cs = j < 4 ? c0[j & 3] : c1[j & 3], sn = j < 4 ? s0[j & 3] : s1[j & 3]; const float x1 = qv4[j], x2 = qv5[j]; qv4[j] = x1 * cs - x2 * sn; qv5[j] = x1 * sn + x2 * cs; }
#pragma unroll
        for (int v = 0; v < 8; ++v) { const int w_ = __builtin_amdgcn_cvt_pk_fp8_f32(qn[4 * v], qn[4 * v + 1], 0, false); q8[v] = __builtin_amdgcn_cvt_pk_fp8_f32(qn[4 * v + 2], qn[4 * v + 3], w_, true); }
        u32x4 w4, w5;
#pragma unroll
        for (int j = 0; j < 4; ++j) { w4[j] = pk2(qv4[2 * j] * (8.f * C2), qv4[2 * j + 1] * (8.f * C2)); w5[j] = pk2(qv5[2 * j] * (8.f * C2), qv5[2 * j + 1] * (8.f * C2)); }
        qr4 = __builtin_bit_cast(bf16x8, w4); qr5 = __builtin_bit_cast(bf16x8, w5);
    }
    if (wid >= 4) __builtin_amdgcn_s_setprio(1);
    f32x16 o[2]; o[0] = f32x16{}; o[1] = f32x16{}; f32x4 lsum = {0.f, 0.f, 0.f, 0.f};
    f32x16 pA0, pA1, pB0, pB1, negm; v8i pwo = (v8i){0, 0, 0, 0, 0, 0, 0, 0};
    int onev = ((((lane >> 4) & 1) != 0) == ((lane & 15) >= 8)) ? 0x38383838 : 0; asm volatile("" : "+v"(onev));
    const v8i ones8 = (v8i){onev, onev, onev, onev, onev, onev, onev, onev};
#define A5_SUM(pw_) lsum = __builtin_amdgcn_mfma_scale_f32_16x16x128_f8f6f4(pw_, ones8, lsum, 0, 0, 0, 0x7f7f7f7f, 0, 0x7f7f7f7f)
    asm volatile("s_waitcnt vmcnt(3)" ::: "memory");
    A5_BAR();
    if (NT > 5) { A5_DMAK(4, 4); A5_DMAK(5, 5); } A5_DMAV(2, 2);
    {
        const LAS unsigned char* kp = shm + A6_K + hi * 1024 + r32 * 16; v8i ka, kb8;
        A5_K8(ka, 0); A5_K8(kb8, 1);
        pA0 = A5_QKM(ka, q8, (f32x16{})); pA1 = A5_QKM(kb8, q8, (f32x16{}));
        pA0 = A2_MF(A5_KR(0, 0), qr4, pA0); pA1 = A2_MF(A5_KR(0, 1), qr4, pA1); pA0 = A2_MF(A5_KR(1, 0), qr5, pA0); pA1 = A2_MF(A5_KR(1, 1), qr5, pA1);
        float rm = fmaxf(pA0[0], pA1[0]);
#pragma unroll
        for (int r = 1; r < 16; ++r) rm = fmaxf(rm, fmaxf(pA0[r], pA1[r]));
        rm = fmaxf(rm, __shfl_xor(rm, 32));
        const float nb = 64.f - rm;
#pragma unroll
        for (int r = 0; r < 16; ++r) { pA0[r] += nb; pA1[r] += nb; negm[r] = nb; }
        asm volatile("" : "+v"(negm));
    }
    int sk_next = 8192, sv_prev = 20480;
#define A5_CVU(W, j, P, b) do { if (ABL == 4) { W[j] = pwo[j]; break; } unsigned w_ = __builtin_amdgcn_cvt_pk_u8_f32(P[b], 0, 0u); w_ = __builtin_amdgcn_cvt_pk_u8_f32(P[(b) + 1], 1, w_); w_ = __builtin_amdgcn_cvt_pk_u8_f32(P[(b) + 2], 2, w_); W[j] = (int)__builtin_amdgcn_cvt_pk_u8_f32(P[(b) + 3], 3, w_); } while (0)
#define A5_STEP(C0, C1, N0, N1, t, HASN, HASP) do { \
        const LAS unsigned char* kp = shm + A6_K + sk_next + hi * 1024 + r32 * 16; const LAS unsigned char* vp = shm + A6_V + sv_prev + hi * 1024 + r32 * 16; \
        v8i ka, kb8, vfa, vfb, pwn; bf16x8 r0, r1, r2, r3; \
        A2_SB(); \
        if (HASN) { A5_K8(ka, 0); A5_K8(kb8, 1); r0 = A5_KR(0, 0); r1 = A5_KR(0, 1); A2_SB(); \
            N0 = A5_QKM(ka, q8, negm);  r2 = A5_KR(1, 0); r3 = A5_KR(1, 1); if (HASP) A4_VLD(vfa, 0); A5_CVU(pwn, 0, C0, 0); A5_CVU(pwn, 1, C0, 4); A2_PIN(pwn); A2_SB(); \
            N1 = A5_QKM(kb8, q8, negm); if (HASP) A4_VLD(vfb, 1); A5_CVU(pwn, 2, C0, 8); A5_CVU(pwn, 3, C0, 12); A2_PIN(pwn); A2_SB(); \
            if (ABL != 5) N0 = A2_MF(r0, qr4, N0); A5_CVU(pwn, 4, C1, 0); A2_PIN(pwn); A2_SB(); \
            if (ABL != 5) N1 = A2_MF(r1, qr4, N1); A5_CVU(pwn, 5, C1, 4); A2_PIN(pwn); A2_SB(); \
            if (HASP) { o[0] = A4_PVM(pwo, vfa, o[0]); } A5_CVU(pwn, 6, C1, 8); A5_CVU(pwn, 7, C1, 12); A2_PIN(pwn); A2_SB(); \
            if (ABL != 5) N0 = A2_MF(r2, qr5, N0); A2_SB(); \
            if (ABL != 5) N1 = A2_MF(r3, qr5, N1); A2_SB(); \
            if (HASP) { o[1] = A4_PVM(pwo, vfb, o[1]); } A2_SB(); \
            if (HASP && ABL != 2) { A5_SUM(pwo); } A2_SB(); \
        } else { \
            if (HASP) { A4_VLD(vfa, 0); A4_VLD(vfb, 1); } \
            A5_CVU(pwn, 0, C0, 0); A5_CVU(pwn, 1, C0, 4); A5_CVU(pwn, 2, C0, 8); A5_CVU(pwn, 3, C0, 12); A5_CVU(pwn, 4, C1, 0); A5_CVU(pwn, 5, C1, 4); A5_CVU(pwn, 6, C1, 8); A5_CVU(pwn, 7, C1, 12); \
            if (HASP) { o[0] = A4_PVM(pwo, vfa, o[0]); o[1] = A4_PVM(pwo, vfb, o[1]); A5_SUM(pwo); } A2_SB(); \
        } \
        if ((t) > mylast) { pwn = (v8i){0, 0, 0, 0, 0, 0, 0, 0}; } \
        pwo = pwn; \
        sk_next = (sk_next == 40960) ? 0 : sk_next + 8192; sv_prev = (sv_prev == 20480) ? 0 : sv_prev + 4096; \
    } while (0)
#define A5_TOP(t) do { const int t_ = (t); \
        if (t_ + 4 < NT) asm volatile("s_waitcnt vmcnt(3)" ::: "memory"); else if (t_ + 2 < NT) asm volatile("s_waitcnt vmcnt(1)" ::: "memory"); else asm volatile("s_waitcnt vmcnt(0)" ::: "memory"); \
        if (ABL != 3) A5_BAR(); \
        if (t_ + 6 < NT) { glds16(kg5, (unsigned)__builtin_amdgcn_readfirstlane(kdst + dk)); glds16(kg5 + 8192, (unsigned)__builtin_amdgcn_readfirstlane(kdst + dk + 8192u)); } \
        if (t_ + 4 < NT) glds16(vg3, (unsigned)__builtin_amdgcn_readfirstlane(vdst + dv)); \
        kg5 += 16384; vg3 += 8192; dk = (dk == 32768u) ? 0u : dk + 16384u; dv = (dv == 16384u) ? 0u : dv + 8192u; } while (0)
    const unsigned char* kg5 = ksrc + 6 * 8192; const unsigned char* vg3 = vsrc + 4 * 4096; unsigned dk = 0u, dv = 16384u;
    A5_STEP(pA0, pA1, pB0, pB1, 0, true, false);
    int t = 1;
    for (; t + 2 < NT; t += 2) {
        A5_TOP(t);
        A5_STEP(pB0, pB1, pA0, pA1, t, true, true);
        if (MK_MIDBAR) A5_BAR();
        A5_STEP(pA0, pA1, pB0, pB1, t + 1, true, true);
    }
    A5_TOP(t); A5_STEP(pB0, pB1, pA0, pA1, t, false, true);
    {
        const LAS unsigned char* vp = shm + A6_V + sv_prev + hi * 1024 + r32 * 16; v8i vfa, vfb;
        A4_VLD(vfa, 0); A4_VLD(vfb, 1); o[0] = A4_PVM(pwo, vfa, o[0]); o[1] = A4_PVM(pwo, vfb, o[1]); A5_SUM(pwo);
    }
#undef A5_STEP
#undef A5_TOP
#undef A5_CVU
#undef A5_SUM
    __builtin_amdgcn_s_setprio(0);
    LAS float* sums = (LAS float*)(shm + A6_WS) + wid * 64;
    if ((lane & 7) == 0) *(LAS f32x4*)(sums + ((lane & 8) ? 16 : 0) + 4 * (lane >> 4)) = lsum;
    LDS_WAIT();
    f32x4 ls4[4];
#pragma unroll
    for (int g = 0; g < 4; ++g) ls4[g] = *(const LAS f32x4*)(sums + 8 * g + 4 * hi);
    LAS bf16_t* stg = (LAS bf16_t*)(shm + A6_OST) + wid * 2048;
#pragma unroll
    for (int r = 0; r < 16; ++r) { const int orow = crow(r, hi); const float il = frcp(ls4[r >> 2][r & 3]);
#pragma unroll
        for (int d0 = 0; d0 < 2; ++d0) stg[orow * 64 + d0 * 32 + r32] = (bf16_t)f2bf(o[d0][r] * il); }
    LDS_WAIT();
    const bf16_t* GB = (const bf16_t*)a.out; const bf16_t* HL = (const bf16_t*)(ws + WS_GR); const bf16_t* AC = (const bf16_t*)(ws + WS_GA); bf16_t* MG = (bf16_t*)(ws + WS_XR);
#pragma unroll
    for (int i = 0; i < 4; ++i) { const int row = i * 8 + (lane >> 3), ch = lane & 7; const u32x4 yv = *(const LAS u32x4*)(stg + row * 64 + ch * 8);
        const size_t go = (size_t)(q0 + wid * 32 + row) * 1024 + h * 64 + ch * 8;
        const u32x4 gb = *(const u32x4*)(GB + go), hl = *(const u32x4*)(HL + go), ac = *(const u32x4*)(AC + go); u32x4 w;
#pragma unroll
        for (int j = 0; j < 4; ++j) { const float c0 = carry[ch * 8 + 2 * j], c1 = carry[ch * 8 + 2 * j + 1];
            w[j] = pk2(lo2f(yv[j]) * lo2f(gb[j]) + lo2f(hl[j]) + lo2f(ac[j]) * c0, hi2f(yv[j]) * hi2f(gb[j]) + hi2f(hl[j]) + hi2f(ac[j]) * c1); }
        *(u32x4*)(MG + go) = w; }
    asm volatile("s_waitcnt vmcnt(0) lgkmcnt(0)\n\ts_barrier" ::: "memory");
#undef A5_DMAK
#undef A5_DMAV
#undef A5_BAR
}

template <int ABL> __device__ __forceinline__ void p3_attention(Frame& F, CArgs a) {
    if (ABL == 9) {
        f32x16 c0 = f32x16{}, c1 = f32x16{}, c2 = f32x16{}, c3 = f32x16{}; f32x4 c4 = {0.f, 0.f, 0.f, 0.f};
        v8i x = (v8i){(int)F.tid, 1, 2, 3, 4, 5, 6, 7}; bf16x8 y = __builtin_bit_cast(bf16x8, (u32x4){(unsigned)F.tid, 1u, 2u, 3u});
#pragma unroll 1
        for (int it = 0; it < 520; ++it) {
            c0 = __builtin_amdgcn_mfma_scale_f32_32x32x64_f8f6f4(x, x, c0, 0, 0, 0, 0x7f7f7f7f, 0, 0x7f7f7f7f); c1 = __builtin_amdgcn_mfma_scale_f32_32x32x64_f8f6f4(x, x, c1, 0, 0, 0, 0x7f7f7f7f, 0, 0x7f7f7f7f);
            c2 = __builtin_amdgcn_mfma_f32_32x32x16_bf16(y, y, c2, 0, 0, 0); c3 = __builtin_amdgcn_mfma_f32_32x32x16_bf16(y, y, c3, 0, 0, 0);
            c0 = __builtin_amdgcn_mfma_scale_f32_32x32x64_f8f6f4(x, x, c0, 0, 0, 0, 0x7f7f7f7f, 0, 0x7f7f7f7f);
            c2 = __builtin_amdgcn_mfma_f32_32x32x16_bf16(y, y, c2, 0, 0, 0); c3 = __builtin_amdgcn_mfma_f32_32x32x16_bf16(y, y, c3, 0, 0, 0);
            c1 = __builtin_amdgcn_mfma_scale_f32_32x32x64_f8f6f4(x, x, c1, 0, 0, 0, 0x7f7f7f7f, 0, 0x7f7f7f7f);
            c4 = __builtin_amdgcn_mfma_scale_f32_16x16x128_f8f6f4(x, x, c4, 0, 0, 0, 0x7f7f7f7f, 0, 0x7f7f7f7f);
        }
        asm volatile("" :: "v"(c0), "v"(c1), "v"(c2), "v"(c3), "v"(c4));
        return;
    }
    const int head = (F.vcu >> 4) & 15, s = F.vcu & 15; const int qbs[4] = {s, 31 - s, 32 + s, 63 - s};
    LAS float* carry = (LAS float*)(F.lds + LDS_XCH);
    if (F.wave == 0) {
        const float* HEND = (const float*)(a.ws + WS_MISC + MISC_HEND); const float* AEND = (const float*)(a.ws + WS_MISC + MISC_AEND); const int c = head * 64 + LANE_NOW(); float cr = 0.f;
        for (int k = 0; k < 64; ++k) {
#pragma unroll
            for (int i = 0; i < 4; ++i) if (k == qbs[i]) carry[i * 64 + LANE_NOW()] = cr;
            cr = AEND[(size_t)k * 1024 + c] * cr + HEND[(size_t)k * 1024 + c];
        }
    }
    LDS_WAIT(); __syncthreads();
    if (F.vcu < 256)
        if (MK_FP8V && MK_FP8K && MK_V7) attn_block_v7<ABL>(head, s, a, carry, F.lds); else
        for (int i = 0; i < 4; ++i) { if (MK_FP8V && MK_FP8K && MK_V6) attn_unit_v6<ABL>(head, qbs[i], a, carry + i * 64, F.lds); else if (MK_FP8V && MK_FP8K) attn_unit_v5<ABL>(head, qbs[i], a, carry + i * 64, F.lds); else if (MK_FP8V) attn_unit_v4(head, qbs[i], a, carry + i * 64, F.lds); else attn_unit_v2<ABL>(head, qbs[i], a, carry + i * 64, F.lds); }
}

template <bool DRY> __device__ __forceinline__ void p6_route(Frame& F, CArgs a) {
    unsigned char* ws = a.ws; const float* H = a.out; const float* WR = (const float*)(ws + WS_MISC + MISC_WR);
    float* RH = (float*)(ws + WS_CTL + CTL_SSQ_H); const float* PH = (const float*)(ws + WS_SSQP + SSQP_H);
    const float* bg = (const float*)a.in[20]; const float* be = (const float*)a.in[22];
    unsigned* cnt = (unsigned*)(ws + WS_CTL) + CW_CNT; int* lists = (int*)(ws + WS_LIST); float* cwl = (float*)(ws + WS_LIST + 2 * MiB); unsigned* tokinfo = (unsigned*)(ws + WS_MISC + MISC_TOK);
    const int lane = LANE_NOW(), r = lane & 15, kq = lane >> 4, w4 = F.wave & 3, kh = F.wave >> 2;
    LAS float* lg = (LAS float*)F.lds + F.wave * (16 * 48);
    for (int rb0 = F.vcu * 4; rb0 < M / 16; rb0 += F.G * 4) {
        const int rb_ = rb0 + w4, rb = rb_ < M / 16 ? rb_ : M / 16 - 1;
        const float* hp = H + (size_t)(rb * 16 + r) * 1024 + 4 * kq + 512 * kh;
        const int c0 = r, c1 = 16 + r, c2 = (32 + r < 36) ? 32 + r : 35;
        const float* w0 = WR + (size_t)c0 * 1024 + 4 * kq + 512 * kh; const float* w1 = WR + (size_t)c1 * 1024 + 4 * kq + 512 * kh; const float* w2 = WR + (size_t)c2 * 1024 + 4 * kq + 512 * kh;
        f32x4 acc0 = {0.f, 0.f, 0.f, 0.f}, acc1 = acc0, acc2 = acc0;
#pragma unroll 8
        for (int S = 0; S < 32; ++S) {
            const f32x4 av = *(const f32x4*)(hp + 16 * S), b0 = *(const f32x4*)(w0 + 16 * S), b1 = *(const f32x4*)(w1 + 16 * S), b2 = *(const f32x4*)(w2 + 16 * S);
#pragma unroll
            for (int s4 = 0; s4 < 4; ++s4) { acc0 = __builtin_amdgcn_mfma_f32_16x16x4f32(av[s4], b0[s4], acc0, 0, 0, 0); acc1 = __builtin_amdgcn_mfma_f32_16x16x4f32(av[s4], b1[s4], acc1, 0, 0, 0); acc2 = __builtin_amdgcn_mfma_f32_16x16x4f32(av[s4], b2[s4], acc2, 0, 0, 0); }
        }
#pragma unroll
        for (int i = 0; i < 4; ++i) { lg[(4 * kq + i) * 48 + r] = acc0[i]; lg[(4 * kq + i) * 48 + 16 + r] = acc1[i]; lg[(4 * kq + i) * 48 + 32 + r] = acc2[i]; }
        LDS_WAIT(); __syncthreads();
        if (kh == 0 && lane < 16 && rb_ < M / 16) {
            const int tok = rb * 16 + lane; const float* pp = PH + (size_t)tok * 16; const f32x4 a0 = *(const f32x4*)pp, a1 = *(const f32x4*)(pp + 4), a2 = *(const f32x4*)(pp + 8), a3 = *(const f32x4*)(pp + 12);
            const float sh = (((a0[0] + a0[1]) + (a0[2] + a0[3])) + ((a1[0] + a1[1]) + (a1[2] + a1[3]))) + (((a2[0] + a2[1]) + (a2[2] + a2[3])) + ((a3[0] + a3[1]) + (a3[2] + a3[3])));
            const float rs = rsqrtf(sh * (1.f / 1024.f) + EPS);
            const LAS float* lr = lg + lane * 48; const LAS float* lr2 = lr + 4 * (16 * 48);
            float gl[4];
#pragma unroll
            for (int q = 0; q < 4; ++q) gl[q] = (lr[q] + lr2[q]) * rs + bg[q];
            int g = 0; float mx = gl[0];
#pragma unroll
            for (int q = 1; q < 4; ++q) if (gl[q] > mx) { mx = gl[q]; g = q; }
            float den = 0.f;
#pragma unroll
            for (int q = 0; q < 4; ++q) den += expf(gl[q] - mx);
            const float pg = 1.f / den;
            float v1 = -INFINITY, v2 = -INFINITY; int i1 = 0, i2 = 0;
#pragma unroll
            for (int q = 0; q < 8; ++q) { const float v = (lr[4 + g * 8 + q] + lr2[4 + g * 8 + q]) * rs + be[g * 8 + q];
                if (v > v1) { v2 = v1; i2 = i1; v1 = v; i1 = q; } else if (v > v2) { v2 = v; i2 = q; } }
            const float e2 = expf(v2 - v1), s1 = 1.f / (1.f + e2), s2 = e2 * s1; const int e1 = g * 8 + i1, eb = g * 8 + i2;
            if (DRY) { asm volatile("" :: "v"(s1 + s2 + pg), "v"(e1 + eb)); }
            else {
                RH[tok] = rs;
                const unsigned sl1 = atomicAdd(cnt + e1, 1u), sl2 = atomicAdd(cnt + eb, 1u);
                lists[(size_t)e1 * M + sl1] = tok; cwl[(size_t)e1 * M + sl1] = pg * s1; lists[(size_t)eb * M + sl2] = tok; cwl[(size_t)eb * M + sl2] = pg * s2;
                tokinfo[tok * 2] = ((unsigned)e1 << 16) | sl1; tokinfo[tok * 2 + 1] = ((unsigned)eb << 16) | sl2;
            }
        }
        LDS_WAIT(); __syncthreads();
    }
}

__device__ __forceinline__ void moe_prefix(Frame& F, CArgs a, volatile LAS int* tpre, volatile LAS int* cnts) {
    const unsigned* cnt = (const unsigned*)(a.ws + WS_CTL) + CW_CNT;
    if (F.wave == 0) {
        int ln = threadIdx.x; asm volatile("" : "+v"(ln)); ln &= 63; const int e = ln & 31; const int c = (int)__hip_atomic_load(cnt + e, RLX_AGENT); const int nt_ = (c + 255) >> 8; int inc = nt_;
#pragma unroll
        for (int d = 1; d < 32; d <<= 1) { const int v = __shfl_up(inc, d); if (e >= d) inc += v; }
        const int exc = inc - nt_;
        if (ln < 32) { tpre[e] = exc; cnts[e] = c; for (int q = 0; q < nt_; ++q) tpre[80 + exc + q] = e; if (e == 31) tpre[32] = inc; }
    }
    LDS_WAIT(); __syncthreads();
}

template <bool DRY> __device__ __forceinline__ void p8_final(Frame& F, CArgs a, const volatile LAS int* tpre) {
    float* out = a.out; const unsigned char* Y = (const unsigned char*)(a.ws + WS_Y); const unsigned* tokinfo = (const unsigned*)(a.ws + WS_MISC + MISC_TOK);
    const int gw = F.vcu * NWAVES + F.wave, NGW = F.G * NWAVES, lane = LANE_NOW();
    for (int tok = gw; tok < M; tok += NGW) {
        const unsigned i0 = tokinfo[tok * 2], i1 = tokinfo[tok * 2 + 1];
        const size_t s0 = (size_t)tpre[i0 >> 16] * 256 + (i0 & 0xffffu), s1 = (size_t)tpre[i1 >> 16] * 256 + (i1 & 0xffffu);
        const size_t c = 16 * lane; const u32x4 y0 = *(const u32x4*)(Y + s0 * 1024 + c), y1 = *(const u32x4*)(Y + s1 * 1024 + c);
#pragma unroll
        for (int q = 0; q < 4; ++q) { f32x4 h = *(const f32x4*)(out + (size_t)tok * 1024 + c + 4 * q);
            const f32x2 a01 = __builtin_amdgcn_cvt_pk_f32_fp8((int)y0[q], false), a23 = __builtin_amdgcn_cvt_pk_f32_fp8((int)y0[q], true), b01 = __builtin_amdgcn_cvt_pk_f32_fp8((int)y1[q], false), b23 = __builtin_amdgcn_cvt_pk_f32_fp8((int)y1[q], true);
            h[0] += (a01[0] + b01[0]) * 0.125f; h[1] += (a01[1] + b01[1]) * 0.125f; h[2] += (a23[0] + b23[0]) * 0.125f; h[3] += (a23[1] + b23[1]) * 0.125f;
            if (DRY) asm volatile("" :: "v"(h)); else *(f32x4*)(out + (size_t)tok * 1024 + c + 4 * q) = h; }
    }
}
constexpr int NPHASE = 10;
#ifndef MK_ONE_LAUNCH
#define MK_ONE_LAUNCH 1
#endif
#ifndef MK_DRY
#define MK_DRY 0
#endif
__global__ void __launch_bounds__(NTHREADS, 2) mega(Args a) {
    extern __shared__ __attribute__((aligned(16))) unsigned char lds_raw[];
    Frame F;
    F.lds = (LAS unsigned char*)lds_raw; F.MISC = (volatile LAS unsigned*)(F.lds + MISC_OFF);
    F.tid = threadIdx.x; F.lane = F.tid & 63; F.wave = __builtin_amdgcn_readfirstlane(F.tid >> 6);
    F.G = gridDim.x; { const int bx = blockIdx.x; F.vcu = (F.G % 8 == 0) ? (bx % 8) * (F.G / 8) + bx / 8 : bx; }
    const __attribute__((address_space(4))) Args* ap0 = (const __attribute__((address_space(4))) Args*)__builtin_amdgcn_kernarg_segment_ptr();
#define KA() (*({ const __attribute__((address_space(4))) Args* p_ = ap0; asm volatile("" : "+s"(p_)); p_; }))
    unsigned char* ws = a.ws; F.ctl = (gu32*)(ws + WS_CTL);
    for (int u = F.tid; u < (LDS_BYTES - LDSCTL_OFF) / 4; u += NTHREADS) ((LAS unsigned*)(F.lds + LDSCTL_OFF))[u] = 0u;
    __syncthreads();
    const int lo = a.ph_lo, hi = a.ph_hi;
    XcdBarrier bar; bar.bar = (unsigned*)(F.ctl + CW_BAR); bar.x = 0; bar.st = nullptr;
    if (hi - lo > 1) bar = xcd_barrier_post((unsigned*)(F.ctl + CW_BAR), F.MISC + 8);
#ifndef PH_MASK
#define PH_MASK 0x3ff
#endif
#define IN(k) (((PH_MASK >> (k)) & 1) && lo <= (k) && (k) < hi)
#ifdef MK_STAMPS
#define STAMP(k) do { if (blockIdx.x == 0 && F.tid == 0) ((unsigned long long*)(ws + WS_CTL + 400000))[k] = __builtin_amdgcn_s_memrealtime(); } while (0)
#else
#define STAMP(k) do {} while (0)
#endif
#ifndef MK_DOUBLE_MASK
#define MK_DOUBLE_MASK 0
#endif
#define REP(k) for (int rep_ = 0; rep_ < (((MK_DOUBLE_MASK >> (k)) & 1) ? 2 : 1); ++rep_)
#ifndef MK_XBAR
#define MK_XBAR 0
#endif
#define SEAM(k) do { if (IN(k) && IN((k) + 1)) { xcd_barrier(bar); if (MK_XBAR && (k) == 4) { for (int xb_ = 0; xb_ < 8; ++xb_) xcd_barrier(bar); } } STAMP((k) + 1); } while (0)
    volatile LAS int* tpre = (volatile LAS int*)(F.lds + LDS_XCH + 8192); volatile LAS int* cnts = tpre + 40;
    const int bx = (int)blockIdx.x;
#ifndef MK_CXV
#define MK_CXV 1
#endif
    const int cx = MK_CXV ? F.vcu : bx;

    STAMP(0);
    if (IN(0)) REP(0) { p0_prologue(F, KA()); SEAM(0); }
    if (IN(1) && MK_DRY == 11) {
        DenseOrder S; S.init(M, 5120, F.G, bx, ws + WS_R1, ws + WS_WIN, 1024, 1024);
        EpiNull E{}; gemm_phase<EpiNull, DenseOrder, true>(F.lds, 1024, 1024, S, E);
        xcd_barrier(bar);
    }
    if (IN(1) && MK_DRY == 1) {
        DenseOrder S; S.init(M, 5120, F.G, bx, ws + WS_R1, ws + WS_WIN, 1024, 1024);
        EpiProj E{(bf16_t*)(ws + WS_XR), (bf16_t*)(ws + WS_GR), (bf16_t*)(ws + WS_QC), (bf16_t*)(ws + WS_KVC), (bf16_t*)(ws + WS_GA), (bf16_t*)KA().out, (bf16_t*)(ws + WS_MISC + MISC_HALO), (float*)(ws + WS_KPE), (float*)(ws + WS_SSQP), (float*)(ws + WS_SSQP + SSQP_KV)};
        gemm_phase<EpiProj, DenseOrder, true>(F.lds, 1024, 1024, S, E);
        xcd_barrier(bar);
    }
    if (IN(6) && MK_DRY == 60) { moe_weight_convert(F, KA(), 0, F.vcu, F.G); xcd_barrier(bar); }
    if (IN(1)) REP(1) {
        DenseOrder S; S.init(M, 5120, F.G, bx, ws + WS_R1, ws + WS_WIN, 1024, 1024);
        EpiProj E{(bf16_t*)(ws + WS_XR), (bf16_t*)(ws + WS_GR), (bf16_t*)(ws + WS_QC), (bf16_t*)(ws + WS_KVC), (bf16_t*)(ws + WS_GA), (bf16_t*)KA().out, (bf16_t*)(ws + WS_MISC + MISC_HALO), (float*)(ws + WS_KPE), (float*)(ws + WS_SSQP), (float*)(ws + WS_SSQP + SSQP_KV)};
        gemm_phase<EpiProj, DenseOrder, true>(F.lds, 1024, 1024, S, E);
        SEAM(1);
    }
    if (IN(2)) { if (MK_DRY == 2) { p2a_conv<true>(F, KA()); xcd_barrier(bar); } p2a_conv<false>(F, KA()); SEAM(2); }
    if (IN(3)) {
        typedef EpiLruT<false> EpiLru;
#define P3_LRU() do { EpiLru EL{(const bf16_t*)(ws + WS_XR), (const float*)KA().in[7], (const float*)KA().in[9], (const float*)KA().in[10], (bf16_t*)(ws + WS_GR), (bf16_t*)(ws + WS_GA), (float*)(ws + WS_MISC + MISC_HEND), (float*)(ws + WS_MISC + MISC_AEND)}; \
            for (int half = 0; half < 2; ++half) { OneOrder S{half * F.G, 8, (const char*)(ws + WS_XR), (const char*)(ws + WS_WLRU), (size_t)256 * 1024 * 2, (size_t)256 * 256 * 2, 512, cx, 512}; \
                gemm_phase<EpiLru, OneOrder, false>(F.lds, 256, 1024, S, EL); } } while (0)
#define P3_QKV() P3_QKVS(3)
#define P3_QKVS(sel_) do { \
            if ((sel_) & 1) { DenseOrder S; S.init(M, 1536, F.G, bx, ws + WS_QC, ws + WS_WUQ, 768, 768, 0, 0, 1); EpiQ E{(bf16_t*)(ws + WS_R1), (float*)(ws + WS_CTL + CTL_SSQ_Q)}; gemm_phase<EpiQ, DenseOrder, true, true, 0x7a7a7a7a>(F.lds, 768, 768, S, E); } \
            if ((sel_) & 2) { DenseOrder S; S.init(M, 2048, F.G, bx, ws + WS_KVC, ws + WS_WUKV, 256, 256, 0, 0, 1); if (F.G == 256) { S.skew_h = 128; S.skew_a = 1; S.skew_b = 3; } \
              EpiKV E{ws + WS_KIMG, (unsigned char*)KA().out + 32 * MiB, (float*)(ws + WS_CTL + CTL_SSQ_KV), (const float*)(ws + WS_MISC + MISC_KSSQ), (const float*)(ws + WS_KPE), (const float*)KA().in[16]}; \
              gemm_phase<EpiKV, DenseOrder, true, true, 0x7b7b7b7b>(F.lds, 256, 256, S, E); } } while (0)
        if (MK_DRY == 31) {
            DenseOrder S; S.init(M, 2048, F.G, bx, ws + WS_KVC, ws + WS_WUKV, 256, 256, 0, 0, 1); if (F.G == 256) { S.skew_h = 128; S.skew_a = 1; S.skew_b = 3; }
            EpiNull E{}; gemm_phase<EpiNull, DenseOrder, true, true, 0x7b7b7b7b>(F.lds, 256, 256, S, E); xcd_barrier(bar); }
        if (MK_DRY == 32) {
            DenseOrder S; S.init(M, 2048, F.G, bx, ws + WS_KVC, ws + WS_WUKV, 256, 256, 0, 0, 1);
            EpiNull E{}; gemm_phase<EpiNull, DenseOrder, true, true, 0x7b7b7b7b>(F.lds, 256, 256, S, E); xcd_barrier(bar); }
        if (MK_DRY == 3) { typedef EpiLruT<true> EpiLruD;
            EpiLruD EL{(const bf16_t*)(ws + WS_XR), (const float*)KA().in[7], (const float*)KA().in[9], (const float*)KA().in[10], (bf16_t*)(ws + WS_GR), (bf16_t*)(ws + WS_GA), (float*)(ws + WS_MISC + MISC_HEND), (float*)(ws + WS_MISC + MISC_AEND)};
#ifndef MK_DRY3
#define MK_DRY3 7
#endif
            if (bx & 1) { if (MK_DRY3 & 1) for (int half = 0; half < 2; ++half) { OneOrder S{half * F.G, 8, (const char*)(ws + WS_XR), (const char*)(ws + WS_WLRU), (size_t)256 * 1024 * 2, (size_t)256 * 256 * 2, 512, cx, 512}; gemm_phase<EpiLruD, OneOrder, false>(F.lds, 256, 1024, S, EL); } if (MK_DRY3 & 6) P3_QKVS((MK_DRY3 >> 1) & 3); }
            else { if (MK_DRY3 & 6) P3_QKVS((MK_DRY3 >> 1) & 3); if (MK_DRY3 & 1) for (int half = 0; half < 2; ++half) { OneOrder S{half * F.G, 8, (const char*)(ws + WS_XR), (const char*)(ws + WS_WLRU), (size_t)256 * 1024 * 2, (size_t)256 * 256 * 2, 512, cx, 512}; gemm_phase<EpiLruD, OneOrder, false>(F.lds, 256, 1024, S, EL); } }
            xcd_barrier(bar); }
        if (bx & 1) { P3_LRU(); P3_QKV(); } else { P3_QKV(); P3_LRU(); }
#undef P3_LRU
#undef P3_QKV
#undef P3_QKVS
        SEAM(3);
    }
#ifndef MK_ABL
#define MK_ABL 0
#endif
    if (IN(4)) { if (MK_ABL) { p3_attention<MK_ABL>(F, KA()); xcd_barrier(bar); } p3_attention<0>(F, KA()); SEAM(4); }
    if (IN(5)) REP(5) {
        DenseOrder S; S.init(M, 1024, F.G, bx, ws + WS_XR, ws + WS_WOUT, 1024, 1024);
        EpiWout E{(const float*)KA().in[0], KA().out, (bf16_t*)(ws + WS_GR), (float*)(ws + WS_SSQP + SSQP_H)};
        gemm_phase<EpiWout, DenseOrder, true>(F.lds, 1024, 1024, S, E);
        SEAM(5);
    }
    if (IN(6)) { if (MK_DRY == 6) { p6_route<true>(F, KA()); xcd_barrier(bar); } if (MK_DRY == 61) { moe_weight_convert(F, KA(), 0, F.vcu, F.G); xcd_barrier(bar); } if (MK_DRY == 62) { moe_weight_convert(F, KA(), 1, F.vcu, F.G); xcd_barrier(bar); } p6_route<false>(F, KA()); moe_weight_convert(F, KA(), 0, F.vcu, F.G); SEAM(6); }
    if (IN(7) && MK_DRY == 7) {
        moe_prefix(F, KA(), tpre, cnts);
        MoeOrder S{tpre, cnts, 2, F.G, cx, (const char*)(ws + WS_GR), (const char*)(ws + WS_WGU), (size_t)512 * 1024, (size_t)256 * 1024, (const int*)(ws + WS_LIST), 1, 0};
        EpiMoeGU E{(bf16_t*)(ws + WS_GA), (float*)(ws + WS_CTL + CTL_SSQ_H), (const int*)(ws + WS_LIST)};
        gemm_phase<EpiMoeGU, MoeOrder, true, true, 0x7a7a7a7a>(F.lds, 1024, 1024, S, E);
        xcd_barrier(bar);
    }
    if (IN(8) && MK_DRY == 8) {
        moe_prefix(F, KA(), tpre, cnts);
        MoeOrder S{tpre, cnts, 4, F.G, cx, (const char*)(ws + WS_GA), (const char*)(ws + WS_WDN), (size_t)1024 * 256, (size_t)256 * 256, (const int*)(ws + WS_LIST), 0, (size_t)256 * 256};
        EpiMoeDown E{(bf16_t*)(ws + WS_Y), (const float*)(ws + WS_LIST + 2 * MiB)};
        gemm_phase<EpiMoeDown, MoeOrder, true, true, 0x7b7b7b7b>(F.lds, 256, 256, S, E);
        xcd_barrier(bar);
    }
    if (IN(7)) REP(7) {
        moe_prefix(F, KA(), tpre, cnts);
        MoeOrder S{tpre, cnts, 2, F.G, cx, (const char*)(ws + WS_GR), (const char*)(ws + WS_WGU), (size_t)512 * 1024, (size_t)256 * 1024, (const int*)(ws + WS_LIST), 1, 0};
        EpiMoeGU E{(bf16_t*)(ws + WS_GA), (float*)(ws + WS_CTL + CTL_SSQ_H), (const int*)(ws + WS_LIST)};
        gemm_phase<EpiMoeGU, MoeOrder, true, true, 0x7a7a7a7a>(F.lds, 1024, 1024, S, E);
        { const int nG = 2 * tpre[32], heavy = nG > F.G ? (nG - F.G < F.G ? nG - F.G : F.G - 1) : 0;
          if (cx >= heavy) moe_weight_convert(F, KA(), 1, cx - heavy, F.G - heavy); }
        SEAM(7);
    }
    if (IN(8)) REP(8) {
        if (!IN(7)) moe_prefix(F, KA(), tpre, cnts);
        MoeOrder S{tpre, cnts, 4, F.G, cx, (const char*)(ws + WS_GA), (const char*)(ws + WS_WDN), (size_t)1024 * 256, (size_t)256 * 256, (const int*)(ws + WS_LIST), 0, (size_t)256 * 256};
        EpiMoeDown E{(bf16_t*)(ws + WS_Y), (const float*)(ws + WS_LIST + 2 * MiB)};
        gemm_phase<EpiMoeDown, MoeOrder, true, true, 0x7b7b7b7b>(F.lds, 256, 256, S, E);
        SEAM(8);
    }
    if (IN(9)) { if (!IN(8)) moe_prefix(F, KA(), tpre, cnts); if (MK_DRY == 9) { p8_final<true>(F, KA(), tpre); xcd_barrier(bar); } p8_final<false>(F, KA(), tpre); VM_WAIT(); STAMP(10); }
#undef IN
#undef SEAM
}

[[maybe_unused]] static void launch(void* const* d_in, float* d_out, unsigned char* ws, hipStream_t stream, int one_launch) {
    static int grid = 0;
    if (grid == 0) {
        int dev = 0, cus = 0;
        if (hipGetDevice(&dev) != hipSuccess || hipDeviceGetAttribute(&cus, hipDeviceAttributeMultiprocessorCount, dev) != hipSuccess) { fprintf(stderr, "device query failed\n"); grid = -1; return; }
        if (hipFuncSetAttribute((const void*)mega, hipFuncAttributeMaxDynamicSharedMemorySize, LDS_BYTES) != hipSuccess) { fprintf(stderr, "hipFuncSetAttribute failed\n"); grid = -1; return; }
        (void)hipGetLastError();
        grid = cus;
        if (grid != 256) fprintf(stderr, "warning: %d CUs (kernel built for 256)\n", grid);
    }
    if (grid < 0) return;
    (void)hipMemsetAsync(ws + WS_CTL + CW_BAR * 4, 0, (size_t)(CW_CNT - CW_BAR) * 4 + 256, stream);
    Args a{};
    for (int i = 0; i < 26; ++i) a.in[i] = d_in[i];
    a.out = d_out; a.ws = ws;
    if (one_launch) { a.ph_lo = 0; a.ph_hi = NPHASE; hipLaunchKernelGGL(mega, dim3(grid), dim3(NTHREADS), LDS_BYTES, stream, a); }
    else for (int p = 0; p < NPHASE; ++p) { a.ph_lo = p; a.ph_hi = p + 1; hipLaunchKernelGGL(mega, dim3(grid), dim3(NTHREADS), LDS_BYTES, stream, a); }
}
}
extern "C" void kernel_launch(void* const* d_in, const int* in_sizes, int n_in, void* d_out, int out_size, void* d_ws, size_t ws_size, hipStream_t stream) {
    (void)in_sizes; (void)n_in; (void)out_size; (void)ws_size;
    mk::launch(d_in, (float*)d_out, (unsigned char*)d_ws, stream, MK_ONE_LAUNCH);
}
```

```cpp
#include <hip/hip_runtime.h>
#include <hip/hip_bf16.h>
#include <cstdint>
#include <cstdio>
#include <cmath>
namespace mk {
#define LAS __attribute__((address_space(3)))
#define GAS __attribute__((address_space(1)))
typedef unsigned short bf16_t;
typedef short bf16x8 __attribute__((ext_vector_type(8)));
typedef short s16x4 __attribute__((ext_vector_type(4)));
typedef float f32x2 __attribute__((ext_vector_type(2)));
typedef float f32x4 __attribute__((ext_vector_type(4)));
typedef float f32x16 __attribute__((ext_vector_type(16)));
typedef unsigned u32x2 __attribute__((ext_vector_type(2)));
typedef unsigned u32x4 __attribute__((ext_vector_type(4)));
typedef GAS unsigned gu32;

#ifndef MK_FP8V
#define MK_FP8V 1
#endif
#ifndef MK_FP8K
#define MK_FP8K 1
#endif
constexpr int M = 16384, D = 1024, NWAVES = 8, NTHREADS = 512;
constexpr float EPS = 1e-6f, LOG2E = 1.4426950408889634f;
constexpr size_t MiB = 1u << 20;
constexpr size_t WS_CTL = 0, CTL_BYTES = 1 * MiB;
constexpr size_t WS_WIN = 1 * MiB, WS_WUQ = 12 * MiB, WS_WUKV = 15 * MiB, WS_WLRU = 16 * MiB, WS_WOUT = 17 * MiB;
constexpr size_t WS_CS = 19 * MiB, WS_KPE = 21 * MiB, WS_MISC = 23 * MiB, WS_LIST = 25 * MiB;
constexpr size_t WS_R1 = 29 * MiB, WS_XR = 77 * MiB, WS_GR = 109 * MiB, WS_GA = 141 * MiB, WS_QC = 173 * MiB, WS_KVC = 197 * MiB, WS_KIMG = 205 * MiB, WS_DBG = 253 * MiB;
constexpr size_t MISC_HALO = 0, MISC_HEND = 512 * 1024, MISC_AEND = 768 * 1024, MISC_KSSQ = 1024 * 1024, MISC_WR = 1152 * 1024, MISC_TOK = 1408 * 1024;
constexpr size_t WS_SSQP = 253 * MiB, SSQP_KV = 786432, SSQP_H = 1048576;
constexpr size_t WS_Y = WS_QC;
constexpr size_t WS_WGU = WS_R1, WS_WDN = WS_R1 + 32 * MiB;
constexpr int CW_TMO = 0, CW_CODE = 1, CW_BAR = 4096, CW_CNT = 8192;
constexpr size_t CTL_SSQ_Q = 65536, CTL_SSQ_KV = 131072, CTL_SSQ_H = 196608;
constexpr int RING_BYTES = 131072, LDS_XCH = 135168  , LDSCTL_OFF = 147456, MISC_OFF = LDSCTL_OFF + 320, LDS_BYTES = 163840;

#define RLX_AGENT __ATOMIC_RELAXED, __HIP_MEMORY_SCOPE_AGENT
#define LDS_WAIT() asm volatile("s_waitcnt lgkmcnt(0)" ::: "memory")
#define VM_WAIT() asm volatile("s_waitcnt vmcnt(0)" ::: "memory")
__device__ __forceinline__ float bf2f(unsigned v) { return __uint_as_float(v << 16); }
__device__ __forceinline__ unsigned f2bf(float f) { unsigned u = __float_as_uint(f); return (u + 0x7fffu + ((u >> 16) & 1u)) >> 16; }
__device__ __forceinline__ unsigned pk2(float lo, float hi) { typedef __bf16 bf16x2_t __attribute__((ext_vector_type(2))); f32x2 v = {lo, hi}; bf16x2_t b = __builtin_convertvector(v, bf16x2_t); return __builtin_bit_cast(unsigned, b); }
__device__ __forceinline__ float lo2f(unsigned w) { return __uint_as_float(w << 16); }
__device__ __forceinline__ float hi2f(unsigned w) { return __uint_as_float(w & 0xffff0000u); }
__device__ __forceinline__ float fexp2(float x) { return __builtin_amdgcn_exp2f(x); }
__device__ __forceinline__ float frcp(float x) { return __builtin_amdgcn_rcpf(x); }
__device__ __forceinline__ float fsigm(float x) { return frcp(1.f + fexp2(-x * LOG2E)); }
__device__ __forceinline__ float fgelu(float x) { const float u = 0.7978845608028654f * (x + 0.044715f * x * x * x); return x * frcp(1.f + fexp2(-2.f * LOG2E * u)); }
__device__ __forceinline__ float wave_sum(float v) {
#pragma unroll
    for (int o = 1; o < 64; o <<= 1) v += __shfl_xor(v, o);
    return v;
}

#define XB_TMO      128
#define XB_XCNT(j)  (256  + 64 * (j))
#define XB_XSUB(j)  (1280 + 64 * (j))
#define XB_XGEN(j)  (2304 + 64 * (j))
#define XB_TOP      3328
#define XB_TOPGEN   3392
#define XCD_BAR_WORDS 3456
#define XB_SPIN_CAP (1u << 18)
__device__ __forceinline__ unsigned xb_ld(unsigned* p)              { return __hip_atomic_load(p, __ATOMIC_RELAXED, __HIP_MEMORY_SCOPE_AGENT); }
__device__ __forceinline__ unsigned xb_add(unsigned* p, unsigned v) { return __hip_atomic_fetch_add(p, v, __ATOMIC_RELAXED, __HIP_MEMORY_SCOPE_AGENT); }
__device__ __forceinline__ unsigned xb_xcc_id() { return (unsigned)__builtin_amdgcn_s_getreg((3 << 11) | 20) & 0xFu; }
#define XB_SPIN(cond, bar) do { unsigned _sp = 0; while (cond) { __builtin_amdgcn_s_sleep(1); \
    if ((++_sp & 255u) == 0u) { if (xb_ld(&(bar)[XB_TMO])) break; if (_sp > XB_SPIN_CAP) { atomicAdd(&(bar)[XB_TMO], 1u); break; } } } } while (0)
struct XcdBarrier { unsigned* bar; unsigned x; volatile LAS unsigned* st; };
__device__ __forceinline__ XcdBarrier xcd_barrier_post(unsigned* bar, volatile LAS unsigned* st) {
    XcdBarrier b; b.bar = bar; b.x = xb_xcc_id(); b.st = st;
    if (threadIdx.x == 0) (void)xb_add(&bar[XB_XCNT(b.x)], 1u);
    return b;
}
__device__ __forceinline__ void xcd_barrier_complete(unsigned* bar, unsigned x, unsigned& nloc, unsigned& nx) {
    const unsigned G = gridDim.x * gridDim.y * gridDim.z;
    unsigned sum, cnt, mine, sp = 0u;
    for (;;) {
        sum = 0u; cnt = 0u; mine = 0u;
#pragma unroll
        for (unsigned j = 0; j < 16; ++j) { const unsigned c = xb_ld(&bar[XB_XCNT(j)]); sum += c; cnt += (c > 0u) ? 1u : 0u; mine = (j == x) ? c : mine; }
        if (sum == G) break;
        __builtin_amdgcn_s_sleep(1);
        if ((++sp & 255u) == 0u) { if (xb_ld(&bar[XB_TMO])) break; if (sp > XB_SPIN_CAP) { atomicAdd(&bar[XB_TMO], 1u); break; } }
    }
    nloc = mine > 0u ? mine : 1u; nx = cnt > 0u ? cnt : 1u;
}
__device__ __forceinline__ void xcd_barrier(const XcdBarrier& b) {
    asm volatile("s_waitcnt vmcnt(0)" ::: "memory");
    __syncthreads();
    if (threadIdx.x == 0) {
        unsigned* bar = b.bar;
        __builtin_amdgcn_s_waitcnt(0);
        unsigned nloc = b.st[0], nx = b.st[1];
        if (nloc == 0u) { xcd_barrier_complete(bar, b.x, nloc, nx); b.st[0] = nloc; b.st[1] = nx; }
        const unsigned old = xb_add(&bar[XB_XSUB(b.x)], 1u);
        const unsigned gen = old / nloc;
        if (old + 1u == (gen + 1u) * nloc) {
            __builtin_amdgcn_fence(__ATOMIC_RELEASE, "agent");
            asm volatile("s_waitcnt vmcnt(0)" ::: "memory");
            const unsigned og = xb_add(&bar[XB_TOP], 1u);
            const unsigned tg = og / nx;
            if (og + 1u == (tg + 1u) * nx) xb_add(&bar[XB_TOPGEN], 1u);
            else XB_SPIN(xb_ld(&bar[XB_TOPGEN]) == tg, bar);
            __builtin_amdgcn_fence(__ATOMIC_ACQUIRE, "agent");
            xb_add(&bar[XB_XGEN(b.x)], 1u);
            asm volatile("s_waitcnt vmcnt(0)" ::: "memory");
        } else {
            XB_SPIN(xb_ld(&bar[XB_XGEN(b.x)]) == gen, bar);
            __builtin_amdgcn_fence(__ATOMIC_ACQUIRE, "agent");
            asm volatile("s_waitcnt vmcnt(0)" ::: "memory");
        }
    }
    __syncthreads();
}

constexpr int BM = 256, BK = 64, HALF = 128, HTB = HALF * BK * 2, STAGE_BYTES = 8 * HTB;
__device__ __forceinline__ int lds_byte(int r, int c) { const int st = (r >> 4) * 2 + (c >> 5), rr = r & 15, cc = c & 31, ob = rr * 64 + cc * 2; return st * 1024 + (ob ^ (((ob >> 9) & 1) << 5)); }
__device__ __forceinline__ void stage_rc(int b, int& R, int& C) { const int st = b / 1024, sb = b % 1024, swz = sb ^ (((sb >> 9) & 1) << 5); R = (st >> 1) * 16 + swz / 64; C = (st & 1) * 32 + (swz % 64) / 2; }
__device__ __forceinline__ int perm32(int rho) { const int n = rho >> 4, i = rho & 15; return 8 * (i >> 2) + 4 * n + (i & 3); }

struct Unit { int pm, pn; const char* A; const char* B; const int* gat; int valid; int x0, x1; };
typedef f32x4 Acc[2][2][4][2];

#define PG8_SA(b, h) (((b) * 2 + (h)) * HTB)
#define PG8_SB(b, h) ((4 + (b) * 2 + (h)) * HTB)
#define PG8_STAGE(bufoff, gbase, voff) do { _Pragma("unroll") for (int _i = 0; _i < 2; ++_i) \
        __builtin_amdgcn_global_load_lds((const unsigned*)((const char*)(gbase) + (voff)[_i]), (LAS unsigned*)(lds + (bufoff) + ldsw + _i * 8192), 16, 0, 0); } while (0)
#define PG8_LDA(dst, b, h) do { if constexpr (F8) { _Pragma("unroll") for (int m = 0; m < 4; ++m) { const u32x4 x0_ = *(const LAS u32x4*)(lds + PG8_SA(b, h) + a8o0 + m * 2048), x1_ = *(const LAS u32x4*)(lds + PG8_SA(b, h) + a8o1 + m * 2048); \
            dst##8[m] = __builtin_bit_cast(v8i_t, __builtin_shufflevector(x0_, x1_, 0, 1, 2, 3, 4, 5, 6, 7)); } } \
        else { _Pragma("unroll") for (int m = 0; m < 4; ++m) _Pragma("unroll") for (int k = 0; k < 2; ++k) dst[m][k] = *(const LAS bf16x8*)(lds + PG8_SA(b, h) + aoff + m * 2048 + k * 1024); } } while (0)
#define PG8_LDB(dst, b, h) do { if constexpr (F8) { _Pragma("unroll") for (int n = 0; n < 2; ++n) { const u32x4 x0_ = *(const LAS u32x4*)(lds + PG8_SB(b, h) + b8o0 + n * 2048), x1_ = *(const LAS u32x4*)(lds + PG8_SB(b, h) + b8o1 + n * 2048); \
            dst##8[n] = __builtin_bit_cast(v8i_t, __builtin_shufflevector(x0_, x1_, 0, 1, 2, 3, 4, 5, 6, 7)); } } \
        else { _Pragma("unroll") for (int n = 0; n < 2; ++n) _Pragma("unroll") for (int k = 0; k < 2; ++k) dst[n][k] = *(const LAS bf16x8*)(lds + PG8_SB(b, h) + boff + n * 2048 + k * 1024); } } while (0)
#define PG8_MMA(ai, bj, At, Bt) do { __builtin_amdgcn_s_setprio(1); if constexpr (F8) { _Pragma("unroll") for (int m = 0; m < 4; ++m) _Pragma("unroll") for (int n = 0; n < 2; ++n) \
            asm volatile("v_mfma_scale_f32_16x16x128_f8f6f4 %0, %1, %2, %0, %3, %4 op_sel_hi:[0,0,0]" : "+v"(acc[ai][bj][m][n]) : "v"(Bt##8[n]), "v"(At##8[m]), "v"(scw_), "v"(scx_)); } \
        else { _Pragma("unroll") for (int m = 0; m < 4; ++m) _Pragma("unroll") for (int n = 0; n < 2; ++n) _Pragma("unroll") for (int k = 0; k < 2; ++k) \
            acc[ai][bj][m][n] = __builtin_amdgcn_mfma_f32_16x16x32_bf16(Bt[n][k], At[m][k], acc[ai][bj][m][n], 0, 0, 0); } __builtin_amdgcn_s_setprio(0); } while (0)
#define PG8_WAIT_V(n) asm volatile("s_waitcnt vmcnt(" #n ")" ::: "memory")
#define PG8_WAIT_L(n) asm volatile("s_waitcnt lgkmcnt(" #n ")" ::: "memory")
#define PG8_BAR __builtin_amdgcn_s_barrier()
#define PG8_SCHED __builtin_amdgcn_sched_barrier(0)
#define PG8_VOFFA(u, vo) do { _Pragma("unroll") for (int _h = 0; _h < 2; ++_h) _Pragma("unroll") for (int _i = 0; _i < 2; ++_i) { const int _row = _h * HALF + Ra[_i]; \
        const int _ri = (u).gat ? (_row < (u).valid ? (u).gat[_row] : 0) : _row; vo[_h][_i] = F8 ? (unsigned)(_ri * lda + 2 * Ca[_i]) : (unsigned)(_ri * lda + Ca[_i]) * 2u; } } while (0)

typedef int v8i_t __attribute__((ext_vector_type(8)));
#ifndef MK_FRESH
#define MK_FRESH 1
#endif
template <class Epi, class Sched, bool ALIGN_EPI, bool F8 = false, int SC_W = 0x7f7f7f7f>
__device__ __forceinline__ void gemm_phase(LAS unsigned char* lds, const int K, const int lda, const Sched& S, const Epi& E) {
    int tid_ = threadIdx.x; asm volatile("" : "+v"(tid_));
    const int tid = tid_, wid = __builtin_amdgcn_readfirstlane(tid >> 6), lane = tid & 63, wr = wid >> 2, wc = wid & 3, fr = lane & 15, fq = lane >> 4;
    const int nt = F8 ? K / 128 : K / BK;
    int Ra[2], Ca[2]; unsigned voffB[2];
#pragma unroll
    for (int i = 0; i < 2; ++i) { int R, C; stage_rc(tid * 16 + i * 8192, R, C); const int Rb = Epi::PERM ? ((R & ~31) + perm32(R & 31)) : R; Ra[i] = R; Ca[i] = C; voffB[i] = F8 ? (unsigned)(Rb * K + 2 * C) : (unsigned)(Rb * K + C) * 2u; }
    const size_t kstep = (size_t)(BK * 2);
    const size_t hstep = F8 ? (size_t)HALF * K : (size_t)HALF * K * 2;
    const unsigned ldsw = (unsigned)wid * 1024u;
    const int aoff = lds_byte(wr * 64 + fr, fq * 8), boff = lds_byte(wc * 32 + fr, fq * 8);
    const int a8o0 = lds_byte(wr * 64 + fr, 16 * fq), a8o1 = lds_byte(wr * 64 + fr, 16 * fq + 8), b8o0 = lds_byte(wc * 32 + fr, 16 * fq), b8o1 = lds_byte(wc * 32 + fr, 16 * fq + 8);
    Unit cur, nxt; int ui = 0; bool fresh = false;
    if (!S.next(0, cur)) return;
    Acc acc;
#pragma unroll
    for (int a = 0; a < 2; ++a)
#pragma unroll
        for (int b = 0; b < 2; ++b)
#pragma unroll
            for (int m = 0; m < 4; ++m)
#pragma unroll
                for (int n = 0; n < 2; ++n) acc[a][b][m][n] = (f32x4){0.f, 0.f, 0.f, 0.f};
    bf16x8 At[4][2], B0[2][2], B1[2][2]; v8i_t At8[4], B08[2], B18[2]; const int scw_ = SC_W, scx_ = 0x7f7f7f7f;
    unsigned vC[2][2], vN[2][2];
    PG8_VOFFA(cur, vC);
    const char* cA = cur.A; const char* cB = cur.B;
    PG8_STAGE(PG8_SB(0, 0), cB, voffB); PG8_STAGE(PG8_SB(0, 1), cB + hstep, voffB); PG8_STAGE(PG8_SA(0, 0), cA, vC[0]); PG8_STAGE(PG8_SA(0, 1), cA, vC[1]);
    if (wr == 1) PG8_BAR;
    PG8_WAIT_V(2); PG8_BAR;
    PG8_STAGE(PG8_SB(1, 0), cB + kstep, voffB); PG8_STAGE(PG8_SA(1, 0), cA + kstep, vC[0]); PG8_STAGE(PG8_SB(1, 1), cB + hstep + kstep, voffB);
    PG8_WAIT_V(6); PG8_BAR;
    for (;;) {
        const bool has_next = S.next(ui + 1, nxt);
        if (!has_next) nxt = cur;
        PG8_VOFFA(nxt, vN);
        const char* nA = nxt.A; const char* nB = nxt.B;
#pragma unroll 1
        for (int t = 0; t < nt; t += 2) {
            const bool last = (t == nt - 2);
            const bool skipw = MK_FRESH && Epi::ORDERS && fresh && t == 0;
            const char* a1 = cA + (size_t)(t + 1) * kstep;
            const char* a2 = last ? nA : cA + (size_t)(t + 2) * kstep; const char* b2 = last ? nB : cB + (size_t)(t + 2) * kstep;
            const char* a3 = a2 + kstep; const char* b3 = b2 + kstep;
            unsigned vS[2][2];
#pragma unroll
            for (int h = 0; h < 2; ++h)
#pragma unroll
                for (int i = 0; i < 2; ++i) vS[h][i] = last ? vN[h][i] : vC[h][i];
            PG8_LDB(B0, 0, 0); PG8_LDB(B1, 0, 1); PG8_SCHED; PG8_LDA(At, 0, 0); PG8_STAGE(PG8_SA(1, 1), a1, vC[1]);
            if (!skipw) PG8_WAIT_V(8); PG8_WAIT_L(0); PG8_BAR; PG8_MMA(0, 0, At, B0); PG8_MMA(0, 1, At, B1); PG8_BAR; PG8_SCHED;
            PG8_LDA(At, 0, 1); PG8_STAGE(PG8_SB(0, 0), b2, voffB); PG8_STAGE(PG8_SB(0, 1), b2 + hstep, voffB); PG8_STAGE(PG8_SA(0, 0), a2, vS[0]);
            if (!skipw) PG8_WAIT_V(8); PG8_WAIT_L(0); PG8_BAR; PG8_MMA(1, 0, At, B0); PG8_MMA(1, 1, At, B1); PG8_BAR; PG8_SCHED;
            PG8_LDB(B0, 1, 0); PG8_LDB(B1, 1, 1); PG8_SCHED; PG8_LDA(At, 1, 0); PG8_STAGE(PG8_SA(0, 1), a2, vS[1]);
            PG8_WAIT_V(8); PG8_WAIT_L(0); PG8_BAR; PG8_MMA(0, 0, At, B0); PG8_MMA(0, 1, At, B1); PG8_BAR; PG8_SCHED;
            PG8_LDA(At, 1, 1); PG8_STAGE(PG8_SB(1, 0), b3, voffB); PG8_STAGE(PG8_SB(1, 1), b3 + hstep, voffB); PG8_STAGE(PG8_SA(1, 0), a3, vS[0]);
            PG8_WAIT_V(8); PG8_WAIT_L(0); PG8_BAR; PG8_MMA(1, 0, At, B0); PG8_MMA(1, 1, At, B1); PG8_BAR; PG8_SCHED;
            fresh = false;
        }
        if constexpr (F8) asm volatile("s_nop 15\n\ts_nop 15" ::: "memory");
        if constexpr (ALIGN_EPI) { if (wr == 0) PG8_BAR; }
        if constexpr (!Epi::AFTER_DRAIN) { E(acc, cur, wr, wc, fr, fq); fresh = true; }
        if (!has_next) break;
#pragma unroll
        for (int a = 0; a < 2; ++a)
#pragma unroll
            for (int b = 0; b < 2; ++b)
#pragma unroll
                for (int m = 0; m < 4; ++m)
#pragma unroll
                    for (int n = 0; n < 2; ++n) acc[a][b][m][n] = (f32x4){0.f, 0.f, 0.f, 0.f};
        cur = nxt; cA = nA; cB = nB; ++ui;
#pragma unroll
        for (int h = 0; h < 2; ++h)
#pragma unroll
            for (int i = 0; i < 2; ++i) vC[h][i] = vN[h][i];
        if constexpr (ALIGN_EPI) { if (wr == 1) PG8_BAR; }
    }
    PG8_WAIT_V(0);
    if constexpr (!ALIGN_EPI) { if (wr == 0) PG8_BAR; }
    PG8_BAR;
    if constexpr (Epi::AFTER_DRAIN) { E.fused(acc, cur, wr, wc, fr, fq, lds, wid, lane); }
}
struct DenseOrder {
    int nM, nN, nwg, G, c; const char* A; const char* B; size_t a_tile, b_tile; int a_col_tile;
    int pn_per_ablk;
    int skew_h, skew_a, skew_b;
    __device__ void init(int Mr, int N, int G_, int c_, const void* A_, const void* B_, int lda, int K, int pnpa = 0, int acolbytes = 0, int esz = 2) {
        nM = Mr / BM; nN = N / BM; nwg = nM * nN; G = G_; c = c_; A = (const char*)A_; B = (const char*)B_; a_tile = (size_t)BM * lda * esz; b_tile = (size_t)BM * K * esz; pn_per_ablk = pnpa; a_col_tile = acolbytes; skew_h = 0; skew_a = 0; skew_b = 0; }
    __device__ bool next(int i, Unit& u) const {
        long L = (long)i * G + c;
        if (skew_h > 0) { if (c < skew_h) { if (i >= skew_a) return false; L = (long)c * skew_a + i; } else { if (i >= skew_b) return false; L = (long)skew_h * skew_a + (long)(c - skew_h) * skew_b + i; } }
        if (L >= nwg) return false;
        int wgid = (int)L; { const int q = nwg / 8, r = nwg % 8, xcd = wgid % 8, off = wgid / 8; wgid = (xcd < r ? xcd * (q + 1) : r * (q + 1) + (xcd - r) * q) + off; }
        const int WGM = 8, nig = WGM * nN, gid = wgid / nig, fm = gid * WGM, gsz = (nM - fm) < WGM ? (nM - fm) : WGM;
        u.pm = fm + ((wgid % nig) % gsz); u.pn = (wgid % nig) / gsz;
        u.A = A + (size_t)u.pm * a_tile + (pn_per_ablk ? (size_t)(u.pn / pn_per_ablk) * a_col_tile : 0); u.B = B + (size_t)u.pn * b_tile; u.gat = nullptr; u.valid = 256; u.x0 = 0; u.x1 = 0; return true;
    }
};
struct OneOrder {
    int first, nN; const char* A; const char* B; size_t a_tile, b_tile; int a_col_tile; int c; int total;
    __device__ bool next(int i, Unit& u) const {
        if (i > 0) return false; const int L = first + c; if (L >= total) return false;
        u.pm = L / nN; u.pn = L % nN; u.A = A + (size_t)u.pm * a_tile + (size_t)(u.pn >> 1) * a_col_tile; u.B = B + (size_t)u.pn * b_tile; u.gat = nullptr; u.valid = 256; u.x0 = 0; u.x1 = 0; return true; }
};
struct MoeOrder {
    const volatile LAS int* tpre; const volatile LAS int* cnt; int ncol; int G, c; const char* A; const char* B; size_t b_exp; size_t b_tile; const int* lists; int gather; size_t a_tile;
    __device__ bool next(int i, Unit& u) const {
        const int L = i * G + c; const int ntile = __builtin_amdgcn_readfirstlane(tpre[32]); if (L >= ntile * ncol) return false;
        const int T = L / ncol, pn = L % ncol; const int e = __builtin_amdgcn_readfirstlane(tpre[80 + T]);
        const int rt = __builtin_amdgcn_readfirstlane(T - tpre[e]); int valid = cnt[e] - rt * 256; valid = __builtin_amdgcn_readfirstlane(valid > 256 ? 256 : valid);
        u.pm = T; u.pn = pn; u.x0 = e; u.x1 = rt; u.valid = valid; u.B = B + (size_t)e * b_exp + (size_t)pn * b_tile;
        if (gather) { u.A = A; u.gat = lists + (size_t)e * M + rt * 256; } else { u.A = A + (size_t)T * a_tile; u.gat = nullptr; }
        return true; }
};

#ifndef MK_FRESH_P1
#define MK_FRESH_P1 0
#endif
__device__ __forceinline__ u32x4 pack8(f32x4 a, f32x4 b) { u32x4 w; w.x = pk2(a[0], a[1]); w.y = pk2(a[2], a[3]); w.z = pk2(b[0], b[1]); w.w = pk2(b[2], b[3]); return w; }
__device__ __forceinline__ float dot4(f32x4 a) { return (a[0] * a[0] + a[1] * a[1]) + (a[2] * a[2] + a[3] * a[3]); }

struct EpiProj {
    static constexpr bool PERM = true, AFTER_DRAIN = false, ORDERS = MK_FRESH_P1;
    bf16_t *XR, *GR, *QC, *KVC, *GA, *GB, *HALO; float *KPE, *ssq_q, *ssq_kv;
    __device__ __forceinline__ void operator()(const Acc& acc, const Unit& u, int wr, int wc, int fr, int fq) const {
        const int pn = u.pn, rowb = u.pm * BM + wr * 64 + fr;
        if (pn == 20) {
            if (MK_FRESH_P1) asm volatile("s_waitcnt vmcnt(0)" ::: "memory");
            if (wc == 0) {
#pragma unroll
                for (int ai = 0; ai < 2; ++ai)
#pragma unroll
                    for (int m = 0; m < 4; ++m) { float* p = KPE + (size_t)(rowb + ai * HALF + m * 16) * 32 + 8 * fq; *(f32x4*)p = acc[ai][0][m][0]; *(f32x4*)(p + 4) = acc[ai][0][m][1]; }
            }
            return;
        }
        bf16_t* dst; int ldc, colt, act = 0; float* ssq = nullptr; int nslot = 0, slot = 0;
        if (pn < 4) { dst = XR; ldc = 1024; colt = pn * 256; }
        else if (pn < 8) { dst = GR; ldc = 1024; colt = (pn - 4) * 256; act = 1; }
        else if (pn < 11) { dst = QC; ldc = 768; colt = (pn - 8) * 256; ssq = ssq_q; nslot = 12; slot = (pn - 8) * 4 + wc; act = 3; }
        else if (pn == 11) { dst = KVC; ldc = 256; colt = 0; ssq = ssq_kv; nslot = 4; slot = wc; act = 3; }
        else if (pn < 16) { dst = GA; ldc = 1024; colt = (pn - 12) * 256; act = 2; }
        else { dst = GB; ldc = 1024; colt = (pn - 16) * 256; act = 2; }
        const int col0 = colt + wc * 32 + 8 * fq;
        if (MK_FRESH_P1) asm volatile("s_waitcnt vmcnt(0)" ::: "memory");
#pragma unroll
        for (int ai = 0; ai < 2; ++ai)
#pragma unroll
            for (int m = 0; m < 4; ++m) {
                const int row = rowb + ai * HALF + m * 16; float ss = 0.f;
#pragma unroll
                for (int bj = 0; bj < 2; ++bj) {
                    f32x4 v0 = acc[ai][bj][m][0], v1 = acc[ai][bj][m][1];
                    if (ssq) ss += dot4(v0) + dot4(v1);
                    if (act == 1) {
#pragma unroll
                        for (int e = 0; e < 4; ++e) { v0[e] = fgelu(v0[e]); v1[e] = fgelu(v1[e]); }
                    } else if (act == 2) {
#pragma unroll
                        for (int e = 0; e < 4; ++e) { v0[e] = fsigm(v0[e]); v1[e] = fsigm(v1[e]); }
                    }
                    if (act == 3) { u32x2 w8; int w_ = __builtin_amdgcn_cvt_pk_fp8_f32(v0[0], v0[1], 0, false); w8.x = (unsigned)__builtin_amdgcn_cvt_pk_fp8_f32(v0[2], v0[3], w_, true);
                        w_ = __builtin_amdgcn_cvt_pk_fp8_f32(v1[0], v1[1], 0, false); w8.y = (unsigned)__builtin_amdgcn_cvt_pk_fp8_f32(v1[2], v1[3], w_, true);
                        *(u32x2*)((unsigned char*)dst + (size_t)row * ldc + col0 + bj * HALF) = w8; }
                    else *(u32x4*)(dst + (size_t)row * ldc + col0 + bj * HALF) = pack8(v0, v1);
                }
                if (ssq) { ss += __shfl_xor(ss, 16); ss += __shfl_xor(ss, 32); if (fq == 0) ssq[(size_t)row * nslot + slot] = ss; }
            }
        if (pn < 4 && wr == 1 && fr >= 13) {
#pragma unroll
            for (int bj = 0; bj < 2; ++bj) *(u32x4*)(HALO + ((size_t)u.pm * 3 + (fr - 13)) * 1024 + col0 + bj * HALF) = pack8(acc[1][bj][3][0], acc[1][bj][3][1]);
        }
    }
};

struct EpiQ {
    static constexpr bool PERM = true, AFTER_DRAIN = false, ORDERS = true;
    bf16_t* Q; const float* ssq_q;
    __device__ __forceinline__ void operator()(const Acc& acc, const Unit& u, int wr, int wc, int fr, int fq) const {
        const int rowb = u.pm * BM + wr * 64 + fr, col0 = u.pn * BM + wc * 32 + 8 * fq;
#pragma unroll
        for (int ai = 0; ai < 2; ++ai)
#pragma unroll
            for (int m = 0; m < 4; ++m) {
                const int row = rowb + ai * HALF + m * 16; const float rs = ssq_q[row];
#pragma unroll
                for (int bj = 0; bj < 2; ++bj) *(u32x4*)(Q + (size_t)row * 1536 + col0 + bj * HALF) = pack8(acc[ai][bj][m][0] * rs, acc[ai][bj][m][1] * rs);
            }
    }
};

extern __shared__ __attribute__((aligned(16))) unsigned char kv_lds_raw[];
__device__ __forceinline__ LAS unsigned char* kv_stage_lds() { return (LAS unsigned char*)kv_lds_raw + RING_BYTES; }
struct EpiNull {
    static constexpr bool PERM = true, AFTER_DRAIN = false, ORDERS = false;
    __device__ __forceinline__ void operator()(const Acc& acc, const Unit& u, int wr, int wc, int fr, int fq) const {
#pragma unroll
        for (int a = 0; a < 2; ++a)
#pragma unroll
            for (int b = 0; b < 2; ++b)
#pragma unroll
                for (int m = 0; m < 4; ++m)
#pragma unroll
                    for (int n = 0; n < 2; ++n) asm volatile("" :: "v"(acc[a][b][m][n]));
    }
};
#ifndef MK_KVCLOB
#define MK_KVCLOB 1
#endif
struct EpiKV {
    static constexpr bool PERM = true, AFTER_DRAIN = false, ORDERS = true;
    unsigned char* KIMG; unsigned char* VIMG; const float* ssq_kv; const float* kssq; const float* KPER; const float* kg;
    __device__ __forceinline__ void operator()(const Acc& acc, const Unit& u, int wr, int wc, int fr, int fq) const {
        asm volatile("" : "+v"(fr), "+v"(fq));
        const int rowb = u.pm * BM + wr * 64 + fr, h = 2 * u.pn + (wc & 1);
        if (wc < 2) {
            f32x4 g[2][2];
#pragma unroll
            for (int bj = 0; bj < 2; ++bj)
#pragma unroll
                for (int n = 0; n < 2; ++n) g[bj][n] = *(const f32x4*)(kg + 32 * bj + 8 * fq + 4 * n);
#pragma unroll
            for (int am = 0; am < 8; ++am) { const int ai = am >> 2;
                f32x4 kr[4][2];
#pragma unroll
                for (int m = (am & 3); m < (am & 3) + 1; ++m) { const float* kp_ = KPER + (size_t)(rowb + ai * HALF + m * 16) * 32 + 8 * fq; kr[m][0] = *(const f32x4*)kp_; kr[m][1] = *(const f32x4*)(kp_ + 4); }
#pragma unroll
                for (int m = (am & 3); m < (am & 3) + 1; ++m) {
                    const int row = rowb + ai * HALF + m * 16; const float rs = ssq_kv[row], ksq = kssq[row];
                    f32x4 v[2][2]; float ss = 0.f;
#pragma unroll
                    for (int bj = 0; bj < 2; ++bj)
#pragma unroll
                        for (int n = 0; n < 2; ++n) { v[bj][n] = acc[ai][bj][m][n] * rs; ss += dot4(v[bj][n]); }
                    ss += __shfl_xor(ss, 16); ss += __shfl_xor(ss, 32);
                    const float rk = rsqrtf((ss + ksq) * (1.f / 96.f) + EPS);
#if MK_FP8K
                    unsigned char* img = KIMG + ((size_t)h * 256 + (row >> 6)) * 8192;
#pragma unroll
                    for (int bj = 0; bj < 2; ++bj) { const f32x4 x0 = v[bj][0] * g[bj][0] * rk, x1 = v[bj][1] * g[bj][1] * rk; u32x2 w;
                        int w0 = __builtin_amdgcn_cvt_pk_fp8_f32(x0[0], x0[1], 0, false); w0 = __builtin_amdgcn_cvt_pk_fp8_f32(x0[2], x0[3], w0, true);
                        int w1 = __builtin_amdgcn_cvt_pk_fp8_f32(x1[0], x1[1], 0, false); w1 = __builtin_amdgcn_cvt_pk_fp8_f32(x1[2], x1[3], w1, true);
                        w.x = (unsigned)w0; w.y = (unsigned)w1;
                        *(u32x2*)(img + ((row & 63) >> 5) * 2048 + bj * 1024 + (fq >> 1) * 512 + (row & 31) * 16 + 8 * (fq & 1)) = w; }
                    *(u32x4*)(img + 4096 + fq * 1024 + (row & 63) * 16) = pack8(kr[m][0] * rk, kr[m][1] * rk);
#else
                    unsigned char* img = KIMG + ((size_t)h * 256 + (row >> 6)) * 12288 + (row & 63) * 16;
#pragma unroll
                    for (int bj = 0; bj < 2; ++bj) *(u32x4*)(img + (4 * bj + fq) * 1024) = pack8(v[bj][0] * g[bj][0] * rk, v[bj][1] * g[bj][1] * rk);
                    *(u32x4*)(img + (8 + fq) * 1024) = pack8(kr[m][0] * rk, kr[m][1] * rk);
#endif
                }
                if (MK_KVCLOB && (am & 3) == 3) asm volatile("" ::: "memory");
            }
        } else {
#if MK_FP8V
            LAS unsigned char* stg = (LAS unsigned char*)kv_stage_lds() + (wr * 2 + (wc - 2)) * 4096;
#pragma unroll
            for (int ai = 0; ai < 2; ++ai) {
#pragma unroll
                for (int m = 0; m < 4; ++m) {
                    const int row = rowb + ai * HALF + m * 16; const float rs = ssq_kv[row]; const int key = row & 63, kk = key & 31;
                    LAS unsigned char* img = stg + ((kk >> 2) & 1) * 1024 + (key >> 5) * 512 + ((kk & 3) + 4 * (kk >> 3)) + fq * 128;
#pragma unroll
                    for (int bj = 0; bj < 2; ++bj) { const f32x4 v0 = acc[ai][bj][m][0] * rs, v1 = acc[ai][bj][m][1] * rs;
                        unsigned w0 = (unsigned)__builtin_amdgcn_cvt_pk_fp8_f32(v0[0], v0[1], 0, false); w0 = (unsigned)__builtin_amdgcn_cvt_pk_fp8_f32(v0[2], v0[3], (int)w0, true);
                        unsigned w1 = (unsigned)__builtin_amdgcn_cvt_pk_fp8_f32(v1[0], v1[1], 0, false); w1 = (unsigned)__builtin_amdgcn_cvt_pk_fp8_f32(v1[2], v1[3], (int)w1, true);
                        LAS unsigned char* p = img + bj * 2048;
                        p[0] = (unsigned char)w0; p[16] = (unsigned char)(w0 >> 8); p[32] = (unsigned char)(w0 >> 16); p[48] = (unsigned char)(w0 >> 24);
                        p[64] = (unsigned char)w1; p[80] = (unsigned char)(w1 >> 8); p[96] = (unsigned char)(w1 >> 16); p[112] = (unsigned char)(w1 >> 24); }
                }
                LDS_WAIT();
                unsigned char* tile = VIMG + ((size_t)h * 256 + ((u.pm * BM + wr * 64 + ai * HALF) >> 6)) * 4096; const int ln = fr + 16 * fq;
#pragma unroll
                for (int i = 0; i < 4; ++i) *(u32x4*)(tile + i * 1024 + ln * 16) = *(const LAS u32x4*)(stg + i * 1024 + ln * 16);
            }
#else
#pragma unroll
            for (int ai = 0; ai < 2; ++ai)
#pragma unroll
                for (int m = 0; m < 4; ++m) {
                    const int row = rowb + ai * HALF + m * 16; const float rs = ssq_kv[row]; const int key = row & 63;
                    unsigned char* img = VIMG + ((size_t)h * 256 + (row >> 6)) * 8192 + (key >> 4) * 1024 + (key & 15) * 64 + fq * 16;
#pragma unroll
                    for (int bj = 0; bj < 2; ++bj) *(u32x4*)(img + bj * 4096) = pack8(acc[ai][bj][m][0] * rs, acc[ai][bj][m][1] * rs);
                }
#endif
        }
    }
};

template <bool DRY> struct EpiLruT {
    static constexpr bool PERM = false, AFTER_DRAIN = true, ORDERS = false;
    const bf16_t* XA; const float *ba, *bx, *lam; bf16_t* GRio; bf16_t* GAio; float* HEND; float* AEND;
    __device__ __forceinline__ void fused(Acc& acc, const Unit& u, int wr, int wc, int fr, int fq, LAS unsigned char* lds, int wid, int lane) const {
        int tid = threadIdx.x; asm volatile("" : "+v"(tid));
        const int chb = 256 * (u.pn >> 1) + 128 * (u.pn & 1);
        LAS unsigned* S = (LAS unsigned*)lds;
        {
            f32x4 vba[2], vbx[2], vsp[2];
#pragma unroll
            for (int n = 0; n < 2; ++n) { const int c = chb + 32 * wc + 16 * n + 4 * fq; vba[n] = *(const f32x4*)(ba + c); vbx[n] = *(const f32x4*)(bx + c); const f32x4 l4 = *(const f32x4*)(lam + c);
#pragma unroll
                for (int e = 0; e < 4; ++e) vsp[n][e] = -8.f * LOG2E * log1pf(expf(-l4[e])); }
#pragma unroll
            for (int am = 0; am < 4; ++am) { const int ai = am >> 1;
                u32x2 xw[4][2];
#pragma unroll
                for (int m = 2 * (am & 1); m < 2 * (am & 1) + 2; ++m)
#pragma unroll
                    for (int n = 0; n < 2; ++n) xw[m][n] = *(const u32x2*)((const char*)XA + (unsigned)((((unsigned)(u.pm * BM + ai * HALF + wr * 64 + m * 16 + fr)) * 1024u + (unsigned)(chb + 32 * wc + 16 * n + 4 * fq)) * 2u));
#pragma unroll
                for (int m = 2 * (am & 1); m < 2 * (am & 1) + 2; ++m) {
                    const int r = ai * HALF + wr * 64 + m * 16 + fr;
#pragma unroll
                    for (int n = 0; n < 2; ++n) {
                        const int x0 = 32 * wc + 16 * n + 4 * fq;
                        const float xa[4] = {lo2f(xw[m][n].x), hi2f(xw[m][n].x), lo2f(xw[m][n].y), hi2f(xw[m][n].y)}; u32x4 o;
#pragma unroll
                        for (int e = 0; e < 4; ++e) {
                            const float rr = fsigm(acc[ai][0][m][n][e] + vba[n][e]), ii = fsigm(acc[ai][1][m][n][e] + vbx[n][e]);
                            const float la2 = rr * vsp[n][e]; const float a2 = fexp2(2.f * la2); const float mult = sqrtf(fmaxf(1.f - a2, 0.f));
                            o[e] = pk2(mult * ii * xa[e], la2);
                        }
                        *(LAS u32x4*)(S + r * 132 + x0) = o;
                    }
                }
                asm volatile("" ::: "memory");
            }
        }
        const int cp = tid & 63, sg = tid >> 6, c0 = 2 * cp; LAS f32x4* X = (LAS f32x4*)(lds + LDS_XCH);
        const unsigned gb32 = ((unsigned)(u.pm * BM) * 1024u + (unsigned)(chb + c0)) * 2u;
        asm volatile("" ::: "memory");
        unsigned gr[32], ga[32];
#pragma unroll
        for (int j = 0; j < 32; ++j) { const unsigned ob = gb32 + (unsigned)(sg * 32 + j) * 2048u; gr[j] = *(const unsigned*)((const char*)GRio + ob); ga[j] = *(const unsigned*)((const char*)GAio + ob); }
        LDS_WAIT(); __builtin_amdgcn_s_barrier(); asm volatile("" ::: "memory");
        float h0 = 0.f, h1 = 0.f, s0 = 0.f, s1 = 0.f;
#pragma unroll 8
        for (int j = 0; j < 32; ++j) { const int r = sg * 32 + j; const u32x2 w = *(const LAS u32x2*)(S + r * 132 + c0);
            const float l0 = hi2f(w.x), l1 = hi2f(w.y); h0 = fexp2(l0) * h0 + lo2f(w.x); h1 = fexp2(l1) * h1 + lo2f(w.y); s0 += l0; s1 += l1; }
        X[sg * 64 + cp] = (f32x4){h0, s0, h1, s1};
        LDS_WAIT(); __builtin_amdgcn_s_barrier(); asm volatile("" ::: "memory");
        h0 = 0.f; h1 = 0.f; s0 = 0.f; s1 = 0.f;
        for (int q = 0; q < sg; ++q) { const f32x4 x = X[q * 64 + cp]; h0 = fexp2(x[1]) * h0 + x[0]; s0 += x[1]; h1 = fexp2(x[3]) * h1 + x[2]; s1 += x[3]; }
#pragma unroll
        for (int j = 0; j < 32; ++j) { const int r = sg * 32 + j; const u32x2 w = *(const LAS u32x2*)(S + r * 132 + c0);
            const float l0 = hi2f(w.x), l1 = hi2f(w.y); h0 = fexp2(l0) * h0 + lo2f(w.x); h1 = fexp2(l1) * h1 + lo2f(w.y); s0 += l0; s1 += l1;
            const unsigned ob = gb32 + (unsigned)r * 2048u;
            const float g0 = lo2f(gr[j]) * lo2f(ga[j]), g1 = hi2f(gr[j]) * hi2f(ga[j]);
            const unsigned o1_ = pk2(h0 * g0, h1 * g1), o2_ = pk2(fexp2(s0) * g0, fexp2(s1) * g1); if (DRY) asm volatile("" :: "v"(o1_), "v"(o2_)); else { *(unsigned*)((char*)GRio + ob) = o1_; *(unsigned*)((char*)GAio + ob) = o2_; }
            if ((j & 3) == 3) asm volatile("" ::: "memory"); }
        if (sg == 7 && !DRY) { *(f32x2*)(HEND + (size_t)u.pm * 1024 + chb + c0) = (f32x2){h0, h1}; *(f32x2*)(AEND + (size_t)u.pm * 1024 + chb + c0) = (f32x2){fexp2(s0), fexp2(s1)}; }
        LDS_WAIT(); __builtin_amdgcn_s_barrier(); asm volatile("" ::: "memory");
    }
};

struct EpiWout {
    static constexpr bool PERM = true, AFTER_DRAIN = false, ORDERS = true;
    const float* x; float* out; bf16_t* HB; float* ssq_h;
    __device__ __forceinline__ void operator()(const Acc& acc, const Unit& u, int wr, int wc, int fr, int fq) const {
        const int rowb = u.pm * BM + wr * 64 + fr, col0 = u.pn * BM + wc * 32 + 8 * fq;
#pragma unroll
        for (int ai = 0; ai < 2; ++ai)
#pragma unroll
            for (int m = 0; m < 4; ++m) {
                const int row = rowb + ai * HALF + m * 16; float ss = 0.f;
#pragma unroll
                for (int bj = 0; bj < 2; ++bj) { const size_t o = (size_t)row * 1024 + col0 + bj * HALF;
                    const f32x4 h0 = *(const f32x4*)(x + o) + acc[ai][bj][m][0], h1 = *(const f32x4*)(x + o + 4) + acc[ai][bj][m][1];
                    ss += dot4(h0) + dot4(h1); *(f32x4*)(out + o) = h0; *(f32x4*)(out + o + 4) = h1;
                    { u32x2 w8; int w_ = __builtin_amdgcn_cvt_pk_fp8_f32(h0[0], h0[1], 0, false); w8.x = (unsigned)__builtin_amdgcn_cvt_pk_fp8_f32(h0[2], h0[3], w_, true); w_ = __builtin_amdgcn_cvt_pk_fp8_f32(h1[0], h1[1], 0, false); w8.y = (unsigned)__builtin_amdgcn_cvt_pk_fp8_f32(h1[2], h1[3], w_, true);
                      *(u32x2*)((unsigned char*)HB + o) = w8; } }
                ss += __shfl_xor(ss, 16); ss += __shfl_xor(ss, 32); if (fq == 0) ssq_h[(size_t)row * 16 + u.pn * 4 + wc] = ss;
            }
    }
};

struct EpiMoeGU {
    static constexpr bool PERM = false, AFTER_DRAIN = false, ORDERS = true;
    bf16_t* HID; const float* ssq_h; const int* lists;
    __device__ __forceinline__ void operator()(const Acc& acc, const Unit& u, int wr, int wc, int fr, int fq) const {
        const int rb = wr * 64 + fr; float rsv[2][4];
#pragma unroll
        for (int ai = 0; ai < 2; ++ai)
#pragma unroll
            for (int m = 0; m < 4; ++m) { const int r = rb + ai * HALF + m * 16; const int rc = r < u.valid ? r : u.valid - 1; rsv[ai][m] = ssq_h[lists[(size_t)u.x0 * M + u.x1 * 256 + rc]]; }
        asm volatile("" :: "v"(rsv[0][0]));
#pragma unroll
        for (int ai = 0; ai < 2; ++ai)
#pragma unroll
            for (int m = 0; m < 4; ++m) {
                const int r = rb + ai * HALF + m * 16;
                if (r < u.valid) {
                    const float rs = rsv[ai][m];
#pragma unroll
                    for (int n = 0; n < 2; ++n) { f32x4 g = acc[ai][0][m][n] * rs, up = acc[ai][1][m][n] * rs, hb;
#pragma unroll
                        for (int e = 0; e < 4; ++e) hb[e] = g[e] * fsigm(g[e]) * up[e];
                        int w_ = __builtin_amdgcn_cvt_pk_fp8_f32(hb[0], hb[1], 0, false); w_ = __builtin_amdgcn_cvt_pk_fp8_f32(hb[2], hb[3], w_, true);
                        *(unsigned*)((char*)HID + (unsigned)(((unsigned)u.pm * 256u + (unsigned)r) * 256u + 128u * (unsigned)u.pn + 32u * (unsigned)wc + 16u * (unsigned)n + 4u * (unsigned)fq)) = (unsigned)w_; }
                }
            }
    }
};
template <int VAR> struct EpiMoeDownT {
    static constexpr bool PERM = true, AFTER_DRAIN = false, ORDERS = (VAR == 0);
    bf16_t* Y; const float* cwl;
    __device__ __forceinline__ void operator()(const Acc& acc, const Unit& u, int wr, int wc, int fr, int fq) const {
        asm volatile("" : "+v"(fr), "+v"(fq));
        const int rb = wr * 64 + fr, col0 = u.pn * BM + wc * 32 + 8 * fq;
#pragma unroll
        for (int ai = 0; ai < 2; ++ai) {
            float cwv[4];
#pragma unroll
            for (int m = 0; m < 4; ++m) { const int r = rb + ai * HALF + m * 16; const int rc = r < u.valid ? r : u.valid - 1; cwv[m] = (VAR == 2) ? 1.f : cwl[(size_t)u.x0 * M + u.x1 * 256 + rc] * 8.f; }
            if (ai == 0) asm volatile("" :: "v"(cwv[0]));
#pragma unroll
            for (int m = 0; m < 4; ++m) {
                const int r = rb + ai * HALF + m * 16;
                if (r < u.valid) { const float cw = cwv[m];
#pragma unroll
                    for (int bj = 0; bj < 2; ++bj) { const f32x4 y0 = acc[ai][bj][m][0] * cw, y1 = acc[ai][bj][m][1] * cw; u32x2 w8;
                        int w_ = __builtin_amdgcn_cvt_pk_fp8_f32(y0[0], y0[1], 0, false); w8.x = (unsigned)__builtin_amdgcn_cvt_pk_fp8_f32(y0[2], y0[3], w_, true);
                        w_ = __builtin_amdgcn_cvt_pk_fp8_f32(y1[0], y1[1], 0, false); w8.y = (unsigned)__builtin_amdgcn_cvt_pk_fp8_f32(y1[2], y1[3], w_, true);
                        if (VAR == 1) asm volatile("" :: "v"(w8)); else *(u32x2*)((char*)Y + (unsigned)(((unsigned)u.pm * 256u + (unsigned)r) * 1024u + (unsigned)(col0 + bj * HALF))) = w8; } }
            }
            asm volatile("" ::: "memory");
        }
    }
};
typedef EpiMoeDownT<0> EpiMoeDown;
#define LANE_NOW() ({ int t__ = threadIdx.x; asm volatile("" : "+v"(t__)); t__ & 63; })
struct Frame {
    LAS unsigned char* lds; volatile LAS unsigned* MISC; gu32* ctl;
    int tid, lane, wave, vcu, G;
    void* const* in_dummy;
};
struct Args { const void* in[26]; float* out; unsigned char* ws; int ph_lo, ph_hi; };
typedef const __attribute__((address_space(4))) Args& CArgs;

__device__ __forceinline__ int crow(int r, int hi) { return (r & 3) + 8 * (r >> 2) + 4 * hi; }
__device__ __forceinline__ void tr_item(const float* W, int ldn, int ns0, bf16_t* WT, int K, int nd0, int k0, const float* kscale, LAS float* scr, int lane, int ncols = 64, int nwrite = 64, float f8mul = 0.f) {
    const int c4 = (lane & 15) * 4, kr = lane >> 4;
    f32x4 v[16];
#pragma unroll
    for (int i = 0; i < 16; ++i) { const int kk = 4 * i + kr; v[i] = (c4 < ncols) ? *(const f32x4*)(W + (size_t)(k0 + kk) * ldn + ns0 + c4) : (f32x4){0.f, 0.f, 0.f, 0.f}; }
#pragma unroll
    for (int i = 0; i < 16; ++i) { const int kk = 4 * i + kr; f32x4 x = v[i]; if (kscale) x = x * kscale[k0 + kk];
        LAS float* p = scr + kk * 65 + c4; p[0] = x[0]; p[1] = x[1]; p[2] = x[2]; p[3] = x[3]; }
    LDS_WAIT(); asm volatile("" ::: "memory");
    const int c = lane & 7;
#pragma unroll
    for (int j = 0; j < 8; ++j) { const int n = (lane >> 3) + 8 * j; if (n >= nwrite) break; const LAS float* sp = scr + (8 * c) * 65 + n;
        if (f8mul != 0.f) { u32x2 o8; int w_ = __builtin_amdgcn_cvt_pk_fp8_f32(sp[0 * 65] * f8mul, sp[1 * 65] * f8mul, 0, false); o8.x = (unsigned)__builtin_amdgcn_cvt_pk_fp8_f32(sp[2 * 65] * f8mul, sp[3 * 65] * f8mul, w_, true);
            w_ = __builtin_amdgcn_cvt_pk_fp8_f32(sp[4 * 65] * f8mul, sp[5 * 65] * f8mul, 0, false); o8.y = (unsigned)__builtin_amdgcn_cvt_pk_fp8_f32(sp[6 * 65] * f8mul, sp[7 * 65] * f8mul, w_, true);
            *(u32x2*)((unsigned char*)WT + (size_t)(nd0 + n) * K + k0 + 8 * c) = o8; continue; }
        u32x4 o; o.x = pk2(sp[0 * 65], sp[1 * 65]); o.y = pk2(sp[2 * 65], sp[3 * 65]); o.z = pk2(sp[4 * 65], sp[5 * 65]); o.w = pk2(sp[6 * 65], sp[7 * 65]);
        *(u32x4*)(WT + (size_t)(nd0 + n) * K + k0 + 8 * c) = o; }
    LDS_WAIT(); asm volatile("" ::: "memory");
}

__device__ __forceinline__ void p0_prologue(Frame& F, CArgs a) {
    LAS float* scr = (LAS float*)(F.lds + F.wave * 16640);
    const int gw = F.vcu * NWAVES + F.wave, NGW = F.G * NWAVES, lane = LANE_NOW();
    unsigned char* ws = a.ws;
    const float* w_in = (const float*)a.in[3];
    bf16_t* WIN = (bf16_t*)(ws + WS_WIN); bf16_t* WUQ = (bf16_t*)(ws + WS_WUQ); bf16_t* WUKV = (bf16_t*)(ws + WS_WUKV); bf16_t* WLRU = (bf16_t*)(ws + WS_WLRU); bf16_t* WOUT = (bf16_t*)(ws + WS_WOUT);
    constexpr int I_IN = 16 * 81, I_UQ = 12 * 24, I_UKV = 4 * 32, I_LRU = 4 * 32, I_OUT = 16 * 16, NITEMS = I_IN + I_UQ + I_UKV + I_LRU + I_OUT;
    for (int it = gw; it < NITEMS; it += NGW) {
        int r = it;
        if (r < I_IN) { const int kb = r / 81, nb = r % 81, nd0 = 64 * nb, k0 = 64 * kb;
            if (nd0 < 5120) tr_item(w_in, 5152, nd0 < 3072 ? nd0 : nd0 + 32, WIN, 1024, nd0, k0, nullptr, scr, lane);
            else tr_item(w_in, 5152, 3072, WIN, 1024, nd0, k0, nullptr, scr, lane, 32, 32);
            continue; }
        r -= I_IN;
        if (r < I_UQ) { const int kb = r / 24, nb = r % 24; tr_item((const float*)a.in[12], 1536, 64 * nb, WUQ, 768, 64 * nb, 64 * kb, (const float*)a.in[11], scr, lane, 64, 64, 32.f); continue; }
        r -= I_UQ;
        if (r < I_UKV) { const int kb = r / 32, nb = r % 32, nd0 = 64 * nb, pn = nd0 >> 8, bj = (nd0 >> 7) & 1, wcp = (nd0 >> 6) & 1;
#pragma unroll 1
            for (int hh = 0; hh < 2; ++hh) tr_item((const float*)a.in[14], 2048, (2 * pn + hh) * 128 + wcp * 64 + 32 * bj, WUKV, 256, nd0 + 32 * hh, 64 * kb, (const float*)a.in[13], scr, lane, 32, 32, 16.f);
            continue; }
        r -= I_UKV;
        if (r < I_LRU) { const int kb = r / 32, nb = r % 32, nd0 = 64 * nb, pn = nd0 >> 8, bj = (nd0 >> 7) & 1, xb = nd0 & 127, blk = pn >> 1;
            tr_item((const float*)a.in[bj ? 8 : 6] + (size_t)blk * 65536, 256, 128 * (pn & 1) + xb, WLRU, 256, nd0, 64 * kb, nullptr, scr, lane); continue; }
        r -= I_LRU;
        { const int kb = r / 16, nb = r % 16; tr_item((const float*)a.in[17], 1024, 64 * nb, WOUT, 1024, 64 * nb, 64 * kb, nullptr, scr, lane); }
    }
    const float* x = (const float*)a.in[0]; const float* gm = (const float*)a.in[2]; bf16_t* XN = (bf16_t*)(ws + WS_R1);
    f32x4 g4[4];
#pragma unroll
    for (int j = 0; j < 4; ++j) g4[j] = *(const f32x4*)(gm + 4 * lane + 256 * j);
    for (int m = gw; m < M; m += NGW) {
        const f32x4* xr = (const f32x4*)(x + (size_t)m * D) + lane; f32x4 v[4]; float s = 0.f;
#pragma unroll
        for (int j = 0; j < 4; ++j) { v[j] = xr[64 * j]; s += dot4(v[j]); }
        const float rstd = rsqrtf(wave_sum(s) * (1.f / 1024.f) + EPS);
        u32x2* o8 = (u32x2*)(XN + (size_t)m * D) + lane;
#pragma unroll
        for (int j = 0; j < 4; ++j) { const f32x4 y = v[j] * rstd * g4[j]; u32x2 w; w.x = pk2(y[0], y[1]); w.y = pk2(y[2], y[3]); o8[64 * j] = w; }
    }
    const int gt = F.vcu * NTHREADS + F.tid, NGT = F.G * NTHREADS;
    const int* pos = (const int*)a.in[1]; float* CS = (float*)(ws + WS_CS);
    for (int i = gt; i < M * 16; i += NGT) { const int t = i >> 4, j = i & 15; const float fr = powf(10000.f, -(float)j / 16.f); const float ang = (float)pos[t] * fr; CS[t * 32 + j] = cosf(ang); CS[t * 32 + 16 + j] = sinf(ang); }
    float* WR = (float*)(ws + WS_MISC + MISC_WR); const float* gf = (const float*)a.in[18]; const float* wg = (const float*)a.in[19]; const float* we = (const float*)a.in[21];
    for (int i = gt; i < 36 * 1024; i += NGT) { const int j = i >> 10, k = i & 1023; WR[i] = (j < 4 ? wg[k * 4 + j] : we[k * 32 + (j - 4)]) * gf[k]; }
}

__device__ __forceinline__ void moe_weight_convert(Frame& F, CArgs a, int part, int lo, int nblk) {
    LAS float* scr = (LAS float*)(F.lds + F.wave * 16640);
    const int gw = lo * NWAVES + F.wave, NGW = nblk * NWAVES, lane = LANE_NOW();
    bf16_t* WGU = (bf16_t*)(a.ws + WS_WGU); bf16_t* WDN = (bf16_t*)(a.ws + WS_WDN); const float* gf = (const float*)a.in[18];
    constexpr int I_GU = 32 * 16 * 8, I_DN = 32 * 4 * 16;
    for (int it = (part == 0 ? gw : I_GU + gw); it < (part == 0 ? I_GU : I_GU + I_DN); it += NGW) {
        if (it < I_GU) { const int e = it >> 7, r = it & 127, kb = r >> 3, nb = r & 7, nd0 = 64 * nb, pn = nd0 >> 8, bj = (nd0 >> 7) & 1, xb = nd0 & 127;
            tr_item((const float*)a.in[bj ? 24 : 23] + (size_t)e * 262144, 256, 128 * pn + xb, (bf16_t*)((unsigned char*)WGU + (size_t)e * 524288), 1024, nd0, 64 * kb, gf, scr, lane, 64, 64, 32.f); }
        else { const int r0 = it - I_GU, e = r0 >> 6, r = r0 & 63, kb = r >> 4, nb = r & 15;
            tr_item((const float*)a.in[25] + (size_t)e * 262144, 1024, 64 * nb, (bf16_t*)((unsigned char*)WDN + (size_t)e * 262144), 256, 64 * nb, 64 * kb, nullptr, scr, lane, 64, 64, 16.f); }
    }
}

template <bool DRY> __device__ __forceinline__ void p2a_conv(Frame& F, CArgs a) {
    unsigned char* ws = a.ws; bf16_t* XR = (bf16_t*)(ws + WS_XR); const bf16_t* HALO = (const bf16_t*)(ws + WS_MISC + MISC_HALO);
    const float* cw = (const float*)a.in[4]; const float* cb = (const float*)a.in[5];
    for (int b = F.vcu; b < 256; b += F.G) {
        const int pm = b >> 2, cg = b & 3, cp = F.tid & 127, sg = F.tid >> 7, c = cg * 256 + 2 * cp, base = pm * 256 + sg * 64;
        float h0[3], h1[3];
#pragma unroll
        for (int i = 0; i < 3; ++i) { unsigned w = 0u;
            if (sg == 0) { if (pm > 0) w = *(const unsigned*)(HALO + ((size_t)(pm - 1) * 3 + i) * 1024 + c); }
            else w = *(const unsigned*)(XR + (size_t)(base - 3 + i) * 1024 + c);
            h0[i] = lo2f(w); h1[i] = hi2f(w); }
        VM_WAIT(); __syncthreads();
        float w0[4], w1[4];
#pragma unroll
        for (int k = 0; k < 4; ++k) { w0[k] = cw[k * 1024 + c]; w1[k] = cw[k * 1024 + c + 1]; }
        const float b0 = cb[c], b1 = cb[c + 1];
        for (int j0 = 0; j0 < 64; j0 += 8) {
            unsigned xw[8];
#pragma unroll
            for (int j = 0; j < 8; ++j) xw[j] = *(const unsigned*)(XR + (size_t)(base + j0 + j) * 1024 + c);
#pragma unroll
            for (int j = 0; j < 8; ++j) { const float x0 = lo2f(xw[j]), x1 = hi2f(xw[j]);
                const float y0 = b0 + w0[0] * h0[0] + w0[1] * h0[1] + w0[2] * h0[2] + w0[3] * x0, y1 = b1 + w1[0] * h1[0] + w1[1] * h1[1] + w1[2] * h1[2] + w1[3] * x1;
                h0[0] = h0[1]; h0[1] = h0[2]; h0[2] = x0; h1[0] = h1[1]; h1[1] = h1[2]; h1[2] = x1;
                const unsigned yw_ = pk2(y0, y1); if (DRY) asm volatile("" :: "v"(yw_)); else *(unsigned*)(XR + (size_t)(base + j0 + j) * 1024 + c) = yw_; }
        }
        __syncthreads();
    }
    if (!DRY && F.wave < 4) {
        const float* PQ = (const float*)(ws + WS_SSQP); const float* PKV = (const float*)(ws + WS_SSQP + SSQP_KV); float* RQ = (float*)(ws + WS_CTL + CTL_SSQ_Q); float* RKV = (float*)(ws + WS_CTL + CTL_SSQ_KV);
        float* KPE = (float*)(ws + WS_KPE); const float* CS = (const float*)(ws + WS_CS); float* KSSQ = (float*)(ws + WS_MISC + MISC_KSSQ); const float* kg = (const float*)a.in[16];
        const bf16_t* XN = (const bf16_t*)(ws + WS_R1); const bf16_t* WK = (const bf16_t*)(ws + WS_WIN) + (size_t)5120 * 1024;
        const int lane = LANE_NOW(), r16 = lane & 15, q4 = lane >> 4; LAS float* kl = (LAS float*)(F.lds + F.wave * 4096);
        for (int rb = F.vcu * 4 + F.wave; rb < M / 16; rb += F.G * 4) {
            const bf16_t* ap = XN + (size_t)(rb * 16 + r16) * 1024 + 8 * q4; const bf16_t* bp0 = WK + (size_t)r16 * 1024 + 8 * q4; const bf16_t* bp1 = bp0 + 16 * 1024;
            f32x4 acc0 = {0.f, 0.f, 0.f, 0.f}, acc1 = acc0;
#pragma unroll 8
            for (int s32 = 0; s32 < 32; ++s32) { const bf16x8 av = *(const bf16x8*)(ap + 32 * s32), b0 = *(const bf16x8*)(bp0 + 32 * s32), b1 = *(const bf16x8*)(bp1 + 32 * s32);
                acc0 = __builtin_amdgcn_mfma_f32_16x16x32_bf16(av, b0, acc0, 0, 0, 0); acc1 = __builtin_amdgcn_mfma_f32_16x16x32_bf16(av, b1, acc1, 0, 0, 0); }
#pragma unroll
            for (int i2 = 0; i2 < 4; ++i2) { kl[(4 * q4 + i2) * 33 + r16] = acc0[i2]; kl[(4 * q4 + i2) * 33 + 16 + r16] = acc1[i2]; }
            LDS_WAIT();
            if (lane < 16) {
                const int row = rb * 16 + lane; float kp[32]; float ss = 0.f;
#pragma unroll
                for (int j2 = 0; j2 < 32; ++j2) { kp[j2] = kl[lane * 33 + j2]; ss += kp[j2] * kp[j2]; }
                KSSQ[row] = ss;
                { const f32x4 a0 = *(const f32x4*)(PQ + (size_t)row * 12), a1 = *(const f32x4*)(PQ + (size_t)row * 12 + 4), a2 = *(const f32x4*)(PQ + (size_t)row * 12 + 8), b0 = *(const f32x4*)(PKV + (size_t)row * 4);
                  const float sq = ((a0[0] + a0[1]) + (a0[2] + a0[3])) + ((a1[0] + a1[1]) + (a1[2] + a1[3])) + ((a2[0] + a2[1]) + (a2[2] + a2[3])), sk = (b0[0] + b0[1]) + (b0[2] + b0[3]);
                  RQ[row] = rsqrtf(sq * (1.f / 768.f) + EPS); RKV[row] = rsqrtf(sk * (1.f / 256.f) + EPS); }
#pragma unroll
                for (int i = 0; i < 4; ++i) { const f32x4 g1 = *(const f32x4*)(kg + 64 + 4 * i), g2 = *(const f32x4*)(kg + 80 + 4 * i), cs = *(const f32x4*)(CS + (size_t)row * 32 + 4 * i), sn = *(const f32x4*)(CS + (size_t)row * 32 + 16 + 4 * i);
                    f32x4 o1, o2;
#pragma unroll
                    for (int e = 0; e < 4; ++e) { const float k1 = kp[4 * i + e] * g1[e], k2 = kp[16 + 4 * i + e] * g2[e]; o1[e] = k1 * cs[e] - k2 * sn[e]; o2[e] = k1 * sn[e] + k2 * cs[e]; }
                    *(f32x4*)(KPE + (size_t)row * 32 + 4 * i) = o1; *(f32x4*)(KPE + (size_t)row * 32 + 16 + 4 * i) = o2; }
            }
            LDS_WAIT();
        }
    }
}

__device__ __forceinline__ void glds16(const void* gsrc, unsigned lds_dst) { unsigned keep;
    asm volatile("s_mov_b32 %0, m0\n\ts_mov_b32 m0, %2\n\ts_nop 0\n\tglobal_load_lds_dwordx4 %1, off\n\ts_mov_b32 m0, %0" : "=&s"(keep) : "v"(gsrc), "s"(lds_dst) : "memory"); }
__device__ __forceinline__ void glds16s(const void* sbase, unsigned voff, unsigned lds_dst) { unsigned keep;
    asm volatile("s_mov_b32 %0, m0\n\ts_mov_b32 m0, %3\n\ts_nop 0\n\tglobal_load_lds_dwordx4 %1, %2\n\ts_mov_b32 m0, %0" : "=&s"(keep) : "v"(voff), "s"(sbase), "s"(lds_dst) : "memory"); }
__device__ __forceinline__ void glds12(const void* gsrc, unsigned lds_dst) { unsigned keep;
    asm volatile("s_mov_b32 %0, m0\n\ts_mov_b32 m0, %2\n\ts_nop 0\n\tglobal_load_lds_dwordx3 %1, off\n\ts_mov_b32 m0, %0" : "=&s"(keep) : "v"(gsrc), "s"(lds_dst) : "memory"); }
#define AWAIT_BAR(N) asm volatile("s_waitcnt vmcnt(" #N ") lgkmcnt(0)\n\ts_barrier" ::: "memory")
constexpr int AT_K = 0, AT_V = 24576, AT_WS = 40960, AT_OST = 43008, AT_END = 75776;
constexpr float C2 = 0.10206207261596575f * 1.4426950408889634f;

__device__ __forceinline__ void attn_unit_v1(int h, int qb, CArgs a, const LAS float* carry, LAS unsigned char* shm) {
    const int tid = threadIdx.x, lane = tid & 63, r32 = lane & 31, hi = lane >> 5; const int wid = __builtin_amdgcn_readfirstlane(tid >> 6);
    unsigned char* ws = a.ws;
    const bf16_t* QRAW = (const bf16_t*)(ws + WS_R1); const unsigned char* KI = ws + WS_KIMG + (size_t)h * 256 * 12288; const unsigned char* VI = (const unsigned char*)a.out + 32 * MiB + (size_t)h * 256 * 8192;
    const float* CS = (const float*)(ws + WS_CS); const float* qg = (const float*)a.in[15];
    const int q0 = qb * 256, rowq = q0 + wid * 32 + r32;
    const unsigned lds0 = (unsigned)(uintptr_t)shm;
    LAS float* wsf = (LAS float*)(shm + AT_WS) + wid * 64;
    bf16x8 qr[6];
    {
        const bf16_t* qp = QRAW + (size_t)rowq * 1536 + h * 96 + hi * 8;
        u32x4 raw[6]; float qv[6][8]; float ss = 0.f;
#pragma unroll
        for (int d0 = 0; d0 < 6; ++d0) raw[d0] = *(const u32x4*)(qp + d0 * 16);
#pragma unroll
        for (int d0 = 0; d0 < 6; ++d0)
#pragma unroll
            for (int j = 0; j < 4; ++j) { qv[d0][2 * j] = lo2f(raw[d0][j]); qv[d0][2 * j + 1] = hi2f(raw[d0][j]); ss += qv[d0][2 * j] * qv[d0][2 * j] + qv[d0][2 * j + 1] * qv[d0][2 * j + 1]; }
        ss += __shfl_xor(ss, 32);
        const float rs = rsqrtf(ss * (1.f / 96.f) + EPS);
#pragma unroll
        for (int d0 = 0; d0 < 6; ++d0) { const f32x4 g0 = *(const f32x4*)(qg + d0 * 16 + hi * 8), g1 = *(const f32x4*)(qg + d0 * 16 + hi * 8 + 4);
#pragma unroll
            for (int j = 0; j < 4; ++j) { qv[d0][j] *= rs * g0[j]; qv[d0][4 + j] *= rs * g1[j]; } }
        const f32x4 c0 = *(const f32x4*)(CS + (size_t)rowq * 32 + hi * 8), c1 = *(const f32x4*)(CS + (size_t)rowq * 32 + hi * 8 + 4), s0 = *(const f32x4*)(CS + (size_t)rowq * 32 + 16 + hi * 8), s1 = *(const f32x4*)(CS + (size_t)rowq * 32 + 16 + hi * 8 + 4);
#pragma unroll
        for (int j = 0; j < 8; ++j) { const float cs = j < 4 ? c0[j & 3] : c1[j & 3], sn = j < 4 ? s0[j & 3] : s1[j & 3]; const float x1 = qv[4][j], x2 = qv[5][j]; qv[4][j] = x1 * cs - x2 * sn; qv[5][j] = x1 * sn + x2 * cs; }
#pragma unroll
        for (int d0 = 0; d0 < 6; ++d0) { u32x4 w;
#pragma unroll
            for (int j = 0; j < 4; ++j) w[j] = pk2(qv[d0][2 * j] * C2, qv[d0][2 * j + 1] * C2);
            qr[d0] = __builtin_bit_cast(bf16x8, w); }
    }
    const int NT = 4 * qb + 4, mylast = 4 * qb + (wid >> 1);
#define AT_DMA(t, buf) do { const unsigned char* kt_ = KI + (size_t)(t) * 12288 + wid * 1024 + lane * 16; const unsigned kd_ = lds0 + AT_K + (buf) * 12288 + wid * 1024; \
        glds16(kt_, (unsigned)__builtin_amdgcn_readfirstlane(kd_)); if (wid < 4) glds16(kt_ + 8192, (unsigned)__builtin_amdgcn_readfirstlane(kd_ + 8192)); \
        glds16(VI + (size_t)(t) * 8192 + wid * 1024 + lane * 16, (unsigned)__builtin_amdgcn_readfirstlane(lds0 + AT_V + (buf) * 8192 + wid * 1024)); } while (0)
#define AT_WAIT1() do { if (wid < 4) asm volatile("s_waitcnt vmcnt(3)" ::: "memory"); else asm volatile("s_waitcnt vmcnt(2)" ::: "memory"); asm volatile("s_waitcnt lgkmcnt(0)\n\ts_barrier" ::: "memory"); } while (0)
    float m_run = -1e30f, l_run = 0.f; f32x16 o[2]; o[0] = f32x16{}; o[1] = f32x16{};
    AT_DMA(0, 0);
    for (int t = 0; t < NT; ++t) {
        const int buf = t & 1;
        if (t + 1 < NT) { AT_DMA(t + 1, buf ^ 1); AT_WAIT1(); } else { AWAIT_BAR(0); }
        if (t <= mylast) {
            const LAS unsigned char* kb = shm + AT_K + buf * 12288 + hi * 1024 + r32 * 16;
            f32x16 p0 = f32x16{}, p1 = f32x16{};
#pragma unroll
            for (int d0 = 0; d0 < 6; ++d0) { const bf16x8 b0 = *(const LAS bf16x8*)(kb + d0 * 2048), b1 = *(const LAS bf16x8*)(kb + d0 * 2048 + 512);
                p0 = __builtin_amdgcn_mfma_f32_32x32x16_bf16(b0, qr[d0], p0, 0, 0, 0); p1 = __builtin_amdgcn_mfma_f32_32x32x16_bf16(b1, qr[d0], p1, 0, 0, 0); }
            float rm = fmaxf(p0[0], p1[0]);
#pragma unroll
            for (int r = 1; r < 16; ++r) rm = fmaxf(rm, fmaxf(p0[r], p1[r]));
            rm = fmaxf(rm, __shfl_xor(rm, 32));
            const float mn = fmaxf(m_run, rm), alpha = fexp2(m_run - mn); m_run = mn;
            float ps = 0.f;
#pragma unroll
            for (int r = 0; r < 16; ++r) { p0[r] = fexp2(p0[r] - mn); p1[r] = fexp2(p1[r] - mn); ps += p0[r] + p1[r]; }
            l_run = l_run * alpha + ps;
            if (__any(alpha != 1.f)) {
                if (hi == 0) wsf[r32] = alpha;
                LDS_WAIT();
#pragma unroll
                for (int r = 0; r < 16; ++r) { const float f = wsf[crow(r, hi)]; o[0][r] *= f; o[1][r] *= f; }
            }
            u32x4 pw[4];
#pragma unroll
            for (int j = 0; j < 4; ++j) { pw[0][j] = pk2(p0[2 * j], p0[2 * j + 1]); pw[1][j] = pk2(p0[8 + 2 * j], p0[8 + 2 * j + 1]); pw[2][j] = pk2(p1[2 * j], p1[2 * j + 1]); pw[3][j] = pk2(p1[8 + 2 * j], p1[8 + 2 * j + 1]); }
            const LAS unsigned char* vb = shm + AT_V + buf * 8192 + ((lane >> 4) & 1) * 32 + (lane & 3) * 8 + (4 * hi + ((lane & 15) >> 2)) * 64;
#pragma unroll
            for (int d0 = 0; d0 < 2; ++d0)
#pragma unroll
                for (int ks = 0; ks < 4; ++ks) {
                    typedef short v4i16_t __attribute__((ext_vector_type(4)));
                    const s16x4 lo = __builtin_bit_cast(s16x4, __builtin_amdgcn_ds_read_tr16_b64_v4i16((LAS v4i16_t*)(vb + d0 * 4096 + ks * 1024)));
                    const s16x4 hh = __builtin_bit_cast(s16x4, __builtin_amdgcn_ds_read_tr16_b64_v4i16((LAS v4i16_t*)(vb + d0 * 4096 + ks * 1024 + 512)));
                    const bf16x8 vf = (bf16x8){lo[0], lo[1], lo[2], lo[3], hh[0], hh[1], hh[2], hh[3]};
                    o[d0] = __builtin_amdgcn_mfma_f32_32x32x16_bf16(__builtin_bit_cast(bf16x8, pw[ks]), vf, o[d0], 0, 0, 0);
                }
        }
        asm volatile("s_waitcnt lgkmcnt(0)\n\ts_barrier" ::: "memory");
    }
#undef AT_DMA
#undef AT_WAIT1
    l_run += __shfl_xor(l_run, 32);
    if (hi == 0) wsf[32 + r32] = l_run;
    LDS_WAIT();
    LAS bf16_t* stg = (LAS bf16_t*)(shm + AT_OST) + wid * 2048;
#pragma unroll
    for (int r = 0; r < 16; ++r) { const int orow = crow(r, hi); const float il = frcp(wsf[32 + orow]);
#pragma unroll
        for (int d0 = 0; d0 < 2; ++d0) stg[orow * 64 + d0 * 32 + r32] = (bf16_t)f2bf(o[d0][r] * il); }
    LDS_WAIT();
    const bf16_t* GB = (const bf16_t*)a.out; const bf16_t* HL = (const bf16_t*)(ws + WS_GR); const bf16_t* AC = (const bf16_t*)(ws + WS_GA); bf16_t* MG = (bf16_t*)(ws + WS_XR);
#pragma unroll
    for (int i = 0; i < 4; ++i) { const int row = i * 8 + (lane >> 3), ch = lane & 7; const u32x4 yv = *(const LAS u32x4*)(stg + row * 64 + ch * 8);
        const size_t go = (size_t)(q0 + wid * 32 + row) * 1024 + h * 64 + ch * 8;
        const u32x4 gb = *(const u32x4*)(GB + go), hl = *(const u32x4*)(HL + go), ac = *(const u32x4*)(AC + go); u32x4 w;
#pragma unroll
        for (int j = 0; j < 4; ++j) { const float c0 = carry[ch * 8 + 2 * j], c1 = carry[ch * 8 + 2 * j + 1];
            w[j] = pk2(lo2f(yv[j]) * lo2f(gb[j]) + lo2f(hl[j]) + lo2f(ac[j]) * c0, hi2f(yv[j]) * hi2f(gb[j]) + hi2f(hl[j]) + hi2f(ac[j]) * c1); }
        *(u32x4*)(MG + go) = w; }
    asm volatile("s_waitcnt lgkmcnt(0)\n\ts_barrier" ::: "memory");
}


constexpr int A2_K = 0, A2_V = 36864, A2_WS = 61440, A2_OST = 63488;
#define A2_MF(a_, b_, c_) __builtin_amdgcn_mfma_f32_32x32x16_bf16(a_, b_, c_, 0, 0, 0)
#define A2_SB() __builtin_amdgcn_sched_barrier(0)
#define A2_PIN(x) asm volatile("" : "+v"(x))
#define A2_KF(d0, blk) ((ABL == 5) ? qr[(d0)] : *(const LAS bf16x8*)(kp + (d0) * 2048 + (blk) * 512))
typedef short v4i16_t __attribute__((ext_vector_type(4)));
#define A2_VT(off) __builtin_bit_cast(s16x4, __builtin_amdgcn_ds_read_tr16_b64_v4i16((LAS v4i16_t*)(vp + (off))))
#define A2_VJ(lo_, hi_, j) do { if (ABL == 5) { lo_ = (s16x4){qr[0][0], qr[0][1], qr[1][2], qr[1][3]}; hi_ = (s16x4){qr[2][0], qr[2][1], qr[3][2], qr[3][3]}; } else { lo_ = A2_VT(((j) & 1) * 4096 + ((j) >> 1) * 1024); hi_ = A2_VT(((j) & 1) * 4096 + ((j) >> 1) * 1024 + 512); } } while (0)
#define A2_VF(lo_, hi_) ((bf16x8){lo_[0], lo_[1], lo_[2], lo_[3], hi_[0], hi_[1], hi_[2], hi_[3]})
#define A2_EX(x) ((ABL == 2) ? (x) : fexp2(x))
#define A2_E3(P, b) do { P[b] = A2_EX(P[b]); P[(b) + 1] = A2_EX(P[(b) + 1]); P[(b) + 2] = A2_EX(P[(b) + 2]); } while (0)
#define A2_E2(P, b) do { P[b] = A2_EX(P[b]); P[(b) + 1] = A2_EX(P[(b) + 1]); } while (0)
#define A2_PK2(W, j, P, b) do { W[j] = pk2(P[b], P[(b) + 1]); W[(j) + 1] = pk2(P[(b) + 2], P[(b) + 3]); } while (0)
#define A2_S4(P, b) do { if (ABL != 2) { sacc += P[b]; sacc += P[(b) + 1]; sacc += P[(b) + 2]; sacc += P[(b) + 3]; } } while (0)

template <int ABL> __device__ __forceinline__ void attn_unit_v2(int h, int qb, CArgs a, const LAS float* carry, LAS unsigned char* shm) {
    const int tid = threadIdx.x, lane = tid & 63, r32 = lane & 31, hi = lane >> 5; const int wid = __builtin_amdgcn_readfirstlane(tid >> 6);
    unsigned char* ws = a.ws;
    const bf16_t* QRAW = (const bf16_t*)(ws + WS_R1); const unsigned char* KI = ws + WS_KIMG + (size_t)h * 256 * 12288; const unsigned char* VI = (const unsigned char*)a.out + 32 * MiB + (size_t)h * 256 * 8192;
    const float* CS = (const float*)(ws + WS_CS); const float* qg = (const float*)a.in[15];
    const int q0 = qb * 256, rowq = q0 + wid * 32 + r32;
    const unsigned lds0 = (unsigned)(uintptr_t)shm;
    LAS float* wsf = (LAS float*)(shm + A2_WS) + wid * 64;
    const int NT = 4 * qb + 4, mylast = 4 * qb + (wid >> 1);
    const unsigned char* ksrc = KI + wid * 1024 + lane * 16; const unsigned char* vsrc = VI + wid * 1024 + lane * 16;
    const unsigned kdst = lds0 + A2_K + wid * 1024, vdst = lds0 + A2_V + wid * 1024;
#define A2_DMAK(t, slot) do { if (ABL == 3) break; glds16(ksrc + (size_t)(t) * 12288, (unsigned)__builtin_amdgcn_readfirstlane(kdst + (slot) * 12288)); \
        if (wid < 4) glds16(ksrc + (size_t)(t) * 12288 + 8192, (unsigned)__builtin_amdgcn_readfirstlane(kdst + (slot) * 12288 + 8192)); } while (0)
#define A2_DMAV(t, slot) do { if (ABL != 3) glds16(vsrc + (size_t)(t) * 8192, (unsigned)__builtin_amdgcn_readfirstlane(vdst + (slot) * 8192)); } while (0)
#define A2_WAITFULL() do { if (wid < 4) asm volatile("s_waitcnt vmcnt(3)" ::: "memory"); else asm volatile("s_waitcnt vmcnt(2)" ::: "memory"); } while (0)
#define A2_BAR() do { if (ABL == 1) asm volatile("s_waitcnt lgkmcnt(0)" ::: "memory"); else asm volatile("s_waitcnt lgkmcnt(0)\n\ts_barrier" ::: "memory"); } while (0)
    bf16x8 qr[6];
    {
        const bf16_t* qp = QRAW + (size_t)rowq * 1536 + h * 96 + hi * 8;
        u32x4 raw[6]; float qv[6][8]; float ss = 0.f;
#pragma unroll
        for (int d0 = 0; d0 < 6; ++d0) raw[d0] = *(const u32x4*)(qp + d0 * 16);
        A2_DMAK(0, 0); A2_DMAV(0, 0); A2_DMAK(1, 1); A2_DMAV(1, 1); A2_DMAK(2, 2);
#pragma unroll
        for (int d0 = 0; d0 < 6; ++d0)
#pragma unroll
            for (int j = 0; j < 4; ++j) { qv[d0][2 * j] = lo2f(raw[d0][j]); qv[d0][2 * j + 1] = hi2f(raw[d0][j]); ss += qv[d0][2 * j] * qv[d0][2 * j] + qv[d0][2 * j + 1] * qv[d0][2 * j + 1]; }
        ss += __shfl_xor(ss, 32);
        const float rs = rsqrtf(ss * (1.f / 96.f) + EPS);
#pragma unroll
        for (int d0 = 0; d0 < 6; ++d0) { const f32x4 g0 = *(const f32x4*)(qg + d0 * 16 + hi * 8), g1 = *(const f32x4*)(qg + d0 * 16 + hi * 8 + 4);
#pragma unroll
            for (int j = 0; j < 4; ++j) { qv[d0][j] *= rs * g0[j]; qv[d0][4 + j] *= rs * g1[j]; } }
        const f32x4 c0 = *(const f32x4*)(CS + (size_t)rowq * 32 + hi * 8), c1 = *(const f32x4*)(CS + (size_t)rowq * 32 + hi * 8 + 4), s0 = *(const f32x4*)(CS + (size_t)rowq * 32 + 16 + hi * 8), s1 = *(const f32x4*)(CS + (size_t)rowq * 32 + 16 + hi * 8 + 4);
#pragma unroll
        for (int j = 0; j < 8; ++j) { const float cs = j < 4 ? c0[j & 3] : c1[j & 3], sn = j < 4 ? s0[j & 3] : s1[j & 3]; const float x1 = qv[4][j], x2 = qv[5][j]; qv[4][j] = x1 * cs - x2 * sn; qv[5][j] = x1 * sn + x2 * cs; }
#pragma unroll
        for (int d0 = 0; d0 < 6; ++d0) { u32x4 w;
#pragma unroll
            for (int j = 0; j < 4; ++j) w[j] = pk2(qv[d0][2 * j] * C2, qv[d0][2 * j + 1] * C2);
            qr[d0] = __builtin_bit_cast(bf16x8, w); }
    }
    if (wid >= 4) __builtin_amdgcn_s_setprio(1);
    float lsum = 0.f; f32x16 o[2]; o[0] = f32x16{}; o[1] = f32x16{};
    f32x16 pA0, pA1, pB0, pB1;
    if (wid < 4) asm volatile("s_waitcnt vmcnt(6)" ::: "memory"); else asm volatile("s_waitcnt vmcnt(4)" ::: "memory");
    A2_BAR();
    {
        const LAS unsigned char* kp = shm + A2_K + hi * 1024 + r32 * 16;
        pA0 = f32x16{}; pA1 = f32x16{};
#pragma unroll
        for (int d0 = 0; d0 < 6; ++d0) { pA0 = A2_MF(A2_KF(d0, 0), qr[d0], pA0); pA1 = A2_MF(A2_KF(d0, 1), qr[d0], pA1); }
    }
    int sk_next = 12288, sv_cur = 0;
#define A2_STEP(C0, C1, N0, N1, t, HASN) do { \
        const LAS unsigned char* kp = shm + A2_K + sk_next + hi * 1024 + r32 * 16; const LAS unsigned char* vp = shm + A2_V + sv_cur + ((lane >> 4) & 1) * 32 + (lane & 3) * 8 + (4 * hi + ((lane & 15) >> 2)) * 64; \
        bf16x8 k0, k1, k2; s16x4 vl0, vh0, vl1, vh1, vl2, vh2; u32x4 w0, w1, w2, w3; float sacc = 0.f; \
        A2_SB(); \
        if (HASN) { k0 = A2_KF(0, 0); k1 = A2_KF(0, 1); k2 = A2_KF(1, 0); A2_SB(); \
            N0 = A2_MF(k0, qr[0], (f32x16{})); k0 = A2_KF(1, 1); A2_E3(C0, 0);  A2_PIN(C0); A2_SB(); \
            N1 = A2_MF(k1, qr[0], (f32x16{})); k1 = A2_KF(2, 0); A2_E3(C0, 3);  A2_PIN(C0); A2_SB(); \
            N0 = A2_MF(k2, qr[1], N0);         k2 = A2_KF(2, 1); A2_E3(C0, 6);  A2_PIN(C0); A2_SB(); \
            N1 = A2_MF(k0, qr[1], N1);         k0 = A2_KF(3, 0); A2_E3(C0, 9);  A2_PIN(C0); A2_SB(); \
            N0 = A2_MF(k1, qr[2], N0);         k1 = A2_KF(3, 1); A2_E3(C0, 12); A2_PIN(C0); A2_SB(); \
            N1 = A2_MF(k2, qr[2], N1);         k2 = A2_KF(4, 0); C0[15] = A2_EX(C0[15]); A2_E2(C1, 0); A2_PIN(C0); A2_PIN(C1); A2_SB(); \
            N0 = A2_MF(k0, qr[3], N0);         k0 = A2_KF(4, 1); A2_E3(C1, 2);  A2_PIN(C1); A2_SB(); \
            N1 = A2_MF(k1, qr[3], N1);         k1 = A2_KF(5, 0); A2_E3(C1, 5);  A2_PIN(C1); A2_SB(); \
            N0 = A2_MF(k2, qr[4], N0);         k2 = A2_KF(5, 1); A2_E2(C1, 8);  A2_PK2(w0, 0, C0, 0);  A2_PIN(C1); A2_PIN(w0); A2_SB(); \
            N1 = A2_MF(k0, qr[4], N1);                           A2_E2(C1, 10); A2_PK2(w0, 2, C0, 4);  A2_PIN(C1); A2_PIN(w0); A2_SB(); \
            N0 = A2_MF(k1, qr[5], N0);         A2_VJ(vl0, vh0, 0); A2_E2(C1, 12); A2_PK2(w1, 0, C0, 8);  A2_PIN(C1); A2_PIN(w1); A2_SB(); \
            N1 = A2_MF(k2, qr[5], N1);         A2_VJ(vl1, vh1, 1); A2_E2(C1, 14); A2_PK2(w1, 2, C0, 12); A2_PIN(C1); A2_PIN(w1); A2_SB(); \
        } else { \
            _Pragma("unroll") for (int r_ = 0; r_ < 16; ++r_) { C0[r_] = A2_EX(C0[r_]); C1[r_] = A2_EX(C1[r_]); } \
            A2_PK2(w0, 0, C0, 0); A2_PK2(w0, 2, C0, 4); A2_PK2(w1, 0, C0, 8); A2_PK2(w1, 2, C0, 12); A2_VJ(vl0, vh0, 0); A2_VJ(vl1, vh1, 1); A2_SB(); \
        } \
        if ((t) > mylast) { w0 = (u32x4){0u, 0u, 0u, 0u}; w1 = w0; C0 = f32x16{}; C1 = f32x16{}; } \
        o[0] = A2_MF(__builtin_bit_cast(bf16x8, w0), A2_VF(vl0, vh0), o[0]); A2_VJ(vl2, vh2, 2); A2_PK2(w2, 0, C1, 0);  A2_S4(C0, 0);  A2_PIN(w2); A2_PIN(sacc); A2_SB(); \
        o[1] = A2_MF(__builtin_bit_cast(bf16x8, w0), A2_VF(vl1, vh1), o[1]); A2_VJ(vl0, vh0, 3); A2_PK2(w2, 2, C1, 4);  A2_S4(C0, 4);  A2_PIN(w2); A2_PIN(sacc); A2_SB(); \
        o[0] = A2_MF(__builtin_bit_cast(bf16x8, w1), A2_VF(vl2, vh2), o[0]); A2_VJ(vl1, vh1, 4); A2_PK2(w3, 0, C1, 8);  A2_S4(C0, 8);  A2_PIN(w3); A2_PIN(sacc); A2_SB(); \
        o[1] = A2_MF(__builtin_bit_cast(bf16x8, w1), A2_VF(vl0, vh0), o[1]); A2_VJ(vl2, vh2, 5); A2_PK2(w3, 2, C1, 12); A2_S4(C0, 12); A2_PIN(w3); A2_PIN(sacc); A2_SB(); \
        o[0] = A2_MF(__builtin_bit_cast(bf16x8, w2), A2_VF(vl1, vh1), o[0]); A2_VJ(vl0, vh0, 6); A2_S4(C1, 0);  A2_PIN(sacc); A2_SB(); \
        o[1] = A2_MF(__builtin_bit_cast(bf16x8, w2), A2_VF(vl2, vh2), o[1]); A2_VJ(vl1, vh1, 7); A2_S4(C1, 4);  A2_PIN(sacc); A2_SB(); \
        o[0] = A2_MF(__builtin_bit_cast(bf16x8, w3), A2_VF(vl0, vh0), o[0]); A2_S4(C1, 8);  A2_PIN(sacc); A2_SB(); \
        o[1] = A2_MF(__builtin_bit_cast(bf16x8, w3), A2_VF(vl1, vh1), o[1]); A2_S4(C1, 12); A2_PIN(sacc); A2_SB(); \
        lsum += sacc; \
        sk_next = (sk_next == 24576) ? 0 : sk_next + 12288; sv_cur = (sv_cur == 16384) ? 0 : sv_cur + 8192; \
    } while (0)
#define A2_TOP(t) do { const int t_ = (t); if (t_ - 1 <= NT - 4) { A2_WAITFULL(); } else if (t_ - 1 == NT - 3) { asm volatile("s_waitcnt vmcnt(1)" ::: "memory"); } else { asm volatile("s_waitcnt vmcnt(0)" ::: "memory"); } \
        A2_BAR(); if (t_ + 3 < NT) { glds16(kg3, (unsigned)__builtin_amdgcn_readfirstlane(kdst + dk)); if (wid < 4) glds16(kg3 + 8192, (unsigned)__builtin_amdgcn_readfirstlane(kdst + dk + 8192)); } \
        if (t_ + 2 < NT) glds16(vg2, (unsigned)__builtin_amdgcn_readfirstlane(vdst + dv)); \
        kg3 += 12288; vg2 += 8192; dk = (dk == 24576u) ? 0u : dk + 12288u; dv = (dv == 16384u) ? 0u : dv + 8192u; } while (0)
    const unsigned char* kg3 = ksrc + 3 * 12288; const unsigned char* vg2 = vsrc + 2 * 8192; unsigned dk = 0u, dv = 16384u;
    int t = 0;
    for (; t + 2 < NT; t += 2) {
        A2_TOP(t);     A2_STEP(pA0, pA1, pB0, pB1, t, true);
        A2_TOP(t + 1); A2_STEP(pB0, pB1, pA0, pA1, t + 1, true);
    }
    A2_TOP(t);     A2_STEP(pA0, pA1, pB0, pB1, t, true);
    A2_TOP(t + 1); A2_STEP(pB0, pB1, pA0, pA1, t + 1, false);
#undef A2_STEP
#undef A2_TOP
    __builtin_amdgcn_s_setprio(0);
    lsum += __shfl_xor(lsum, 32);
    if (hi == 0) wsf[32 + r32] = lsum;
    LDS_WAIT();
    LAS bf16_t* stg = (LAS bf16_t*)(shm + A2_OST) + wid * 2048;
#pragma unroll
    for (int r = 0; r < 16; ++r) { const int orow = crow(r, hi); const float il = frcp(wsf[32 + orow]);
#pragma unroll
        for (int d0 = 0; d0 < 2; ++d0) stg[orow * 64 + d0 * 32 + r32] = (bf16_t)f2bf(o[d0][r] * il); }
    LDS_WAIT();
    const bf16_t* GB = (const bf16_t*)a.out; const bf16_t* HL = (const bf16_t*)(ws + WS_GR); const bf16_t* AC = (const bf16_t*)(ws + WS_GA); bf16_t* MG = (bf16_t*)(ws + WS_XR);
#pragma unroll
    for (int i = 0; i < 4; ++i) { const int row = i * 8 + (lane >> 3), ch = lane & 7; const u32x4 yv = *(const LAS u32x4*)(stg + row * 64 + ch * 8);
        const size_t go = (size_t)(q0 + wid * 32 + row) * 1024 + h * 64 + ch * 8;
        const u32x4 gb = *(const u32x4*)(GB + go), hl = *(const u32x4*)(HL + go), ac = *(const u32x4*)(AC + go); u32x4 w;
#pragma unroll
        for (int j = 0; j < 4; ++j) { const float c0 = carry[ch * 8 + 2 * j], c1 = carry[ch * 8 + 2 * j + 1];
            w[j] = pk2(lo2f(yv[j]) * lo2f(gb[j]) + lo2f(hl[j]) + lo2f(ac[j]) * c0, hi2f(yv[j]) * hi2f(gb[j]) + hi2f(hl[j]) + hi2f(ac[j]) * c1); }
        *(u32x4*)(MG + go) = w; }
    asm volatile("s_waitcnt vmcnt(0) lgkmcnt(0)\n\ts_barrier" ::: "memory");
#undef A2_DMAK
#undef A2_DMAV
#undef A2_WAITFULL
#undef A2_BAR
}


typedef int v8i __attribute__((ext_vector_type(8)));
constexpr int A4_K = 0, A4_V = 36864, A4_WS = 53248, A4_OST = 55296;
#define A4_PVM(pw_, vf_, acc_) __builtin_amdgcn_mfma_scale_f32_32x32x64_f8f6f4(pw_, vf_, acc_, 0, 0, 0, 0x7f7f7f7f, 0, 0x7f7f7f7f)
#define A4_CV(W, j, P, b) do { int w_ = __builtin_amdgcn_cvt_pk_fp8_f32(P[b], P[(b) + 1], 0, false); W[j] = __builtin_amdgcn_cvt_pk_fp8_f32(P[(b) + 2], P[(b) + 3], w_, true); } while (0)
#define A4_VLD(vf_, d0) do { const u32x4 x0_ = *(const LAS u32x4*)(vp + (d0) * 2048), x1_ = *(const LAS u32x4*)(vp + (d0) * 2048 + 512); \
        vf_ = (v8i){(int)x0_[0], (int)x0_[1], (int)x0_[2], (int)x0_[3], (int)x1_[0], (int)x1_[1], (int)x1_[2], (int)x1_[3]}; } while (0)

__device__ __forceinline__ void attn_unit_v4(int h, int qb, CArgs a, const LAS float* carry, LAS unsigned char* shm) {
    constexpr int ABL = 0;
    const int tid = threadIdx.x, lane = tid & 63, r32 = lane & 31, hi = lane >> 5; const int wid = __builtin_amdgcn_readfirstlane(tid >> 6);
    unsigned char* ws = a.ws;
    const bf16_t* QRAW = (const bf16_t*)(ws + WS_R1); const unsigned char* KI = ws + WS_KIMG + (size_t)h * 256 * 12288; const unsigned char* VI = (const unsigned char*)a.out + 32 * MiB + (size_t)h * 256 * 4096;
    const float* CS = (const float*)(ws + WS_CS); const float* qg = (const float*)a.in[15];
    const int q0 = qb * 256, rowq = q0 + wid * 32 + r32;
    const unsigned lds0 = (unsigned)(uintptr_t)shm;
    LAS float* wsf = (LAS float*)(shm + A4_WS) + wid * 64;
    const int NT = 4 * qb + 4, mylast = 4 * qb + (wid >> 1);
    const unsigned char* ksrc = KI + wid * 1024 + lane * 16; const unsigned char* vsrc = VI + wid * 1024 + lane * 16;
    const unsigned kdst = lds0 + A4_K + wid * 1024, vdst = lds0 + A4_V + wid * 1024;
#define A4_DMAK(t, slot) do { glds16(ksrc + (size_t)(t) * 12288, (unsigned)__builtin_amdgcn_readfirstlane(kdst + (slot) * 12288)); \
        if (wid < 4) glds16(ksrc + (size_t)(t) * 12288 + 8192, (unsigned)__builtin_amdgcn_readfirstlane(kdst + (slot) * 12288 + 8192)); } while (0)
#define A4_DMAV(t, slot) do { if (wid < 4) glds16(vsrc + (size_t)(t) * 4096, (unsigned)__builtin_amdgcn_readfirstlane(vdst + (slot) * 4096)); } while (0)
#define A4_BAR() asm volatile("s_waitcnt lgkmcnt(0)\n\ts_barrier" ::: "memory")
    bf16x8 qr[6];
    {
        const bf16_t* qp = QRAW + (size_t)rowq * 1536 + h * 96 + hi * 8;
        u32x4 raw[6]; float qv[6][8]; float ss = 0.f;
#pragma unroll
        for (int d0 = 0; d0 < 6; ++d0) raw[d0] = *(const u32x4*)(qp + d0 * 16);
        A4_DMAK(0, 0); A4_DMAV(0, 0); A4_DMAK(1, 1); A4_DMAV(1, 1); A4_DMAK(2, 2);
#pragma unroll
        for (int d0 = 0; d0 < 6; ++d0)
#pragma unroll
            for (int j = 0; j < 4; ++j) { qv[d0][2 * j] = lo2f(raw[d0][j]); qv[d0][2 * j + 1] = hi2f(raw[d0][j]); ss += qv[d0][2 * j] * qv[d0][2 * j] + qv[d0][2 * j + 1] * qv[d0][2 * j + 1]; }
        ss += __shfl_xor(ss, 32);
        const float rs = rsqrtf(ss * (1.f / 96.f) + EPS);
#pragma unroll
        for (int d0 = 0; d0 < 6; ++d0) { const f32x4 g0 = *(const f32x4*)(qg + d0 * 16 + hi * 8), g1 = *(const f32x4*)(qg + d0 * 16 + hi * 8 + 4);
#pragma unroll
            for (int j = 0; j < 4; ++j) { qv[d0][j] *= rs * g0[j]; qv[d0][4 + j] *= rs * g1[j]; } }
        const f32x4 c0 = *(const f32x4*)(CS + (size_t)rowq * 32 + hi * 8), c1 = *(const f32x4*)(CS + (size_t)rowq * 32 + hi * 8 + 4), s0 = *(const f32x4*)(CS + (size_t)rowq * 32 + 16 + hi * 8), s1 = *(const f32x4*)(CS + (size_t)rowq * 32 + 16 + hi * 8 + 4);
#pragma unroll
        for (int j = 0; j < 8; ++j) { const float cs = j < 4 ? c0[j & 3] : c1[j & 3], sn = j < 4 ? s0[j & 3] : s1[j & 3]; const float x1 = qv[4][j], x2 = qv[5][j]; qv[4][j] = x1 * cs - x2 * sn; qv[5][j] = x1 * sn + x2 * cs; }
#pragma unroll
        for (int d0 = 0; d0 < 6; ++d0) { u32x4 w;
#pragma unroll
            for (int j = 0; j < 4; ++j) w[j] = pk2(qv[d0][2 * j] * C2, qv[d0][2 * j + 1] * C2);
            qr[d0] = __builtin_bit_cast(bf16x8, w); }
    }
    if (wid >= 4) __builtin_amdgcn_s_setprio(1);
    float lsum = 0.f; f32x16 o[2]; o[0] = f32x16{}; o[1] = f32x16{};
    f32x16 pA0, pA1, pB0, pB1, negm; v8i pwo = (v8i){0, 0, 0, 0, 0, 0, 0, 0};
    if (wid < 4) asm volatile("s_waitcnt vmcnt(6)" ::: "memory"); else asm volatile("s_waitcnt vmcnt(2)" ::: "memory");
    A4_BAR();
    {
        const LAS unsigned char* kp = shm + A4_K + hi * 1024 + r32 * 16;
        pA0 = f32x16{}; pA1 = f32x16{};
#pragma unroll
        for (int d0 = 0; d0 < 6; ++d0) { pA0 = A2_MF(A2_KF(d0, 0), qr[d0], pA0); pA1 = A2_MF(A2_KF(d0, 1), qr[d0], pA1); }
        float rm = fmaxf(pA0[0], pA1[0]);
#pragma unroll
        for (int r = 1; r < 16; ++r) rm = fmaxf(rm, fmaxf(pA0[r], pA1[r]));
        rm = fmaxf(rm, __shfl_xor(rm, 32));
        const float nb = 64.f - rm;
#pragma unroll
        for (int r = 0; r < 16; ++r) { pA0[r] += nb; pA1[r] += nb; negm[r] = nb; }
        asm volatile("" : "+v"(negm));
    }
    int sk_next = 12288, sv_prev = 12288;
#define A4_STEP(C0, C1, N0, N1, t, HASN, HASP) do { \
        const LAS unsigned char* kp = shm + A4_K + sk_next + hi * 1024 + r32 * 16; const LAS unsigned char* vp = shm + A4_V + sv_prev + hi * 1024 + r32 * 16; \
        bf16x8 k0, k1, k2; v8i vfa, vfb, pwn; float sacc = 0.f; \
        A2_SB(); \
        if (HASN) { k0 = A2_KF(0, 0); k1 = A2_KF(0, 1); k2 = A2_KF(1, 0); if (HASP) A4_VLD(vfa, 0); A2_SB(); \
            N0 = A2_MF(k0, qr[0], negm); k0 = A2_KF(1, 1); A3E3(C0, 0);  A2_PIN(C0); A2_SB(); \
            N1 = A2_MF(k1, qr[0], negm); k1 = A2_KF(2, 0); A3E3(C0, 3);  A2_PIN(C0); A2_SB(); \
            N0 = A2_MF(k2, qr[1], N0);   k2 = A2_KF(2, 1); A3E3(C0, 6);  A2_PIN(C0); A2_SB(); \
            N1 = A2_MF(k0, qr[1], N1);   k0 = A2_KF(3, 0); A3E3(C0, 9);  A2_PIN(C0); A2_SB(); \
            if (HASP) { o[0] = A4_PVM(pwo, vfa, o[0]); A4_VLD(vfb, 1); } A4_CV(pwn, 0, C0, 0); A4_CV(pwn, 1, C0, 4); A3S4(C0, 0); A3S4(C0, 4); A2_PIN(pwn); A2_PIN(sacc); A2_SB(); \
            N0 = A2_MF(k1, qr[2], N0);   k1 = A2_KF(3, 1); A3E3(C0, 12); A2_PIN(C0); A2_SB(); \
            N1 = A2_MF(k2, qr[2], N1);   k2 = A2_KF(4, 0); C0[15] = fexp2(C0[15]); A3E2(C1, 0); A2_PIN(C0); A2_PIN(C1); A2_SB(); \
            N0 = A2_MF(k0, qr[3], N0);   k0 = A2_KF(4, 1); A3E3(C1, 2);  A2_PIN(C1); A2_SB(); \
            N1 = A2_MF(k1, qr[3], N1);   k1 = A2_KF(5, 0); A3E3(C1, 5);  A2_PIN(C1); A2_SB(); \
            if (HASP) { o[1] = A4_PVM(pwo, vfb, o[1]); } A4_CV(pwn, 2, C0, 8); A4_CV(pwn, 3, C0, 12); A4_CV(pwn, 4, C1, 0); A4_CV(pwn, 5, C1, 4); A3S4(C0, 8); A3S4(C0, 12); A3S4(C1, 0); A3S4(C1, 4); A2_PIN(pwn); A2_PIN(sacc); A2_SB(); \
            N0 = A2_MF(k2, qr[4], N0);   k2 = A2_KF(5, 1); A3E3(C1, 8);  A2_PIN(C1); A2_SB(); \
            N1 = A2_MF(k0, qr[4], N1);                      A3E3(C1, 11); A2_PIN(C1); A2_SB(); \
            N0 = A2_MF(k1, qr[5], N0);                      A3E2(C1, 14); A4_CV(pwn, 6, C1, 8); A3S4(C1, 8); A2_PIN(C1); A2_PIN(pwn); A2_PIN(sacc); A2_SB(); \
            N1 = A2_MF(k2, qr[5], N1);                      A4_CV(pwn, 7, C1, 12); A3S4(C1, 12); A2_PIN(pwn); A2_PIN(sacc); A2_SB(); \
        } else { \
            if (HASP) { A4_VLD(vfa, 0); A4_VLD(vfb, 1); } \
            _Pragma("unroll") for (int r_ = 0; r_ < 16; ++r_) { C0[r_] = fexp2(C0[r_]); C1[r_] = fexp2(C1[r_]); } \
            if (HASP) { o[0] = A4_PVM(pwo, vfa, o[0]); o[1] = A4_PVM(pwo, vfb, o[1]); } \
            A4_CV(pwn, 0, C0, 0); A4_CV(pwn, 1, C0, 4); A4_CV(pwn, 2, C0, 8); A4_CV(pwn, 3, C0, 12); A4_CV(pwn, 4, C1, 0); A4_CV(pwn, 5, C1, 4); A4_CV(pwn, 6, C1, 8); A4_CV(pwn, 7, C1, 12); \
            A3S4(C0, 0); A3S4(C0, 4); A3S4(C0, 8); A3S4(C0, 12); A3S4(C1, 0); A3S4(C1, 4); A3S4(C1, 8); A3S4(C1, 12); A2_SB(); \
        } \
        if ((t) > mylast) { pwn = (v8i){0, 0, 0, 0, 0, 0, 0, 0}; sacc = 0.f; } \
        pwo = pwn; lsum += sacc; \
        sk_next = (sk_next == 24576) ? 0 : sk_next + 12288; sv_prev = (sv_prev == 12288) ? 0 : sv_prev + 4096; \
    } while (0)
#define A3E3(P, b) do { P[b] = fexp2(P[b]); P[(b) + 1] = fexp2(P[(b) + 1]); P[(b) + 2] = fexp2(P[(b) + 2]); } while (0)
#define A3E2(P, b) do { P[b] = fexp2(P[b]); P[(b) + 1] = fexp2(P[(b) + 1]); } while (0)
#define A3S4(P, b) do { sacc += P[b]; sacc += P[(b) + 1]; sacc += P[(b) + 2]; sacc += P[(b) + 3]; } while (0)
#define A4_TOP(t) do { const int t_ = (t); \
        if (t_ - 1 <= NT - 4) { if (wid < 4) asm volatile("s_waitcnt vmcnt(3)" ::: "memory"); else asm volatile("s_waitcnt vmcnt(1)" ::: "memory"); } \
        else if (t_ - 1 == NT - 3 && wid < 4) { asm volatile("s_waitcnt vmcnt(1)" ::: "memory"); } else { asm volatile("s_waitcnt vmcnt(0)" ::: "memory"); } \
        A4_BAR(); if (t_ + 3 < NT) { glds16(kg3, (unsigned)__builtin_amdgcn_readfirstlane(kdst + dk)); if (wid < 4) glds16(kg3 + 8192, (unsigned)__builtin_amdgcn_readfirstlane(kdst + dk + 8192)); } \
        if (t_ + 2 < NT && wid < 4) glds16(vg2, (unsigned)__builtin_amdgcn_readfirstlane(vdst + dv)); \
        kg3 += 12288; vg2 += 4096; dk = (dk == 24576u) ? 0u : dk + 12288u; dv = (dv == 12288u) ? 0u : dv + 4096u; } while (0)
    const unsigned char* kg3 = ksrc + 3 * 12288; const unsigned char* vg2 = vsrc + 2 * 4096; unsigned dk = 0u, dv = 8192u;
    A4_TOP(0); A4_STEP(pA0, pA1, pB0, pB1, 0, true, false);
    A4_TOP(1); A4_STEP(pB0, pB1, pA0, pA1, 1, true, true);
    int t = 2;
    for (; t + 2 < NT; t += 2) {
        A4_TOP(t);     A4_STEP(pA0, pA1, pB0, pB1, t, true, true);
        A4_TOP(t + 1); A4_STEP(pB0, pB1, pA0, pA1, t + 1, true, true);
    }
    A4_TOP(t);     A4_STEP(pA0, pA1, pB0, pB1, t, true, true);
    A4_TOP(t + 1); A4_STEP(pB0, pB1, pA0, pA1, t + 1, false, true);
    {
        const LAS unsigned char* vp = shm + A4_V + sv_prev + hi * 1024 + r32 * 16; v8i vfa, vfb;
        A4_VLD(vfa, 0); A4_VLD(vfb, 1); o[0] = A4_PVM(pwo, vfa, o[0]); o[1] = A4_PVM(pwo, vfb, o[1]);
    }
#undef A4_STEP
#undef A4_TOP
#undef A3E3
#undef A3E2
#undef A3S4
    __builtin_amdgcn_s_setprio(0);
    lsum += __shfl_xor(lsum, 32);
    if (hi == 0) wsf[32 + r32] = lsum;
    LDS_WAIT();
    LAS bf16_t* stg = (LAS bf16_t*)(shm + A4_OST) + wid * 2048;
#pragma unroll
    for (int r = 0; r < 16; ++r) { const int orow = crow(r, hi); const float il = frcp(wsf[32 + orow]);
#pragma unroll
        for (int d0 = 0; d0 < 2; ++d0) stg[orow * 64 + d0 * 32 + r32] = (bf16_t)f2bf(o[d0][r] * il); }
    LDS_WAIT();
    const bf16_t* GB = (const bf16_t*)a.out; const bf16_t* HL = (const bf16_t*)(ws + WS_GR); const bf16_t* AC = (const bf16_t*)(ws + WS_GA); bf16_t* MG = (bf16_t*)(ws + WS_XR);
#pragma unroll
    for (int i = 0; i < 4; ++i) { const int row = i * 8 + (lane >> 3), ch = lane & 7; const u32x4 yv = *(const LAS u32x4*)(stg + row * 64 + ch * 8);
        const size_t go = (size_t)(q0 + wid * 32 + row) * 1024 + h * 64 + ch * 8;
        const u32x4 gb = *(const u32x4*)(GB + go), hl = *(const u32x4*)(HL + go), ac = *(const u32x4*)(AC + go); u32x4 w;
#pragma unroll
        for (int j = 0; j < 4; ++j) { const float c0 = carry[ch * 8 + 2 * j], c1 = carry[ch * 8 + 2 * j + 1];
            w[j] = pk2(lo2f(yv[j]) * lo2f(gb[j]) + lo2f(hl[j]) + lo2f(ac[j]) * c0, hi2f(yv[j]) * hi2f(gb[j]) + hi2f(hl[j]) + hi2f(ac[j]) * c1); }
        *(u32x4*)(MG + go) = w; }
    asm volatile("s_waitcnt vmcnt(0) lgkmcnt(0)\n\ts_barrier" ::: "memory");
#undef A4_DMAK
#undef A4_DMAV
#undef A4_BAR
}


constexpr int A5_K = 0, A5_V = 24576, A5_WS = 40960, A5_OST = 43008;
#define A5_QKM(k8_, q8_, c_) __builtin_amdgcn_mfma_scale_f32_32x32x64_f8f6f4(k8_, q8_, c_, 0, 0, 0, 0x7f7f7f7f, 0, 0x7f7f7f7f)
#define A5_K8(kf_, kb) do { const u32x4 x0_ = *(const LAS u32x4*)(kp + (kb) * 2048), x1_ = *(const LAS u32x4*)(kp + (kb) * 2048 + 512); \
        kf_ = (v8i){(int)x0_[0], (int)x0_[1], (int)x0_[2], (int)x0_[3], (int)x1_[0], (int)x1_[1], (int)x1_[2], (int)x1_[3]}; } while (0)
#define A5_KR(d0r, kb) (*(const LAS bf16x8*)(kp + 4096 + (d0r) * 2048 + (kb) * 512))

#ifndef MK_LATEDMA
#define MK_LATEDMA 0
#endif
#ifndef MK_KD
#define MK_KD 2
#endif
#ifndef MK_VD
#define MK_VD 1
#endif
template <int ABL> __device__ __forceinline__ void attn_unit_v5(int h, int qb, CArgs a, const LAS float* carry, LAS unsigned char* shm) {
    int tid = threadIdx.x; asm volatile("" : "+v"(tid));
    const int lane = tid & 63, r32 = lane & 31, hi = lane >> 5; const int wid = __builtin_amdgcn_readfirstlane(tid >> 6);
    unsigned char* ws = a.ws;
    const bf16_t* QRAW = (const bf16_t*)(ws + WS_R1); const unsigned char* KI = ws + WS_KIMG + (size_t)h * 256 * 8192; const unsigned char* VI = (const unsigned char*)a.out + 32 * MiB + (size_t)h * 256 * 4096;
    const float* CS = (const float*)(ws + WS_CS); const float* qg = (const float*)a.in[15];
    const int q0 = qb * 256, rowq = q0 + wid * 32 + r32;
    const unsigned lds0 = (unsigned)(uintptr_t)shm;
    const int NT = 4 * qb + 4, mylast = 4 * qb + (wid >> 1);
    const unsigned char* ksrc = KI + wid * 1024 + lane * 16; const unsigned char* vsrc = VI + wid * 1024 + lane * 16;
    constexpr int KD = MK_KD, VD = MK_VD, A5_K = 0, A5_V = KD * 8192, A5_WS = A5_V + (VD + 2) * 4096, A5_OST = A5_WS + 2048;
    const unsigned kdst = lds0 + A5_K + wid * 1024, vdst = lds0 + A5_V + wid * 1024;
#define A5_DMAK(t, slot) glds16(ksrc + (size_t)(t) * 8192, (unsigned)__builtin_amdgcn_readfirstlane(kdst + (slot) * 8192))
#define A5_DMAV(t, slot) do { if (wid < 4) glds16(vsrc + (size_t)(t) * 4096, (unsigned)__builtin_amdgcn_readfirstlane(vdst + (slot) * 4096)); } while (0)
#define A5_BAR() asm volatile("s_waitcnt lgkmcnt(0)\n\ts_barrier" ::: "memory")
#define A5_VMW(n_) do { const int vw_ = (n_); if (vw_ >= 7) asm volatile("s_waitcnt vmcnt(7)" ::: "memory"); else if (vw_ == 6) asm volatile("s_waitcnt vmcnt(6)" ::: "memory"); else if (vw_ == 5) asm volatile("s_waitcnt vmcnt(5)" ::: "memory"); else if (vw_ == 4) asm volatile("s_waitcnt vmcnt(4)" ::: "memory"); \
        else if (vw_ == 3) asm volatile("s_waitcnt vmcnt(3)" ::: "memory"); else if (vw_ == 2) asm volatile("s_waitcnt vmcnt(2)" ::: "memory"); else if (vw_ == 1) asm volatile("s_waitcnt vmcnt(1)" ::: "memory"); else asm volatile("s_waitcnt vmcnt(0)" ::: "memory"); } while (0)
    v8i q8; bf16x8 qr4, qr5;
    {
        const bf16_t* qp = QRAW + (size_t)rowq * 1536 + h * 96;
        u32x4 rawn[4], rawr[2]; float qn[32], qv4[8], qv5[8]; float ss = 0.f;
#pragma unroll
        for (int i = 0; i < 4; ++i) rawn[i] = *(const u32x4*)(qp + 32 * hi + 8 * i);
        rawr[0] = *(const u32x4*)(qp + 64 + 8 * hi); rawr[1] = *(const u32x4*)(qp + 80 + 8 * hi);
        f32x4 gq[8];
#pragma unroll
        for (int i = 0; i < 8; ++i) gq[i] = *(const f32x4*)(qg + 32 * hi + 4 * i);
        const f32x4 g0 = *(const f32x4*)(qg + 64 + hi * 8), g1 = *(const f32x4*)(qg + 64 + hi * 8 + 4), g2 = *(const f32x4*)(qg + 80 + hi * 8), g3 = *(const f32x4*)(qg + 80 + hi * 8 + 4);
        const f32x4 c0 = *(const f32x4*)(CS + (size_t)rowq * 32 + hi * 8), c1 = *(const f32x4*)(CS + (size_t)rowq * 32 + hi * 8 + 4), s0 = *(const f32x4*)(CS + (size_t)rowq * 32 + 16 + hi * 8), s1 = *(const f32x4*)(CS + (size_t)rowq * 32 + 16 + hi * 8 + 4);
#pragma unroll
        for (int tp = -KD; tp < 0; ++tp) { A5_DMAK(tp + KD, tp + KD); if (tp + VD >= 0) A5_DMAV(tp + VD, tp + VD); }
#pragma unroll
        for (int i = 0; i < 4; ++i)
#pragma unroll
            for (int j = 0; j < 4; ++j) { qn[8 * i + 2 * j] = lo2f(rawn[i][j]); qn[8 * i + 2 * j + 1] = hi2f(rawn[i][j]); }
#pragma unroll
        for (int j = 0; j < 4; ++j) { qv4[2 * j] = lo2f(rawr[0][j]); qv4[2 * j + 1] = hi2f(rawr[0][j]); qv5[2 * j] = lo2f(rawr[1][j]); qv5[2 * j + 1] = hi2f(rawr[1][j]); }
#pragma unroll
        for (int j = 0; j < 32; ++j) ss += qn[j] * qn[j];
#pragma unroll
        for (int j = 0; j < 8; ++j) ss += qv4[j] * qv4[j] + qv5[j] * qv5[j];
        ss += __shfl_xor(ss, 32);
        const float rs = rsqrtf(ss * (1.f / 96.f) + EPS);
#pragma unroll
        for (int i = 0; i < 8; ++i) { const f32x4 g = gq[i];
#pragma unroll
            for (int e = 0; e < 4; ++e) qn[4 * i + e] *= rs * g[e] * 1.1779544f; }
        {
#pragma unroll
          for (int j = 0; j < 4; ++j) { qv4[j] *= rs * g0[j]; qv4[4 + j] *= rs * g1[j]; qv5[j] *= rs * g2[j]; qv5[4 + j] *= rs * g3[j]; } }
#pragma unroll
        for (int j = 0; j < 8; ++j) { const float cs = j < 4 ? c0[j & 3] : c1[j & 3], sn = j < 4 ? s0[j & 3] : s1[j & 3]; const float x1 = qv4[j], x2 = qv5[j]; qv4[j] = x1 * cs - x2 * sn; qv5[j] = x1 * sn + x2 * cs; }
#pragma unroll
        for (int v = 0; v < 8; ++v) { const int w_ = __builtin_amdgcn_cvt_pk_fp8_f32(qn[4 * v], qn[4 * v + 1], 0, false); q8[v] = __builtin_amdgcn_cvt_pk_fp8_f32(qn[4 * v + 2], qn[4 * v + 3], w_, true); }
        u32x4 w4, w5;
#pragma unroll
        for (int j = 0; j < 4; ++j) { w4[j] = pk2(qv4[2 * j] * (8.f * C2), qv4[2 * j + 1] * (8.f * C2)); w5[j] = pk2(qv5[2 * j] * (8.f * C2), qv5[2 * j + 1] * (8.f * C2)); }
        qr4 = __builtin_bit_cast(bf16x8, w4); qr5 = __builtin_bit_cast(bf16x8, w5);
    }
    if (wid >= 4) __builtin_amdgcn_s_setprio(1);
    f32x16 o[2]; o[0] = f32x16{}; o[1] = f32x16{}; f32x4 lsum = {0.f, 0.f, 0.f, 0.f};
    f32x16 pA0, pA1, pB0, pB1, negm; v8i pwo = (v8i){0, 0, 0, 0, 0, 0, 0, 0};
    int onev = ((((lane >> 4) & 1) != 0) == ((lane & 15) >= 8)) ? 0x38383838 : 0; asm volatile("" : "+v"(onev));
    const v8i ones8 = (v8i){onev, onev, onev, onev, onev, onev, onev, onev};
#define A5_SUM(pw_) lsum = __builtin_amdgcn_mfma_scale_f32_16x16x128_f8f6f4(pw_, ones8, lsum, 0, 0, 0, 0x7f7f7f7f, 0, 0x7f7f7f7f)
    A5_VMW((KD - 1) + (wid < 4 ? VD : 0));
    A5_BAR();
    {
        const LAS unsigned char* kp = shm + A5_K + hi * 1024 + r32 * 16; v8i ka, kb8;
        A5_K8(ka, 0); A5_K8(kb8, 1);
        pA0 = A5_QKM(ka, q8, (f32x16{})); pA1 = A5_QKM(kb8, q8, (f32x16{}));
        pA0 = A2_MF(A5_KR(0, 0), qr4, pA0); pA1 = A2_MF(A5_KR(0, 1), qr4, pA1); pA0 = A2_MF(A5_KR(1, 0), qr5, pA0); pA1 = A2_MF(A5_KR(1, 1), qr5, pA1);
        float rm = fmaxf(pA0[0], pA1[0]);
#pragma unroll
        for (int r = 1; r < 16; ++r) rm = fmaxf(rm, fmaxf(pA0[r], pA1[r]));
        rm = fmaxf(rm, __shfl_xor(rm, 32));
        const float nb = 64.f - rm;
#pragma unroll
        for (int r = 0; r < 16; ++r) { pA0[r] += nb; pA1[r] += nb; negm[r] = nb; }
        asm volatile("" : "+v"(negm));
    }
    int sk_next = 8192, sv_prev = (VD + 1) * 4096;
#define A5_CVU(W, j, P, b) do { if (ABL == 4) { W[j] = pwo[j]; break; } unsigned w_ = __builtin_amdgcn_cvt_pk_u8_f32(P[b], 0, 0u); w_ = __builtin_amdgcn_cvt_pk_u8_f32(P[(b) + 1], 1, w_); w_ = __builtin_amdgcn_cvt_pk_u8_f32(P[(b) + 2], 2, w_); W[j] = (int)__builtin_amdgcn_cvt_pk_u8_f32(P[(b) + 3], 3, w_); } while (0)
#define A5_STEP(C0, C1, N0, N1, t, HASN, HASP) do { \
        const LAS unsigned char* kp = shm + A5_K + sk_next + hi * 1024 + r32 * 16; const LAS unsigned char* vp = shm + A5_V + sv_prev + hi * 1024 + r32 * 16; \
        v8i ka, kb8, vfa, vfb, pwn; bf16x8 r0, r1, r2, r3; \
        A2_SB(); \
        if (HASN) { A5_K8(ka, 0); A5_K8(kb8, 1); r0 = A5_KR(0, 0); r1 = A5_KR(0, 1); A2_SB(); \
            N0 = A5_QKM(ka, q8, negm);  r2 = A5_KR(1, 0); r3 = A5_KR(1, 1); if (HASP) A4_VLD(vfa, 0); A5_CVU(pwn, 0, C0, 0); A5_CVU(pwn, 1, C0, 4); A2_PIN(pwn); A2_SB(); \
            N1 = A5_QKM(kb8, q8, negm); if (HASP) A4_VLD(vfb, 1); if (MK_LATEDMA) A5_ISSUEK(t); A5_CVU(pwn, 2, C0, 8); A5_CVU(pwn, 3, C0, 12); A2_PIN(pwn); A2_SB(); \
            if (ABL != 5) N0 = A2_MF(r0, qr4, N0); A5_CVU(pwn, 4, C1, 0); A2_PIN(pwn); A2_SB(); \
            if (ABL != 5) N1 = A2_MF(r1, qr4, N1); A5_CVU(pwn, 5, C1, 4); A2_PIN(pwn); A2_SB(); \
            if (HASP) { o[0] = A4_PVM(pwo, vfa, o[0]); } if (MK_LATEDMA) A5_ISSUEV(t); A5_CVU(pwn, 6, C1, 8); A5_CVU(pwn, 7, C1, 12); A2_PIN(pwn); A2_SB(); \
            if (ABL != 5) N0 = A2_MF(r2, qr5, N0); A2_SB(); \
            if (ABL != 5) N1 = A2_MF(r3, qr5, N1); A2_SB(); \
            if (HASP) { o[1] = A4_PVM(pwo, vfb, o[1]); } A2_SB(); \
            if (HASP && ABL != 2) { A5_SUM(pwo); } A2_SB(); \
        } else { \
            if (HASP) { A4_VLD(vfa, 0); A4_VLD(vfb, 1); } \
            A5_CVU(pwn, 0, C0, 0); A5_CVU(pwn, 1, C0, 4); A5_CVU(pwn, 2, C0, 8); A5_CVU(pwn, 3, C0, 12); A5_CVU(pwn, 4, C1, 0); A5_CVU(pwn, 5, C1, 4); A5_CVU(pwn, 6, C1, 8); A5_CVU(pwn, 7, C1, 12); \
            if (HASP) { o[0] = A4_PVM(pwo, vfa, o[0]); o[1] = A4_PVM(pwo, vfb, o[1]); A5_SUM(pwo); } A2_SB(); \
        } \
        if ((t) > mylast) { pwn = (v8i){0, 0, 0, 0, 0, 0, 0, 0}; } \
        pwo = pwn; \
        sk_next = (sk_next == (KD - 1) * 8192) ? 0 : sk_next + 8192; sv_prev = (sv_prev == (VD + 1) * 4096) ? 0 : sv_prev + 4096; \
    } while (0)
#define A5_TOP(t) do { const int t_ = (t); int c_ = 0; \
        _Pragma("unroll") for (int b_ = 1; b_ <= KD - 2; ++b_) { c_ += (t_ - b_ + KD < NT) ? 1 : 0; if (wid < 4) c_ += (t_ - b_ + VD < NT) ? 1 : 0; } \
        A5_VMW(c_); \
        if (ABL != 3) A5_BAR(); if (!MK_LATEDMA) { A5_ISSUEK(t_); A5_ISSUEV(t_); } } while (0)
#define A5_ISSUEK(t_) do { if ((t_) + KD < NT) glds16(kg3, (unsigned)__builtin_amdgcn_readfirstlane(kdst + dk)); kg3 += 8192; dk = (dk == (KD - 1) * 8192u) ? 0u : dk + 8192u; } while (0)
#define A5_ISSUEV(t_) do { if ((t_) + VD < NT && wid < 4) glds16(vg2, (unsigned)__builtin_amdgcn_readfirstlane(vdst + dv)); vg2 += 4096; dv = (dv == (VD + 1) * 4096u) ? 0u : dv + 4096u; } while (0)
    const unsigned char* kg3 = ksrc + KD * 8192; const unsigned char* vg2 = vsrc + VD * 4096; unsigned dk = 0u, dv = VD * 4096u;
    A5_TOP(0); A5_STEP(pA0, pA1, pB0, pB1, 0, true, false);
    A5_TOP(1); A5_STEP(pB0, pB1, pA0, pA1, 1, true, true);
    int t = 2;
    for (; t + 2 < NT; t += 2) {
        A5_TOP(t);     A5_STEP(pA0, pA1, pB0, pB1, t, true, true);
        A5_TOP(t + 1); A5_STEP(pB0, pB1, pA0, pA1, t + 1, true, true);
    }
    A5_TOP(t);     A5_STEP(pA0, pA1, pB0, pB1, t, true, true);
    A5_TOP(t + 1); A5_STEP(pB0, pB1, pA0, pA1, t + 1, false, true);
    {
        const LAS unsigned char* vp = shm + A5_V + sv_prev + hi * 1024 + r32 * 16; v8i vfa, vfb;
        A4_VLD(vfa, 0); A4_VLD(vfb, 1); o[0] = A4_PVM(pwo, vfa, o[0]); o[1] = A4_PVM(pwo, vfb, o[1]); A5_SUM(pwo);
    }
#undef A5_STEP
#undef A5_TOP
#undef A5_ISSUEK
#undef A5_ISSUEV
#undef A5_CVU
#undef A5_SUM
    __builtin_amdgcn_s_setprio(0);
    LAS float* sums = (LAS float*)(shm + A5_WS) + wid * 64;
    if ((lane & 7) == 0) *(LAS f32x4*)(sums + ((lane & 8) ? 16 : 0) + 4 * (lane >> 4)) = lsum;
    LDS_WAIT();
    f32x4 ls4[4];
#pragma unroll
    for (int g = 0; g < 4; ++g) ls4[g] = *(const LAS f32x4*)(sums + 8 * g + 4 * hi);
    LAS bf16_t* stg = (LAS bf16_t*)(shm + A5_OST) + wid * 2048;
#pragma unroll
    for (int r = 0; r < 16; ++r) { const int orow = crow(r, hi); const float il = frcp(ls4[r >> 2][r & 3]);
#pragma unroll
        for (int d0 = 0; d0 < 2; ++d0) stg[orow * 64 + d0 * 32 + r32] = (bf16_t)f2bf(o[d0][r] * il); }
    LDS_WAIT();
    const bf16_t* GB = (const bf16_t*)a.out; const bf16_t* HL = (const bf16_t*)(ws + WS_GR); const bf16_t* AC = (const bf16_t*)(ws + WS_GA); bf16_t* MG = (bf16_t*)(ws + WS_XR);
#pragma unroll
    for (int i = 0; i < 4; ++i) { const int row = i * 8 + (lane >> 3), ch = lane & 7; const u32x4 yv = *(const LAS u32x4*)(stg + row * 64 + ch * 8);
        const size_t go = (size_t)(q0 + wid * 32 + row) * 1024 + h * 64 + ch * 8;
        const u32x4 gb = *(const u32x4*)(GB + go), hl = *(const u32x4*)(HL + go), ac = *(const u32x4*)(AC + go); u32x4 w;
#pragma unroll
        for (int j = 0; j < 4; ++j) { const float c0 = carry[ch * 8 + 2 * j], c1 = carry[ch * 8 + 2 * j + 1];
            w[j] = pk2(lo2f(yv[j]) * lo2f(gb[j]) + lo2f(hl[j]) + lo2f(ac[j]) * c0, hi2f(yv[j]) * hi2f(gb[j]) + hi2f(hl[j]) + hi2f(ac[j]) * c1); }
        *(u32x4*)(MG + go) = w; }
    asm volatile("s_waitcnt vmcnt(0) lgkmcnt(0)\n\ts_barrier" ::: "memory");
#undef A5_DMAK
#undef A5_DMAV
#undef A5_BAR
#undef A5_VMW
}

#ifndef MK_V7
#define MK_V7 1
#endif
#ifndef MK_PFVD
#define MK_PFVD 1
#endif
#ifndef MK_PF
#define MK_PF 0
#endif
#ifndef MK_PRIO
#define MK_PRIO 1
#endif
#ifndef MK_VW
#define MK_VW 0
#endif
#ifndef MK_PVF
#define MK_PVF 0
#endif
template <int ABL> __device__ __forceinline__ void attn_block_v7(int h, int s_, CArgs a, const LAS float* carry4, LAS unsigned char* shm) {
    int tid = threadIdx.x; asm volatile("" : "+v"(tid));
    const int lane0 = tid & 63; const int wid = __builtin_amdgcn_readfirstlane(tid >> 6);
    unsigned char* ws = a.ws;
    const bf16_t* QRAW = (const bf16_t*)(ws + WS_R1); const unsigned char* KI = ws + WS_KIMG + (size_t)h * 256 * 8192; const unsigned char* VI = (const unsigned char*)a.out + 32 * MiB + (size_t)h * 256 * 4096;
    const float* CS = (const float*)(ws + WS_CS); const float* qg = (const float*)a.in[15];
    const unsigned lds0 = (unsigned)(uintptr_t)shm; const bool vwave = MK_VW ? (wid >= 4) : (wid < 4); const int wv = wid & 3;
    constexpr int KD = MK_PF ? 3 : MK_KD, VD = MK_PF ? MK_PFVD : MK_VD, A5_K = 0, A5_V = KD * 8192, A5_WS = A5_V + (VD + 2) * 4096, A5_OST = A5_WS + 2048, A5_G = A5_OST + 8 * 4096;
    const unsigned kdst = lds0 + A5_K + wid * 1024, vdst = lds0 + A5_V + wv * 1024;
#define A5_DMAK(t, slot) glds16(ksrc_ + (size_t)(t) * 8192, (unsigned)__builtin_amdgcn_readfirstlane(kdst + (slot) * 8192))
#define A5_DMAV(t, slot) do { if (vwave) glds16(vsrc_ + (size_t)(t) * 4096, (unsigned)__builtin_amdgcn_readfirstlane(vdst + (slot) * 4096)); } while (0)
#define A5_BAR() asm volatile("s_waitcnt lgkmcnt(0)\n\ts_barrier" ::: "memory")
#define A5_VMW(n_) do { const int vw_ = (n_); if (vw_ >= 7) asm volatile("s_waitcnt vmcnt(7)" ::: "memory"); else if (vw_ == 6) asm volatile("s_waitcnt vmcnt(6)" ::: "memory"); else if (vw_ == 5) asm volatile("s_waitcnt vmcnt(5)" ::: "memory"); else if (vw_ == 4) asm volatile("s_waitcnt vmcnt(4)" ::: "memory"); \
        else if (vw_ == 3) asm volatile("s_waitcnt vmcnt(3)" ::: "memory"); else if (vw_ == 2) asm volatile("s_waitcnt vmcnt(2)" ::: "memory"); else if (vw_ == 1) asm volatile("s_waitcnt vmcnt(1)" ::: "memory"); else asm volatile("s_waitcnt vmcnt(0)" ::: "memory"); } while (0)
    LAS float* gl = (LAS float*)(shm + A5_G);
    if (tid < 96) gl[tid] = qg[tid];
    u32x4 rawn[4], rawr[2];
#define A7_LOADQ(qb_, L_) do { const int r32 = (L_) & 31, hi = (L_) >> 5; const unsigned char* ksrc_ = KI + wid * 1024 + (L_) * 16; const unsigned char* vsrc_ = VI + wv * 1024 + (L_) * 16; const int rq_ = (qb_) * 256 + wid * 32 + r32; const bf16_t* qp = QRAW + (size_t)rq_ * 1536 + h * 96; \
        _Pragma("unroll") for (int i_ = 0; i_ < 4; ++i_) rawn[i_] = *(const u32x4*)(qp + 32 * hi + 8 * i_); \
        rawr[0] = *(const u32x4*)(qp + 64 + 8 * hi); rawr[1] = *(const u32x4*)(qp + 80 + 8 * hi); \
        _Pragma("unroll") for (int tp = -KD; tp < 0; ++tp) { A5_DMAK(tp + KD, tp + KD); if (tp + VD >= 0) A5_DMAV(tp + VD, tp + VD); } } while (0)
    A7_LOADQ(s_, lane0);
    A5_BAR();
#pragma unroll 1
    for (int ui = 0; ui < 4; ++ui) {
    int lane = lane0; asm volatile("" : "+v"(lane));
    const int r32 = lane & 31, hi = lane >> 5;
    const unsigned char* ksrc = KI + wid * 1024; const unsigned char* vsrc = VI + wv * 1024; const unsigned loff = (unsigned)lane * 16u;
    int onev = ((((lane >> 4) & 1) != 0) == ((lane & 15) >= 8)) ? 0x38383838 : 0; asm volatile("" : "+v"(onev));
    const v8i ones8 = (v8i){onev, onev, onev, onev, onev, onev, onev, onev};
#define A5_SUM(pw_) lsum = __builtin_amdgcn_mfma_scale_f32_16x16x128_f8f6f4(pw_, ones8, lsum, 0, 0, 0, 0x7f7f7f7f, 0, 0x7f7f7f7f)
    const int qb = ((ui & 2) ? 32 : 0) + ((ui & 1) ? 31 - s_ : s_);
    const int q0 = qb * 256; const int NT = 4 * qb + 4, mylast = 4 * qb + (wid >> 1);
    const LAS float* carry = carry4 + ui * 64;
    v8i q8; bf16x8 qr4, qr5;
    {
        const int rowq = q0 + wid * 32 + r32;
        const f32x4 c0 = *(const f32x4*)(CS + (size_t)rowq * 32 + hi * 8), c1 = *(const f32x4*)(CS + (size_t)rowq * 32 + hi * 8 + 4), s0 = *(const f32x4*)(CS + (size_t)rowq * 32 + 16 + hi * 8), s1 = *(const f32x4*)(CS + (size_t)rowq * 32 + 16 + hi * 8 + 4);
        float qn[32], qv4[8], qv5[8]; float ss = 0.f;
        f32x4 gq[8];
#pragma unroll
        for (int i = 0; i < 8; ++i) gq[i] = *(const LAS f32x4*)(gl + 32 * hi + 4 * i);
        const f32x4 g0 = *(const LAS f32x4*)(gl + 64 + hi * 8), g1 = *(const LAS f32x4*)(gl + 64 + hi * 8 + 4), g2 = *(const LAS f32x4*)(gl + 80 + hi * 8), g3 = *(const LAS f32x4*)(gl + 80 + hi * 8 + 4);
#pragma unroll
        for (int i = 0; i < 4; ++i)
#pragma unroll
            for (int j = 0; j < 4; ++j) { qn[8 * i + 2 * j] = lo2f(rawn[i][j]); qn[8 * i + 2 * j + 1] = hi2f(rawn[i][j]); }
#pragma unroll
        for (int j = 0; j < 4; ++j) { qv4[2 * j] = lo2f(rawr[0][j]); qv4[2 * j + 1] = hi2f(rawr[0][j]); qv5[2 * j] = lo2f(rawr[1][j]); qv5[2 * j + 1] = hi2f(rawr[1][j]); }
#pragma unroll
        for (int j = 0; j < 32; ++j) ss += qn[j] * qn[j];
#pragma unroll
        for (int j = 0; j < 8; ++j) ss += qv4[j] * qv4[j] + qv5[j] * qv5[j];
        ss += __shfl_xor(ss, 32);
        const float rs = rsqrtf(ss * (1.f / 96.f) + EPS);
#pragma unroll
        for (int i = 0; i < 8; ++i) { const f32x4 g = gq[i];
#pragma unroll
            for (int e = 0; e < 4; ++e) qn[4 * i + e] *= rs * g[e] * 1.1779544f; }
        {
#pragma unroll
          for (int j = 0; j < 4; ++j) { qv4[j] *= rs * g0[j]; qv4[4 + j] *= rs * g1[j]; qv5[j] *= rs * g2[j]; qv5[4 + j] *= rs * g3[j]; } }
#pragma unroll
        for (int j = 0; j < 8; ++j) { const float cs = j < 4 ? c0[j & 3] : c1[j & 3], sn = j < 4 ? s0[j & 3] : s1[j & 3]; const float x1 = qv4[j], x2 = qv5[j]; qv4[j] = x1 * cs - x2 * sn; qv5[j] = x1 * sn + x2 * cs; }
#pragma unroll
        for (int v = 0; v < 8; ++v) { const int w_ = __builtin_amdgcn_cvt_pk_fp8_f32(qn[4 * v], qn[4 * v + 1], 0, false); q8[v] = __builtin_amdgcn_cvt_pk_fp8_f32(qn[4 * v + 2], qn[4 * v + 3], w_, true); }
        u32x4 w4, w5;
#pragma unroll
        for (int j = 0; j < 4; ++j) { w4[j] = pk2(qv4[2 * j] * (8.f * C2), qv4[2 * j + 1] * (8.f * C2)); w5[j] = pk2(qv5[2 * j] * (8.f * C2), qv5[2 * j + 1] * (8.f * C2)); }
        qr4 = __builtin_bit_cast(bf16x8, w4); qr5 = __builtin_bit_cast(bf16x8, w5);
    }
    if (MK_PRIO == 1 ? wid >= 4 : MK_PRIO == 2 ? vwave : false) __builtin_amdgcn_s_setprio(1);
    f32x16 o[2]; o[0] = f32x16{}; o[1] = f32x16{}; f32x4 lsum = {0.f, 0.f, 0.f, 0.f};
    f32x16 pA0, pA1, pB0, pB1, negm; v8i pwo = (v8i){0, 0, 0, 0, 0, 0, 0, 0};
    A5_VMW((MK_PF ? KD - 2 : KD - 1) + (vwave ? VD : 0));
    A5_BAR();
    {
        const LAS unsigned char* kp = shm + A5_K + hi * 1024 + r32 * 16; v8i ka, kb8;
        A5_K8(ka, 0); A5_K8(kb8, 1);
        pA0 = A5_QKM(ka, q8, (f32x16{})); pA1 = A5_QKM(kb8, q8, (f32x16{}));
        pA0 = A2_MF(A5_KR(0, 0), qr4, pA0); pA1 = A2_MF(A5_KR(0, 1), qr4, pA1); pA0 = A2_MF(A5_KR(1, 0), qr5, pA0); pA1 = A2_MF(A5_KR(1, 1), qr5, pA1);
        float rm = fmaxf(pA0[0], pA1[0]);
#pragma unroll
        for (int r = 1; r < 16; ++r) rm = fmaxf(rm, fmaxf(pA0[r], pA1[r]));
        rm = fmaxf(rm, __shfl_xor(rm, 32));
        const float nb = 64.f - rm;
#pragma unroll
        for (int r = 0; r < 16; ++r) { pA0[r] += nb; pA1[r] += nb; negm[r] = nb; }
        asm volatile("" : "+v"(negm));
    }
#if MK_PF
    v8i ka;
    { const LAS unsigned char* kp = shm + A5_K + 8192 + hi * 1024 + r32 * 16; A5_K8(ka, 0); }
    int sk_pf = 16384;
#endif
#if MK_PVF
    v8i vfa = q8, vfb = q8; int sv_cur = 0;
#endif
    int sk_next = 8192, sv_prev = (VD + 1) * 4096; v8i kst = q8; bf16x8 rst = qr4; if (ABL == 7) { asm volatile("" : "+v"(kst), "+v"(rst)); }
#define A5_CVU(W, j, P, b) do { if (ABL == 4) { W[j] = pwo[j]; break; } unsigned w_ = __builtin_amdgcn_cvt_pk_u8_f32(P[b], 0, 0u); w_ = __builtin_amdgcn_cvt_pk_u8_f32(P[(b) + 1], 1, w_); w_ = __builtin_amdgcn_cvt_pk_u8_f32(P[(b) + 2], 2, w_); W[j] = (int)__builtin_amdgcn_cvt_pk_u8_f32(P[(b) + 3], 3, w_); } while (0)
#define A5_STEP(C0, C1, N0, N1, t, HASN, HASP, HASN2) do { \
        const LAS unsigned char* kp = shm + A5_K + sk_next + hi * 1024 + r32 * 16; const LAS unsigned char* vp = shm + A5_V + sv_prev + hi * 1024 + r32 * 16; \
        v8i ka = kst, kb8 = kst, vfa = kst, vfb = kst, pwn; bf16x8 r0 = rst, r1 = rst, r2 = rst, r3 = rst; \
        A2_SB(); \
        if (HASN) { if (ABL != 7) { A5_K8(ka, 0); A5_K8(kb8, 1); r0 = A5_KR(0, 0); r1 = A5_KR(0, 1); } A2_SB(); \
            N0 = A5_QKM(ka, q8, negm);  if (ABL != 7) { r2 = A5_KR(1, 0); r3 = A5_KR(1, 1); if (HASP) A4_VLD(vfa, 0); } A5_CVU(pwn, 0, C0, 0); A5_CVU(pwn, 1, C0, 4); A2_PIN(pwn); A2_SB(); \
            N1 = A5_QKM(kb8, q8, negm); if (HASP && ABL != 7) A4_VLD(vfb, 1); if (MK_LATEDMA) A5_ISSUEK(t); A5_CVU(pwn, 2, C0, 8); A5_CVU(pwn, 3, C0, 12); A2_PIN(pwn); A2_SB(); \
            if (ABL != 5) N0 = A2_MF(r0, qr4, N0); A5_CVU(pwn, 4, C1, 0); A2_PIN(pwn); A2_SB(); \
            if (ABL != 5) N1 = A2_MF(r1, qr4, N1); A5_CVU(pwn, 5, C1, 4); A2_PIN(pwn); A2_SB(); \
            if (HASP) { o[0] = A4_PVM(pwo, vfa, o[0]); } if (MK_LATEDMA) A5_ISSUEV(t); A5_CVU(pwn, 6, C1, 8); A5_CVU(pwn, 7, C1, 12); A2_PIN(pwn); A2_SB(); \
            if (ABL != 5) N0 = A2_MF(r2, qr5, N0); A2_SB(); \
            if (ABL != 5) N1 = A2_MF(r3, qr5, N1); A2_SB(); \
            if (HASP) { o[1] = A4_PVM(pwo, vfb, o[1]); } A2_SB(); \
            if (HASP && ABL != 2) { A5_SUM(pwo); } A2_SB(); \
        } else { \
            if (HASP) { A4_VLD(vfa, 0); A4_VLD(vfb, 1); } \
            A5_CVU(pwn, 0, C0, 0); A5_CVU(pwn, 1, C0, 4); A5_CVU(pwn, 2, C0, 8); A5_CVU(pwn, 3, C0, 12); A5_CVU(pwn, 4, C1, 0); A5_CVU(pwn, 5, C1, 4); A5_CVU(pwn, 6, C1, 8); A5_CVU(pwn, 7, C1, 12); \
            if (HASP) { o[0] = A4_PVM(pwo, vfa, o[0]); o[1] = A4_PVM(pwo, vfb, o[1]); A5_SUM(pwo); } A2_SB(); \
        } \
        if ((t) > mylast) { pwn = (v8i){0, 0, 0, 0, 0, 0, 0, 0}; } \
        pwo = pwn; \
        sk_next = (sk_next == (KD - 1) * 8192) ? 0 : sk_next + 8192; sv_prev = (sv_prev == (VD + 1) * 4096) ? 0 : sv_prev + 4096; \
    } while (0)
#if MK_PF
#undef A5_STEP
#define A5_STEP(C0, C1, N0, N1, t, HASN, HASP, HASN2) do { \
        const LAS unsigned char* kp = shm + A5_K + sk_next + hi * 1024 + r32 * 16; const LAS unsigned char* vp = shm + A5_V + sv_prev + hi * 1024 + r32 * 16;        \
        v8i kb8, vfa, vfb, pwn; bf16x8 r0, r1, r2, r3; \
        A2_SB(); \
        if (HASN) { A5_K8(kb8, 1); r0 = A5_KR(0, 0); r1 = A5_KR(0, 1); A2_SB(); \
            N0 = A5_QKM(ka, q8, negm);  r2 = A5_KR(1, 0); r3 = A5_KR(1, 1); if (HASP) A4_VLD(vfa, 0); A5_CVU(pwn, 0, C0, 0); A5_CVU(pwn, 1, C0, 4); A2_PIN(pwn); A2_SB(); \
            N1 = A5_QKM(kb8, q8, negm); if (HASP) A4_VLD(vfb, 1); if (HASN2) { const LAS unsigned char* kp = shm + A5_K + sk_pf + hi * 1024 + r32 * 16; A5_K8(ka, 0); } A5_CVU(pwn, 2, C0, 8); A5_CVU(pwn, 3, C0, 12); A2_PIN(pwn); A2_SB(); \
            N0 = A2_MF(r0, qr4, N0); A5_CVU(pwn, 4, C1, 0); A2_PIN(pwn); A2_SB(); \
            N1 = A2_MF(r1, qr4, N1); A5_CVU(pwn, 5, C1, 4); A2_PIN(pwn); A2_SB(); \
            if (HASP) { o[0] = A4_PVM(pwo, vfa, o[0]); } A5_CVU(pwn, 6, C1, 8); A5_CVU(pwn, 7, C1, 12); A2_PIN(pwn); A2_SB(); \
            N0 = A2_MF(r2, qr5, N0); A2_SB(); \
            N1 = A2_MF(r3, qr5, N1); A2_SB(); \
            if (HASP) { o[1] = A4_PVM(pwo, vfb, o[1]); } A2_SB(); \
            if (HASP) { A5_SUM(pwo); } A2_SB(); \
        } else { \
            if (HASP) { A4_VLD(vfa, 0); A4_VLD(vfb, 1); } \
            A5_CVU(pwn, 0, C0, 0); A5_CVU(pwn, 1, C0, 4); A5_CVU(pwn, 2, C0, 8); A5_CVU(pwn, 3, C0, 12); A5_CVU(pwn, 4, C1, 0); A5_CVU(pwn, 5, C1, 4); A5_CVU(pwn, 6, C1, 8); A5_CVU(pwn, 7, C1, 12); \
            if (HASP) { o[0] = A4_PVM(pwo, vfa, o[0]); o[1] = A4_PVM(pwo, vfb, o[1]); A5_SUM(pwo); } A2_SB(); \
        } \
        if ((t) > mylast) { pwn = (v8i){0, 0, 0, 0, 0, 0, 0, 0}; } \
        pwo = pwn; \
        sk_next = (sk_next == (KD - 1) * 8192) ? 0 : sk_next + 8192; sv_prev = (sv_prev == (VD + 1) * 4096) ? 0 : sv_prev + 4096; sk_pf = (sk_pf == (KD - 1) * 8192) ? 0 : sk_pf + 8192; \
    } while (0)
#endif
#if MK_PVF
#undef A5_STEP
#define A5_STEP(C0, C1, N0, N1, t, HASN, HASP, HASN2) do { \
        const LAS unsigned char* kp = shm + A5_K + sk_next + hi * 1024 + r32 * 16; const LAS unsigned char* vp = shm + A5_V + sv_cur + hi * 1024 + r32 * 16;        \
        v8i ka, kb8, pwn; bf16x8 r0, r1, r2, r3; \
        A2_SB(); \
        if (HASN) { A5_K8(ka, 0); A5_K8(kb8, 1); r0 = A5_KR(0, 0); r1 = A5_KR(0, 1); A2_SB(); \
            if (HASP) { o[0] = A4_PVM(pwo, vfa, o[0]); } r2 = A5_KR(1, 0); r3 = A5_KR(1, 1); A5_CVU(pwn, 0, C0, 0); A5_CVU(pwn, 1, C0, 4); A2_PIN(pwn); A2_SB(); \
            if (HASP) { o[1] = A4_PVM(pwo, vfb, o[1]); } A5_CVU(pwn, 2, C0, 8); A5_CVU(pwn, 3, C0, 12); A2_PIN(pwn); A2_SB(); \
            if (HASP) { A5_SUM(pwo); } A5_CVU(pwn, 4, C1, 0); A2_PIN(pwn); A2_SB(); \
            N0 = A5_QKM(ka, q8, negm);  A4_VLD(vfa, 0); A5_CVU(pwn, 5, C1, 4); A5_CVU(pwn, 6, C1, 8); A2_PIN(pwn); A2_SB(); \
            N1 = A5_QKM(kb8, q8, negm); A4_VLD(vfb, 1); A5_CVU(pwn, 7, C1, 12); A2_PIN(pwn); A2_SB(); \
            N0 = A2_MF(r0, qr4, N0); A2_SB(); \
            N1 = A2_MF(r1, qr4, N1); A2_SB(); \
            N0 = A2_MF(r2, qr5, N0); A2_SB(); \
            N1 = A2_MF(r3, qr5, N1); A2_SB(); \
        } else { \
            A5_CVU(pwn, 0, C0, 0); A5_CVU(pwn, 1, C0, 4); A5_CVU(pwn, 2, C0, 8); A5_CVU(pwn, 3, C0, 12); A5_CVU(pwn, 4, C1, 0); A5_CVU(pwn, 5, C1, 4); A5_CVU(pwn, 6, C1, 8); A5_CVU(pwn, 7, C1, 12); \
            if (HASP) { o[0] = A4_PVM(pwo, vfa, o[0]); o[1] = A4_PVM(pwo, vfb, o[1]); A5_SUM(pwo); } A2_SB(); \
            A4_VLD(vfa, 0); A4_VLD(vfb, 1); A2_SB(); \
        } \
        if ((t) > mylast) { pwn = (v8i){0, 0, 0, 0, 0, 0, 0, 0}; } \
        pwo = pwn; \
        sk_next = (sk_next == (KD - 1) * 8192) ? 0 : sk_next + 8192; sv_cur = (sv_cur == (VD + 1) * 4096) ? 0 : sv_cur + 4096; \
    } while (0)
#endif
#define A5_TOP(t) do { const int t_ = (t); int c_ = 0; \
        if (!MK_PF) { _Pragma("unroll") for (int b_ = 1; b_ <= KD - 2; ++b_) { c_ += (t_ - b_ + KD < NT) ? 1 : 0; if (vwave) c_ += (t_ - b_ + VD < NT) ? 1 : 0; } } \
        A5_VMW(c_); \
        if (ABL != 3) A5_BAR(); if (!MK_LATEDMA) { A5_ISSUEK(t_); A5_ISSUEV(t_); } } while (0)
#define A5_ISSUEK(t_) do { if ((t_) + KD < NT && ABL != 6) glds16s(kg3, loff, (unsigned)__builtin_amdgcn_readfirstlane(kdst + dk)); kg3 += 8192; dk = (dk == (KD - 1) * 8192u) ? 0u : dk + 8192u; } while (0)
#define A5_ISSUEV(t_) do { if ((t_) + VD < NT && vwave && ABL != 6) glds16s(vg2, loff, (unsigned)__builtin_amdgcn_readfirstlane(vdst + dv)); vg2 += 4096; dv = (dv == (VD + 1) * 4096u) ? 0u : dv + 4096u; } while (0)
    const unsigned char* kg3 = ksrc + KD * 8192; const unsigned char* vg2 = vsrc + VD * 4096; unsigned dk = 0u, dv = VD * 4096u;
    A5_TOP(0); A5_STEP(pA0, pA1, pB0, pB1, 0, true, false, true);
    A5_TOP(1); A5_STEP(pB0, pB1, pA0, pA1, 1, true, true, true);
    int t = 2;
    for (; t + 2 < NT; t += 2) {
        A5_TOP(t);     A5_STEP(pA0, pA1, pB0, pB1, t, true, true, true);
        A5_TOP(t + 1); A5_STEP(pB0, pB1, pA0, pA1, t + 1, true, true, true);
    }
    A5_TOP(t);     A5_STEP(pA0, pA1, pB0, pB1, t, true, true, false);
    A5_TOP(t + 1); A5_STEP(pB0, pB1, pA0, pA1, t + 1, false, true, false);
#if MK_PVF
    { o[0] = A4_PVM(pwo, vfa, o[0]); o[1] = A4_PVM(pwo, vfb, o[1]); A5_SUM(pwo); }
#else
    {
        const LAS unsigned char* vp = shm + A5_V + sv_prev + hi * 1024 + r32 * 16; v8i vfa, vfb;
        A4_VLD(vfa, 0); A4_VLD(vfb, 1); o[0] = A4_PVM(pwo, vfa, o[0]); o[1] = A4_PVM(pwo, vfb, o[1]); A5_SUM(pwo);
    }
#endif
#undef A5_STEP
#undef A5_TOP
#undef A5_ISSUEK
#undef A5_ISSUEV
#undef A5_CVU
    __builtin_amdgcn_s_setprio(0);
    A5_BAR();
    int lane_e = lane; asm volatile("" : "+v"(lane_e));
    const int r32e = lane_e & 31, hie = lane_e >> 5;
    if (ui < 3) { const int qbn = (((ui + 1) & 2) ? 32 : 0) + (((ui + 1) & 1) ? 31 - s_ : s_); A7_LOADQ(qbn, lane_e); }
    LAS float* sums = (LAS float*)(shm + A5_WS) + wid * 64;
    if ((lane_e & 7) == 0) *(LAS f32x4*)(sums + ((lane_e & 8) ? 16 : 0) + 4 * (lane_e >> 4)) = lsum;
    LDS_WAIT();
    f32x4 ls4[4];
#pragma unroll
    for (int g = 0; g < 4; ++g) ls4[g] = *(const LAS f32x4*)(sums + 8 * g + 4 * hie);
    LAS bf16_t* stg = (LAS bf16_t*)(shm + A5_OST) + wid * 2048;
#pragma unroll
    for (int r = 0; r < 16; ++r) { const int orow = crow(r, hie); const float il = frcp(ls4[r >> 2][r & 3]);
#pragma unroll
        for (int d0 = 0; d0 < 2; ++d0) stg[orow * 64 + d0 * 32 + r32e] = (bf16_t)f2bf(o[d0][r] * il); }
    LDS_WAIT();
    const bf16_t* GB = (const bf16_t*)a.out; const bf16_t* HL = (const bf16_t*)(ws + WS_GR); const bf16_t* AC = (const bf16_t*)(ws + WS_GA); bf16_t* MG = (bf16_t*)(ws + WS_XR);
#pragma unroll
    for (int i = 0; i < 4; ++i) { const int row = i * 8 + (lane_e >> 3), ch = lane_e & 7; const u32x4 yv = *(const LAS u32x4*)(stg + row * 64 + ch * 8);
        const size_t go = (size_t)(q0 + wid * 32 + row) * 1024 + h * 64 + ch * 8;
        const u32x4 gb = *(const u32x4*)(GB + go), hl = *(const u32x4*)(HL + go), ac = *(const u32x4*)(AC + go); u32x4 w;
#pragma unroll
        for (int j = 0; j < 4; ++j) { const float c0 = carry[ch * 8 + 2 * j], c1 = carry[ch * 8 + 2 * j + 1];
            w[j] = pk2(lo2f(yv[j]) * lo2f(gb[j]) + lo2f(hl[j]) + lo2f(ac[j]) * c0, hi2f(yv[j]) * hi2f(gb[j]) + hi2f(hl[j]) + hi2f(ac[j]) * c1); }
        *(u32x4*)(MG + go) = w; }
    A2_PIN(rawr[0]); A2_PIN(rawr[1]); A2_PIN(rawn[0]); A2_PIN(rawn[1]); A2_PIN(rawn[2]); A2_PIN(rawn[3]);
    }
#undef A5_SUM
#undef A7_LOADQ
    asm volatile("s_waitcnt vmcnt(0) lgkmcnt(0)\n\ts_barrier" ::: "memory");
#undef A5_DMAK
#undef A5_DMAV
#undef A5_BAR
#undef A5_VMW
}

#ifndef MK_V6
#define MK_V6 0
#endif
#ifndef MK_MIDBAR
#define MK_MIDBAR 0
#endif
constexpr int A6_K = 0, A6_V = 49152, A6_WS = 73728, A6_OST = 75776;
template <int ABL> __device__ __forceinline__ void attn_unit_v6(int h, int qb, CArgs a, const LAS float* carry, LAS unsigned char* shm) {
    int tid = threadIdx.x; asm volatile("" : "+v"(tid));
    const int lane = tid & 63, r32 = lane & 31, hi = lane >> 5; const int wid = __builtin_amdgcn_readfirstlane(tid >> 6);
    unsigned char* ws = a.ws;
    const bf16_t* QRAW = (const bf16_t*)(ws + WS_R1); const unsigned char* KI = ws + WS_KIMG + (size_t)h * 256 * 8192; const unsigned char* VI = (const unsigned char*)a.out + 32 * MiB + (size_t)h * 256 * 4096;
    const float* CS = (const float*)(ws + WS_CS); const float* qg = (const float*)a.in[15];
    const int q0 = qb * 256, rowq = q0 + wid * 32 + r32;
    const unsigned lds0 = (unsigned)(uintptr_t)shm;
    const int NT = 4 * qb + 4, mylast = 4 * qb + (wid >> 1);
    const unsigned char* ksrc = KI + wid * 1024 + lane * 16; const unsigned char* vsrc = VI + (wid >> 2) * 4096 + (wid & 3) * 1024 + lane * 16;
    const unsigned kdst = lds0 + A6_K + wid * 1024, vdst = lds0 + A6_V + (wid >> 2) * 4096 + (wid & 3) * 1024;
#define A5_DMAK(t, slot) glds16(ksrc + (size_t)(t) * 8192, (unsigned)__builtin_amdgcn_readfirstlane(kdst + (slot) * 8192))
#define A5_DMAV(t, slot) glds16(vsrc + (size_t)(t) * 4096, (unsigned)__builtin_amdgcn_readfirstlane(vdst + (slot) * 4096))
#define A5_BAR() asm volatile("s_waitcnt lgkmcnt(0)\n\ts_barrier" ::: "memory")
    v8i q8; bf16x8 qr4, qr5;
    {
        const bf16_t* qp = QRAW + (size_t)rowq * 1536 + h * 96;
        u32x4 rawn[4], rawr[2]; float qn[32], qv4[8], qv5[8]; float ss = 0.f;
#pragma unroll
        for (int i = 0; i < 4; ++i) rawn[i] = *(const u32x4*)(qp + 32 * hi + 8 * i);
        rawr[0] = *(const u32x4*)(qp + 64 + 8 * hi); rawr[1] = *(const u32x4*)(qp + 80 + 8 * hi);
        A5_DMAK(0, 0); A5_DMAK(1, 1); A5_DMAK(2, 2); A5_DMAK(3, 3); A5_DMAV(0, 0);
#pragma unroll
        for (int i = 0; i < 4; ++i)
#pragma unroll
            for (int j = 0; j < 4; ++j) { qn[8 * i + 2 * j] = lo2f(rawn[i][j]); qn[8 * i + 2 * j + 1] = hi2f(rawn[i][j]); }
#pragma unroll
        for (int j = 0; j < 4; ++j) { qv4[2 * j] = lo2f(rawr[0][j]); qv4[2 * j + 1] = hi2f(rawr[0][j]); qv5[2 * j] = lo2f(rawr[1][j]); qv5[2 * j + 1] = hi2f(rawr[1][j]); }
#pragma unroll
        for (int j = 0; j < 32; ++j) ss += qn[j] * qn[j];
#pragma unroll
        for (int j = 0; j < 8; ++j) ss += qv4[j] * qv4[j] + qv5[j] * qv5[j];
        ss += __shfl_xor(ss, 32);
        const float rs = rsqrtf(ss * (1.f / 96.f) + EPS);
#pragma unroll
        for (int i = 0; i < 8; ++i) { const f32x4 g = *(const f32x4*)(qg + 32 * hi + 4 * i);
#pragma unroll
            for (int e = 0; e < 4; ++e) qn[4 * i + e] *= rs * g[e] * 1.1779544f; }
        { const f32x4 g0 = *(const f32x4*)(qg + 64 + hi * 8), g1 = *(const f32x4*)(qg + 64 + hi * 8 + 4), g2 = *(const f32x4*)(qg + 80 + hi * 8), g3 = *(const f32x4*)(qg + 80 + hi * 8 + 4);
#pragma unroll
          for (int j = 0; j < 4; ++j) { qv4[j] *= rs * g0[j]; qv4[4 + j] *= rs * g1[j]; qv5[j] *= rs * g2[j]; qv5[4 + j] *= rs * g3[j]; } }
        const f32x4 c0 = *(const f32x4*)(CS + (size_t)rowq * 32 + hi * 8), c1 = *(const f32x4*)(CS + (size_t)rowq * 32 + hi * 8 + 4), s0 = *(const f32x4*)(CS + (size_t)rowq * 32 + 16 + hi * 8), s1 = *(const f32x4*)(CS + (size_t)rowq * 32 + 16 + hi * 8 + 4);
#pragma unroll
        for (int j = 0; j < 8; ++j) { const float cs = j < 4 ? c0[j & 3] : c1[j & 3], sn = j < 4 ? s0[j & 3] : s1[j & 3]; const float x1 = qv4[j], x2 = qv5[j]; qv4[j] = x1 * cs - x2 * sn; qv5[j] = x1 * sn + x2 * cs; }
#pragma unroll
        for (int v = 0; v < 8; ++v) { const int w_ = __builtin_amdgcn_cvt_pk_fp8_f32(qn[4 * v], qn[4 * v + 1], 0, false); q8[v] = __builtin_amdgcn_cvt_pk_fp8_f32(qn[4 * v + 2], qn[4 * v + 3], w_, true); }
        u32x4 w4, w5;
#pragma unroll
        for (int j = 0; j < 4; ++j) { w4[j] = pk2(qv4[2 * j] * (8.f * C2), qv4[2 * j + 1] * (8.f * C2)); w5[j] = pk2(qv5[2 * j] * (8.f * C2), qv5[2 * j + 1] * (8.f * C2)); }
        qr4 = __builtin_bit_cast(bf16x8, w4); qr5 = __builtin_bit_cast(bf16x8, w5);
    }
    if (wid >= 4) __builtin_amdgcn_s_setprio(1);
    f32x16 o[2]; o[0] = f32x16{}; o[1] = f32x16{}; f32x4 lsum = {0.f, 0.f, 0.f, 0.f};
    f32x16 pA0, pA1, pB0, pB1, negm; v8i pwo = (v8i){0, 0, 0, 0, 0, 0, 0, 0};
    int onev = ((((lane >> 4) & 1) != 0) == ((lane & 15) >= 8)) ? 0x38383838 : 0; asm volatile("" : "+v"(onev));
    const v8i ones8 = (v8i){onev, onev, onev, onev, onev, onev, onev, onev};
#define A5_SUM(pw_) lsum = __builtin_amdgcn_mfma_scale_f32_16x16x128_f8f6f4(pw_, ones8, lsum, 0, 0, 0, 0x7f7f7f7f, 0, 0x7f7f7f7f)
    asm volatile("s_waitcnt vmcnt(3)" ::: "memory");
    A5_BAR();
    if (NT > 5) { A5_DMAK(4, 4); A5_DMAK(5, 5); } A5_DMAV(2, 2);
    {
        const LAS unsigned char* kp = shm + A6_K + hi * 1024 + r32 * 16; v8i ka, kb8;
        A5_K8(ka, 0); A5_K8(kb8, 1);
        pA0 = A5_QKM(ka, q8, (f32x16{})); pA1 = A5_QKM(kb8, q8, (f32x16{}));
        pA0 = A2_MF(A5_KR(0, 0), qr4, pA0); pA1 = A2_MF(A5_KR(0, 1), qr4, pA1); pA0 = A2_MF(A5_KR(1, 0), qr5, pA0); pA1 = A2_MF(A5_KR(1, 1), qr5, pA1);
        float rm = fmaxf(pA0[0], pA1[0]);
#pragma unroll
        for (int r = 1; r < 16; ++r) rm = fmaxf(rm, fmaxf(pA0[r], pA1[r]));
        rm = fmaxf(rm, __shfl_xor(rm, 32));
        const float nb = 64.f - rm;
#pragma unroll
        for (int r = 0; r < 16; ++r) { pA0[r] += nb; pA1[r] += nb; negm[r] = nb; }
        asm volatile("" : "+v"(negm));
    }
    int sk_next = 8192, sv_prev = 20480;
#define A5_CVU(W, j, P, b) do { if (ABL == 4) { W[j] = pwo[j]; break; } unsigned w_ = __builtin_amdgcn_cvt_pk_u8_f32(P[b], 0, 0u); w_ = __builtin_amdgcn_cvt_pk_u8_f32(P[(b) + 1], 1, w_); w_ = __builtin_amdgcn_cvt_pk_u8_f32(P[(b) + 2], 2, w_); W[j] = (int)__builtin_amdgcn_cvt_pk_u8_f32(P[(b) + 3], 3, w_); } while (0)
#define A5_STEP(C0, C1, N0, N1, t, HASN, HASP) do { \
        const LAS unsigned char* kp = shm + A6_K + sk_next + hi * 1024 + r32 * 16; const LAS unsigned char* vp = shm + A6_V + sv_prev + hi * 1024 + r32 * 16; \
        v8i ka, kb8, vfa, vfb, pwn; bf16x8 r0, r1, r2, r3; \
        A2_SB(); \
        if (HASN) { A5_K8(ka, 0); A5_K8(kb8, 1); r0 = A5_KR(0, 0); r1 = A5_KR(0, 1); A2_SB(); \
            N0 = A5_QKM(ka, q8, negm);  r2 = A5_KR(1, 0); r3 = A5_KR(1, 1); if (HASP) A4_VLD(vfa, 0); A5_CVU(pwn, 0, C0, 0); A5_CVU(pwn, 1, C0, 4); A2_PIN(pwn); A2_SB(); \
            N1 = A5_QKM(kb8, q8, negm); if (HASP) A4_VLD(vfb, 1); A5_CVU(pwn, 2, C0, 8); A5_CVU(pwn, 3, C0, 12); A2_PIN(pwn); A2_SB(); \
            if (ABL != 5) N0 = A2_MF(r0, qr4, N0); A5_CVU(pwn, 4, C1, 0); A2_PIN(pwn); A2_SB(); \
            if (ABL != 5) N1 = A2_MF(r1, qr4, N1); A5_CVU(pwn, 5, C1, 4); A2_PIN(pwn); A2_SB(); \
            if (HASP) { o[0] = A4_PVM(pwo, vfa, o[0]); } A5_CVU(pwn, 6, C1, 8); A5_CVU(pwn, 7, C1, 12); A2_PIN(pwn); A2_SB(); \
            if (ABL != 5) N0 = A2_MF(r2, qr5, N0); A2_SB(); \
            if (ABL != 5) N1 = A2_MF(r3, qr5, N1); A2_SB(); \
            if (HASP) { o[1] = A4_PVM(pwo, vfb, o[1]); } A2_SB(); \
            if (HASP && ABL != 2) { A5_SUM(pwo); } A2_SB(); \
        } else { \
            if (HASP) { A4_VLD(vfa, 0); A4_VLD(vfb, 1); } \
            A5_CVU(pwn, 0, C0, 0); A5_CVU(pwn, 1, C0, 4); A5_CVU(pwn, 2, C0, 8); A5_CVU(pwn, 3, C0, 12); A5_CVU(pwn, 4, C1, 0); A5_CVU(pwn, 5, C1, 4); A5_CVU(pwn, 6, C1, 8); A5_CVU(pwn, 7, C1, 12); \
            if (HASP) { o[0] = A4_PVM(pwo, vfa, o[0]); o[1] = A4_PVM(pwo, vfb, o[1]); A5_SUM(pwo); } A2_SB(); \
        } \
        if ((t) > mylast) { pwn = (v8i){0, 0, 0, 0, 0, 0, 0, 0}; } \
        pwo = pwn; \
        sk_next = (sk_next == 40960) ? 0 : sk_next + 8192; sv_prev = (sv_prev == 20480) ? 0 : sv_prev + 4096; \
    } while (0)
#define A5_TOP(t) do { const int t_ = (t); \
        if (t_ + 4 < NT) asm volatile("s_waitcnt vmcnt(3)" ::: "memory"); else if (t_ + 2 < NT) asm volatile("s_waitcnt vmcnt(1)" ::: "memory"); else asm volatile("s_waitcnt vmcnt(0)" ::: "memory"); \
        if (ABL != 3) A5_BAR(); \
        if (t_ + 6 < NT) { glds16(kg5, (unsigned)__builtin_amdgcn_readfirstlane(kdst + dk)); glds16(kg5 + 8192, (unsigned)__builtin_amdgcn_readfirstlane(kdst + dk + 8192u)); } \
        if (t_ + 4 < NT) glds16(vg3, (unsigned)__builtin_amdgcn_readfirstlane(vdst + dv)); \
        kg5 += 16384; vg3 += 8192; dk = (dk == 32768u) ? 0u : dk + 16384u; dv = (dv == 16384u) ? 0u : dv + 8192u; } while (0)
    const unsigned char* kg5 = ksrc + 6 * 8192; const unsigned char* vg3 = vsrc + 4 * 4096; unsigned dk = 0u, dv = 16384u;
    A5_STEP(pA0, pA1, pB0, pB1, 0, true, false);
    int t = 1;
    for (; t + 2 < NT; t += 2) {
        A5_TOP(t);
        A5_STEP(pB0, pB1, pA0, pA1, t, true, true);
        if (MK_MIDBAR) A5_BAR();
        A5_STEP(pA0, pA1, pB0, pB1, t + 1, true, true);
    }
    A5_TOP(t); A5_STEP(pB0, pB1, pA0, pA1, t, false, true);
    {
        const LAS unsigned char* vp = shm + A6_V + sv_prev + hi * 1024 + r32 * 16; v8i vfa, vfb;
        A4_VLD(vfa, 0); A4_VLD(vfb, 1); o[0] = A4_PVM(pwo, vfa, o[0]); o[1] = A4_PVM(pwo, vfb, o[1]); A5_SUM(pwo);
    }
#undef A5_STEP
#undef A5_TOP
#undef A5_CVU
#undef A5_SUM
    __builtin_amdgcn_s_setprio(0);
    LAS float* sums = (LAS float*)(shm + A6_WS) + wid * 64;
    if ((lane & 7) == 0) *(LAS f32x4*)(sums + ((lane & 8) ? 16 : 0) + 4 * (lane >> 4)) = lsum;
    LDS_WAIT();
    f32x4 ls4[4];
#pragma unroll
    for (int g = 0; g < 4; ++g) ls4[g] = *(const LAS f32x4*)(sums + 8 * g + 4 * hi);
    LAS bf16_t* stg = (LAS bf16_t*)(shm + A6_OST) + wid * 2048;
#pragma unroll
    for (int r = 0; r < 16; ++r) { const int orow = crow(r, hi); const float il = frcp(ls4[r >> 2][r & 3]);
#pragma unroll
        for (int d0 = 0; d0 < 2; ++d0) stg[orow * 64 + d0 * 32 + r32] = (bf16_t)f2bf(o[d0][r] * il); }
    LDS_WAIT();
    const bf16_t* GB = (const bf16_t*)a.out; const bf16_t* HL = (const bf16_t*)(ws + WS_GR); const bf16_t* AC = (const bf16_t*)(ws + WS_GA); bf16_t* MG = (bf16_t*)(ws + WS_XR);
#pragma unroll
    for (int i = 0; i < 4; ++i) { const int row = i * 8 + (lane >> 3), ch = lane & 7; const u32x4 yv = *(const LAS u32x4*)(stg + row * 64 + ch * 8);
        const size_t go = (size_t)(q0 + wid * 32 + row) * 1024 + h * 64 + ch * 8;
        const u32x4 gb = *(const u32x4*)(GB + go), hl = *(const u32x4*)(HL + go), ac = *(const u32x4*)(AC + go); u32x4 w;
#pragma unroll
        for (int j = 0; j < 4; ++j) { const float c0 = carry[ch * 8 + 2 * j], c1 = carry[ch * 8 + 2 * j + 1];
            w[j] = pk2(lo2f(yv[j]) * lo2f(gb[j]) + lo2f(hl[j]) + lo2f(ac[j]) * c0, hi2f(yv[j]) * hi2f(gb[j]) + hi2f(hl[j]) + hi2f(ac[j]) * c1); }
        *(u32x4*)(MG + go) = w; }
    asm volatile("s_waitcnt vmcnt(0) lgkmcnt(0)\n\ts_barrier" ::: "memory");
#undef A5_DMAK
#undef A5_DMAV
#undef A5_BAR
}

template <int ABL> __device__ __forceinline__ void p3_attention(Frame& F, CArgs a) {
    if (ABL == 9) {
        f32x16 c0 = f32x16{}, c1 = f32x16{}, c2 = f32x16{}, c3 = f32x16{}; f32x4 c4 = {0.f, 0.f, 0.f, 0.f};
        v8i x = (v8i){(int)F.tid, 1, 2, 3, 4, 5, 6, 7}; bf16x8 y = __builtin_bit_cast(bf16x8, (u32x4){(unsigned)F.tid, 1u, 2u, 3u});
#pragma unroll 1
        for (int it = 0; it < 520; ++it) {
            c0 = __builtin_amdgcn_mfma_scale_f32_32x32x64_f8f6f4(x, x, c0, 0, 0, 0, 0x7f7f7f7f, 0, 0x7f7f7f7f); c1 = __builtin_amdgcn_mfma_scale_f32_32x32x64_f8f6f4(x, x, c1, 0, 0, 0, 0x7f7f7f7f, 0, 0x7f7f7f7f);
            c2 = __builtin_amdgcn_mfma_f32_32x32x16_bf16(y, y, c2, 0, 0, 0); c3 = __builtin_amdgcn_mfma_f32_32x32x16_bf16(y, y, c3, 0, 0, 0);
            c0 = __builtin_amdgcn_mfma_scale_f32_32x32x64_f8f6f4(x, x, c0, 0, 0, 0, 0x7f7f7f7f, 0, 0x7f7f7f7f);
            c2 = __builtin_amdgcn_mfma_f32_32x32x16_bf16(y, y, c2, 0, 0, 0); c3 = __builtin_amdgcn_mfma_f32_32x32x16_bf16(y, y, c3, 0, 0, 0);
            c1 = __builtin_amdgcn_mfma_scale_f32_32x32x64_f8f6f4(x, x, c1, 0, 0, 0, 0x7f7f7f7f, 0, 0x7f7f7f7f);
            c4 = __builtin_amdgcn_mfma_scale_f32_16x16x128_f8f6f4(x, x, c4, 0, 0, 0, 0x7f7f7f7f, 0, 0x7f7f7f7f);
        }
        asm volatile("" :: "v"(c0), "v"(c1), "v"(c2), "v"(c3), "v"(c4));
        return;
    }
    const int head = (F.vcu >> 4) & 15, s = F.vcu & 15; const int qbs[4] = {s, 31 - s, 32 + s, 63 - s};
    LAS float* carry = (LAS float*)(F.lds + LDS_XCH);
    if (F.wave == 0) {
        const float* HEND = (const float*)(a.ws + WS_MISC + MISC_HEND); const float* AEND = (const float*)(a.ws + WS_MISC + MISC_AEND); const int c = head * 64 + LANE_NOW(); float cr = 0.f;
        for (int k = 0; k < 64; ++k) {
#pragma unroll
            for (int i = 0; i < 4; ++i) if (k == qbs[i]) carry[i * 64 + LANE_NOW()] = cr;
            cr = AEND[(size_t)k * 1024 + c] * cr + HEND[(size_t)k * 1024 + c];
        }
    }
    LDS_WAIT(); __syncthreads();
    if (F.vcu < 256)
        if (MK_FP8V && MK_FP8K && MK_V7) attn_block_v7<ABL>(head, s, a, carry, F.lds); else
        for (int i = 0; i < 4; ++i) { if (MK_FP8V && MK_FP8K && MK_V6) attn_unit_v6<ABL>(head, qbs[i], a, carry + i * 64, F.lds); else if (MK_FP8V && MK_FP8K) attn_unit_v5<ABL>(head, qbs[i], a, carry + i * 64, F.lds); else if (MK_FP8V) attn_unit_v4(head, qbs[i], a, carry + i * 64, F.lds); else attn_unit_v2<ABL>(head, qbs[i], a, carry + i * 64, F.lds); }
}

template <bool DRY> __device__ __forceinline__ void p6_route(Frame& F, CArgs a) {
    unsigned char* ws = a.ws; const float* H = a.out; const float* WR = (const float*)(ws + WS_MISC + MISC_WR);
    float* RH = (float*)(ws + WS_CTL + CTL_SSQ_H); const float* PH = (const float*)(ws + WS_SSQP + SSQP_H);
    const float* bg = (const float*)a.in[20]; const float* be = (const float*)a.in[22];
    unsigned* cnt = (unsigned*)(ws + WS_CTL) + CW_CNT; int* lists = (int*)(ws + WS_LIST); float* cwl = (float*)(ws + WS_LIST + 2 * MiB); unsigned* tokinfo = (unsigned*)(ws + WS_MISC + MISC_TOK);
    const int lane = LANE_NOW(), r = lane & 15, kq = lane >> 4, w4 = F.wave & 3, kh = F.wave >> 2;
    LAS float* lg = (LAS float*)F.lds + F.wave * (16 * 48);
    for (int rb0 = F.vcu * 4; rb0 < M / 16; rb0 += F.G * 4) {
        const int rb_ = rb0 + w4, rb = rb_ < M / 16 ? rb_ : M / 16 - 1;
        const float* hp = H + (size_t)(rb * 16 + r) * 1024 + 4 * kq + 512 * kh;
        const int c0 = r, c1 = 16 + r, c2 = (32 + r < 36) ? 32 + r : 35;
        const float* w0 = WR + (size_t)c0 * 1024 + 4 * kq + 512 * kh; const float* w1 = WR + (size_t)c1 * 1024 + 4 * kq + 512 * kh; const float* w2 = WR + (size_t)c2 * 1024 + 4 * kq + 512 * kh;
        f32x4 acc0 = {0.f, 0.f, 0.f, 0.f}, acc1 = acc0, acc2 = acc0;
#pragma unroll 8
        for (int S = 0; S < 32; ++S) {
            const f32x4 av = *(const f32x4*)(hp + 16 * S), b0 = *(const f32x4*)(w0 + 16 * S), b1 = *(const f32x4*)(w1 + 16 * S), b2 = *(const f32x4*)(w2 + 16 * S);
#pragma unroll
            for (int s4 = 0; s4 < 4; ++s4) { acc0 = __builtin_amdgcn_mfma_f32_16x16x4f32(av[s4], b0[s4], acc0, 0, 0, 0); acc1 = __builtin_amdgcn_mfma_f32_16x16x4f32(av[s4], b1[s4], acc1, 0, 0, 0); acc2 = __builtin_amdgcn_mfma_f32_16x16x4f32(av[s4], b2[s4], acc2, 0, 0, 0); }
        }
#pragma unroll
        for (int i = 0; i < 4; ++i) { lg[(4 * kq + i) * 48 + r] = acc0[i]; lg[(4 * kq + i) * 48 + 16 + r] = acc1[i]; lg[(4 * kq + i) * 48 + 32 + r] = acc2[i]; }
        LDS_WAIT(); __syncthreads();
        if (kh == 0 && lane < 16 && rb_ < M / 16) {
            const int tok = rb * 16 + lane; const float* pp = PH + (size_t)tok * 16; const f32x4 a0 = *(const f32x4*)pp, a1 = *(const f32x4*)(pp + 4), a2 = *(const f32x4*)(pp + 8), a3 = *(const f32x4*)(pp + 12);
            const float sh = (((a0[0] + a0[1]) + (a0[2] + a0[3])) + ((a1[0] + a1[1]) + (a1[2] + a1[3]))) + (((a2[0] + a2[1]) + (a2[2] + a2[3])) + ((a3[0] + a3[1]) + (a3[2] + a3[3])));
            const float rs = rsqrtf(sh * (1.f / 1024.f) + EPS);
            const LAS float* lr = lg + lane * 48; const LAS float* lr2 = lr + 4 * (16 * 48);
            float gl[4];
#pragma unroll
            for (int q = 0; q < 4; ++q) gl[q] = (lr[q] + lr2[q]) * rs + bg[q];
            int g = 0; float mx = gl[0];
#pragma unroll
            for (int q = 1; q < 4; ++q) if (gl[q] > mx) { mx = gl[q]; g = q; }
            float den = 0.f;
#pragma unroll
            for (int q = 0; q < 4; ++q) den += expf(gl[q] - mx);
            const float pg = 1.f / den;
            float v1 = -INFINITY, v2 = -INFINITY; int i1 = 0, i2 = 0;
#pragma unroll
            for (int q = 0; q < 8; ++q) { const float v = (lr[4 + g * 8 + q] + lr2[4 + g * 8 + q]) * rs + be[g * 8 + q];
                if (v > v1) { v2 = v1; i2 = i1; v1 = v; i1 = q; } else if (v > v2) { v2 = v; i2 = q; } }
            const float e2 = expf(v2 - v1), s1 = 1.f / (1.f + e2), s2 = e2 * s1; const int e1 = g * 8 + i1, eb = g * 8 + i2;
            if (DRY) { asm volatile("" :: "v"(s1 + s2 + pg), "v"(e1 + eb)); }
            else {
                RH[tok] = rs;
                const unsigned sl1 = atomicAdd(cnt + e1, 1u), sl2 = atomicAdd(cnt + eb, 1u);
                lists[(size_t)e1 * M + sl1] = tok; cwl[(size_t)e1 * M + sl1] = pg * s1; lists[(size_t)eb * M + sl2] = tok; cwl[(size_t)eb * M + sl2] = pg * s2;
                tokinfo[tok * 2] = ((unsigned)e1 << 16) | sl1; tokinfo[tok * 2 + 1] = ((unsigned)eb << 16) | sl2;
            }
        }
        LDS_WAIT(); __syncthreads();
    }
}

__device__ __forceinline__ void moe_prefix(Frame& F, CArgs a, volatile LAS int* tpre, volatile LAS int* cnts) {
    const unsigned* cnt = (const unsigned*)(a.ws + WS_CTL) + CW_CNT;
    if (F.wave == 0) {
        int ln = threadIdx.x; asm volatile("" : "+v"(ln)); ln &= 63; const int e = ln & 31; const int c = (int)__hip_atomic_load(cnt + e, RLX_AGENT); const int nt_ = (c + 255) >> 8; int inc = nt_;
#pragma unroll
        for (int d = 1; d < 32; d <<= 1) { const int v = __shfl_up(inc, d); if (e >= d) inc += v; }
        const int exc = inc - nt_;
        if (ln < 32) { tpre[e] = exc; cnts[e] = c; for (int q = 0; q < nt_; ++q) tpre[80 + exc + q] = e; if (e == 31) tpre[32] = inc; }
    }
    LDS_WAIT(); __syncthreads();
}

template <bool DRY> __device__ __forceinline__ void p8_final(Frame& F, CArgs a, const volatile LAS int* tpre) {
    float* out = a.out; const unsigned char* Y = (const unsigned char*)(a.ws + WS_Y); const unsigned* tokinfo = (const unsigned*)(a.ws + WS_MISC + MISC_TOK);
    const int gw = F.vcu * NWAVES + F.wave, NGW = F.G * NWAVES, lane = LANE_NOW();
    for (int tok = gw; tok < M; tok += NGW) {
        const unsigned i0 = tokinfo[tok * 2], i1 = tokinfo[tok * 2 + 1];
        const size_t s0 = (size_t)tpre[i0 >> 16] * 256 + (i0 & 0xffffu), s1 = (size_t)tpre[i1 >> 16] * 256 + (i1 & 0xffffu);
        const size_t c = 16 * lane; const u32x4 y0 = *(const u32x4*)(Y + s0 * 1024 + c), y1 = *(const u32x4*)(Y + s1 * 1024 + c);
#pragma unroll
        for (int q = 0; q < 4; ++q) { f32x4 h = *(const f32x4*)(out + (size_t)tok * 1024 + c + 4 * q);
            const f32x2 a01 = __builtin_amdgcn_cvt_pk_f32_fp8((int)y0[q], false), a23 = __builtin_amdgcn_cvt_pk_f32_fp8((int)y0[q], true), b01 = __builtin_amdgcn_cvt_pk_f32_fp8((int)y1[q], false), b23 = __builtin_amdgcn_cvt_pk_f32_fp8((int)y1[q], true);
            h[0] += (a01[0] + b01[0]) * 0.125f; h[1] += (a01[1] + b01[1]) * 0.125f; h[2] += (a23[0] + b23[0]) * 0.125f; h[3] += (a23[1] + b23[1]) * 0.125f;
            if (DRY) asm volatile("" :: "v"(h)); else *(f32x4*)(out + (size_t)tok * 1024 + c + 4 * q) = h; }
    }
}
constexpr int NPHASE = 10;
#ifndef MK_ONE_LAUNCH
#define MK_ONE_LAUNCH 1
#endif
#ifndef MK_DRY
#define MK_DRY 0
#endif
__global__ void __launch_bounds__(NTHREADS, 2) mega(Args a) {
    extern __shared__ __attribute__((aligned(16))) unsigned char lds_raw[];
    Frame F;
    F.lds = (LAS unsigned char*)lds_raw; F.MISC = (volatile LAS unsigned*)(F.lds + MISC_OFF);
    F.tid = threadIdx.x; F.lane = F.tid & 63; F.wave = __builtin_amdgcn_readfirstlane(F.tid >> 6);
    F.G = gridDim.x; { const int bx = blockIdx.x; F.vcu = (F.G % 8 == 0) ? (bx % 8) * (F.G / 8) + bx / 8 : bx; }
    const __attribute__((address_space(4))) Args* ap0 = (const __attribute__((address_space(4))) Args*)__builtin_amdgcn_kernarg_segment_ptr();
#define KA() (*({ const __attribute__((address_space(4))) Args* p_ = ap0; asm volatile("" : "+s"(p_)); p_; }))
    unsigned char* ws = a.ws; F.ctl = (gu32*)(ws + WS_CTL);
    for (int u = F.tid; u < (LDS_BYTES - LDSCTL_OFF) / 4; u += NTHREADS) ((LAS unsigned*)(F.lds + LDSCTL_OFF))[u] = 0u;
    __syncthreads();
    const int lo = a.ph_lo, hi = a.ph_hi;
    XcdBarrier bar; bar.bar = (unsigned*)(F.ctl + CW_BAR); bar.x = 0; bar.st = nullptr;
    if (hi - lo > 1) bar = xcd_barrier_post((unsigned*)(F.ctl + CW_BAR), F.MISC + 8);
#ifndef PH_MASK
#define PH_MASK 0x3ff
#endif
#define IN(k) (((PH_MASK >> (k)) & 1) && lo <= (k) && (k) < hi)
#ifdef MK_STAMPS
#define STAMP(k) do { if (blockIdx.x == 0 && F.tid == 0) ((unsigned long long*)(ws + WS_CTL + 400000))[k] = __builtin_amdgcn_s_memrealtime(); } while (0)
#else
#define STAMP(k) do {} while (0)
#endif
#ifndef MK_DOUBLE_MASK
#define MK_DOUBLE_MASK 0
#endif
#define REP(k) for (int rep_ = 0; rep_ < (((MK_DOUBLE_MASK >> (k)) & 1) ? 2 : 1); ++rep_)
#ifndef MK_XBAR
#define MK_XBAR 0
#endif
#define SEAM(k) do { if (IN(k) && IN((k) + 1)) { xcd_barrier(bar); if (MK_XBAR && (k) == 4) { for (int xb_ = 0; xb_ < 8; ++xb_) xcd_barrier(bar); } } STAMP((k) + 1); } while (0)
    volatile LAS int* tpre = (volatile LAS int*)(F.lds + LDS_XCH + 8192); volatile LAS int* cnts = tpre + 40;
    const int bx = (int)blockIdx.x;
#ifndef MK_CXV
#define MK_CXV 1
#endif
    const int cx = MK_CXV ? F.vcu : bx;

    STAMP(0);
    if (IN(0)) REP(0) { p0_prologue(F, KA()); SEAM(0); }
    if (IN(1) && MK_DRY == 11) {
        DenseOrder S; S.init(M, 5120, F.G, bx, ws + WS_R1, ws + WS_WIN, 1024, 1024);
        EpiNull E{}; gemm_phase<EpiNull, DenseOrder, true>(F.lds, 1024, 1024, S, E);
        xcd_barrier(bar);
    }
    if (IN(1) && MK_DRY == 1) {
        DenseOrder S; S.init(M, 5120, F.G, bx, ws + WS_R1, ws + WS_WIN, 1024, 1024);
        EpiProj E{(bf16_t*)(ws + WS_XR), (bf16_t*)(ws + WS_GR), (bf16_t*)(ws + WS_QC), (bf16_t*)(ws + WS_KVC), (bf16_t*)(ws + WS_GA), (bf16_t*)KA().out, (bf16_t*)(ws + WS_MISC + MISC_HALO), (float*)(ws + WS_KPE), (float*)(ws + WS_SSQP), (float*)(ws + WS_SSQP + SSQP_KV)};
        gemm_phase<EpiProj, DenseOrder, true>(F.lds, 1024, 1024, S, E);
        xcd_barrier(bar);
    }
    if (IN(6) && MK_DRY == 60) { moe_weight_convert(F, KA(), 0, F.vcu, F.G); xcd_barrier(bar); }
    if (IN(1)) REP(1) {
        DenseOrder S; S.init(M, 5120, F.G, bx, ws + WS_R1, ws + WS_WIN, 1024, 1024);
        EpiProj E{(bf16_t*)(ws + WS_XR), (bf16_t*)(ws + WS_GR), (bf16_t*)(ws + WS_QC), (bf16_t*)(ws + WS_KVC), (bf16_t*)(ws + WS_GA), (bf16_t*)KA().out, (bf16_t*)(ws + WS_MISC + MISC_HALO), (float*)(ws + WS_KPE), (float*)(ws + WS_SSQP), (float*)(ws + WS_SSQP + SSQP_KV)};
        gemm_phase<EpiProj, DenseOrder, true>(F.lds, 1024, 1024, S, E);
        SEAM(1);
    }
    if (IN(2)) { if (MK_DRY == 2) { p2a_conv<true>(F, KA()); xcd_barrier(bar); } p2a_conv<false>(F, KA()); SEAM(2); }
    if (IN(3)) {
        typedef EpiLruT<false> EpiLru;
#define P3_LRU() do { EpiLru EL{(const bf16_t*)(ws + WS_XR), (const float*)KA().in[7], (const float*)KA().in[9], (const float*)KA().in[10], (bf16_t*)(ws + WS_GR), (bf16_t*)(ws + WS_GA), (float*)(ws + WS_MISC + MISC_HEND), (float*)(ws + WS_MISC + MISC_AEND)}; \
            for (int half = 0; half < 2; ++half) { OneOrder S{half * F.G, 8, (const char*)(ws + WS_XR), (const char*)(ws + WS_WLRU), (size_t)256 * 1024 * 2, (size_t)256 * 256 * 2, 512, cx, 512}; \
                gemm_phase<EpiLru, OneOrder, false>(F.lds, 256, 1024, S, EL); } } while (0)
#define P3_QKV() P3_QKVS(3)
#define P3_QKVS(sel_) do { \
            if ((sel_) & 1) { DenseOrder S; S.init(M, 1536, F.G, bx, ws + WS_QC, ws + WS_WUQ, 768, 768, 0, 0, 1); EpiQ E{(bf16_t*)(ws + WS_R1), (float*)(ws + WS_CTL + CTL_SSQ_Q)}; gemm_phase<EpiQ, DenseOrder, true, true, 0x7a7a7a7a>(F.lds, 768, 768, S, E); } \
            if ((sel_) & 2) { DenseOrder S; S.init(M, 2048, F.G, bx, ws + WS_KVC, ws + WS_WUKV, 256, 256, 0, 0, 1); if (F.G == 256) { S.skew_h = 128; S.skew_a = 1; S.skew_b = 3; } \
              EpiKV E{ws + WS_KIMG, (unsigned char*)KA().out + 32 * MiB, (float*)(ws + WS_CTL + CTL_SSQ_KV), (const float*)(ws + WS_MISC + MISC_KSSQ), (const float*)(ws + WS_KPE), (const float*)KA().in[16]}; \
              gemm_phase<EpiKV, DenseOrder, true, true, 0x7b7b7b7b>(F.lds, 256, 256, S, E); } } while (0)
        if (MK_DRY == 31) {
            DenseOrder S; S.init(M, 2048, F.G, bx, ws + WS_KVC, ws + WS_WUKV, 256, 256, 0, 0, 1); if (F.G == 256) { S.skew_h = 128; S.skew_a = 1; S.skew_b = 3; }
            EpiNull E{}; gemm_phase<EpiNull, DenseOrder, true, true, 0x7b7b7b7b>(F.lds, 256, 256, S, E); xcd_barrier(bar); }
        if (MK_DRY == 32) {
            DenseOrder S; S.init(M, 2048, F.G, bx, ws + WS_KVC, ws + WS_WUKV, 256, 256, 0, 0, 1);
            EpiNull E{}; gemm_phase<EpiNull, DenseOrder, true, true, 0x7b7b7b7b>(F.lds, 256, 256, S, E); xcd_barrier(bar); }
        if (MK_DRY == 3) { typedef EpiLruT<true> EpiLruD;
            EpiLruD EL{(const bf16_t*)(ws + WS_XR), (const float*)KA().in[7], (const float*)KA().in[9], (const float*)KA().in[10], (bf16_t*)(ws + WS_GR), (bf16_t*)(ws + WS_GA), (float*)(ws + WS_MISC + MISC_HEND), (float*)(ws + WS_MISC + MISC_AEND)};
#ifndef MK_DRY3
#define MK_DRY3 7
#endif
            if (bx & 1) { if (MK_DRY3 & 1) for (int half = 0; half < 2; ++half) { OneOrder S{half * F.G, 8, (const char*)(ws + WS_XR), (const char*)(ws + WS_WLRU), (size_t)256 * 1024 * 2, (size_t)256 * 256 * 2, 512, cx, 512}; gemm_phase<EpiLruD, OneOrder, false>(F.lds, 256, 1024, S, EL); } if (MK_DRY3 & 6) P3_QKVS((MK_DRY3 >> 1) & 3); }
            else { if (MK_DRY3 & 6) P3_QKVS((MK_DRY3 >> 1) & 3); if (MK_DRY3 & 1) for (int half = 0; half < 2; ++half) { OneOrder S{half * F.G, 8, (const char*)(ws + WS_XR), (const char*)(ws + WS_WLRU), (size_t)256 * 1024 * 2, (size_t)256 * 256 * 2, 512, cx, 512}; gemm_phase<EpiLruD, OneOrder, false>(F.lds, 256, 1024, S, EL); } }
            xcd_barrier(bar); }
        if (bx & 1) { P3_LRU(); P3_QKV(); } else { P3_QKV(); P3_LRU(); }
#undef P3_LRU
#undef P3_QKV
#undef P3_QKVS
        SEAM(3);
    }
#ifndef MK_ABL
#define MK_ABL 0
#endif
    if (IN(4)) { if (MK_ABL) { p3_attention<MK_ABL>(F, KA()); xcd_barrier(bar); } p3_attention<0>(F, KA()); SEAM(4); }
    if (IN(5)) REP(5) {
        DenseOrder S; S.init(M, 1024, F.G, bx, ws + WS_XR, ws + WS_WOUT, 1024, 1024);
        EpiWout E{(const float*)KA().in[0], KA().out, (bf16_t*)(ws + WS_GR), (float*)(ws + WS_SSQP + SSQP_H)};
        gemm_phase<EpiWout, DenseOrder, true>(F.lds, 1024, 1024, S, E);
        SEAM(5);
    }
    if (IN(6)) { if (MK_DRY == 6) { p6_route<true>(F, KA()); xcd_barrier(bar); } if (MK_DRY == 61) { moe_weight_convert(F, KA(), 0, F.vcu, F.G); xcd_barrier(bar); } if (MK_DRY == 62) { moe_weight_convert(F, KA(), 1, F.vcu, F.G); xcd_barrier(bar); } p6_route<false>(F, KA()); moe_weight_convert(F, KA(), 0, F.vcu, F.G); SEAM(6); }
    if (IN(7) && MK_DRY == 7) {
        moe_prefix(F, KA(), tpre, cnts);
        MoeOrder S{tpre, cnts, 2, F.G, cx, (const char*)(ws + WS_GR), (const char*)(ws + WS_WGU), (size_t)512 * 1024, (size_t)256 * 1024, (const int*)(ws + WS_LIST), 1, 0};
        EpiMoeGU E{(bf16_t*)(ws + WS_GA), (float*)(ws + WS_CTL + CTL_SSQ_H), (const int*)(ws + WS_LIST)};
        gemm_phase<EpiMoeGU, MoeOrder, true, true, 0x7a7a7a7a>(F.lds, 1024, 1024, S, E);
        xcd_barrier(bar);
    }
    if (IN(8) && (MK_DRY == 82 || MK_DRY == 83)) {
        moe_prefix(F, KA(), tpre, cnts);
        MoeOrder S{tpre, cnts, 4, F.G, cx, (const char*)(ws + WS_GA), (const char*)(ws + WS_WDN), (size_t)1024 * 256, (size_t)256 * 256, (const int*)(ws + WS_LIST), 0, (size_t)256 * 256};
        typedef EpiMoeDownT<(MK_DRY == 82 ? 1 : 2)> EpiD; EpiD E{(bf16_t*)(ws + WS_Y), (const float*)(ws + WS_LIST + 2 * MiB)};
        gemm_phase<EpiD, MoeOrder, true, true, 0x7b7b7b7b>(F.lds, 256, 256, S, E);
        xcd_barrier(bar);
    }
    if (IN(8) && MK_DRY == 81) {
        moe_prefix(F, KA(), tpre, cnts);
        MoeOrder S{tpre, cnts, 4, F.G, cx, (const char*)(ws + WS_GA), (const char*)(ws + WS_WDN), (size_t)1024 * 256, (size_t)256 * 256, (const int*)(ws + WS_LIST), 0, (size_t)256 * 256};
        EpiNull E{}; gemm_phase<EpiNull, MoeOrder, true, true, 0x7b7b7b7b>(F.lds, 256, 256, S, E);
        xcd_barrier(bar);
    }
    if (IN(7) && MK_DRY == 71) {
        moe_prefix(F, KA(), tpre, cnts);
        MoeOrder S{tpre, cnts, 2, F.G, cx, (const char*)(ws + WS_GR), (const char*)(ws + WS_WGU), (size_t)512 * 1024, (size_t)256 * 1024, (const int*)(ws + WS_LIST), 1, 0};
        EpiNull E{}; gemm_phase<EpiNull, MoeOrder, true, true, 0x7a7a7a7a>(F.lds, 1024, 1024, S, E);
        xcd_barrier(bar);
    }
    if (IN(8) && MK_DRY == 8) {
        moe_prefix(F, KA(), tpre, cnts);
        MoeOrder S{tpre, cnts, 4, F.G, cx, (const char*)(ws + WS_GA), (const char*)(ws + WS_WDN), (size_t)1024 * 256, (size_t)256 * 256, (const int*)(ws + WS_LIST), 0, (size_t)256 * 256};
        EpiMoeDown E{(bf16_t*)(ws + WS_Y), (const float*)(ws + WS_LIST + 2 * MiB)};
        gemm_phase<EpiMoeDown, MoeOrder, true, true, 0x7b7b7b7b>(F.lds, 256, 256, S, E);
        xcd_barrier(bar);
    }
    if (IN(7)) REP(7) {
        moe_prefix(F, KA(), tpre, cnts);
        MoeOrder S{tpre, cnts, 2, F.G, cx, (const char*)(ws + WS_GR), (const char*)(ws + WS_WGU), (size_t)512 * 1024, (size_t)256 * 1024, (const int*)(ws + WS_LIST), 1, 0};
        EpiMoeGU E{(bf16_t*)(ws + WS_GA), (float*)(ws + WS_CTL + CTL_SSQ_H), (const int*)(ws + WS_LIST)};
        gemm_phase<EpiMoeGU, MoeOrder, true, true, 0x7a7a7a7a>(F.lds, 1024, 1024, S, E);
        { const int nG = 2 * tpre[32], heavy = nG > F.G ? (nG - F.G < F.G ? nG - F.G : F.G - 1) : 0;
          if (cx >= heavy) moe_weight_convert(F, KA(), 1, cx - heavy, F.G - heavy); }
        SEAM(7);
    }
    if (IN(8)) REP(8) {
        if (!IN(7)) moe_prefix(F, KA(), tpre, cnts);
        MoeOrder S{tpre, cnts, 4, F.G, cx, (const char*)(ws + WS_GA), (const char*)(ws + WS_WDN), (size_t)1024 * 256, (size_t)256 * 256, (const int*)(ws + WS_LIST), 0, (size_t)256 * 256};
        EpiMoeDown E{(bf16_t*)(ws + WS_Y), (const float*)(ws + WS_LIST + 2 * MiB)};
        gemm_phase<EpiMoeDown, MoeOrder, true, true, 0x7b7b7b7b>(F.lds, 256, 256, S, E);
        SEAM(8);
    }
    if (IN(9)) { if (!IN(8)) moe_prefix(F, KA(), tpre, cnts); if (MK_DRY == 9) { p8_final<true>(F, KA(), tpre); xcd_barrier(bar); } p8_final<false>(F, KA(), tpre); VM_WAIT(); STAMP(10); }
#undef IN
#undef SEAM
}

[[maybe_unused]] static void launch(void* const* d_in, float* d_out, unsigned char* ws, hipStream_t stream, int one_launch) {
    static int grid = 0;
    if (grid == 0) {
        int dev = 0, cus = 0;
        if (hipGetDevice(&dev) != hipSuccess || hipDeviceGetAttribute(&cus, hipDeviceAttributeMultiprocessorCount, dev) != hipSuccess) { fprintf(stderr, "device query failed\n"); grid = -1; return; }
        if (hipFuncSetAttribute((const void*)mega, hipFuncAttributeMaxDynamicSharedMemorySize, LDS_BYTES) != hipSuccess) { fprintf(stderr, "hipFuncSetAttribute failed\n"); grid = -1; return; }
        (void)hipGetLastError();
        grid = cus;
        if (grid != 256) fprintf(stderr, "warning: %d CUs (kernel built for 256)\n", grid);
    }
    if (grid < 0) return;
    (void)hipMemsetAsync(ws + WS_CTL + CW_BAR * 4, 0, (size_t)(CW_CNT - CW_BAR) * 4 + 256, stream);
    Args a{};
    for (int i = 0; i < 26; ++i) a.in[i] = d_in[i];
    a.out = d_out; a.ws = ws;
    if (one_launch) { a.ph_lo = 0; a.ph_hi = NPHASE; hipLaunchKernelGGL(mega, dim3(grid), dim3(NTHREADS), LDS_BYTES, stream, a); }
    else for (int p = 0; p < NPHASE; ++p) { a.ph_lo = p; a.ph_hi = p + 1; hipLaunchKernelGGL(mega, dim3(grid), dim3(NTHREADS), LDS_BYTES, stream, a); }
}
}
extern "C" void kernel_launch(void* const* d_in, const int* in_sizes, int n_in, void* d_out, int out_size, void* d_ws, size_t ws_size, hipStream_t stream) {
    (void)in_sizes; (void)n_in; (void)out_size; (void)ws_size;
    mk::launch(d_in, (float*)d_out, (unsigned char*)d_ws, stream, MK_ONE_LAUNCH);
}
```

```cpp
#include <hip/hip_runtime.h>
#include <hip/hip_bf16.h>
#include <cstdint>
#include <cstdio>
#include <cmath>
namespace mk {
#define LAS __attribute__((address_space(3)))
#define GAS __attribute__((address_space(1)))
typedef unsigned short bf16_t;
typedef short bf16x8 __attribute__((ext_vector_type(8)));
typedef short s16x4 __attribute__((ext_vector_type(4)));
typedef float f32x2 __attribute__((ext_vector_type(2)));
typedef float f32x4 __attribute__((ext_vector_type(4)));
typedef float f32x16 __attribute__((ext_vector_type(16)));
typedef unsigned u32x2 __attribute__((ext_vector_type(2)));
typedef unsigned u32x4 __attribute__((ext_vector_type(4)));
typedef GAS unsigned gu32;

#ifndef MK_FP8V
#define MK_FP8V 1
#endif
#ifndef MK_FP8K
#define MK_FP8K 1
#endif
constexpr int M = 16384, D = 1024, NWAVES = 8, NTHREADS = 512;
constexpr float EPS = 1e-6f, LOG2E = 1.4426950408889634f;
constexpr size_t MiB = 1u << 20;
constexpr size_t WS_CTL = 0, CTL_BYTES = 1 * MiB;
constexpr size_t WS_WIN = 1 * MiB, WS_WUQ = 12 * MiB, WS_WUKV = 15 * MiB, WS_WLRU = 16 * MiB, WS_WOUT = 17 * MiB;
constexpr size_t WS_CS = 19 * MiB, WS_KPE = 21 * MiB, WS_MISC = 23 * MiB, WS_LIST = 25 * MiB;
constexpr size_t WS_R1 = 29 * MiB, WS_XR = 77 * MiB, WS_GR = 109 * MiB, WS_GA = 141 * MiB, WS_QC = 173 * MiB, WS_KVC = 197 * MiB, WS_KIMG = 205 * MiB, WS_DBG = 253 * MiB;
constexpr size_t MISC_HALO = 0, MISC_HEND = 512 * 1024, MISC_AEND = 768 * 1024, MISC_KSSQ = 1024 * 1024, MISC_WR = 1152 * 1024, MISC_TOK = 1408 * 1024;
constexpr size_t WS_SSQP = 253 * MiB, SSQP_KV = 786432, SSQP_H = 1048576;
constexpr size_t WS_Y = WS_QC;
constexpr size_t WS_WGU = WS_R1, WS_WDN = WS_R1 + 32 * MiB;
constexpr int CW_TMO = 0, CW_CODE = 1, CW_BAR = 4096, CW_CNT = 8192;
constexpr size_t CTL_SSQ_Q = 65536, CTL_SSQ_KV = 131072, CTL_SSQ_H = 196608;
constexpr int RING_BYTES = 131072, LDS_XCH = 135168  , LDSCTL_OFF = 147456, MISC_OFF = LDSCTL_OFF + 320, LDS_BYTES = 163840;

#define RLX_AGENT __ATOMIC_RELAXED, __HIP_MEMORY_SCOPE_AGENT
#define LDS_WAIT() asm volatile("s_waitcnt lgkmcnt(0)" ::: "memory")
#define VM_WAIT() asm volatile("s_waitcnt vmcnt(0)" ::: "memory")
__device__ __forceinline__ float bf2f(unsigned v) { return __uint_as_float(v << 16); }
__device__ __forceinline__ unsigned f2bf(float f) { unsigned u = __float_as_uint(f); return (u + 0x7fffu + ((u >> 16) & 1u)) >> 16; }
__device__ __forceinline__ unsigned pk2(float lo, float hi) { typedef __bf16 bf16x2_t __attribute__((ext_vector_type(2))); f32x2 v = {lo, hi}; bf16x2_t b = __builtin_convertvector(v, bf16x2_t); return __builtin_bit_cast(unsigned, b); }
__device__ __forceinline__ float lo2f(unsigned w) { return __uint_as_float(w << 16); }
__device__ __forceinline__ float hi2f(unsigned w) { return __uint_as_float(w & 0xffff0000u); }
__device__ __forceinline__ float fexp2(float x) { return __builtin_amdgcn_exp2f(x); }
__device__ __forceinline__ float frcp(float x) { return __builtin_amdgcn_rcpf(x); }
__device__ __forceinline__ float fsigm(float x) { return frcp(1.f + fexp2(-x * LOG2E)); }
__device__ __forceinline__ float fgelu(float x) { const float u = 0.7978845608028654f * (x + 0.044715f * x * x * x); return x * frcp(1.f + fexp2(-2.f * LOG2E * u)); }
__device__ __forceinline__ float wave_sum(float v) {
#pragma unroll
    for (int o = 1; o < 64; o <<= 1) v += __shfl_xor(v, o);
    return v;
}

#define XB_TMO      128
#define XB_XCNT(j)  (256  + 64 * (j))
#define XB_XSUB(j)  (1280 + 64 * (j))
#define XB_XGEN(j)  (2304 + 64 * (j))
#define XB_TOP      3328
#define XB_TOPGEN   3392
#define XCD_BAR_WORDS 3456
#define XB_SPIN_CAP (1u << 18)
__device__ __forceinline__ unsigned xb_ld(unsigned* p)              { return __hip_atomic_load(p, __ATOMIC_RELAXED, __HIP_MEMORY_SCOPE_AGENT); }
__device__ __forceinline__ unsigned xb_add(unsigned* p, unsigned v) { return __hip_atomic_fetch_add(p, v, __ATOMIC_RELAXED, __HIP_MEMORY_SCOPE_AGENT); }
__device__ __forceinline__ unsigned xb_xcc_id() { return (unsigned)__builtin_amdgcn_s_getreg((3 << 11) | 20) & 0xFu; }
#define XB_SPIN(cond, bar) do { unsigned _sp = 0; while (cond) { __builtin_amdgcn_s_sleep(1); \
    if ((++_sp & 255u) == 0u) { if (xb_ld(&(bar)[XB_TMO])) break; if (_sp > XB_SPIN_CAP) { atomicAdd(&(bar)[XB_TMO], 1u); break; } } } } while (0)
struct XcdBarrier { unsigned* bar; unsigned x; volatile LAS unsigned* st; };
__device__ __forceinline__ XcdBarrier xcd_barrier_post(unsigned* bar, volatile LAS unsigned* st) {
    XcdBarrier b; b.bar = bar; b.x = xb_xcc_id(); b.st = st;
    if (threadIdx.x == 0) (void)xb_add(&bar[XB_XCNT(b.x)], 1u);
    return b;
}
__device__ __forceinline__ void xcd_barrier_complete(unsigned* bar, unsigned x, unsigned& nloc, unsigned& nx) {
    const unsigned G = gridDim.x * gridDim.y * gridDim.z;
    unsigned sum, cnt, mine, sp = 0u;
    for (;;) {
        sum = 0u; cnt = 0u; mine = 0u;
#pragma unroll
        for (unsigned j = 0; j < 16; ++j) { const unsigned c = xb_ld(&bar[XB_XCNT(j)]); sum += c; cnt += (c > 0u) ? 1u : 0u; mine = (j == x) ? c : mine; }
        if (sum == G) break;
        __builtin_amdgcn_s_sleep(1);
        if ((++sp & 255u) == 0u) { if (xb_ld(&bar[XB_TMO])) break; if (sp > XB_SPIN_CAP) { atomicAdd(&bar[XB_TMO], 1u); break; } }
    }
    nloc = mine > 0u ? mine : 1u; nx = cnt > 0u ? cnt : 1u;
}
__device__ __forceinline__ void xcd_barrier(const XcdBarrier& b) {
    asm volatile("s_waitcnt vmcnt(0)" ::: "memory");
    __syncthreads();
    if (threadIdx.x == 0) {
        unsigned* bar = b.bar;
        __builtin_amdgcn_s_waitcnt(0);
        unsigned nloc = b.st[0], nx = b.st[1];
        if (nloc == 0u) { xcd_barrier_complete(bar, b.x, nloc, nx); b.st[0] = nloc; b.st[1] = nx; }
        const unsigned old = xb_add(&bar[XB_XSUB(b.x)], 1u);
        const unsigned gen = old / nloc;
        if (old + 1u == (gen + 1u) * nloc) {
            __builtin_amdgcn_fence(__ATOMIC_RELEASE, "agent");
            asm volatile("s_waitcnt vmcnt(0)" ::: "memory");
            const unsigned og = xb_add(&bar[XB_TOP], 1u);
            const unsigned tg = og / nx;
            if (og + 1u == (tg + 1u) * nx) xb_add(&bar[XB_TOPGEN], 1u);
            else XB_SPIN(xb_ld(&bar[XB_TOPGEN]) == tg, bar);
            __builtin_amdgcn_fence(__ATOMIC_ACQUIRE, "agent");
            xb_add(&bar[XB_XGEN(b.x)], 1u);
            asm volatile("s_waitcnt vmcnt(0)" ::: "memory");
        } else {
            XB_SPIN(xb_ld(&bar[XB_XGEN(b.x)]) == gen, bar);
            __builtin_amdgcn_fence(__ATOMIC_ACQUIRE, "agent");
            asm volatile("s_waitcnt vmcnt(0)" ::: "memory");
        }
    }
    __syncthreads();
}

constexpr int BM = 256, BK = 64, HALF = 128, HTB = HALF * BK * 2, STAGE_BYTES = 8 * HTB;
__device__ __forceinline__ int lds_byte(int r, int c) { const int st = (r >> 4) * 2 + (c >> 5), rr = r & 15, cc = c & 31, ob = rr * 64 + cc * 2; return st * 1024 + (ob ^ (((ob >> 9) & 1) << 5)); }
__device__ __forceinline__ void stage_rc(int b, int& R, int& C) { const int st = b / 1024, sb = b % 1024, swz = sb ^ (((sb >> 9) & 1) << 5); R = (st >> 1) * 16 + swz / 64; C = (st & 1) * 32 + (swz % 64) / 2; }
__device__ __forceinline__ int perm32(int rho) { const int n = rho >> 4, i = rho & 15; return 8 * (i >> 2) + 4 * n + (i & 3); }

struct Unit { int pm, pn; const char* A; const char* B; const int* gat; int valid; int x0, x1; };
typedef f32x4 Acc[2][2][4][2];

#define PG8_SA(b, h) (((b) * 2 + (h)) * HTB)
#define PG8_SB(b, h) ((4 + (b) * 2 + (h)) * HTB)
#define PG8_STAGE(bufoff, gbase, voff) do { _Pragma("unroll") for (int _i = 0; _i < 2; ++_i) \
        __builtin_amdgcn_global_load_lds((const unsigned*)((const char*)(gbase) + (voff)[_i]), (LAS unsigned*)(lds + (bufoff) + ldsw + _i * 8192), 16, 0, 0); } while (0)
#define PG8_LDA(dst, b, h) do { if constexpr (F8) { _Pragma("unroll") for (int m = 0; m < 4; ++m) { const u32x4 x0_ = *(const LAS u32x4*)(lds + PG8_SA(b, h) + a8o0 + m * 2048), x1_ = *(const LAS u32x4*)(lds + PG8_SA(b, h) + a8o1 + m * 2048); \
            dst##8[m] = __builtin_bit_cast(v8i_t, __builtin_shufflevector(x0_, x1_, 0, 1, 2, 3, 4, 5, 6, 7)); } } \
        else { _Pragma("unroll") for (int m = 0; m < 4; ++m) _Pragma("unroll") for (int k = 0; k < 2; ++k) dst[m][k] = *(const LAS bf16x8*)(lds + PG8_SA(b, h) + aoff + m * 2048 + k * 1024); } } while (0)
#define PG8_LDB(dst, b, h) do { if constexpr (F8) { _Pragma("unroll") for (int n = 0; n < 2; ++n) { const u32x4 x0_ = *(const LAS u32x4*)(lds + PG8_SB(b, h) + b8o0 + n * 2048), x1_ = *(const LAS u32x4*)(lds + PG8_SB(b, h) + b8o1 + n * 2048); \
            dst##8[n] = __builtin_bit_cast(v8i_t, __builtin_shufflevector(x0_, x1_, 0, 1, 2, 3, 4, 5, 6, 7)); } } \
        else { _Pragma("unroll") for (int n = 0; n < 2; ++n) _Pragma("unroll") for (int k = 0; k < 2; ++k) dst[n][k] = *(const LAS bf16x8*)(lds + PG8_SB(b, h) + boff + n * 2048 + k * 1024); } } while (0)
#define PG8_MMA(ai, bj, At, Bt) do { __builtin_amdgcn_s_setprio(1); if constexpr (F8) { _Pragma("unroll") for (int m = 0; m < 4; ++m) _Pragma("unroll") for (int n = 0; n < 2; ++n) \
            asm volatile("v_mfma_scale_f32_16x16x128_f8f6f4 %0, %1, %2, %0, %3, %4 op_sel_hi:[0,0,0]" : "+v"(acc[ai][bj][m][n]) : "v"(Bt##8[n]), "v"(At##8[m]), "v"(scw_), "v"(scx_)); } \
        else { _Pragma("unroll") for (int m = 0; m < 4; ++m) _Pragma("unroll") for (int n = 0; n < 2; ++n) _Pragma("unroll") for (int k = 0; k < 2; ++k) \
            acc[ai][bj][m][n] = __builtin_amdgcn_mfma_f32_16x16x32_bf16(Bt[n][k], At[m][k], acc[ai][bj][m][n], 0, 0, 0); } __builtin_amdgcn_s_setprio(0); } while (0)
#define PG8_WAIT_V(n) asm volatile("s_waitcnt vmcnt(" #n ")" ::: "memory")
#define PG8_WAIT_L(n) asm volatile("s_waitcnt lgkmcnt(" #n ")" ::: "memory")
#define PG8_BAR __builtin_amdgcn_s_barrier()
#define PG8_SCHED __builtin_amdgcn_sched_barrier(0)
#define PG8_VOFFA(u, vo) do { _Pragma("unroll") for (int _h = 0; _h < 2; ++_h) _Pragma("unroll") for (int _i = 0; _i < 2; ++_i) { const int _row = _h * HALF + Ra[_i]; \
        const int _ri = (u).gat ? (_row < (u).valid ? (u).gat[_row] : 0) : _row; vo[_h][_i] = F8 ? (unsigned)(_ri * lda + 2 * Ca[_i]) : (unsigned)(_ri * lda + Ca[_i]) * 2u; } } while (0)

typedef int v8i_t __attribute__((ext_vector_type(8)));
#ifndef MK_FRESH
#define MK_FRESH 1
#endif
template <class Epi, class Sched, bool ALIGN_EPI, bool F8 = false, int SC_W = 0x7f7f7f7f>
__device__ __forceinline__ void gemm_phase(LAS unsigned char* lds, const int K, const int lda, const Sched& S, const Epi& E) {
    int tid_ = threadIdx.x; asm volatile("" : "+v"(tid_));
    const int tid = tid_, wid = __builtin_amdgcn_readfirstlane(tid >> 6), lane = tid & 63, wr = wid >> 2, wc = wid & 3, fr = lane & 15, fq = lane >> 4;
    const int nt = F8 ? K / 128 : K / BK;
    int Ra[2], Ca[2]; unsigned voffB[2];
#pragma unroll
    for (int i = 0; i < 2; ++i) { int R, C; stage_rc(tid * 16 + i * 8192, R, C); const int Rb = Epi::PERM ? ((R & ~31) + perm32(R & 31)) : R; Ra[i] = R; Ca[i] = C; voffB[i] = F8 ? (unsigned)(Rb * K + 2 * C) : (unsigned)(Rb * K + C) * 2u; }
    const size_t kstep = (size_t)(BK * 2);
    const size_t hstep = F8 ? (size_t)HALF * K : (size_t)HALF * K * 2;
    const unsigned ldsw = (unsigned)wid * 1024u;
    const int aoff = lds_byte(wr * 64 + fr, fq * 8), boff = lds_byte(wc * 32 + fr, fq * 8);
    const int a8o0 = lds_byte(wr * 64 + fr, 16 * fq), a8o1 = lds_byte(wr * 64 + fr, 16 * fq + 8), b8o0 = lds_byte(wc * 32 + fr, 16 * fq), b8o1 = lds_byte(wc * 32 + fr, 16 * fq + 8);
    Unit cur, nxt; int ui = 0; bool fresh = false;
    if (!S.next(0, cur)) return;
    Acc acc;
#pragma unroll
    for (int a = 0; a < 2; ++a)
#pragma unroll
        for (int b = 0; b < 2; ++b)
#pragma unroll
            for (int m = 0; m < 4; ++m)
#pragma unroll
                for (int n = 0; n < 2; ++n) acc[a][b][m][n] = (f32x4){0.f, 0.f, 0.f, 0.f};
    bf16x8 At[4][2], B0[2][2], B1[2][2]; v8i_t At8[4], B08[2], B18[2]; const int scw_ = SC_W, scx_ = 0x7f7f7f7f;
    unsigned vC[2][2], vN[2][2];
    PG8_VOFFA(cur, vC);
    const char* cA = cur.A; const char* cB = cur.B;
    PG8_STAGE(PG8_SB(0, 0), cB, voffB); PG8_STAGE(PG8_SB(0, 1), cB + hstep, voffB); PG8_STAGE(PG8_SA(0, 0), cA, vC[0]); PG8_STAGE(PG8_SA(0, 1), cA, vC[1]);
    if (wr == 1) PG8_BAR;
    PG8_WAIT_V(2); PG8_BAR;
    PG8_STAGE(PG8_SB(1, 0), cB + kstep, voffB); PG8_STAGE(PG8_SA(1, 0), cA + kstep, vC[0]); PG8_STAGE(PG8_SB(1, 1), cB + hstep + kstep, voffB);
    PG8_WAIT_V(6); PG8_BAR;
    for (;;) {
        const bool has_next = S.next(ui + 1, nxt);
        if (!has_next) nxt = cur;
        PG8_VOFFA(nxt, vN);
        const char* nA = nxt.A; const char* nB = nxt.B;
#pragma unroll 1
        for (int t = 0; t < nt; t += 2) {
            const bool last = (t == nt - 2);
            const bool skipw = MK_FRESH && Epi::ORDERS && fresh && t == 0;
            const char* a1 = cA + (size_t)(t + 1) * kstep;
            const char* a2 = last ? nA : cA + (size_t)(t + 2) * kstep; const char* b2 = last ? nB : cB + (size_t)(t + 2) * kstep;
            const char* a3 = a2 + kstep; const char* b3 = b2 + kstep;
            unsigned vS[2][2];
#pragma unroll
            for (int h = 0; h < 2; ++h)
#pragma unroll
                for (int i = 0; i < 2; ++i) vS[h][i] = last ? vN[h][i] : vC[h][i];
            PG8_LDB(B0, 0, 0); PG8_LDB(B1, 0, 1); PG8_SCHED; PG8_LDA(At, 0, 0); PG8_STAGE(PG8_SA(1, 1), a1, vC[1]);
            if (!skipw) PG8_WAIT_V(8); PG8_WAIT_L(0); PG8_BAR; PG8_MMA(0, 0, At, B0); PG8_MMA(0, 1, At, B1); PG8_BAR; PG8_SCHED;
            PG8_LDA(At, 0, 1); PG8_STAGE(PG8_SB(0, 0), b2, voffB); PG8_STAGE(PG8_SB(0, 1), b2 + hstep, voffB); PG8_STAGE(PG8_SA(0, 0), a2, vS[0]);
            if (!skipw) PG8_WAIT_V(8); PG8_WAIT_L(0); PG8_BAR; PG8_MMA(1, 0, At, B0); PG8_MMA(1, 1, At, B1); PG8_BAR; PG8_SCHED;
            PG8_LDB(B0, 1, 0); PG8_LDB(B1, 1, 1); PG8_SCHED; PG8_LDA(At, 1, 0); PG8_STAGE(PG8_SA(0, 1), a2, vS[1]);
            PG8_WAIT_V(8); PG8_WAIT_L(0); PG8_BAR; PG8_MMA(0, 0, At, B0); PG8_MMA(0, 1, At, B1); PG8_BAR; PG8_SCHED;
            PG8_LDA(At, 1, 1); PG8_STAGE(PG8_SB(1, 0), b3, voffB); PG8_STAGE(PG8_SB(1, 1), b3 + hstep, voffB); PG8_STAGE(PG8_SA(1, 0), a3, vS[0]);
            PG8_WAIT_V(8); PG8_WAIT_L(0); PG8_BAR; PG8_MMA(1, 0, At, B0); PG8_MMA(1, 1, At, B1); PG8_BAR; PG8_SCHED;
            fresh = false;
        }
        if constexpr (F8) asm volatile("s_nop 15\n\ts_nop 15" ::: "memory");
        if constexpr (ALIGN_EPI) { if (wr == 0) PG8_BAR; }
        if constexpr (!Epi::AFTER_DRAIN) { E(acc, cur, wr, wc, fr, fq); fresh = true; }
        if (!has_next) break;
#pragma unroll
        for (int a = 0; a < 2; ++a)
#pragma unroll
            for (int b = 0; b < 2; ++b)
#pragma unroll
                for (int m = 0; m < 4; ++m)
#pragma unroll
                    for (int n = 0; n < 2; ++n) acc[a][b][m][n] = (f32x4){0.f, 0.f, 0.f, 0.f};
        cur = nxt; cA = nA; cB = nB; ++ui;
#pragma unroll
        for (int h = 0; h < 2; ++h)
#pragma unroll
            for (int i = 0; i < 2; ++i) vC[h][i] = vN[h][i];
        if constexpr (ALIGN_EPI) { if (wr == 1) PG8_BAR; }
    }
    PG8_WAIT_V(0);
    if constexpr (!ALIGN_EPI) { if (wr == 0) PG8_BAR; }
    PG8_BAR;
    if constexpr (Epi::AFTER_DRAIN) { E.fused(acc, cur, wr, wc, fr, fq, lds, wid, lane); }
}
struct DenseOrder {
    int nM, nN, nwg, G, c; const char* A; const char* B; size_t a_tile, b_tile; int a_col_tile;
    int pn_per_ablk;
    int skew_h, skew_a, skew_b;
    __device__ void init(int Mr, int N, int G_, int c_, const void* A_, const void* B_, int lda, int K, int pnpa = 0, int acolbytes = 0, int esz = 2) {
        nM = Mr / BM; nN = N / BM; nwg = nM * nN; G = G_; c = c_; A = (const char*)A_; B = (const char*)B_; a_tile = (size_t)BM * lda * esz; b_tile = (size_t)BM * K * esz; pn_per_ablk = pnpa; a_col_tile = acolbytes; skew_h = 0; skew_a = 0; skew_b = 0; }
    __device__ bool next(int i, Unit& u) const {
        long L = (long)i * G + c;
        if (skew_h > 0) { if (c < skew_h) { if (i >= skew_a) return false; L = (long)c * skew_a + i; } else { if (i >= skew_b) return false; L = (long)skew_h * skew_a + (long)(c - skew_h) * skew_b + i; } }
        if (L >= nwg) return false;
        int wgid = (int)L; { const int q = nwg / 8, r = nwg % 8, xcd = wgid % 8, off = wgid / 8; wgid = (xcd < r ? xcd * (q + 1) : r * (q + 1) + (xcd - r) * q) + off; }
        const int WGM = 8, nig = WGM * nN, gid = wgid / nig, fm = gid * WGM, gsz = (nM - fm) < WGM ? (nM - fm) : WGM;
        u.pm = fm + ((wgid % nig) % gsz); u.pn = (wgid % nig) / gsz;
        u.A = A + (size_t)u.pm * a_tile + (pn_per_ablk ? (size_t)(u.pn / pn_per_ablk) * a_col_tile : 0); u.B = B + (size_t)u.pn * b_tile; u.gat = nullptr; u.valid = 256; u.x0 = 0; u.x1 = 0; return true;
    }
};
struct OneOrder {
    int first, nN; const char* A; const char* B; size_t a_tile, b_tile; int a_col_tile; int c; int total;
    __device__ bool next(int i, Unit& u) const {
        if (i > 0) return false; const int L = first + c; if (L >= total) return false;
        u.pm = L / nN; u.pn = L % nN; u.A = A + (size_t)u.pm * a_tile + (size_t)(u.pn >> 1) * a_col_tile; u.B = B + (size_t)u.pn * b_tile; u.gat = nullptr; u.valid = 256; u.x0 = 0; u.x1 = 0; return true; }
};
struct MoeOrder {
    const volatile LAS int* tpre; const volatile LAS int* cnt; int ncol; int G, c; const char* A; const char* B; size_t b_exp; size_t b_tile; const int* lists; int gather; size_t a_tile;
    __device__ bool next(int i, Unit& u) const {
        const int L = i * G + c; const int ntile = __builtin_amdgcn_readfirstlane(tpre[32]); if (L >= ntile * ncol) return false;
        const int T = L / ncol, pn = L % ncol; const int e = __builtin_amdgcn_readfirstlane(tpre[80 + T]);
        const int rt = __builtin_amdgcn_readfirstlane(T - tpre[e]); int valid = cnt[e] - rt * 256; valid = __builtin_amdgcn_readfirstlane(valid > 256 ? 256 : valid);
        u.pm = T; u.pn = pn; u.x0 = e; u.x1 = rt; u.valid = valid; u.B = B + (size_t)e * b_exp + (size_t)pn * b_tile;
        if (gather) { u.A = A; u.gat = lists + (size_t)e * M + rt * 256; } else { u.A = A + (size_t)T * a_tile; u.gat = nullptr; }
        return true; }
};

#ifndef MK_FRESH_P1
#define MK_FRESH_P1 1
#endif
__device__ __forceinline__ u32x4 pack8(f32x4 a, f32x4 b) { u32x4 w; w.x = pk2(a[0], a[1]); w.y = pk2(a[2], a[3]); w.z = pk2(b[0], b[1]); w.w = pk2(b[2], b[3]); return w; }
__device__ __forceinline__ float dot4(f32x4 a) { return (a[0] * a[0] + a[1] * a[1]) + (a[2] * a[2] + a[3] * a[3]); }

struct EpiProj {
    static constexpr bool PERM = true, AFTER_DRAIN = false, ORDERS = MK_FRESH_P1;
    bf16_t *XR, *GR, *QC, *KVC, *GA, *GB, *HALO; float *KPE, *ssq_q, *ssq_kv;
    __device__ __forceinline__ void operator()(const Acc& acc, const Unit& u, int wr, int wc, int fr, int fq) const {
        const int pn = u.pn, rowb = u.pm * BM + wr * 64 + fr;
        if (pn == 20) {
            if (MK_FRESH_P1) asm volatile("s_waitcnt vmcnt(0)" ::: "memory");
            if (wc == 0) {
#pragma unroll
                for (int ai = 0; ai < 2; ++ai)
#pragma unroll
                    for (int m = 0; m < 4; ++m) { float* p = KPE + (size_t)(rowb + ai * HALF + m * 16) * 32 + 8 * fq; *(f32x4*)p = acc[ai][0][m][0]; *(f32x4*)(p + 4) = acc[ai][0][m][1]; }
            }
            return;
        }
        bf16_t* dst; int ldc, colt, act = 0; float* ssq = nullptr; int nslot = 0, slot = 0;
        if (pn < 4) { dst = XR; ldc = 1024; colt = pn * 256; }
        else if (pn < 8) { dst = GR; ldc = 1024; colt = (pn - 4) * 256; act = 1; }
        else if (pn < 11) { dst = QC; ldc = 768; colt = (pn - 8) * 256; ssq = ssq_q; nslot = 12; slot = (pn - 8) * 4 + wc; act = 3; }
        else if (pn == 11) { dst = KVC; ldc = 256; colt = 0; ssq = ssq_kv; nslot = 4; slot = wc; act = 3; }
        else if (pn < 16) { dst = GA; ldc = 1024; colt = (pn - 12) * 256; act = 2; }
        else { dst = GB; ldc = 1024; colt = (pn - 16) * 256; act = 2; }
        const int col0 = colt + wc * 32 + 8 * fq;
        if (MK_FRESH_P1) asm volatile("s_waitcnt vmcnt(0)" ::: "memory");
#pragma unroll
        for (int ai = 0; ai < 2; ++ai)
#pragma unroll
            for (int m = 0; m < 4; ++m) {
                const int row = rowb + ai * HALF + m * 16; float ss = 0.f;
#pragma unroll
                for (int bj = 0; bj < 2; ++bj) {
                    f32x4 v0 = acc[ai][bj][m][0], v1 = acc[ai][bj][m][1];
                    if (ssq) ss += dot4(v0) + dot4(v1);
                    if (act == 1) {
#pragma unroll
                        for (int e = 0; e < 4; ++e) { v0[e] = fgelu(v0[e]); v1[e] = fgelu(v1[e]); }
                    } else if (act == 2) {
#pragma unroll
                        for (int e = 0; e < 4; ++e) { v0[e] = fsigm(v0[e]); v1[e] = fsigm(v1[e]); }
                    }
                    if (act == 3) { u32x2 w8; int w_ = __builtin_amdgcn_cvt_pk_fp8_f32(v0[0], v0[1], 0, false); w8.x = (unsigned)__builtin_amdgcn_cvt_pk_fp8_f32(v0[2], v0[3], w_, true);
                        w_ = __builtin_amdgcn_cvt_pk_fp8_f32(v1[0], v1[1], 0, false); w8.y = (unsigned)__builtin_amdgcn_cvt_pk_fp8_f32(v1[2], v1[3], w_, true);
                        *(u32x2*)((unsigned char*)dst + (size_t)row * ldc + col0 + bj * HALF) = w8; }
                    else *(u32x4*)(dst + (size_t)row * ldc + col0 + bj * HALF) = pack8(v0, v1);
                }
                if (ssq) { ss += __shfl_xor(ss, 16); ss += __shfl_xor(ss, 32); if (fq == 0) ssq[(size_t)row * nslot + slot] = ss; }
            }
        if (pn < 4 && wr == 1 && fr >= 13) {
#pragma unroll
            for (int bj = 0; bj < 2; ++bj) *(u32x4*)(HALO + ((size_t)u.pm * 3 + (fr - 13)) * 1024 + col0 + bj * HALF) = pack8(acc[1][bj][3][0], acc[1][bj][3][1]);
        }
    }
};

struct EpiQ {
    static constexpr bool PERM = true, AFTER_DRAIN = false, ORDERS = true;
    bf16_t* Q; const float* ssq_q;
    __device__ __forceinline__ void operator()(const Acc& acc, const Unit& u, int wr, int wc, int fr, int fq) const {
        const int rowb = u.pm * BM + wr * 64 + fr, col0 = u.pn * BM + wc * 32 + 8 * fq;
#pragma unroll
        for (int ai = 0; ai < 2; ++ai)
#pragma unroll
            for (int m = 0; m < 4; ++m) {
                const int row = rowb + ai * HALF + m * 16; const float rs = ssq_q[row];
#pragma unroll
                for (int bj = 0; bj < 2; ++bj) *(u32x4*)(Q + (size_t)row * 1536 + col0 + bj * HALF) = pack8(acc[ai][bj][m][0] * rs, acc[ai][bj][m][1] * rs);
            }
    }
};

extern __shared__ __attribute__((aligned(16))) unsigned char kv_lds_raw[];
__device__ __forceinline__ LAS unsigned char* kv_stage_lds() { return (LAS unsigned char*)kv_lds_raw + RING_BYTES; }
struct EpiNull {
    static constexpr bool PERM = true, AFTER_DRAIN = false, ORDERS = false;
    __device__ __forceinline__ void operator()(const Acc& acc, const Unit& u, int wr, int wc, int fr, int fq) const {
#pragma unroll
        for (int a = 0; a < 2; ++a)
#pragma unroll
            for (int b = 0; b < 2; ++b)
#pragma unroll
                for (int m = 0; m < 4; ++m)
#pragma unroll
                    for (int n = 0; n < 2; ++n) asm volatile("" :: "v"(acc[a][b][m][n]));
    }
};
#ifndef MK_KVCLOB
#define MK_KVCLOB 1
#endif
struct EpiKV {
    static constexpr bool PERM = true, AFTER_DRAIN = false, ORDERS = true;
    unsigned char* KIMG; unsigned char* VIMG; const float* ssq_kv; const float* kssq; const float* KPER; const float* kg;
    __device__ __forceinline__ void operator()(const Acc& acc, const Unit& u, int wr, int wc, int fr, int fq) const {
        asm volatile("" : "+v"(fr), "+v"(fq));
        const int rowb = u.pm * BM + wr * 64 + fr, h = 2 * u.pn + (wc & 1);
        if (wc < 2) {
            f32x4 g[2][2];
#pragma unroll
            for (int bj = 0; bj < 2; ++bj)
#pragma unroll
                for (int n = 0; n < 2; ++n) g[bj][n] = *(const f32x4*)(kg + 32 * bj + 8 * fq + 4 * n);
#pragma unroll
            for (int am = 0; am < 8; ++am) { const int ai = am >> 2;
                f32x4 kr[4][2];
#pragma unroll
                for (int m = (am & 3); m < (am & 3) + 1; ++m) { const float* kp_ = KPER + (size_t)(rowb + ai * HALF + m * 16) * 32 + 8 * fq; kr[m][0] = *(const f32x4*)kp_; kr[m][1] = *(const f32x4*)(kp_ + 4); }
#pragma unroll
                for (int m = (am & 3); m < (am & 3) + 1; ++m) {
                    const int row = rowb + ai * HALF + m * 16; const float rs = ssq_kv[row], ksq = kssq[row];
                    f32x4 v[2][2]; float ss = 0.f;
#pragma unroll
                    for (int bj = 0; bj < 2; ++bj)
#pragma unroll
                        for (int n = 0; n < 2; ++n) { v[bj][n] = acc[ai][bj][m][n] * rs; ss += dot4(v[bj][n]); }
                    ss += __shfl_xor(ss, 16); ss += __shfl_xor(ss, 32);
                    const float rk = rsqrtf((ss + ksq) * (1.f / 96.f) + EPS);
#if MK_FP8K
                    unsigned char* img = KIMG + ((size_t)h * 256 + (row >> 6)) * 8192;
#pragma unroll
                    for (int bj = 0; bj < 2; ++bj) { const f32x4 x0 = v[bj][0] * g[bj][0] * rk, x1 = v[bj][1] * g[bj][1] * rk; u32x2 w;
                        int w0 = __builtin_amdgcn_cvt_pk_fp8_f32(x0[0], x0[1], 0, false); w0 = __builtin_amdgcn_cvt_pk_fp8_f32(x0[2], x0[3], w0, true);
                        int w1 = __builtin_amdgcn_cvt_pk_fp8_f32(x1[0], x1[1], 0, false); w1 = __builtin_amdgcn_cvt_pk_fp8_f32(x1[2], x1[3], w1, true);
                        w.x = (unsigned)w0; w.y = (unsigned)w1;
                        *(u32x2*)(img + ((row & 63) >> 5) * 2048 + bj * 1024 + (fq >> 1) * 512 + (row & 31) * 16 + 8 * (fq & 1)) = w; }
                    *(u32x4*)(img + 4096 + fq * 1024 + (row & 63) * 16) = pack8(kr[m][0] * rk, kr[m][1] * rk);
#else
                    unsigned char* img = KIMG + ((size_t)h * 256 + (row >> 6)) * 12288 + (row & 63) * 16;
#pragma unroll
                    for (int bj = 0; bj < 2; ++bj) *(u32x4*)(img + (4 * bj + fq) * 1024) = pack8(v[bj][0] * g[bj][0] * rk, v[bj][1] * g[bj][1] * rk);
                    *(u32x4*)(img + (8 + fq) * 1024) = pack8(kr[m][0] * rk, kr[m][1] * rk);
#endif
                }
                if (MK_KVCLOB && (am & 3) == 3) asm volatile("" ::: "memory");
            }
        } else {
#if MK_FP8V
            LAS unsigned char* stg = (LAS unsigned char*)kv_stage_lds() + (wr * 2 + (wc - 2)) * 4096;
#pragma unroll
            for (int ai = 0; ai < 2; ++ai) {
#pragma unroll
                for (int m = 0; m < 4; ++m) {
                    const int row = rowb + ai * HALF + m * 16; const float rs = ssq_kv[row]; const int key = row & 63, kk = key & 31;
                    LAS unsigned char* img = stg + ((kk >> 2) & 1) * 1024 + (key >> 5) * 512 + ((kk & 3) + 4 * (kk >> 3)) + fq * 128;
#pragma unroll
                    for (int bj = 0; bj < 2; ++bj) { const f32x4 v0 = acc[ai][bj][m][0] * rs, v1 = acc[ai][bj][m][1] * rs;
                        unsigned w0 = (unsigned)__builtin_amdgcn_cvt_pk_fp8_f32(v0[0], v0[1], 0, false); w0 = (unsigned)__builtin_amdgcn_cvt_pk_fp8_f32(v0[2], v0[3], (int)w0, true);
                        unsigned w1 = (unsigned)__builtin_amdgcn_cvt_pk_fp8_f32(v1[0], v1[1], 0, false); w1 = (unsigned)__builtin_amdgcn_cvt_pk_fp8_f32(v1[2], v1[3], (int)w1, true);
                        LAS unsigned char* p = img + bj * 2048;
                        p[0] = (unsigned char)w0; p[16] = (unsigned char)(w0 >> 8); p[32] = (unsigned char)(w0 >> 16); p[48] = (unsigned char)(w0 >> 24);
                        p[64] = (unsigned char)w1; p[80] = (unsigned char)(w1 >> 8); p[96] = (unsigned char)(w1 >> 16); p[112] = (unsigned char)(w1 >> 24); }
                }
                LDS_WAIT();
                unsigned char* tile = VIMG + ((size_t)h * 256 + ((u.pm * BM + wr * 64 + ai * HALF) >> 6)) * 4096; const int ln = fr + 16 * fq;
#pragma unroll
                for (int i = 0; i < 4; ++i) *(u32x4*)(tile + i * 1024 + ln * 16) = *(const LAS u32x4*)(stg + i * 1024 + ln * 16);
            }
#else
#pragma unroll
            for (int ai = 0; ai < 2; ++ai)
#pragma unroll
                for (int m = 0; m < 4; ++m) {
                    const int row = rowb + ai * HALF + m * 16; const float rs = ssq_kv[row]; const int key = row & 63;
                    unsigned char* img = VIMG + ((size_t)h * 256 + (row >> 6)) * 8192 + (key >> 4) * 1024 + (key & 15) * 64 + fq * 16;
#pragma unroll
                    for (int bj = 0; bj < 2; ++bj) *(u32x4*)(img + bj * 4096) = pack8(acc[ai][bj][m][0] * rs, acc[ai][bj][m][1] * rs);
                }
#endif
        }
    }
};

template <bool DRY> struct EpiLruT {
    static constexpr bool PERM = false, AFTER_DRAIN = true, ORDERS = false;
    const bf16_t* XA; const float *ba, *bx, *lam; bf16_t* GRio; bf16_t* GAio; float* HEND; float* AEND;
    __device__ __forceinline__ void fused(Acc& acc, const Unit& u, int wr, int wc, int fr, int fq, LAS unsigned char* lds, int wid, int lane) const {
        int tid = threadIdx.x; asm volatile("" : "+v"(tid));
        const int chb = 256 * (u.pn >> 1) + 128 * (u.pn & 1);
        LAS unsigned* S = (LAS unsigned*)lds;
        {
            f32x4 vba[2], vbx[2], vsp[2];
#pragma unroll
            for (int n = 0; n < 2; ++n) { const int c = chb + 32 * wc + 16 * n + 4 * fq; vba[n] = *(const f32x4*)(ba + c); vbx[n] = *(const f32x4*)(bx + c); const f32x4 l4 = *(const f32x4*)(lam + c);
#pragma unroll
                for (int e = 0; e < 4; ++e) vsp[n][e] = -8.f * LOG2E * log1pf(expf(-l4[e])); }
#pragma unroll
            for (int am = 0; am < 4; ++am) { const int ai = am >> 1;
                u32x2 xw[4][2];
#pragma unroll
                for (int m = 2 * (am & 1); m < 2 * (am & 1) + 2; ++m)
#pragma unroll
                    for (int n = 0; n < 2; ++n) xw[m][n] = *(const u32x2*)((const char*)XA + (unsigned)((((unsigned)(u.pm * BM + ai * HALF + wr * 64 + m * 16 + fr)) * 1024u + (unsigned)(chb + 32 * wc + 16 * n + 4 * fq)) * 2u));
#pragma unroll
                for (int m = 2 * (am & 1); m < 2 * (am & 1) + 2; ++m) {
                    const int r = ai * HALF + wr * 64 + m * 16 + fr;
#pragma unroll
                    for (int n = 0; n < 2; ++n) {
                        const int x0 = 32 * wc + 16 * n + 4 * fq;
                        const float xa[4] = {lo2f(xw[m][n].x), hi2f(xw[m][n].x), lo2f(xw[m][n].y), hi2f(xw[m][n].y)}; u32x4 o;
#pragma unroll
                        for (int e = 0; e < 4; ++e) {
                            const float rr = fsigm(acc[ai][0][m][n][e] + vba[n][e]), ii = fsigm(acc[ai][1][m][n][e] + vbx[n][e]);
                            const float la2 = rr * vsp[n][e]; const float a2 = fexp2(2.f * la2); const float mult = sqrtf(fmaxf(1.f - a2, 0.f));
                            o[e] = pk2(mult * ii * xa[e], la2);
                        }
                        *(LAS u32x4*)(S + r * 132 + x0) = o;
                    }
                }
                asm volatile("" ::: "memory");
            }
        }
        const int cp = tid & 63, sg = tid >> 6, c0 = 2 * cp; LAS f32x4* X = (LAS f32x4*)(lds + LDS_XCH);
        const unsigned gb32 = ((unsigned)(u.pm * BM) * 1024u + (unsigned)(chb + c0)) * 2u;
        asm volatile("" ::: "memory");
        unsigned gr[32], ga[32];
#pragma unroll
        for (int j = 0; j < 32; ++j) { const unsigned ob = gb32 + (unsigned)(sg * 32 + j) * 2048u; gr[j] = *(const unsigned*)((const char*)GRio + ob); ga[j] = *(const unsigned*)((const char*)GAio + ob); }
        LDS_WAIT(); __builtin_amdgcn_s_barrier(); asm volatile("" ::: "memory");
        float h0 = 0.f, h1 = 0.f, s0 = 0.f, s1 = 0.f;
#pragma unroll 8
        for (int j = 0; j < 32; ++j) { const int r = sg * 32 + j; const u32x2 w = *(const LAS u32x2*)(S + r * 132 + c0);
            const float l0 = hi2f(w.x), l1 = hi2f(w.y); h0 = fexp2(l0) * h0 + lo2f(w.x); h1 = fexp2(l1) * h1 + lo2f(w.y); s0 += l0; s1 += l1; }
        X[sg * 64 + cp] = (f32x4){h0, s0, h1, s1};
        LDS_WAIT(); __builtin_amdgcn_s_barrier(); asm volatile("" ::: "memory");
        h0 = 0.f; h1 = 0.f; s0 = 0.f; s1 = 0.f;
        for (int q = 0; q < sg; ++q) { const f32x4 x = X[q * 64 + cp]; h0 = fexp2(x[1]) * h0 + x[0]; s0 += x[1]; h1 = fexp2(x[3]) * h1 + x[2]; s1 += x[3]; }
#pragma unroll
        for (int j = 0; j < 32; ++j) { const int r = sg * 32 + j; const u32x2 w = *(const LAS u32x2*)(S + r * 132 + c0);
            const float l0 = hi2f(w.x), l1 = hi2f(w.y); h0 = fexp2(l0) * h0 + lo2f(w.x); h1 = fexp2(l1) * h1 + lo2f(w.y); s0 += l0; s1 += l1;
            const unsigned ob = gb32 + (unsigned)r * 2048u;
            const float g0 = lo2f(gr[j]) * lo2f(ga[j]), g1 = hi2f(gr[j]) * hi2f(ga[j]);
            const unsigned o1_ = pk2(h0 * g0, h1 * g1), o2_ = pk2(fexp2(s0) * g0, fexp2(s1) * g1); if (DRY) asm volatile("" :: "v"(o1_), "v"(o2_)); else { *(unsigned*)((char*)GRio + ob) = o1_; *(unsigned*)((char*)GAio + ob) = o2_; }
            if ((j & 3) == 3) asm volatile("" ::: "memory"); }
        if (sg == 7 && !DRY) { *(f32x2*)(HEND + (size_t)u.pm * 1024 + chb + c0) = (f32x2){h0, h1}; *(f32x2*)(AEND + (size_t)u.pm * 1024 + chb + c0) = (f32x2){fexp2(s0), fexp2(s1)}; }
        LDS_WAIT(); __builtin_amdgcn_s_barrier(); asm volatile("" ::: "memory");
    }
};

struct EpiWout {
    static constexpr bool PERM = true, AFTER_DRAIN = false, ORDERS = true;
    const float* x; float* out; bf16_t* HB; float* ssq_h;
    __device__ __forceinline__ void operator()(const Acc& acc, const Unit& u, int wr, int wc, int fr, int fq) const {
        const int rowb = u.pm * BM + wr * 64 + fr, col0 = u.pn * BM + wc * 32 + 8 * fq;
#pragma unroll
        for (int ai = 0; ai < 2; ++ai)
#pragma unroll
            for (int m = 0; m < 4; ++m) {
                const int row = rowb + ai * HALF + m * 16; float ss = 0.f;
#pragma unroll
                for (int bj = 0; bj < 2; ++bj) { const size_t o = (size_t)row * 1024 + col0 + bj * HALF;
                    const f32x4 h0 = *(const f32x4*)(x + o) + acc[ai][bj][m][0], h1 = *(const f32x4*)(x + o + 4) + acc[ai][bj][m][1];
                    ss += dot4(h0) + dot4(h1); *(f32x4*)(out + o) = h0; *(f32x4*)(out + o + 4) = h1;
                    { u32x2 w8; int w_ = __builtin_amdgcn_cvt_pk_fp8_f32(h0[0], h0[1], 0, false); w8.x = (unsigned)__builtin_amdgcn_cvt_pk_fp8_f32(h0[2], h0[3], w_, true); w_ = __builtin_amdgcn_cvt_pk_fp8_f32(h1[0], h1[1], 0, false); w8.y = (unsigned)__builtin_amdgcn_cvt_pk_fp8_f32(h1[2], h1[3], w_, true);
                      *(u32x2*)((unsigned char*)HB + o) = w8; } }
                ss += __shfl_xor(ss, 16); ss += __shfl_xor(ss, 32); if (fq == 0) ssq_h[(size_t)row * 16 + u.pn * 4 + wc] = ss;
            }
    }
};

struct EpiMoeGU {
    static constexpr bool PERM = false, AFTER_DRAIN = false, ORDERS = true;
    bf16_t* HID; const float* ssq_h; const int* lists;
    __device__ __forceinline__ void operator()(const Acc& acc, const Unit& u, int wr, int wc, int fr, int fq) const {
        const int rb = wr * 64 + fr; float rsv[2][4];
#pragma unroll
        for (int ai = 0; ai < 2; ++ai)
#pragma unroll
            for (int m = 0; m < 4; ++m) { const int r = rb + ai * HALF + m * 16; const int rc = r < u.valid ? r : u.valid - 1; rsv[ai][m] = ssq_h[lists[(size_t)u.x0 * M + u.x1 * 256 + rc]]; }
        asm volatile("" :: "v"(rsv[0][0]));
#pragma unroll
        for (int ai = 0; ai < 2; ++ai)
#pragma unroll
            for (int m = 0; m < 4; ++m) {
                const int r = rb + ai * HALF + m * 16;
                if (r < u.valid) {
                    const float rs = rsv[ai][m];
#pragma unroll
                    for (int n = 0; n < 2; ++n) { f32x4 g = acc[ai][0][m][n] * rs, up = acc[ai][1][m][n] * rs, hb;
#pragma unroll
                        for (int e = 0; e < 4; ++e) hb[e] = g[e] * fsigm(g[e]) * up[e];
                        int w_ = __builtin_amdgcn_cvt_pk_fp8_f32(hb[0], hb[1], 0, false); w_ = __builtin_amdgcn_cvt_pk_fp8_f32(hb[2], hb[3], w_, true);
                        *(unsigned*)((char*)HID + (unsigned)(((unsigned)u.pm * 256u + (unsigned)r) * 256u + 128u * (unsigned)u.pn + 32u * (unsigned)wc + 16u * (unsigned)n + 4u * (unsigned)fq)) = (unsigned)w_; }
                }
            }
    }
};
template <int VAR> struct EpiMoeDownT {
    static constexpr bool PERM = true, AFTER_DRAIN = false, ORDERS = (VAR == 0);
    bf16_t* Y; const float* cwl;
    __device__ __forceinline__ void operator()(const Acc& acc, const Unit& u, int wr, int wc, int fr, int fq) const {
        asm volatile("" : "+v"(fr), "+v"(fq));
        const int rb = wr * 64 + fr, col0 = u.pn * BM + wc * 32 + 8 * fq;
#pragma unroll
        for (int ai = 0; ai < 2; ++ai) {
            float cwv[4];
#pragma unroll
            for (int m = 0; m < 4; ++m) { const int r = rb + ai * HALF + m * 16; const int rc = r < u.valid ? r : u.valid - 1; cwv[m] = (VAR == 2) ? 1.f : cwl[(size_t)u.x0 * M + u.x1 * 256 + rc] * 8.f; }
            if (ai == 0) asm volatile("" :: "v"(cwv[0]));
#pragma unroll
            for (int m = 0; m < 4; ++m) {
                const int r = rb + ai * HALF + m * 16;
                if (r < u.valid) { const float cw = cwv[m];
#pragma unroll
                    for (int bj = 0; bj < 2; ++bj) { const f32x4 y0 = acc[ai][bj][m][0] * cw, y1 = acc[ai][bj][m][1] * cw; u32x2 w8;
                        int w_ = __builtin_amdgcn_cvt_pk_fp8_f32(y0[0], y0[1], 0, false); w8.x = (unsigned)__builtin_amdgcn_cvt_pk_fp8_f32(y0[2], y0[3], w_, true);
                        w_ = __builtin_amdgcn_cvt_pk_fp8_f32(y1[0], y1[1], 0, false); w8.y = (unsigned)__builtin_amdgcn_cvt_pk_fp8_f32(y1[2], y1[3], w_, true);
                        if (VAR == 1) asm volatile("" :: "v"(w8)); else *(u32x2*)((char*)Y + (unsigned)(((unsigned)u.pm * 256u + (unsigned)r) * 1024u + (unsigned)(col0 + bj * HALF))) = w8; } }
            }
            asm volatile("" ::: "memory");
        }
    }
};
typedef EpiMoeDownT<0> EpiMoeDown;
#define LANE_NOW() ({ int t__ = threadIdx.x; asm volatile("" : "+v"(t__)); t__ & 63; })
struct Frame {
    LAS unsigned char* lds; volatile LAS unsigned* MISC; gu32* ctl;
    int tid, lane, wave, vcu, G;
    void* const* in_dummy;
};
struct Args { const void* in[26]; float* out; unsigned char* ws; int ph_lo, ph_hi; };
typedef const __attribute__((address_space(4))) Args& CArgs;

__device__ __forceinline__ int crow(int r, int hi) { return (r & 3) + 8 * (r >> 2) + 4 * hi; }
__device__ __forceinline__ void tr_item(const float* W, int ldn, int ns0, bf16_t* WT, int K, int nd0, int k0, const float* kscale, LAS float* scr, int lane, int ncols = 64, int nwrite = 64, float f8mul = 0.f) {
    const int c4 = (lane & 15) * 4, kr = lane >> 4;
    f32x4 v[16];
#pragma unroll
    for (int i = 0; i < 16; ++i) { const int kk = 4 * i + kr; v[i] = (c4 < ncols) ? *(const f32x4*)(W + (size_t)(k0 + kk) * ldn + ns0 + c4) : (f32x4){0.f, 0.f, 0.f, 0.f}; }
#pragma unroll
    for (int i = 0; i < 16; ++i) { const int kk = 4 * i + kr; f32x4 x = v[i]; if (kscale) x = x * kscale[k0 + kk];
        LAS float* p = scr + kk * 65 + c4; p[0] = x[0]; p[1] = x[1]; p[2] = x[2]; p[3] = x[3]; }
    LDS_WAIT(); asm volatile("" ::: "memory");
    const int c = lane & 7;
#pragma unroll
    for (int j = 0; j < 8; ++j) { const int n = (lane >> 3) + 8 * j; if (n >= nwrite) break; const LAS float* sp = scr + (8 * c) * 65 + n;
        if (f8mul != 0.f) { u32x2 o8; int w_ = __builtin_amdgcn_cvt_pk_fp8_f32(sp[0 * 65] * f8mul, sp[1 * 65] * f8mul, 0, false); o8.x = (unsigned)__builtin_amdgcn_cvt_pk_fp8_f32(sp[2 * 65] * f8mul, sp[3 * 65] * f8mul, w_, true);
            w_ = __builtin_amdgcn_cvt_pk_fp8_f32(sp[4 * 65] * f8mul, sp[5 * 65] * f8mul, 0, false); o8.y = (unsigned)__builtin_amdgcn_cvt_pk_fp8_f32(sp[6 * 65] * f8mul, sp[7 * 65] * f8mul, w_, true);
            *(u32x2*)((unsigned char*)WT + (size_t)(nd0 + n) * K + k0 + 8 * c) = o8; continue; }
        u32x4 o; o.x = pk2(sp[0 * 65], sp[1 * 65]); o.y = pk2(sp[2 * 65], sp[3 * 65]); o.z = pk2(sp[4 * 65], sp[5 * 65]); o.w = pk2(sp[6 * 65], sp[7 * 65]);
        *(u32x4*)(WT + (size_t)(nd0 + n) * K + k0 + 8 * c) = o; }
    LDS_WAIT(); asm volatile("" ::: "memory");
}

__device__ __forceinline__ void p0_prologue(Frame& F, CArgs a) {
    LAS float* scr = (LAS float*)(F.lds + F.wave * 16640);
    const int gw = F.vcu * NWAVES + F.wave, NGW = F.G * NWAVES, lane = LANE_NOW();
    unsigned char* ws = a.ws;
    const float* w_in = (const float*)a.in[3];
    bf16_t* WIN = (bf16_t*)(ws + WS_WIN); bf16_t* WUQ = (bf16_t*)(ws + WS_WUQ); bf16_t* WUKV = (bf16_t*)(ws + WS_WUKV); bf16_t* WLRU = (bf16_t*)(ws + WS_WLRU); bf16_t* WOUT = (bf16_t*)(ws + WS_WOUT);
    constexpr int I_IN = 16 * 81, I_UQ = 12 * 24, I_UKV = 4 * 32, I_LRU = 4 * 32, I_OUT = 16 * 16, NITEMS = I_IN + I_UQ + I_UKV + I_LRU + I_OUT;
    for (int it = gw; it < NITEMS; it += NGW) {
        int r = it;
        if (r < I_IN) { const int kb = r / 81, nb = r % 81, nd0 = 64 * nb, k0 = 64 * kb;
            if (nd0 < 5120) tr_item(w_in, 5152, nd0 < 3072 ? nd0 : nd0 + 32, WIN, 1024, nd0, k0, nullptr, scr, lane);
            else tr_item(w_in, 5152, 3072, WIN, 1024, nd0, k0, nullptr, scr, lane, 32, 32);
            continue; }
        r -= I_IN;
        if (r < I_UQ) { const int kb = r / 24, nb = r % 24; tr_item((const float*)a.in[12], 1536, 64 * nb, WUQ, 768, 64 * nb, 64 * kb, (const float*)a.in[11], scr, lane, 64, 64, 32.f); continue; }
        r -= I_UQ;
        if (r < I_UKV) { const int kb = r / 32, nb = r % 32, nd0 = 64 * nb, pn = nd0 >> 8, bj = (nd0 >> 7) & 1, wcp = (nd0 >> 6) & 1;
#pragma unroll 1
            for (int hh = 0; hh < 2; ++hh) tr_item((const float*)a.in[14], 2048, (2 * pn + hh) * 128 + wcp * 64 + 32 * bj, WUKV, 256, nd0 + 32 * hh, 64 * kb, (const float*)a.in[13], scr, lane, 32, 32, 16.f);
            continue; }
        r -= I_UKV;
        if (r < I_LRU) { const int kb = r / 32, nb = r % 32, nd0 = 64 * nb, pn = nd0 >> 8, bj = (nd0 >> 7) & 1, xb = nd0 & 127, blk = pn >> 1;
            tr_item((const float*)a.in[bj ? 8 : 6] + (size_t)blk * 65536, 256, 128 * (pn & 1) + xb, WLRU, 256, nd0, 64 * kb, nullptr, scr, lane); continue; }
        r -= I_LRU;
        { const int kb = r / 16, nb = r % 16; tr_item((const float*)a.in[17], 1024, 64 * nb, WOUT, 1024, 64 * nb, 64 * kb, nullptr, scr, lane); }
    }
    const float* x = (const float*)a.in[0]; const float* gm = (const float*)a.in[2]; bf16_t* XN = (bf16_t*)(ws + WS_R1);
    f32x4 g4[4];
#pragma unroll
    for (int j = 0; j < 4; ++j) g4[j] = *(const f32x4*)(gm + 4 * lane + 256 * j);
    for (int m = gw; m < M; m += NGW) {
        const f32x4* xr = (const f32x4*)(x + (size_t)m * D) + lane; f32x4 v[4]; float s = 0.f;
#pragma unroll
        for (int j = 0; j < 4; ++j) { v[j] = xr[64 * j]; s += dot4(v[j]); }
        const float rstd = rsqrtf(wave_sum(s) * (1.f / 1024.f) + EPS);
        u32x2* o8 = (u32x2*)(XN + (size_t)m * D) + lane;
#pragma unroll
        for (int j = 0; j < 4; ++j) { const f32x4 y = v[j] * rstd * g4[j]; u32x2 w; w.x = pk2(y[0], y[1]); w.y = pk2(y[2], y[3]); o8[64 * j] = w; }
    }
    const int gt = F.vcu * NTHREADS + F.tid, NGT = F.G * NTHREADS;
    const int* pos = (const int*)a.in[1]; float* CS = (float*)(ws + WS_CS);
    for (int i = gt; i < M * 16; i += NGT) { const int t = i >> 4, j = i & 15; const float fr = powf(10000.f, -(float)j / 16.f); const float ang = (float)pos[t] * fr; CS[t * 32 + j] = cosf(ang); CS[t * 32 + 16 + j] = sinf(ang); }
    float* WR = (float*)(ws + WS_MISC + MISC_WR); const float* gf = (const float*)a.in[18]; const float* wg = (const float*)a.in[19]; const float* we = (const float*)a.in[21];
    for (int i = gt; i < 36 * 1024; i += NGT) { const int j = i >> 10, k = i & 1023; WR[i] = (j < 4 ? wg[k * 4 + j] : we[k * 32 + (j - 4)]) * gf[k]; }
}

__device__ __forceinline__ void moe_weight_convert(Frame& F, CArgs a, int part, int lo, int nblk) {
    LAS float* scr = (LAS float*)(F.lds + F.wave * 16640);
    const int gw = lo * NWAVES + F.wave, NGW = nblk * NWAVES, lane = LANE_NOW();
    bf16_t* WGU = (bf16_t*)(a.ws + WS_WGU); bf16_t* WDN = (bf16_t*)(a.ws + WS_WDN); const float* gf = (const float*)a.in[18];
    constexpr int I_GU = 32 * 16 * 8, I_DN = 32 * 4 * 16;
    for (int it = (part == 0 ? gw : I_GU + gw); it < (part == 0 ? I_GU : I_GU + I_DN); it += NGW) {
        if (it < I_GU) { const int e = it >> 7, r = it & 127, kb = r >> 3, nb = r & 7, nd0 = 64 * nb, pn = nd0 >> 8, bj = (nd0 >> 7) & 1, xb = nd0 & 127;
            tr_item((const float*)a.in[bj ? 24 : 23] + (size_t)e * 262144, 256, 128 * pn + xb, (bf16_t*)((unsigned char*)WGU + (size_t)e * 524288), 1024, nd0, 64 * kb, gf, scr, lane, 64, 64, 32.f); }
        else { const int r0 = it - I_GU, e = r0 >> 6, r = r0 & 63, kb = r >> 4, nb = r & 15;
            tr_item((const float*)a.in[25] + (size_t)e * 262144, 1024, 64 * nb, (bf16_t*)((unsigned char*)WDN + (size_t)e * 262144), 256, 64 * nb, 64 * kb, nullptr, scr, lane, 64, 64, 16.f); }
    }
}

template <bool DRY> __device__ __forceinline__ void p2a_conv(Frame& F, CArgs a) {
    unsigned char* ws = a.ws; bf16_t* XR = (bf16_t*)(ws + WS_XR); const bf16_t* HALO = (const bf16_t*)(ws + WS_MISC + MISC_HALO);
    const float* cw = (const float*)a.in[4]; const float* cb = (const float*)a.in[5];
    for (int b = F.vcu; b < 256; b += F.G) {
        const int pm = b >> 2, cg = b & 3, cp = F.tid & 127, sg = F.tid >> 7, c = cg * 256 + 2 * cp, base = pm * 256 + sg * 64;
        float h0[3], h1[3];
#pragma unroll
        for (int i = 0; i < 3; ++i) { unsigned w = 0u;
            if (sg == 0) { if (pm > 0) w = *(const unsigned*)(HALO + ((size_t)(pm - 1) * 3 + i) * 1024 + c); }
            else w = *(const unsigned*)(XR + (size_t)(base - 3 + i) * 1024 + c);
            h0[i] = lo2f(w); h1[i] = hi2f(w); }
        VM_WAIT(); __syncthreads();
        float w0[4], w1[4];
#pragma unroll
        for (int k = 0; k < 4; ++k) { w0[k] = cw[k * 1024 + c]; w1[k] = cw[k * 1024 + c + 1]; }
        const float b0 = cb[c], b1 = cb[c + 1];
        for (int j0 = 0; j0 < 64; j0 += 8) {
            unsigned xw[8];
#pragma unroll
            for (int j = 0; j < 8; ++j) xw[j] = *(const unsigned*)(XR + (size_t)(base + j0 + j) * 1024 + c);
#pragma unroll
            for (int j = 0; j < 8; ++j) { const float x0 = lo2f(xw[j]), x1 = hi2f(xw[j]);
                const float y0 = b0 + w0[0] * h0[0] + w0[1] * h0[1] + w0[2] * h0[2] + w0[3] * x0, y1 = b1 + w1[0] * h1[0] + w1[1] * h1[1] + w1[2] * h1[2] + w1[3] * x1;
                h0[0] = h0[1]; h0[1] = h0[2]; h0[2] = x0; h1[0] = h1[1]; h1[1] = h1[2]; h1[2] = x1;
                const unsigned yw_ = pk2(y0, y1); if (DRY) asm volatile("" :: "v"(yw_)); else *(unsigned*)(XR + (size_t)(base + j0 + j) * 1024 + c) = yw_; }
        }
        __syncthreads();
    }
    if (!DRY && F.wave < 4) {
        const float* PQ = (const float*)(ws + WS_SSQP); const float* PKV = (const float*)(ws + WS_SSQP + SSQP_KV); float* RQ = (float*)(ws + WS_CTL + CTL_SSQ_Q); float* RKV = (float*)(ws + WS_CTL + CTL_SSQ_KV);
        float* KPE = (float*)(ws + WS_KPE); const float* CS = (const float*)(ws + WS_CS); float* KSSQ = (float*)(ws + WS_MISC + MISC_KSSQ); const float* kg = (const float*)a.in[16];
        const bf16_t* XN = (const bf16_t*)(ws + WS_R1); const bf16_t* WK = (const bf16_t*)(ws + WS_WIN) + (size_t)5120 * 1024;
        const int lane = LANE_NOW(), r16 = lane & 15, q4 = lane >> 4; LAS float* kl = (LAS float*)(F.lds + F.wave * 4096);
        for (int rb = F.vcu * 4 + F.wave; rb < M / 16; rb += F.G * 4) {
            const bf16_t* ap = XN + (size_t)(rb * 16 + r16) * 1024 + 8 * q4; const bf16_t* bp0 = WK + (size_t)r16 * 1024 + 8 * q4; const bf16_t* bp1 = bp0 + 16 * 1024;
            f32x4 acc0 = {0.f, 0.f, 0.f, 0.f}, acc1 = acc0;
#pragma unroll 8
            for (int s32 = 0; s32 < 32; ++s32) { const bf16x8 av = *(const bf16x8*)(ap + 32 * s32), b0 = *(const bf16x8*)(bp0 + 32 * s32), b1 = *(const bf16x8*)(bp1 + 32 * s32);
                acc0 = __builtin_amdgcn_mfma_f32_16x16x32_bf16(av, b0, acc0, 0, 0, 0); acc1 = __builtin_amdgcn_mfma_f32_16x16x32_bf16(av, b1, acc1, 0, 0, 0); }
#pragma unroll
            for (int i2 = 0; i2 < 4; ++i2) { kl[(4 * q4 + i2) * 33 + r16] = acc0[i2]; kl[(4 * q4 + i2) * 33 + 16 + r16] = acc1[i2]; }
            LDS_WAIT();
            if (lane < 16) {
                const int row = rb * 16 + lane; float kp[32]; float ss = 0.f;
#pragma unroll
                for (int j2 = 0; j2 < 32; ++j2) { kp[j2] = kl[lane * 33 + j2]; ss += kp[j2] * kp[j2]; }
                KSSQ[row] = ss;
                { const f32x4 a0 = *(const f32x4*)(PQ + (size_t)row * 12), a1 = *(const f32x4*)(PQ + (size_t)row * 12 + 4), a2 = *(const f32x4*)(PQ + (size_t)row * 12 + 8), b0 = *(const f32x4*)(PKV + (size_t)row * 4);
                  const float sq = ((a0[0] + a0[1]) + (a0[2] + a0[3])) + ((a1[0] + a1[1]) + (a1[2] + a1[3])) + ((a2[0] + a2[1]) + (a2[2] + a2[3])), sk = (b0[0] + b0[1]) + (b0[2] + b0[3]);
                  RQ[row] = rsqrtf(sq * (1.f / 768.f) + EPS); RKV[row] = rsqrtf(sk * (1.f / 256.f) + EPS); }
#pragma unroll
                for (int i = 0; i < 4; ++i) { const f32x4 g1 = *(const f32x4*)(kg + 64 + 4 * i), g2 = *(const f32x4*)(kg + 80 + 4 * i), cs = *(const f32x4*)(CS + (size_t)row * 32 + 4 * i), sn = *(const f32x4*)(CS + (size_t)row * 32 + 16 + 4 * i);
                    f32x4 o1, o2;
#pragma unroll
                    for (int e = 0; e < 4; ++e) { const float k1 = kp[4 * i + e] * g1[e], k2 = kp[16 + 4 * i + e] * g2[e]; o1[e] = k1 * cs[e] - k2 * sn[e]; o2[e] = k1 * sn[e] + k2 * cs[e]; }
                    *(f32x4*)(KPE + (size_t)row * 32 + 4 * i) = o1; *(f32x4*)(KPE + (size_t)row * 32 + 16 + 4 * i) = o2; }
            }
            LDS_WAIT();
        }
    }
}

__device__ __forceinline__ void glds16(const void* gsrc, unsigned lds_dst) { unsigned keep;
    asm volatile("s_mov_b32 %0, m0\n\ts_mov_b32 m0, %2\n\ts_nop 0\n\tglobal_load_lds_dwordx4 %1, off\n\ts_mov_b32 m0, %0" : "=&s"(keep) : "v"(gsrc), "s"(lds_dst) : "memory"); }
__device__ __forceinline__ void glds16s(const void* sbase, unsigned voff, unsigned lds_dst) { unsigned keep;
    asm volatile("s_mov_b32 %0, m0\n\ts_mov_b32 m0, %3\n\ts_nop 0\n\tglobal_load_lds_dwordx4 %1, %2\n\ts_mov_b32 m0, %0" : "=&s"(keep) : "v"(voff), "s"(sbase), "s"(lds_dst) : "memory"); }
__device__ __forceinline__ void glds12(const void* gsrc, unsigned lds_dst) { unsigned keep;
    asm volatile("s_mov_b32 %0, m0\n\ts_mov_b32 m0, %2\n\ts_nop 0\n\tglobal_load_lds_dwordx3 %1, off\n\ts_mov_b32 m0, %0" : "=&s"(keep) : "v"(gsrc), "s"(lds_dst) : "memory"); }
#define AWAIT_BAR(N) asm volatile("s_waitcnt vmcnt(" #N ") lgkmcnt(0)\n\ts_barrier" ::: "memory")
constexpr int AT_K = 0, AT_V = 24576, AT_WS = 40960, AT_OST = 43008, AT_END = 75776;
constexpr float C2 = 0.10206207261596575f * 1.4426950408889634f;

__device__ __forceinline__ void attn_unit_v1(int h, int qb, CArgs a, const LAS float* carry, LAS unsigned char* shm) {
    const int tid = threadIdx.x, lane = tid & 63, r32 = lane & 31, hi = lane >> 5; const int wid = __builtin_amdgcn_readfirstlane(tid >> 6);
    unsigned char* ws = a.ws;
    const bf16_t* QRAW = (const bf16_t*)(ws + WS_R1); const unsigned char* KI = ws + WS_KIMG + (size_t)h * 256 * 12288; const unsigned char* VI = (const unsigned char*)a.out + 32 * MiB + (size_t)h * 256 * 8192;
    const float* CS = (const float*)(ws + WS_CS); const float* qg = (const float*)a.in[15];
    const int q0 = qb * 256, rowq = q0 + wid * 32 + r32;
    const unsigned lds0 = (unsigned)(uintptr_t)shm;
    LAS float* wsf = (LAS float*)(shm + AT_WS) + wid * 64;
    bf16x8 qr[6];
    {
        const bf16_t* qp = QRAW + (size_t)rowq * 1536 + h * 96 + hi * 8;
        u32x4 raw[6]; float qv[6][8]; float ss = 0.f;
#pragma unroll
        for (int d0 = 0; d0 < 6; ++d0) raw[d0] = *(const u32x4*)(qp + d0 * 16);
#pragma unroll
        for (int d0 = 0; d0 < 6; ++d0)
#pragma unroll
            for (int j = 0; j < 4; ++j) { qv[d0][2 * j] = lo2f(raw[d0][j]); qv[d0][2 * j + 1] = hi2f(raw[d0][j]); ss += qv[d0][2 * j] * qv[d0][2 * j] + qv[d0][2 * j + 1] * qv[d0][2 * j + 1]; }
        ss += __shfl_xor(ss, 32);
        const float rs = rsqrtf(ss * (1.f / 96.f) + EPS);
#pragma unroll
        for (int d0 = 0; d0 < 6; ++d0) { const f32x4 g0 = *(const f32x4*)(qg + d0 * 16 + hi * 8), g1 = *(const f32x4*)(qg + d0 * 16 + hi * 8 + 4);
#pragma unroll
            for (int j = 0; j < 4; ++j) { qv[d0][j] *= rs * g0[j]; qv[d0][4 + j] *= rs * g1[j]; } }
        const f32x4 c0 = *(const f32x4*)(CS + (size_t)rowq * 32 + hi * 8), c1 = *(const f32x4*)(CS + (size_t)rowq * 32 + hi * 8 + 4), s0 = *(const f32x4*)(CS + (size_t)rowq * 32 + 16 + hi * 8), s1 = *(const f32x4*)(CS + (size_t)rowq * 32 + 16 + hi * 8 + 4);
#pragma unroll
        for (int j = 0; j < 8; ++j) { const float cs = j < 4 ? c0[j & 3] : c1[j & 3], sn = j < 4 ? s0[j & 3] : s1[j & 3]; const float x1 = qv[4][j], x2 = qv[5][j]; qv[4][j] = x1 * cs - x2 * sn; qv[5][j] = x1 * sn + x2 * cs; }
#pragma unroll
        for (int d0 = 0; d0 < 6; ++d0) { u32x4 w;
#pragma unroll
            for (int j = 0; j < 4; ++j) w[j] = pk2(qv[d0][2 * j] * C2, qv[d0][2 * j + 1] * C2);
            qr[d0] = __builtin_bit_cast(bf16x8, w); }
    }
    const int NT = 4 * qb + 4, mylast = 4 * qb + (wid >> 1);
#define AT_DMA(t, buf) do { const unsigned char* kt_ = KI + (size_t)(t) * 12288 + wid * 1024 + lane * 16; const unsigned kd_ = lds0 + AT_K + (buf) * 12288 + wid * 1024; \
        glds16(kt_, (unsigned)__builtin_amdgcn_readfirstlane(kd_)); if (wid < 4) glds16(kt_ + 8192, (unsigned)__builtin_amdgcn_readfirstlane(kd_ + 8192)); \
        glds16(VI + (size_t)(t) * 8192 + wid * 1024 + lane * 16, (unsigned)__builtin_amdgcn_readfirstlane(lds0 + AT_V + (buf) * 8192 + wid * 1024)); } while (0)
#define AT_WAIT1() do { if (wid < 4) asm volatile("s_waitcnt vmcnt(3)" ::: "memory"); else asm volatile("s_waitcnt vmcnt(2)" ::: "memory"); asm volatile("s_waitcnt lgkmcnt(0)\n\ts_barrier" ::: "memory"); } while (0)
    float m_run = -1e30f, l_run = 0.f; f32x16 o[2]; o[0] = f32x16{}; o[1] = f32x16{};
    AT_DMA(0, 0);
    for (int t = 0; t < NT; ++t) {
        const int buf = t & 1;
        if (t + 1 < NT) { AT_DMA(t + 1, buf ^ 1); AT_WAIT1(); } else { AWAIT_BAR(0); }
        if (t <= mylast) {
            const LAS unsigned char* kb = shm + AT_K + buf * 12288 + hi * 1024 + r32 * 16;
            f32x16 p0 = f32x16{}, p1 = f32x16{};
#pragma unroll
            for (int d0 = 0; d0 < 6; ++d0) { const bf16x8 b0 = *(const LAS bf16x8*)(kb + d0 * 2048), b1 = *(const LAS bf16x8*)(kb + d0 * 2048 + 512);
                p0 = __builtin_amdgcn_mfma_f32_32x32x16_bf16(b0, qr[d0], p0, 0, 0, 0); p1 = __builtin_amdgcn_mfma_f32_32x32x16_bf16(b1, qr[d0], p1, 0, 0, 0); }
            float rm = fmaxf(p0[0], p1[0]);
#pragma unroll
            for (int r = 1; r < 16; ++r) rm = fmaxf(rm, fmaxf(p0[r], p1[r]));
            rm = fmaxf(rm, __shfl_xor(rm, 32));
            const float mn = fmaxf(m_run, rm), alpha = fexp2(m_run - mn); m_run = mn;
            float ps = 0.f;
#pragma unroll
            for (int r = 0; r < 16; ++r) { p0[r] = fexp2(p0[r] - mn); p1[r] = fexp2(p1[r] - mn); ps += p0[r] + p1[r]; }
            l_run = l_run * alpha + ps;
            if (__any(alpha != 1.f)) {
                if (hi == 0) wsf[r32] = alpha;
                LDS_WAIT();
#pragma unroll
                for (int r = 0; r < 16; ++r) { const float f = wsf[crow(r, hi)]; o[0][r] *= f; o[1][r] *= f; }
            }
            u32x4 pw[4];
#pragma unroll
            for (int j = 0; j < 4; ++j) { pw[0][j] = pk2(p0[2 * j], p0[2 * j + 1]); pw[1][j] = pk2(p0[8 + 2 * j], p0[8 + 2 * j + 1]); pw[2][j] = pk2(p1[2 * j], p1[2 * j + 1]); pw[3][j] = pk2(p1[8 + 2 * j], p1[8 + 2 * j + 1]); }
            const LAS unsigned char* vb = shm + AT_V + buf * 8192 + ((lane >> 4) & 1) * 32 + (lane & 3) * 8 + (4 * hi + ((lane & 15) >> 2)) * 64;
#pragma unroll
            for (int d0 = 0; d0 < 2; ++d0)
#pragma unroll
                for (int ks = 0; ks < 4; ++ks) {
                    typedef short v4i16_t __attribute__((ext_vector_type(4)));
                    const s16x4 lo = __builtin_bit_cast(s16x4, __builtin_amdgcn_ds_read_tr16_b64_v4i16((LAS v4i16_t*)(vb + d0 * 4096 + ks * 1024)));
                    const s16x4 hh = __builtin_bit_cast(s16x4, __builtin_amdgcn_ds_read_tr16_b64_v4i16((LAS v4i16_t*)(vb + d0 * 4096 + ks * 1024 + 512)));
                    const bf16x8 vf = (bf16x8){lo[0], lo[1], lo[2], lo[3], hh[0], hh[1], hh[2], hh[3]};
                    o[d0] = __builtin_amdgcn_mfma_f32_32x32x16_bf16(__builtin_bit_cast(bf16x8, pw[ks]), vf, o[d0], 0, 0, 0);
                }
        }
        asm volatile("s_waitcnt lgkmcnt(0)\n\ts_barrier" ::: "memory");
    }
#undef AT_DMA
#undef AT_WAIT1
    l_run += __shfl_xor(l_run, 32);
    if (hi == 0) wsf[32 + r32] = l_run;
    LDS_WAIT();
    LAS bf16_t* stg = (LAS bf16_t*)(shm + AT_OST) + wid * 2048;
#pragma unroll
    for (int r = 0; r < 16; ++r) { const int orow = crow(r, hi); const float il = frcp(wsf[32 + orow]);
#pragma unroll
        for (int d0 = 0; d0 < 2; ++d0) stg[orow * 64 + d0 * 32 + r32] = (bf16_t)f2bf(o[d0][r] * il); }
    LDS_WAIT();
    const bf16_t* GB = (const bf16_t*)a.out; const bf16_t* HL = (const bf16_t*)(ws + WS_GR); const bf16_t* AC = (const bf16_t*)(ws + WS_GA); bf16_t* MG = (bf16_t*)(ws + WS_XR);
#pragma unroll
    for (int i = 0; i < 4; ++i) { const int row = i * 8 + (lane >> 3), ch = lane & 7; const u32x4 yv = *(const LAS u32x4*)(stg + row * 64 + ch * 8);
        const size_t go = (size_t)(q0 + wid * 32 + row) * 1024 + h * 64 + ch * 8;
        const u32x4 gb = *(const u32x4*)(GB + go), hl = *(const u32x4*)(HL + go), ac = *(const u32x4*)(AC + go); u32x4 w;
#pragma unroll
        for (int j = 0; j < 4; ++j) { const float c0 = carry[ch * 8 + 2 * j], c1 = carry[ch * 8 + 2 * j + 1];
            w[j] = pk2(lo2f(yv[j]) * lo2f(gb[j]) + lo2f(hl[j]) + lo2f(ac[j]) * c0, hi2f(yv[j]) * hi2f(gb[j]) + hi2f(hl[j]) + hi2f(ac[j]) * c1); }
        *(u32x4*)(MG + go) = w; }
    asm volatile("s_waitcnt lgkmcnt(0)\n\ts_barrier" ::: "memory");
}


constexpr int A2_K = 0, A2_V = 36864, A2_WS = 61440, A2_OST = 63488;
#define A2_MF(a_, b_, c_) __builtin_amdgcn_mfma_f32_32x32x16_bf16(a_, b_, c_, 0, 0, 0)
#define A2_SB() __builtin_amdgcn_sched_barrier(0)
#define A2_PIN(x) asm volatile("" : "+v"(x))
#define A2_KF(d0, blk) ((ABL == 5) ? qr[(d0)] : *(const LAS bf16x8*)(kp + (d0) * 2048 + (blk) * 512))
typedef short v4i16_t __attribute__((ext_vector_type(4)));
#define A2_VT(off) __builtin_bit_cast(s16x4, __builtin_amdgcn_ds_read_tr16_b64_v4i16((LAS v4i16_t*)(vp + (off))))
#define A2_VJ(lo_, hi_, j) do { if (ABL == 5) { lo_ = (s16x4){qr[0][0], qr[0][1], qr[1][2], qr[1][3]}; hi_ = (s16x4){qr[2][0], qr[2][1], qr[3][2], qr[3][3]}; } else { lo_ = A2_VT(((j) & 1) * 4096 + ((j) >> 1) * 1024); hi_ = A2_VT(((j) & 1) * 4096 + ((j) >> 1) * 1024 + 512); } } while (0)
#define A2_VF(lo_, hi_) ((bf16x8){lo_[0], lo_[1], lo_[2], lo_[3], hi_[0], hi_[1], hi_[2], hi_[3]})
#define A2_EX(x) ((ABL == 2) ? (x) : fexp2(x))
#define A2_E3(P, b) do { P[b] = A2_EX(P[b]); P[(b) + 1] = A2_EX(P[(b) + 1]); P[(b) + 2] = A2_EX(P[(b) + 2]); } while (0)
#define A2_E2(P, b) do { P[b] = A2_EX(P[b]); P[(b) + 1] = A2_EX(P[(b) + 1]); } while (0)
#define A2_PK2(W, j, P, b) do { W[j] = pk2(P[b], P[(b) + 1]); W[(j) + 1] = pk2(P[(b) + 2], P[(b) + 3]); } while (0)
#define A2_S4(P, b) do { if (ABL != 2) { sacc += P[b]; sacc += P[(b) + 1]; sacc += P[(b) + 2]; sacc += P[(b) + 3]; } } while (0)

template <int ABL> __device__ __forceinline__ void attn_unit_v2(int h, int qb, CArgs a, const LAS float* carry, LAS unsigned char* shm) {
    const int tid = threadIdx.x, lane = tid & 63, r32 = lane & 31, hi = lane >> 5; const int wid = __builtin_amdgcn_readfirstlane(tid >> 6);
    unsigned char* ws = a.ws;
    const bf16_t* QRAW = (const bf16_t*)(ws + WS_R1); const unsigned char* KI = ws + WS_KIMG + (size_t)h * 256 * 12288; const unsigned char* VI = (const unsigned char*)a.out + 32 * MiB + (size_t)h * 256 * 8192;
    const float* CS = (const float*)(ws + WS_CS); const float* qg = (const float*)a.in[15];
    const int q0 = qb * 256, rowq = q0 + wid * 32 + r32;
    const unsigned lds0 = (unsigned)(uintptr_t)shm;
    LAS float* wsf = (LAS float*)(shm + A2_WS) + wid * 64;
    const int NT = 4 * qb + 4, mylast = 4 * qb + (wid >> 1);
    const unsigned char* ksrc = KI + wid * 1024 + lane * 16; const unsigned char* vsrc = VI + wid * 1024 + lane * 16;
    const unsigned kdst = lds0 + A2_K + wid * 1024, vdst = lds0 + A2_V + wid * 1024;
#define A2_DMAK(t, slot) do { if (ABL == 3) break; glds16(ksrc + (size_t)(t) * 12288, (unsigned)__builtin_amdgcn_readfirstlane(kdst + (slot) * 12288)); \
        if (wid < 4) glds16(ksrc + (size_t)(t) * 12288 + 8192, (unsigned)__builtin_amdgcn_readfirstlane(kdst + (slot) * 12288 + 8192)); } while (0)
#define A2_DMAV(t, slot) do { if (ABL != 3) glds16(vsrc + (size_t)(t) * 8192, (unsigned)__builtin_amdgcn_readfirstlane(vdst + (slot) * 8192)); } while (0)
#define A2_WAITFULL() do { if (wid < 4) asm volatile("s_waitcnt vmcnt(3)" ::: "memory"); else asm volatile("s_waitcnt vmcnt(2)" ::: "memory"); } while (0)
#define A2_BAR() do { if (ABL == 1) asm volatile("s_waitcnt lgkmcnt(0)" ::: "memory"); else asm volatile("s_waitcnt lgkmcnt(0)\n\ts_barrier" ::: "memory"); } while (0)
    bf16x8 qr[6];
    {
        const bf16_t* qp = QRAW + (size_t)rowq * 1536 + h * 96 + hi * 8;
        u32x4 raw[6]; float qv[6][8]; float ss = 0.f;
#pragma unroll
        for (int d0 = 0; d0 < 6; ++d0) raw[d0] = *(const u32x4*)(qp + d0 * 16);
        A2_DMAK(0, 0); A2_DMAV(0, 0); A2_DMAK(1, 1); A2_DMAV(1, 1); A2_DMAK(2, 2);
#pragma unroll
        for (int d0 = 0; d0 < 6; ++d0)
#pragma unroll
            for (int j = 0; j < 4; ++j) { qv[d0][2 * j] = lo2f(raw[d0][j]); qv[d0][2 * j + 1] = hi2f(raw[d0][j]); ss += qv[d0][2 * j] * qv[d0][2 * j] + qv[d0][2 * j + 1] * qv[d0][2 * j + 1]; }
        ss += __shfl_xor(ss, 32);
        const float rs = rsqrtf(ss * (1.f / 96.f) + EPS);
#pragma unroll
        for (int d0 = 0; d0 < 6; ++d0) { const f32x4 g0 = *(const f32x4*)(qg + d0 * 16 + hi * 8), g1 = *(const f32x4*)(qg + d0 * 16 + hi * 8 + 4);
#pragma unroll
            for (int j = 0; j < 4; ++j) { qv[d0][j] *= rs * g0[j]; qv[d0][4 + j] *= rs * g1[j]; } }
        const f32x4 c0 = *(const f32x4*)(CS + (size_t)rowq * 32 + hi * 8), c1 = *(const f32x4*)(CS + (size_t)rowq * 32 + hi * 8 + 4), s0 = *(const f32x4*)(CS + (size_t)rowq * 32 + 16 + hi * 8), s1 = *(const f32x4*)(CS + (size_t)rowq * 32 + 16 + hi * 8 + 4);
#pragma unroll
        for (int j = 0; j < 8; ++j) { const float cs = j < 4 ? c0[j & 3] : c1[j & 3], sn = j < 4 ? s0[j & 3] : s1[j & 3]; const float x1 = qv[4][j], x2 = qv[5][j]; qv[4][j] = x1 * cs - x2 * sn; qv[5][j] = x1 * sn + x2 * cs; }
#pragma unroll
        for (int d0 = 0; d0 < 6; ++d0) { u32x4 w;
#pragma unroll
            for (int j = 0; j < 4; ++j) w[j] = pk2(qv[d0][2 * j] * C2, qv[d0][2 * j + 1] * C2);
            qr[d0] = __builtin_bit_cast(bf16x8, w); }
    }
    if (wid >= 4) __builtin_amdgcn_s_setprio(1);
    float lsum = 0.f; f32x16 o[2]; o[0] = f32x16{}; o[1] = f32x16{};
    f32x16 pA0, pA1, pB0, pB1;
    if (wid < 4) asm volatile("s_waitcnt vmcnt(6)" ::: "memory"); else asm volatile("s_waitcnt vmcnt(4)" ::: "memory");
    A2_BAR();
    {
        const LAS unsigned char* kp = shm + A2_K + hi * 1024 + r32 * 16;
        pA0 = f32x16{}; pA1 = f32x16{};
#pragma unroll
        for (int d0 = 0; d0 < 6; ++d0) { pA0 = A2_MF(A2_KF(d0, 0), qr[d0], pA0); pA1 = A2_MF(A2_KF(d0, 1), qr[d0], pA1); }
    }
    int sk_next = 12288, sv_cur = 0;
#define A2_STEP(C0, C1, N0, N1, t, HASN) do { \
        const LAS unsigned char* kp = shm + A2_K + sk_next + hi * 1024 + r32 * 16; const LAS unsigned char* vp = shm + A2_V + sv_cur + ((lane >> 4) & 1) * 32 + (lane & 3) * 8 + (4 * hi + ((lane & 15) >> 2)) * 64; \
        bf16x8 k0, k1, k2; s16x4 vl0, vh0, vl1, vh1, vl2, vh2; u32x4 w0, w1, w2, w3; float sacc = 0.f; \
        A2_SB(); \
        if (HASN) { k0 = A2_KF(0, 0); k1 = A2_KF(0, 1); k2 = A2_KF(1, 0); A2_SB(); \
            N0 = A2_MF(k0, qr[0], (f32x16{})); k0 = A2_KF(1, 1); A2_E3(C0, 0);  A2_PIN(C0); A2_SB(); \
            N1 = A2_MF(k1, qr[0], (f32x16{})); k1 = A2_KF(2, 0); A2_E3(C0, 3);  A2_PIN(C0); A2_SB(); \
            N0 = A2_MF(k2, qr[1], N0);         k2 = A2_KF(2, 1); A2_E3(C0, 6);  A2_PIN(C0); A2_SB(); \
            N1 = A2_MF(k0, qr[1], N1);         k0 = A2_KF(3, 0); A2_E3(C0, 9);  A2_PIN(C0); A2_SB(); \
            N0 = A2_MF(k1, qr[2], N0);         k1 = A2_KF(3, 1); A2_E3(C0, 12); A2_PIN(C0); A2_SB(); \
            N1 = A2_MF(k2, qr[2], N1);         k2 = A2_KF(4, 0); C0[15] = A2_EX(C0[15]); A2_E2(C1, 0); A2_PIN(C0); A2_PIN(C1); A2_SB(); \
            N0 = A2_MF(k0, qr[3], N0);         k0 = A2_KF(4, 1); A2_E3(C1, 2);  A2_PIN(C1); A2_SB(); \
            N1 = A2_MF(k1, qr[3], N1);         k1 = A2_KF(5, 0); A2_E3(C1, 5);  A2_PIN(C1); A2_SB(); \
            N0 = A2_MF(k2, qr[4], N0);         k2 = A2_KF(5, 1); A2_E2(C1, 8);  A2_PK2(w0, 0, C0, 0);  A2_PIN(C1); A2_PIN(w0); A2_SB(); \
            N1 = A2_MF(k0, qr[4], N1);                           A2_E2(C1, 10); A2_PK2(w0, 2, C0, 4);  A2_PIN(C1); A2_PIN(w0); A2_SB(); \
            N0 = A2_MF(k1, qr[5], N0);         A2_VJ(vl0, vh0, 0); A2_E2(C1, 12); A2_PK2(w1, 0, C0, 8);  A2_PIN(C1); A2_PIN(w1); A2_SB(); \
            N1 = A2_MF(k2, qr[5], N1);         A2_VJ(vl1, vh1, 1); A2_E2(C1, 14); A2_PK2(w1, 2, C0, 12); A2_PIN(C1); A2_PIN(w1); A2_SB(); \
        } else { \
            _Pragma("unroll") for (int r_ = 0; r_ < 16; ++r_) { C0[r_] = A2_EX(C0[r_]); C1[r_] = A2_EX(C1[r_]); } \
            A2_PK2(w0, 0, C0, 0); A2_PK2(w0, 2, C0, 4); A2_PK2(w1, 0, C0, 8); A2_PK2(w1, 2, C0, 12); A2_VJ(vl0, vh0, 0); A2_VJ(vl1, vh1, 1); A2_SB(); \
        } \
        if ((t) > mylast) { w0 = (u32x4){0u, 0u, 0u, 0u}; w1 = w0; C0 = f32x16{}; C1 = f32x16{}; } \
        o[0] = A2_MF(__builtin_bit_cast(bf16x8, w0), A2_VF(vl0, vh0), o[0]); A2_VJ(vl2, vh2, 2); A2_PK2(w2, 0, C1, 0);  A2_S4(C0, 0);  A2_PIN(w2); A2_PIN(sacc); A2_SB(); \
        o[1] = A2_MF(__builtin_bit_cast(bf16x8, w0), A2_VF(vl1, vh1), o[1]); A2_VJ(vl0, vh0, 3); A2_PK2(w2, 2, C1, 4);  A2_S4(C0, 4);  A2_PIN(w2); A2_PIN(sacc); A2_SB(); \
        o[0] = A2_MF(__builtin_bit_cast(bf16x8, w1), A2_VF(vl2, vh2), o[0]); A2_VJ(vl1, vh1, 4); A2_PK2(w3, 0, C1, 8);  A2_S4(C0, 8);  A2_PIN(w3); A2_PIN(sacc); A2_SB(); \
        o[1] = A2_MF(__builtin_bit_cast(bf16x8, w1), A2_VF(vl0, vh0), o[1]); A2_VJ(vl2, vh2, 5); A2_PK2(w3, 2, C1, 12); A2_S4(C0, 12); A2_PIN(w3); A2_PIN(sacc); A2_SB(); \
        o[0] = A2_MF(__builtin_bit_cast(bf16x8, w2), A2_VF(vl1, vh1), o[0]); A2_VJ(vl0, vh0, 6); A2_S4(C1, 0);  A2_PIN(sacc); A2_SB(); \
        o[1] = A2_MF(__builtin_bit_cast(bf16x8, w2), A2_VF(vl2, vh2), o[1]); A2_VJ(vl1, vh1, 7); A2_S4(C1, 4);  A2_PIN(sacc); A2_SB(); \
        o[0] = A2_MF(__builtin_bit_cast(bf16x8, w3), A2_VF(vl0, vh0), o[0]); A2_S4(C1, 8);  A2_PIN(sacc); A2_SB(); \
        o[1] = A2_MF(__builtin_bit_cast(bf16x8, w3), A2_VF(vl1, vh1), o[1]); A2_S4(C1, 12); A2_PIN(sacc); A2_SB(); \
        lsum += sacc; \
        sk_next = (sk_next == 24576) ? 0 : sk_next + 12288; sv_cur = (sv_cur == 16384) ? 0 : sv_cur + 8192; \
    } while (0)
#define A2_TOP(t) do { const int t_ = (t); if (t_ - 1 <= NT - 4) { A2_WAITFULL(); } else if (t_ - 1 == NT - 3) { asm volatile("s_waitcnt vmcnt(1)" ::: "memory"); } else { asm volatile("s_waitcnt vmcnt(0)" ::: "memory"); } \
        A2_BAR(); if (t_ + 3 < NT) { glds16(kg3, (unsigned)__builtin_amdgcn_readfirstlane(kdst + dk)); if (wid < 4) glds16(kg3 + 8192, (unsigned)__builtin_amdgcn_readfirstlane(kdst + dk + 8192)); } \
        if (t_ + 2 < NT) glds16(vg2, (unsigned)__builtin_amdgcn_readfirstlane(vdst + dv)); \
        kg3 += 12288; vg2 += 8192; dk = (dk == 24576u) ? 0u : dk + 12288u; dv = (dv == 16384u) ? 0u : dv + 8192u; } while (0)
    const unsigned char* kg3 = ksrc + 3 * 12288; const unsigned char* vg2 = vsrc + 2 * 8192; unsigned dk = 0u, dv = 16384u;
    int t = 0;
    for (; t + 2 < NT; t += 2) {
        A2_TOP(t);     A2_STEP(pA0, pA1, pB0, pB1, t, true);
        A2_TOP(t + 1); A2_STEP(pB0, pB1, pA0, pA1, t + 1, true);
    }
    A2_TOP(t);     A2_STEP(pA0, pA1, pB0, pB1, t, true);
    A2_TOP(t + 1); A2_STEP(pB0, pB1, pA0, pA1, t + 1, false);
#undef A2_STEP
#undef A2_TOP
    __builtin_amdgcn_s_setprio(0);
    lsum += __shfl_xor(lsum, 32);
    if (hi == 0) wsf[32 + r32] = lsum;
    LDS_WAIT();
    LAS bf16_t* stg = (LAS bf16_t*)(shm + A2_OST) + wid * 2048;
#pragma unroll
    for (int r = 0; r < 16; ++r) { const int orow = crow(r, hi); const float il = frcp(wsf[32 + orow]);
#pragma unroll
        for (int d0 = 0; d0 < 2; ++d0) stg[orow * 64 + d0 * 32 + r32] = (bf16_t)f2bf(o[d0][r] * il); }
    LDS_WAIT();
    const bf16_t* GB = (const bf16_t*)a.out; const bf16_t* HL = (const bf16_t*)(ws + WS_GR); const bf16_t* AC = (const bf16_t*)(ws + WS_GA); bf16_t* MG = (bf16_t*)(ws + WS_XR);
#pragma unroll
    for (int i = 0; i < 4; ++i) { const int row = i * 8 + (lane >> 3), ch = lane & 7; const u32x4 yv = *(const LAS u32x4*)(stg + row * 64 + ch * 8);
        const size_t go = (size_t)(q0 + wid * 32 + row) * 1024 + h * 64 + ch * 8;
        const u32x4 gb = *(const u32x4*)(GB + go), hl = *(const u32x4*)(HL + go), ac = *(const u32x4*)(AC + go); u32x4 w;
#pragma unroll
        for (int j = 0; j < 4; ++j) { const float c0 = carry[ch * 8 + 2 * j], c1 = carry[ch * 8 + 2 * j + 1];
            w[j] = pk2(lo2f(yv[j]) * lo2f(gb[j]) + lo2f(hl[j]) + lo2f(ac[j]) * c0, hi2f(yv[j]) * hi2f(gb[j]) + hi2f(hl[j]) + hi2f(ac[j]) * c1); }
        *(u32x4*)(MG + go) = w; }
    asm volatile("s_waitcnt vmcnt(0) lgkmcnt(0)\n\ts_barrier" ::: "memory");
#undef A2_DMAK
#undef A2_DMAV
#undef A2_WAITFULL
#undef A2_BAR
}


typedef int v8i __attribute__((ext_vector_type(8)));
constexpr int A4_K = 0, A4_V = 36864, A4_WS = 53248, A4_OST = 55296;
#define A4_PVM(pw_, vf_, acc_) __builtin_amdgcn_mfma_scale_f32_32x32x64_f8f6f4(pw_, vf_, acc_, 0, 0, 0, 0x7f7f7f7f, 0, 0x7f7f7f7f)
#define A4_CV(W, j, P, b) do { int w_ = __builtin_amdgcn_cvt_pk_fp8_f32(P[b], P[(b) + 1], 0, false); W[j] = __builtin_amdgcn_cvt_pk_fp8_f32(P[(b) + 2], P[(b) + 3], w_, true); } while (0)
#define A4_VLD(vf_, d0) do { const u32x4 x0_ = *(const LAS u32x4*)(vp + (d0) * 2048), x1_ = *(const LAS u32x4*)(vp + (d0) * 2048 + 512); \
        vf_ = (v8i){(int)x0_[0], (int)x0_[1], (int)x0_[2], (int)x0_[3], (int)x1_[0], (int)x1_[1], (int)x1_[2], (int)x1_[3]}; } while (0)

__device__ __forceinline__ void attn_unit_v4(int h, int qb, CArgs a, const LAS float* carry, LAS unsigned char* shm) {
    constexpr int ABL = 0;
    const int tid = threadIdx.x, lane = tid & 63, r32 = lane & 31, hi = lane >> 5; const int wid = __builtin_amdgcn_readfirstlane(tid >> 6);
    unsigned char* ws = a.ws;
    const bf16_t* QRAW = (const bf16_t*)(ws + WS_R1); const unsigned char* KI = ws + WS_KIMG + (size_t)h * 256 * 12288; const unsigned char* VI = (const unsigned char*)a.out + 32 * MiB + (size_t)h * 256 * 4096;
    const float* CS = (const float*)(ws + WS_CS); const float* qg = (const float*)a.in[15];
    const int q0 = qb * 256, rowq = q0 + wid * 32 + r32;
    const unsigned lds0 = (unsigned)(uintptr_t)shm;
    LAS float* wsf = (LAS float*)(shm + A4_WS) + wid * 64;
    const int NT = 4 * qb + 4, mylast = 4 * qb + (wid >> 1);
    const unsigned char* ksrc = KI + wid * 1024 + lane * 16; const unsigned char* vsrc = VI + wid * 1024 + lane * 16;
    const unsigned kdst = lds0 + A4_K + wid * 1024, vdst = lds0 + A4_V + wid * 1024;
#define A4_DMAK(t, slot) do { glds16(ksrc + (size_t)(t) * 12288, (unsigned)__builtin_amdgcn_readfirstlane(kdst + (slot) * 12288)); \
        if (wid < 4) glds16(ksrc + (size_t)(t) * 12288 + 8192, (unsigned)__builtin_amdgcn_readfirstlane(kdst + (slot) * 12288 + 8192)); } while (0)
#define A4_DMAV(t, slot) do { if (wid < 4) glds16(vsrc + (size_t)(t) * 4096, (unsigned)__builtin_amdgcn_readfirstlane(vdst + (slot) * 4096)); } while (0)
#define A4_BAR() asm volatile("s_waitcnt lgkmcnt(0)\n\ts_barrier" ::: "memory")
    bf16x8 qr[6];
    {
        const bf16_t* qp = QRAW + (size_t)rowq * 1536 + h * 96 + hi * 8;
        u32x4 raw[6]; float qv[6][8]; float ss = 0.f;
#pragma unroll
        for (int d0 = 0; d0 < 6; ++d0) raw[d0] = *(const u32x4*)(qp + d0 * 16);
        A4_DMAK(0, 0); A4_DMAV(0, 0); A4_DMAK(1, 1); A4_DMAV(1, 1); A4_DMAK(2, 2);
#pragma unroll
        for (int d0 = 0; d0 < 6; ++d0)
#pragma unroll
            for (int j = 0; j < 4; ++j) { qv[d0][2 * j] = lo2f(raw[d0][j]); qv[d0][2 * j + 1] = hi2f(raw[d0][j]); ss += qv[d0][2 * j] * qv[d0][2 * j] + qv[d0][2 * j + 1] * qv[d0][2 * j + 1]; }
        ss += __shfl_xor(ss, 32);
        const float rs = rsqrtf(ss * (1.f / 96.f) + EPS);
#pragma unroll
        for (int d0 = 0; d0 < 6; ++d0) { const f32x4 g0 = *(const f32x4*)(qg + d0 * 16 + hi * 8), g1 = *(const f32x4*)(qg + d0 * 16 + hi * 8 + 4);
#pragma unroll
            for (int j = 0; j < 4; ++j) { qv[d0][j] *= rs * g0[j]; qv[d0][4 + j] *= rs * g1[j]; } }
        const f32x4 c0 = *(const f32x4*)(CS + (size_t)rowq * 32 + hi * 8), c1 = *(const f32x4*)(CS + (size_t)rowq * 32 + hi * 8 + 4), s0 = *(const f32x4*)(CS + (size_t)rowq * 32 + 16 + hi * 8), s1 = *(const f32x4*)(CS + (size_t)rowq * 32 + 16 + hi * 8 + 4);
#pragma unroll
        for (int j = 0; j < 8; ++j) { const float cs = j < 4 ? c0[j & 3] : c1[j & 3], sn = j < 4 ? s0[j & 3] : s1[j & 3]; const float x1 = qv[4][j], x2 = qv[5][j]; qv[4][j] = x1 * cs - x2 * sn; qv[5][j] = x1 * sn + x2 * cs; }
#pragma unroll
        for (int d0 = 0; d0 < 6; ++d0) { u32x4 w;
#pragma unroll
            for (int j = 0; j < 4; ++j) w[j] = pk2(qv[d0][2 * j] * C2, qv[d0][2 * j + 1] * C2);
            qr[d0] = __builtin_bit_cast(bf16x8, w); }
    }
    if (wid >= 4) __builtin_amdgcn_s_setprio(1);
    float lsum = 0.f; f32x16 o[2]; o[0] = f32x16{}; o[1] = f32x16{};
    f32x16 pA0, pA1, pB0, pB1, negm; v8i pwo = (v8i){0, 0, 0, 0, 0, 0, 0, 0};
    if (wid < 4) asm volatile("s_waitcnt vmcnt(6)" ::: "memory"); else asm volatile("s_waitcnt vmcnt(2)" ::: "memory");
    A4_BAR();
    {
        const LAS unsigned char* kp = shm + A4_K + hi * 1024 + r32 * 16;
        pA0 = f32x16{}; pA1 = f32x16{};
#pragma unroll
        for (int d0 = 0; d0 < 6; ++d0) { pA0 = A2_MF(A2_KF(d0, 0), qr[d0], pA0); pA1 = A2_MF(A2_KF(d0, 1), qr[d0], pA1); }
        float rm = fmaxf(pA0[0], pA1[0]);
#pragma unroll
        for (int r = 1; r < 16; ++r) rm = fmaxf(rm, fmaxf(pA0[r], pA1[r]));
        rm = fmaxf(rm, __shfl_xor(rm, 32));
        const float nb = 64.f - rm;
#pragma unroll
        for (int r = 0; r < 16; ++r) { pA0[r] += nb; pA1[r] += nb; negm[r] = nb; }
        asm volatile("" : "+v"(negm));
    }
    int sk_next = 12288, sv_prev = 12288;
#define A4_STEP(C0, C1, N0, N1, t, HASN, HASP) do { \
        const LAS unsigned char* kp = shm + A4_K + sk_next + hi * 1024 + r32 * 16; const LAS unsigned char* vp = shm + A4_V + sv_prev + hi * 1024 + r32 * 16; \
        bf16x8 k0, k1, k2; v8i vfa, vfb, pwn; float sacc = 0.f; \
        A2_SB(); \
        if (HASN) { k0 = A2_KF(0, 0); k1 = A2_KF(0, 1); k2 = A2_KF(1, 0); if (HASP) A4_VLD(vfa, 0); A2_SB(); \
            N0 = A2_MF(k0, qr[0], negm); k0 = A2_KF(1, 1); A3E3(C0, 0);  A2_PIN(C0); A2_SB(); \
            N1 = A2_MF(k1, qr[0], negm); k1 = A2_KF(2, 0); A3E3(C0, 3);  A2_PIN(C0); A2_SB(); \
            N0 = A2_MF(k2, qr[1], N0);   k2 = A2_KF(2, 1); A3E3(C0, 6);  A2_PIN(C0); A2_SB(); \
            N1 = A2_MF(k0, qr[1], N1);   k0 = A2_KF(3, 0); A3E3(C0, 9);  A2_PIN(C0); A2_SB(); \
            if (HASP) { o[0] = A4_PVM(pwo, vfa, o[0]); A4_VLD(vfb, 1); } A4_CV(pwn, 0, C0, 0); A4_CV(pwn, 1, C0, 4); A3S4(C0, 0); A3S4(C0, 4); A2_PIN(pwn); A2_PIN(sacc); A2_SB(); \
            N0 = A2_MF(k1, qr[2], N0);   k1 = A2_KF(3, 1); A3E3(C0, 12); A2_PIN(C0); A2_SB(); \
            N1 = A2_MF(k2, qr[2], N1);   k2 = A2_KF(4, 0); C0[15] = fexp2(C0[15]); A3E2(C1, 0); A2_PIN(C0); A2_PIN(C1); A2_SB(); \
            N0 = A2_MF(k0, qr[3], N0);   k0 = A2_KF(4, 1); A3E3(C1, 2);  A2_PIN(C1); A2_SB(); \
            N1 = A2_MF(k1, qr[3], N1);   k1 = A2_KF(5, 0); A3E3(C1, 5);  A2_PIN(C1); A2_SB(); \
            if (HASP) { o[1] = A4_PVM(pwo, vfb, o[1]); } A4_CV(pwn, 2, C0, 8); A4_CV(pwn, 3, C0, 12); A4_CV(pwn, 4, C1, 0); A4_CV(pwn, 5, C1, 4); A3S4(C0, 8); A3S4(C0, 12); A3S4(C1, 0); A3S4(C1, 4); A2_PIN(pwn); A2_PIN(sacc); A2_SB(); \
            N0 = A2_MF(k2, qr[4], N0);   k2 = A2_KF(5, 1); A3E3(C1, 8);  A2_PIN(C1); A2_SB(); \
            N1 = A2_MF(k0, qr[4], N1);                      A3E3(C1, 11); A2_PIN(C1); A2_SB(); \
            N0 = A2_MF(k1, qr[5], N0);                      A3E2(C1, 14); A4_CV(pwn, 6, C1, 8); A3S4(C1, 8); A2_PIN(C1); A2_PIN(pwn); A2_PIN(sacc); A2_SB(); \
            N1 = A2_MF(k2, qr[5], N1);                      A4_CV(pwn, 7, C1, 12); A3S4(C1, 12); A2_PIN(pwn); A2_PIN(sacc); A2_SB(); \
        } else { \
            if (HASP) { A4_VLD(vfa, 0); A4_VLD(vfb, 1); } \
            _Pragma("unroll") for (int r_ = 0; r_ < 16; ++r_) { C0[r_] = fexp2(C0[r_]); C1[r_] = fexp2(C1[r_]); } \
            if (HASP) { o[0] = A4_PVM(pwo, vfa, o[0]); o[1] = A4_PVM(pwo, vfb, o[1]); } \
            A4_CV(pwn, 0, C0, 0); A4_CV(pwn, 1, C0, 4); A4_CV(pwn, 2, C0, 8); A4_CV(pwn, 3, C0, 12); A4_CV(pwn, 4, C1, 0); A4_CV(pwn, 5, C1, 4); A4_CV(pwn, 6, C1, 8); A4_CV(pwn, 7, C1, 12); \
            A3S4(C0, 0); A3S4(C0, 4); A3S4(C0, 8); A3S4(C0, 12); A3S4(C1, 0); A3S4(C1, 4); A3S4(C1, 8); A3S4(C1, 12); A2_SB(); \
        } \
        if ((t) > mylast) { pwn = (v8i){0, 0, 0, 0, 0, 0, 0, 0}; sacc = 0.f; } \
        pwo = pwn; lsum += sacc; \
        sk_next = (sk_next == 24576) ? 0 : sk_next + 12288; sv_prev = (sv_prev == 12288) ? 0 : sv_prev + 4096; \
    } while (0)
#define A3E3(P, b) do { P[b] = fexp2(P[b]); P[(b) + 1] = fexp2(P[(b) + 1]); P[(b) + 2] = fexp2(P[(b) + 2]); } while (0)
#define A3E2(P, b) do { P[b] = fexp2(P[b]); P[(b) + 1] = fexp2(P[(b) + 1]); } while (0)
#define A3S4(P, b) do { sacc += P[b]; sacc += P[(b) + 1]; sacc += P[(b) + 2]; sacc += P[(b) + 3]; } while (0)
#define A4_TOP(t) do { const int t_ = (t); \
        if (t_ - 1 <= NT - 4) { if (wid < 4) asm volatile("s_waitcnt vmcnt(3)" ::: "memory"); else asm volatile("s_waitcnt vmcnt(1)" ::: "memory"); } \
        else if (t_ - 1 == NT - 3 && wid < 4) { asm volatile("s_waitcnt vmcnt(1)" ::: "memory"); } else { asm volatile("s_waitcnt vmcnt(0)" ::: "memory"); } \
        A4_BAR(); if (t_ + 3 < NT) { glds16(kg3, (unsigned)__builtin_amdgcn_readfirstlane(kdst + dk)); if (wid < 4) glds16(kg3 + 8192, (unsigned)__builtin_amdgcn_readfirstlane(kdst + dk + 8192)); } \
        if (t_ + 2 < NT && wid < 4) glds16(vg2, (unsigned)__builtin_amdgcn_readfirstlane(vdst + dv)); \
        kg3 += 12288; vg2 += 4096; dk = (dk == 24576u) ? 0u : dk + 12288u; dv = (dv == 12288u) ? 0u : dv + 4096u; } while (0)
    const unsigned char* kg3 = ksrc + 3 * 12288; const unsigned char* vg2 = vsrc + 2 * 4096; unsigned dk = 0u, dv = 8192u;
    A4_TOP(0); A4_STEP(pA0, pA1, pB0, pB1, 0, true, false);
    A4_TOP(1); A4_STEP(pB0, pB1, pA0, pA1, 1, true, true);
    int t = 2;
    for (; t + 2 < NT; t += 2) {
        A4_TOP(t);     A4_STEP(pA0, pA1, pB0, pB1, t, true, true);
        A4_TOP(t + 1); A4_STEP(pB0, pB1, pA0, pA1, t + 1, true, true);
    }
    A4_TOP(t);     A4_STEP(pA0, pA1, pB0, pB1, t, true, true);
    A4_TOP(t + 1); A4_STEP(pB0, pB1, pA0, pA1, t + 1, false, true);
    {
        const LAS unsigned char* vp = shm + A4_V + sv_prev + hi * 1024 + r32 * 16; v8i vfa, vfb;
        A4_VLD(vfa, 0); A4_VLD(vfb, 1); o[0] = A4_PVM(pwo, vfa, o[0]); o[1] = A4_PVM(pwo, vfb, o[1]);
    }
#undef A4_STEP
#undef A4_TOP
#undef A3E3
#undef A3E2
#undef A3S4
    __builtin_amdgcn_s_setprio(0);
    lsum += __shfl_xor(lsum, 32);
    if (hi == 0) wsf[32 + r32] = lsum;
    LDS_WAIT();
    LAS bf16_t* stg = (LAS bf16_t*)(shm + A4_OST) + wid * 2048;
#pragma unroll
    for (int r = 0; r < 16; ++r) { const int orow = crow(r, hi); const float il = frcp(wsf[32 + orow]);
#pragma unroll
        for (int d0 = 0; d0 < 2; ++d0) stg[orow * 64 + d0 * 32 + r32] = (bf16_t)f2bf(o[d0][r] * il); }
    LDS_WAIT();
    const bf16_t* GB = (const bf16_t*)a.out; const bf16_t* HL = (const bf16_t*)(ws + WS_GR); const bf16_t* AC = (const bf16_t*)(ws + WS_GA); bf16_t* MG = (bf16_t*)(ws + WS_XR);
#pragma unroll
    for (int i = 0; i < 4; ++i) { const int row = i * 8 + (lane >> 3), ch = lane & 7; const u32x4 yv = *(const LAS u32x4*)(stg + row * 64 + ch * 8);
        const size_t go = (size_t)(q0 + wid * 32 + row) * 1024 + h * 64 + ch * 8;
        const u32x4 gb = *(const u32x4*)(GB + go), hl = *(const u32x4*)(HL + go), ac = *(const u32x4*)(AC + go); u32x4 w;
#pragma unroll
        for (int j = 0; j < 4; ++j) { const float c0 = carry[ch * 8 + 2 * j], c1 = carry[ch * 8 + 2 * j + 1];
            w[j] = pk2(lo2f(yv[j]) * lo2f(gb[j]) + lo2f(hl[j]) + lo2f(ac[j]) * c0, hi2f(yv[j]) * hi2f(gb[j]) + hi2f(hl[j]) + hi2f(ac[j]) * c1); }
        *(u32x4*)(MG + go) = w; }
    asm volatile("s_waitcnt vmcnt(0) lgkmcnt(0)\n\ts_barrier" ::: "memory");
#undef A4_DMAK
#undef A4_DMAV
#undef A4_BAR
}


constexpr int A5_K = 0, A5_V = 24576, A5_WS = 40960, A5_OST = 43008;
#define A5_QKM(k8_, q8_, c_) __builtin_amdgcn_mfma_scale_f32_32x32x64_f8f6f4(k8_, q8_, c_, 0, 0, 0, 0x7f7f7f7f, 0, 0x7f7f7f7f)
#define A5_K8(kf_, kb) do { const u32x4 x0_ = *(const LAS u32x4*)(kp + (kb) * 2048), x1_ = *(const LAS u32x4*)(kp + (kb) * 2048 + 512); \
        kf_ = (v8i){(int)x0_[0], (int)x0_[1], (int)x0_[2], (int)x0_[3], (int)x1_[0], (int)x1_[1], (int)x1_[2], (int)x1_[3]}; } while (0)
#define A5_KR(d0r, kb) (*(const LAS bf16x8*)(kp + 4096 + (d0r) * 2048 + (kb) * 512))

#ifndef MK_LATEDMA
#define MK_LATEDMA 0
#endif
#ifndef MK_KD
#define MK_KD 2
#endif
#ifndef MK_VD
#define MK_VD 1
#endif
template <int ABL> __device__ __forceinline__ void attn_unit_v5(int h, int qb, CArgs a, const LAS float* carry, LAS unsigned char* shm) {
    int tid = threadIdx.x; asm volatile("" : "+v"(tid));
    const int lane = tid & 63, r32 = lane & 31, hi = lane >> 5; const int wid = __builtin_amdgcn_readfirstlane(tid >> 6);
    unsigned char* ws = a.ws;
    const bf16_t* QRAW = (const bf16_t*)(ws + WS_R1); const unsigned char* KI = ws + WS_KIMG + (size_t)h * 256 * 8192; const unsigned char* VI = (const unsigned char*)a.out + 32 * MiB + (size_t)h * 256 * 4096;
    const float* CS = (const float*)(ws + WS_CS); const float* qg = (const float*)a.in[15];
    const int q0 = qb * 256, rowq = q0 + wid * 32 + r32;
    const unsigned lds0 = (unsigned)(uintptr_t)shm;
    const int NT = 4 * qb + 4, mylast = 4 * qb + (wid >> 1);
    const unsigned char* ksrc = KI + wid * 1024 + lane * 16; const unsigned char* vsrc = VI + wid * 1024 + lane * 16;
    constexpr int KD = MK_KD, VD = MK_VD, A5_K = 0, A5_V = KD * 8192, A5_WS = A5_V + (VD + 2) * 4096, A5_OST = A5_WS + 2048;
    const unsigned kdst = lds0 + A5_K + wid * 1024, vdst = lds0 + A5_V + wid * 1024;
#define A5_DMAK(t, slot) glds16(ksrc + (size_t)(t) * 8192, (unsigned)__builtin_amdgcn_readfirstlane(kdst + (slot) * 8192))
#define A5_DMAV(t, slot) do { if (wid < 4) glds16(vsrc + (size_t)(t) * 4096, (unsigned)__builtin_amdgcn_readfirstlane(vdst + (slot) * 4096)); } while (0)
#define A5_BAR() asm volatile("s_waitcnt lgkmcnt(0)\n\ts_barrier" ::: "memory")
#define A5_VMW(n_) do { const int vw_ = (n_); if (vw_ >= 7) asm volatile("s_waitcnt vmcnt(7)" ::: "memory"); else if (vw_ == 6) asm volatile("s_waitcnt vmcnt(6)" ::: "memory"); else if (vw_ == 5) asm volatile("s_waitcnt vmcnt(5)" ::: "memory"); else if (vw_ == 4) asm volatile("s_waitcnt vmcnt(4)" ::: "memory"); \
        else if (vw_ == 3) asm volatile("s_waitcnt vmcnt(3)" ::: "memory"); else if (vw_ == 2) asm volatile("s_waitcnt vmcnt(2)" ::: "memory"); else if (vw_ == 1) asm volatile("s_waitcnt vmcnt(1)" ::: "memory"); else asm volatile("s_waitcnt vmcnt(0)" ::: "memory"); } while (0)
    v8i q8; bf16x8 qr4, qr5;
    {
        const bf16_t* qp = QRAW + (size_t)rowq * 1536 + h * 96;
        u32x4 rawn[4], rawr[2]; float qn[32], qv4[8], qv5[8]; float ss = 0.f;
#pragma unroll
        for (int i = 0; i < 4; ++i) rawn[i] = *(const u32x4*)(qp + 32 * hi + 8 * i);
        rawr[0] = *(const u32x4*)(qp + 64 + 8 * hi); rawr[1] = *(const u32x4*)(qp + 80 + 8 * hi);
        f32x4 gq[8];
#pragma unroll
        for (int i = 0; i < 8; ++i) gq[i] = *(const f32x4*)(qg + 32 * hi + 4 * i);
        const f32x4 g0 = *(const f32x4*)(qg + 64 + hi * 8), g1 = *(const f32x4*)(qg + 64 + hi * 8 + 4), g2 = *(const f32x4*)(qg + 80 + hi * 8), g3 = *(const f32x4*)(qg + 80 + hi * 8 + 4);
        const f32x4 c0 = *(const f32x4*)(CS + (size_t)rowq * 32 + hi * 8), c1 = *(const f32x4*)(CS + (size_t)rowq * 32 + hi * 8 + 4), s0 = *(const f32x4*)(CS + (size_t)rowq * 32 + 16 + hi * 8), s1 = *(const f32x4*)(CS + (size_t)rowq * 32 + 16 + hi * 8 + 4);
#pragma unroll
        for (int tp = -KD; tp < 0; ++tp) { A5_DMAK(tp + KD, tp + KD); if (tp + VD >= 0) A5_DMAV(tp + VD, tp + VD); }
#pragma unroll
        for (int i = 0; i < 4; ++i)
#pragma unroll
            for (int j = 0; j < 4; ++j) { qn[8 * i + 2 * j] = lo2f(rawn[i][j]); qn[8 * i + 2 * j + 1] = hi2f(rawn[i][j]); }
#pragma unroll
        for (int j = 0; j < 4; ++j) { qv4[2 * j] = lo2f(rawr[0][j]); qv4[2 * j + 1] = hi2f(rawr[0][j]); qv5[2 * j] = lo2f(rawr[1][j]); qv5[2 * j + 1] = hi2f(rawr[1][j]); }
#pragma unroll
        for (int j = 0; j < 32; ++j) ss += qn[j] * qn[j];
#pragma unroll
        for (int j = 0; j < 8; ++j) ss += qv4[j] * qv4[j] + qv5[j] * qv5[j];
        ss += __shfl_xor(ss, 32);
        const float rs = rsqrtf(ss * (1.f / 96.f) + EPS);
#pragma unroll
        for (int i = 0; i < 8; ++i) { const f32x4 g = gq[i];
#pragma unroll
            for (int e = 0; e < 4; ++e) qn[4 * i + e] *= rs * g[e] * 1.1779544f; }
        {
#pragma unroll
          for (int j = 0; j < 4; ++j) { qv4[j] *= rs * g0[j]; qv4[4 + j] *= rs * g1[j]; qv5[j] *= rs * g2[j]; qv5[4 + j] *= rs * g3[j]; } }
#pragma unroll
        for (int j = 0; j < 8; ++j) { const float cs = j < 4 ? c0[j & 3] : c1[j & 3], sn = j < 4 ? s0[j & 3] : s1[j & 3]; const float x1 = qv4[j], x2 = qv5[j]; qv4[j] = x1 * cs - x2 * sn; qv5[j] = x1 * sn + x2 * cs; }
#pragma unroll
        for (int v = 0; v < 8; ++v) { const int w_ = __builtin_amdgcn_cvt_pk_fp8_f32(qn[4 * v], qn[4 * v + 1], 0, false); q8[v] = __builtin_amdgcn_cvt_pk_fp8_f32(qn[4 * v + 2], qn[4 * v + 3], w_, true); }
        u32x4 w4, w5;
#pragma unroll
        for (int j = 0; j < 4; ++j) { w4[j] = pk2(qv4[2 * j] * (8.f * C2), qv4[2 * j + 1] * (8.f * C2)); w5[j] = pk2(qv5[2 * j] * (8.f * C2), qv5[2 * j + 1] * (8.f * C2)); }
        qr4 = __builtin_bit_cast(bf16x8, w4); qr5 = __builtin_bit_cast(bf16x8, w5);
    }
    if (wid >= 4) __builtin_amdgcn_s_setprio(1);
    f32x16 o[2]; o[0] = f32x16{}; o[1] = f32x16{}; f32x4 lsum = {0.f, 0.f, 0.f, 0.f};
    f32x16 pA0, pA1, pB0, pB1, negm; v8i pwo = (v8i){0, 0, 0, 0, 0, 0, 0, 0};
    int onev = ((((lane >> 4) & 1) != 0) == ((lane & 15) >= 8)) ? 0x38383838 : 0; asm volatile("" : "+v"(onev));
    const v8i ones8 = (v8i){onev, onev, onev, onev, onev, onev, onev, onev};
#define A5_SUM(pw_) lsum = __builtin_amdgcn_mfma_scale_f32_16x16x128_f8f6f4(pw_, ones8, lsum, 0, 0, 0, 0x7f7f7f7f, 0, 0x7f7f7f7f)
    A5_VMW((KD - 1) + (wid < 4 ? VD : 0));
    A5_BAR();
    {
        const LAS unsigned char* kp = shm + A5_K + hi * 1024 + r32 * 16; v8i ka, kb8;
        A5_K8(ka, 0); A5_K8(kb8, 1);
        pA0 = A5_QKM(ka, q8, (f32x16{})); pA1 = A5_QKM(kb8, q8, (f32x16{}));
        pA0 = A2_MF(A5_KR(0, 0), qr4, pA0); pA1 = A2_MF(A5_KR(0, 1), qr4, pA1); pA0 = A2_MF(A5_KR(1, 0), qr5, pA0); pA1 = A2_MF(A5_KR(1, 1), qr5, pA1);
        float rm = fmaxf(pA0[0], pA1[0]);
#pragma unroll
        for (int r = 1; r < 16; ++r) rm = fmaxf(rm, fmaxf(pA0[r], pA1[r]));
        rm = fmaxf(rm, __shfl_xor(rm, 32));
        const float nb = 64.f - rm;
#pragma unroll
        for (int r = 0; r < 16; ++r) { pA0[r] += nb; pA1[r] += nb; negm[r] = nb; }
        asm volatile("" : "+v"(negm));
    }
    int sk_next = 8192, sv_prev = (VD + 1) * 4096;
#define A5_CVU(W, j, P, b) do { if (ABL == 4) { W[j] = pwo[j]; break; } unsigned w_ = __builtin_amdgcn_cvt_pk_u8_f32(P[b], 0, 0u); w_ = __builtin_amdgcn_cvt_pk_u8_f32(P[(b) + 1], 1, w_); w_ = __builtin_amdgcn_cvt_pk_u8_f32(P[(b) + 2], 2, w_); W[j] = (int)__builtin_amdgcn_cvt_pk_u8_f32(P[(b) + 3], 3, w_); } while (0)
#define A5_STEP(C0, C1, N0, N1, t, HASN, HASP) do { \
        const LAS unsigned char* kp = shm + A5_K + sk_next + hi * 1024 + r32 * 16; const LAS unsigned char* vp = shm + A5_V + sv_prev + hi * 1024 + r32 * 16; \
        v8i ka, kb8, vfa, vfb, pwn; bf16x8 r0, r1, r2, r3; \
        A2_SB(); \
        if (HASN) { A5_K8(ka, 0); A5_K8(kb8, 1); r0 = A5_KR(0, 0); r1 = A5_KR(0, 1); A2_SB(); \
            N0 = A5_QKM(ka, q8, negm);  r2 = A5_KR(1, 0); r3 = A5_KR(1, 1); if (HASP) A4_VLD(vfa, 0); A5_CVU(pwn, 0, C0, 0); A5_CVU(pwn, 1, C0, 4); A2_PIN(pwn); A2_SB(); \
            N1 = A5_QKM(kb8, q8, negm); if (HASP) A4_VLD(vfb, 1); if (MK_LATEDMA) A5_ISSUEK(t); A5_CVU(pwn, 2, C0, 8); A5_CVU(pwn, 3, C0, 12); A2_PIN(pwn); A2_SB(); \
            if (ABL != 5) N0 = A2_MF(r0, qr4, N0); A5_CVU(pwn, 4, C1, 0); A2_PIN(pwn); A2_SB(); \
            if (ABL != 5) N1 = A2_MF(r1, qr4, N1); A5_CVU(pwn, 5, C1, 4); A2_PIN(pwn); A2_SB(); \
            if (HASP) { o[0] = A4_PVM(pwo, vfa, o[0]); } if (MK_LATEDMA) A5_ISSUEV(t); A5_CVU(pwn, 6, C1, 8); A5_CVU(pwn, 7, C1, 12); A2_PIN(pwn); A2_SB(); \
            if (ABL != 5) N0 = A2_MF(r2, qr5, N0); A2_SB(); \
            if (ABL != 5) N1 = A2_MF(r3, qr5, N1); A2_SB(); \
            if (HASP) { o[1] = A4_PVM(pwo, vfb, o[1]); } A2_SB(); \
            if (HASP && ABL != 2) { A5_SUM(pwo); } A2_SB(); \
        } else { \
            if (HASP) { A4_VLD(vfa, 0); A4_VLD(vfb, 1); } \
            A5_CVU(pwn, 0, C0, 0); A5_CVU(pwn, 1, C0, 4); A5_CVU(pwn, 2, C0, 8); A5_CVU(pwn, 3, C0, 12); A5_CVU(pwn, 4, C1, 0); A5_CVU(pwn, 5, C1, 4); A5_CVU(pwn, 6, C1, 8); A5_CVU(pwn, 7, C1, 12); \
            if (HASP) { o[0] = A4_PVM(pwo, vfa, o[0]); o[1] = A4_PVM(pwo, vfb, o[1]); A5_SUM(pwo); } A2_SB(); \
        } \
        if ((t) > mylast) { pwn = (v8i){0, 0, 0, 0, 0, 0, 0, 0}; } \
        pwo = pwn; \
        sk_next = (sk_next == (KD - 1) * 8192) ? 0 : sk_next + 8192; sv_prev = (sv_prev == (VD + 1) * 4096) ? 0 : sv_prev + 4096; \
    } while (0)
#define A5_TOP(t) do { const int t_ = (t); int c_ = 0; \
        _Pragma("unroll") for (int b_ = 1; b_ <= KD - 2; ++b_) { c_ += (t_ - b_ + KD < NT) ? 1 : 0; if (wid < 4) c_ += (t_ - b_ + VD < NT) ? 1 : 0; } \
        A5_VMW(c_); \
        if (ABL != 3) A5_BAR(); if (!MK_LATEDMA) { A5_ISSUEK(t_); A5_ISSUEV(t_); } } while (0)
#define A5_ISSUEK(t_) do { if ((t_) + KD < NT) glds16(kg3, (unsigned)__builtin_amdgcn_readfirstlane(kdst + dk)); kg3 += 8192; dk = (dk == (KD - 1) * 8192u) ? 0u : dk + 8192u; } while (0)
#define A5_ISSUEV(t_) do { if ((t_) + VD < NT && wid < 4) glds16(vg2, (unsigned)__builtin_amdgcn_readfirstlane(vdst + dv)); vg2 += 4096; dv = (dv == (VD + 1) * 4096u) ? 0u : dv + 4096u; } while (0)
    const unsigned char* kg3 = ksrc + KD * 8192; const unsigned char* vg2 = vsrc + VD * 4096; unsigned dk = 0u, dv = VD * 4096u;
    A5_TOP(0); A5_STEP(pA0, pA1, pB0, pB1, 0, true, false);
    A5_TOP(1); A5_STEP(pB0, pB1, pA0, pA1, 1, true, true);
    int t = 2;
    for (; t + 2 < NT; t += 2) {
        A5_TOP(t);     A5_STEP(pA0, pA1, pB0, pB1, t, true, true);
        A5_TOP(t + 1); A5_STEP(pB0, pB1, pA0, pA1, t + 1, true, true);
    }
    A5_TOP(t);     A5_STEP(pA0, pA1, pB0, pB1, t, true, true);
    A5_TOP(t + 1); A5_STEP(pB0, pB1, pA0, pA1, t + 1, false, true);
    {
        const LAS unsigned char* vp = shm + A5_V + sv_prev + hi * 1024 + r32 * 16; v8i vfa, vfb;
        A4_VLD(vfa, 0); A4_VLD(vfb, 1); o[0] = A4_PVM(pwo, vfa, o[0]); o[1] = A4_PVM(pwo, vfb, o[1]); A5_SUM(pwo);
    }
#undef A5_STEP
#undef A5_TOP
#undef A5_ISSUEK
#undef A5_ISSUEV
#undef A5_CVU
#undef A5_SUM
    __builtin_amdgcn_s_setprio(0);
    LAS float* sums = (LAS float*)(shm + A5_WS) + wid * 64;
    if ((lane & 7) == 0) *(LAS f32x4*)(sums + ((lane & 8) ? 16 : 0) + 4 * (lane >> 4)) = lsum;
    LDS_WAIT();
    f32x4 ls4[4];
#pragma unroll
    for (int g = 0; g < 4; ++g) ls4[g] = *(const LAS f32x4*)(sums + 8 * g + 4 * hi);
    LAS bf16_t* stg = (LAS bf16_t*)(shm + A5_OST) + wid * 2048;
#pragma unroll
    for (int r = 0; r < 16; ++r) { const int orow = crow(r, hi); const float il = frcp(ls4[r >> 2][r & 3]);
#pragma unroll
        for (int d0 = 0; d0 < 2; ++d0) stg[orow * 64 + d0 * 32 + r32] = (bf16_t)f2bf(o[d0][r] * il); }
    LDS_WAIT();
    const bf16_t* GB = (const bf16_t*)a.out; const bf16_t* HL = (const bf16_t*)(ws + WS_GR); const bf16_t* AC = (const bf16_t*)(ws + WS_GA); bf16_t* MG = (bf16_t*)(ws + WS_XR);
#pragma unroll
    for (int i = 0; i < 4; ++i) { const int row = i * 8 + (lane >> 3), ch = lane & 7; const u32x4 yv = *(const LAS u32x4*)(stg + row * 64 + ch * 8);
        const size_t go = (size_t)(q0 + wid * 32 + row) * 1024 + h * 64 + ch * 8;
        const u32x4 gb = *(const u32x4*)(GB + go), hl = *(const u32x4*)(HL + go), ac = *(const u32x4*)(AC + go); u32x4 w;
#pragma unroll
        for (int j = 0; j < 4; ++j) { const float c0 = carry[ch * 8 + 2 * j], c1 = carry[ch * 8 + 2 * j + 1];
            w[j] = pk2(lo2f(yv[j]) * lo2f(gb[j]) + lo2f(hl[j]) + lo2f(ac[j]) * c0, hi2f(yv[j]) * hi2f(gb[j]) + hi2f(hl[j]) + hi2f(ac[j]) * c1); }
        *(u32x4*)(MG + go) = w; }
    asm volatile("s_waitcnt vmcnt(0) lgkmcnt(0)\n\ts_barrier" ::: "memory");
#undef A5_DMAK
#undef A5_DMAV
#undef A5_BAR
#undef A5_VMW
}

#ifndef MK_V7
#define MK_V7 1
#endif
#ifndef MK_PFVD
#define MK_PFVD 1
#endif
#ifndef MK_PF
#define MK_PF 0
#endif
#ifndef MK_PRIO
#define MK_PRIO 1
#endif
#ifndef MK_VW
#define MK_VW 0
#endif
#ifndef MK_PVF
#define MK_PVF 0
#endif
template <int ABL> __device__ __forceinline__ void attn_block_v7(int h, int s_, CArgs a, const LAS float* carry4, LAS unsigned char* shm) {
    int tid = threadIdx.x; asm volatile("" : "+v"(tid));
    const int lane0 = tid & 63; const int wid = __builtin_amdgcn_readfirstlane(tid >> 6);
    unsigned char* ws = a.ws;
    const bf16_t* QRAW = (const bf16_t*)(ws + WS_R1); const unsigned char* KI = ws + WS_KIMG + (size_t)h * 256 * 8192; const unsigned char* VI = (const unsigned char*)a.out + 32 * MiB + (size_t)h * 256 * 4096;
    const float* CS = (const float*)(ws + WS_CS); const float* qg = (const float*)a.in[15];
    const unsigned lds0 = (unsigned)(uintptr_t)shm; const bool vwave = MK_VW ? (wid >= 4) : (wid < 4); const int wv = wid & 3;
    constexpr int KD = MK_PF ? 3 : MK_KD, VD = MK_PF ? MK_PFVD : MK_VD, A5_K = 0, A5_V = KD * 8192, A5_WS = A5_V + (VD + 2) * 4096, A5_OST = A5_WS + 2048, A5_G = A5_OST + 8 * 4096;
    const unsigned kdst = lds0 + A5_K + wid * 1024, vdst = lds0 + A5_V + wv * 1024;
#define A5_DMAK(t, slot) glds16(ksrc_ + (size_t)(t) * 8192, (unsigned)__builtin_amdgcn_readfirstlane(kdst + (slot) * 8192))
#define A5_DMAV(t, slot) do { if (vwave) glds16(vsrc_ + (size_t)(t) * 4096, (unsigned)__builtin_amdgcn_readfirstlane(vdst + (slot) * 4096)); } while (0)
#define A5_BAR() asm volatile("s_waitcnt lgkmcnt(0)\n\ts_barrier" ::: "memory")
#define A5_VMW(n_) do { const int vw_ = (n_); if (vw_ >= 7) asm volatile("s_waitcnt vmcnt(7)" ::: "memory"); else if (vw_ == 6) asm volatile("s_waitcnt vmcnt(6)" ::: "memory"); else if (vw_ == 5) asm volatile("s_waitcnt vmcnt(5)" ::: "memory"); else if (vw_ == 4) asm volatile("s_waitcnt vmcnt(4)" ::: "memory"); \
        else if (vw_ == 3) asm volatile("s_waitcnt vmcnt(3)" ::: "memory"); else if (vw_ == 2) asm volatile("s_waitcnt vmcnt(2)" ::: "memory"); else if (vw_ == 1) asm volatile("s_waitcnt vmcnt(1)" ::: "memory"); else asm volatile("s_waitcnt vmcnt(0)" ::: "memory"); } while (0)
    LAS float* gl = (LAS float*)(shm + A5_G);
    if (tid < 96) gl[tid] = qg[tid];
    u32x4 rawn[4], rawr[2];
#define A7_LOADQ(qb_, L_) do { const int r32 = (L_) & 31, hi = (L_) >> 5; const unsigned char* ksrc_ = KI + wid * 1024 + (L_) * 16; const unsigned char* vsrc_ = VI + wv * 1024 + (L_) * 16; const int rq_ = (qb_) * 256 + wid * 32 + r32; const bf16_t* qp = QRAW + (size_t)rq_ * 1536 + h * 96; \
        _Pragma("unroll") for (int i_ = 0; i_ < 4; ++i_) rawn[i_] = *(const u32x4*)(qp + 32 * hi + 8 * i_); \
        rawr[0] = *(const u32x4*)(qp + 64 + 8 * hi); rawr[1] = *(const u32x4*)(qp + 80 + 8 * hi); \
        _Pragma("unroll") for (int tp = -KD; tp < 0; ++tp) { A5_DMAK(tp + KD, tp + KD); if (tp + VD >= 0) A5_DMAV(tp + VD, tp + VD); } } while (0)
    A7_LOADQ(s_, lane0);
    A5_BAR();
#pragma unroll 1
    for (int ui = 0; ui < 4; ++ui) {
    int lane = lane0; asm volatile("" : "+v"(lane));
    const int r32 = lane & 31, hi = lane >> 5;
    const unsigned char* ksrc = KI + wid * 1024; const unsigned char* vsrc = VI + wv * 1024; const unsigned loff = (unsigned)lane * 16u;
    int onev = ((((lane >> 4) & 1) != 0) == ((lane & 15) >= 8)) ? 0x38383838 : 0; asm volatile("" : "+v"(onev));
    const v8i ones8 = (v8i){onev, onev, onev, onev, onev, onev, onev, onev};
#define A5_SUM(pw_) lsum = __builtin_amdgcn_mfma_scale_f32_16x16x128_f8f6f4(pw_, ones8, lsum, 0, 0, 0, 0x7f7f7f7f, 0, 0x7f7f7f7f)
    const int qb = ((ui & 2) ? 32 : 0) + ((ui & 1) ? 31 - s_ : s_);
    const int q0 = qb * 256; const int NT = 4 * qb + 4, mylast = 4 * qb + (wid >> 1);
    const LAS float* carry = carry4 + ui * 64;
    v8i q8; bf16x8 qr4, qr5;
    {
        const int rowq = q0 + wid * 32 + r32;
        const f32x4 c0 = *(const f32x4*)(CS + (size_t)rowq * 32 + hi * 8), c1 = *(const f32x4*)(CS + (size_t)rowq * 32 + hi * 8 + 4), s0 = *(const f32x4*)(CS + (size_t)rowq * 32 + 16 + hi * 8), s1 = *(const f32x4*)(CS + (size_t)rowq * 32 + 16 + hi * 8 + 4);
        float qn[32], qv4[8], qv5[8]; float ss = 0.f;
        f32x4 gq[8];
#pragma unroll
        for (int i = 0; i < 8; ++i) gq[i] = *(const LAS f32x4*)(gl + 32 * hi + 4 * i);
        const f32x4 g0 = *(const LAS f32x4*)(gl + 64 + hi * 8), g1 = *(const LAS f32x4*)(gl + 64 + hi * 8 + 4), g2 = *(const LAS f32x4*)(gl + 80 + hi * 8), g3 = *(const LAS f32x4*)(gl + 80 + hi * 8 + 4);
#pragma unroll
        for (int i = 0; i < 4; ++i)
#pragma unroll
            for (int j = 0; j < 4; ++j) { qn[8 * i + 2 * j] = lo2f(rawn[i][j]); qn[8 * i + 2 * j + 1] = hi2f(rawn[i][j]); }
#pragma unroll
        for (int j = 0; j < 4; ++j) { qv4[2 * j] = lo2f(rawr[0][j]); qv4[2 * j + 1] = hi2f(rawr[0][j]); qv5[2 * j] = lo2f(rawr[1][j]); qv5[2 * j + 1] = hi2f(rawr[1][j]); }
#pragma unroll
        for (int j = 0; j < 32; ++j) ss += qn[j] * qn[j];
#pragma unroll
        for (int j = 0; j < 8; ++j) ss += qv4[j] * qv4[j] + qv5[j] * qv5[j];
        ss += __shfl_xor(ss, 32);
        const float rs = rsqrtf(ss * (1.f / 96.f) + EPS);
#pragma unroll
        for (int i = 0; i < 8; ++i) { const f32x4 g = gq[i];
#pragma unroll
            for (int e = 0; e < 4; ++e) qn[4 * i + e] *= rs * g[e] * 1.1779544f; }
        {
#pragma unroll
          for (int j = 0; j < 4; ++j) { qv4[j] *= rs * g0[j]; qv4[4 + j] *= rs * g1[j]; qv5[j] *= rs * g2[j]; qv5[4 + j] *= rs * g3[j]; } }
#pragma unroll
        for (int j = 0; j < 8; ++j) { const float cs = j < 4 ? c0[j & 3] : c1[j & 3], sn = j < 4 ? s0[j & 3] : s1[j & 3]; const float x1 = qv4[j], x2 = qv5[j]; qv4[j] = x1 * cs - x2 * sn; qv5[j] = x1 * sn + x2 * cs; }
#pragma unroll
        for (int v = 0; v < 8; ++v) { const int w_ = __builtin_amdgcn_cvt_pk_fp8_f32(qn[4 * v], qn[4 * v + 1], 0, false); q8[v] = __builtin_amdgcn_cvt_pk_fp8_f32(qn[4 * v + 2], qn[4 * v + 3], w_, true); }
        u32x4 w4, w5;
#pragma unroll
        for (int j = 0; j < 4; ++j) { w4[j] = pk2(qv4[2 * j] * (8.f * C2), qv4[2 * j + 1] * (8.f * C2)); w5[j] = pk2(qv5[2 * j] * (8.f * C2), qv5[2 * j + 1] * (8.f * C2)); }
        qr4 = __builtin_bit_cast(bf16x8, w4); qr5 = __builtin_bit_cast(bf16x8, w5);
    }
    if (MK_PRIO == 1 ? wid >= 4 : MK_PRIO == 2 ? vwave : false) __builtin_amdgcn_s_setprio(1);
    f32x16 o[2]; o[0] = f32x16{}; o[1] = f32x16{}; f32x4 lsum = {0.f, 0.f, 0.f, 0.f};
    f32x16 pA0, pA1, pB0, pB1, negm; v8i pwo = (v8i){0, 0, 0, 0, 0, 0, 0, 0};
    A5_VMW((MK_PF ? KD - 2 : KD - 1) + (vwave ? VD : 0));
    A5_BAR();
    {
        const LAS unsigned char* kp = shm + A5_K + hi * 1024 + r32 * 16; v8i ka, kb8;
        A5_K8(ka, 0); A5_K8(kb8, 1);
        pA0 = A5_QKM(ka, q8, (f32x16{})); pA1 = A5_QKM(kb8, q8, (f32x16{}));
        pA0 = A2_MF(A5_KR(0, 0), qr4, pA0); pA1 = A2_MF(A5_KR(0, 1), qr4, pA1); pA0 = A2_MF(A5_KR(1, 0), qr5, pA0); pA1 = A2_MF(A5_KR(1, 1), qr5, pA1);
        float rm = fmaxf(pA0[0], pA1[0]);
#pragma unroll
        for (int r = 1; r < 16; ++r) rm = fmaxf(rm, fmaxf(pA0[r], pA1[r]));
        rm = fmaxf(rm, __shfl_xor(rm, 32));
        const float nb = 64.f - rm;
#pragma unroll
        for (int r = 0; r < 16; ++r) { pA0[r] += nb; pA1[r] += nb; negm[r] = nb; }
        asm volatile("" : "+v"(negm));
    }
#if MK_PF
    v8i ka;
    { const LAS unsigned char* kp = shm + A5_K + 8192 + hi * 1024 + r32 * 16; A5_K8(ka, 0); }
    int sk_pf = 16384;
#endif
#if MK_PVF
    v8i vfa = q8, vfb = q8; int sv_cur = 0;
#endif
    int sk_next = 8192, sv_prev = (VD + 1) * 4096; v8i kst = q8; bf16x8 rst = qr4; if (ABL == 7) { asm volatile("" : "+v"(kst), "+v"(rst)); }
#define A5_CVU(W, j, P, b) do { if (ABL == 4) { W[j] = pwo[j]; break; } unsigned w_ = __builtin_amdgcn_cvt_pk_u8_f32(P[b], 0, 0u); w_ = __builtin_amdgcn_cvt_pk_u8_f32(P[(b) + 1], 1, w_); w_ = __builtin_amdgcn_cvt_pk_u8_f32(P[(b) + 2], 2, w_); W[j] = (int)__builtin_amdgcn_cvt_pk_u8_f32(P[(b) + 3], 3, w_); } while (0)
#define A5_STEP(C0, C1, N0, N1, t, HASN, HASP, HASN2) do { \
        const LAS unsigned char* kp = shm + A5_K + sk_next + hi * 1024 + r32 * 16; const LAS unsigned char* vp = shm + A5_V + sv_prev + hi * 1024 + r32 * 16; \
        v8i ka = kst, kb8 = kst, vfa = kst, vfb = kst, pwn; bf16x8 r0 = rst, r1 = rst, r2 = rst, r3 = rst; \
        A2_SB(); \
        if (HASN) { if (ABL != 7) { A5_K8(ka, 0); A5_K8(kb8, 1); r0 = A5_KR(0, 0); r1 = A5_KR(0, 1); } A2_SB(); \
            N0 = A5_QKM(ka, q8, negm);  if (ABL != 7) { r2 = A5_KR(1, 0); r3 = A5_KR(1, 1); if (HASP) A4_VLD(vfa, 0); } A5_CVU(pwn, 0, C0, 0); A5_CVU(pwn, 1, C0, 4); A2_PIN(pwn); A2_SB(); \
            N1 = A5_QKM(kb8, q8, negm); if (HASP && ABL != 7) A4_VLD(vfb, 1); if (MK_LATEDMA) A5_ISSUEK(t); A5_CVU(pwn, 2, C0, 8); A5_CVU(pwn, 3, C0, 12); A2_PIN(pwn); A2_SB(); \
            if (ABL != 5) N0 = A2_MF(r0, qr4, N0); A5_CVU(pwn, 4, C1, 0); A2_PIN(pwn); A2_SB(); \
            if (ABL != 5) N1 = A2_MF(r1, qr4, N1); A5_CVU(pwn, 5, C1, 4); A2_PIN(pwn); A2_SB(); \
            if (HASP) { o[0] = A4_PVM(pwo, vfa, o[0]); } if (MK_LATEDMA) A5_ISSUEV(t); A5_CVU(pwn, 6, C1, 8); A5_CVU(pwn, 7, C1, 12); A2_PIN(pwn); A2_SB(); \
            if (ABL != 5) N0 = A2_MF(r2, qr5, N0); A2_SB(); \
            if (ABL != 5) N1 = A2_MF(r3, qr5, N1); A2_SB(); \
            if (HASP) { o[1] = A4_PVM(pwo, vfb, o[1]); } A2_SB(); \
            if (HASP && ABL != 2) { A5_SUM(pwo); } A2_SB(); \
        } else { \
            if (HASP) { A4_VLD(vfa, 0); A4_VLD(vfb, 1); } \
            A5_CVU(pwn, 0, C0, 0); A5_CVU(pwn, 1, C0, 4); A5_CVU(pwn, 2, C0, 8); A5_CVU(pwn, 3, C0, 12); A5_CVU(pwn, 4, C1, 0); A5_CVU(pwn, 5, C1, 4); A5_CVU(pwn, 6, C1, 8); A5_CVU(pwn, 7, C1, 12); \
            if (HASP) { o[0] = A4_PVM(pwo, vfa, o[0]); o[1] = A4_PVM(pwo, vfb, o[1]); A5_SUM(pwo); } A2_SB(); \
        } \
        if ((t) > mylast) { pwn = (v8i){0, 0, 0, 0, 0, 0, 0, 0}; } \
        pwo = pwn; \
        sk_next = (sk_next == (KD - 1) * 8192) ? 0 : sk_next + 8192; sv_prev = (sv_prev == (VD + 1) * 4096) ? 0 : sv_prev + 4096; \
    } while (0)
#if MK_PF
#undef A5_STEP
#define A5_STEP(C0, C1, N0, N1, t, HASN, HASP, HASN2) do { \
        const LAS unsigned char* kp = shm + A5_K + sk_next + hi * 1024 + r32 * 16; const LAS unsigned char* vp = shm + A5_V + sv_prev + hi * 1024 + r32 * 16;        \
        v8i kb8, vfa, vfb, pwn; bf16x8 r0, r1, r2, r3; \
        A2_SB(); \
        if (HASN) { A5_K8(kb8, 1); r0 = A5_KR(0, 0); r1 = A5_KR(0, 1); A2_SB(); \
            N0 = A5_QKM(ka, q8, negm);  r2 = A5_KR(1, 0); r3 = A5_KR(1, 1); if (HASP) A4_VLD(vfa, 0); A5_CVU(pwn, 0, C0, 0); A5_CVU(pwn, 1, C0, 4); A2_PIN(pwn); A2_SB(); \
            N1 = A5_QKM(kb8, q8, negm); if (HASP) A4_VLD(vfb, 1); if (HASN2) { const LAS unsigned char* kp = shm + A5_K + sk_pf + hi * 1024 + r32 * 16; A5_K8(ka, 0); } A5_CVU(pwn, 2, C0, 8); A5_CVU(pwn, 3, C0, 12); A2_PIN(pwn); A2_SB(); \
            N0 = A2_MF(r0, qr4, N0); A5_CVU(pwn, 4, C1, 0); A2_PIN(pwn); A2_SB(); \
            N1 = A2_MF(r1, qr4, N1); A5_CVU(pwn, 5, C1, 4); A2_PIN(pwn); A2_SB(); \
            if (HASP) { o[0] = A4_PVM(pwo, vfa, o[0]); } A5_CVU(pwn, 6, C1, 8); A5_CVU(pwn, 7, C1, 12); A2_PIN(pwn); A2_SB(); \
            N0 = A2_MF(r2, qr5, N0); A2_SB(); \
            N1 = A2_MF(r3, qr5, N1); A2_SB(); \
            if (HASP) { o[1] = A4_PVM(pwo, vfb, o[1]); } A2_SB(); \
            if (HASP) { A5_SUM(pwo); } A2_SB(); \
        } else { \
            if (HASP) { A4_VLD(vfa, 0); A4_VLD(vfb, 1); } \
            A5_CVU(pwn, 0, C0, 0); A5_CVU(pwn, 1, C0, 4); A5_CVU(pwn, 2, C0, 8); A5_CVU(pwn, 3, C0, 12); A5_CVU(pwn, 4, C1, 0); A5_CVU(pwn, 5, C1, 4); A5_CVU(pwn, 6, C1, 8); A5_CVU(pwn, 7, C1, 12); \
            if (HASP) { o[0] = A4_PVM(pwo, vfa, o[0]); o[1] = A4_PVM(pwo, vfb, o[1]); A5_SUM(pwo); } A2_SB(); \
        } \
        if ((t) > mylast) { pwn = (v8i){0, 0, 0, 0, 0, 0, 0, 0}; } \
        pwo = pwn; \
        sk_next = (sk_next == (KD - 1) * 8192) ? 0 : sk_next + 8192; sv_prev = (sv_prev == (VD + 1) * 4096) ? 0 : sv_prev + 4096; sk_pf = (sk_pf == (KD - 1) * 8192) ? 0 : sk_pf + 8192; \
    } while (0)
#endif
#if MK_PVF
#undef A5_STEP
#define A5_STEP(C0, C1, N0, N1, t, HASN, HASP, HASN2) do { \
        const LAS unsigned char* kp = shm + A5_K + sk_next + hi * 1024 + r32 * 16; const LAS unsigned char* vp = shm + A5_V + sv_cur + hi * 1024 + r32 * 16;        \
        v8i ka, kb8, pwn; bf16x8 r0, r1, r2, r3; \
        A2_SB(); \
        if (HASN) { A5_K8(ka, 0); A5_K8(kb8, 1); r0 = A5_KR(0, 0); r1 = A5_KR(0, 1); A2_SB(); \
            if (HASP) { o[0] = A4_PVM(pwo, vfa, o[0]); } r2 = A5_KR(1, 0); r3 = A5_KR(1, 1); A5_CVU(pwn, 0, C0, 0); A5_CVU(pwn, 1, C0, 4); A2_PIN(pwn); A2_SB(); \
            if (HASP) { o[1] = A4_PVM(pwo, vfb, o[1]); } A5_CVU(pwn, 2, C0, 8); A5_CVU(pwn, 3, C0, 12); A2_PIN(pwn); A2_SB(); \
            if (HASP) { A5_SUM(pwo); } A5_CVU(pwn, 4, C1, 0); A2_PIN(pwn); A2_SB(); \
            N0 = A5_QKM(ka, q8, negm);  A4_VLD(vfa, 0); A5_CVU(pwn, 5, C1, 4); A5_CVU(pwn, 6, C1, 8); A2_PIN(pwn); A2_SB(); \
            N1 = A5_QKM(kb8, q8, negm); A4_VLD(vfb, 1); A5_CVU(pwn, 7, C1, 12); A2_PIN(pwn); A2_SB(); \
            N0 = A2_MF(r0, qr4, N0); A2_SB(); \
            N1 = A2_MF(r1, qr4, N1); A2_SB(); \
            N0 = A2_MF(r2, qr5, N0); A2_SB(); \
            N1 = A2_MF(r3, qr5, N1); A2_SB(); \
        } else { \
            A5_CVU(pwn, 0, C0, 0); A5_CVU(pwn, 1, C0, 4); A5_CVU(pwn, 2, C0, 8); A5_CVU(pwn, 3, C0, 12); A5_CVU(pwn, 4, C1, 0); A5_CVU(pwn, 5, C1, 4); A5_CVU(pwn, 6, C1, 8); A5_CVU(pwn, 7, C1, 12); \
            if (HASP) { o[0] = A4_PVM(pwo, vfa, o[0]); o[1] = A4_PVM(pwo, vfb, o[1]); A5_SUM(pwo); } A2_SB(); \
            A4_VLD(vfa, 0); A4_VLD(vfb, 1); A2_SB(); \
        } \
        if ((t) > mylast) { pwn = (v8i){0, 0, 0, 0, 0, 0, 0, 0}; } \
        pwo = pwn; \
        sk_next = (sk_next == (KD - 1) * 8192) ? 0 : sk_next + 8192; sv_cur = (sv_cur == (VD + 1) * 4096) ? 0 : sv_cur + 4096; \
    } while (0)
#endif
#define A5_TOP(t) do { const int t_ = (t); int c_ = 0; \
        if (!MK_PF) { _Pragma("unroll") for (int b_ = 1; b_ <= KD - 2; ++b_) { c_ += (t_ - b_ + KD < NT) ? 1 : 0; if (vwave) c_ += (t_ - b_ + VD < NT) ? 1 : 0; } } \
        A5_VMW(c_); \
        if (ABL != 3) A5_BAR(); if (!MK_LATEDMA) { A5_ISSUEK(t_); A5_ISSUEV(t_); } } while (0)
#define A5_ISSUEK(t_) do { if ((t_) + KD < NT && ABL != 6) glds16s(kg3, loff, (unsigned)__builtin_amdgcn_readfirstlane(kdst + dk)); kg3 += 8192; dk = (dk == (KD - 1) * 8192u) ? 0u : dk + 8192u; } while (0)
#define A5_ISSUEV(t_) do { if ((t_) + VD < NT && vwave && ABL != 6) glds16s(vg2, loff, (unsigned)__builtin_amdgcn_readfirstlane(vdst + dv)); vg2 += 4096; dv = (dv == (VD + 1) * 4096u) ? 0u : dv + 4096u; } while (0)
    const unsigned char* kg3 = ksrc + KD * 8192; const unsigned char* vg2 = vsrc + VD * 4096; unsigned dk = 0u, dv = VD * 4096u;
    A5_TOP(0); A5_STEP(pA0, pA1, pB0, pB1, 0, true, false, true);
    A5_TOP(1); A5_STEP(pB0, pB1, pA0, pA1, 1, true, true, true);
    int t = 2;
    for (; t + 2 < NT; t += 2) {
        A5_TOP(t);     A5_STEP(pA0, pA1, pB0, pB1, t, true, true, true);
        A5_TOP(t + 1); A5_STEP(pB0, pB1, pA0, pA1, t + 1, true, true, true);
    }
    A5_TOP(t);     A5_STEP(pA0, pA1, pB0, pB1, t, true, true, false);
    A5_TOP(t + 1); A5_STEP(pB0, pB1, pA0, pA1, t + 1, false, true, false);
#if MK_PVF
    { o[0] = A4_PVM(pwo, vfa, o[0]); o[1] = A4_PVM(pwo, vfb, o[1]); A5_SUM(pwo); }
#else
    {
        const LAS unsigned char* vp = shm + A5_V + sv_prev + hi * 1024 + r32 * 16; v8i vfa, vfb;
        A4_VLD(vfa, 0); A4_VLD(vfb, 1); o[0] = A4_PVM(pwo, vfa, o[0]); o[1] = A4_PVM(pwo, vfb, o[1]); A5_SUM(pwo);
    }
#endif
#undef A5_STEP
#undef A5_TOP
#undef A5_ISSUEK
#undef A5_ISSUEV
#undef A5_CVU
    __builtin_amdgcn_s_setprio(0);
    A5_BAR();
    int lane_e = lane; asm volatile("" : "+v"(lane_e));
    const int r32e = lane_e & 31, hie = lane_e >> 5;
    if (ui < 3) { const int qbn = (((ui + 1) & 2) ? 32 : 0) + (((ui + 1) & 1) ? 31 - s_ : s_); A7_LOADQ(qbn, lane_e); }
    LAS float* sums = (LAS float*)(shm + A5_WS) + wid * 64;
    if ((lane_e & 7) == 0) *(LAS f32x4*)(sums + ((lane_e & 8) ? 16 : 0) + 4 * (lane_e >> 4)) = lsum;
    LDS_WAIT();
    f32x4 ls4[4];
#pragma unroll
    for (int g = 0; g < 4; ++g) ls4[g] = *(const LAS f32x4*)(sums + 8 * g + 4 * hie);
    LAS bf16_t* stg = (LAS bf16_t*)(shm + A5_OST) + wid * 2048;
#pragma unroll
    for (int r = 0; r < 16; ++r) { const int orow = crow(r, hie); const float il = frcp(ls4[r >> 2][r & 3]);
#pragma unroll
        for (int d0 = 0; d0 < 2; ++d0) stg[orow * 64 + d0 * 32 + r32e] = (bf16_t)f2bf(o[d0][r] * il); }
    LDS_WAIT();
    const bf16_t* GB = (const bf16_t*)a.out; const bf16_t* HL = (const bf16_t*)(ws + WS_GR); const bf16_t* AC = (const bf16_t*)(ws + WS_GA); bf16_t* MG = (bf16_t*)(ws + WS_XR);
#pragma unroll
    for (int i = 0; i < 4; ++i) { const int row = i * 8 + (lane_e >> 3), ch = lane_e & 7; const u32x4 yv = *(const LAS u32x4*)(stg + row * 64 + ch * 8);
        const size_t go = (size_t)(q0 + wid * 32 + row) * 1024 + h * 64 + ch * 8;
        const u32x4 gb = *(const u32x4*)(GB + go), hl = *(const u32x4*)(HL + go), ac = *(const u32x4*)(AC + go); u32x4 w;
#pragma unroll
        for (int j = 0; j < 4; ++j) { const float c0 = carry[ch * 8 + 2 * j], c1 = carry[ch * 8 + 2 * j + 1];
            w[j] = pk2(lo2f(yv[j]) * lo2f(gb[j]) + lo2f(hl[j]) + lo2f(ac[j]) * c0, hi2f(yv[j]) * hi2f(gb[j]) + hi2f(hl[j]) + hi2f(ac[j]) * c1); }
        *(u32x4*)(MG + go) = w; }
    A2_PIN(rawr[0]); A2_PIN(rawr[1]); A2_PIN(rawn[0]); A2_PIN(rawn[1]); A2_PIN(rawn[2]); A2_PIN(rawn[3]);
    }
#undef A5_SUM
#undef A7_LOADQ
    asm volatile("s_waitcnt vmcnt(0) lgkmcnt(0)\n\ts_barrier" ::: "memory");
#undef A5_DMAK
#undef A5_DMAV
#undef A5_BAR
#undef A5_VMW
}

#ifndef MK_V6
#define MK_V6 0
#endif
#ifndef MK_MIDBAR
#define MK_MIDBAR 0
#endif
constexpr int A6_K = 0, A6_V = 49152, A6_WS = 73728, A6_OST = 75776;
template <int ABL> __device__ __forceinline__ void attn_unit_v6(int h, int qb, CArgs a, const LAS float* carry, LAS unsigned char* shm) {
    int tid = threadIdx.x; asm volatile("" : "+v"(tid));
    const int lane = tid & 63, r32 = lane & 31, hi = lane >> 5; const int wid = __builtin_amdgcn_readfirstlane(tid >> 6);
    unsigned char* ws = a.ws;
    const bf16_t* QRAW = (const bf16_t*)(ws + WS_R1); const unsigned char* KI = ws + WS_KIMG + (size_t)h * 256 * 8192; const unsigned char* VI = (const unsigned char*)a.out + 32 * MiB + (size_t)h * 256 * 4096;
    const float* CS = (const float*)(ws + WS_CS); const float* qg = (const float*)a.in[15];
    const int q0 = qb * 256, rowq = q0 + wid * 32 + r32;
    const unsigned lds0 = (unsigned)(uintptr_t)shm;
    const int NT = 4 * qb + 4, mylast = 4 * qb + (wid >> 1);
    const unsigned char* ksrc = KI + wid * 1024 + lane * 16; const unsigned char* vsrc = VI + (wid >> 2) * 4096 + (wid & 3) * 1024 + lane * 16;
    const unsigned kdst = lds0 + A6_K + wid * 1024, vdst = lds0 + A6_V + (wid >> 2) * 4096 + (wid & 3) * 1024;
#define A5_DMAK(t, slot) glds16(ksrc + (size_t)(t) * 8192, (unsigned)__builtin_amdgcn_readfirstlane(kdst + (slot) * 8192))
#define A5_DMAV(t, slot) glds16(vsrc + (size_t)(t) * 4096, (unsigned)__builtin_amdgcn_readfirstlane(vdst + (slot) * 4096))
#define A5_BAR() asm volatile("s_waitcnt lgkmcnt(0)\n\ts_barrier" ::: "memory")
    v8i q8; bf16x8 qr4, qr5;
    {
        const bf16_t* qp = QRAW + (size_t)rowq * 1536 + h * 96;
        u32x4 rawn[4], rawr[2]; float qn[32], qv4[8], qv5[8]; float ss = 0.f;
#pragma unroll
        for (int i = 0; i < 4; ++i) rawn[i] = *(const u32x4*)(qp + 32 * hi + 8 * i);
        rawr[0] = *(const u32x4*)(qp + 64 + 8 * hi); rawr[1] = *(const u32x4*)(qp + 80 + 8 * hi);
        A5_DMAK(0, 0); A5_DMAK(1, 1); A5_DMAK(2, 2); A5_DMAK(3, 3); A5_DMAV(0, 0);
#pragma unroll
        for (int i = 0; i < 4; ++i)
#pragma unroll
            for (int j = 0; j < 4; ++j) { qn[8 * i + 2 * j] = lo2f(rawn[i][j]); qn[8 * i + 2 * j + 1] = hi2f(rawn[i][j]); }
#pragma unroll
        for (int j = 0; j < 4; ++j) { qv4[2 * j] = lo2f(rawr[0][j]); qv4[2 * j + 1] = hi2f(rawr[0][j]); qv5[2 * j] = lo2f(rawr[1][j]); qv5[2 * j + 1] = hi2f(rawr[1][j]); }
#pragma unroll
        for (int j = 0; j < 32; ++j) ss += qn[j] * qn[j];
#pragma unroll
        for (int j = 0; j < 8; ++j) ss += qv4[j] * qv4[j] + qv5[j] * qv5[j];
        ss += __shfl_xor(ss, 32);
        const float rs = rsqrtf(ss * (1.f / 96.f) + EPS);
#pragma unroll
        for (int i = 0; i < 8; ++i) { const f32x4 g = *(const f32x4*)(qg + 32 * hi + 4 * i);
#pragma unroll
            for (int e = 0; e < 4; ++e) qn[4 * i + e] *= rs * g[e] * 1.1779544f; }
        { const f32x4 g0 = *(const f32x4*)(qg + 64 + hi * 8), g1 = *(const f32x4*)(qg + 64 + hi * 8 + 4), g2 = *(const f32x4*)(qg + 80 + hi * 8), g3 = *(const f32x4*)(qg + 80 + hi * 8 + 4);
#pragma unroll
          for (int j = 0; j < 4; ++j) { qv4[j] *= rs * g0[j]; qv4[4 + j] *= rs * g1[j]; qv5[j] *= rs * g2[j]; qv5[4 + j] *= rs * g3[j]; } }
        const f32x4 c0 = *(const f32x4*)(CS + (size_t)rowq * 32 + hi * 8), c1 = *(const f32x4*)(CS + (size_t)rowq * 32 + hi * 8 + 4), s0 = *(const f32x4*)(CS + (size_t)rowq * 32 + 16 + hi * 8), s1 = *(const f32x4*)(CS + (size_t)rowq * 32 + 16 + hi * 8 + 4);
#pragma unroll
        for (int j = 0; j < 8; ++j) { const float cs = j < 4 ? c0[j & 3] : c1[j & 3], sn = j < 4 ? s0[j & 3] : s1[j & 3]; const float x1 = qv4[j], x2 = qv5[j]; qv4[j] = x1 * cs - x2 * sn; qv5[j] = x1 * sn + x2 * cs; }
#pragma unroll
        for (int v = 0; v < 8; ++v) { const int w_ = __builtin_amdgcn_cvt_pk_fp8_f32(qn[4 * v], qn[4 * v + 1], 0, false); q8[v] = __builtin_amdgcn_cvt_pk_fp8_f32(qn[4 * v + 2], qn[4 * v + 3], w_, true); }
        u32x4 w4, w5;
#pragma unroll
        for (int j = 0; j < 4; ++j) { w4[j] = pk2(qv4[2 * j] * (8.f * C2), qv4[2 * j + 1] * (8.f * C2)); w5[j] = pk2(qv5[2 * j] * (8.f * C2), qv5[2 * j + 1] * (8.f * C2)); }
        qr4 = __builtin_bit_cast(bf16x8, w4); qr5 = __builtin_bit_cast(bf16x8, w5);
    }
    if (wid >= 4) __builtin_amdgcn_s_setprio(1);
    f32x16 o[2]; o[0] = f32x16{}; o[1] = f32x16{}; f32x4 lsum = {0.f, 0.f, 0.f, 0.f};
    f32x16 pA0, pA1, pB0, pB1, negm; v8i pwo = (v8i){0, 0, 0, 0, 0, 0, 0, 0};
    int onev = ((((lane >> 4) & 1) != 0) == ((lane & 15) >= 8)) ? 0x38383838 : 0; asm volatile("" : "+v"(onev));
    const v8i ones8 = (v8i){onev, onev, onev, onev, onev, onev, onev, onev};
#define A5_SUM(pw_) lsum = __builtin_amdgcn_mfma_scale_f32_16x16x128_f8f6f4(pw_, ones8, lsum, 0, 0, 0, 0x7f7f7f7f, 0, 0x7f7f7f7f)
    asm volatile("s_waitcnt vmcnt(3)" ::: "memory");
    A5_BAR();
    if (NT > 5) { A5_DMAK(4, 4); A5_DMAK(5, 5); } A5_DMAV(2, 2);
    {
        const LAS unsigned char* kp = shm + A6_K + hi * 1024 + r32 * 16; v8i ka, kb8;
        A5_K8(ka, 0); A5_K8(kb8, 1);
        pA0 = A5_QKM(ka, q8, (f32x16{})); pA1 = A5_QKM(kb8, q8, (f32x16{}));
        pA0 = A2_MF(A5_KR(0, 0), qr4, pA0); pA1 = A2_MF(A5_KR(0, 1), qr4, pA1); pA0 = A2_MF(A5_KR(1, 0), qr5, pA0); pA1 = A2_MF(A5_KR(1, 1), qr5, pA1);
        float rm = fmaxf(pA0[0], pA1[0]);
#pragma unroll
        for (int r = 1; r < 16; ++r) rm = fmaxf(rm, fmaxf(pA0[r], pA1[r]));
        rm = fmaxf(rm, __shfl_xor(rm, 32));
        const float nb = 64.f - rm;
#pragma unroll
        for (int r = 0; r < 16; ++r) { pA0[r] += nb; pA1[r] += nb; negm[r] = nb; }
        asm volatile("" : "+v"(negm));
    }
    int sk_next = 8192, sv_prev = 20480;
#define A5_CVU(W, j, P, b) do { if (ABL == 4) { W[j] = pwo[j]; break; } unsigned w_ = __builtin_amdgcn_cvt_pk_u8_f32(P[b], 0, 0u); w_ = __builtin_amdgcn_cvt_pk_u8_f32(P[(b) + 1], 1, w_); w_ = __builtin_amdgcn_cvt_pk_u8_f32(P[(b) + 2], 2, w_); W[j] = (int)__builtin_amdgcn_cvt_pk_u8_f32(P[(b) + 3], 3, w_); } while (0)
#define A5_STEP(C0, C1, N0, N1, t, HASN, HASP) do { \
        const LAS unsigned char* kp = shm + A6_K + sk_next + hi * 1024 + r32 * 16; const LAS unsigned char* vp = shm + A6_V + sv_prev + hi * 1024 + r32 * 16; \
        v8i ka, kb8, vfa, vfb, pwn; bf16x8 r0, r1, r2, r3; \
        A2_SB(); \
        if (HASN) { A5_K8(ka, 0); A5_K8(kb8, 1); r0 = A5_KR(0, 0); r1 = A5_KR(0, 1); A2_SB(); \
            N0 = A5_QKM(ka, q8, negm);  r2 = A5_KR(1, 0); r3 = A5_KR(1, 1); if (HASP) A4_VLD(vfa, 0); A5_CVU(pwn, 0, C0, 0); A5_CVU(pwn, 1, C0, 4); A2_PIN(pwn); A2_SB(); \
            N1 = A5_QKM(kb8, q8, negm); if (HASP) A4_VLD(vfb, 1); A5_CVU(pwn, 2, C0, 8); A5_CVU(pwn, 3, C0, 12); A2_PIN(pwn); A2_SB(); \
            if (ABL != 5) N0 = A2_MF(r0, qr4, N0); A5_CVU(pwn, 4, C1, 0); A2_PIN(pwn); A2_SB(); \
            if (ABL != 5) N1 = A2_MF(r1, qr4, N1); A5_CVU(pwn, 5, C1, 4); A2_PIN(pwn); A2_SB(); \
            if (HASP) { o[0] = A4_PVM(pwo, vfa, o[0]); } A5_CVU(pwn, 6, C1, 8); A5_CVU(pwn, 7, C1, 12); A2_PIN(pwn); A2_SB(); \
            if (ABL != 5) N0 = A2_MF(r2, qr5, N0); A2_SB(); \
            if (ABL != 5) N1 = A2_MF(r3, qr5, N1); A2_SB(); \
            if (HASP) { o[1] = A4_PVM(pwo, vfb, o[1]); } A2_SB(); \
            if (HASP && ABL != 2) { A5_SUM(pwo); } A2_SB(); \
        } else { \
            if (HASP) { A4_VLD(vfa, 0); A4_VLD(vfb, 1); } \
            A5_CVU(pwn, 0, C0, 0); A5_CVU(pwn, 1, C0, 4); A5_CVU(pwn, 2, C0, 8); A5_CVU(pwn, 3, C0, 12); A5_CVU(pwn, 4, C1, 0); A5_CVU(pwn, 5, C1, 4); A5_CVU(pwn, 6, C1, 8); A5_CVU(pwn, 7, C1, 12); \
            if (HASP) { o[0] = A4_PVM(pwo, vfa, o[0]); o[1] = A4_PVM(pwo, vfb, o[1]); A5_SUM(pwo); } A2_SB(); \
        } \
        if ((t) > mylast) { pwn = (v8i){0, 0, 0, 0, 0, 0, 0, 0}; } \
        pwo = pwn; \
        sk_next = (sk_next == 40960) ? 0 : sk_next + 8192; sv_prev = (sv_prev == 20480) ? 0 : sv_prev + 4096; \
    } while (0)
#define A5_TOP(t) do { const int t_ = (t); \
        if (t_ + 4 < NT) asm volatile("s_waitcnt vmcnt(3)" ::: "memory"); else if (t_ + 2 < NT) asm volatile("s_waitcnt vmcnt(1)" ::: "memory"); else asm volatile("s_waitcnt vmcnt(0)" ::: "memory"); \
        if (ABL != 3) A5_BAR(); \
        if (t_ + 6 < NT) { glds16(kg5, (unsigned)__builtin_amdgcn_readfirstlane(kdst + dk)); glds16(kg5 + 8192, (unsigned)__builtin_amdgcn_readfirstlane(kdst + dk + 8192u)); } \
        if (t_ + 4 < NT) glds16(vg3, (unsigned)__builtin_amdgcn_readfirstlane(vdst + dv)); \
        kg5 += 16384; vg3 += 8192; dk = (dk == 32768u) ? 0u : dk + 16384u; dv = (dv == 16384u) ? 0u : dv + 8192u; } while (0)
    const unsigned char* kg5 = ksrc + 6 * 8192; const unsigned char* vg3 = vsrc + 4 * 4096; unsigned dk = 0u, dv = 16384u;
    A5_STEP(pA0, pA1, pB0, pB1, 0, true, false);
    int t = 1;
    for (; t + 2 < NT; t += 2) {
        A5_TOP(t);
        A5_STEP(pB0, pB1, pA0, pA1, t, true, true);
        if (MK_MIDBAR) A5_BAR();
        A5_STEP(pA0, pA1, pB0, pB1, t + 1, true, true);
    }
    A5_TOP(t); A5_STEP(pB0, pB1, pA0, pA1, t, false, true);
    {
        const LAS unsigned char* vp = shm + A6_V + sv_prev + hi * 1024 + r32 * 16; v8i vfa, vfb;
        A4_VLD(vfa, 0); A4_VLD(vfb, 1); o[0] = A4_PVM(pwo, vfa, o[0]); o[1] = A4_PVM(pwo, vfb, o[1]); A5_SUM(pwo);
    }
#undef A5_STEP
#undef A5_TOP
#undef A5_CVU
#undef A5_SUM
    __builtin_amdgcn_s_setprio(0);
    LAS float* sums = (LAS float*)(shm + A6_WS) + wid * 64;
    if ((lane & 7) == 0) *(LAS f32x4*)(sums + ((lane & 8) ? 16 : 0) + 4 * (lane >> 4)) = lsum;
    LDS_WAIT();
    f32x4 ls4[4];
#pragma unroll
    for (int g = 0; g < 4; ++g) ls4[g] = *(const LAS f32x4*)(sums + 8 * g + 4 * hi);
    LAS bf16_t* stg = (LAS bf16_t*)(shm + A6_OST) + wid * 2048;
#pragma unroll
    for (int r = 0; r < 16; ++r) { const int orow = crow(r, hi); const float il = frcp(ls4[r >> 2][r & 3]);
#pragma unroll
        for (int d0 = 0; d0 < 2; ++d0) stg[orow * 64 + d0 * 32 + r32] = (bf16_t)f2bf(o[d0][r] * il); }
    LDS_WAIT();
    const bf16_t* GB = (const bf16_t*)a.out; const bf16_t* HL = (const bf16_t*)(ws + WS_GR); const bf16_t* AC = (const bf16_t*)(ws + WS_GA); bf16_t* MG = (bf16_t*)(ws + WS_XR);
#pragma unroll
    for (int i = 0; i < 4; ++i) { const int row = i * 8 + (lane >> 3), ch = lane & 7; const u32x4 yv = *(const LAS u32x4*)(stg + row * 64 + ch * 8);
        const size_t go = (size_t)(q0 + wid * 32 + row) * 1024 + h * 64 + ch * 8;
        const u32x4 gb = *(const u32x4*)(GB + go), hl = *(const u32x4*)(HL + go), ac = *(const u32x4*)(AC + go); u32x4 w;
#pragma unroll
        for (int j = 0; j < 4; ++j) { const float c0 = carry[ch * 8 + 2 * j], c1 = carry[ch * 8 + 2 * j + 1];
            w[j] = pk2(lo2f(yv[j]) * lo2f(gb[j]) + lo2f(hl[j]) + lo2f(ac[j]) * c0, hi2f(yv[j]) * hi2f(gb[j]) + hi2f(hl[j]) + hi2f(ac[j]) * c1); }
        *(u32x4*)(MG + go) = w; }
    asm volatile("s_waitcnt vmcnt(0) lgkmcnt(0)\n\ts_barrier" ::: "memory");
#undef A5_DMAK
#undef A5_DMAV
#undef A5_BAR
}

template <int ABL> __device__ __forceinline__ void p3_attention(Frame& F, CArgs a) {
    if (ABL == 9) {
        f32x16 c0 = f32x16{}, c1 = f32x16{}, c2 = f32x16{}, c3 = f32x16{}; f32x4 c4 = {0.f, 0.f, 0.f, 0.f};
        v8i x = (v8i){(int)F.tid, 1, 2, 3, 4, 5, 6, 7}; bf16x8 y = __builtin_bit_cast(bf16x8, (u32x4){(unsigned)F.tid, 1u, 2u, 3u});
#pragma unroll 1
        for (int it = 0; it < 520; ++it) {
            c0 = __builtin_amdgcn_mfma_scale_f32_32x32x64_f8f6f4(x, x, c0, 0, 0, 0, 0x7f7f7f7f, 0, 0x7f7f7f7f); c1 = __builtin_amdgcn_mfma_scale_f32_32x32x64_f8f6f4(x, x, c1, 0, 0, 0, 0x7f7f7f7f, 0, 0x7f7f7f7f);
            c2 = __builtin_amdgcn_mfma_f32_32x32x16_bf16(y, y, c2, 0, 0, 0); c3 = __builtin_amdgcn_mfma_f32_32x32x16_bf16(y, y, c3, 0, 0, 0);
            c0 = __builtin_amdgcn_mfma_scale_f32_32x32x64_f8f6f4(x, x, c0, 0, 0, 0, 0x7f7f7f7f, 0, 0x7f7f7f7f);
            c2 = __builtin_amdgcn_mfma_f32_32x32x16_bf16(y, y, c2, 0, 0, 0); c3 = __builtin_amdgcn_mfma_f32_32x32x16_bf16(y, y, c3, 0, 0, 0);
            c1 = __builtin_amdgcn_mfma_scale_f32_32x32x64_f8f6f4(x, x, c1, 0, 0, 0, 0x7f7f7f7f, 0, 0x7f7f7f7f);
            c4 = __builtin_amdgcn_mfma_scale_f32_16x16x128_f8f6f4(x, x, c4, 0, 0, 0, 0x7f7f7f7f, 0, 0x7f7f7f7f);
        }
        asm volatile("" :: "v"(c0), "v"(c1), "v"(c2), "v"(c3), "v"(c4));
        return;
    }
    const int head = (F.vcu >> 4) & 15, s = F.vcu & 15; const int qbs[4] = {s, 31 - s, 32 + s, 63 - s};
    LAS float* carry = (LAS float*)(F.lds + LDS_XCH);
    if (F.wave == 0) {
        const float* HEND = (const float*)(a.ws + WS_MISC + MISC_HEND); const float* AEND = (const float*)(a.ws + WS_MISC + MISC_AEND); const int c = head * 64 + LANE_NOW(); float cr = 0.f;
        for (int k = 0; k < 64; ++k) {
#pragma unroll
            for (int i = 0; i < 4; ++i) if (k == qbs[i]) carry[i * 64 + LANE_NOW()] = cr;
            cr = AEND[(size_t)k * 1024 + c] * cr + HEND[(size_t)k * 1024 + c];
        }
    }
    LDS_WAIT(); __syncthreads();
    if (F.vcu < 256)
        if (MK_FP8V && MK_FP8K && MK_V7) attn_block_v7<ABL>(head, s, a, carry, F.lds); else
        for (int i = 0; i < 4; ++i) { if (MK_FP8V && MK_FP8K && MK_V6) attn_unit_v6<ABL>(head, qbs[i], a, carry + i * 64, F.lds); else if (MK_FP8V && MK_FP8K) attn_unit_v5<ABL>(head, qbs[i], a, carry + i * 64, F.lds); else if (MK_FP8V) attn_unit_v4(head, qbs[i], a, carry + i * 64, F.lds); else attn_unit_v2<ABL>(head, qbs[i], a, carry + i * 64, F.lds); }
}

template <bool DRY> __device__ __forceinline__ void p6_route(Frame& F, CArgs a) {
    unsigned char* ws = a.ws; const float* H = a.out; const float* WR = (const float*)(ws + WS_MISC + MISC_WR);
    float* RH = (float*)(ws + WS_CTL + CTL_SSQ_H); const float* PH = (const float*)(ws + WS_SSQP + SSQP_H);
    const float* bg = (const float*)a.in[20]; const float* be = (const float*)a.in[22];
    unsigned* cnt = (unsigned*)(ws + WS_CTL) + CW_CNT; int* lists = (int*)(ws + WS_LIST); float* cwl = (float*)(ws + WS_LIST + 2 * MiB); unsigned* tokinfo = (unsigned*)(ws + WS_MISC + MISC_TOK);
    const int lane = LANE_NOW(), r = lane & 15, kq = lane >> 4, w4 = F.wave & 3, kh = F.wave >> 2;
    LAS float* lg = (LAS float*)F.lds + F.wave * (16 * 48);
    for (int rb0 = F.vcu * 4; rb0 < M / 16; rb0 += F.G * 4) {
        const int rb_ = rb0 + w4, rb = rb_ < M / 16 ? rb_ : M / 16 - 1;
        const float* hp = H + (size_t)(rb * 16 + r) * 1024 + 4 * kq + 512 * kh;
        const int c0 = r, c1 = 16 + r, c2 = (32 + r < 36) ? 32 + r : 35;
        const float* w0 = WR + (size_t)c0 * 1024 + 4 * kq + 512 * kh; const float* w1 = WR + (size_t)c1 * 1024 + 4 * kq + 512 * kh; const float* w2 = WR + (size_t)c2 * 1024 + 4 * kq + 512 * kh;
        f32x4 acc0 = {0.f, 0.f, 0.f, 0.f}, acc1 = acc0, acc2 = acc0;
#pragma unroll 8
        for (int S = 0; S < 32; ++S) {
            const f32x4 av = *(const f32x4*)(hp + 16 * S), b0 = *(const f32x4*)(w0 + 16 * S), b1 = *(const f32x4*)(w1 + 16 * S), b2 = *(const f32x4*)(w2 + 16 * S);
#pragma unroll
            for (int s4 = 0; s4 < 4; ++s4) { acc0 = __builtin_amdgcn_mfma_f32_16x16x4f32(av[s4], b0[s4], acc0, 0, 0, 0); acc1 = __builtin_amdgcn_mfma_f32_16x16x4f32(av[s4], b1[s4], acc1, 0, 0, 0); acc2 = __builtin_amdgcn_mfma_f32_16x16x4f32(av[s4], b2[s4], acc2, 0, 0, 0); }
        }
#pragma unroll
        for (int i = 0; i < 4; ++i) { lg[(4 * kq + i) * 48 + r] = acc0[i]; lg[(4 * kq + i) * 48 + 16 + r] = acc1[i]; lg[(4 * kq + i) * 48 + 32 + r] = acc2[i]; }
        LDS_WAIT(); __syncthreads();
        if (kh == 0 && lane < 16 && rb_ < M / 16) {
            const int tok = rb * 16 + lane; const float* pp = PH + (size_t)tok * 16; const f32x4 a0 = *(const f32x4*)pp, a1 = *(const f32x4*)(pp + 4), a2 = *(const f32x4*)(pp + 8), a3 = *(const f32x4*)(pp + 12);
            const float sh = (((a0[0] + a0[1]) + (a0[2] + a0[3])) + ((a1[0] + a1[1]) + (a1[2] + a1[3]))) + (((a2[0] + a2[1]) + (a2[2] + a2[3])) + ((a3[0] + a3[1]) + (a3[2] + a3[3])));
            const float rs = rsqrtf(sh * (1.f / 1024.f) + EPS);
            const LAS float* lr = lg + lane * 48; const LAS float* lr2 = lr + 4 * (16 * 48);
            float gl[4];
#pragma unroll
            for (int q = 0; q < 4; ++q) gl[q] = (lr[q] + lr2[q]) * rs + bg[q];
            int g = 0; float mx = gl[0];
#pragma unroll
            for (int q = 1; q < 4; ++q) if (gl[q] > mx) { mx = gl[q]; g = q; }
            float den = 0.f;
#pragma unroll
            for (int q = 0; q < 4; ++q) den += expf(gl[q] - mx);
            const float pg = 1.f / den;
            float v1 = -INFINITY, v2 = -INFINITY; int i1 = 0, i2 = 0;
#pragma unroll
            for (int q = 0; q < 8; ++q) { const float v = (lr[4 + g * 8 + q] + lr2[4 + g * 8 + q]) * rs + be[g * 8 + q];
                if (v > v1) { v2 = v1; i2 = i1; v1 = v; i1 = q; } else if (v > v2) { v2 = v; i2 = q; } }
            const float e2 = expf(v2 - v1), s1 = 1.f / (1.f + e2), s2 = e2 * s1; const int e1 = g * 8 + i1, eb = g * 8 + i2;
            if (DRY) { asm volatile("" :: "v"(s1 + s2 + pg), "v"(e1 + eb)); }
            else {
                RH[tok] = rs;
                const unsigned sl1 = atomicAdd(cnt + e1, 1u), sl2 = atomicAdd(cnt + eb, 1u);
                lists[(size_t)e1 * M + sl1] = tok; cwl[(size_t)e1 * M + sl1] = pg * s1; lists[(size_t)eb * M + sl2] = tok; cwl[(size_t)eb * M + sl2] = pg * s2;
                tokinfo[tok * 2] = ((unsigned)e1 << 16) | sl1; tokinfo[tok * 2 + 1] = ((unsigned)eb << 16) | sl2;
            }
        }
        LDS_WAIT(); __syncthreads();
    }
}

__device__ __forceinline__ void moe_prefix(Frame& F, CArgs a, volatile LAS int* tpre, volatile LAS int* cnts) {
    const unsigned* cnt = (const unsigned*)(a.ws + WS_CTL) + CW_CNT;
    if (F.wave == 0) {
        int ln = threadIdx.x; asm volatile("" : "+v"(ln)); ln &= 63; const int e = ln & 31; const int c = (int)__hip_atomic_load(cnt + e, RLX_AGENT); const int nt_ = (c + 255) >> 8; int inc = nt_;
#pragma unroll
        for (int d = 1; d < 32; d <<= 1) { const int v = __shfl_up(inc, d); if (e >= d) inc += v; }
        const int exc = inc - nt_;
        if (ln < 32) { tpre[e] = exc; cnts[e] = c; for (int q = 0; q < nt_; ++q) tpre[80 + exc + q] = e; if (e == 31) tpre[32] = inc; }
    }
    LDS_WAIT(); __syncthreads();
}

template <bool DRY> __device__ __forceinline__ void p8_final(Frame& F, CArgs a, const volatile LAS int* tpre) {
    float* out = a.out; const unsigned char* Y = (const unsigned char*)(a.ws + WS_Y); const unsigned* tokinfo = (const unsigned*)(a.ws + WS_MISC + MISC_TOK);
    const int gw = F.vcu * NWAVES + F.wave, NGW = F.G * NWAVES, lane = LANE_NOW();
    for (int tok = gw; tok < M; tok += NGW) {
        const unsigned i0 = tokinfo[tok * 2], i1 = tokinfo[tok * 2 + 1];
        const size_t s0 = (size_t)tpre[i0 >> 16] * 256 + (i0 & 0xffffu), s1 = (size_t)tpre[i1 >> 16] * 256 + (i1 & 0xffffu);
        const size_t c = 16 * lane; const u32x4 y0 = *(const u32x4*)(Y + s0 * 1024 + c), y1 = *(const u32x4*)(Y + s1 * 1024 + c);
#pragma unroll
        for (int q = 0; q < 4; ++q) { f32x4 h = *(const f32x4*)(out + (size_t)tok * 1024 + c + 4 * q);
            const f32x2 a01 = __builtin_amdgcn_cvt_pk_f32_fp8((int)y0[q], false), a23 = __builtin_amdgcn_cvt_pk_f32_fp8((int)y0[q], true), b01 = __builtin_amdgcn_cvt_pk_f32_fp8((int)y1[q], false), b23 = __builtin_amdgcn_cvt_pk_f32_fp8((int)y1[q], true);
            h[0] += (a01[0] + b01[0]) * 0.125f; h[1] += (a01[1] + b01[1]) * 0.125f; h[2] += (a23[0] + b23[0]) * 0.125f; h[3] += (a23[1] + b23[1]) * 0.125f;
            if (DRY) asm volatile("" :: "v"(h)); else *(f32x4*)(out + (size_t)tok * 1024 + c + 4 * q) = h; }
    }
}
constexpr int NPHASE = 10;
#ifndef MK_ONE_LAUNCH
#define MK_ONE_LAUNCH 1
#endif
#ifndef MK_DRY
#define MK_DRY 0
#endif
__global__ void __launch_bounds__(NTHREADS, 2) mega(Args a) {
    extern __shared__ __attribute__((aligned(16))) unsigned char lds_raw[];
    Frame F;
    F.lds = (LAS unsigned char*)lds_raw; F.MISC = (volatile LAS unsigned*)(F.lds + MISC_OFF);
    F.tid = threadIdx.x; F.lane = F.tid & 63; F.wave = __builtin_amdgcn_readfirstlane(F.tid >> 6);
    F.G = gridDim.x; { const int bx = blockIdx.x; F.vcu = (F.G % 8 == 0) ? (bx % 8) * (F.G / 8) + bx / 8 : bx; }
    const __attribute__((address_space(4))) Args* ap0 = (const __attribute__((address_space(4))) Args*)__builtin_amdgcn_kernarg_segment_ptr();
#define KA() (*({ const __attribute__((address_space(4))) Args* p_ = ap0; asm volatile("" : "+s"(p_)); p_; }))
    unsigned char* ws = a.ws; F.ctl = (gu32*)(ws + WS_CTL);
    for (int u = F.tid; u < (LDS_BYTES - LDSCTL_OFF) / 4; u += NTHREADS) ((LAS unsigned*)(F.lds + LDSCTL_OFF))[u] = 0u;
    __syncthreads();
    const int lo = a.ph_lo, hi = a.ph_hi;
    XcdBarrier bar; bar.bar = (unsigned*)(F.ctl + CW_BAR); bar.x = 0; bar.st = nullptr;
    if (hi - lo > 1) bar = xcd_barrier_post((unsigned*)(F.ctl + CW_BAR), F.MISC + 8);
#ifndef PH_MASK
#define PH_MASK 0x3ff
#endif
#define IN(k) (((PH_MASK >> (k)) & 1) && lo <= (k) && (k) < hi)
#ifdef MK_STAMPS
#define STAMP(k) do { if (blockIdx.x == 0 && F.tid == 0) ((unsigned long long*)(ws + WS_CTL + 400000))[k] = __builtin_amdgcn_s_memrealtime(); } while (0)
#else
#define STAMP(k) do {} while (0)
#endif
#ifndef MK_DOUBLE_MASK
#define MK_DOUBLE_MASK 0
#endif
#define REP(k) for (int rep_ = 0; rep_ < (((MK_DOUBLE_MASK >> (k)) & 1) ? 2 : 1); ++rep_)
#ifndef MK_XBAR
#define MK_XBAR 0
#endif
#define SEAM(k) do { if (IN(k) && IN((k) + 1)) { xcd_barrier(bar); if (MK_XBAR && (k) == 4) { for (int xb_ = 0; xb_ < 8; ++xb_) xcd_barrier(bar); } } STAMP((k) + 1); } while (0)
    volatile LAS int* tpre = (volatile LAS int*)(F.lds + LDS_XCH + 8192); volatile LAS int* cnts = tpre + 40;
    const int bx = (int)blockIdx.x;
#ifndef MK_CXV
#define MK_CXV 1
#endif
    const int cx = MK_CXV ? F.vcu : bx;

    STAMP(0);
    if (IN(0)) REP(0) { p0_prologue(F, KA()); SEAM(0); }
    if (IN(1) && MK_DRY == 11) {
        DenseOrder S; S.init(M, 5120, F.G, bx, ws + WS_R1, ws + WS_WIN, 1024, 1024);
        EpiNull E{}; gemm_phase<EpiNull, DenseOrder, true>(F.lds, 1024, 1024, S, E);
        xcd_barrier(bar);
    }
    if (IN(1) && MK_DRY == 1) {
        DenseOrder S; S.init(M, 5120, F.G, bx, ws + WS_R1, ws + WS_WIN, 1024, 1024);
        EpiProj E{(bf16_t*)(ws + WS_XR), (bf16_t*)(ws + WS_GR), (bf16_t*)(ws + WS_QC), (bf16_t*)(ws + WS_KVC), (bf16_t*)(ws + WS_GA), (bf16_t*)KA().out, (bf16_t*)(ws + WS_MISC + MISC_HALO), (float*)(ws + WS_KPE), (float*)(ws + WS_SSQP), (float*)(ws + WS_SSQP + SSQP_KV)};
        gemm_phase<EpiProj, DenseOrder, true>(F.lds, 1024, 1024, S, E);
        xcd_barrier(bar);
    }
    if (IN(6) && MK_DRY == 60) { moe_weight_convert(F, KA(), 0, F.vcu, F.G); xcd_barrier(bar); }
    if (IN(1)) REP(1) {
        DenseOrder S; S.init(M, 5120, F.G, bx, ws + WS_R1, ws + WS_WIN, 1024, 1024);
        EpiProj E{(bf16_t*)(ws + WS_XR), (bf16_t*)(ws + WS_GR), (bf16_t*)(ws + WS_QC), (bf16_t*)(ws + WS_KVC), (bf16_t*)(ws + WS_GA), (bf16_t*)KA().out, (bf16_t*)(ws + WS_MISC + MISC_HALO), (float*)(ws + WS_KPE), (float*)(ws + WS_SSQP), (float*)(ws + WS_SSQP + SSQP_KV)};
        gemm_phase<EpiProj, DenseOrder, true>(F.lds, 1024, 1024, S, E);
        SEAM(1);
    }
    if (IN(2)) { if (MK_DRY == 2) { p2a_conv<true>(F, KA()); xcd_barrier(bar); } p2a_conv<false>(F, KA()); SEAM(2); }
    if (IN(3)) {
        typedef EpiLruT<false> EpiLru;
#define P3_LRU() do { EpiLru EL{(const bf16_t*)(ws + WS_XR), (const float*)KA().in[7], (const float*)KA().in[9], (const float*)KA().in[10], (bf16_t*)(ws + WS_GR), (bf16_t*)(ws + WS_GA), (float*)(ws + WS_MISC + MISC_HEND), (float*)(ws + WS_MISC + MISC_AEND)}; \
            for (int half = 0; half < 2; ++half) { OneOrder S{half * F.G, 8, (const char*)(ws + WS_XR), (const char*)(ws + WS_WLRU), (size_t)256 * 1024 * 2, (size_t)256 * 256 * 2, 512, cx, 512}; \
                gemm_phase<EpiLru, OneOrder, false>(F.lds, 256, 1024, S, EL); } } while (0)
#define P3_QKV() P3_QKVS(3)
#define P3_QKVS(sel_) do { \
            if ((sel_) & 1) { DenseOrder S; S.init(M, 1536, F.G, bx, ws + WS_QC, ws + WS_WUQ, 768, 768, 0, 0, 1); EpiQ E{(bf16_t*)(ws + WS_R1), (float*)(ws + WS_CTL + CTL_SSQ_Q)}; gemm_phase<EpiQ, DenseOrder, true, true, 0x7a7a7a7a>(F.lds, 768, 768, S, E); } \
            if ((sel_) & 2) { DenseOrder S; S.init(M, 2048, F.G, bx, ws + WS_KVC, ws + WS_WUKV, 256, 256, 0, 0, 1); if (F.G == 256) { S.skew_h = 128; S.skew_a = 1; S.skew_b = 3; } \
              EpiKV E{ws + WS_KIMG, (unsigned char*)KA().out + 32 * MiB, (float*)(ws + WS_CTL + CTL_SSQ_KV), (const float*)(ws + WS_MISC + MISC_KSSQ), (const float*)(ws + WS_KPE), (const float*)KA().in[16]}; \
              gemm_phase<EpiKV, DenseOrder, true, true, 0x7b7b7b7b>(F.lds, 256, 256, S, E); } } while (0)
        if (MK_DRY == 31) {
            DenseOrder S; S.init(M, 2048, F.G, bx, ws + WS_KVC, ws + WS_WUKV, 256, 256, 0, 0, 1); if (F.G == 256) { S.skew_h = 128; S.skew_a = 1; S.skew_b = 3; }
            EpiNull E{}; gemm_phase<EpiNull, DenseOrder, true, true, 0x7b7b7b7b>(F.lds, 256, 256, S, E); xcd_barrier(bar); }
        if (MK_DRY == 32) {
            DenseOrder S; S.init(M, 2048, F.G, bx, ws + WS_KVC, ws + WS_WUKV, 256, 256, 0, 0, 1);
            EpiNull E{}; gemm_phase<EpiNull, DenseOrder, true, true, 0x7b7b7b7b>(F.lds, 256, 256, S, E); xcd_barrier(bar); }
        if (MK_DRY == 3) { typedef EpiLruT<true> EpiLruD;
            EpiLruD EL{(const bf16_t*)(ws + WS_XR), (const float*)KA().in[7], (const float*)KA().in[9], (const float*)KA().in[10], (bf16_t*)(ws + WS_GR), (bf16_t*)(ws + WS_GA), (float*)(ws + WS_MISC + MISC_HEND), (float*)(ws + WS_MISC + MISC_AEND)};
#ifndef MK_DRY3
#define MK_DRY3 7
#endif
            if (bx & 1) { if (MK_DRY3 & 1) for (int half = 0; half < 2; ++half) { OneOrder S{half * F.G, 8, (const char*)(ws + WS_XR), (const char*)(ws + WS_WLRU), (size_t)256 * 1024 * 2, (size_t)256 * 256 * 2, 512, cx, 512}; gemm_phase<EpiLruD, OneOrder, false>(F.lds, 256, 1024, S, EL); } if (MK_DRY3 & 6) P3_QKVS((MK_DRY3 >> 1) & 3); }
            else { if (MK_DRY3 & 6) P3_QKVS((MK_DRY3 >> 1) & 3); if (MK_DRY3 & 1) for (int half = 0; half < 2; ++half) { OneOrder S{half * F.G, 8, (const char*)(ws + WS_XR), (const char*)(ws + WS_WLRU), (size_t)256 * 1024 * 2, (size_t)256 * 256 * 2, 512, cx, 512}; gemm_phase<EpiLruD, OneOrder, false>(F.lds, 256, 1024, S, EL); } }
            xcd_barrier(bar); }
        if (bx & 1) { P3_LRU(); P3_QKV(); } else { P3_QKV(); P3_LRU(); }
#undef P3_LRU
#undef P3_QKV
#undef P3_QKVS
        SEAM(3);
    }
#ifndef MK_ABL
#define MK_ABL 0
#endif
    if (IN(4)) { if (MK_ABL) { p3_attention<MK_ABL>(F, KA()); xcd_barrier(bar); } p3_attention<0>(F, KA()); SEAM(4); }
    if (IN(5)) REP(5) {
        DenseOrder S; S.init(M, 1024, F.G, bx, ws + WS_XR, ws + WS_WOUT, 1024, 1024);
        EpiWout E{(const float*)KA().in[0], KA().out, (bf16_t*)(ws + WS_GR), (float*)(ws + WS_SSQP + SSQP_H)};
        gemm_phase<EpiWout, DenseOrder, true>(F.lds, 1024, 1024, S, E);
        SEAM(5);
    }
    if (IN(6)) { if (MK_DRY == 6) { p6_route<true>(F, KA()); xcd_barrier(bar); } if (MK_DRY == 61) { moe_weight_convert(F, KA(), 0, F.vcu, F.G); xcd_barrier(bar); } if (MK_DRY == 62) { moe_weight_convert(F, KA(), 1, F.vcu, F.G); xcd_barrier(bar); } p6_route<false>(F, KA()); moe_weight_convert(F, KA(), 0, F.vcu, F.G); SEAM(6); }
    if (IN(7) && MK_DRY == 7) {
        moe_prefix(F, KA(), tpre, cnts);
        MoeOrder S{tpre, cnts, 2, F.G, cx, (const char*)(ws + WS_GR), (const char*)(ws + WS_WGU), (size_t)512 * 1024, (size_t)256 * 1024, (const int*)(ws + WS_LIST), 1, 0};
        EpiMoeGU E{(bf16_t*)(ws + WS_GA), (float*)(ws + WS_CTL + CTL_SSQ_H), (const int*)(ws + WS_LIST)};
        gemm_phase<EpiMoeGU, MoeOrder, true, true, 0x7a7a7a7a>(F.lds, 1024, 1024, S, E);
        xcd_barrier(bar);
    }
    if (IN(8) && (MK_DRY == 82 || MK_DRY == 83)) {
        moe_prefix(F, KA(), tpre, cnts);
        MoeOrder S{tpre, cnts, 4, F.G, cx, (const char*)(ws + WS_GA), (const char*)(ws + WS_WDN), (size_t)1024 * 256, (size_t)256 * 256, (const int*)(ws + WS_LIST), 0, (size_t)256 * 256};
        typedef EpiMoeDownT<(MK_DRY == 82 ? 1 : 2)> EpiD; EpiD E{(bf16_t*)(ws + WS_Y), (const float*)(ws + WS_LIST + 2 * MiB)};
        gemm_phase<EpiD, MoeOrder, true, true, 0x7b7b7b7b>(F.lds, 256, 256, S, E);
        xcd_barrier(bar);
    }
    if (IN(8) && MK_DRY == 81) {
        moe_prefix(F, KA(), tpre, cnts);
        MoeOrder S{tpre, cnts, 4, F.G, cx, (const char*)(ws + WS_GA), (const char*)(ws + WS_WDN), (size_t)1024 * 256, (size_t)256 * 256, (const int*)(ws + WS_LIST), 0, (size_t)256 * 256};
        EpiNull E{}; gemm_phase<EpiNull, MoeOrder, true, true, 0x7b7b7b7b>(F.lds, 256, 256, S, E);
        xcd_barrier(bar);
    }
    if (IN(7) && MK_DRY == 71) {
        moe_prefix(F, KA(), tpre, cnts);
        MoeOrder S{tpre, cnts, 2, F.G, cx, (const char*)(ws + WS_GR), (const char*)(ws + WS_WGU), (size_t)512 * 1024, (size_t)256 * 1024, (const int*)(ws + WS_LIST), 1, 0};
        EpiNull E{}; gemm_phase<EpiNull, MoeOrder, true, true, 0x7a7a7a7a>(F.lds, 1024, 1024, S, E);
        xcd_barrier(bar);
    }
    if (IN(8) && MK_DRY == 8) {
        moe_prefix(F, KA(), tpre, cnts);
        MoeOrder S{tpre, cnts, 4, F.G, cx, (const char*)(ws + WS_GA), (const char*)(ws + WS_WDN), (size_t)1024 * 256, (size_t)256 * 256, (const int*)(ws + WS_LIST), 0, (size_t)256 * 256};
        EpiMoeDown E{(bf16_t*)(ws + WS_Y), (const float*)(ws + WS_LIST + 2 * MiB)};
        gemm_phase<EpiMoeDown, MoeOrder, true, true, 0x7b7b7b7b>(F.lds, 256, 256, S, E);
        xcd_barrier(bar);
    }
    if (IN(7)) REP(7) {
        moe_prefix(F, KA(), tpre, cnts);
        MoeOrder S{tpre, cnts, 2, F.G, cx, (const char*)(ws + WS_GR), (const char*)(ws + WS_WGU), (size_t)512 * 1024, (size_t)256 * 1024, (const int*)(ws + WS_LIST), 1, 0};
        EpiMoeGU E{(bf16_t*)(ws + WS_GA), (float*)(ws + WS_CTL + CTL_SSQ_H), (const int*)(ws + WS_LIST)};
        gemm_phase<EpiMoeGU, MoeOrder, true, true, 0x7a7a7a7a>(F.lds, 1024, 1024, S, E);
        { const int nG = 2 * tpre[32], heavy = nG > F.G ? (nG - F.G < F.G ? nG - F.G : F.G - 1) : 0;
          if (cx >= heavy) moe_weight_convert(F, KA(), 1, cx - heavy, F.G - heavy); }
        SEAM(7);
    }
    if (IN(8)) REP(8) {
        if (!IN(7)) moe_prefix(F, KA(), tpre, cnts);
        MoeOrder S{tpre, cnts, 4, F.G, cx, (const char*)(ws + WS_GA), (const char*)(ws + WS_WDN), (size_t)1024 * 256, (size_t)256 * 256, (const int*)(ws + WS_LIST), 0, (size_t)256 * 256};
        EpiMoeDown E{(bf16_t*)(ws + WS_Y), (const float*)(ws + WS_LIST + 2 * MiB)};
        gemm_phase<EpiMoeDown, MoeOrder, true, true, 0x7b7b7b7b>(F.lds, 256, 256, S, E);
        SEAM(8);
    }
    if (IN(9)) { if (!IN(8)) moe_prefix(F, KA(), tpre, cnts); if (MK_DRY == 9) { p8_final<true>(F, KA(), tpre); xcd_barrier(bar); } p8_final<false>(F, KA(), tpre); VM_WAIT(); STAMP(10); }
#undef IN
#undef SEAM
}

[[maybe_unused]] static void launch(void* const* d_in, float* d_out, unsigned char* ws, hipStream_t stream, int one_launch) {
    static int grid = 0;
    if (grid == 0) {
        int dev = 0, cus = 0;
        if (hipGetDevice(&dev) != hipSuccess || hipDeviceGetAttribute(&cus, hipDeviceAttributeMultiprocessorCount, dev) != hipSuccess) { fprintf(stderr, "device query failed\n"); grid = -1; return; }
        if (hipFuncSetAttribute((const void*)mega, hipFuncAttributeMaxDynamicSharedMemorySize, LDS_BYTES) != hipSuccess) { fprintf(stderr, "hipFuncSetAttribute failed\n"); grid = -1; return; }
        (void)hipGetLastError();
        grid = cus;
        if (grid != 256) fprintf(stderr, "warning: %d CUs (kernel built for 256)\n", grid);
    }
    if (grid < 0) return;
    (void)hipMemsetAsync(ws + WS_CTL + CW_BAR * 4, 0, (size_t)(CW_CNT - CW_BAR) * 4 + 256, stream);
    Args a{};
    for (int i = 0; i < 26; ++i) a.in[i] = d_in[i];
    a.out = d_out; a.ws = ws;
    if (one_launch) { a.ph_lo = 0; a.ph_hi = NPHASE; hipLaunchKernelGGL(mega, dim3(grid), dim3(NTHREADS), LDS_BYTES, stream, a); }
    else for (int p = 0; p < NPHASE; ++p) { a.ph_lo = p; a.ph_hi = p + 1; hipLaunchKernelGGL(mega, dim3(grid), dim3(NTHREADS), LDS_BYTES, stream, a); }
}
}
extern "C" void kernel_launch(void* const* d_in, const int* in_sizes, int n_in, void* d_out, int out_size, void* d_ws, size_t ws_size, hipStream_t stream) {
    (void)in_sizes; (void)n_in; (void)out_size; (void)ws_size;
    mk::launch(d_in, (float*)d_out, (unsigned char*)d_ws, stream, MK_ONE_LAUNCH);
}
```
